# Optimizing an MI355X kernel written in HIP

```python
import jax, jax.numpy as jnp
from jax import lax
import numpy as np

D_MODEL = 1024
BATCH = 32
SEQ = 256
DEPTH = 2
DEC_BATCH = 2
DEC_SEQ = 2048
PAST_LEN = 512

GRID_W = 64
HEAD_DIM = 64
GROUP_WIDTH = D_MODEL // 4
CONV_CH = GROUP_WIDTH
MLA_HEADS = GROUP_WIDTH // HEAD_DIM
MLA_NOPE = 64
MLA_ROPE = 32
MLA_V = GROUP_WIDTH // MLA_HEADS
MLA_Q_LORA = 192
MLA_KV_LORA = 128
GQA_HEADS = GROUP_WIDTH // HEAD_DIM
GQA_KV_HEADS = 2
SWA_HEADS = GROUP_WIDTH // HEAD_DIM
SWA_KV_HEADS = 2
WINDOW = 128
Q_BLOCK = 128
D_FF = 2816
ROPE_THETA = 10000.0
EPS = 1e-6
NEG_INF = -1e30
ATTN_SCALE = HEAD_DIM ** -0.5
MLA_SCALE = (MLA_NOPE + MLA_ROPE) ** -0.5
IN_SIZES = (3 * CONV_CH, MLA_Q_LORA, MLA_KV_LORA, MLA_ROPE, GQA_HEADS * HEAD_DIM,
            2 * GQA_KV_HEADS * HEAD_DIM, SWA_HEADS * HEAD_DIM, 2 * SWA_KV_HEADS * HEAD_DIM)
IN_COLS = sum(IN_SIZES)
IN_SPLITS = tuple(sum(IN_SIZES[:i + 1]) for i in range(len(IN_SIZES) - 1))

kernel_name = 'hybrid_parallel_group_diffusion_step'


def rmsnorm(x, g):
    xf = x.astype(jnp.float32)
    y = xf * lax.rsqrt(jnp.mean(xf * xf, axis=-1, keepdims=True) + EPS)
    return (y * g.astype(jnp.float32)).astype(x.dtype)


def conv3(x, w):
    xp = jnp.pad(x, ((0, 0), (1, 1), (0, 0)))
    return xp[:, :-2] * w[0] + xp[:, 1:-1] * w[1] + xp[:, 2:] * w[2]


def axial_tables(T, dim):
    rows = T // GRID_W
    row = jnp.repeat(jnp.arange(rows, dtype=jnp.float32), GRID_W)
    col = jnp.tile(jnp.arange(GRID_W, dtype=jnp.float32), rows)
    half = dim // 2
    inv = jnp.power(ROPE_THETA, -jnp.arange(0, half, 2, dtype=jnp.float32) / half)
    ar = row[:, None] * inv
    ac = col[:, None] * inv
    return (jnp.cos(ar)[:, None, :], jnp.sin(ar)[:, None, :], jnp.cos(ac)[:, None, :], jnp.sin(ac)[:, None, :])


def rope_half(x, c, s):
    x1, x2 = jnp.split(x, 2, axis=-1)
    return jnp.concatenate([x1 * c - x2 * s, x2 * c + x1 * s], axis=-1)


def axial_rope(x, tables):
    cr, sr, cc, sc = tables
    xr, xc = jnp.split(x.astype(jnp.float32), 2, axis=-1)
    return jnp.concatenate([rope_half(xr, cr, sr), rope_half(xc, cc, sc)], axis=-1).astype(x.dtype)


def group_heads(q, kvh):
    B, T, H, d = q.shape
    return q.reshape(B, T, kvh, H // kvh, d)


def blocked_attention(qs, ks, vs, scale, sink=None):
    B, T, KVH, G, _ = qs[0].shape
    nb = T // Q_BLOCK
    qb = tuple(jnp.moveaxis(q.reshape(B, nb, Q_BLOCK, *q.shape[2:]), 1, 0) for q in qs)
    sizes = [k.shape[1] for k in ks]

    def one(qblk):
        logits = [jnp.einsum('bqkgd,bskd->bkgqs', qi, ki).astype(jnp.float32) * scale for qi, ki in zip(qblk, ks)]
        if sink is not None:
            logits.append(jnp.broadcast_to(sink.reshape(KVH, G)[None, :, :, None, None].astype(jnp.float32),
                                           (B, KVH, G, Q_BLOCK, 1)))
        p = jax.nn.softmax(jnp.concatenate(logits, axis=-1), axis=-1)
        outs = []
        off = 0
        for vi, n in zip(vs, sizes):
            outs.append(jnp.einsum('bkgqs,bskd->bqkgd', p[..., off:off + n].astype(vi.dtype), vi))
            off += n
        return sum(outs[1:], outs[0])

    o = lax.map(one, qb)
    return jnp.moveaxis(o, 0, 1).reshape(B, T, -1)


def windowed_attention(q, k, v, q_ctx, k_ctx, v_ctx, sink, scale):
    B, T, KVH, G, Dh = q.shape
    nb = T // Q_BLOCK
    W3 = 3 * Q_BLOCK

    def band(a):
        ab = jnp.pad(a, ((0, 0), (Q_BLOCK, Q_BLOCK), (0, 0), (0, 0))).reshape(B, nb + 2, Q_BLOCK, KVH, a.shape[-1])
        return jnp.concatenate([ab[:, :-2], ab[:, 1:-1], ab[:, 2:]], axis=2)

    kw, vw = band(k), band(v)
    qb = q.reshape(B, nb, Q_BLOCK, KVH, G, Dh)
    qcb = q_ctx.reshape(B, nb, Q_BLOCK, KVH, G, Dh)
    qpos = jnp.arange(nb)[:, None, None] * Q_BLOCK + jnp.arange(Q_BLOCK)[None, :, None]
    kpos = jnp.arange(nb)[:, None, None] * Q_BLOCK - Q_BLOCK + jnp.arange(W3)[None, None, :]
    valid = (jnp.abs(kpos - qpos) <= WINDOW) & (kpos >= 0) & (kpos < T)
    s_loc = jnp.einsum('bnqkgd,bnskd->bnkgqs', qb, kw).astype(jnp.float32) * scale
    s_loc = jnp.where(valid[None, :, None, None], s_loc, NEG_INF)
    s_ctx = jnp.einsum('bnqkgd,bskd->bnkgqs', qcb, k_ctx).astype(jnp.float32) * scale
    s_sink = jnp.broadcast_to(sink.reshape(KVH, G)[None, None, :, :, None, None].astype(jnp.float32),
                              (B, nb, KVH, G, Q_BLOCK, 1))
    p = jax.nn.softmax(jnp.concatenate([s_loc, s_ctx, s_sink], axis=-1), axis=-1)
    L = k_ctx.shape[1]
    out = (jnp.einsum('bnkgqs,bnskd->bnqkgd', p[..., :W3].astype(vw.dtype), vw)
           + jnp.einsum('bnkgqs,bskd->bnqkgd', p[..., W3:W3 + L].astype(v_ctx.dtype), v_ctx))
    return out.reshape(B, T, KVH * G * Dh)


def mla_kv(ckv, kpe, w_kv_b):
    B, S, _ = ckv.shape
    kv = (ckv @ w_kv_b).reshape(B, S, MLA_HEADS, MLA_NOPE + MLA_V)
    k_nope, v = jnp.split(kv, [MLA_NOPE], axis=-1)
    k = jnp.concatenate([k_nope, jnp.broadcast_to(kpe, (B, S, MLA_HEADS, MLA_ROPE)).astype(k_nope.dtype)], axis=-1)
    return k, v


def layer(x, cond, lp, cache=None, ropes=None):
    B, T, _ = x.shape
    mod = (jax.nn.silu(cond) @ lp['w_ada'] + lp['b_ada'])[:, None, :]
    sh1, sc1, g1, sh2, sc2, g2 = jnp.split(mod, 6, axis=-1)
    h = rmsnorm(x, lp['norm1']) * (1 + sc1) + sh1
    proj = h @ lp['w_in']
    pa, pcq, pckv, pkpe, pq_c, pkv_c, pq_d, pkv_d = jnp.split(proj, IN_SPLITS, axis=-1)
    xa, gb, gc = jnp.split(pa, 3, axis=-1)
    y_a = gb * conv3(gc * xa, lp['conv_a'])
    cq = rmsnorm(pcq, lp['mla_q_norm'])
    q = (cq @ lp['mla_wq_b']).reshape(B, T, MLA_HEADS, MLA_NOPE + MLA_ROPE)
    q_nope, q_pe = jnp.split(q, [MLA_NOPE], axis=-1)
    ckv = rmsnorm(pckv, lp['mla_kv_norm'])
    kpe = pkpe[:, :, None, :]
    qc = rmsnorm(pq_c.reshape(B, T, GQA_HEADS, HEAD_DIM), lp['gqa_q_norm'])
    kc, vc = jnp.split(pkv_c.reshape(B, T, 2 * GQA_KV_HEADS, HEAD_DIM), 2, axis=2)
    kc = rmsnorm(kc, lp['gqa_k_norm'])
    qd = pq_d.reshape(B, T, SWA_HEADS, HEAD_DIM)
    kd, vd = jnp.split(pkv_d.reshape(B, T, 2 * SWA_KV_HEADS, HEAD_DIM), 2, axis=2)
    q_mla_raw = jnp.concatenate([q_nope, q_pe], axis=-1)[:, :, :, None, :]
    if cache is None:
        k_m, v_m = mla_kv(ckv, kpe, lp['mla_wkv_b'])
        y_b = blocked_attention((q_mla_raw,), (k_m,), (v_m,), MLA_SCALE)
        y_c = blocked_attention((group_heads(qc, GQA_KV_HEADS),), (kc,), (vc,), ATTN_SCALE)
        y_d = blocked_attention((group_heads(qd, SWA_KV_HEADS),), (kd,), (vd,), ATTN_SCALE, lp['swa_sink'])
        new = (ckv, pkpe, kc, vc, kd, vd)
    else:
        ckv_x, kpe_x, kc_x, vc_x, kd_x, vd_x = cache
        rope64, rope32 = ropes
        q_mla_rot = jnp.concatenate([q_nope, axial_rope(q_pe, rope32)], axis=-1)[:, :, :, None, :]
        k_l, v_l = mla_kv(ckv, axial_rope(kpe, rope32), lp['mla_wkv_b'])
        k_x, v_x = mla_kv(ckv_x, kpe_x[:, :, None, :], lp['mla_wkv_b'])
        y_b = blocked_attention((q_mla_rot, q_mla_raw), (k_l, k_x), (v_l, v_x), MLA_SCALE)
        y_c = blocked_attention((group_heads(axial_rope(qc, rope64), GQA_KV_HEADS), group_heads(qc, GQA_KV_HEADS)),
                                (axial_rope(kc, rope64), kc_x), (vc, vc_x), ATTN_SCALE)
        y_d = windowed_attention(group_heads(axial_rope(qd, rope64), SWA_KV_HEADS), axial_rope(kd, rope64), vd,
                                 group_heads(qd, SWA_KV_HEADS), kd_x, vd_x, lp['swa_sink'], ATTN_SCALE)
        new = None
    y = jnp.concatenate([y_a, y_b, y_c, y_d], axis=-1) @ lp['w_out']
    x = x + g1 * y
    h = rmsnorm(x, lp['norm2']) * (1 + sc2) + sh2
    u = conv3(h @ lp['w_up'], lp['conv_ff'])
    ua, ub = jnp.split(u, 2, axis=-1)
    x = x + g2 * ((jax.nn.silu(ua) * ub) @ lp['w_down'])
    return x, new


def setup_inputs(seed: int = 0) -> dict:
    key = jax.random.key(seed)
    ks = iter(jax.random.split(key, 32))
    nrm = lambda shape, s: jax.random.normal(next(ks), shape, jnp.float32) * s
    gain = lambda shape: 1.0 + nrm(shape, 0.05)
    L = DEPTH
    return {
        'x_prompt': nrm((BATCH, SEQ, D_MODEL), 1.0),
        'x_sample': nrm((DEC_BATCH, DEC_SEQ, D_MODEL), 1.0),
        'cache_mla_ckv': nrm((DEC_BATCH, L, PAST_LEN, MLA_KV_LORA), 1.0),
        'cache_mla_kpe': nrm((DEC_BATCH, L, PAST_LEN, MLA_ROPE), 1.0),
        'cache_gqa_k': nrm((DEC_BATCH, L, PAST_LEN, GQA_KV_HEADS, HEAD_DIM), 1.0),
        'cache_gqa_v': nrm((DEC_BATCH, L, PAST_LEN, GQA_KV_HEADS, HEAD_DIM), 1.0),
        'cache_swa_k': nrm((DEC_BATCH, L, PAST_LEN, SWA_KV_HEADS, HEAD_DIM), 1.0),
        'cache_swa_v': nrm((DEC_BATCH, L, PAST_LEN, SWA_KV_HEADS, HEAD_DIM), 1.0),
        'c': nrm((DEC_BATCH, D_MODEL), 1.0),
        'c_ctx': nrm((D_MODEL,), 1.0),
        'w_ada': nrm((L, D_MODEL, 6 * D_MODEL), D_MODEL ** -0.5),
        'b_ada': nrm((L, 6 * D_MODEL), 0.01),
        'norm1': gain((L, D_MODEL)),
        'w_in': nrm((L, D_MODEL, IN_COLS), D_MODEL ** -0.5),
        'conv_a': nrm((L, 3, CONV_CH), 0.5),
        'mla_q_norm': gain((L, MLA_Q_LORA)),
        'mla_wq_b': nrm((L, MLA_Q_LORA, MLA_HEADS * (MLA_NOPE + MLA_ROPE)), MLA_Q_LORA ** -0.5),
        'mla_kv_norm': gain((L, MLA_KV_LORA)),
        'mla_wkv_b': nrm((L, MLA_KV_LORA, MLA_HEADS * (MLA_NOPE + MLA_V)), MLA_KV_LORA ** -0.5),
        'gqa_q_norm': gain((L, HEAD_DIM)),
        'gqa_k_norm': gain((L, HEAD_DIM)),
        'swa_sink': nrm((L, SWA_HEADS), 0.5),
        'w_out': nrm((L, D_MODEL, D_MODEL), D_MODEL ** -0.5),
        'norm2': gain((L, D_MODEL)),
        'w_up': nrm((L, D_MODEL, 2 * D_FF), D_MODEL ** -0.5),
        'conv_ff': nrm((L, 3, 2 * D_FF), 0.5),
        'w_down': nrm((L, D_FF, D_MODEL), D_FF ** -0.5),
        'final_norm': gain((D_MODEL,)),
    }


def reference(x_prompt, x_sample, cache_mla_ckv, cache_mla_kpe, cache_gqa_k, cache_gqa_v, cache_swa_k, cache_swa_v,
              c, c_ctx, w_ada, b_ada, norm1, w_in, conv_a, mla_q_norm, mla_wq_b, mla_kv_norm, mla_wkv_b,
              gqa_q_norm, gqa_k_norm, swa_sink, w_out, norm2, w_up, conv_ff, w_down, final_norm):
    T_lat = x_sample.shape[1]
    ropes = (axial_tables(T_lat, HEAD_DIM), axial_tables(T_lat, MLA_ROPE))
    xp, xs = x_prompt, x_sample
    states = []
    for l in range(DEPTH):
        lp = {'w_ada': w_ada[l], 'b_ada': b_ada[l], 'norm1': norm1[l], 'w_in': w_in[l], 'conv_a': conv_a[l],
              'mla_q_norm': mla_q_norm[l], 'mla_wq_b': mla_wq_b[l], 'mla_kv_norm': mla_kv_norm[l],
              'mla_wkv_b': mla_wkv_b[l], 'gqa_q_norm': gqa_q_norm[l], 'gqa_k_norm': gqa_k_norm[l],
              'swa_sink': swa_sink[l], 'w_out': w_out[l], 'norm2': norm2[l], 'w_up': w_up[l],
              'conv_ff': conv_ff[l], 'w_down': w_down[l]}
        xp, st = layer(xp, c_ctx[None, :], lp)
        states.append(st)
        cache_l = (cache_mla_ckv[:, l], cache_mla_kpe[:, l], cache_gqa_k[:, l], cache_gqa_v[:, l],
                   cache_swa_k[:, l], cache_swa_v[:, l])
        xs, _ = layer(xs, c, lp, cache_l, ropes)
    new_mla_ckv, new_mla_kpe, new_gqa_k, new_gqa_v, new_swa_k, new_swa_v = [
        jnp.stack([s[i] for s in states], axis=1) for i in range(6)]
    y_prompt = rmsnorm(xp, final_norm)
    y_sample = rmsnorm(xs, final_norm)
    return (y_prompt, y_sample, new_mla_ckv, new_mla_kpe, new_gqa_k, new_gqa_v, new_swa_k, new_swa_v)
```

```cpp
#include <hip/hip_runtime.h>
#include <hip/hip_cooperative_groups.h>
#include <cstdio>
#include <cstdint>
namespace cg = cooperative_groups;

namespace pg8 {
#define PG8_LAS __attribute__((address_space(3)))
typedef unsigned short bf16_t;
typedef short bf16x8 __attribute__((ext_vector_type(8)));
typedef float f32x4 __attribute__((ext_vector_type(4)));
typedef unsigned u32x4 __attribute__((ext_vector_type(4)));
constexpr int BM = 256, BK = 64, HALF = 128, HTB = HALF * BK * 2, STAGE_BYTES = 8 * HTB, NXCD = 8, WGM = 8;

__host__ __device__ __forceinline__ int lds_byte(int r, int c) { const int st = (r >> 4) * 2 + (c >> 5), rr = r & 15, cc = c & 31, ob = rr * 64 + cc * 2; return st * 1024 + (ob ^ (((ob >> 9) & 1) << 5)); }
__host__ __device__ __forceinline__ void stage_rc(int b, int& R, int& C) { const int st = b / 1024, sb = b % 1024, swz = sb ^ (((sb >> 9) & 1) << 5); R = (st >> 1) * 16 + swz / 64; C = (st & 1) * 32 + (swz % 64) / 2; }
__host__ __device__ __forceinline__ int perm32(int rho) { const int n = rho >> 4, i = rho & 15; return 8 * (i >> 2) + 4 * n + (i & 3); }

struct Unit { int pm, pn; };
struct Gemm { const bf16_t* A; const bf16_t* Bt; int M, N, K; };

struct StaticOrder {
    int nM, nN, nwg, G, c;
    __host__ __device__ void init(int M, int N, int G_, int c_) { nM = M / BM; nN = N / BM; nwg = nM * nN; G = G_; c = c_; }
    __host__ __device__ bool next(int i, Unit& u) const {
        const long L = (long)i * G + c; if (L >= nwg) return false;
        int wgid = (int)L; { const int q = nwg / NXCD, r = nwg % NXCD, xcd = wgid % NXCD, off = wgid / NXCD; wgid = (xcd < r ? xcd * (q + 1) : r * (q + 1) + (xcd - r) * q) + off; }
        const int nig = WGM * nN, gid = wgid / nig, fm = gid * WGM, gsz = (nM - fm) < WGM ? (nM - fm) : WGM;
        u.pm = fm + ((wgid % nig) % gsz); u.pn = (wgid % nig) / gsz; return true;
    }
    __device__ __forceinline__ void a_ready(const Unit&) const {}
    __device__ __forceinline__ void done(const Unit&) const {}
};

__device__ __forceinline__ unsigned cvt_pk_bf16(float lo, float hi) { unsigned r; asm volatile("v_cvt_pk_bf16_f32 %0, %1, %2" : "=v"(r) : "v"(lo), "v"(hi)); return r; }

struct EpiBf16 {
    static constexpr bool PERM = true, AFTER_DRAIN = false;
    bf16_t* O; int ldc;
    __device__ __forceinline__ void operator()(const f32x4 (&acc)[2][2][4][2], const Unit& u, int wr, int wc, int fr, int fq) const {
        const int row0 = u.pm * BM + wr * 64 + fr; const int col0 = u.pn * BM + wc * 32 + 8 * fq;
#pragma unroll
        for (int ai = 0; ai < 2; ++ai)
#pragma unroll
            for (int m = 0; m < 4; ++m) { bf16_t* rowp = O + (size_t)(row0 + ai * HALF + m * 16) * ldc + col0;
#pragma unroll
                for (int bj = 0; bj < 2; ++bj) { const f32x4 v0 = acc[ai][bj][m][0], v1 = acc[ai][bj][m][1];
                    u32x4 w; w.x = cvt_pk_bf16(v0[0], v0[1]); w.y = cvt_pk_bf16(v0[2], v0[3]); w.z = cvt_pk_bf16(v1[0], v1[1]); w.w = cvt_pk_bf16(v1[2], v1[3]);
                    *(u32x4*)(rowp + bj * HALF) = w; } }
    }
};
struct EpiResid {
    static constexpr bool PERM = false, AFTER_DRAIN = false;
    const float* r0; const float* r1; float* out; const float* gate;
    __device__ __forceinline__ void operator()(const f32x4 (&acc)[2][2][4][2], const Unit& u, int wr, int wc, int fr, int fq) const {
        const int cnd = u.pm < 32 ? 0 : 1 + ((u.pm - 32) >> 3);
        const float* gp = gate + cnd * 6144;
        const int col0 = u.pn * BM + wc * 32 + 4 * fq;
        f32x4 gv[2][2];
#pragma unroll
        for (int bj = 0; bj < 2; ++bj)
#pragma unroll
            for (int n = 0; n < 2; ++n) gv[bj][n] = *(const f32x4*)(gp + col0 + bj * HALF + n * 16);
#pragma unroll
        for (int ai = 0; ai < 2; ++ai)
#pragma unroll
            for (int m = 0; m < 4; ++m) { const int row = u.pm * BM + ai * HALF + wr * 64 + m * 16 + fr;
                const float* rs = row < 8192 ? r0 + (size_t)row * 1024 : r1 + (size_t)(row - 8192) * 1024; float* op = out + (size_t)row * 1024;
#pragma unroll
                for (int bj = 0; bj < 2; ++bj)
#pragma unroll
                    for (int n = 0; n < 2; ++n) { const int c = col0 + bj * HALF + n * 16; const f32x4 x = *(const f32x4*)(rs + c);
                        *(f32x4*)(op + c) = x + gv[bj][n] * acc[ai][bj][m][n]; } }
    }
};

template <class Epi, class Sched, bool ALIGN_EPI = false, bool SP2 = false>
__device__ __forceinline__ void gemm_phase(PG8_LAS unsigned char* lds, const Gemm g, const Sched& S, const Epi& E, const int tid) {
    const int wid = __builtin_amdgcn_readfirstlane(tid >> 6), lane = tid & 63, wr = wid >> 2, wc = wid & 3, fr = lane & 15, fq = lane >> 4;
    const int K = g.K, nt = K / BK;
    unsigned voffA[2], voffB[2];
#pragma unroll
    for (int i = 0; i < 2; ++i) { int R, C; stage_rc(tid * 16 + i * 8192, R, C); const int Rb = Epi::PERM ? ((R & ~31) + perm32(R & 31)) : R;
        voffA[i] = (unsigned)(R * K + C) * 2u; voffB[i] = (unsigned)(Rb * K + C) * 2u; }
    const size_t kstep = (size_t)(BK * 2);
    const size_t hstep = (size_t)HALF * K * 2;
    const size_t tstep = 2 * hstep;
    const unsigned ldsw = (unsigned)wid * 1024u;
    const int aoff = lds_byte(wr * 64 + fr, fq * 8), boff = lds_byte(wc * 32 + fr, fq * 8);
#define PG8_SA(b, h) (((b) * 2 + (h)) * HTB)
#define PG8_SB(b, h) ((4 + (b) * 2 + (h)) * HTB)
#define PG8_STAGE(bufoff, gbase, voff) do { _Pragma("unroll") for (int _i = 0; _i < 2; ++_i) \
        __builtin_amdgcn_global_load_lds((const unsigned*)((const char*)(gbase) + (voff)[_i]), (PG8_LAS unsigned*)(lds + (bufoff) + ldsw + _i * 8192), 16, 0, 0); } while (0)
#define PG8_LDA(dst, b, h) do { _Pragma("unroll") for (int m = 0; m < 4; ++m) _Pragma("unroll") for (int k = 0; k < 2; ++k) dst[m][k] = *(const PG8_LAS bf16x8*)(lds + PG8_SA(b, h) + aoff + m * 2048 + k * 1024); } while (0)
#define PG8_LDB(dst, b, h) do { _Pragma("unroll") for (int n = 0; n < 2; ++n) _Pragma("unroll") for (int k = 0; k < 2; ++k) dst[n][k] = *(const PG8_LAS bf16x8*)(lds + PG8_SB(b, h) + boff + n * 2048 + k * 1024); } while (0)
#define PG8_MMA(ai, bj, At, Bt) do { __builtin_amdgcn_s_setprio(1); _Pragma("unroll") for (int m = 0; m < 4; ++m) _Pragma("unroll") for (int n = 0; n < 2; ++n) _Pragma("unroll") for (int k = 0; k < 2; ++k) \
        acc[ai][bj][m][n] = __builtin_amdgcn_mfma_f32_16x16x32_bf16(Bt[n][k], At[m][k], acc[ai][bj][m][n], 0, 0, 0); __builtin_amdgcn_s_setprio(0); } while (0)
#define PG8_WAIT_V(n) asm volatile("s_waitcnt vmcnt(" #n ")" ::: "memory")
#define PG8_WAIT_L(n) asm volatile("s_waitcnt lgkmcnt(" #n ")" ::: "memory")
#define PG8_BAR __builtin_amdgcn_s_barrier()
#define PG8_SCHED __builtin_amdgcn_sched_barrier(0)
    Unit cur, nxt; int ui = 0;
    if (!S.next(0, cur)) return;
    f32x4 acc[2][2][4][2];
#pragma unroll
    for (int a = 0; a < 2; ++a)
#pragma unroll
        for (int b = 0; b < 2; ++b)
#pragma unroll
            for (int m = 0; m < 4; ++m)
#pragma unroll
                for (int n = 0; n < 2; ++n) acc[a][b][m][n] = (f32x4){0.f, 0.f, 0.f, 0.f};
    bf16x8 At[4][2], B0[2][2], B1[2][2];
    const char* cA = (const char*)g.A + (size_t)cur.pm * tstep; const char* cB = (const char*)g.Bt + (size_t)cur.pn * tstep;
    S.a_ready(cur);
    if constexpr (SP2) {
        PG8_STAGE(PG8_SB(0, 0), cB, voffB); PG8_STAGE(PG8_SB(0, 1), cB + hstep, voffB); PG8_STAGE(PG8_SA(0, 0), cA, voffA); PG8_STAGE(PG8_SA(0, 1), cA + hstep, voffA);
        if (wr == 1) PG8_BAR;
        PG8_WAIT_V(2); PG8_BAR;
        PG8_STAGE(PG8_SB(1, 0), cB + kstep, voffB); PG8_STAGE(PG8_SA(1, 0), cA + kstep, voffA); PG8_STAGE(PG8_SB(1, 1), cB + hstep + kstep, voffB);
        PG8_WAIT_V(6); PG8_BAR;
    } else {
        PG8_STAGE(PG8_SB(0, 0), cB, voffB); PG8_STAGE(PG8_SA(0, 0), cA, voffA); PG8_STAGE(PG8_SB(0, 1), cB + hstep, voffB); PG8_STAGE(PG8_SA(0, 1), cA + hstep, voffA);
        if (wr == 1) PG8_BAR;
        PG8_WAIT_V(4); PG8_BAR;
        PG8_STAGE(PG8_SB(1, 0), cB + kstep, voffB); PG8_STAGE(PG8_SA(1, 0), cA + kstep, voffA); PG8_STAGE(PG8_SB(1, 1), cB + hstep + kstep, voffB);
        PG8_WAIT_V(6); PG8_BAR;
    }
    for (;;) {
        const bool has_next = S.next(ui + 1, nxt);
        const char* nA = has_next ? (const char*)g.A + (size_t)nxt.pm * tstep : cA; const char* nB = has_next ? (const char*)g.Bt + (size_t)nxt.pn * tstep : cB;
        for (int t = 0; t < nt; t += 2) {
            const bool last = (t == nt - 2);
            const char* a1 = cA + (size_t)(t + 1) * kstep;
            const char* a2 = last ? nA : cA + (size_t)(t + 2) * kstep; const char* b2 = last ? nB : cB + (size_t)(t + 2) * kstep;
            const char* a3 = a2 + kstep; const char* b3 = b2 + kstep;
            if (last && has_next) S.a_ready(nxt);
            if constexpr (SP2) {
            PG8_LDB(B0, 0, 0); PG8_LDB(B1, 0, 1); PG8_SCHED; PG8_LDA(At, 0, 0); PG8_STAGE(PG8_SA(1, 1), a1 + hstep, voffA);
            PG8_WAIT_V(8); PG8_WAIT_L(0); PG8_BAR; PG8_MMA(0, 0, At, B0); PG8_MMA(0, 1, At, B1); PG8_BAR; PG8_SCHED;
            PG8_LDA(At, 0, 1); PG8_STAGE(PG8_SB(0, 0), b2, voffB); PG8_STAGE(PG8_SB(0, 1), b2 + hstep, voffB); PG8_STAGE(PG8_SA(0, 0), a2, voffA);
            PG8_WAIT_V(8); PG8_WAIT_L(0); PG8_BAR; PG8_MMA(1, 0, At, B0); PG8_MMA(1, 1, At, B1); PG8_BAR; PG8_SCHED;
            PG8_LDB(B0, 1, 0); PG8_LDB(B1, 1, 1); PG8_SCHED; PG8_LDA(At, 1, 0); PG8_STAGE(PG8_SA(0, 1), a2 + hstep, voffA);
            PG8_WAIT_V(8); PG8_WAIT_L(0); PG8_BAR; PG8_MMA(0, 0, At, B0); PG8_MMA(0, 1, At, B1); PG8_BAR; PG8_SCHED;
            PG8_LDA(At, 1, 1); PG8_STAGE(PG8_SB(1, 0), b3, voffB); PG8_STAGE(PG8_SB(1, 1), b3 + hstep, voffB); PG8_STAGE(PG8_SA(1, 0), a3, voffA);
            PG8_WAIT_V(8); PG8_WAIT_L(0); PG8_BAR; PG8_MMA(1, 0, At, B0); PG8_MMA(1, 1, At, B1); PG8_BAR; PG8_SCHED;
            } else {
            PG8_LDB(B0, 0, 0); PG8_SCHED; PG8_LDA(At, 0, 0); PG8_STAGE(PG8_SA(1, 1), a1 + hstep, voffA);
            PG8_WAIT_L(8); PG8_BAR; PG8_WAIT_L(0); PG8_MMA(0, 0, At, B0); PG8_BAR; PG8_SCHED;
            PG8_LDB(B1, 0, 1); PG8_STAGE(PG8_SB(0, 0), b2, voffB);
            PG8_BAR; PG8_WAIT_L(0); PG8_MMA(0, 1, At, B1); PG8_BAR;
            PG8_LDA(At, 0, 1); PG8_STAGE(PG8_SA(0, 0), a2, voffA);
            PG8_BAR; PG8_WAIT_L(0); PG8_MMA(1, 0, At, B0); PG8_BAR; PG8_SCHED;
            PG8_STAGE(PG8_SB(0, 1), b2 + hstep, voffB);
            PG8_WAIT_V(6); PG8_BAR; PG8_MMA(1, 1, At, B1); PG8_BAR;
            PG8_LDB(B0, 1, 0); PG8_SCHED; PG8_LDA(At, 1, 0); PG8_STAGE(PG8_SA(0, 1), a2 + hstep, voffA);
            PG8_WAIT_L(8); PG8_BAR; PG8_WAIT_L(0); PG8_MMA(0, 0, At, B0); PG8_BAR; PG8_SCHED;
            PG8_LDB(B1, 1, 1); PG8_STAGE(PG8_SB(1, 0), b3, voffB);
            PG8_BAR; PG8_WAIT_L(0); PG8_MMA(0, 1, At, B1); PG8_BAR;
            PG8_LDA(At, 1, 1); PG8_STAGE(PG8_SA(1, 0), a3, voffA);
            PG8_BAR; PG8_WAIT_L(0); PG8_MMA(1, 0, At, B0); PG8_BAR; PG8_SCHED;
            PG8_STAGE(PG8_SB(1, 1), b3 + hstep, voffB);
            PG8_WAIT_V(6); PG8_BAR; PG8_MMA(1, 1, At, B1); PG8_BAR;
            }
        }
        if constexpr (ALIGN_EPI) { if (wr == 0) PG8_BAR; }
        if constexpr (!Epi::AFTER_DRAIN) { E(acc, cur, wr, wc, fr, fq); S.done(cur); }
        if (!has_next) break;
#pragma unroll
        for (int a = 0; a < 2; ++a)
#pragma unroll
            for (int b = 0; b < 2; ++b)
#pragma unroll
                for (int m = 0; m < 4; ++m)
#pragma unroll
                    for (int n = 0; n < 2; ++n) acc[a][b][m][n] = (f32x4){0.f, 0.f, 0.f, 0.f};
        cur = nxt; cA = nA; cB = nB; ++ui;
        if constexpr (ALIGN_EPI) { if (wr == 1) PG8_BAR; }
    }
    PG8_WAIT_V(0);
    if constexpr (!ALIGN_EPI) { if (wr == 0) PG8_BAR; }
    PG8_BAR;
#undef PG8_SA
#undef PG8_SB
#undef PG8_STAGE
#undef PG8_LDA
#undef PG8_LDB
#undef PG8_MMA
#undef PG8_WAIT_V
#undef PG8_WAIT_L
#undef PG8_BAR
#undef PG8_SCHED
}
}

typedef unsigned short bf16;
typedef float f32x4 __attribute__((ext_vector_type(4)));
typedef short bf16x8 __attribute__((ext_vector_type(8)));
typedef unsigned u32x4 __attribute__((ext_vector_type(4)));
typedef unsigned u32x2 __attribute__((ext_vector_type(2)));

constexpr int NW = 8, NT = 512;
constexpr int DM = 1024, NTOK = 12288, NPR = 8192, NKR = 13312, INC = 2144, INP = 2304, DFF = 2816, DUP = 5632;
constexpr float EPS = 1e-6f, LOG2E = 1.4426950408889634f;
constexpr float QS = 0.125f * LOG2E;
constexpr float MLAQS = 0.10206207261596575f * LOG2E;

constexpr size_t MiB = 1u << 20;
constexpr size_t WS_CTL = 0, WS_MOD = 1 * MiB, WS_ROPE = 1 * MiB + 256 * 1024, WS_W = 2 * MiB, W_LSTRIDE = 24 * MiB;
constexpr size_t W_IN = 0, W_OUT = 4718592, W_UP = W_OUT + 2097152, W_DOWN = W_UP + 11534336, W_B2 = W_DOWN + 5767168;
static_assert(W_B2 + 786432 <= W_LSTRIDE, "weights");
constexpr size_t WS_XN = 50 * MiB, WS_PROJ = 74 * MiB, WS_A2 = 128 * MiB, WS_MQKV = 138 * MiB, WS_QC = 164 * MiB, WS_KPE = 203 * MiB, WS_YCAT = 204 * MiB;
constexpr size_t WS_ACT = 50 * MiB, WS_U = 116 * MiB, WS_END = 248 * MiB;
constexpr size_t QSZ = (size_t)NKR * 256 * 2, KSZ = (size_t)NKR * 128 * 2;
constexpr int LDS_BYTES = 131072 + 4096, LDS_CTL = 131072;

struct Args { const float* in[28]; float* out; unsigned char* ws; };

__device__ __forceinline__ unsigned f2bf(float f) { unsigned u = __builtin_bit_cast(unsigned, f); return (u + 0x7fffu + ((u >> 16) & 1u)) >> 16; }
__device__ __forceinline__ unsigned pk2(float lo, float hi) { return f2bf(lo) | (f2bf(hi) << 16); }
__device__ __forceinline__ float bflo(unsigned u) { return __builtin_bit_cast(float, u << 16); }
__device__ __forceinline__ float bfhi(unsigned u) { return __builtin_bit_cast(float, u & 0xffff0000u); }
__device__ __forceinline__ f32x4 ld4bf(const bf16* p) { const u32x2 u = *(const u32x2*)p; return (f32x4){bflo(u.x), bfhi(u.x), bflo(u.y), bfhi(u.y)}; }
__device__ __forceinline__ void st4bf(bf16* p, f32x4 v) { u32x2 u; u.x = pk2(v[0], v[1]); u.y = pk2(v[2], v[3]); *(u32x2*)p = u; }
__device__ __forceinline__ float wave_sum(float v) {
#pragma unroll
    for (int o = 1; o < 64; o <<= 1) v += __shfl_xor(v, o);
    return v;
}
__device__ __forceinline__ float sum16(float v) {
#pragma unroll
    for (int o = 1; o < 16; o <<= 1) v += __shfl_xor(v, o);
    return v;
}
__device__ __forceinline__ float dot4(f32x4 a) { return (a[0] * a[0] + a[1] * a[1]) + (a[2] * a[2] + a[3] * a[3]); }
__device__ __forceinline__ f32x4 shfl4(f32x4 v, int m) { return (f32x4){__shfl_xor(v[0], m), __shfl_xor(v[1], m), __shfl_xor(v[2], m), __shfl_xor(v[3], m)}; }

__device__ __forceinline__ void transpose_item(const float* W, int N, bf16* WT, int ldk, int row_off, int k_off, float scale, float* scr, int item, int lane) {
    const int nblk = N / 32, kb = item / nblk, nb = item % nblk, k0 = 64 * kb, n0 = 32 * nb;
#pragma unroll 8
    for (int i = 0; i < 32; ++i) { const int kk = 2 * i + (lane >> 5); scr[kk * 33 + (lane & 31)] = W[(size_t)(k0 + kk) * N + n0 + (lane & 31)] * scale; }
    asm volatile("s_waitcnt lgkmcnt(0)" ::: "memory");
    const int c = lane & 7;
#pragma unroll
    for (int j = 0; j < 4; ++j) { const int n = (lane >> 3) + 8 * j; const float* s = scr + (8 * c) * 33 + n;
        u32x4 o; o.x = pk2(s[0 * 33], s[1 * 33]); o.y = pk2(s[2 * 33], s[3 * 33]); o.z = pk2(s[4 * 33], s[5 * 33]); o.w = pk2(s[6 * 33], s[7 * 33]);
        *(u32x4*)(WT + (size_t)(row_off + n0 + n) * ldk + k_off + k0 + 8 * c) = o; }
    asm volatile("s_waitcnt lgkmcnt(0)" ::: "memory");
}

__device__ __forceinline__ void phase0(const Args& a, unsigned char* lds, int tid, int lane, int wave) {
    unsigned char* ws = a.ws;
    const int G = gridDim.x, bid = blockIdx.x;
    for (int it = bid; it < 96; it += G) {
        const int l = it / 48, n0 = (it % 48) * 128;
        const float* wa = a.in[10] + (size_t)l * 1024 * 6144;
        float acc[3][2] = {{0.f, 0.f}, {0.f, 0.f}, {0.f, 0.f}};
        const int kb = wave * 128;
#pragma unroll 4
        for (int k = 0; k < 128; ++k) {
            const int kk = kb + k;
            const float2 w = *(const float2*)(wa + (size_t)kk * 6144 + n0 + 2 * lane);
            const float c0 = a.in[9][kk], c1 = a.in[8][kk], c2 = a.in[8][1024 + kk];
            const float s0 = c0 / (1.f + __expf(-c0)), s1 = c1 / (1.f + __expf(-c1)), s2 = c2 / (1.f + __expf(-c2));
            acc[0][0] += s0 * w.x; acc[0][1] += s0 * w.y; acc[1][0] += s1 * w.x; acc[1][1] += s1 * w.y; acc[2][0] += s2 * w.x; acc[2][1] += s2 * w.y;
        }
        float* red = (float*)lds;
#pragma unroll
        for (int c = 0; c < 3; ++c) { red[(wave * 3 + c) * 128 + 2 * lane] = acc[c][0]; red[(wave * 3 + c) * 128 + 2 * lane + 1] = acc[c][1]; }
        __syncthreads();
        if (tid < 384) { const int c = tid / 128, n = tid % 128; float s = 0.f;
#pragma unroll
            for (int w = 0; w < 8; ++w) s += red[(w * 3 + c) * 128 + n];
            ((float*)(ws + WS_MOD))[(size_t)(l * 3 + c) * 6144 + n0 + n] = s + a.in[11][(size_t)l * 6144 + n0 + n]; }
        __syncthreads();
    }
    if (bid == G - 1) {
        float* rt = (float*)(ws + WS_ROPE);
        for (int e = tid; e < 1024; e += NT) { const int pos = e >> 4, i = e & 15; const float inv = exp2f(-(float)(2 * i) / 32.f * 13.287712379549449f); const float ang = (float)pos * inv;
            rt[e] = __cosf(ang); rt[1024 + e] = __sinf(ang); }
        for (int e = tid; e < 512; e += NT) { const int pos = e >> 3, i = e & 7; const float inv = exp2f(-(float)(2 * i) / 16.f * 13.287712379549449f); const float ang = (float)pos * inv;
            rt[2048 + e] = __cosf(ang); rt[2560 + e] = __sinf(ang); }
    }
    const int gt = bid * NT + tid, NGT = G * NT;
    if (gt < 256) ((unsigned*)(ws + WS_CTL))[gt] = 0u;
    for (int l = 0; l < 2; ++l) {
        bf16* b2 = (bf16*)(ws + WS_W + l * W_LSTRIDE + W_B2);
        for (int ch = gt; ch < 1024 * 48; ch += NGT) { const int n = ch / 48, k = (ch % 48) * 8;
            const bool data = (n < 384 && k < 192) || (n >= 384 && n < 896 && k >= 192 && k < 320);
            if (!data) *(u32x4*)(b2 + (size_t)n * 384 + k) = (u32x4){0u, 0u, 0u, 0u}; }
        bf16* wi = (bf16*)(ws + WS_W + l * W_LSTRIDE + W_IN) + (size_t)INC * 1024;
        for (int ch = gt; ch < 160 * 128; ch += NGT) *(u32x4*)(wi + (size_t)ch * 8) = (u32x4){0u, 0u, 0u, 0u};
    }
    float* scr = (float*)(lds + 16384 + wave * 12288);
    const int gw = bid * NW + wave, NGW = G * NW;
    constexpr int I_IN = 16 * 67, I_OUT = 16 * 32, I_UP = 16 * 176, I_DN = 44 * 32, I_Q = 3 * 12, I_KV = 2 * 16, I_L = I_IN + I_OUT + I_UP + I_DN + I_Q + I_KV;
    for (int it = gw; it < 2 * I_L; it += NGW) {
        const int l = it / I_L; int r = it % I_L;
        unsigned char* wl = ws + WS_W + l * W_LSTRIDE;
        if (r < I_IN) { transpose_item(a.in[13] + (size_t)l * 1024 * INC, INC, (bf16*)(wl + W_IN), 1024, 0, 0, 1.f, scr, r, lane); continue; } r -= I_IN;
        if (r < I_OUT) { transpose_item(a.in[22] + (size_t)l * 1024 * 1024, 1024, (bf16*)(wl + W_OUT), 1024, 0, 0, 1.f, scr, r, lane); continue; } r -= I_OUT;
        if (r < I_UP) { transpose_item(a.in[24] + (size_t)l * 1024 * DUP, DUP, (bf16*)(wl + W_UP), 1024, 0, 0, 1.f, scr, r, lane); continue; } r -= I_UP;
        if (r < I_DN) { transpose_item(a.in[26] + (size_t)l * DFF * 1024, 1024, (bf16*)(wl + W_DOWN), DFF, 0, 0, 1.f, scr, r, lane); continue; } r -= I_DN;
        if (r < I_Q) { transpose_item(a.in[16] + (size_t)l * 192 * 384, 384, (bf16*)(wl + W_B2), 384, 0, 0, MLAQS, scr, r, lane); continue; } r -= I_Q;
        transpose_item(a.in[18] + (size_t)l * 128 * 512, 512, (bf16*)(wl + W_B2), 384, 384, 192, 1.f, scr, r, lane);
    }
}

__device__ __forceinline__ void norm_mod_phase(const float* x0, const float* x1, const float* nw, const float* mod, int sc_off, int sh_off, bf16* XN, int lane, int gw, int NGW) {
    for (int row = gw; row < NTOK; row += NGW) {
        const float* xr = row < NPR ? x0 + (size_t)row * DM : x1 + (size_t)(row - NPR) * DM;
        const int c = row < NPR ? 0 : 1 + ((row - NPR) >> 11);
        const float* mp = mod + c * 6144;
        f32x4 v[4]; float ss = 0.f;
#pragma unroll
        for (int j = 0; j < 4; ++j) { v[j] = *(const f32x4*)(xr + 4 * (lane + 64 * j)); ss += dot4(v[j]); }
        const float rs = rsqrtf(wave_sum(ss) * (1.f / DM) + EPS);
#pragma unroll
        for (int j = 0; j < 4; ++j) { const int col = 4 * (lane + 64 * j);
            const f32x4 g = *(const f32x4*)(nw + col), sc = *(const f32x4*)(mp + sc_off + col), sh = *(const f32x4*)(mp + sh_off + col);
            const f32x4 h = v[j] * rs * g * (1.f + sc) + sh;
            st4bf(XN + (size_t)row * DM + col, h); }
    }
}

struct P3Ptrs {
    const bf16* PROJ; bf16 *A2, *KPE, *YCAT, *Qc_rot, *Qc_raw, *Kc, *Vc, *Qd_rot, *Qd_raw, *Kd, *Vd;
    const float *conv_a, *gq_mla, *gkv_mla, *gq, *gk, *rope;
    const float *c_ckv, *c_kpe, *c_gk, *c_gv, *c_sk, *c_sv;
    float *o_ckv, *o_kpe, *o_gk, *o_gv, *o_sk, *o_sv;
    int l;
};
__device__ __forceinline__ f32x4 rope64(f32x4 v, int jl, int prow, int pcol, const float* rt) {
    const f32x4 pr = shfl4(v, 4);
    const int pos = jl < 8 ? prow : pcol, fi = 4 * (jl & 3);
    const f32x4 c = *(const f32x4*)(rt + pos * 16 + fi), s = *(const f32x4*)(rt + 1024 + pos * 16 + fi);
    const float sg = (jl & 4) ? 1.f : -1.f;
    return v * c + pr * s * sg;
}
__device__ __forceinline__ void p3_phase(const P3Ptrs& P, int lane, int gw, int NGW) {
    const int l = P.l;
    for (int row = gw; row < NKR; row += NGW) {
        if (row < NTOK) {
            const bool samp = row >= NPR;
            int b, t, kr, T;
            if (!samp) { b = row >> 8; t = row & 255; kr = row; T = 256; } else { b = (row - NPR) >> 11; t = (row - NPR) & 2047; kr = NPR + b * 2560 + t; T = 2048; }
            const int prow = t >> 6, pcol = t & 63;
            const bf16* pr = P.PROJ + (size_t)row * INP;
            const size_t ob = (size_t)((b * 2 + l) * 256 + t);
            { const int ci = 4 * lane;
              const f32x4 xa = ld4bf(pr + ci), gb = ld4bf(pr + 256 + ci), gc = ld4bf(pr + 512 + ci);
              f32x4 pv = (f32x4){0.f, 0.f, 0.f, 0.f}, nx = pv;
              if (t > 0) pv = ld4bf(pr - INP + ci) * ld4bf(pr - INP + 512 + ci);
              if (t < T - 1) nx = ld4bf(pr + INP + ci) * ld4bf(pr + INP + 512 + ci);
              const float* cw = P.conv_a + (size_t)l * 768;
              const f32x4 w0 = *(const f32x4*)(cw + ci), w1 = *(const f32x4*)(cw + 256 + ci), w2 = *(const f32x4*)(cw + 512 + ci);
              st4bf(P.YCAT + (size_t)row * DM + ci, gb * (w0 * pv + w1 * (xa * gc) + w2 * nx)); }
            { f32x4 v = (f32x4){0.f, 0.f, 0.f, 0.f}; if (lane < 48) v = ld4bf(pr + 768 + 4 * lane);
              const float rs = rsqrtf(wave_sum(dot4(v)) * (1.f / 192.f) + EPS);
              if (lane < 48) st4bf(P.A2 + (size_t)kr * 384 + 4 * lane, v * rs * *(const f32x4*)(P.gq_mla + l * 192 + 4 * lane)); }
            { f32x4 v = (f32x4){0.f, 0.f, 0.f, 0.f}; if (lane < 32) v = ld4bf(pr + 960 + 4 * lane);
              const float rs = rsqrtf(wave_sum(dot4(v)) * (1.f / 128.f) + EPS);
              if (lane < 32) { const f32x4 o = v * rs * *(const f32x4*)(P.gkv_mla + l * 128 + 4 * lane);
                  st4bf(P.A2 + (size_t)kr * 384 + 192 + 4 * lane, o);
                  if (!samp) *(f32x4*)(P.o_ckv + ob * 128 + 4 * lane) = o; }
              else if (lane < 48) st4bf(P.A2 + (size_t)kr * 384 + 320 + 4 * (lane - 32), (f32x4){0.f, 0.f, 0.f, 0.f}); }
            { f32x4 v = (f32x4){0.f, 0.f, 0.f, 0.f}; if (lane < 8) v = ld4bf(pr + 1088 + 4 * lane);
              const f32x4 pt = shfl4(v, 2);
              const int pos = lane < 4 ? prow : pcol, fi = 4 * (lane & 1);
              const int psafe = pos & 63;
              const f32x4 c = *(const f32x4*)(P.rope + 2048 + psafe * 8 + fi), s = *(const f32x4*)(P.rope + 2560 + psafe * 8 + fi);
              const float sg = (lane & 2) ? 1.f : -1.f;
              const f32x4 r = v * c + pt * s * sg;
              if (lane < 8) { if (!samp) *(f32x4*)(P.o_kpe + ob * 32 + 4 * lane) = v; st4bf(P.KPE + (size_t)kr * 32 + 4 * lane, samp ? r : v); } }
            const int jl = lane & 15;
            { f32x4 v = ld4bf(pr + 1120 + 4 * lane);
              const float rs = rsqrtf(sum16(dot4(v)) * (1.f / 64.f) + EPS);
              v = v * rs * *(const f32x4*)(P.gq + l * 64 + 4 * jl);
              st4bf(P.Qc_raw + (size_t)kr * 256 + 4 * lane, v * QS);
              const f32x4 r = rope64(v, jl, prow, pcol, P.rope);
              if (samp) st4bf(P.Qc_rot + (size_t)kr * 256 + 4 * lane, r * QS); }
            { f32x4 v = ld4bf(pr + 1376 + 4 * lane);
              const float rs = rsqrtf(sum16(dot4(v)) * (1.f / 64.f) + EPS);
              const f32x4 kn = v * rs * *(const f32x4*)(P.gk + l * 64 + 4 * jl);
              const f32x4 r = rope64(kn, jl, prow, pcol, P.rope);
              if (lane < 32) { if (!samp) *(f32x4*)(P.o_gk + ob * 128 + 4 * lane) = kn; st4bf(P.Kc + (size_t)kr * 128 + 4 * lane, samp ? r : kn); }
              else { if (!samp) *(f32x4*)(P.o_gv + ob * 128 + 4 * (lane - 32)) = v; st4bf(P.Vc + (size_t)kr * 128 + 4 * (lane - 32), v); } }
            { const f32x4 v = ld4bf(pr + 1632 + 4 * lane);
              st4bf(P.Qd_raw + (size_t)kr * 256 + 4 * lane, v * QS);
              const f32x4 r = rope64(v, jl, prow, pcol, P.rope);
              if (samp) st4bf(P.Qd_rot + (size_t)kr * 256 + 4 * lane, r * QS); }
            { const f32x4 v = ld4bf(pr + 1888 + 4 * lane);
              const f32x4 r = rope64(v, jl, prow, pcol, P.rope);
              if (lane < 32) { if (!samp) *(f32x4*)(P.o_sk + ob * 128 + 4 * lane) = v; st4bf(P.Kd + (size_t)kr * 128 + 4 * lane, samp ? r : v); }
              else { if (!samp) *(f32x4*)(P.o_sv + ob * 128 + 4 * (lane - 32)) = v; st4bf(P.Vd + (size_t)kr * 128 + 4 * (lane - 32), v); } }
        } else {
            const int ci = row - NTOK, b = ci >> 9, j = ci & 511, kr = NPR + b * 2560 + 2048 + j;
            const size_t cb = (size_t)((b * 2 + l) * 512 + j);
            const f32x4 z = (f32x4){0.f, 0.f, 0.f, 0.f};
            if (lane < 48) st4bf(P.A2 + (size_t)kr * 384 + 4 * lane, z);
            if (lane < 32) st4bf(P.A2 + (size_t)kr * 384 + 192 + 4 * lane, *(const f32x4*)(P.c_ckv + cb * 128 + 4 * lane));
            else if (lane < 48) st4bf(P.A2 + (size_t)kr * 384 + 320 + 4 * (lane - 32), z);
            if (lane < 8) st4bf(P.KPE + (size_t)kr * 32 + 4 * lane, *(const f32x4*)(P.c_kpe + cb * 32 + 4 * lane));
            if (lane < 32) { st4bf(P.Kc + (size_t)kr * 128 + 4 * lane, *(const f32x4*)(P.c_gk + cb * 128 + 4 * lane));
                             st4bf(P.Kd + (size_t)kr * 128 + 4 * lane, *(const f32x4*)(P.c_sk + cb * 128 + 4 * lane)); }
            else { st4bf(P.Vc + (size_t)kr * 128 + 4 * (lane - 32), *(const f32x4*)(P.c_gv + cb * 128 + 4 * (lane - 32)));
                   st4bf(P.Vd + (size_t)kr * 128 + 4 * (lane - 32), *(const f32x4*)(P.c_sv + cb * 128 + 4 * (lane - 32))); }
        }
    }
}

struct AttnSrc {
    const bf16* Qraw; const bf16* Qrot; int qpitch;
    const bf16* K0; int k0pitch; const bf16* K1;
    const bf16* V; int vpitch;
    bf16* Y; int outcol;
    int krbase, rowbase, q0, lo, hi, nctx;
    bool samp, window; float m0; bool sink;
    const float* rope;
};
template <int DK>
__device__ __forceinline__ void attn_unit(const AttnSrc& S, unsigned char* lds, int tid, int lane, int wave) {
    constexpr int KP = DK + 8, VP = 68, KS = DK / 32, CPK = DK / 8;
    bf16* Ks = (bf16*)lds;
    bf16* Vt = (bf16*)(lds + 2 * 64 * KP * 2);
    const int g = lane >> 4, fr = lane & 15;
    const int qpos = S.q0 + wave * 16 + fr;
    const size_t qkr = (size_t)(S.krbase + qpos);
    bf16x8 qraw[KS], qrot[KS];
#pragma unroll
    for (int ks = 0; ks < KS; ++ks) { qraw[ks] = *(const bf16x8*)(S.Qraw + qkr * S.qpitch + ks * 32 + g * 8); qrot[ks] = qraw[ks]; }
    if (S.samp) {
        if (DK == 96) {
            const bf16x8 own = qraw[KS - 1], par = *(const bf16x8*)(S.Qraw + qkr * S.qpitch + 64 + (g ^ 1) * 8);
            const int pos = g < 2 ? (qpos >> 6) : (qpos & 63);
            const float sg = (g & 1) ? 1.f : -1.f;
            const float* ct = S.rope + 2048 + pos * 8; const float* st = S.rope + 2560 + pos * 8;
            bf16x8 r;
#pragma unroll
            for (int e = 0; e < 8; ++e) { const float o = bflo((unsigned)(unsigned short)own[e]), p = bflo((unsigned)(unsigned short)par[e]);
                r[e] = (short)f2bf(o * ct[e] + p * st[e] * sg); }
            qrot[KS - 1] = r;
        } else {
#pragma unroll
            for (int ks = 0; ks < KS; ++ks) qrot[ks] = *(const bf16x8*)(S.Qrot + qkr * S.qpitch + ks * 32 + g * 8);
        }
    }
    float m = S.m0, l = (S.sink && g == 0) ? 1.f : 0.f;
    f32x4 o[4];
#pragma unroll
    for (int d = 0; d < 4; ++d) o[d] = (f32x4){0.f, 0.f, 0.f, 0.f};
    const int nloc = S.hi - S.lo, ntile = nloc + S.nctx;
    u32x4 kreg0, kreg1, vreg;
    const int kc0 = tid, kc1 = tid + NT;
    const int key0 = kc0 / CPK, part0 = kc0 % CPK, key1 = kc1 / CPK, part1 = kc1 % CPK;
    const int vkey = tid & 63, vdc = tid >> 6;
    auto gload = [&](int j) {
        const int tile = j < nloc ? S.lo + j : 32 + (j - nloc);
        const size_t kr = (size_t)(S.krbase + tile * 64);
        if (DK == 64) { kreg0 = *(const u32x4*)(S.K0 + (kr + key0) * S.k0pitch + part0 * 8); }
        else {
            kreg0 = part0 < 8 ? *(const u32x4*)(S.K0 + (kr + key0) * S.k0pitch + part0 * 8) : *(const u32x4*)(S.K1 + (kr + key0) * 32 + (part0 - 8) * 8);
            if (kc1 < 64 * CPK) kreg1 = part1 < 8 ? *(const u32x4*)(S.K0 + (kr + key1) * S.k0pitch + part1 * 8) : *(const u32x4*)(S.K1 + (kr + key1) * 32 + (part1 - 8) * 8);
        }
        vreg = *(const u32x4*)(S.V + (kr + vkey) * S.vpitch + vdc * 8);
    };
    auto lstore = [&](int buf) {
        bf16* kb = Ks + buf * 64 * KP; bf16* vb = Vt + buf * 64 * VP;
        *(u32x4*)(kb + key0 * KP + part0 * 8) = kreg0;
        if (DK == 96) { if (kc1 < 64 * CPK) *(u32x4*)(kb + key1 * KP + part1 * 8) = kreg1; }
        bf16* vp = vb + (vdc * 8) * VP + vkey;
        vp[0 * VP] = (bf16)(vreg.x & 0xffffu); vp[1 * VP] = (bf16)(vreg.x >> 16); vp[2 * VP] = (bf16)(vreg.y & 0xffffu); vp[3 * VP] = (bf16)(vreg.y >> 16);
        vp[4 * VP] = (bf16)(vreg.z & 0xffffu); vp[5 * VP] = (bf16)(vreg.z >> 16); vp[6 * VP] = (bf16)(vreg.w & 0xffffu); vp[7 * VP] = (bf16)(vreg.w >> 16);
    };
    gload(0); lstore(0);
    __syncthreads();
    for (int j = 0; j < ntile; ++j) {
        const int buf = j & 1;
        if (j + 1 < ntile) gload(j + 1);
        const bool loc = j < nloc;
        const bool use_rot = loc && S.samp;
        const bf16* kb = Ks + buf * 64 * KP; const bf16* vb = Vt + buf * 64 * VP;
        f32x4 s[4];
#pragma unroll
        for (int kk = 0; kk < 4; ++kk) { s[kk] = (f32x4){0.f, 0.f, 0.f, 0.f};
#pragma unroll
            for (int ks = 0; ks < KS; ++ks) { const bf16x8 af = *(const bf16x8*)(kb + (kk * 16 + fr) * KP + ks * 32 + g * 8);
                const bf16x8 qf = use_rot ? qrot[ks] : qraw[ks];
                s[kk] = __builtin_amdgcn_mfma_f32_16x16x32_bf16(af, qf, s[kk], 0, 0, 0); } }
        if (S.window && loc) {
            const int kp0 = (S.lo + j) * 64 + g * 4;
#pragma unroll
            for (int kk = 0; kk < 4; ++kk)
#pragma unroll
                for (int i = 0; i < 4; ++i) { const int d = kp0 + kk * 16 + i - qpos; if (d > 128 || d < -128) s[kk][i] = -INFINITY; }
        }
        float mx = -INFINITY;
#pragma unroll
        for (int kk = 0; kk < 4; ++kk) mx = fmaxf(mx, fmaxf(fmaxf(s[kk][0], s[kk][1]), fmaxf(s[kk][2], s[kk][3])));
        mx = fmaxf(mx, __shfl_xor(mx, 16)); mx = fmaxf(mx, __shfl_xor(mx, 32));
        const float mn = fmaxf(m, mx), alpha = __builtin_amdgcn_exp2f(m - mn);
        m = mn;
        float ls = 0.f;
#pragma unroll
        for (int kk = 0; kk < 4; ++kk)
#pragma unroll
            for (int i = 0; i < 4; ++i) { const float p = __builtin_amdgcn_exp2f(s[kk][i] - mn); s[kk][i] = p; ls += p; }
        l = l * alpha + ls;
#pragma unroll
        for (int d = 0; d < 4; ++d) o[d] = o[d] * alpha;
        bf16x8 pf[2];
#pragma unroll
        for (int pp = 0; pp < 2; ++pp) {
            const unsigned w0 = pk2(s[2 * pp][0], s[2 * pp][1]), w1 = pk2(s[2 * pp][2], s[2 * pp][3]), w2 = pk2(s[2 * pp + 1][0], s[2 * pp + 1][1]), w3 = pk2(s[2 * pp + 1][2], s[2 * pp + 1][3]);
            pf[pp] = __builtin_bit_cast(bf16x8, (u32x4){w0, w1, w2, w3});
        }
#pragma unroll
        for (int d = 0; d < 4; ++d)
#pragma unroll
            for (int pp = 0; pp < 2; ++pp) {
                const bf16* vr = vb + (d * 16 + fr) * VP + pp * 32 + g * 4;
                const u32x2 lo = *(const u32x2*)vr, hi = *(const u32x2*)(vr + 16);
                const bf16x8 af = __builtin_bit_cast(bf16x8, (u32x4){lo.x, lo.y, hi.x, hi.y});
                o[d] = __builtin_amdgcn_mfma_f32_16x16x32_bf16(af, pf[pp], o[d], 0, 0, 0);
            }
        if (j + 1 < ntile) lstore(buf ^ 1);
        __syncthreads();
    }
    float lt = l + __shfl_xor(l, 16); lt += __shfl_xor(lt, 32);
    const float inv = 1.f / lt;
    bf16* yr = S.Y + (size_t)(S.rowbase + qpos) * DM + S.outcol + g * 4;
#pragma unroll
    for (int d = 0; d < 4; ++d) st4bf(yr + d * 16, o[d] * inv);
}

struct AttnBufs { const bf16 *MQKV, *KPE, *Qc_rot, *Qc_raw, *Kc, *Vc, *Qd_rot, *Qd_raw, *Kd, *Vd; bf16* YCAT; const float* sink; const float* rope; unsigned* ctr; };
constexpr int ATT_NU = 384 + 768;
__device__ __forceinline__ void attn_phase(const AttnBufs& B, unsigned char* lds, int tid, int lane, int wave) {
    volatile unsigned* shu = (volatile unsigned*)(lds + LDS_CTL);
    for (;;) {
        if (tid == 0) *shu = atomicAdd(B.ctr, 1u);
        __syncthreads();
        const int u = (int)*shu;
        if (u >= ATT_NU) break;
        int type, b, h, qt; bool samp;
        if (u < 384) { type = u >> 7; const int v = u & 127; b = v >> 6; h = (v >> 4) & 3; qt = v & 15; samp = true; }
        else { const int w = u - 384; type = w >> 8; const int v = w & 255; b = v >> 3; h = (v >> 1) & 3; qt = v & 1; samp = false; }
        AttnSrc S;
        S.samp = samp; S.q0 = qt * 128; S.rope = B.rope; S.Y = B.YCAT;
        S.krbase = samp ? NPR + b * 2560 : b * 256; S.rowbase = samp ? NPR + b * 2048 : b * 256;
        S.window = false; S.sink = false; S.m0 = -1e30f;
        if (!samp) { S.lo = 0; S.hi = 4; S.nctx = 0; }
        else { S.lo = 0; S.hi = 32; S.nctx = 8; }
        if (type == 0) {
            S.Qraw = B.MQKV + h * 96; S.Qrot = S.Qraw; S.qpitch = 1024; S.K0 = B.MQKV + 384 + h * 128; S.k0pitch = 1024; S.K1 = B.KPE; S.V = B.MQKV + 384 + h * 128 + 64; S.vpitch = 1024; S.outcol = 256 + h * 64;
            attn_unit<96>(S, lds, tid, lane, wave);
        } else {
            if (type == 1) { S.Qraw = B.Qc_raw + h * 64; S.Qrot = B.Qc_rot + h * 64; S.K0 = B.Kc + (h >> 1) * 64; S.V = B.Vc + (h >> 1) * 64; S.outcol = 512 + h * 64; }
            else { S.Qraw = B.Qd_raw + h * 64; S.Qrot = B.Qd_rot + h * 64; S.K0 = B.Kd + (h >> 1) * 64; S.V = B.Vd + (h >> 1) * 64; S.outcol = 768 + h * 64;
                   S.sink = true; S.m0 = B.sink[h] * LOG2E;
                   if (samp) { S.window = true; const int lo = (S.q0 - 128) / 64; S.lo = lo < 0 ? 0 : lo; const int hi = (S.q0 + 256) / 64; S.hi = hi > 32 ? 32 : hi; } }
            S.qpitch = 256; S.k0pitch = 128; S.K1 = nullptr; S.vpitch = 128;
            attn_unit<64>(S, lds, tid, lane, wave);
        }
    }
}

__device__ __forceinline__ void load8(const bf16* p, float (&o)[8]) { const u32x4 u = *(const u32x4*)p; o[0] = bflo(u.x); o[1] = bfhi(u.x); o[2] = bflo(u.y); o[3] = bfhi(u.y); o[4] = bflo(u.z); o[5] = bfhi(u.z); o[6] = bflo(u.w); o[7] = bfhi(u.w); }
__device__ __forceinline__ void convgate_phase(const bf16* U, const float* cf, bf16* ACT, int gt, int NGT) {
    constexpr int NCH = DFF / 8, RG = 16;
    for (int it = gt; it < (NTOK / RG) * NCH; it += NGT) {
        const int rg = it / NCH, cc = it % NCH, r0 = rg * RG, col = cc * 8;
        const bool samp = r0 >= NPR; const int t0 = samp ? ((r0 - NPR) & 2047) : (r0 & 255), T = samp ? 2048 : 256;
        float wa[3][8], wb[3][8];
#pragma unroll
        for (int k = 0; k < 3; ++k)
#pragma unroll
            for (int e = 0; e < 8; ++e) { wa[k][e] = cf[k * DUP + col + e]; wb[k][e] = cf[k * DUP + DFF + col + e]; }
        float pa[8], pb[8], ca[8], cb[8], na[8], nb[8];
        const bf16* up = U + (size_t)r0 * DUP + col;
        if (t0 > 0) { load8(up - DUP, pa); load8(up - DUP + DFF, pb); } else {
#pragma unroll
            for (int e = 0; e < 8; ++e) { pa[e] = 0.f; pb[e] = 0.f; } }
        load8(up, ca); load8(up + DFF, cb);
        for (int i = 0; i < RG; ++i) {
            const bf16* un = up + (size_t)(i + 1) * DUP;
            if (t0 + i + 1 < T) { load8(un, na); load8(un + DFF, nb); } else {
#pragma unroll
                for (int e = 0; e < 8; ++e) { na[e] = 0.f; nb[e] = 0.f; } }
            float r[8];
#pragma unroll
            for (int e = 0; e < 8; ++e) { const float xa = wa[0][e] * pa[e] + wa[1][e] * ca[e] + wa[2][e] * na[e], xb = wb[0][e] * pb[e] + wb[1][e] * cb[e] + wb[2][e] * nb[e];
                r[e] = xa * __builtin_amdgcn_rcpf(1.f + __builtin_amdgcn_exp2f(-xa * LOG2E)) * xb; }
            u32x4 w; w.x = pk2(r[0], r[1]); w.y = pk2(r[2], r[3]); w.z = pk2(r[4], r[5]); w.w = pk2(r[6], r[7]);
            *(u32x4*)(ACT + (size_t)(r0 + i) * DFF + col) = w;
#pragma unroll
            for (int e = 0; e < 8; ++e) { pa[e] = ca[e]; pb[e] = cb[e]; ca[e] = na[e]; cb[e] = nb[e]; }
        }
    }
}

#ifndef PH
#define PH 0xFFFF
#endif
#define ON(k) ((PH >> (k)) & 1)
__global__ void __launch_bounds__(NT, 2) mega_fwd(Args a) {
    extern __shared__ __attribute__((aligned(16))) unsigned char lds[];
    cg::grid_group grid = cg::this_grid();
    const int G = gridDim.x, bid = blockIdx.x;
    PG8_LAS unsigned char* ring = (PG8_LAS unsigned char*)lds;
#define PHASE_BEGIN int tid = threadIdx.x; asm volatile("" : "+v"(tid)); unsigned char* ws = a.ws; asm volatile("" : "+s"(ws)); float* out = a.out; asm volatile("" : "+s"(out)); \
    const int lane = tid & 63, wave = __builtin_amdgcn_readfirstlane(tid >> 6); const int gw = bid * NW + wave, NGW = G * NW, gt = bid * NT + tid, NGT = G * NT; \
    (void)lane; (void)wave; (void)gw; (void)NGW; (void)gt; (void)NGT; (void)out; \
    const float* mod = (const float*)(ws + WS_MOD); const float* rope = (const float*)(ws + WS_ROPE); (void)mod; (void)rope; \
    bf16* XN = (bf16*)(ws + WS_XN); bf16* PROJ = (bf16*)(ws + WS_PROJ); bf16* A2 = (bf16*)(ws + WS_A2); bf16* MQKV = (bf16*)(ws + WS_MQKV); \
    bf16* KPE = (bf16*)(ws + WS_KPE); bf16* YCAT = (bf16*)(ws + WS_YCAT); bf16* ACT = (bf16*)(ws + WS_ACT); bf16* U = (bf16*)(ws + WS_U); \
    bf16* Qc_rot = (bf16*)(ws + WS_QC); bf16* Qc_raw = (bf16*)(ws + WS_QC + QSZ); bf16* Kc = (bf16*)(ws + WS_QC + 2 * QSZ); bf16* Vc = (bf16*)(ws + WS_QC + 2 * QSZ + KSZ); \
    bf16* Qd_rot = (bf16*)(ws + WS_QC + 2 * QSZ + 2 * KSZ); bf16* Qd_raw = Qd_rot + (size_t)NKR * 256; bf16* Kd = Qd_raw + (size_t)NKR * 256; bf16* Vd = Kd + (size_t)NKR * 128; \
    (void)XN; (void)PROJ; (void)A2; (void)MQKV; (void)KPE; (void)YCAT; (void)ACT; (void)U; (void)Qc_rot; (void)Qc_raw; (void)Kc; (void)Vc; (void)Qd_rot; (void)Qd_raw; (void)Kd; (void)Vd;
#define LAYER_VALS const float* modl = mod + (size_t)l * 3 * 6144; unsigned char* wl = ws + WS_W + l * W_LSTRIDE; (void)modl; (void)wl; \
    const float* x0 = l == 0 ? a.in[0] : out; const float* x1 = l == 0 ? a.in[1] : out + (size_t)NPR * DM; (void)x0; (void)x1;

    if (ON(0)) { PHASE_BEGIN phase0(a, lds, tid, lane, wave); }
    grid.sync();

    for (int l = 0; l < 2; ++l) {
        if (ON(1)) { PHASE_BEGIN LAYER_VALS norm_mod_phase(x0, x1, a.in[12] + l * DM, modl, 1024, 0, XN, lane, gw, NGW); }
        grid.sync();
        if (ON(2)) { PHASE_BEGIN LAYER_VALS pg8::Gemm g{XN, (const bf16*)(wl + W_IN), NTOK, INP, DM}; pg8::StaticOrder S; S.init(NTOK, INP, G, bid); pg8::EpiBf16 E{PROJ, INP};
          pg8::gemm_phase<pg8::EpiBf16, pg8::StaticOrder, true, true>(ring, g, S, E, tid); }
        grid.sync();
        if (ON(3)) { PHASE_BEGIN P3Ptrs P; P.PROJ = PROJ; P.A2 = A2; P.KPE = KPE; P.YCAT = YCAT; P.Qc_rot = Qc_rot; P.Qc_raw = Qc_raw; P.Kc = Kc; P.Vc = Vc; P.Qd_rot = Qd_rot; P.Qd_raw = Qd_raw; P.Kd = Kd; P.Vd = Vd;
          P.conv_a = a.in[14]; P.gq_mla = a.in[15]; P.gkv_mla = a.in[17]; P.gq = a.in[19]; P.gk = a.in[20]; P.rope = rope;
          P.c_ckv = a.in[2]; P.c_kpe = a.in[3]; P.c_gk = a.in[4]; P.c_gv = a.in[5]; P.c_sk = a.in[6]; P.c_sv = a.in[7];
          P.o_ckv = out + 12582912; P.o_kpe = out + 14680064; P.o_gk = out + 15204352; P.o_gv = out + 17301504; P.o_sk = out + 19398656; P.o_sv = out + 21495808; P.l = l;
          p3_phase(P, lane, gw, NGW); }
        grid.sync();
        if (ON(4)) { PHASE_BEGIN LAYER_VALS pg8::Gemm g{A2, (const bf16*)(wl + W_B2), NKR, 1024, 384}; pg8::StaticOrder S; S.init(NKR, 1024, G, bid); pg8::EpiBf16 E{MQKV, 1024};
          pg8::gemm_phase<pg8::EpiBf16, pg8::StaticOrder, true, true>(ring, g, S, E, tid); }
        grid.sync();
        if (ON(5)) { PHASE_BEGIN AttnBufs B; B.MQKV = MQKV; B.KPE = KPE; B.Qc_rot = Qc_rot; B.Qc_raw = Qc_raw; B.Kc = Kc; B.Vc = Vc; B.Qd_rot = Qd_rot; B.Qd_raw = Qd_raw; B.Kd = Kd; B.Vd = Vd; B.YCAT = YCAT;
          B.sink = a.in[21] + l * 4; B.rope = rope; B.ctr = (unsigned*)(ws + WS_CTL) + 64 * l;
          attn_phase(B, lds, tid, lane, wave); }
        grid.sync();
        if (ON(6)) { PHASE_BEGIN LAYER_VALS pg8::Gemm g{YCAT, (const bf16*)(wl + W_OUT), NTOK, DM, DM}; pg8::StaticOrder S; S.init(NTOK, DM, G, bid); pg8::EpiResid E{x0, x1, out, modl + 2048};
          pg8::gemm_phase<pg8::EpiResid, pg8::StaticOrder, true, true>(ring, g, S, E, tid); }
        grid.sync();
        if (ON(7)) { PHASE_BEGIN LAYER_VALS norm_mod_phase(out, out + (size_t)NPR * DM, a.in[23] + l * DM, modl, 4096, 3072, XN, lane, gw, NGW); }
        grid.sync();
        if (ON(8)) { PHASE_BEGIN LAYER_VALS pg8::Gemm g{XN, (const bf16*)(wl + W_UP), NTOK, DUP, DM}; pg8::StaticOrder S; S.init(NTOK, DUP, G, bid); pg8::EpiBf16 E{U, DUP};
          pg8::gemm_phase<pg8::EpiBf16, pg8::StaticOrder, true, true>(ring, g, S, E, tid); }
        grid.sync();
        if (ON(9)) { PHASE_BEGIN convgate_phase(U, a.in[25] + (size_t)l * 3 * DUP, ACT, gt, NGT); }
        grid.sync();
        if (ON(10)) { PHASE_BEGIN LAYER_VALS pg8::Gemm g{ACT, (const bf16*)(wl + W_DOWN), NTOK, DM, DFF}; pg8::StaticOrder S; S.init(NTOK, DM, G, bid); pg8::EpiResid E{out, out + (size_t)NPR * DM, out, modl + 5120};
          pg8::gemm_phase<pg8::EpiResid, pg8::StaticOrder, true, true>(ring, g, S, E, tid); }
        grid.sync();
    }
    { PHASE_BEGIN
    for (int row = gw; row < NTOK; row += NGW) {
        float* xr = out + (size_t)row * DM;
        f32x4 v[4]; float ss = 0.f;
#pragma unroll
        for (int j = 0; j < 4; ++j) { v[j] = *(const f32x4*)(xr + 4 * (lane + 64 * j)); ss += dot4(v[j]); }
        const float rs = rsqrtf(wave_sum(ss) * (1.f / DM) + EPS);
#pragma unroll
        for (int j = 0; j < 4; ++j) { const int col = 4 * (lane + 64 * j); *(f32x4*)(xr + col) = v[j] * rs * *(const f32x4*)(a.in[27] + col); }
    } }
}

extern "C" void kernel_launch(void* const* d_in, const int* in_sizes, int n_in, void* d_out, int out_size, void* d_ws, size_t ws_size, hipStream_t stream) {
    static int grid = 0;
    if (grid == 0) {
        if (n_in != 28 || ws_size < WS_END) { fprintf(stderr, "kernel_launch: unexpected n_in %d / ws %zu\n", n_in, ws_size); grid = -1; return; }
        int dev = 0, cus = 0, per_cu = 0;
        hipGetDevice(&dev); hipDeviceGetAttribute(&cus, hipDeviceAttributeMultiprocessorCount, dev);
        hipFuncSetAttribute((const void*)mega_fwd, hipFuncAttributeMaxDynamicSharedMemorySize, LDS_BYTES);
        hipOccupancyMaxActiveBlocksPerMultiprocessor(&per_cu, (const void*)mega_fwd, NT, LDS_BYTES);
        if (per_cu < 1) per_cu = 1;
        grid = cus * per_cu;
        (void)hipGetLastError();
    }
    if (grid < 0) return;
    Args a{};
    for (int i = 0; i < 28; ++i) a.in[i] = (const float*)d_in[i];
    a.out = (float*)d_out; a.ws = (unsigned char*)d_ws;
    void* args[] = {&a};
    hipError_t e = hipLaunchCooperativeKernel((const void*)mega_fwd, dim3(grid), dim3(NT), args, LDS_BYTES, stream);
    if (e != hipSuccess) fprintf(stderr, "cooperative launch failed: %s (grid %d)\n", hipGetErrorString(e), grid);
}
```

```cpp
#include <hip/hip_runtime.h>
#include <hip/hip_cooperative_groups.h>
#include <cstdio>
#include <cstdint>
namespace cg = cooperative_groups;

namespace pg8 {
#define PG8_LAS __attribute__((address_space(3)))
typedef unsigned short bf16_t;
typedef short bf16x8 __attribute__((ext_vector_type(8)));
typedef float f32x4 __attribute__((ext_vector_type(4)));
typedef unsigned u32x4 __attribute__((ext_vector_type(4)));
constexpr int BM = 256, BK = 64, HALF = 128, HTB = HALF * BK * 2, STAGE_BYTES = 8 * HTB, NXCD = 8, WGM = 8;

__host__ __device__ __forceinline__ int lds_byte(int r, int c) { const int st = (r >> 4) * 2 + (c >> 5), rr = r & 15, cc = c & 31, ob = rr * 64 + cc * 2; return st * 1024 + (ob ^ (((ob >> 9) & 1) << 5)); }
__host__ __device__ __forceinline__ void stage_rc(int b, int& R, int& C) { const int st = b / 1024, sb = b % 1024, swz = sb ^ (((sb >> 9) & 1) << 5); R = (st >> 1) * 16 + swz / 64; C = (st & 1) * 32 + (swz % 64) / 2; }
__host__ __device__ __forceinline__ int perm32(int rho) { const int n = rho >> 4, i = rho & 15; return 8 * (i >> 2) + 4 * n + (i & 3); }

struct Unit { int pm, pn; };
struct Gemm { const bf16_t* A; const bf16_t* Bt; int M, N, K; };

struct StaticOrder {
    int nM, nN, nwg, G, c;
    __host__ __device__ void init(int M, int N, int G_, int c_) { nM = M / BM; nN = N / BM; nwg = nM * nN; G = G_; c = c_; }
    __host__ __device__ bool next(int i, Unit& u) const {
        const long L = (long)i * G + c; if (L >= nwg) return false;
        int wgid = (int)L; { const int q = nwg / NXCD, r = nwg % NXCD, xcd = wgid % NXCD, off = wgid / NXCD; wgid = (xcd < r ? xcd * (q + 1) : r * (q + 1) + (xcd - r) * q) + off; }
        const int nig = WGM * nN, gid = wgid / nig, fm = gid * WGM, gsz = (nM - fm) < WGM ? (nM - fm) : WGM;
        u.pm = fm + ((wgid % nig) % gsz); u.pn = (wgid % nig) / gsz; return true;
    }
    __device__ __forceinline__ void a_ready(const Unit&) const {}
    __device__ __forceinline__ void done(const Unit&) const {}
};

__device__ __forceinline__ unsigned cvt_pk_bf16(float lo, float hi) { unsigned r; asm volatile("v_cvt_pk_bf16_f32 %0, %1, %2" : "=v"(r) : "v"(lo), "v"(hi)); return r; }

struct EpiBf16 {
    static constexpr bool PERM = true, AFTER_DRAIN = false;
    bf16_t* O; int ldc;
    __device__ __forceinline__ void operator()(const f32x4 (&acc)[2][2][4][2], const Unit& u, int wr, int wc, int fr, int fq) const {
        const int row0 = u.pm * BM + wr * 64 + fr; const int col0 = u.pn * BM + wc * 32 + 8 * fq;
#pragma unroll
        for (int ai = 0; ai < 2; ++ai)
#pragma unroll
            for (int m = 0; m < 4; ++m) { bf16_t* rowp = O + (size_t)(row0 + ai * HALF + m * 16) * ldc + col0;
#pragma unroll
                for (int bj = 0; bj < 2; ++bj) { const f32x4 v0 = acc[ai][bj][m][0], v1 = acc[ai][bj][m][1];
                    u32x4 w; w.x = cvt_pk_bf16(v0[0], v0[1]); w.y = cvt_pk_bf16(v0[2], v0[3]); w.z = cvt_pk_bf16(v1[0], v1[1]); w.w = cvt_pk_bf16(v1[2], v1[3]);
                    *(u32x4*)(rowp + bj * HALF) = w; } }
    }
};
struct EpiResid {
    static constexpr bool PERM = false, AFTER_DRAIN = false;
    const float* r0; const float* r1; float* out; const float* gate;
    __device__ __forceinline__ void operator()(const f32x4 (&acc)[2][2][4][2], const Unit& u, int wr, int wc, int fr, int fq) const {
        const int cnd = u.pm < 32 ? 0 : 1 + ((u.pm - 32) >> 3);
        const float* gp = gate + cnd * 6144;
        const int col0 = u.pn * BM + wc * 32 + 4 * fq;
        f32x4 gv[2][2];
#pragma unroll
        for (int bj = 0; bj < 2; ++bj)
#pragma unroll
            for (int n = 0; n < 2; ++n) gv[bj][n] = *(const f32x4*)(gp + col0 + bj * HALF + n * 16);
#pragma unroll
        for (int ai = 0; ai < 2; ++ai)
#pragma unroll
            for (int m = 0; m < 4; ++m) { const int row = u.pm * BM + ai * HALF + wr * 64 + m * 16 + fr;
                const float* rs = row < 8192 ? r0 + (size_t)row * 1024 : r1 + (size_t)(row - 8192) * 1024; float* op = out + (size_t)row * 1024;
#pragma unroll
                for (int bj = 0; bj < 2; ++bj)
#pragma unroll
                    for (int n = 0; n < 2; ++n) { const int c = col0 + bj * HALF + n * 16; const f32x4 x = *(const f32x4*)(rs + c);
                        *(f32x4*)(op + c) = x + gv[bj][n] * acc[ai][bj][m][n]; } }
    }
};

template <class Epi, class Sched, bool ALIGN_EPI = false, bool SP2 = false>
__device__ __forceinline__ void gemm_phase(PG8_LAS unsigned char* lds, const Gemm g, const Sched& S, const Epi& E, const int tid) {
    const int wid = __builtin_amdgcn_readfirstlane(tid >> 6), lane = tid & 63, wr = wid >> 2, wc = wid & 3, fr = lane & 15, fq = lane >> 4;
    const int K = g.K, nt = K / BK;
    unsigned voffA[2], voffB[2];
#pragma unroll
    for (int i = 0; i < 2; ++i) { int R, C; stage_rc(tid * 16 + i * 8192, R, C); const int Rb = Epi::PERM ? ((R & ~31) + perm32(R & 31)) : R;
        voffA[i] = (unsigned)(R * K + C) * 2u; voffB[i] = (unsigned)(Rb * K + C) * 2u; }
    const size_t kstep = (size_t)(BK * 2);
    const size_t hstep = (size_t)HALF * K * 2;
    const size_t tstep = 2 * hstep;
    const unsigned ldsw = (unsigned)wid * 1024u;
    const int aoff = lds_byte(wr * 64 + fr, fq * 8), boff = lds_byte(wc * 32 + fr, fq * 8);
#define PG8_SA(b, h) (((b) * 2 + (h)) * HTB)
#define PG8_SB(b, h) ((4 + (b) * 2 + (h)) * HTB)
#define PG8_STAGE(bufoff, gbase, voff) do { _Pragma("unroll") for (int _i = 0; _i < 2; ++_i) \
        __builtin_amdgcn_global_load_lds((const unsigned*)((const char*)(gbase) + (voff)[_i]), (PG8_LAS unsigned*)(lds + (bufoff) + ldsw + _i * 8192), 16, 0, 0); } while (0)
#define PG8_LDA(dst, b, h) do { _Pragma("unroll") for (int m = 0; m < 4; ++m) _Pragma("unroll") for (int k = 0; k < 2; ++k) dst[m][k] = *(const PG8_LAS bf16x8*)(lds + PG8_SA(b, h) + aoff + m * 2048 + k * 1024); } while (0)
#define PG8_LDB(dst, b, h) do { _Pragma("unroll") for (int n = 0; n < 2; ++n) _Pragma("unroll") for (int k = 0; k < 2; ++k) dst[n][k] = *(const PG8_LAS bf16x8*)(lds + PG8_SB(b, h) + boff + n * 2048 + k * 1024); } while (0)
#define PG8_MMA(ai, bj, At, Bt) do { __builtin_amdgcn_s_setprio(1); _Pragma("unroll") for (int m = 0; m < 4; ++m) _Pragma("unroll") for (int n = 0; n < 2; ++n) _Pragma("unroll") for (int k = 0; k < 2; ++k) \
        acc[ai][bj][m][n] = __builtin_amdgcn_mfma_f32_16x16x32_bf16(Bt[n][k], At[m][k], acc[ai][bj][m][n], 0, 0, 0); __builtin_amdgcn_s_setprio(0); } while (0)
#define PG8_WAIT_V(n) asm volatile("s_waitcnt vmcnt(" #n ")" ::: "memory")
#define PG8_WAIT_L(n) asm volatile("s_waitcnt lgkmcnt(" #n ")" ::: "memory")
#define PG8_BAR __builtin_amdgcn_s_barrier()
#define PG8_SCHED __builtin_amdgcn_sched_barrier(0)
    Unit cur, nxt; int ui = 0;
    if (!S.next(0, cur)) return;
    f32x4 acc[2][2][4][2];
#pragma unroll
    for (int a = 0; a < 2; ++a)
#pragma unroll
        for (int b = 0; b < 2; ++b)
#pragma unroll
            for (int m = 0; m < 4; ++m)
#pragma unroll
                for (int n = 0; n < 2; ++n) acc[a][b][m][n] = (f32x4){0.f, 0.f, 0.f, 0.f};
    bf16x8 At[4][2], B0[2][2], B1[2][2];
    const char* cA = (const char*)g.A + (size_t)cur.pm * tstep; const char* cB = (const char*)g.Bt + (size_t)cur.pn * tstep;
    S.a_ready(cur);
    if constexpr (SP2) {
        PG8_STAGE(PG8_SB(0, 0), cB, voffB); PG8_STAGE(PG8_SB(0, 1), cB + hstep, voffB); PG8_STAGE(PG8_SA(0, 0), cA, voffA); PG8_STAGE(PG8_SA(0, 1), cA + hstep, voffA);
        if (wr == 1) PG8_BAR;
        PG8_WAIT_V(2); PG8_BAR;
        PG8_STAGE(PG8_SB(1, 0), cB + kstep, voffB); PG8_STAGE(PG8_SA(1, 0), cA + kstep, voffA); PG8_STAGE(PG8_SB(1, 1), cB + hstep + kstep, voffB);
        PG8_WAIT_V(6); PG8_BAR;
    } else {
        PG8_STAGE(PG8_SB(0, 0), cB, voffB); PG8_STAGE(PG8_SA(0, 0), cA, voffA); PG8_STAGE(PG8_SB(0, 1), cB + hstep, voffB); PG8_STAGE(PG8_SA(0, 1), cA + hstep, voffA);
        if (wr == 1) PG8_BAR;
        PG8_WAIT_V(4); PG8_BAR;
        PG8_STAGE(PG8_SB(1, 0), cB + kstep, voffB); PG8_STAGE(PG8_SA(1, 0), cA + kstep, voffA); PG8_STAGE(PG8_SB(1, 1), cB + hstep + kstep, voffB);
        PG8_WAIT_V(6); PG8_BAR;
    }
    for (;;) {
        const bool has_next = S.next(ui + 1, nxt);
        const char* nA = has_next ? (const char*)g.A + (size_t)nxt.pm * tstep : cA; const char* nB = has_next ? (const char*)g.Bt + (size_t)nxt.pn * tstep : cB;
        for (int t = 0; t < nt; t += 2) {
            const bool last = (t == nt - 2);
            const char* a1 = cA + (size_t)(t + 1) * kstep;
            const char* a2 = last ? nA : cA + (size_t)(t + 2) * kstep; const char* b2 = last ? nB : cB + (size_t)(t + 2) * kstep;
            const char* a3 = a2 + kstep; const char* b3 = b2 + kstep;
            if (last && has_next) S.a_ready(nxt);
            if constexpr (SP2) {
            PG8_LDB(B0, 0, 0); PG8_LDB(B1, 0, 1); PG8_SCHED; PG8_LDA(At, 0, 0); PG8_STAGE(PG8_SA(1, 1), a1 + hstep, voffA);
            PG8_WAIT_V(8); PG8_WAIT_L(0); PG8_BAR; PG8_MMA(0, 0, At, B0); PG8_MMA(0, 1, At, B1); PG8_BAR; PG8_SCHED;
            PG8_LDA(At, 0, 1); PG8_STAGE(PG8_SB(0, 0), b2, voffB); PG8_STAGE(PG8_SB(0, 1), b2 + hstep, voffB); PG8_STAGE(PG8_SA(0, 0), a2, voffA);
            PG8_WAIT_V(8); PG8_WAIT_L(0); PG8_BAR; PG8_MMA(1, 0, At, B0); PG8_MMA(1, 1, At, B1); PG8_BAR; PG8_SCHED;
            PG8_LDB(B0, 1, 0); PG8_LDB(B1, 1, 1); PG8_SCHED; PG8_LDA(At, 1, 0); PG8_STAGE(PG8_SA(0, 1), a2 + hstep, voffA);
            PG8_WAIT_V(8); PG8_WAIT_L(0); PG8_BAR; PG8_MMA(0, 0, At, B0); PG8_MMA(0, 1, At, B1); PG8_BAR; PG8_SCHED;
            PG8_LDA(At, 1, 1); PG8_STAGE(PG8_SB(1, 0), b3, voffB); PG8_STAGE(PG8_SB(1, 1), b3 + hstep, voffB); PG8_STAGE(PG8_SA(1, 0), a3, voffA);
            PG8_WAIT_V(8); PG8_WAIT_L(0); PG8_BAR; PG8_MMA(1, 0, At, B0); PG8_MMA(1, 1, At, B1); PG8_BAR; PG8_SCHED;
            } else {
            PG8_LDB(B0, 0, 0); PG8_SCHED; PG8_LDA(At, 0, 0); PG8_STAGE(PG8_SA(1, 1), a1 + hstep, voffA);
            PG8_WAIT_L(8); PG8_BAR; PG8_WAIT_L(0); PG8_MMA(0, 0, At, B0); PG8_BAR; PG8_SCHED;
            PG8_LDB(B1, 0, 1); PG8_STAGE(PG8_SB(0, 0), b2, voffB);
            PG8_BAR; PG8_WAIT_L(0); PG8_MMA(0, 1, At, B1); PG8_BAR;
            PG8_LDA(At, 0, 1); PG8_STAGE(PG8_SA(0, 0), a2, voffA);
            PG8_BAR; PG8_WAIT_L(0); PG8_MMA(1, 0, At, B0); PG8_BAR; PG8_SCHED;
            PG8_STAGE(PG8_SB(0, 1), b2 + hstep, voffB);
            PG8_WAIT_V(6); PG8_BAR; PG8_MMA(1, 1, At, B1); PG8_BAR;
            PG8_LDB(B0, 1, 0); PG8_SCHED; PG8_LDA(At, 1, 0); PG8_STAGE(PG8_SA(0, 1), a2 + hstep, voffA);
            PG8_WAIT_L(8); PG8_BAR; PG8_WAIT_L(0); PG8_MMA(0, 0, At, B0); PG8_BAR; PG8_SCHED;
            PG8_LDB(B1, 1, 1); PG8_STAGE(PG8_SB(1, 0), b3, voffB);
            PG8_BAR; PG8_WAIT_L(0); PG8_MMA(0, 1, At, B1); PG8_BAR;
            PG8_LDA(At, 1, 1); PG8_STAGE(PG8_SA(1, 0), a3, voffA);
            PG8_BAR; PG8_WAIT_L(0); PG8_MMA(1, 0, At, B0); PG8_BAR; PG8_SCHED;
            PG8_STAGE(PG8_SB(1, 1), b3 + hstep, voffB);
            PG8_WAIT_V(6); PG8_BAR; PG8_MMA(1, 1, At, B1); PG8_BAR;
            }
        }
        if constexpr (ALIGN_EPI) { if (wr == 0) PG8_BAR; }
        if constexpr (!Epi::AFTER_DRAIN) { E(acc, cur, wr, wc, fr, fq); S.done(cur); }
        if (!has_next) break;
#pragma unroll
        for (int a = 0; a < 2; ++a)
#pragma unroll
            for (int b = 0; b < 2; ++b)
#pragma unroll
                for (int m = 0; m < 4; ++m)
#pragma unroll
                    for (int n = 0; n < 2; ++n) acc[a][b][m][n] = (f32x4){0.f, 0.f, 0.f, 0.f};
        cur = nxt; cA = nA; cB = nB; ++ui;
        if constexpr (ALIGN_EPI) { if (wr == 1) PG8_BAR; }
    }
    PG8_WAIT_V(0);
    if constexpr (!ALIGN_EPI) { if (wr == 0) PG8_BAR; }
    PG8_BAR;
#undef PG8_SA
#undef PG8_SB
#undef PG8_STAGE
#undef PG8_LDA
#undef PG8_LDB
#undef PG8_MMA
#undef PG8_WAIT_V
#undef PG8_WAIT_L
#undef PG8_BAR
#undef PG8_SCHED
}
}

typedef unsigned short bf16;
typedef float f32x4 __attribute__((ext_vector_type(4)));
typedef short bf16x8 __attribute__((ext_vector_type(8)));
typedef unsigned u32x4 __attribute__((ext_vector_type(4)));
typedef unsigned u32x2 __attribute__((ext_vector_type(2)));

constexpr int NW = 8, NT = 512;
constexpr int DM = 1024, NTOK = 12288, NPR = 8192, NKR = 13312, INC = 2144, INP = 2304, DFF = 2816, DUP = 5632;
constexpr float EPS = 1e-6f, LOG2E = 1.4426950408889634f;
constexpr float QS = 0.125f * LOG2E;
constexpr float MLAQS = 0.10206207261596575f * LOG2E;

constexpr size_t MiB = 1u << 20;
constexpr size_t WS_CTL = 0, WS_MOD = 1 * MiB, WS_ROPE = 1 * MiB + 256 * 1024, WS_W = 2 * MiB, W_LSTRIDE = 24 * MiB;
constexpr size_t W_IN = 0, W_OUT = 4718592, W_UP = W_OUT + 2097152, W_DOWN = W_UP + 11534336, W_B2 = W_DOWN + 5767168;
static_assert(W_B2 + 786432 <= W_LSTRIDE, "weights");
constexpr size_t WS_XN = 50 * MiB, WS_PROJ = 74 * MiB, WS_A2 = 128 * MiB, WS_MQKV = 138 * MiB, WS_QC = 164 * MiB, WS_KPE = 203 * MiB, WS_YCAT = 204 * MiB;
constexpr size_t WS_ACT = 50 * MiB, WS_U = 116 * MiB, WS_END = 248 * MiB;
constexpr size_t QSZ = (size_t)NKR * 256 * 2, KSZ = (size_t)NKR * 128 * 2;
constexpr int LDS_BYTES = 131072 + 4096, LDS_CTL = 131072;
constexpr size_t WS_BAR = 16384;

struct Args { const float* in[28]; float* out; unsigned char* ws; };

__device__ __forceinline__ unsigned f2bf(float f) { unsigned u = __builtin_bit_cast(unsigned, f); return (u + 0x7fffu + ((u >> 16) & 1u)) >> 16; }
__device__ __forceinline__ unsigned pk2(float lo, float hi) { return f2bf(lo) | (f2bf(hi) << 16); }
__device__ __forceinline__ float bflo(unsigned u) { return __builtin_bit_cast(float, u << 16); }
__device__ __forceinline__ float bfhi(unsigned u) { return __builtin_bit_cast(float, u & 0xffff0000u); }
__device__ __forceinline__ f32x4 ld4bf(const bf16* p) { const u32x2 u = *(const u32x2*)p; return (f32x4){bflo(u.x), bfhi(u.x), bflo(u.y), bfhi(u.y)}; }
__device__ __forceinline__ void st4bf(bf16* p, f32x4 v) { u32x2 u; u.x = pk2(v[0], v[1]); u.y = pk2(v[2], v[3]); *(u32x2*)p = u; }
__device__ __forceinline__ float wave_sum(float v) {
#pragma unroll
    for (int o = 1; o < 64; o <<= 1) v += __shfl_xor(v, o);
    return v;
}
__device__ __forceinline__ float sum16(float v) {
#pragma unroll
    for (int o = 1; o < 16; o <<= 1) v += __shfl_xor(v, o);
    return v;
}
__device__ __forceinline__ float dot4(f32x4 a) { return (a[0] * a[0] + a[1] * a[1]) + (a[2] * a[2] + a[3] * a[3]); }
__device__ __forceinline__ f32x4 shfl4(f32x4 v, int m) { return (f32x4){__shfl_xor(v[0], m), __shfl_xor(v[1], m), __shfl_xor(v[2], m), __shfl_xor(v[3], m)}; }

__device__ __forceinline__ void transpose_item(const float* W, int N, bf16* WT, int ldk, int row_off, int k_off, float scale, float* scr, int item, int lane) {
    const int nblk = N / 32, kb = item / nblk, nb = item % nblk, k0 = 64 * kb, n0 = 32 * nb;
#pragma unroll 8
    for (int i = 0; i < 32; ++i) { const int kk = 2 * i + (lane >> 5); scr[kk * 33 + (lane & 31)] = W[(size_t)(k0 + kk) * N + n0 + (lane & 31)] * scale; }
    asm volatile("s_waitcnt lgkmcnt(0)" ::: "memory");
    const int c = lane & 7;
#pragma unroll
    for (int j = 0; j < 4; ++j) { const int n = (lane >> 3) + 8 * j; const float* s = scr + (8 * c) * 33 + n;
        u32x4 o; o.x = pk2(s[0 * 33], s[1 * 33]); o.y = pk2(s[2 * 33], s[3 * 33]); o.z = pk2(s[4 * 33], s[5 * 33]); o.w = pk2(s[6 * 33], s[7 * 33]);
        *(u32x4*)(WT + (size_t)(row_off + n0 + n) * ldk + k_off + k0 + 8 * c) = o; }
    asm volatile("s_waitcnt lgkmcnt(0)" ::: "memory");
}

__device__ __forceinline__ void phase0(const Args& a, unsigned char* lds, int tid, int lane, int wave) {
    unsigned char* ws = a.ws;
    const int G = gridDim.x, bid = blockIdx.x;
    for (int it = bid; it < 96; it += G) {
        const int l = it / 48, n0 = (it % 48) * 128;
        const float* wa = a.in[10] + (size_t)l * 1024 * 6144;
        float acc[3][2] = {{0.f, 0.f}, {0.f, 0.f}, {0.f, 0.f}};
        const int kb = wave * 128;
#pragma unroll 4
        for (int k = 0; k < 128; ++k) {
            const int kk = kb + k;
            const float2 w = *(const float2*)(wa + (size_t)kk * 6144 + n0 + 2 * lane);
            const float c0 = a.in[9][kk], c1 = a.in[8][kk], c2 = a.in[8][1024 + kk];
            const float s0 = c0 / (1.f + __expf(-c0)), s1 = c1 / (1.f + __expf(-c1)), s2 = c2 / (1.f + __expf(-c2));
            acc[0][0] += s0 * w.x; acc[0][1] += s0 * w.y; acc[1][0] += s1 * w.x; acc[1][1] += s1 * w.y; acc[2][0] += s2 * w.x; acc[2][1] += s2 * w.y;
        }
        float* red = (float*)lds;
#pragma unroll
        for (int c = 0; c < 3; ++c) { red[(wave * 3 + c) * 128 + 2 * lane] = acc[c][0]; red[(wave * 3 + c) * 128 + 2 * lane + 1] = acc[c][1]; }
        __syncthreads();
        if (tid < 384) { const int c = tid / 128, n = tid % 128; float s = 0.f;
#pragma unroll
            for (int w = 0; w < 8; ++w) s += red[(w * 3 + c) * 128 + n];
            ((float*)(ws + WS_MOD))[(size_t)(l * 3 + c) * 6144 + n0 + n] = s + a.in[11][(size_t)l * 6144 + n0 + n]; }
        __syncthreads();
    }
    if (bid == G - 1) {
        float* rt = (float*)(ws + WS_ROPE);
        for (int e = tid; e < 1024; e += NT) { const int pos = e >> 4, i = e & 15; const float inv = exp2f(-(float)(2 * i) / 32.f * 13.287712379549449f); const float ang = (float)pos * inv;
            rt[e] = __cosf(ang); rt[1024 + e] = __sinf(ang); }
        for (int e = tid; e < 512; e += NT) { const int pos = e >> 3, i = e & 7; const float inv = exp2f(-(float)(2 * i) / 16.f * 13.287712379549449f); const float ang = (float)pos * inv;
            rt[2048 + e] = __cosf(ang); rt[2560 + e] = __sinf(ang); }
    }
    const int gt = bid * NT + tid, NGT = G * NT;
    if (gt < 256) ((unsigned*)(ws + WS_CTL))[gt] = 0u;
    if (gt < 3456) ((unsigned*)(ws + WS_BAR))[gt] = 0u;
    for (int l = 0; l < 2; ++l) {
        bf16* b2 = (bf16*)(ws + WS_W + l * W_LSTRIDE + W_B2);
        for (int ch = gt; ch < 1024 * 48; ch += NGT) { const int n = ch / 48, k = (ch % 48) * 8;
            const bool data = (n < 384 && k < 192) || (n >= 384 && n < 896 && k >= 192 && k < 320);
            if (!data) *(u32x4*)(b2 + (size_t)n * 384 + k) = (u32x4){0u, 0u, 0u, 0u}; }
        bf16* wi = (bf16*)(ws + WS_W + l * W_LSTRIDE + W_IN) + (size_t)INC * 1024;
        for (int ch = gt; ch < 160 * 128; ch += NGT) *(u32x4*)(wi + (size_t)ch * 8) = (u32x4){0u, 0u, 0u, 0u};
    }
    float* scr = (float*)(lds + 16384 + wave * 12288);
    const int gw = bid * NW + wave, NGW = G * NW;
    constexpr int I_IN = 16 * 67, I_OUT = 16 * 32, I_UP = 16 * 176, I_DN = 44 * 32, I_Q = 3 * 12, I_KV = 2 * 16, I_L = I_IN + I_OUT + I_UP + I_DN + I_Q + I_KV;
    for (int it = gw; it < 2 * I_L; it += NGW) {
        const int l = it / I_L; int r = it % I_L;
        unsigned char* wl = ws + WS_W + l * W_LSTRIDE;
        if (r < I_IN) { transpose_item(a.in[13] + (size_t)l * 1024 * INC, INC, (bf16*)(wl + W_IN), 1024, 0, 0, 1.f, scr, r, lane); continue; } r -= I_IN;
        if (r < I_OUT) { transpose_item(a.in[22] + (size_t)l * 1024 * 1024, 1024, (bf16*)(wl + W_OUT), 1024, 0, 0, 1.f, scr, r, lane); continue; } r -= I_OUT;
        if (r < I_UP) { transpose_item(a.in[24] + (size_t)l * 1024 * DUP, DUP, (bf16*)(wl + W_UP), 1024, 0, 0, 1.f, scr, r, lane); continue; } r -= I_UP;
        if (r < I_DN) { transpose_item(a.in[26] + (size_t)l * DFF * 1024, 1024, (bf16*)(wl + W_DOWN), DFF, 0, 0, 1.f, scr, r, lane); continue; } r -= I_DN;
        if (r < I_Q) { transpose_item(a.in[16] + (size_t)l * 192 * 384, 384, (bf16*)(wl + W_B2), 384, 0, 0, MLAQS, scr, r, lane); continue; } r -= I_Q;
        transpose_item(a.in[18] + (size_t)l * 128 * 512, 512, (bf16*)(wl + W_B2), 384, 384, 192, 1.f, scr, r, lane);
    }
}

__device__ __forceinline__ void norm_mod_phase(const float* x0, const float* x1, const float* nw, const float* mod, int sc_off, int sh_off, bf16* XN, int lane, int gw, int NGW) {
    for (int row = gw; row < NTOK; row += NGW) {
        const float* xr = row < NPR ? x0 + (size_t)row * DM : x1 + (size_t)(row - NPR) * DM;
        const int c = row < NPR ? 0 : 1 + ((row - NPR) >> 11);
        const float* mp = mod + c * 6144;
        f32x4 v[4]; float ss = 0.f;
#pragma unroll
        for (int j = 0; j < 4; ++j) { v[j] = *(const f32x4*)(xr + 4 * (lane + 64 * j)); ss += dot4(v[j]); }
        const float rs = rsqrtf(wave_sum(ss) * (1.f / DM) + EPS);
#pragma unroll
        for (int j = 0; j < 4; ++j) { const int col = 4 * (lane + 64 * j);
            const f32x4 g = *(const f32x4*)(nw + col), sc = *(const f32x4*)(mp + sc_off + col), sh = *(const f32x4*)(mp + sh_off + col);
            const f32x4 h = v[j] * rs * g * (1.f + sc) + sh;
            st4bf(XN + (size_t)row * DM + col, h); }
    }
}

struct P3Ptrs {
    const bf16* PROJ; bf16 *A2, *KPE, *YCAT, *Qc_rot, *Qc_raw, *Kc, *Vc, *Qd_rot, *Qd_raw, *Kd, *Vd;
    const float *conv_a, *gq_mla, *gkv_mla, *gq, *gk, *rope;
    const float *c_ckv, *c_kpe, *c_gk, *c_gv, *c_sk, *c_sv;
    float *o_ckv, *o_kpe, *o_gk, *o_gv, *o_sk, *o_sv;
    int l;
};
__device__ __forceinline__ f32x4 rope64(f32x4 v, int jl, int prow, int pcol, const float* rt) {
    const f32x4 pr = shfl4(v, 4);
    const int pos = jl < 8 ? prow : pcol, fi = 4 * (jl & 3);
    const f32x4 c = *(const f32x4*)(rt + pos * 16 + fi), s = *(const f32x4*)(rt + 1024 + pos * 16 + fi);
    const float sg = (jl & 4) ? 1.f : -1.f;
    return v * c + pr * s * sg;
}
__device__ __forceinline__ void p3_phase(const P3Ptrs& P, int lane, int gw, int NGW) {
    const int l = P.l;
    for (int row = gw; row < NKR; row += NGW) {
        if (row < NTOK) {
            const bool samp = row >= NPR;
            int b, t, kr, T;
            if (!samp) { b = row >> 8; t = row & 255; kr = row; T = 256; } else { b = (row - NPR) >> 11; t = (row - NPR) & 2047; kr = NPR + b * 2560 + t; T = 2048; }
            const int prow = t >> 6, pcol = t & 63;
            const bf16* pr = P.PROJ + (size_t)row * INP;
            const size_t ob = (size_t)((b * 2 + l) * 256 + t);
            { const int ci = 4 * lane;
              const f32x4 xa = ld4bf(pr + ci), gb = ld4bf(pr + 256 + ci), gc = ld4bf(pr + 512 + ci);
              f32x4 pv = (f32x4){0.f, 0.f, 0.f, 0.f}, nx = pv;
              if (t > 0) pv = ld4bf(pr - INP + ci) * ld4bf(pr - INP + 512 + ci);
              if (t < T - 1) nx = ld4bf(pr + INP + ci) * ld4bf(pr + INP + 512 + ci);
              const float* cw = P.conv_a + (size_t)l * 768;
              const f32x4 w0 = *(const f32x4*)(cw + ci), w1 = *(const f32x4*)(cw + 256 + ci), w2 = *(const f32x4*)(cw + 512 + ci);
              st4bf(P.YCAT + (size_t)row * DM + ci, gb * (w0 * pv + w1 * (xa * gc) + w2 * nx)); }
            { f32x4 v = (f32x4){0.f, 0.f, 0.f, 0.f}; if (lane < 48) v = ld4bf(pr + 768 + 4 * lane);
              const float rs = rsqrtf(wave_sum(dot4(v)) * (1.f / 192.f) + EPS);
              if (lane < 48) st4bf(P.A2 + (size_t)kr * 384 + 4 * lane, v * rs * *(const f32x4*)(P.gq_mla + l * 192 + 4 * lane)); }
            { f32x4 v = (f32x4){0.f, 0.f, 0.f, 0.f}; if (lane < 32) v = ld4bf(pr + 960 + 4 * lane);
              const float rs = rsqrtf(wave_sum(dot4(v)) * (1.f / 128.f) + EPS);
              if (lane < 32) { const f32x4 o = v * rs * *(const f32x4*)(P.gkv_mla + l * 128 + 4 * lane);
                  st4bf(P.A2 + (size_t)kr * 384 + 192 + 4 * lane, o);
                  if (!samp) *(f32x4*)(P.o_ckv + ob * 128 + 4 * lane) = o; }
              else if (lane < 48) { unsigned zz = 0u; asm volatile("" : "+v"(zz)); *(u32x2*)(P.A2 + (size_t)kr * 384 + 320 + 4 * (lane - 32)) = (u32x2){zz, zz}; } }
            { f32x4 v = (f32x4){0.f, 0.f, 0.f, 0.f}; if (lane < 8) v = ld4bf(pr + 1088 + 4 * lane);
              const f32x4 pt = shfl4(v, 2);
              const int pos = lane < 4 ? prow : pcol, fi = 4 * (lane & 1);
              const int psafe = pos & 63;
              const f32x4 c = *(const f32x4*)(P.rope + 2048 + psafe * 8 + fi), s = *(const f32x4*)(P.rope + 2560 + psafe * 8 + fi);
              const float sg = (lane & 2) ? 1.f : -1.f;
              const f32x4 r = v * c + pt * s * sg;
              if (lane < 8) { if (!samp) *(f32x4*)(P.o_kpe + ob * 32 + 4 * lane) = v; st4bf(P.KPE + (size_t)kr * 32 + 4 * lane, samp ? r : v); } }
            const int jl = lane & 15;
            { f32x4 v = ld4bf(pr + 1120 + 4 * lane);
              const float rs = rsqrtf(sum16(dot4(v)) * (1.f / 64.f) + EPS);
              v = v * rs * *(const f32x4*)(P.gq + l * 64 + 4 * jl);
              st4bf(P.Qc_raw + (size_t)kr * 256 + 4 * lane, v * QS);
              const f32x4 r = rope64(v, jl, prow, pcol, P.rope);
              if (samp) st4bf(P.Qc_rot + (size_t)kr * 256 + 4 * lane, r * QS); }
            { f32x4 v = ld4bf(pr + 1376 + 4 * lane);
              const float rs = rsqrtf(sum16(dot4(v)) * (1.f / 64.f) + EPS);
              const f32x4 kn = v * rs * *(const f32x4*)(P.gk + l * 64 + 4 * jl);
              const f32x4 r = rope64(kn, jl, prow, pcol, P.rope);
              if (lane < 32) { if (!samp) *(f32x4*)(P.o_gk + ob * 128 + 4 * lane) = kn; st4bf(P.Kc + (size_t)kr * 128 + 4 * lane, samp ? r : kn); }
              else { if (!samp) *(f32x4*)(P.o_gv + ob * 128 + 4 * (lane - 32)) = v; st4bf(P.Vc + (size_t)kr * 128 + 4 * (lane - 32), v); } }
            { const f32x4 v = ld4bf(pr + 1632 + 4 * lane);
              st4bf(P.Qd_raw + (size_t)kr * 256 + 4 * lane, v * QS);
              const f32x4 r = rope64(v, jl, prow, pcol, P.rope);
              if (samp) st4bf(P.Qd_rot + (size_t)kr * 256 + 4 * lane, r * QS); }
            { const f32x4 v = ld4bf(pr + 1888 + 4 * lane);
              const f32x4 r = rope64(v, jl, prow, pcol, P.rope);
              if (lane < 32) { if (!samp) *(f32x4*)(P.o_sk + ob * 128 + 4 * lane) = v; st4bf(P.Kd + (size_t)kr * 128 + 4 * lane, samp ? r : v); }
              else { if (!samp) *(f32x4*)(P.o_sv + ob * 128 + 4 * (lane - 32)) = v; st4bf(P.Vd + (size_t)kr * 128 + 4 * (lane - 32), v); } }
        } else {
            const int ci = row - NTOK, b = ci >> 9, j = ci & 511, kr = NPR + b * 2560 + 2048 + j;
            const size_t cb = (size_t)((b * 2 + l) * 512 + j);
            f32x4 z = (f32x4){0.f, 0.f, 0.f, 0.f}; asm volatile("" : "+v"(z));
            if (lane < 48) st4bf(P.A2 + (size_t)kr * 384 + 4 * lane, z);
            if (lane < 32) st4bf(P.A2 + (size_t)kr * 384 + 192 + 4 * lane, *(const f32x4*)(P.c_ckv + cb * 128 + 4 * lane));
            else if (lane < 48) st4bf(P.A2 + (size_t)kr * 384 + 320 + 4 * (lane - 32), z);
            if (lane < 8) st4bf(P.KPE + (size_t)kr * 32 + 4 * lane, *(const f32x4*)(P.c_kpe + cb * 32 + 4 * lane));
            if (lane < 32) { st4bf(P.Kc + (size_t)kr * 128 + 4 * lane, *(const f32x4*)(P.c_gk + cb * 128 + 4 * lane));
                             st4bf(P.Kd + (size_t)kr * 128 + 4 * lane, *(const f32x4*)(P.c_sk + cb * 128 + 4 * lane)); }
            else { st4bf(P.Vc + (size_t)kr * 128 + 4 * (lane - 32), *(const f32x4*)(P.c_gv + cb * 128 + 4 * (lane - 32)));
                   st4bf(P.Vd + (size_t)kr * 128 + 4 * (lane - 32), *(const f32x4*)(P.c_sv + cb * 128 + 4 * (lane - 32))); }
        }
    }
}

struct AttnSrc {
    const bf16* Qraw; const bf16* Qrot; int qpitch;
    const bf16* K0; int k0pitch; const bf16* K1;
    const bf16* V; int vpitch;
    bf16* Y; int outcol;
    int krbase, rowbase, q0, lo, hi, nctx;
    bool samp, window; float m0; bool sink;
    const float* rope;
};
template <int DK>
__device__ __forceinline__ void attn_unit(const AttnSrc& S, unsigned char* lds, int tid, int lane, int wave) {
    constexpr int KP = DK + 8, VP = 68, KS = DK / 32, CPK = DK / 8;
    bf16* Ks = (bf16*)lds;
    bf16* Vt = (bf16*)(lds + 2 * 64 * KP * 2);
    const int g = lane >> 4, fr = lane & 15;
    const int qpos = S.q0 + wave * 16 + fr;
    const size_t qkr = (size_t)(S.krbase + qpos);
    bf16x8 qraw[KS], qrot[KS];
#pragma unroll
    for (int ks = 0; ks < KS; ++ks) { qraw[ks] = *(const bf16x8*)(S.Qraw + qkr * S.qpitch + ks * 32 + g * 8); qrot[ks] = qraw[ks]; }
    if (S.samp) {
        if (DK == 96) {
            const bf16x8 own = qraw[KS - 1], par = *(const bf16x8*)(S.Qraw + qkr * S.qpitch + 64 + (g ^ 1) * 8);
            const int pos = g < 2 ? (qpos >> 6) : (qpos & 63);
            const float sg = (g & 1) ? 1.f : -1.f;
            const float* ct = S.rope + 2048 + pos * 8; const float* st = S.rope + 2560 + pos * 8;
            bf16x8 r;
#pragma unroll
            for (int e = 0; e < 8; ++e) { const float o = bflo((unsigned)(unsigned short)own[e]), p = bflo((unsigned)(unsigned short)par[e]);
                r[e] = (short)f2bf(o * ct[e] + p * st[e] * sg); }
            qrot[KS - 1] = r;
        } else {
#pragma unroll
            for (int ks = 0; ks < KS; ++ks) qrot[ks] = *(const bf16x8*)(S.Qrot + qkr * S.qpitch + ks * 32 + g * 8);
        }
    }
    float m = S.m0, l = (S.sink && g == 0) ? 1.f : 0.f;
    f32x4 o[4];
#pragma unroll
    for (int d = 0; d < 4; ++d) o[d] = (f32x4){0.f, 0.f, 0.f, 0.f};
    const int nloc = S.hi - S.lo, ntile = nloc + S.nctx;
    u32x4 kreg0, kreg1, vreg;
    const int kc0 = tid, kc1 = tid + NT;
    const int key0 = kc0 / CPK, part0 = kc0 % CPK, key1 = kc1 / CPK, part1 = kc1 % CPK;
    const int vkey = tid & 63, vdc = tid >> 6;
    auto gload = [&](int j) {
        const int tile = j < nloc ? S.lo + j : 32 + (j - nloc);
        const size_t kr = (size_t)(S.krbase + tile * 64);
        if (DK == 64) { kreg0 = *(const u32x4*)(S.K0 + (kr + key0) * S.k0pitch + part0 * 8); }
        else {
            kreg0 = part0 < 8 ? *(const u32x4*)(S.K0 + (kr + key0) * S.k0pitch + part0 * 8) : *(const u32x4*)(S.K1 + (kr + key0) * 32 + (part0 - 8) * 8);
            if (kc1 < 64 * CPK) kreg1 = part1 < 8 ? *(const u32x4*)(S.K0 + (kr + key1) * S.k0pitch + part1 * 8) : *(const u32x4*)(S.K1 + (kr + key1) * 32 + (part1 - 8) * 8);
        }
        vreg = *(const u32x4*)(S.V + (kr + vkey) * S.vpitch + vdc * 8);
    };
    auto lstore = [&](int buf) {
        bf16* kb = Ks + buf * 64 * KP; bf16* vb = Vt + buf * 64 * VP;
        *(u32x4*)(kb + key0 * KP + part0 * 8) = kreg0;
        if (DK == 96) { if (kc1 < 64 * CPK) *(u32x4*)(kb + key1 * KP + part1 * 8) = kreg1; }
        bf16* vp = vb + (vdc * 8) * VP + vkey;
        vp[0 * VP] = (bf16)(vreg.x & 0xffffu); vp[1 * VP] = (bf16)(vreg.x >> 16); vp[2 * VP] = (bf16)(vreg.y & 0xffffu); vp[3 * VP] = (bf16)(vreg.y >> 16);
        vp[4 * VP] = (bf16)(vreg.z & 0xffffu); vp[5 * VP] = (bf16)(vreg.z >> 16); vp[6 * VP] = (bf16)(vreg.w & 0xffffu); vp[7 * VP] = (bf16)(vreg.w >> 16);
    };
    gload(0); lstore(0);
    __syncthreads();
    for (int j = 0; j < ntile; ++j) {
        const int buf = j & 1;
        if (j + 1 < ntile) gload(j + 1);
        const bool loc = j < nloc;
        const bool use_rot = loc && S.samp;
        const bf16* kb = Ks + buf * 64 * KP; const bf16* vb = Vt + buf * 64 * VP;
        f32x4 s[4];
#pragma unroll
        for (int kk = 0; kk < 4; ++kk) { s[kk] = (f32x4){0.f, 0.f, 0.f, 0.f};
#pragma unroll
            for (int ks = 0; ks < KS; ++ks) { const bf16x8 af = *(const bf16x8*)(kb + (kk * 16 + fr) * KP + ks * 32 + g * 8);
                const bf16x8 qf = use_rot ? qrot[ks] : qraw[ks];
                s[kk] = __builtin_amdgcn_mfma_f32_16x16x32_bf16(af, qf, s[kk], 0, 0, 0); } }
        if (S.window && loc) {
            const int kp0 = (S.lo + j) * 64 + g * 4;
#pragma unroll
            for (int kk = 0; kk < 4; ++kk)
#pragma unroll
                for (int i = 0; i < 4; ++i) { const int d = kp0 + kk * 16 + i - qpos; if (d > 128 || d < -128) s[kk][i] = -INFINITY; }
        }
        float mx = -INFINITY;
#pragma unroll
        for (int kk = 0; kk < 4; ++kk) mx = fmaxf(mx, fmaxf(fmaxf(s[kk][0], s[kk][1]), fmaxf(s[kk][2], s[kk][3])));
        mx = fmaxf(mx, __shfl_xor(mx, 16)); mx = fmaxf(mx, __shfl_xor(mx, 32));
        const float mn = fmaxf(m, mx), alpha = __builtin_amdgcn_exp2f(m - mn);
        m = mn;
        float ls = 0.f;
#pragma unroll
        for (int kk = 0; kk < 4; ++kk)
#pragma unroll
            for (int i = 0; i < 4; ++i) { const float p = __builtin_amdgcn_exp2f(s[kk][i] - mn); s[kk][i] = p; ls += p; }
        l = l * alpha + ls;
#pragma unroll
        for (int d = 0; d < 4; ++d) o[d] = o[d] * alpha;
        bf16x8 pf[2];
#pragma unroll
        for (int pp = 0; pp < 2; ++pp) {
            const unsigned w0 = pk2(s[2 * pp][0], s[2 * pp][1]), w1 = pk2(s[2 * pp][2], s[2 * pp][3]), w2 = pk2(s[2 * pp + 1][0], s[2 * pp + 1][1]), w3 = pk2(s[2 * pp + 1][2], s[2 * pp + 1][3]);
            pf[pp] = __builtin_bit_cast(bf16x8, (u32x4){w0, w1, w2, w3});
        }
#pragma unroll
        for (int d = 0; d < 4; ++d)
#pragma unroll
            for (int pp = 0; pp < 2; ++pp) {
                const bf16* vr = vb + (d * 16 + fr) * VP + pp * 32 + g * 4;
                const u32x2 lo = *(const u32x2*)vr, hi = *(const u32x2*)(vr + 16);
                const bf16x8 af = __builtin_bit_cast(bf16x8, (u32x4){lo.x, lo.y, hi.x, hi.y});
                o[d] = __builtin_amdgcn_mfma_f32_16x16x32_bf16(af, pf[pp], o[d], 0, 0, 0);
            }
        if (j + 1 < ntile) lstore(buf ^ 1);
        __syncthreads();
    }
    float lt = l + __shfl_xor(l, 16); lt += __shfl_xor(lt, 32);
    const float inv = 1.f / lt;
    bf16* yr = S.Y + (size_t)(S.rowbase + qpos) * DM + S.outcol + g * 4;
#pragma unroll
    for (int d = 0; d < 4; ++d) st4bf(yr + d * 16, o[d] * inv);
}

struct AttnBufs { const bf16 *MQKV, *KPE, *Qc_rot, *Qc_raw, *Kc, *Vc, *Qd_rot, *Qd_raw, *Kd, *Vd; bf16* YCAT; const float* sink; const float* rope; unsigned* ctr; };
constexpr int ATT_NU = 384 + 768;
__device__ __forceinline__ void attn_phase(const AttnBufs& B, unsigned char* lds, int tid, int lane, int wave) {
    volatile unsigned* shu = (volatile unsigned*)(lds + LDS_CTL);
    for (;;) {
        if (tid == 0) *shu = atomicAdd(B.ctr, 1u);
        __syncthreads();
        const int u = (int)*shu;
        if (u >= ATT_NU) break;
        int type, b, h, qt; bool samp;
        if (u < 384) { type = u >> 7; const int v = u & 127; b = v >> 6; h = (v >> 4) & 3; qt = v & 15; samp = true; }
        else { const int w = u - 384; type = w >> 8; const int v = w & 255; b = v >> 3; h = (v >> 1) & 3; qt = v & 1; samp = false; }
        AttnSrc S;
        S.samp = samp; S.q0 = qt * 128; S.rope = B.rope; S.Y = B.YCAT;
        S.krbase = samp ? NPR + b * 2560 : b * 256; S.rowbase = samp ? NPR + b * 2048 : b * 256;
        S.window = false; S.sink = false; S.m0 = -1e30f;
        if (!samp) { S.lo = 0; S.hi = 4; S.nctx = 0; }
        else { S.lo = 0; S.hi = 32; S.nctx = 8; }
        if (type == 0) {
            S.Qraw = B.MQKV + h * 96; S.Qrot = S.Qraw; S.qpitch = 1024; S.K0 = B.MQKV + 384 + h * 128; S.k0pitch = 1024; S.K1 = B.KPE; S.V = B.MQKV + 384 + h * 128 + 64; S.vpitch = 1024; S.outcol = 256 + h * 64;
            attn_unit<96>(S, lds, tid, lane, wave);
        } else {
            if (type == 1) { S.Qraw = B.Qc_raw + h * 64; S.Qrot = B.Qc_rot + h * 64; S.K0 = B.Kc + (h >> 1) * 64; S.V = B.Vc + (h >> 1) * 64; S.outcol = 512 + h * 64; }
            else { S.Qraw = B.Qd_raw + h * 64; S.Qrot = B.Qd_rot + h * 64; S.K0 = B.Kd + (h >> 1) * 64; S.V = B.Vd + (h >> 1) * 64; S.outcol = 768 + h * 64;
                   S.sink = true; S.m0 = B.sink[h] * LOG2E;
                   if (samp) { S.window = true; const int lo = (S.q0 - 128) / 64; S.lo = lo < 0 ? 0 : lo; const int hi = (S.q0 + 256) / 64; S.hi = hi > 32 ? 32 : hi; } }
            S.qpitch = 256; S.k0pitch = 128; S.K1 = nullptr; S.vpitch = 128;
            attn_unit<64>(S, lds, tid, lane, wave);
        }
    }
}

__device__ __forceinline__ void load8(const bf16* p, float (&o)[8]) { const u32x4 u = *(const u32x4*)p; o[0] = bflo(u.x); o[1] = bfhi(u.x); o[2] = bflo(u.y); o[3] = bfhi(u.y); o[4] = bflo(u.z); o[5] = bfhi(u.z); o[6] = bflo(u.w); o[7] = bfhi(u.w); }
__device__ __forceinline__ void convgate_phase(const bf16* U, const float* cf, bf16* ACT, int gt, int NGT) {
    constexpr int NCH = DFF / 8, RG = 16;
    for (int it = gt; it < (NTOK / RG) * NCH; it += NGT) {
        const int rg = it / NCH, cc = it % NCH, r0 = rg * RG, col = cc * 8;
        const bool samp = r0 >= NPR; const int t0 = samp ? ((r0 - NPR) & 2047) : (r0 & 255), T = samp ? 2048 : 256;
        float wa[3][8], wb[3][8];
#pragma unroll
        for (int k = 0; k < 3; ++k)
#pragma unroll
            for (int e = 0; e < 8; ++e) { wa[k][e] = cf[k * DUP + col + e]; wb[k][e] = cf[k * DUP + DFF + col + e]; }
        float pa[8], pb[8], ca[8], cb[8], na[8], nb[8];
        const bf16* up = U + (size_t)r0 * DUP + col;
        if (t0 > 0) { load8(up - DUP, pa); load8(up - DUP + DFF, pb); } else {
#pragma unroll
            for (int e = 0; e < 8; ++e) { pa[e] = 0.f; pb[e] = 0.f; } }
        load8(up, ca); load8(up + DFF, cb);
        for (int i = 0; i < RG; ++i) {
            const bf16* un = up + (size_t)(i + 1) * DUP;
            if (t0 + i + 1 < T) { load8(un, na); load8(un + DFF, nb); } else {
#pragma unroll
                for (int e = 0; e < 8; ++e) { na[e] = 0.f; nb[e] = 0.f; } }
            float r[8];
#pragma unroll
            for (int e = 0; e < 8; ++e) { const float xa = wa[0][e] * pa[e] + wa[1][e] * ca[e] + wa[2][e] * na[e], xb = wb[0][e] * pb[e] + wb[1][e] * cb[e] + wb[2][e] * nb[e];
                r[e] = xa * __builtin_amdgcn_rcpf(1.f + __builtin_amdgcn_exp2f(-xa * LOG2E)) * xb; }
            u32x4 w; w.x = pk2(r[0], r[1]); w.y = pk2(r[2], r[3]); w.z = pk2(r[4], r[5]); w.w = pk2(r[6], r[7]);
            *(u32x4*)(ACT + (size_t)(r0 + i) * DFF + col) = w;
#pragma unroll
            for (int e = 0; e < 8; ++e) { pa[e] = ca[e]; pb[e] = cb[e]; ca[e] = na[e]; cb[e] = nb[e]; }
        }
    }
}

#define LAS __attribute__((address_space(3)))
#define XB_TMO      128
#define XB_XCNT(j)  (256  + 64 * (j))
#define XB_XSUB(j)  (1280 + 64 * (j))
#define XB_XGEN(j)  (2304 + 64 * (j))
#define XB_TOP      3328
#define XB_TOPGEN   3392
#define XCD_BAR_WORDS 3456
#define XB_SPIN_CAP (1u << 20)
__device__ __forceinline__ unsigned xb_ld(unsigned* p)              { return __hip_atomic_load(p, __ATOMIC_RELAXED, __HIP_MEMORY_SCOPE_AGENT); }
__device__ __forceinline__ unsigned xb_add(unsigned* p, unsigned v) { return __hip_atomic_fetch_add(p, v, __ATOMIC_RELAXED, __HIP_MEMORY_SCOPE_AGENT); }
__device__ __forceinline__ unsigned xb_xcc_id() { return (unsigned)__builtin_amdgcn_s_getreg((3 << 11) | 20) & 0xFu; }
#define XB_SPIN(cond, bar) do { unsigned _sp = 0; while (cond) { __builtin_amdgcn_s_sleep(1); \
    if ((++_sp & 255u) == 0u) { if (xb_ld(&(bar)[XB_TMO])) break; if (_sp > XB_SPIN_CAP) { atomicAdd(&(bar)[XB_TMO], 1u); break; } } } } while (0)
struct XcdBarrier { unsigned* bar; unsigned x; volatile LAS unsigned* st; };
__device__ __forceinline__ void xcd_barrier_complete(unsigned* bar, unsigned x, unsigned& nloc, unsigned& nx) {
    const unsigned G = gridDim.x * gridDim.y * gridDim.z;
    unsigned sum, cnt, mine, sp = 0u;
    for (;;) {
        sum = 0u; cnt = 0u; mine = 0u;
#pragma unroll
        for (unsigned j = 0; j < 16; ++j) { const unsigned c = xb_ld(&bar[XB_XCNT(j)]); sum += c; cnt += (c > 0u) ? 1u : 0u; mine = (j == x) ? c : mine; }
        if (sum == G) break;
        __builtin_amdgcn_s_sleep(1);
        if ((++sp & 255u) == 0u) { if (xb_ld(&bar[XB_TMO])) break; if (sp > XB_SPIN_CAP) { atomicAdd(&bar[XB_TMO], 1u); break; } }
    }
    nloc = mine > 0u ? mine : 1u; nx = cnt > 0u ? cnt : 1u;
}
__device__ __forceinline__ void xcd_barrier(const XcdBarrier& b, const int tid_) {
    asm volatile("s_waitcnt vmcnt(0)" ::: "memory");
    __syncthreads();
    if (tid_ == 0) {
        unsigned* bar = b.bar;
        __builtin_amdgcn_s_waitcnt(0);
        unsigned nloc = b.st[0], nx = b.st[1];
        if (nloc == 0u) { xcd_barrier_complete(bar, b.x, nloc, nx); b.st[0] = nloc; b.st[1] = nx; }
        const unsigned old = xb_add(&bar[XB_XSUB(b.x)], 1u);
        const unsigned gen = old / nloc;
        if (old + 1u == (gen + 1u) * nloc) {
            __builtin_amdgcn_fence(__ATOMIC_RELEASE, "agent");
            asm volatile("s_waitcnt vmcnt(0)" ::: "memory");
            const unsigned og = xb_add(&bar[XB_TOP], 1u);
            const unsigned tg = og / nx;
            if (og + 1u == (tg + 1u) * nx) xb_add(&bar[XB_TOPGEN], 1u);
            else XB_SPIN(xb_ld(&bar[XB_TOPGEN]) == tg, bar);
            __builtin_amdgcn_fence(__ATOMIC_ACQUIRE, "agent");
            xb_add(&bar[XB_XGEN(b.x)], 1u);
            asm volatile("s_waitcnt vmcnt(0)" ::: "memory");
        } else {
            XB_SPIN(xb_ld(&bar[XB_XGEN(b.x)]) == gen, bar);
            __builtin_amdgcn_fence(__ATOMIC_ACQUIRE, "agent");
            asm volatile("s_waitcnt vmcnt(0)" ::: "memory");
        }
    }
    __syncthreads();
}

__device__ __forceinline__ int lane_id_volatile() { int l; asm volatile("v_mbcnt_lo_u32_b32 %0, -1, 0\n\tv_mbcnt_hi_u32_b32 %0, -1, %0" : "=v"(l)); return l; }

#ifndef PH
#define PH 0xFFFF
#endif
#define ON(k) ((PH >> (k)) & 1)
#ifndef REP
#define REP 0
#endif
#define NREP(k) (1 + ((REP >> (k)) & 1))
__global__ void __launch_bounds__(NT, 2) mega_fwd(Args a_unused) {
    extern __shared__ __attribute__((aligned(16))) unsigned char lds[];
    cg::grid_group grid = cg::this_grid();
    const int G = gridDim.x, bid = blockIdx.x;
    const int wave_s = __builtin_amdgcn_readfirstlane(threadIdx.x >> 6);
    PG8_LAS unsigned char* ring = (PG8_LAS unsigned char*)lds;
#define PHASE_BEGIN int tid = wave_s * 64 + lane_id_volatile(); asm volatile("" : "+v"(tid)); const Args* ap_ = (const Args*)__builtin_amdgcn_kernarg_segment_ptr(); asm volatile("" : "+s"(ap_)); const Args& a = *ap_; unsigned char* ws = a.ws; float* out = a.out; \
    const int lane = tid & 63, wave = __builtin_amdgcn_readfirstlane(tid >> 6); const int gw = bid * NW + wave, NGW = G * NW, gt = bid * NT + tid, NGT = G * NT; \
    (void)lane; (void)wave; (void)gw; (void)NGW; (void)gt; (void)NGT; (void)out; \
    const float* mod = (const float*)(ws + WS_MOD); const float* rope = (const float*)(ws + WS_ROPE); (void)mod; (void)rope; \
    bf16* XN = (bf16*)(ws + WS_XN); bf16* PROJ = (bf16*)(ws + WS_PROJ); bf16* A2 = (bf16*)(ws + WS_A2); bf16* MQKV = (bf16*)(ws + WS_MQKV); \
    bf16* KPE = (bf16*)(ws + WS_KPE); bf16* YCAT = (bf16*)(ws + WS_YCAT); bf16* ACT = (bf16*)(ws + WS_ACT); bf16* U = (bf16*)(ws + WS_U); \
    bf16* Qc_rot = (bf16*)(ws + WS_QC); bf16* Qc_raw = (bf16*)(ws + WS_QC + QSZ); bf16* Kc = (bf16*)(ws + WS_QC + 2 * QSZ); bf16* Vc = (bf16*)(ws + WS_QC + 2 * QSZ + KSZ); \
    bf16* Qd_rot = (bf16*)(ws + WS_QC + 2 * QSZ + 2 * KSZ); bf16* Qd_raw = Qd_rot + (size_t)NKR * 256; bf16* Kd = Qd_raw + (size_t)NKR * 256; bf16* Vd = Kd + (size_t)NKR * 128; \
    (void)XN; (void)PROJ; (void)A2; (void)MQKV; (void)KPE; (void)YCAT; (void)ACT; (void)U; (void)Qc_rot; (void)Qc_raw; (void)Kc; (void)Vc; (void)Qd_rot; (void)Qd_raw; (void)Kd; (void)Vd;
#define GSYNC() do { const Args* bp_ = (const Args*)__builtin_amdgcn_kernarg_segment_ptr(); asm volatile("" : "+s"(bp_)); XcdBarrier xb_; xb_.bar = (unsigned*)(bp_->ws + WS_BAR); xb_.x = xb_xcc_id(); \
    xb_.st = (volatile LAS unsigned*)((LAS unsigned char*)lds + LDS_CTL + 32); xcd_barrier(xb_, wave_s * 64 + lane_id_volatile()); } while (0)
#define LAYER_VALS const float* modl = mod + (size_t)l * 3 * 6144; unsigned char* wl = ws + WS_W + l * W_LSTRIDE; (void)modl; (void)wl; \
    const float* x0 = l == 0 ? a.in[0] : out; const float* x1 = l == 0 ? a.in[1] : out + (size_t)NPR * DM; (void)x0; (void)x1;

    if (threadIdx.x < 16) ((volatile LAS unsigned*)((LAS unsigned char*)lds + LDS_CTL))[threadIdx.x] = 0u;
    __syncthreads();
    for (int rep = 0; rep < NREP(0); ++rep) {
    if (ON(0)) { PHASE_BEGIN phase0(a, lds, tid, lane, wave); }
    if (rep == 0) { grid.sync(); { PHASE_BEGIN if (tid == 0) (void)xb_add((unsigned*)(ws + WS_BAR) + XB_XCNT(xb_xcc_id()), 1u); } } else GSYNC(); }

    for (int l = 0; l < 2; ++l) {
        for (int rep = 0; rep < NREP(1); ++rep) {
        if (ON(1)) { PHASE_BEGIN LAYER_VALS norm_mod_phase(x0, x1, a.in[12] + l * DM, modl, 1024, 0, XN, lane, gw, NGW); }
        GSYNC(); }
        for (int rep = 0; rep < NREP(2); ++rep) {
        if (ON(2)) { PHASE_BEGIN LAYER_VALS pg8::Gemm g{XN, (const bf16*)(wl + W_IN), NTOK, INP, DM}; pg8::StaticOrder S; S.init(NTOK, INP, G, bid); pg8::EpiBf16 E{PROJ, INP};
          pg8::gemm_phase<pg8::EpiBf16, pg8::StaticOrder, true, true>(ring, g, S, E, tid); }
        GSYNC(); }
        for (int rep = 0; rep < NREP(3); ++rep) {
        if (ON(3)) { PHASE_BEGIN P3Ptrs P; P.PROJ = PROJ; P.A2 = A2; P.KPE = KPE; P.YCAT = YCAT; P.Qc_rot = Qc_rot; P.Qc_raw = Qc_raw; P.Kc = Kc; P.Vc = Vc; P.Qd_rot = Qd_rot; P.Qd_raw = Qd_raw; P.Kd = Kd; P.Vd = Vd;
          P.conv_a = a.in[14]; P.gq_mla = a.in[15]; P.gkv_mla = a.in[17]; P.gq = a.in[19]; P.gk = a.in[20]; P.rope = rope;
          P.c_ckv = a.in[2]; P.c_kpe = a.in[3]; P.c_gk = a.in[4]; P.c_gv = a.in[5]; P.c_sk = a.in[6]; P.c_sv = a.in[7];
          P.o_ckv = out + 12582912; P.o_kpe = out + 14680064; P.o_gk = out + 15204352; P.o_gv = out + 17301504; P.o_sk = out + 19398656; P.o_sv = out + 21495808; P.l = l;
          p3_phase(P, lane, gw, NGW); }
        GSYNC(); }
        for (int rep = 0; rep < NREP(4); ++rep) {
        if (ON(4)) { PHASE_BEGIN LAYER_VALS pg8::Gemm g{A2, (const bf16*)(wl + W_B2), NKR, 1024, 384}; pg8::StaticOrder S; S.init(NKR, 1024, G, bid); pg8::EpiBf16 E{MQKV, 1024};
          pg8::gemm_phase<pg8::EpiBf16, pg8::StaticOrder, true, true>(ring, g, S, E, tid); }
        GSYNC(); }
        for (int rep = 0; rep < NREP(5); ++rep) {
        if (ON(5)) { PHASE_BEGIN AttnBufs B; B.MQKV = MQKV; B.KPE = KPE; B.Qc_rot = Qc_rot; B.Qc_raw = Qc_raw; B.Kc = Kc; B.Vc = Vc; B.Qd_rot = Qd_rot; B.Qd_raw = Qd_raw; B.Kd = Kd; B.Vd = Vd; B.YCAT = YCAT;
          B.sink = a.in[21] + l * 4; B.rope = rope; B.ctr = (unsigned*)(ws + WS_CTL) + 64 * l + 128 * rep;
          attn_phase(B, lds, tid, lane, wave); }
        GSYNC(); }
        for (int rep = 0; rep < NREP(6); ++rep) {
        if (ON(6)) { PHASE_BEGIN LAYER_VALS pg8::Gemm g{YCAT, (const bf16*)(wl + W_OUT), NTOK, DM, DM}; pg8::StaticOrder S; S.init(NTOK, DM, G, bid); pg8::EpiResid E{x0, x1, out, modl + 2048};
          pg8::gemm_phase<pg8::EpiResid, pg8::StaticOrder, true, true>(ring, g, S, E, tid); }
        GSYNC(); }
        for (int rep = 0; rep < NREP(7); ++rep) {
        if (ON(7)) { PHASE_BEGIN LAYER_VALS norm_mod_phase(out, out + (size_t)NPR * DM, a.in[23] + l * DM, modl, 4096, 3072, XN, lane, gw, NGW); }
        GSYNC(); }
        for (int rep = 0; rep < NREP(8); ++rep) {
        if (ON(8)) { PHASE_BEGIN LAYER_VALS pg8::Gemm g{XN, (const bf16*)(wl + W_UP), NTOK, DUP, DM}; pg8::StaticOrder S; S.init(NTOK, DUP, G, bid); pg8::EpiBf16 E{U, DUP};
          pg8::gemm_phase<pg8::EpiBf16, pg8::StaticOrder, true, true>(ring, g, S, E, tid); }
        GSYNC(); }
        for (int rep = 0; rep < NREP(9); ++rep) {
        if (ON(9)) { PHASE_BEGIN convgate_phase(U, a.in[25] + (size_t)l * 3 * DUP, ACT, gt, NGT); }
        GSYNC(); }
        for (int rep = 0; rep < NREP(10); ++rep) {
        if (ON(10)) { PHASE_BEGIN LAYER_VALS pg8::Gemm g{ACT, (const bf16*)(wl + W_DOWN), NTOK, DM, DFF}; pg8::StaticOrder S; S.init(NTOK, DM, G, bid); pg8::EpiResid E{out, out + (size_t)NPR * DM, out, modl + 5120};
          pg8::gemm_phase<pg8::EpiResid, pg8::StaticOrder, true, true>(ring, g, S, E, tid); }
        GSYNC(); }
    }
#ifdef XSYNC
    for (int i = 0; i < XSYNC; ++i) GSYNC();
#endif
    { PHASE_BEGIN
    for (int row = gw; row < NTOK; row += NGW) {
        float* xr = out + (size_t)row * DM;
        f32x4 v[4]; float ss = 0.f;
#pragma unroll
        for (int j = 0; j < 4; ++j) { v[j] = *(const f32x4*)(xr + 4 * (lane + 64 * j)); ss += dot4(v[j]); }
        const float rs = rsqrtf(wave_sum(ss) * (1.f / DM) + EPS);
#pragma unroll
        for (int j = 0; j < 4; ++j) { const int col = 4 * (lane + 64 * j); *(f32x4*)(xr + col) = v[j] * rs * *(const f32x4*)(a.in[27] + col); }
    } }
}

extern "C" void kernel_launch(void* const* d_in, const int* in_sizes, int n_in, void* d_out, int out_size, void* d_ws, size_t ws_size, hipStream_t stream) {
    static int grid = 0;
    if (grid == 0) {
        if (n_in != 28 || ws_size < WS_END) { fprintf(stderr, "kernel_launch: unexpected n_in %d / ws %zu\n", n_in, ws_size); grid = -1; return; }
        int dev = 0, cus = 0, per_cu = 0;
        hipGetDevice(&dev); hipDeviceGetAttribute(&cus, hipDeviceAttributeMultiprocessorCount, dev);
        hipFuncSetAttribute((const void*)mega_fwd, hipFuncAttributeMaxDynamicSharedMemorySize, LDS_BYTES);
        hipOccupancyMaxActiveBlocksPerMultiprocessor(&per_cu, (const void*)mega_fwd, NT, LDS_BYTES);
        if (per_cu < 1) per_cu = 1;
        grid = cus * per_cu;
        (void)hipGetLastError();
    }
    if (grid < 0) return;
    Args a{};
    for (int i = 0; i < 28; ++i) a.in[i] = (const float*)d_in[i];
    a.out = (float*)d_out; a.ws = (unsigned char*)d_ws;
    void* args[] = {&a};
    hipError_t e = hipLaunchCooperativeKernel((const void*)mega_fwd, dim3(grid), dim3(NT), args, LDS_BYTES, stream);
    if (e != hipSuccess) fprintf(stderr, "cooperative launch failed: %s (grid %d)\n", hipGetErrorString(e), grid);
}
```

```cpp
#include <hip/hip_runtime.h>
#include <hip/hip_cooperative_groups.h>
#include <cstdio>
#include <cstdint>
namespace cg = cooperative_groups;

namespace pg8 {
#define PG8_LAS __attribute__((address_space(3)))
typedef unsigned short bf16_t;
typedef short bf16x8 __attribute__((ext_vector_type(8)));
typedef float f32x4 __attribute__((ext_vector_type(4)));
typedef unsigned u32x4 __attribute__((ext_vector_type(4)));
constexpr int BM = 256, BK = 64, HALF = 128, HTB = HALF * BK * 2, STAGE_BYTES = 8 * HTB, NXCD = 8, WGM = 8;

__host__ __device__ __forceinline__ int lds_byte(int r, int c) { const int st = (r >> 4) * 2 + (c >> 5), rr = r & 15, cc = c & 31, ob = rr * 64 + cc * 2; return st * 1024 + (ob ^ (((ob >> 9) & 1) << 5)); }
__host__ __device__ __forceinline__ void stage_rc(int b, int& R, int& C) { const int st = b / 1024, sb = b % 1024, swz = sb ^ (((sb >> 9) & 1) << 5); R = (st >> 1) * 16 + swz / 64; C = (st & 1) * 32 + (swz % 64) / 2; }
__host__ __device__ __forceinline__ int perm32(int rho) { const int n = rho >> 4, i = rho & 15; return 8 * (i >> 2) + 4 * n + (i & 3); }

struct Unit { int pm, pn; };
struct Gemm { const bf16_t* A; const bf16_t* Bt; int M, N, K; };

struct StaticOrder {
    int nM, nN, nwg, G, c;
    __host__ __device__ void init(int M, int N, int G_, int c_) { nM = M / BM; nN = N / BM; nwg = nM * nN; G = G_; c = c_; }
    __host__ __device__ bool next(int i, Unit& u) const {
        const long L = (long)i * G + c; if (L >= nwg) return false;
        int wgid = (int)L; { const int q = nwg / NXCD, r = nwg % NXCD, xcd = wgid % NXCD, off = wgid / NXCD; wgid = (xcd < r ? xcd * (q + 1) : r * (q + 1) + (xcd - r) * q) + off; }
        const int nig = WGM * nN, gid = wgid / nig, fm = gid * WGM, gsz = (nM - fm) < WGM ? (nM - fm) : WGM;
        u.pm = fm + ((wgid % nig) % gsz); u.pn = (wgid % nig) / gsz; return true;
    }
    __device__ __forceinline__ void a_ready(const Unit&) const {}
    __device__ __forceinline__ void done(const Unit&) const {}
};

__device__ __forceinline__ unsigned cvt_pk_bf16(float lo, float hi) { unsigned r; asm volatile("v_cvt_pk_bf16_f32 %0, %1, %2" : "=v"(r) : "v"(lo), "v"(hi)); return r; }

struct EpiBf16 {
    static constexpr bool PERM = true, AFTER_DRAIN = false;
    bf16_t* O; int ldc;
    __device__ __forceinline__ void operator()(const f32x4 (&acc)[2][2][4][2], const Unit& u, int wr, int wc, int fr, int fq) const {
        const int row0 = u.pm * BM + wr * 64 + fr; const int col0 = u.pn * BM + wc * 32 + 8 * fq;
#pragma unroll
        for (int ai = 0; ai < 2; ++ai)
#pragma unroll
            for (int m = 0; m < 4; ++m) { bf16_t* rowp = O + (size_t)(row0 + ai * HALF + m * 16) * ldc + col0;
#pragma unroll
                for (int bj = 0; bj < 2; ++bj) { const f32x4 v0 = acc[ai][bj][m][0], v1 = acc[ai][bj][m][1];
                    u32x4 w; w.x = cvt_pk_bf16(v0[0], v0[1]); w.y = cvt_pk_bf16(v0[2], v0[3]); w.z = cvt_pk_bf16(v1[0], v1[1]); w.w = cvt_pk_bf16(v1[2], v1[3]);
                    *(u32x4*)(rowp + bj * HALF) = w; } }
    }
};
struct EpiResid {
    static constexpr bool PERM = false, AFTER_DRAIN = false;
    const float* r0; const float* r1; float* out; const float* gate;
    __device__ __forceinline__ void operator()(const f32x4 (&acc)[2][2][4][2], const Unit& u, int wr, int wc, int fr, int fq) const {
        const int cnd = u.pm < 32 ? 0 : 1 + ((u.pm - 32) >> 3);
        const float* gp = gate + cnd * 6144;
        const int col0 = u.pn * BM + wc * 32 + 4 * fq;
        const int rowb = u.pm * BM + wr * 64 + fr;
        const float* rs = (u.pm < 32 ? r0 + (size_t)rowb * 1024 : r1 + (size_t)(rowb - 8192) * 1024) + col0;
        float* op = out + (size_t)rowb * 1024 + col0;
        f32x4 gv[2][2];
#pragma unroll
        for (int bj = 0; bj < 2; ++bj)
#pragma unroll
            for (int n = 0; n < 2; ++n) gv[bj][n] = *(const f32x4*)(gp + col0 + bj * HALF + n * 16);
        f32x4 xc[2][2], xn[2][2];
#pragma unroll
        for (int bj = 0; bj < 2; ++bj)
#pragma unroll
            for (int n = 0; n < 2; ++n) xc[bj][n] = *(const f32x4*)(rs + bj * HALF + n * 16);
#pragma unroll
        for (int it = 0; it < 8; ++it) { const int ai = it >> 2, m = it & 3; const size_t ro = (size_t)(ai * HALF + m * 16) * 1024;
            if (it < 7) { const int ai2 = (it + 1) >> 2, m2 = (it + 1) & 3; const size_t ro2 = (size_t)(ai2 * HALF + m2 * 16) * 1024;
#pragma unroll
                for (int bj = 0; bj < 2; ++bj)
#pragma unroll
                    for (int n = 0; n < 2; ++n) xn[bj][n] = *(const f32x4*)(rs + ro2 + bj * HALF + n * 16); }
#pragma unroll
            for (int bj = 0; bj < 2; ++bj)
#pragma unroll
                for (int n = 0; n < 2; ++n) *(f32x4*)(op + ro + bj * HALF + n * 16) = xc[bj][n] + gv[bj][n] * acc[ai][bj][m][n];
#pragma unroll
            for (int bj = 0; bj < 2; ++bj)
#pragma unroll
                for (int n = 0; n < 2; ++n) xc[bj][n] = xn[bj][n];
        }
    }
};

template <class Epi, class Sched, bool ALIGN_EPI = false, bool SP2 = false>
__device__ __forceinline__ void gemm_phase(PG8_LAS unsigned char* lds, const Gemm g, const Sched& S, const Epi& E, const int tid) {
    const int wid = __builtin_amdgcn_readfirstlane(tid >> 6), lane = tid & 63, wr = wid >> 2, wc = wid & 3, fr = lane & 15, fq = lane >> 4;
    const int K = g.K, nt = K / BK;
    unsigned voffA[2], voffB[2];
#pragma unroll
    for (int i = 0; i < 2; ++i) { int R, C; stage_rc(tid * 16 + i * 8192, R, C); const int Rb = Epi::PERM ? ((R & ~31) + perm32(R & 31)) : R;
        voffA[i] = (unsigned)(R * K + C) * 2u; voffB[i] = (unsigned)(Rb * K + C) * 2u; }
    const size_t kstep = (size_t)(BK * 2);
    const size_t hstep = (size_t)HALF * K * 2;
    const size_t tstep = 2 * hstep;
    const unsigned ldsw = (unsigned)wid * 1024u;
    const int aoff = lds_byte(wr * 64 + fr, fq * 8), boff = lds_byte(wc * 32 + fr, fq * 8);
#define PG8_SA(b, h) (((b) * 2 + (h)) * HTB)
#define PG8_SB(b, h) ((4 + (b) * 2 + (h)) * HTB)
#define PG8_STAGE(bufoff, gbase, voff) do { _Pragma("unroll") for (int _i = 0; _i < 2; ++_i) \
        __builtin_amdgcn_global_load_lds((const unsigned*)((const char*)(gbase) + (voff)[_i]), (PG8_LAS unsigned*)(lds + (bufoff) + ldsw + _i * 8192), 16, 0, 0); } while (0)
#define PG8_LDA(dst, b, h) do { _Pragma("unroll") for (int m = 0; m < 4; ++m) _Pragma("unroll") for (int k = 0; k < 2; ++k) dst[m][k] = *(const PG8_LAS bf16x8*)(lds + PG8_SA(b, h) + aoff + m * 2048 + k * 1024); } while (0)
#define PG8_LDB(dst, b, h) do { _Pragma("unroll") for (int n = 0; n < 2; ++n) _Pragma("unroll") for (int k = 0; k < 2; ++k) dst[n][k] = *(const PG8_LAS bf16x8*)(lds + PG8_SB(b, h) + boff + n * 2048 + k * 1024); } while (0)
#define PG8_MMA(ai, bj, At, Bt) do { __builtin_amdgcn_s_setprio(1); _Pragma("unroll") for (int m = 0; m < 4; ++m) _Pragma("unroll") for (int n = 0; n < 2; ++n) _Pragma("unroll") for (int k = 0; k < 2; ++k) \
        acc[ai][bj][m][n] = __builtin_amdgcn_mfma_f32_16x16x32_bf16(Bt[n][k], At[m][k], acc[ai][bj][m][n], 0, 0, 0); __builtin_amdgcn_s_setprio(0); } while (0)
#define PG8_WAIT_V(n) asm volatile("s_waitcnt vmcnt(" #n ")" ::: "memory")
#define PG8_WAIT_L(n) asm volatile("s_waitcnt lgkmcnt(" #n ")" ::: "memory")
#define PG8_BAR __builtin_amdgcn_s_barrier()
#define PG8_SCHED __builtin_amdgcn_sched_barrier(0)
    Unit cur, nxt; int ui = 0;
    if (!S.next(0, cur)) return;
    f32x4 acc[2][2][4][2];
#pragma unroll
    for (int a = 0; a < 2; ++a)
#pragma unroll
        for (int b = 0; b < 2; ++b)
#pragma unroll
            for (int m = 0; m < 4; ++m)
#pragma unroll
                for (int n = 0; n < 2; ++n) acc[a][b][m][n] = (f32x4){0.f, 0.f, 0.f, 0.f};
    bf16x8 At[4][2], B0[2][2], B1[2][2];
    const char* cA = (const char*)g.A + (size_t)cur.pm * tstep; const char* cB = (const char*)g.Bt + (size_t)cur.pn * tstep;
    S.a_ready(cur);
    if constexpr (SP2) {
        PG8_STAGE(PG8_SB(0, 0), cB, voffB); PG8_STAGE(PG8_SB(0, 1), cB + hstep, voffB); PG8_STAGE(PG8_SA(0, 0), cA, voffA); PG8_STAGE(PG8_SA(0, 1), cA + hstep, voffA);
        if (wr == 1) PG8_BAR;
        PG8_WAIT_V(2); PG8_BAR;
        PG8_STAGE(PG8_SB(1, 0), cB + kstep, voffB); PG8_STAGE(PG8_SA(1, 0), cA + kstep, voffA); PG8_STAGE(PG8_SB(1, 1), cB + hstep + kstep, voffB);
        PG8_WAIT_V(6); PG8_BAR;
    } else {
        PG8_STAGE(PG8_SB(0, 0), cB, voffB); PG8_STAGE(PG8_SA(0, 0), cA, voffA); PG8_STAGE(PG8_SB(0, 1), cB + hstep, voffB); PG8_STAGE(PG8_SA(0, 1), cA + hstep, voffA);
        if (wr == 1) PG8_BAR;
        PG8_WAIT_V(4); PG8_BAR;
        PG8_STAGE(PG8_SB(1, 0), cB + kstep, voffB); PG8_STAGE(PG8_SA(1, 0), cA + kstep, voffA); PG8_STAGE(PG8_SB(1, 1), cB + hstep + kstep, voffB);
        PG8_WAIT_V(6); PG8_BAR;
    }
    for (;;) {
        const bool has_next = S.next(ui + 1, nxt);
        const char* nA = has_next ? (const char*)g.A + (size_t)nxt.pm * tstep : cA; const char* nB = has_next ? (const char*)g.Bt + (size_t)nxt.pn * tstep : cB;
        for (int t = 0; t < nt; t += 2) {
            const bool last = (t == nt - 2);
            const char* a1 = cA + (size_t)(t + 1) * kstep;
            const char* a2 = last ? nA : cA + (size_t)(t + 2) * kstep; const char* b2 = last ? nB : cB + (size_t)(t + 2) * kstep;
            const char* a3 = a2 + kstep; const char* b3 = b2 + kstep;
            if (last && has_next) S.a_ready(nxt);
            if constexpr (SP2) {
            PG8_LDB(B0, 0, 0); PG8_LDB(B1, 0, 1); PG8_SCHED; PG8_LDA(At, 0, 0); PG8_STAGE(PG8_SA(1, 1), a1 + hstep, voffA);
            PG8_WAIT_V(8); PG8_WAIT_L(0); PG8_BAR; PG8_MMA(0, 0, At, B0); PG8_MMA(0, 1, At, B1); PG8_BAR; PG8_SCHED;
            PG8_LDA(At, 0, 1); PG8_STAGE(PG8_SB(0, 0), b2, voffB); PG8_STAGE(PG8_SB(0, 1), b2 + hstep, voffB); PG8_STAGE(PG8_SA(0, 0), a2, voffA);
            PG8_WAIT_V(8); PG8_WAIT_L(0); PG8_BAR; PG8_MMA(1, 0, At, B0); PG8_MMA(1, 1, At, B1); PG8_BAR; PG8_SCHED;
            PG8_LDB(B0, 1, 0); PG8_LDB(B1, 1, 1); PG8_SCHED; PG8_LDA(At, 1, 0); PG8_STAGE(PG8_SA(0, 1), a2 + hstep, voffA);
            PG8_WAIT_V(8); PG8_WAIT_L(0); PG8_BAR; PG8_MMA(0, 0, At, B0); PG8_MMA(0, 1, At, B1); PG8_BAR; PG8_SCHED;
            PG8_LDA(At, 1, 1); PG8_STAGE(PG8_SB(1, 0), b3, voffB); PG8_STAGE(PG8_SB(1, 1), b3 + hstep, voffB); PG8_STAGE(PG8_SA(1, 0), a3, voffA);
            PG8_WAIT_V(8); PG8_WAIT_L(0); PG8_BAR; PG8_MMA(1, 0, At, B0); PG8_MMA(1, 1, At, B1); PG8_BAR; PG8_SCHED;
            } else {
            PG8_LDB(B0, 0, 0); PG8_SCHED; PG8_LDA(At, 0, 0); PG8_STAGE(PG8_SA(1, 1), a1 + hstep, voffA);
            PG8_WAIT_L(8); PG8_BAR; PG8_WAIT_L(0); PG8_MMA(0, 0, At, B0); PG8_BAR; PG8_SCHED;
            PG8_LDB(B1, 0, 1); PG8_STAGE(PG8_SB(0, 0), b2, voffB);
            PG8_BAR; PG8_WAIT_L(0); PG8_MMA(0, 1, At, B1); PG8_BAR;
            PG8_LDA(At, 0, 1); PG8_STAGE(PG8_SA(0, 0), a2, voffA);
            PG8_BAR; PG8_WAIT_L(0); PG8_MMA(1, 0, At, B0); PG8_BAR; PG8_SCHED;
            PG8_STAGE(PG8_SB(0, 1), b2 + hstep, voffB);
            PG8_WAIT_V(6); PG8_BAR; PG8_MMA(1, 1, At, B1); PG8_BAR;
            PG8_LDB(B0, 1, 0); PG8_SCHED; PG8_LDA(At, 1, 0); PG8_STAGE(PG8_SA(0, 1), a2 + hstep, voffA);
            PG8_WAIT_L(8); PG8_BAR; PG8_WAIT_L(0); PG8_MMA(0, 0, At, B0); PG8_BAR; PG8_SCHED;
            PG8_LDB(B1, 1, 1); PG8_STAGE(PG8_SB(1, 0), b3, voffB);
            PG8_BAR; PG8_WAIT_L(0); PG8_MMA(0, 1, At, B1); PG8_BAR;
            PG8_LDA(At, 1, 1); PG8_STAGE(PG8_SA(1, 0), a3, voffA);
            PG8_BAR; PG8_WAIT_L(0); PG8_MMA(1, 0, At, B0); PG8_BAR; PG8_SCHED;
            PG8_STAGE(PG8_SB(1, 1), b3 + hstep, voffB);
            PG8_WAIT_V(6); PG8_BAR; PG8_MMA(1, 1, At, B1); PG8_BAR;
            }
        }
        if constexpr (ALIGN_EPI) { if (wr == 0) PG8_BAR; }
        if constexpr (!Epi::AFTER_DRAIN) { E(acc, cur, wr, wc, fr, fq); S.done(cur); }
        if (!has_next) break;
#pragma unroll
        for (int a = 0; a < 2; ++a)
#pragma unroll
            for (int b = 0; b < 2; ++b)
#pragma unroll
                for (int m = 0; m < 4; ++m)
#pragma unroll
                    for (int n = 0; n < 2; ++n) acc[a][b][m][n] = (f32x4){0.f, 0.f, 0.f, 0.f};
        cur = nxt; cA = nA; cB = nB; ++ui;
        if constexpr (ALIGN_EPI) { if (wr == 1) PG8_BAR; }
    }
    PG8_WAIT_V(0);
    if constexpr (!ALIGN_EPI) { if (wr == 0) PG8_BAR; }
    PG8_BAR;
#undef PG8_SA
#undef PG8_SB
#undef PG8_STAGE
#undef PG8_LDA
#undef PG8_LDB
#undef PG8_MMA
#undef PG8_WAIT_V
#undef PG8_WAIT_L
#undef PG8_BAR
#undef PG8_SCHED
}
}

#define LAS __attribute__((address_space(3)))
typedef unsigned short bf16;
typedef float f32x4 __attribute__((ext_vector_type(4)));
typedef short bf16x8 __attribute__((ext_vector_type(8)));
typedef unsigned u32x4 __attribute__((ext_vector_type(4)));
typedef unsigned u32x2 __attribute__((ext_vector_type(2)));

constexpr int NW = 8, NT = 512;
constexpr int DM = 1024, NTOK = 12288, NPR = 8192, NKR = 13312, INC = 2144, INP = 2304, DFF = 2816, DUP = 5632;
constexpr float EPS = 1e-6f, LOG2E = 1.4426950408889634f;
constexpr float QS = 0.125f * LOG2E;
constexpr float MLAQS = 0.10206207261596575f * LOG2E;

constexpr size_t MiB = 1u << 20;
constexpr size_t WS_CTL = 0, WS_MOD = 1 * MiB, WS_ROPE = 1 * MiB + 256 * 1024, WS_W = 2 * MiB, W_LSTRIDE = 24 * MiB;
constexpr size_t W_IN = 0, W_OUT = 4718592, W_UP = W_OUT + 2097152, W_DOWN = W_UP + 11534336, W_B2 = W_DOWN + 5767168;
static_assert(W_B2 + 786432 <= W_LSTRIDE, "weights");
constexpr size_t WS_XN = 50 * MiB, WS_PROJ = 74 * MiB, WS_A2 = 128 * MiB, WS_MQKV = 138 * MiB, WS_QC = 164 * MiB, WS_KPE = 203 * MiB, WS_YCAT = 204 * MiB;
constexpr size_t WS_ACT = 50 * MiB, WS_U = 116 * MiB, WS_END = 248 * MiB;
constexpr size_t QSZ = (size_t)NKR * 256 * 2, KSZ = (size_t)NKR * 128 * 2;
constexpr int LDS_BYTES = 131072 + 4096, LDS_CTL = 131072;
constexpr size_t WS_BAR = 16384;

struct Args { const float* in[28]; float* out; unsigned char* ws; };

__device__ __forceinline__ unsigned f2bf(float f) { unsigned u = __builtin_bit_cast(unsigned, f); return (u + 0x7fffu + ((u >> 16) & 1u)) >> 16; }
__device__ __forceinline__ unsigned pk2(float lo, float hi) { unsigned r; asm("v_cvt_pk_bf16_f32 %0, %1, %2" : "=v"(r) : "v"(lo), "v"(hi)); return r; }
__device__ __forceinline__ float bflo(unsigned u) { return __builtin_bit_cast(float, u << 16); }
__device__ __forceinline__ float bfhi(unsigned u) { return __builtin_bit_cast(float, u & 0xffff0000u); }
__device__ __forceinline__ f32x4 ld4bf(const bf16* p) { const u32x2 u = *(const u32x2*)p; return (f32x4){bflo(u.x), bfhi(u.x), bflo(u.y), bfhi(u.y)}; }
__device__ __forceinline__ void st4bf(bf16* p, f32x4 v) { u32x2 u; u.x = pk2(v[0], v[1]); u.y = pk2(v[2], v[3]); *(u32x2*)p = u; }
__device__ __forceinline__ float shx(float v, int m, int lane) { return __builtin_bit_cast(float, __builtin_amdgcn_ds_bpermute((lane ^ m) << 2, __builtin_bit_cast(int, v))); }
__device__ __forceinline__ float wave_sum(float v, int lane) {
#pragma unroll
    for (int o = 1; o < 64; o <<= 1) v += shx(v, o, lane);
    return v;
}
__device__ __forceinline__ float sum16(float v, int lane) {
#pragma unroll
    for (int o = 1; o < 16; o <<= 1) v += shx(v, o, lane);
    return v;
}
__device__ __forceinline__ float dot4(f32x4 a) { return (a[0] * a[0] + a[1] * a[1]) + (a[2] * a[2] + a[3] * a[3]); }
__device__ __forceinline__ f32x4 shfl4(f32x4 v, int m, int lane) { return (f32x4){shx(v[0], m, lane), shx(v[1], m, lane), shx(v[2], m, lane), shx(v[3], m, lane)}; }

__device__ __forceinline__ void transpose_item(const float* W, int N, bf16* WT, int ldk, int row_off, int k_off, float scale, LAS float* scr, int item, int lane) {
    const int nblk = N / 32, kb = item / nblk, nb = item % nblk, k0 = 64 * kb, n0 = 32 * nb;
#pragma unroll 8
    for (int i = 0; i < 32; ++i) { const int kk = 2 * i + (lane >> 5); scr[kk * 33 + (lane & 31)] = W[(size_t)(k0 + kk) * N + n0 + (lane & 31)] * scale; }
    asm volatile("s_waitcnt lgkmcnt(0)" ::: "memory");
    const int c = lane & 7;
#pragma unroll
    for (int j = 0; j < 4; ++j) { const int n = (lane >> 3) + 8 * j; const LAS float* s = scr + (8 * c) * 33 + n;
        u32x4 o; o.x = pk2(s[0 * 33], s[1 * 33]); o.y = pk2(s[2 * 33], s[3 * 33]); o.z = pk2(s[4 * 33], s[5 * 33]); o.w = pk2(s[6 * 33], s[7 * 33]);
        *(u32x4*)(WT + (size_t)(row_off + n0 + n) * ldk + k_off + k0 + 8 * c) = o; }
    asm volatile("s_waitcnt lgkmcnt(0)" ::: "memory");
}

__device__ __forceinline__ void phase0(const Args& a, LAS unsigned char* lds, int tid, int lane, int wave) {
    unsigned char* ws = a.ws;
    const int G = gridDim.x, bid = blockIdx.x;
    if (bid < 96) {
        LAS float* sl = (LAS float*)(lds + 16384);
        for (int e = tid; e < 3072; e += NT) { const int c = e >> 10, k = e & 1023; const float v = c == 0 ? a.in[9][k] : a.in[8][(c - 1) * 1024 + k]; sl[e] = v / (1.f + __expf(-v)); }
        __syncthreads();
    }
    for (int it = bid; it < 96; it += G) {
        const int l = it / 48, n0 = (it % 48) * 128;
        const float* wa = a.in[10] + (size_t)l * 1024 * 6144;
        const LAS float* sl = (const LAS float*)(lds + 16384);
        float acc[3][2] = {{0.f, 0.f}, {0.f, 0.f}, {0.f, 0.f}};
        const int kb = wave * 128;
#pragma unroll 16
        for (int k = 0; k < 128; ++k) {
            const int kk = kb + k;
            const float2 w = *(const float2*)(wa + (size_t)kk * 6144 + n0 + 2 * lane);
            const float s0 = sl[kk], s1 = sl[1024 + kk], s2 = sl[2048 + kk];
            acc[0][0] += s0 * w.x; acc[0][1] += s0 * w.y; acc[1][0] += s1 * w.x; acc[1][1] += s1 * w.y; acc[2][0] += s2 * w.x; acc[2][1] += s2 * w.y;
        }
        LAS float* red = (LAS float*)lds;
#pragma unroll
        for (int c = 0; c < 3; ++c) { red[(wave * 3 + c) * 128 + 2 * lane] = acc[c][0]; red[(wave * 3 + c) * 128 + 2 * lane + 1] = acc[c][1]; }
        __syncthreads();
        if (tid < 384) { const int c = tid / 128, n = tid % 128; float s = 0.f;
#pragma unroll
            for (int w = 0; w < 8; ++w) s += red[(w * 3 + c) * 128 + n];
            ((float*)(ws + WS_MOD))[(size_t)(l * 3 + c) * 6144 + n0 + n] = s + a.in[11][(size_t)l * 6144 + n0 + n]; }
        __syncthreads();
    }
    if (bid == G - 1) {
        float* rt = (float*)(ws + WS_ROPE);
        for (int e = tid; e < 1024; e += NT) { const int pos = e >> 4, i = e & 15; const float inv = exp2f(-(float)(2 * i) / 32.f * 13.287712379549449f); const float ang = (float)pos * inv;
            rt[e] = __cosf(ang); rt[1024 + e] = __sinf(ang); }
        for (int e = tid; e < 512; e += NT) { const int pos = e >> 3, i = e & 7; const float inv = exp2f(-(float)(2 * i) / 16.f * 13.287712379549449f); const float ang = (float)pos * inv;
            rt[2048 + e] = __cosf(ang); rt[2560 + e] = __sinf(ang); }
    }
    const int gt = bid * NT + tid, NGT = G * NT;
    if (gt < 256) ((unsigned*)(ws + WS_CTL))[gt] = 0u;
    if (gt < 3456) ((unsigned*)(ws + WS_BAR))[gt] = 0u;
    for (int l = 0; l < 2; ++l) {
        bf16* b2 = (bf16*)(ws + WS_W + l * W_LSTRIDE + W_B2);
        for (int ch = gt; ch < 1024 * 48; ch += NGT) { const int n = ch / 48, k = (ch % 48) * 8;
            const bool data = (n < 384 && k < 192) || (n >= 384 && n < 896 && k >= 192 && k < 320);
            if (!data) *(u32x4*)(b2 + (size_t)n * 384 + k) = (u32x4){0u, 0u, 0u, 0u}; }
        bf16* wi = (bf16*)(ws + WS_W + l * W_LSTRIDE + W_IN) + (size_t)INC * 1024;
        for (int ch = gt; ch < 160 * 128; ch += NGT) *(u32x4*)(wi + (size_t)ch * 8) = (u32x4){0u, 0u, 0u, 0u};
    }
    LAS float* scr = (LAS float*)(lds + 32768 + wave * 12288);
    const int gw = bid * NW + wave, NGW = G * NW;
    constexpr int I_IN = 16 * 67, I_OUT = 16 * 32, I_UP = 16 * 176, I_DN = 44 * 32, I_Q = 3 * 12, I_KV = 2 * 16, I_L = I_IN + I_OUT + I_UP + I_DN + I_Q + I_KV;
    for (int it = gw; it < 2 * I_L; it += NGW) {
        const int l = it / I_L; int r = it % I_L;
        unsigned char* wl = ws + WS_W + l * W_LSTRIDE;
        if (r < I_IN) { transpose_item(a.in[13] + (size_t)l * 1024 * INC, INC, (bf16*)(wl + W_IN), 1024, 0, 0, 1.f, scr, r, lane); continue; } r -= I_IN;
        if (r < I_OUT) { transpose_item(a.in[22] + (size_t)l * 1024 * 1024, 1024, (bf16*)(wl + W_OUT), 1024, 0, 0, 1.f, scr, r, lane); continue; } r -= I_OUT;
        if (r < I_UP) { transpose_item(a.in[24] + (size_t)l * 1024 * DUP, DUP, (bf16*)(wl + W_UP), 1024, 0, 0, 1.f, scr, r, lane); continue; } r -= I_UP;
        if (r < I_DN) { transpose_item(a.in[26] + (size_t)l * DFF * 1024, 1024, (bf16*)(wl + W_DOWN), DFF, 0, 0, 1.f, scr, r, lane); continue; } r -= I_DN;
        if (r < I_Q) { transpose_item(a.in[16] + (size_t)l * 192 * 384, 384, (bf16*)(wl + W_B2), 384, 0, 0, MLAQS, scr, r, lane); continue; } r -= I_Q;
        transpose_item(a.in[18] + (size_t)l * 128 * 512, 512, (bf16*)(wl + W_B2), 384, 384, 192, 1.f, scr, r, lane);
    }
}

__device__ __forceinline__ void norm_mod_phase(const float* x0, const float* x1, const float* nw, const float* mod, int sc_off, int sh_off, bf16* XN, int lane, int gw, int NGW) {
    for (int row = gw; row < NTOK; row += NGW) {
        const float* xr = row < NPR ? x0 + (size_t)row * DM : x1 + (size_t)(row - NPR) * DM;
        const int c = row < NPR ? 0 : 1 + ((row - NPR) >> 11);
        const float* mp = mod + c * 6144;
        f32x4 v[4]; float ss = 0.f;
#pragma unroll
        for (int j = 0; j < 4; ++j) { v[j] = *(const f32x4*)(xr + 4 * (lane + 64 * j)); ss += dot4(v[j]); }
        const float rs = rsqrtf(wave_sum(ss, lane) * (1.f / DM) + EPS);
#pragma unroll
        for (int j = 0; j < 4; ++j) { const int col = 4 * (lane + 64 * j);
            const f32x4 g = *(const f32x4*)(nw + col), sc = *(const f32x4*)(mp + sc_off + col), sh = *(const f32x4*)(mp + sh_off + col);
            const f32x4 h = v[j] * rs * g * (1.f + sc) + sh;
            st4bf(XN + (size_t)row * DM + col, h); }
    }
}

struct P3Ptrs {
    const bf16* PROJ; bf16 *A2, *KPE, *YCAT, *Qc_rot, *Qc_raw, *Kc, *Vc, *Qd_rot, *Qd_raw, *Kd, *Vd;
    const float *conv_a, *gq_mla, *gkv_mla, *gq, *gk, *rope;
    const float *c_ckv, *c_kpe, *c_gk, *c_gv, *c_sk, *c_sv;
    float *o_ckv, *o_kpe, *o_gk, *o_gv, *o_sk, *o_sv;
    int l;
};
__device__ __forceinline__ f32x4 rope64(f32x4 v, int jl, int prow, int pcol, const float* rt, int lane) {
    const f32x4 pr = shfl4(v, 4, lane);
    const int pos = jl < 8 ? prow : pcol, fi = 4 * (jl & 3);
    const f32x4 c = *(const f32x4*)(rt + pos * 16 + fi), s = *(const f32x4*)(rt + 1024 + pos * 16 + fi);
    const float sg = (jl & 4) ? 1.f : -1.f;
    return v * c + pr * s * sg;
}
__device__ __forceinline__ void p3_phase(const P3Ptrs& P, int lane, int gw, int NGW) {
    const int l = P.l;
    for (int row = gw; row < NKR; row += NGW) {
        if (row < NTOK) {
            const bool samp = row >= NPR;
            int b, t, kr, T;
            if (!samp) { b = row >> 8; t = row & 255; kr = row; T = 256; } else { b = (row - NPR) >> 11; t = (row - NPR) & 2047; kr = NPR + b * 2560 + t; T = 2048; }
            const int prow = t >> 6, pcol = t & 63;
            const bf16* pr = P.PROJ + (size_t)row * INP;
            const size_t ob = (size_t)((b * 2 + l) * 256 + t);
            const int ci = 4 * lane, jl = lane & 15;
            const u32x2 z2 = (u32x2){0u, 0u};
            const bool hp = t > 0, hn = t < T - 1;
            const u32x2 r_xa = *(const u32x2*)(pr + ci), r_gb = *(const u32x2*)(pr + 256 + ci), r_gc = *(const u32x2*)(pr + 512 + ci);
            const u32x2 r_pxa = hp ? *(const u32x2*)(pr - INP + ci) : z2, r_pgc = hp ? *(const u32x2*)(pr - INP + 512 + ci) : z2;
            const u32x2 r_nxa = hn ? *(const u32x2*)(pr + INP + ci) : z2, r_ngc = hn ? *(const u32x2*)(pr + INP + 512 + ci) : z2;
            const u32x2 r_cq = lane < 48 ? *(const u32x2*)(pr + 768 + ci) : z2, r_ckv = lane < 32 ? *(const u32x2*)(pr + 960 + ci) : z2, r_kpe = lane < 8 ? *(const u32x2*)(pr + 1088 + ci) : z2;
            const u32x2 r_qc = *(const u32x2*)(pr + 1120 + ci), r_kvc = *(const u32x2*)(pr + 1376 + ci), r_qd = *(const u32x2*)(pr + 1632 + ci), r_kvd = *(const u32x2*)(pr + 1888 + ci);
            const float* cw = P.conv_a + (size_t)l * 768;
            const f32x4 w0 = *(const f32x4*)(cw + ci), w1 = *(const f32x4*)(cw + 256 + ci), w2 = *(const f32x4*)(cw + 512 + ci);
            const f32x4 g_qm = lane < 48 ? *(const f32x4*)(P.gq_mla + l * 192 + ci) : (f32x4){0.f, 0.f, 0.f, 0.f}, g_kvm = lane < 32 ? *(const f32x4*)(P.gkv_mla + l * 128 + ci) : (f32x4){0.f, 0.f, 0.f, 0.f};
            const f32x4 g_q = *(const f32x4*)(P.gq + l * 64 + 4 * jl), g_k = *(const f32x4*)(P.gk + l * 64 + 4 * jl);
            const int pos64 = jl < 8 ? prow : pcol, fi64 = 4 * (jl & 3);
            const f32x4 c64 = *(const f32x4*)(P.rope + pos64 * 16 + fi64), s64 = *(const f32x4*)(P.rope + 1024 + pos64 * 16 + fi64);
            const int pos32 = (lane & 7) < 4 ? prow : pcol, fi32 = 4 * (lane & 1);
            const f32x4 c32 = *(const f32x4*)(P.rope + 2048 + pos32 * 8 + fi32), s32 = *(const f32x4*)(P.rope + 2560 + pos32 * 8 + fi32);
#define CV4(u) ((f32x4){bflo((u).x), bfhi((u).x), bflo((u).y), bfhi((u).y)})
#define ROPE64(v) ((v) * c64 + shfl4((v), 4, lane) * s64 * ((jl & 4) ? 1.f : -1.f))
            { const f32x4 ya = CV4(r_gb) * (w0 * (CV4(r_pxa) * CV4(r_pgc)) + w1 * (CV4(r_xa) * CV4(r_gc)) + w2 * (CV4(r_nxa) * CV4(r_ngc)));
              st4bf(P.YCAT + (size_t)row * DM + ci, ya); }
            { const f32x4 v = CV4(r_cq);
              const float rs = rsqrtf(wave_sum(dot4(v), lane) * (1.f / 192.f) + EPS);
              if (lane < 48) st4bf(P.A2 + (size_t)kr * 384 + ci, v * rs * g_qm); }
            { const f32x4 v = CV4(r_ckv);
              const float rs = rsqrtf(wave_sum(dot4(v), lane) * (1.f / 128.f) + EPS);
              if (lane < 32) { const f32x4 o = v * rs * g_kvm;
                  st4bf(P.A2 + (size_t)kr * 384 + 192 + ci, o);
                  if (!samp) *(f32x4*)(P.o_ckv + ob * 128 + ci) = o; }
              else if (lane < 48) { unsigned zz = 0u; asm volatile("" : "+v"(zz)); *(u32x2*)(P.A2 + (size_t)kr * 384 + 320 + 4 * (lane - 32)) = (u32x2){zz, zz}; } }
            { const f32x4 v = CV4(r_kpe);
              const f32x4 r = v * c32 + shfl4(v, 2, lane) * s32 * ((lane & 2) ? 1.f : -1.f);
              if (lane < 8) { if (!samp) *(f32x4*)(P.o_kpe + ob * 32 + ci) = v; st4bf(P.KPE + (size_t)kr * 32 + ci, samp ? r : v); } }
            { f32x4 v = CV4(r_qc);
              const float rs = rsqrtf(sum16(dot4(v), lane) * (1.f / 64.f) + EPS);
              v = v * rs * g_q;
              st4bf(P.Qc_raw + (size_t)kr * 256 + ci, v * QS);
              const f32x4 r = ROPE64(v);
              if (samp) st4bf(P.Qc_rot + (size_t)kr * 256 + ci, r * QS); }
            { const f32x4 v = CV4(r_kvc);
              const float rs = rsqrtf(sum16(dot4(v), lane) * (1.f / 64.f) + EPS);
              const f32x4 kn = v * rs * g_k;
              const f32x4 r = ROPE64(kn);
              if (lane < 32) { if (!samp) *(f32x4*)(P.o_gk + ob * 128 + ci) = kn; st4bf(P.Kc + (size_t)kr * 128 + ci, samp ? r : kn); }
              else { if (!samp) *(f32x4*)(P.o_gv + ob * 128 + 4 * (lane - 32)) = v; st4bf(P.Vc + (size_t)kr * 128 + 4 * (lane - 32), v); } }
            { const f32x4 v = CV4(r_qd);
              st4bf(P.Qd_raw + (size_t)kr * 256 + ci, v * QS);
              const f32x4 r = ROPE64(v);
              if (samp) st4bf(P.Qd_rot + (size_t)kr * 256 + ci, r * QS); }
            { const f32x4 v = CV4(r_kvd);
              const f32x4 r = ROPE64(v);
              if (lane < 32) { if (!samp) *(f32x4*)(P.o_sk + ob * 128 + ci) = v; st4bf(P.Kd + (size_t)kr * 128 + ci, samp ? r : v); }
              else { if (!samp) *(f32x4*)(P.o_sv + ob * 128 + 4 * (lane - 32)) = v; st4bf(P.Vd + (size_t)kr * 128 + 4 * (lane - 32), v); } }
#undef CV4
#undef ROPE64
        } else {
            const int ci = row - NTOK, b = ci >> 9, j = ci & 511, kr = NPR + b * 2560 + 2048 + j;
            const size_t cb = (size_t)((b * 2 + l) * 512 + j);
            f32x4 z = (f32x4){0.f, 0.f, 0.f, 0.f}; asm volatile("" : "+v"(z));
            if (lane < 48) st4bf(P.A2 + (size_t)kr * 384 + 4 * lane, z);
            if (lane < 32) st4bf(P.A2 + (size_t)kr * 384 + 192 + 4 * lane, *(const f32x4*)(P.c_ckv + cb * 128 + 4 * lane));
            else if (lane < 48) st4bf(P.A2 + (size_t)kr * 384 + 320 + 4 * (lane - 32), z);
            if (lane < 8) st4bf(P.KPE + (size_t)kr * 32 + 4 * lane, *(const f32x4*)(P.c_kpe + cb * 32 + 4 * lane));
            if (lane < 32) { st4bf(P.Kc + (size_t)kr * 128 + 4 * lane, *(const f32x4*)(P.c_gk + cb * 128 + 4 * lane));
                             st4bf(P.Kd + (size_t)kr * 128 + 4 * lane, *(const f32x4*)(P.c_sk + cb * 128 + 4 * lane)); }
            else { st4bf(P.Vc + (size_t)kr * 128 + 4 * (lane - 32), *(const f32x4*)(P.c_gv + cb * 128 + 4 * (lane - 32)));
                   st4bf(P.Vd + (size_t)kr * 128 + 4 * (lane - 32), *(const f32x4*)(P.c_sv + cb * 128 + 4 * (lane - 32))); }
        }
    }
}

struct AttnSrc {
    const bf16* Qraw; const bf16* Qrot; int qpitch;
    const bf16* K0; int k0pitch; const bf16* K1;
    const bf16* V; int vpitch;
    bf16* Y; int outcol;
    int krbase, rowbase, q0, lo, hi, nctx;
    bool samp, window; float m0; bool sink;
    const float* rope;
};
template <int DK>
__device__ __forceinline__ void attn_unit(const AttnSrc& S, LAS unsigned char* lds, int tid, int lane, int wave) {
    constexpr int KP = DK + 8, VP = 68, KS = DK / 32, CPK = DK / 8;
    LAS bf16* Ks = (LAS bf16*)lds;
    LAS bf16* Vt = (LAS bf16*)(lds + 2 * 64 * KP * 2);
    const int g = lane >> 4, fr = lane & 15;
    const int qpos = S.q0 + wave * 16 + fr;
    const size_t qkr = (size_t)(S.krbase + qpos);
    bf16x8 qraw[KS], qrot[KS];
#pragma unroll
    for (int ks = 0; ks < KS; ++ks) { qraw[ks] = *(const bf16x8*)(S.Qraw + qkr * S.qpitch + ks * 32 + g * 8); qrot[ks] = qraw[ks]; }
    if (S.samp) {
        if (DK == 96) {
            const bf16x8 own = qraw[KS - 1], par = *(const bf16x8*)(S.Qraw + qkr * S.qpitch + 64 + (g ^ 1) * 8);
            const int pos = g < 2 ? (qpos >> 6) : (qpos & 63);
            const float sg = (g & 1) ? 1.f : -1.f;
            const float* ct = S.rope + 2048 + pos * 8; const float* st = S.rope + 2560 + pos * 8;
            bf16x8 r;
#pragma unroll
            for (int e = 0; e < 8; ++e) { const float o = bflo((unsigned)(unsigned short)own[e]), p = bflo((unsigned)(unsigned short)par[e]);
                r[e] = (short)f2bf(o * ct[e] + p * st[e] * sg); }
            qrot[KS - 1] = r;
        } else {
#pragma unroll
            for (int ks = 0; ks < KS; ++ks) qrot[ks] = *(const bf16x8*)(S.Qrot + qkr * S.qpitch + ks * 32 + g * 8);
        }
    }
    bf16x8 qc[KS];
#pragma unroll
    for (int ks = 0; ks < KS; ++ks) qc[ks] = S.samp ? qrot[ks] : qraw[ks];
    float m = S.m0, l = (S.sink && g == 0) ? 1.f : 0.f;
    f32x4 o[4];
#pragma unroll
    for (int d = 0; d < 4; ++d) o[d] = (f32x4){0.f, 0.f, 0.f, 0.f};
    const int nloc = S.hi - S.lo, ntile = nloc + S.nctx;
    u32x4 kreg0, kreg1, vreg;
    const int kc0 = tid, kc1 = tid + NT;
    const int key0 = kc0 / CPK, part0 = kc0 % CPK, key1 = kc1 / CPK, part1 = kc1 % CPK;
    const int vkey = tid & 63, vdc = tid >> 6;
    auto gload = [&](int j) {
        const int tile = j < nloc ? S.lo + j : 32 + (j - nloc);
        const size_t kr = (size_t)(S.krbase + tile * 64);
        if (DK == 64) { kreg0 = *(const u32x4*)(S.K0 + (kr + key0) * S.k0pitch + part0 * 8); }
        else {
            kreg0 = part0 < 8 ? *(const u32x4*)(S.K0 + (kr + key0) * S.k0pitch + part0 * 8) : *(const u32x4*)(S.K1 + (kr + key0) * 32 + (part0 - 8) * 8);
            if (kc1 < 64 * CPK) kreg1 = part1 < 8 ? *(const u32x4*)(S.K0 + (kr + key1) * S.k0pitch + part1 * 8) : *(const u32x4*)(S.K1 + (kr + key1) * 32 + (part1 - 8) * 8);
        }
        vreg = *(const u32x4*)(S.V + (kr + vkey) * S.vpitch + vdc * 8);
    };
    auto lstore = [&](int buf) {
        LAS bf16* kb = Ks + buf * 64 * KP; LAS bf16* vb = Vt + buf * 64 * VP;
        *(LAS u32x4*)(kb + key0 * KP + part0 * 8) = kreg0;
        if (DK == 96) { if (kc1 < 64 * CPK) *(LAS u32x4*)(kb + key1 * KP + part1 * 8) = kreg1; }
        LAS bf16* vp = vb + (vdc * 8) * VP + vkey;
        vp[0 * VP] = (bf16)(vreg.x & 0xffffu); vp[1 * VP] = (bf16)(vreg.x >> 16); vp[2 * VP] = (bf16)(vreg.y & 0xffffu); vp[3 * VP] = (bf16)(vreg.y >> 16);
        vp[4 * VP] = (bf16)(vreg.z & 0xffffu); vp[5 * VP] = (bf16)(vreg.z >> 16); vp[6 * VP] = (bf16)(vreg.w & 0xffffu); vp[7 * VP] = (bf16)(vreg.w >> 16);
    };
    gload(0); lstore(0);
    __syncthreads();
    for (int j = 0; j < ntile; ++j) {
        const int buf = j & 1;
        if (j + 1 < ntile) gload(j + 1);
        const bool loc = j < nloc;
        if (j == nloc) {
#pragma unroll
            for (int ks = 0; ks < KS; ++ks) qc[ks] = qraw[ks]; }
        const LAS bf16* kb = Ks + buf * 64 * KP; const LAS bf16* vb = Vt + buf * 64 * VP;
        f32x4 s[4];
#pragma unroll
        for (int kk = 0; kk < 4; ++kk) { s[kk] = (f32x4){0.f, 0.f, 0.f, 0.f};
#pragma unroll
            for (int ks = 0; ks < KS; ++ks) { const bf16x8 af = *(const LAS bf16x8*)(kb + (kk * 16 + fr) * KP + ks * 32 + g * 8);
                s[kk] = __builtin_amdgcn_mfma_f32_16x16x32_bf16(af, qc[ks], s[kk], 0, 0, 0); } }
        if (S.window && loc) {
            const int kp0 = (S.lo + j) * 64 + g * 4;
#pragma unroll
            for (int kk = 0; kk < 4; ++kk)
#pragma unroll
                for (int i = 0; i < 4; ++i) { const int d = kp0 + kk * 16 + i - qpos; if (d > 128 || d < -128) s[kk][i] = -INFINITY; }
        }
        float mx = -INFINITY;
#pragma unroll
        for (int kk = 0; kk < 4; ++kk) mx = fmaxf(mx, fmaxf(fmaxf(s[kk][0], s[kk][1]), fmaxf(s[kk][2], s[kk][3])));
        mx = fmaxf(mx, shx(mx, 16, lane)); mx = fmaxf(mx, shx(mx, 32, lane));
        const float mn = fmaxf(m, mx), alpha = __builtin_amdgcn_exp2f(m - mn);
        m = mn;
        float ls = 0.f;
#pragma unroll
        for (int kk = 0; kk < 4; ++kk)
#pragma unroll
            for (int i = 0; i < 4; ++i) { const float p = __builtin_amdgcn_exp2f(s[kk][i] - mn); s[kk][i] = p; ls += p; }
        l = l * alpha + ls;
#pragma unroll
        for (int d = 0; d < 4; ++d) o[d] = o[d] * alpha;
        bf16x8 pf[2];
#pragma unroll
        for (int pp = 0; pp < 2; ++pp) {
            const unsigned w0 = pk2(s[2 * pp][0], s[2 * pp][1]), w1 = pk2(s[2 * pp][2], s[2 * pp][3]), w2 = pk2(s[2 * pp + 1][0], s[2 * pp + 1][1]), w3 = pk2(s[2 * pp + 1][2], s[2 * pp + 1][3]);
            pf[pp] = __builtin_bit_cast(bf16x8, (u32x4){w0, w1, w2, w3});
        }
#pragma unroll
        for (int d = 0; d < 4; ++d)
#pragma unroll
            for (int pp = 0; pp < 2; ++pp) {
                const LAS bf16* vr = vb + (d * 16 + fr) * VP + pp * 32 + g * 4;
                const u32x2 lo = *(const LAS u32x2*)vr, hi = *(const LAS u32x2*)(vr + 16);
                const bf16x8 af = __builtin_bit_cast(bf16x8, (u32x4){lo.x, lo.y, hi.x, hi.y});
                o[d] = __builtin_amdgcn_mfma_f32_16x16x32_bf16(af, pf[pp], o[d], 0, 0, 0);
            }
        if (j + 1 < ntile) lstore(buf ^ 1);
        __syncthreads();
    }
    float lt = l + shx(l, 16, lane); lt += shx(lt, 32, lane);
    const float inv = 1.f / lt;
    bf16* yr = S.Y + (size_t)(S.rowbase + qpos) * DM + S.outcol + g * 4;
#pragma unroll
    for (int d = 0; d < 4; ++d) st4bf(yr + d * 16, o[d] * inv);
}

struct AttnBufs { const bf16 *MQKV, *KPE, *Qc_rot, *Qc_raw, *Kc, *Vc, *Qd_rot, *Qd_raw, *Kd, *Vd; bf16* YCAT; const float* sink; const float* rope; unsigned* ctr; };
constexpr int ATT_NU = 384 + 768;
__device__ __forceinline__ void attn_phase(const AttnBufs& B, LAS unsigned char* lds, int tid, int lane, int wave) {
    volatile LAS unsigned* shu = (volatile LAS unsigned*)(lds + LDS_CTL);
    for (;;) {
        if (tid == 0) *shu = atomicAdd(B.ctr, 1u);
        __syncthreads();
        const int u = (int)*shu;
        if (u >= ATT_NU) break;
        int type, b, h, qt; bool samp;
        if (u < 384) { type = u >> 7; const int v = u & 127; b = v >> 6; h = (v >> 4) & 3; qt = v & 15; samp = true; }
        else { const int w = u - 384; type = w >> 8; const int v = w & 255; b = v >> 3; h = (v >> 1) & 3; qt = v & 1; samp = false; }
        AttnSrc S;
        S.samp = samp; S.q0 = qt * 128; S.rope = B.rope; S.Y = B.YCAT;
        S.krbase = samp ? NPR + b * 2560 : b * 256; S.rowbase = samp ? NPR + b * 2048 : b * 256;
        S.window = false; S.sink = false; S.m0 = -1e30f;
        if (!samp) { S.lo = 0; S.hi = 4; S.nctx = 0; }
        else { S.lo = 0; S.hi = 32; S.nctx = 8; }
        if (type == 0) {
            S.Qraw = B.MQKV + h * 96; S.Qrot = S.Qraw; S.qpitch = 1024; S.K0 = B.MQKV + 384 + h * 128; S.k0pitch = 1024; S.K1 = B.KPE; S.V = B.MQKV + 384 + h * 128 + 64; S.vpitch = 1024; S.outcol = 256 + h * 64;
            attn_unit<96>(S, lds, tid, lane, wave);
        } else {
            if (type == 1) { S.Qraw = B.Qc_raw + h * 64; S.Qrot = B.Qc_rot + h * 64; S.K0 = B.Kc + (h >> 1) * 64; S.V = B.Vc + (h >> 1) * 64; S.outcol = 512 + h * 64; }
            else { S.Qraw = B.Qd_raw + h * 64; S.Qrot = B.Qd_rot + h * 64; S.K0 = B.Kd + (h >> 1) * 64; S.V = B.Vd + (h >> 1) * 64; S.outcol = 768 + h * 64;
                   S.sink = true; S.m0 = B.sink[h] * LOG2E;
                   if (samp) { S.window = true; const int lo = (S.q0 - 128) / 64; S.lo = lo < 0 ? 0 : lo; const int hi = (S.q0 + 256) / 64; S.hi = hi > 32 ? 32 : hi; } }
            S.qpitch = 256; S.k0pitch = 128; S.K1 = nullptr; S.vpitch = 128;
            attn_unit<64>(S, lds, tid, lane, wave);
        }
    }
}

__device__ __forceinline__ void load8(const bf16* p, float (&o)[8]) { const u32x4 u = *(const u32x4*)p; o[0] = bflo(u.x); o[1] = bfhi(u.x); o[2] = bflo(u.y); o[3] = bfhi(u.y); o[4] = bflo(u.z); o[5] = bfhi(u.z); o[6] = bflo(u.w); o[7] = bfhi(u.w); }
__device__ __forceinline__ void convgate_phase(const bf16* U, const float* cf, bf16* ACT, int gt, int NGT) {
    constexpr int NCH = DFF / 8, RG = 8;
    for (int it = gt; it < (NTOK / RG) * NCH; it += NGT) {
        const int rg = it / NCH, cc = it % NCH, r0 = rg * RG, col = cc * 8;
        const bool samp = r0 >= NPR; const int t0 = samp ? ((r0 - NPR) & 2047) : (r0 & 255), T = samp ? 2048 : 256;
        const bf16* up = U + (size_t)r0 * DUP + col;
        u32x4 ra[RG + 2], rb[RG + 2];
        const u32x4 z4 = (u32x4){0u, 0u, 0u, 0u};
        ra[0] = z4; rb[0] = z4; ra[RG + 1] = z4; rb[RG + 1] = z4;
        if (t0 > 0) { ra[0] = *(const u32x4*)(up - DUP); rb[0] = *(const u32x4*)(up - DUP + DFF); }
#pragma unroll
        for (int i = 0; i < RG; ++i) { ra[i + 1] = *(const u32x4*)(up + (size_t)i * DUP); rb[i + 1] = *(const u32x4*)(up + (size_t)i * DUP + DFF); }
        if (t0 + RG < T) { ra[RG + 1] = *(const u32x4*)(up + (size_t)RG * DUP); rb[RG + 1] = *(const u32x4*)(up + (size_t)RG * DUP + DFF); }
        float wa[3][8], wb[3][8];
#pragma unroll
        for (int k = 0; k < 3; ++k) { const f32x4 a0 = *(const f32x4*)(cf + k * DUP + col), a1 = *(const f32x4*)(cf + k * DUP + col + 4), b0 = *(const f32x4*)(cf + k * DUP + DFF + col), b1 = *(const f32x4*)(cf + k * DUP + DFF + col + 4);
#pragma unroll
            for (int e = 0; e < 4; ++e) { wa[k][e] = a0[e]; wa[k][4 + e] = a1[e]; wb[k][e] = b0[e]; wb[k][4 + e] = b1[e]; } }
#pragma unroll
        for (int i = 0; i < RG; ++i) {
            float r[8];
#pragma unroll
            for (int h = 0; h < 4; ++h) {
                const unsigned pa = ra[i][h], ca = ra[i + 1][h], na = ra[i + 2][h], pb = rb[i][h], cb = rb[i + 1][h], nb = rb[i + 2][h];
                const float xa0 = wa[0][2 * h] * bflo(pa) + wa[1][2 * h] * bflo(ca) + wa[2][2 * h] * bflo(na), xb0 = wb[0][2 * h] * bflo(pb) + wb[1][2 * h] * bflo(cb) + wb[2][2 * h] * bflo(nb);
                const float xa1 = wa[0][2 * h + 1] * bfhi(pa) + wa[1][2 * h + 1] * bfhi(ca) + wa[2][2 * h + 1] * bfhi(na), xb1 = wb[0][2 * h + 1] * bfhi(pb) + wb[1][2 * h + 1] * bfhi(cb) + wb[2][2 * h + 1] * bfhi(nb);
                r[2 * h] = xa0 * __builtin_amdgcn_rcpf(1.f + __builtin_amdgcn_exp2f(-xa0 * LOG2E)) * xb0;
                r[2 * h + 1] = xa1 * __builtin_amdgcn_rcpf(1.f + __builtin_amdgcn_exp2f(-xa1 * LOG2E)) * xb1;
            }
            u32x4 w; w.x = pk2(r[0], r[1]); w.y = pk2(r[2], r[3]); w.z = pk2(r[4], r[5]); w.w = pk2(r[6], r[7]);
            *(u32x4*)(ACT + (size_t)(r0 + i) * DFF + col) = w;
        }
    }
}

#define XB_TMO      128
#define XB_XCNT(j)  (256  + 64 * (j))
#define XB_XSUB(j)  (1280 + 64 * (j))
#define XB_XGEN(j)  (2304 + 64 * (j))
#define XB_TOP      3328
#define XB_TOPGEN   3392
#define XCD_BAR_WORDS 3456
#define XB_SPIN_CAP (1u << 20)
__device__ __forceinline__ unsigned xb_ld(unsigned* p)              { return __hip_atomic_load(p, __ATOMIC_RELAXED, __HIP_MEMORY_SCOPE_AGENT); }
__device__ __forceinline__ unsigned xb_add(unsigned* p, unsigned v) { return __hip_atomic_fetch_add(p, v, __ATOMIC_RELAXED, __HIP_MEMORY_SCOPE_AGENT); }
__device__ __forceinline__ unsigned xb_xcc_id() { return (unsigned)__builtin_amdgcn_s_getreg((3 << 11) | 20) & 0xFu; }
#define XB_SPIN(cond, bar) do { unsigned _sp = 0; while (cond) { __builtin_amdgcn_s_sleep(1); \
    if ((++_sp & 255u) == 0u) { if (xb_ld(&(bar)[XB_TMO])) break; if (_sp > XB_SPIN_CAP) { atomicAdd(&(bar)[XB_TMO], 1u); break; } } } } while (0)
struct XcdBarrier { unsigned* bar; unsigned x; volatile LAS unsigned* st; };
__device__ __forceinline__ void xcd_barrier_complete(unsigned* bar, unsigned x, unsigned& nloc, unsigned& nx) {
    const unsigned G = gridDim.x * gridDim.y * gridDim.z;
    unsigned sum, cnt, mine, sp = 0u;
    for (;;) {
        sum = 0u; cnt = 0u; mine = 0u;
#pragma unroll
        for (unsigned j = 0; j < 16; ++j) { const unsigned c = xb_ld(&bar[XB_XCNT(j)]); sum += c; cnt += (c > 0u) ? 1u : 0u; mine = (j == x) ? c : mine; }
        if (sum == G) break;
        __builtin_amdgcn_s_sleep(1);
        if ((++sp & 255u) == 0u) { if (xb_ld(&bar[XB_TMO])) break; if (sp > XB_SPIN_CAP) { atomicAdd(&bar[XB_TMO], 1u); break; } }
    }
    nloc = mine > 0u ? mine : 1u; nx = cnt > 0u ? cnt : 1u;
}
__device__ __forceinline__ void xcd_barrier(const XcdBarrier& b, const int tid_) {
    asm volatile("s_waitcnt vmcnt(0)" ::: "memory");
    __syncthreads();
    if (tid_ == 0) {
        unsigned* bar = b.bar;
        __builtin_amdgcn_s_waitcnt(0);
        unsigned nloc = b.st[0], nx = b.st[1];
        if (nloc == 0u) { xcd_barrier_complete(bar, b.x, nloc, nx); b.st[0] = nloc; b.st[1] = nx; }
        const unsigned old = xb_add(&bar[XB_XSUB(b.x)], 1u);
        const unsigned gen = old / nloc;
        if (old + 1u == (gen + 1u) * nloc) {
            __builtin_amdgcn_fence(__ATOMIC_RELEASE, "agent");
            asm volatile("s_waitcnt vmcnt(0)" ::: "memory");
            const unsigned og = xb_add(&bar[XB_TOP], 1u);
            const unsigned tg = og / nx;
            if (og + 1u == (tg + 1u) * nx) xb_add(&bar[XB_TOPGEN], 1u);
            else XB_SPIN(xb_ld(&bar[XB_TOPGEN]) == tg, bar);
            __builtin_amdgcn_fence(__ATOMIC_ACQUIRE, "agent");
            xb_add(&bar[XB_XGEN(b.x)], 1u);
            asm volatile("s_waitcnt vmcnt(0)" ::: "memory");
        } else {
            XB_SPIN(xb_ld(&bar[XB_XGEN(b.x)]) == gen, bar);
            __builtin_amdgcn_fence(__ATOMIC_ACQUIRE, "agent");
            asm volatile("s_waitcnt vmcnt(0)" ::: "memory");
        }
    }
    __syncthreads();
}

__device__ __forceinline__ int lane_id_volatile() { int l; asm volatile("v_mbcnt_lo_u32_b32 %0, -1, 0\n\tv_mbcnt_hi_u32_b32 %0, -1, %0" : "=v"(l)); return l; }

#ifndef PH
#define PH 0xFFFF
#endif
#define ON(k) ((PH >> (k)) & 1)
#ifndef REP
#define REP 0
#endif
#define NREP(k) (1 + ((REP >> (k)) & 1))
__global__ void __launch_bounds__(NT, 2) mega_fwd(Args a_unused) {
    extern __shared__ __attribute__((aligned(16))) unsigned char lds[];
    cg::grid_group grid = cg::this_grid();
    const int G = gridDim.x, bid = blockIdx.x;
    const int wave_s = __builtin_amdgcn_readfirstlane(threadIdx.x >> 6);
    PG8_LAS unsigned char* ring = (PG8_LAS unsigned char*)lds;
#define PHASE_BEGIN int tid = wave_s * 64 + lane_id_volatile(); asm volatile("" : "+v"(tid)); const Args* ap_ = (const Args*)__builtin_amdgcn_kernarg_segment_ptr(); asm volatile("" : "+s"(ap_)); const Args& a = *ap_; unsigned char* ws = a.ws; float* out = a.out; \
    const int lane = tid & 63, wave = __builtin_amdgcn_readfirstlane(tid >> 6); const int gw = bid * NW + wave, NGW = G * NW, gt = bid * NT + tid, NGT = G * NT; \
    (void)lane; (void)wave; (void)gw; (void)NGW; (void)gt; (void)NGT; (void)out; \
    const float* mod = (const float*)(ws + WS_MOD); const float* rope = (const float*)(ws + WS_ROPE); (void)mod; (void)rope; \
    bf16* XN = (bf16*)(ws + WS_XN); bf16* PROJ = (bf16*)(ws + WS_PROJ); bf16* A2 = (bf16*)(ws + WS_A2); bf16* MQKV = (bf16*)(ws + WS_MQKV); \
    bf16* KPE = (bf16*)(ws + WS_KPE); bf16* YCAT = (bf16*)(ws + WS_YCAT); bf16* ACT = (bf16*)(ws + WS_ACT); bf16* U = (bf16*)(ws + WS_U); \
    bf16* Qc_rot = (bf16*)(ws + WS_QC); bf16* Qc_raw = (bf16*)(ws + WS_QC + QSZ); bf16* Kc = (bf16*)(ws + WS_QC + 2 * QSZ); bf16* Vc = (bf16*)(ws + WS_QC + 2 * QSZ + KSZ); \
    bf16* Qd_rot = (bf16*)(ws + WS_QC + 2 * QSZ + 2 * KSZ); bf16* Qd_raw = Qd_rot + (size_t)NKR * 256; bf16* Kd = Qd_raw + (size_t)NKR * 256; bf16* Vd = Kd + (size_t)NKR * 128; \
    (void)XN; (void)PROJ; (void)A2; (void)MQKV; (void)KPE; (void)YCAT; (void)ACT; (void)U; (void)Qc_rot; (void)Qc_raw; (void)Kc; (void)Vc; (void)Qd_rot; (void)Qd_raw; (void)Kd; (void)Vd;
#define GSYNC() do { const Args* bp_ = (const Args*)__builtin_amdgcn_kernarg_segment_ptr(); asm volatile("" : "+s"(bp_)); XcdBarrier xb_; xb_.bar = (unsigned*)(bp_->ws + WS_BAR); xb_.x = xb_xcc_id(); \
    xb_.st = (volatile LAS unsigned*)((LAS unsigned char*)lds + LDS_CTL + 32); xcd_barrier(xb_, wave_s * 64 + lane_id_volatile()); } while (0)
#define LAYER_VALS const float* modl = mod + (size_t)l * 3 * 6144; unsigned char* wl = ws + WS_W + l * W_LSTRIDE; (void)modl; (void)wl; \
    const float* x0 = l == 0 ? a.in[0] : out; const float* x1 = l == 0 ? a.in[1] : out + (size_t)NPR * DM; (void)x0; (void)x1;

    if (threadIdx.x < 16) ((volatile LAS unsigned*)((LAS unsigned char*)lds + LDS_CTL))[threadIdx.x] = 0u;
    __syncthreads();
    for (int rep = 0; rep < NREP(0); ++rep) {
    if (ON(0)) { PHASE_BEGIN phase0(a, (LAS unsigned char*)lds, tid, lane, wave); }
    if (rep == 0) { grid.sync(); { PHASE_BEGIN if (tid == 0) (void)xb_add((unsigned*)(ws + WS_BAR) + XB_XCNT(xb_xcc_id()), 1u); } } else GSYNC(); }

#pragma unroll
    for (int l = 0; l < 2; ++l) {
        for (int rep = 0; rep < NREP(1); ++rep) {
        if (ON(1)) { PHASE_BEGIN LAYER_VALS norm_mod_phase(x0, x1, a.in[12] + l * DM, modl, 1024, 0, XN, lane, gw, NGW); }
        GSYNC(); }
        for (int rep = 0; rep < NREP(2); ++rep) {
        if (ON(2)) { PHASE_BEGIN LAYER_VALS pg8::Gemm g{XN, (const bf16*)(wl + W_IN), NTOK, INP, DM}; pg8::StaticOrder S; S.init(NTOK, INP, G, bid); pg8::EpiBf16 E{PROJ, INP};
          pg8::gemm_phase<pg8::EpiBf16, pg8::StaticOrder, true, true>(ring, g, S, E, tid); }
        GSYNC(); }
        for (int rep = 0; rep < NREP(3); ++rep) {
        if (ON(3)) { PHASE_BEGIN P3Ptrs P; P.PROJ = PROJ; P.A2 = A2; P.KPE = KPE; P.YCAT = YCAT; P.Qc_rot = Qc_rot; P.Qc_raw = Qc_raw; P.Kc = Kc; P.Vc = Vc; P.Qd_rot = Qd_rot; P.Qd_raw = Qd_raw; P.Kd = Kd; P.Vd = Vd;
          P.conv_a = a.in[14]; P.gq_mla = a.in[15]; P.gkv_mla = a.in[17]; P.gq = a.in[19]; P.gk = a.in[20]; P.rope = rope;
          P.c_ckv = a.in[2]; P.c_kpe = a.in[3]; P.c_gk = a.in[4]; P.c_gv = a.in[5]; P.c_sk = a.in[6]; P.c_sv = a.in[7];
          P.o_ckv = out + 12582912; P.o_kpe = out + 14680064; P.o_gk = out + 15204352; P.o_gv = out + 17301504; P.o_sk = out + 19398656; P.o_sv = out + 21495808; P.l = l;
          p3_phase(P, lane, gw, NGW); }
        GSYNC(); }
        for (int rep = 0; rep < NREP(4); ++rep) {
        if (ON(4)) { PHASE_BEGIN LAYER_VALS pg8::Gemm g{A2, (const bf16*)(wl + W_B2), NKR, 1024, 384}; pg8::StaticOrder S; S.init(NKR, 1024, G, bid); pg8::EpiBf16 E{MQKV, 1024};
          pg8::gemm_phase<pg8::EpiBf16, pg8::StaticOrder, true, true>(ring, g, S, E, tid); }
        GSYNC(); }
        for (int rep = 0; rep < NREP(5); ++rep) {
        if (ON(5)) { PHASE_BEGIN AttnBufs B; B.MQKV = MQKV; B.KPE = KPE; B.Qc_rot = Qc_rot; B.Qc_raw = Qc_raw; B.Kc = Kc; B.Vc = Vc; B.Qd_rot = Qd_rot; B.Qd_raw = Qd_raw; B.Kd = Kd; B.Vd = Vd; B.YCAT = YCAT;
          B.sink = a.in[21] + l * 4; B.rope = rope; B.ctr = (unsigned*)(ws + WS_CTL) + 64 * l + 128 * rep;
          attn_phase(B, (LAS unsigned char*)lds, tid, lane, wave); }
        GSYNC(); }
        for (int rep = 0; rep < (l == 0 ? NREP(11) : 1); ++rep) {
        if (ON(6)) { PHASE_BEGIN LAYER_VALS pg8::Gemm g{YCAT, (const bf16*)(wl + W_OUT), NTOK, DM, DM}; pg8::StaticOrder S; S.init(NTOK, DM, G, bid); pg8::EpiResid E{x0, x1, out, modl + 2048};
          pg8::gemm_phase<pg8::EpiResid, pg8::StaticOrder, true, true>(ring, g, S, E, tid); }
        GSYNC(); }
        for (int rep = 0; rep < NREP(7); ++rep) {
        if (ON(7)) { PHASE_BEGIN LAYER_VALS norm_mod_phase(out, out + (size_t)NPR * DM, a.in[23] + l * DM, modl, 4096, 3072, XN, lane, gw, NGW); }
        GSYNC(); }
        for (int rep = 0; rep < NREP(8); ++rep) {
        if (ON(8)) { PHASE_BEGIN LAYER_VALS pg8::Gemm g{XN, (const bf16*)(wl + W_UP), NTOK, DUP, DM}; pg8::StaticOrder S; S.init(NTOK, DUP, G, bid); pg8::EpiBf16 E{U, DUP};
          pg8::gemm_phase<pg8::EpiBf16, pg8::StaticOrder, true, true>(ring, g, S, E, tid); }
        GSYNC(); }
        for (int rep = 0; rep < NREP(9); ++rep) {
        if (ON(9)) { PHASE_BEGIN convgate_phase(U, a.in[25] + (size_t)l * 3 * DUP, ACT, gt, NGT); }
        GSYNC(); }
        for (int rep = 0; rep < NREP(12); ++rep) {
        if (ON(10)) { PHASE_BEGIN LAYER_VALS pg8::Gemm g{ACT, (const bf16*)(wl + W_DOWN), NTOK, DM, DFF}; pg8::StaticOrder S; S.init(NTOK, DM, G, bid); pg8::EpiResid E{out, out + (size_t)NPR * DM, (rep + 1 < NREP(12)) ? (float*)(ws + WS_U) : out, modl + 5120};
          pg8::gemm_phase<pg8::EpiResid, pg8::StaticOrder, true, true>(ring, g, S, E, tid); }
        GSYNC(); }
    }
#ifdef XSYNC
    for (int i = 0; i < XSYNC; ++i) GSYNC();
#endif
    { PHASE_BEGIN
    for (int row = gw; row < NTOK; row += NGW) {
        float* xr = out + (size_t)row * DM;
        f32x4 v[4]; float ss = 0.f;
#pragma unroll
        for (int j = 0; j < 4; ++j) { v[j] = *(const f32x4*)(xr + 4 * (lane + 64 * j)); ss += dot4(v[j]); }
        const float rs = rsqrtf(wave_sum(ss, lane) * (1.f / DM) + EPS);
#pragma unroll
        for (int j = 0; j < 4; ++j) { const int col = 4 * (lane + 64 * j); *(f32x4*)(xr + col) = v[j] * rs * *(const f32x4*)(a.in[27] + col); }
    } }
}

extern "C" void kernel_launch(void* const* d_in, const int* in_sizes, int n_in, void* d_out, int out_size, void* d_ws, size_t ws_size, hipStream_t stream) {
    static int grid = 0;
    if (grid == 0) {
        if (n_in != 28 || ws_size < WS_END) { fprintf(stderr, "kernel_launch: unexpected n_in %d / ws %zu\n", n_in, ws_size); grid = -1; return; }
        int dev = 0, cus = 0, per_cu = 0;
        hipGetDevice(&dev); hipDeviceGetAttribute(&cus, hipDeviceAttributeMultiprocessorCount, dev);
        hipFuncSetAttribute((const void*)mega_fwd, hipFuncAttributeMaxDynamicSharedMemorySize, LDS_BYTES);
        hipOccupancyMaxActiveBlocksPerMultiprocessor(&per_cu, (const void*)mega_fwd, NT, LDS_BYTES);
        if (per_cu < 1) per_cu = 1;
        grid = cus * per_cu;
        (void)hipGetLastError();
    }
    if (grid < 0) return;
    Args a{};
    for (int i = 0; i < 28; ++i) a.in[i] = (const float*)d_in[i];
    a.out = (float*)d_out; a.ws = (unsigned char*)d_ws;
    void* args[] = {&a};
    hipError_t e = hipLaunchCooperativeKernel((const void*)mega_fwd, dim3(grid), dim3(NT), args, LDS_BYTES, stream);
    if (e != hipSuccess) fprintf(stderr, "cooperative launch failed: %s (grid %d)\n", hipGetErrorString(e), grid);
}
```

```cpp
#include <hip/hip_runtime.h>
#include <hip/hip_cooperative_groups.h>
#include <cstdio>
#include <cstdint>
namespace cg = cooperative_groups;

namespace pg8 {
#define PG8_LAS __attribute__((address_space(3)))
typedef unsigned short bf16_t;
typedef short bf16x8 __attribute__((ext_vector_type(8)));
typedef float f32x4 __attribute__((ext_vector_type(4)));
typedef unsigned u32x4 __attribute__((ext_vector_type(4)));
constexpr int BM = 256, BK = 64, HALF = 128, HTB = HALF * BK * 2, STAGE_BYTES = 8 * HTB, NXCD = 8, WGM = 8;

__host__ __device__ __forceinline__ int lds_byte(int r, int c) { const int st = (r >> 4) * 2 + (c >> 5), rr = r & 15, cc = c & 31, ob = rr * 64 + cc * 2; return st * 1024 + (ob ^ (((ob >> 9) & 1) << 5)); }
__host__ __device__ __forceinline__ void stage_rc(int b, int& R, int& C) { const int st = b / 1024, sb = b % 1024, swz = sb ^ (((sb >> 9) & 1) << 5); R = (st >> 1) * 16 + swz / 64; C = (st & 1) * 32 + (swz % 64) / 2; }
__host__ __device__ __forceinline__ int perm32(int rho) { const int n = rho >> 4, i = rho & 15; return 8 * (i >> 2) + 4 * n + (i & 3); }

struct Unit { int pm, pn; };
struct Gemm { const bf16_t* A; const bf16_t* Bt; int M, N, K; };

struct StaticOrder {
    int nM, nN, nwg, G, c;
    __host__ __device__ void init(int M, int N, int G_, int c_) { nM = M / BM; nN = N / BM; nwg = nM * nN; G = G_; c = c_; }
    __host__ __device__ bool next(int i, Unit& u) const {
        const long L = (long)i * G + c; if (L >= nwg) return false;
        int wgid = (int)L; { const int q = nwg / NXCD, r = nwg % NXCD, xcd = wgid % NXCD, off = wgid / NXCD; wgid = (xcd < r ? xcd * (q + 1) : r * (q + 1) + (xcd - r) * q) + off; }
        const int nig = WGM * nN, gid = wgid / nig, fm = gid * WGM, gsz = (nM - fm) < WGM ? (nM - fm) : WGM;
        u.pm = fm + ((wgid % nig) % gsz); u.pn = (wgid % nig) / gsz; return true;
    }
    __device__ __forceinline__ void a_ready(const Unit&) const {}
    __device__ __forceinline__ void done(const Unit&) const {}
};

__device__ __forceinline__ unsigned cvt_pk_bf16(float lo, float hi) { unsigned r; asm volatile("v_cvt_pk_bf16_f32 %0, %1, %2" : "=v"(r) : "v"(lo), "v"(hi)); return r; }

struct EpiBf16 {
    static constexpr bool PERM = true, AFTER_DRAIN = false;
    bf16_t* O; int ldc;
    __device__ __forceinline__ void operator()(const f32x4 (&acc)[2][2][4][2], const Unit& u, int wr, int wc, int fr, int fq) const {
        asm volatile("" : "+v"(fr), "+v"(fq));
        const int row0 = u.pm * BM + wr * 64 + fr; const int col0 = u.pn * BM + wc * 32 + 8 * fq;
#pragma unroll
        for (int ai = 0; ai < 2; ++ai)
#pragma unroll
            for (int m = 0; m < 4; ++m) { bf16_t* rowp = O + (size_t)(row0 + ai * HALF + m * 16) * ldc + col0;
#pragma unroll
                for (int bj = 0; bj < 2; ++bj) { const f32x4 v0 = acc[ai][bj][m][0], v1 = acc[ai][bj][m][1];
                    u32x4 w; w.x = cvt_pk_bf16(v0[0], v0[1]); w.y = cvt_pk_bf16(v0[2], v0[3]); w.z = cvt_pk_bf16(v1[0], v1[1]); w.w = cvt_pk_bf16(v1[2], v1[3]);
                    *(u32x4*)(rowp + bj * HALF) = w; } }
    }
};
__device__ __forceinline__ float shx_(float v, int m, int lane) { return __builtin_bit_cast(float, __builtin_amdgcn_ds_bpermute((lane ^ m) << 2, __builtin_bit_cast(int, v))); }
struct EpiBf16RS {
    static constexpr bool PERM = true, AFTER_DRAIN = false;
    bf16_t* O; int ldc; const float* SS; const float* bias; int ldb;
    __device__ __forceinline__ void operator()(const f32x4 (&acc)[2][2][4][2], const Unit& u, int wr, int wc, int fr, int fq) const {
        asm volatile("" : "+v"(fr), "+v"(fq));
        const int cnd = u.pm < 32 ? 0 : 1 + ((u.pm - 32) >> 3);
        const int row0 = u.pm * BM + wr * 64 + fr; const int col0 = u.pn * BM + wc * 32 + 8 * fq;
        const float* bp = bias + (size_t)cnd * ldb + col0;
        f32x4 bv[2][2];
#pragma unroll
        for (int bj = 0; bj < 2; ++bj)
#pragma unroll
            for (int n = 0; n < 2; ++n) bv[bj][n] = *(const f32x4*)(bp + bj * HALF + 4 * n);
#pragma unroll
        for (int ai = 0; ai < 2; ++ai)
#pragma unroll
            for (int m = 0; m < 4; ++m) { const int row = row0 + ai * HALF + m * 16; const float* sp = SS + (size_t)row * 16;
                const f32x4 s0 = *(const f32x4*)sp, s1 = *(const f32x4*)(sp + 4), s2 = *(const f32x4*)(sp + 8), s3 = *(const f32x4*)(sp + 12);
                const f32x4 st = (s0 + s1) + (s2 + s3);
                const float rs = __builtin_amdgcn_rsqf(((st[0] + st[1]) + (st[2] + st[3])) * (1.f / 1024.f) + 1e-6f);
                bf16_t* rowp = O + (size_t)row * ldc + col0;
#pragma unroll
                for (int bj = 0; bj < 2; ++bj) { const f32x4 v0 = acc[ai][bj][m][0] * rs + bv[bj][0], v1 = acc[ai][bj][m][1] * rs + bv[bj][1];
                    u32x4 w; w.x = cvt_pk_bf16(v0[0], v0[1]); w.y = cvt_pk_bf16(v0[2], v0[3]); w.z = cvt_pk_bf16(v1[0], v1[1]); w.w = cvt_pk_bf16(v1[2], v1[3]);
                    *(u32x4*)(rowp + bj * HALF) = w; } }
    }
};
struct EpiResid {
    static constexpr bool PERM = false, AFTER_DRAIN = false;
    const float* r0; const float* r1; float* out; const float* gate;
    bf16_t* XN; float* SS; const float* nrm; const float* sc;
    __device__ __forceinline__ void operator()(const f32x4 (&acc)[2][2][4][2], const Unit& u, int wr, int wc, int fr, int fq) const {
        asm volatile("" : "+v"(fr), "+v"(fq));
        const int cnd = u.pm < 32 ? 0 : 1 + ((u.pm - 32) >> 3);
        const float* gp = gate + cnd * 6144;
        const int col0 = u.pn * BM + wc * 32 + 4 * fq;
        const int rowb = u.pm * BM + wr * 64 + fr;
        const float* rs = (u.pm < 32 ? r0 + (size_t)rowb * 1024 : r1 + (size_t)(rowb - 8192) * 1024) + col0;
        float* op = out + (size_t)rowb * 1024 + col0;
        const bool prep = XN != nullptr;
        f32x4 gv[2][2], hv[2][2];
#pragma unroll
        for (int bj = 0; bj < 2; ++bj)
#pragma unroll
            for (int n = 0; n < 2; ++n) { gv[bj][n] = *(const f32x4*)(gp + col0 + bj * HALF + n * 16);
                hv[bj][n] = (f32x4){0.f, 0.f, 0.f, 0.f};
                if (prep) hv[bj][n] = *(const f32x4*)(nrm + col0 + bj * HALF + n * 16) * (1.f + *(const f32x4*)(sc + cnd * 6144 + col0 + bj * HALF + n * 16)); }
        f32x4 xc[2][2], xn[2][2];
#pragma unroll
        for (int bj = 0; bj < 2; ++bj)
#pragma unroll
            for (int n = 0; n < 2; ++n) xc[bj][n] = *(const f32x4*)(rs + bj * HALF + n * 16);
#pragma unroll
        for (int it = 0; it < 8; ++it) { const int ai = it >> 2, m = it & 3; const size_t ro = (size_t)(ai * HALF + m * 16) * 1024;
            if (it < 7) { const int ai2 = (it + 1) >> 2, m2 = (it + 1) & 3; const size_t ro2 = (size_t)(ai2 * HALF + m2 * 16) * 1024;
#pragma unroll
                for (int bj = 0; bj < 2; ++bj)
#pragma unroll
                    for (int n = 0; n < 2; ++n) xn[bj][n] = *(const f32x4*)(rs + ro2 + bj * HALF + n * 16); }
            float ssq = 0.f;
#pragma unroll
            for (int bj = 0; bj < 2; ++bj)
#pragma unroll
                for (int n = 0; n < 2; ++n) { const f32x4 v = xc[bj][n] + gv[bj][n] * acc[ai][bj][m][n];
                    *(f32x4*)(op + ro + bj * HALF + n * 16) = v;
                    if (prep) { ssq += (v[0] * v[0] + v[1] * v[1]) + (v[2] * v[2] + v[3] * v[3]); const f32x4 h = v * hv[bj][n];
                        unsigned w0 = cvt_pk_bf16(h[0], h[1]), w1 = cvt_pk_bf16(h[2], h[3]);
                        typedef unsigned u32x2_ __attribute__((ext_vector_type(2)));
                        *(u32x2_*)(XN + (size_t)(rowb + ai * HALF + m * 16) * 1024 + col0 + bj * HALF + n * 16) = (u32x2_){w0, w1}; } }
            if (prep) { const int lane = fq * 16 + fr; ssq += shx_(ssq, 16, lane); ssq += shx_(ssq, 32, lane);
                if (fq == 0) SS[(size_t)(rowb + ai * HALF + m * 16) * 16 + u.pn * 4 + wc] = ssq; }
#pragma unroll
            for (int bj = 0; bj < 2; ++bj)
#pragma unroll
                for (int n = 0; n < 2; ++n) xc[bj][n] = xn[bj][n];
        }
    }
};

template <class Epi, class Sched, bool ALIGN_EPI = false, bool SP2 = false>
__device__ __forceinline__ void gemm_phase(PG8_LAS unsigned char* lds, const Gemm g, const Sched& S, const Epi& E, const int tid) {
    const int wid = __builtin_amdgcn_readfirstlane(tid >> 6), lane = tid & 63, wr = wid >> 2, wc = wid & 3, fr = lane & 15, fq = lane >> 4;
    const int K = g.K, nt = K / BK;
    unsigned voffA[2], voffB[2];
#pragma unroll
    for (int i = 0; i < 2; ++i) { int R, C; stage_rc(tid * 16 + i * 8192, R, C); const int Rb = Epi::PERM ? ((R & ~31) + perm32(R & 31)) : R;
        voffA[i] = (unsigned)(R * K + C) * 2u; voffB[i] = (unsigned)(Rb * K + C) * 2u; }
    const size_t kstep = (size_t)(BK * 2);
    const size_t hstep = (size_t)HALF * K * 2;
    const size_t tstep = 2 * hstep;
    const unsigned ldsw = (unsigned)wid * 1024u;
    const int aoff = lds_byte(wr * 64 + fr, fq * 8), boff = lds_byte(wc * 32 + fr, fq * 8);
#define PG8_SA(b, h) (((b) * 2 + (h)) * HTB)
#define PG8_SB(b, h) ((4 + (b) * 2 + (h)) * HTB)
#define PG8_STAGE(bufoff, gbase, voff) do { _Pragma("unroll") for (int _i = 0; _i < 2; ++_i) \
        __builtin_amdgcn_global_load_lds((const unsigned*)((const char*)(gbase) + (voff)[_i]), (PG8_LAS unsigned*)(lds + (bufoff) + ldsw + _i * 8192), 16, 0, 0); } while (0)
#define PG8_LDA(dst, b, h) do { _Pragma("unroll") for (int m = 0; m < 4; ++m) _Pragma("unroll") for (int k = 0; k < 2; ++k) dst[m][k] = *(const PG8_LAS bf16x8*)(lds + PG8_SA(b, h) + aoff + m * 2048 + k * 1024); } while (0)
#define PG8_LDB(dst, b, h) do { _Pragma("unroll") for (int n = 0; n < 2; ++n) _Pragma("unroll") for (int k = 0; k < 2; ++k) dst[n][k] = *(const PG8_LAS bf16x8*)(lds + PG8_SB(b, h) + boff + n * 2048 + k * 1024); } while (0)
#define PG8_MMA(ai, bj, At, Bt) do { __builtin_amdgcn_s_setprio(1); _Pragma("unroll") for (int m = 0; m < 4; ++m) _Pragma("unroll") for (int n = 0; n < 2; ++n) _Pragma("unroll") for (int k = 0; k < 2; ++k) \
        acc[ai][bj][m][n] = __builtin_amdgcn_mfma_f32_16x16x32_bf16(Bt[n][k], At[m][k], acc[ai][bj][m][n], 0, 0, 0); __builtin_amdgcn_s_setprio(0); } while (0)
#define PG8_WAIT_V(n) asm volatile("s_waitcnt vmcnt(" #n ")" ::: "memory")
#define PG8_WAIT_L(n) asm volatile("s_waitcnt lgkmcnt(" #n ")" ::: "memory")
#define PG8_BAR __builtin_amdgcn_s_barrier()
#define PG8_SCHED __builtin_amdgcn_sched_barrier(0)
    Unit cur, nxt; int ui = 0;
    if (!S.next(0, cur)) return;
    f32x4 acc[2][2][4][2];
#pragma unroll
    for (int a = 0; a < 2; ++a)
#pragma unroll
        for (int b = 0; b < 2; ++b)
#pragma unroll
            for (int m = 0; m < 4; ++m)
#pragma unroll
                for (int n = 0; n < 2; ++n) acc[a][b][m][n] = (f32x4){0.f, 0.f, 0.f, 0.f};
    bf16x8 At[4][2], B0[2][2], B1[2][2];
    const char* cA = (const char*)g.A + (size_t)cur.pm * tstep; const char* cB = (const char*)g.Bt + (size_t)cur.pn * tstep;
    S.a_ready(cur);
    if constexpr (SP2) {
        PG8_STAGE(PG8_SB(0, 0), cB, voffB); PG8_STAGE(PG8_SB(0, 1), cB + hstep, voffB); PG8_STAGE(PG8_SA(0, 0), cA, voffA); PG8_STAGE(PG8_SA(0, 1), cA + hstep, voffA);
        if (wr == 1) PG8_BAR;
        PG8_WAIT_V(2); PG8_BAR;
        PG8_STAGE(PG8_SB(1, 0), cB + kstep, voffB); PG8_STAGE(PG8_SA(1, 0), cA + kstep, voffA); PG8_STAGE(PG8_SB(1, 1), cB + hstep + kstep, voffB);
        PG8_WAIT_V(6); PG8_BAR;
    } else {
        PG8_STAGE(PG8_SB(0, 0), cB, voffB); PG8_STAGE(PG8_SA(0, 0), cA, voffA); PG8_STAGE(PG8_SB(0, 1), cB + hstep, voffB); PG8_STAGE(PG8_SA(0, 1), cA + hstep, voffA);
        if (wr == 1) PG8_BAR;
        PG8_WAIT_V(4); PG8_BAR;
        PG8_STAGE(PG8_SB(1, 0), cB + kstep, voffB); PG8_STAGE(PG8_SA(1, 0), cA + kstep, voffA); PG8_STAGE(PG8_SB(1, 1), cB + hstep + kstep, voffB);
        PG8_WAIT_V(6); PG8_BAR;
    }
    for (;;) {
        const bool has_next = S.next(ui + 1, nxt);
        const char* nA = has_next ? (const char*)g.A + (size_t)nxt.pm * tstep : cA; const char* nB = has_next ? (const char*)g.Bt + (size_t)nxt.pn * tstep : cB;
        for (int t = 0; t < nt; t += 2) {
            const bool last = (t == nt - 2);
            const char* a1 = cA + (size_t)(t + 1) * kstep;
            const char* a2 = last ? nA : cA + (size_t)(t + 2) * kstep; const char* b2 = last ? nB : cB + (size_t)(t + 2) * kstep;
            const char* a3 = a2 + kstep; const char* b3 = b2 + kstep;
            if (last && has_next) S.a_ready(nxt);
            if constexpr (SP2) {
            PG8_LDB(B0, 0, 0); PG8_LDB(B1, 0, 1); PG8_SCHED; PG8_LDA(At, 0, 0); PG8_STAGE(PG8_SA(1, 1), a1 + hstep, voffA);
            PG8_WAIT_V(8); PG8_WAIT_L(0); PG8_BAR; PG8_MMA(0, 0, At, B0); PG8_MMA(0, 1, At, B1); PG8_BAR; PG8_SCHED;
            PG8_LDA(At, 0, 1); PG8_STAGE(PG8_SB(0, 0), b2, voffB); PG8_STAGE(PG8_SB(0, 1), b2 + hstep, voffB); PG8_STAGE(PG8_SA(0, 0), a2, voffA);
            PG8_WAIT_V(8); PG8_WAIT_L(0); PG8_BAR; PG8_MMA(1, 0, At, B0); PG8_MMA(1, 1, At, B1); PG8_BAR; PG8_SCHED;
            PG8_LDB(B0, 1, 0); PG8_LDB(B1, 1, 1); PG8_SCHED; PG8_LDA(At, 1, 0); PG8_STAGE(PG8_SA(0, 1), a2 + hstep, voffA);
            PG8_WAIT_V(8); PG8_WAIT_L(0); PG8_BAR; PG8_MMA(0, 0, At, B0); PG8_MMA(0, 1, At, B1); PG8_BAR; PG8_SCHED;
            PG8_LDA(At, 1, 1); PG8_STAGE(PG8_SB(1, 0), b3, voffB); PG8_STAGE(PG8_SB(1, 1), b3 + hstep, voffB); PG8_STAGE(PG8_SA(1, 0), a3, voffA);
            PG8_WAIT_V(8); PG8_WAIT_L(0); PG8_BAR; PG8_MMA(1, 0, At, B0); PG8_MMA(1, 1, At, B1); PG8_BAR; PG8_SCHED;
            } else {
            PG8_LDB(B0, 0, 0); PG8_SCHED; PG8_LDA(At, 0, 0); PG8_STAGE(PG8_SA(1, 1), a1 + hstep, voffA);
            PG8_WAIT_L(8); PG8_BAR; PG8_WAIT_L(0); PG8_MMA(0, 0, At, B0); PG8_BAR; PG8_SCHED;
            PG8_LDB(B1, 0, 1); PG8_STAGE(PG8_SB(0, 0), b2, voffB);
            PG8_BAR; PG8_WAIT_L(0); PG8_MMA(0, 1, At, B1); PG8_BAR;
            PG8_LDA(At, 0, 1); PG8_STAGE(PG8_SA(0, 0), a2, voffA);
            PG8_BAR; PG8_WAIT_L(0); PG8_MMA(1, 0, At, B0); PG8_BAR; PG8_SCHED;
            PG8_STAGE(PG8_SB(0, 1), b2 + hstep, voffB);
            PG8_WAIT_V(6); PG8_BAR; PG8_MMA(1, 1, At, B1); PG8_BAR;
            PG8_LDB(B0, 1, 0); PG8_SCHED; PG8_LDA(At, 1, 0); PG8_STAGE(PG8_SA(0, 1), a2 + hstep, voffA);
            PG8_WAIT_L(8); PG8_BAR; PG8_WAIT_L(0); PG8_MMA(0, 0, At, B0); PG8_BAR; PG8_SCHED;
            PG8_LDB(B1, 1, 1); PG8_STAGE(PG8_SB(1, 0), b3, voffB);
            PG8_BAR; PG8_WAIT_L(0); PG8_MMA(0, 1, At, B1); PG8_BAR;
            PG8_LDA(At, 1, 1); PG8_STAGE(PG8_SA(1, 0), a3, voffA);
            PG8_BAR; PG8_WAIT_L(0); PG8_MMA(1, 0, At, B0); PG8_BAR; PG8_SCHED;
            PG8_STAGE(PG8_SB(1, 1), b3 + hstep, voffB);
            PG8_WAIT_V(6); PG8_BAR; PG8_MMA(1, 1, At, B1); PG8_BAR;
            }
        }
        if constexpr (ALIGN_EPI) { if (wr == 0) PG8_BAR; }
        if constexpr (!Epi::AFTER_DRAIN) { E(acc, cur, wr, wc, fr, fq); S.done(cur); }
        if (!has_next) break;
#pragma unroll
        for (int a = 0; a < 2; ++a)
#pragma unroll
            for (int b = 0; b < 2; ++b)
#pragma unroll
                for (int m = 0; m < 4; ++m)
#pragma unroll
                    for (int n = 0; n < 2; ++n) acc[a][b][m][n] = (f32x4){0.f, 0.f, 0.f, 0.f};
        cur = nxt; cA = nA; cB = nB; ++ui;
        if constexpr (ALIGN_EPI) { if (wr == 1) PG8_BAR; }
    }
    PG8_WAIT_V(0);
    if constexpr (!ALIGN_EPI) { if (wr == 0) PG8_BAR; }
    PG8_BAR;
#undef PG8_SA
#undef PG8_SB
#undef PG8_STAGE
#undef PG8_LDA
#undef PG8_LDB
#undef PG8_MMA
#undef PG8_WAIT_V
#undef PG8_WAIT_L
#undef PG8_BAR
#undef PG8_SCHED
}
}

#define LAS __attribute__((address_space(3)))
#define CAS __attribute__((address_space(4)))
typedef unsigned short bf16;
typedef float f32x4 __attribute__((ext_vector_type(4)));
typedef short bf16x8 __attribute__((ext_vector_type(8)));
typedef unsigned u32x4 __attribute__((ext_vector_type(4)));
typedef unsigned u32x2 __attribute__((ext_vector_type(2)));

constexpr int NW = 8, NT = 512;
constexpr int DM = 1024, NTOK = 12288, NPR = 8192, NKR = 13312, INC = 2144, INP = 2304, DFF = 2816, DUP = 5632;
constexpr float EPS = 1e-6f, LOG2E = 1.4426950408889634f;
constexpr float QS = 0.125f * LOG2E;
constexpr float MLAQS = 0.10206207261596575f * LOG2E;

constexpr size_t MiB = 1u << 20;
constexpr size_t WS_CTL = 0, WS_MOD = 1 * MiB, WS_ROPE = 1 * MiB + 256 * 1024, WS_W = 2 * MiB, W_LSTRIDE = 24 * MiB;
constexpr size_t W_IN = 0, W_OUT = 4718592, W_UP = W_OUT + 2097152, W_DOWN = W_UP + 11534336, W_B2 = W_DOWN + 5767168;
static_assert(W_B2 + 786432 <= W_LSTRIDE, "weights");
constexpr size_t WS_XN = 50 * MiB, WS_PROJ = 74 * MiB, WS_A2 = 128 * MiB, WS_MQKV = 138 * MiB, WS_QC = 164 * MiB, WS_KPE = 203 * MiB, WS_YCAT = 204 * MiB;
constexpr size_t WS_ACT = 50 * MiB, WS_U = 116 * MiB, WS_SS1 = 248 * MiB, WS_SS2 = 249 * MiB, WS_END = 250 * MiB;
constexpr size_t WS_BIAS = 65536;
constexpr int NBIAS = 2304 + 5632;
constexpr size_t QSZ = (size_t)NKR * 256 * 2, KSZ = (size_t)NKR * 128 * 2;
constexpr int LDS_BYTES = 163840, LDS_CTL = 163840 - 256;
constexpr size_t WS_BAR = 16384;

struct Args { const float* in[28]; float* out; unsigned char* ws; };

__device__ __forceinline__ unsigned f2bf(float f) { unsigned u = __builtin_bit_cast(unsigned, f); return (u + 0x7fffu + ((u >> 16) & 1u)) >> 16; }
__device__ __forceinline__ unsigned pk2(float lo, float hi) { unsigned r; asm("v_cvt_pk_bf16_f32 %0, %1, %2" : "=v"(r) : "v"(lo), "v"(hi)); return r; }
__device__ __forceinline__ float bflo(unsigned u) { return __builtin_bit_cast(float, u << 16); }
__device__ __forceinline__ float bfhi(unsigned u) { return __builtin_bit_cast(float, u & 0xffff0000u); }
__device__ __forceinline__ f32x4 ld4bf(const bf16* p) { const u32x2 u = *(const u32x2*)p; return (f32x4){bflo(u.x), bfhi(u.x), bflo(u.y), bfhi(u.y)}; }
__device__ __forceinline__ void st4bf(bf16* p, f32x4 v) { u32x2 u; u.x = pk2(v[0], v[1]); u.y = pk2(v[2], v[3]); *(u32x2*)p = u; }
__device__ __forceinline__ float shx(float v, int m, int lane) { return __builtin_bit_cast(float, __builtin_amdgcn_ds_bpermute((lane ^ m) << 2, __builtin_bit_cast(int, v))); }
__device__ __forceinline__ float wave_sum(float v, int lane) {
#pragma unroll
    for (int o = 1; o < 64; o <<= 1) v += shx(v, o, lane);
    return v;
}
__device__ __forceinline__ float sum16(float v, int lane) {
#pragma unroll
    for (int o = 1; o < 16; o <<= 1) v += shx(v, o, lane);
    return v;
}
__device__ __forceinline__ float dot4(f32x4 a) { return (a[0] * a[0] + a[1] * a[1]) + (a[2] * a[2] + a[3] * a[3]); }
__device__ __forceinline__ f32x4 shfl4(f32x4 v, int m, int lane) { return (f32x4){shx(v[0], m, lane), shx(v[1], m, lane), shx(v[2], m, lane), shx(v[3], m, lane)}; }

__device__ __forceinline__ void transpose_item(const float* W, int N, bf16* WT, int ldk, int row_off, int k_off, float scale, LAS float* scr, int item, int lane) {
    const int nblk = (N + 63) / 64, kb = item / nblk, nb = item % nblk, k0 = 64 * kb, n0 = 64 * nb;
    const bool act = n0 + lane < N;
    const float* wp = W + (size_t)k0 * N + n0 + lane;
#pragma unroll 16
    for (int i = 0; i < 64; ++i) { const float v = act ? wp[(size_t)i * N] : 0.f; scr[i * 65 + lane] = v * scale; }
    asm volatile("s_waitcnt lgkmcnt(0)" ::: "memory");
    const int c = lane & 7;
#pragma unroll
    for (int j = 0; j < 8; ++j) { const int n = (lane >> 3) + 8 * j; const LAS float* s = scr + (8 * c) * 65 + n;
        u32x4 o; o.x = pk2(s[0 * 65], s[1 * 65]); o.y = pk2(s[2 * 65], s[3 * 65]); o.z = pk2(s[4 * 65], s[5 * 65]); o.w = pk2(s[6 * 65], s[7 * 65]);
        if (n0 + n < N) *(u32x4*)(WT + (size_t)(row_off + n0 + n) * ldk + k_off + k0 + 8 * c) = o; }
    asm volatile("s_waitcnt lgkmcnt(0)" ::: "memory");
}

template <class ArgsRef>
__device__ __forceinline__ void phase0(const ArgsRef& a, LAS unsigned char* lds, int tid, int lane, int wave) {
    unsigned char* ws = a.ws;
    const int G = gridDim.x, bid = blockIdx.x;
    if (bid < 96) {
        LAS float* sl = (LAS float*)(lds + 16384);
        for (int e = tid; e < 3072; e += NT) { const int c = e >> 10, k = e & 1023; const float v = c == 0 ? a.in[9][k] : a.in[8][(c - 1) * 1024 + k]; sl[e] = v / (1.f + __expf(-v)); }
        __syncthreads();
    }
    for (int it = bid; it < 96; it += G) {
        const int l = it / 48, n0 = (it % 48) * 128;
        const float* wa = a.in[10] + (size_t)l * 1024 * 6144;
        const LAS float* sl = (const LAS float*)(lds + 16384);
        float acc[3][2] = {{0.f, 0.f}, {0.f, 0.f}, {0.f, 0.f}};
        const int kb = wave * 128;
#pragma unroll 16
        for (int k = 0; k < 128; ++k) {
            const int kk = kb + k;
            const float2 w = *(const float2*)(wa + (size_t)kk * 6144 + n0 + 2 * lane);
            const float s0 = sl[kk], s1 = sl[1024 + kk], s2 = sl[2048 + kk];
            acc[0][0] += s0 * w.x; acc[0][1] += s0 * w.y; acc[1][0] += s1 * w.x; acc[1][1] += s1 * w.y; acc[2][0] += s2 * w.x; acc[2][1] += s2 * w.y;
        }
        LAS float* red = (LAS float*)lds;
#pragma unroll
        for (int c = 0; c < 3; ++c) { red[(wave * 3 + c) * 128 + 2 * lane] = acc[c][0]; red[(wave * 3 + c) * 128 + 2 * lane + 1] = acc[c][1]; }
        __syncthreads();
        if (tid < 384) { const int c = tid / 128, n = tid % 128; float s = 0.f;
#pragma unroll
            for (int w = 0; w < 8; ++w) s += red[(w * 3 + c) * 128 + n];
            ((float*)(ws + WS_MOD))[(size_t)(l * 3 + c) * 6144 + n0 + n] = s + a.in[11][(size_t)l * 6144 + n0 + n]; }
        __syncthreads();
    }
    if (bid == G - 1) {
        float* rt = (float*)(ws + WS_ROPE);
        for (int e = tid; e < 1024; e += NT) { const int pos = e >> 4, i = e & 15; const float inv = exp2f(-(float)(2 * i) / 32.f * 13.287712379549449f); const float ang = (float)pos * inv;
            rt[e] = __cosf(ang); rt[1024 + e] = __sinf(ang); }
        for (int e = tid; e < 512; e += NT) { const int pos = e >> 3, i = e & 7; const float inv = exp2f(-(float)(2 * i) / 16.f * 13.287712379549449f); const float ang = (float)pos * inv;
            rt[2048 + e] = __cosf(ang); rt[2560 + e] = __sinf(ang); }
    }
    const int gt = bid * NT + tid, NGT = G * NT;
    if (gt < 256) ((unsigned*)(ws + WS_CTL))[gt] = 0u;
    if (gt < 3456) ((unsigned*)(ws + WS_BAR))[gt] = 0u;
    for (int l = 0; l < 2; ++l) {
        bf16* b2 = (bf16*)(ws + WS_W + l * W_LSTRIDE + W_B2);
        for (int ch = gt; ch < 1024 * 48; ch += NGT) { const int n = ch / 48, k = (ch % 48) * 8;
            const bool data = (n < 384 && k < 192) || (n >= 384 && n < 896 && k >= 192 && k < 320);
            if (!data) *(u32x4*)(b2 + (size_t)n * 384 + k) = (u32x4){0u, 0u, 0u, 0u}; }
        bf16* wi = (bf16*)(ws + WS_W + l * W_LSTRIDE + W_IN) + (size_t)INC * 1024;
        for (int ch = gt; ch < 160 * 128; ch += NGT) *(u32x4*)(wi + (size_t)ch * 8) = (u32x4){0u, 0u, 0u, 0u};
    }
    LAS float* scr = (LAS float*)(lds + 28672 + wave * 16640);
    const int gw = bid * NW + wave, NGW = G * NW;
    constexpr int I_IN = 16 * 34, I_OUT = 16 * 16, I_UP = 16 * 88, I_DN = 44 * 16, I_Q = 3 * 6, I_KV = 2 * 8, I_L = I_IN + I_OUT + I_UP + I_DN + I_Q + I_KV;
    for (int it = gw; it < 2 * I_L; it += NGW) {
        const int l = it / I_L; int r = it % I_L;
        unsigned char* wl = ws + WS_W + l * W_LSTRIDE;
        if (r < I_IN) { transpose_item(a.in[13] + (size_t)l * 1024 * INC, INC, (bf16*)(wl + W_IN), 1024, 0, 0, 1.f, scr, r, lane); continue; } r -= I_IN;
        if (r < I_OUT) { transpose_item(a.in[22] + (size_t)l * 1024 * 1024, 1024, (bf16*)(wl + W_OUT), 1024, 0, 0, 1.f, scr, r, lane); continue; } r -= I_OUT;
        if (r < I_UP) { transpose_item(a.in[24] + (size_t)l * 1024 * DUP, DUP, (bf16*)(wl + W_UP), 1024, 0, 0, 1.f, scr, r, lane); continue; } r -= I_UP;
        if (r < I_DN) { transpose_item(a.in[26] + (size_t)l * DFF * 1024, 1024, (bf16*)(wl + W_DOWN), DFF, 0, 0, 1.f, scr, r, lane); continue; } r -= I_DN;
        if (r < I_Q) { transpose_item(a.in[16] + (size_t)l * 192 * 384, 384, (bf16*)(wl + W_B2), 384, 0, 0, MLAQS, scr, r, lane); continue; } r -= I_Q;
        transpose_item(a.in[18] + (size_t)l * 128 * 512, 512, (bf16*)(wl + W_B2), 384, 384, 192, 1.f, scr, r, lane);
    }
}

__device__ __forceinline__ void prep_phase(const float* x0, const float* x1, const float* nw, const float* mod, int sc_off, bf16* XN, float* SS, int lane, int gw, int NGW) {
    for (int row = gw; row < NTOK; row += NGW) {
        const float* xr = row < NPR ? x0 + (size_t)row * DM : x1 + (size_t)(row - NPR) * DM;
        const int c = row < NPR ? 0 : 1 + ((row - NPR) >> 11);
        const float* mp = mod + c * 6144;
        f32x4 v[4]; float ss = 0.f;
#pragma unroll
        for (int j = 0; j < 4; ++j) { v[j] = *(const f32x4*)(xr + 4 * (lane + 64 * j)); ss += dot4(v[j]); }
        ss = wave_sum(ss, lane);
#pragma unroll
        for (int j = 0; j < 4; ++j) { const int col = 4 * (lane + 64 * j);
            const f32x4 g = *(const f32x4*)(nw + col), sc = *(const f32x4*)(mp + sc_off + col);
            st4bf(XN + (size_t)row * DM + col, v[j] * g * (1.f + sc)); }
        if (lane < 16) SS[(size_t)row * 16 + lane] = lane == 0 ? ss : 0.f;
    }
}
__device__ __forceinline__ void bias_phase(unsigned char* ws, int lane, int gw, int NGW) {
    const float* mod = (const float*)(ws + WS_MOD);
    float* BIAS = (float*)(ws + WS_BIAS);
    constexpr int TPL = NBIAS / 4;
    for (int task = gw; task < 2 * TPL; task += NGW) {
        const int l = task / TPL, n0 = (task % TPL) * 4;
        const bool up = n0 >= 2304;
        const bf16* wt = (const bf16*)(ws + WS_W + l * W_LSTRIDE + (up ? W_UP : W_IN)) + (size_t)(up ? n0 - 2304 : n0) * 1024 + lane * 16;
        const float* shp = mod + (size_t)l * 3 * 6144 + (up ? 3072 : 0) + lane * 16;
        float wv[4][16];
#pragma unroll
        for (int r = 0; r < 4; ++r) { const u32x4 a = *(const u32x4*)(wt + (size_t)r * 1024), b = *(const u32x4*)(wt + (size_t)r * 1024 + 8);
            wv[r][0] = bflo(a.x); wv[r][1] = bfhi(a.x); wv[r][2] = bflo(a.y); wv[r][3] = bfhi(a.y); wv[r][4] = bflo(a.z); wv[r][5] = bfhi(a.z); wv[r][6] = bflo(a.w); wv[r][7] = bfhi(a.w);
            wv[r][8] = bflo(b.x); wv[r][9] = bfhi(b.x); wv[r][10] = bflo(b.y); wv[r][11] = bfhi(b.y); wv[r][12] = bflo(b.z); wv[r][13] = bfhi(b.z); wv[r][14] = bflo(b.w); wv[r][15] = bfhi(b.w); }
        float acc[3][4];
#pragma unroll
        for (int c = 0; c < 3; ++c) {
            float sh[16];
#pragma unroll
            for (int q = 0; q < 4; ++q) { const f32x4 t = *(const f32x4*)(shp + c * 6144 + 4 * q); sh[4 * q] = t[0]; sh[4 * q + 1] = t[1]; sh[4 * q + 2] = t[2]; sh[4 * q + 3] = t[3]; }
#pragma unroll
            for (int r = 0; r < 4; ++r) { float a = 0.f;
#pragma unroll
                for (int e = 0; e < 16; ++e) a += sh[e] * wv[r][e];
                acc[c][r] = a; }
        }
#pragma unroll
        for (int o = 1; o < 64; o <<= 1)
#pragma unroll
            for (int c = 0; c < 3; ++c)
#pragma unroll
                for (int r = 0; r < 4; ++r) acc[c][r] += shx(acc[c][r], o, lane);
        if (lane == 0) {
#pragma unroll
            for (int c = 0; c < 3; ++c) *(f32x4*)(BIAS + (size_t)(l * 3 + c) * NBIAS + n0) = (f32x4){acc[c][0], acc[c][1], acc[c][2], acc[c][3]};
        }
    }
}

struct P3Ptrs {
    const bf16* PROJ; bf16 *A2, *KPE, *YCAT, *Qc_rot, *Qc_raw, *Kc, *Vc, *Qd_rot, *Qd_raw, *Kd, *Vd;
    const float *conv_a, *gq_mla, *gkv_mla, *gq, *gk, *rope;
    const float *c_ckv, *c_kpe, *c_gk, *c_gv, *c_sk, *c_sv;
    float *o_ckv, *o_kpe, *o_gk, *o_gv, *o_sk, *o_sv;
    int l;
};
__device__ __forceinline__ f32x4 rope64(f32x4 v, int jl, int prow, int pcol, const float* rt, int lane) {
    const f32x4 pr = shfl4(v, 4, lane);
    const int pos = jl < 8 ? prow : pcol, fi = 4 * (jl & 3);
    const f32x4 c = *(const f32x4*)(rt + pos * 16 + fi), s = *(const f32x4*)(rt + 1024 + pos * 16 + fi);
    const float sg = (jl & 4) ? 1.f : -1.f;
    return v * c + pr * s * sg;
}
__device__ __forceinline__ void p3_phase(const P3Ptrs& P, int lane, int gw, int NGW) {
    const int l = P.l;
    for (int row = gw; row < NKR; row += NGW) {
        if (row < NTOK) {
            const bool samp = row >= NPR;
            int b, t, kr, T;
            if (!samp) { b = row >> 8; t = row & 255; kr = row; T = 256; } else { b = (row - NPR) >> 11; t = (row - NPR) & 2047; kr = NPR + b * 2560 + t; T = 2048; }
            const int prow = t >> 6, pcol = t & 63;
            const bf16* pr = P.PROJ + (size_t)row * INP;
            const size_t ob = (size_t)((b * 2 + l) * 256 + t);
            const int ci = 4 * lane, jl = lane & 15;
            const u32x2 z2 = (u32x2){0u, 0u};
            const bool hp = t > 0, hn = t < T - 1;
            const u32x2 r_xa = *(const u32x2*)(pr + ci), r_gb = *(const u32x2*)(pr + 256 + ci), r_gc = *(const u32x2*)(pr + 512 + ci);
            const u32x2 r_pxa = hp ? *(const u32x2*)(pr - INP + ci) : z2, r_pgc = hp ? *(const u32x2*)(pr - INP + 512 + ci) : z2;
            const u32x2 r_nxa = hn ? *(const u32x2*)(pr + INP + ci) : z2, r_ngc = hn ? *(const u32x2*)(pr + INP + 512 + ci) : z2;
            const u32x2 r_cq = lane < 48 ? *(const u32x2*)(pr + 768 + ci) : z2, r_ckv = lane < 32 ? *(const u32x2*)(pr + 960 + ci) : z2, r_kpe = lane < 8 ? *(const u32x2*)(pr + 1088 + ci) : z2;
            const u32x2 r_qc = *(const u32x2*)(pr + 1120 + ci), r_kvc = *(const u32x2*)(pr + 1376 + ci), r_qd = *(const u32x2*)(pr + 1632 + ci), r_kvd = *(const u32x2*)(pr + 1888 + ci);
            const float* cw = P.conv_a + (size_t)l * 768;
            const f32x4 w0 = *(const f32x4*)(cw + ci), w1 = *(const f32x4*)(cw + 256 + ci), w2 = *(const f32x4*)(cw + 512 + ci);
            const f32x4 g_qm = lane < 48 ? *(const f32x4*)(P.gq_mla + l * 192 + ci) : (f32x4){0.f, 0.f, 0.f, 0.f}, g_kvm = lane < 32 ? *(const f32x4*)(P.gkv_mla + l * 128 + ci) : (f32x4){0.f, 0.f, 0.f, 0.f};
            const f32x4 g_q = *(const f32x4*)(P.gq + l * 64 + 4 * jl), g_k = *(const f32x4*)(P.gk + l * 64 + 4 * jl);
            const int pos64 = jl < 8 ? prow : pcol, fi64 = 4 * (jl & 3);
            const f32x4 c64 = *(const f32x4*)(P.rope + pos64 * 16 + fi64), s64 = *(const f32x4*)(P.rope + 1024 + pos64 * 16 + fi64);
            const int pos32 = (lane & 7) < 4 ? prow : pcol, fi32 = 4 * (lane & 1);
            const f32x4 c32 = *(const f32x4*)(P.rope + 2048 + pos32 * 8 + fi32), s32 = *(const f32x4*)(P.rope + 2560 + pos32 * 8 + fi32);
#define CV4(u) ((f32x4){bflo((u).x), bfhi((u).x), bflo((u).y), bfhi((u).y)})
#define ROPE64(v) ((v) * c64 + shfl4((v), 4, lane) * s64 * ((jl & 4) ? 1.f : -1.f))
            { const f32x4 ya = CV4(r_gb) * (w0 * (CV4(r_pxa) * CV4(r_pgc)) + w1 * (CV4(r_xa) * CV4(r_gc)) + w2 * (CV4(r_nxa) * CV4(r_ngc)));
              st4bf(P.YCAT + (size_t)row * DM + ci, ya); }
            { const f32x4 v = CV4(r_cq);
              const float rs = rsqrtf(wave_sum(dot4(v), lane) * (1.f / 192.f) + EPS);
              if (lane < 48) st4bf(P.A2 + (size_t)kr * 384 + ci, v * rs * g_qm); }
            { const f32x4 v = CV4(r_ckv);
              const float rs = rsqrtf(wave_sum(dot4(v), lane) * (1.f / 128.f) + EPS);
              if (lane < 32) { const f32x4 o = v * rs * g_kvm;
                  st4bf(P.A2 + (size_t)kr * 384 + 192 + ci, o);
                  if (!samp) *(f32x4*)(P.o_ckv + ob * 128 + ci) = o; }
              else if (lane < 48) { unsigned zz = 0u; asm volatile("" : "+v"(zz)); *(u32x2*)(P.A2 + (size_t)kr * 384 + 320 + 4 * (lane - 32)) = (u32x2){zz, zz}; } }
            { const f32x4 v = CV4(r_kpe);
              const f32x4 r = v * c32 + shfl4(v, 2, lane) * s32 * ((lane & 2) ? 1.f : -1.f);
              if (lane < 8) { if (!samp) *(f32x4*)(P.o_kpe + ob * 32 + ci) = v; st4bf(P.KPE + (size_t)kr * 32 + ci, samp ? r : v); } }
            { f32x4 v = CV4(r_qc);
              const float rs = rsqrtf(sum16(dot4(v), lane) * (1.f / 64.f) + EPS);
              v = v * rs * g_q;
              st4bf(P.Qc_raw + (size_t)kr * 256 + ci, v * QS);
              const f32x4 r = ROPE64(v);
              if (samp) st4bf(P.Qc_rot + (size_t)kr * 256 + ci, r * QS); }
            { const f32x4 v = CV4(r_kvc);
              const float rs = rsqrtf(sum16(dot4(v), lane) * (1.f / 64.f) + EPS);
              const f32x4 kn = v * rs * g_k;
              const f32x4 r = ROPE64(kn);
              if (lane < 32) { if (!samp) *(f32x4*)(P.o_gk + ob * 128 + ci) = kn; st4bf(P.Kc + (size_t)kr * 128 + ci, samp ? r : kn); }
              else { if (!samp) *(f32x4*)(P.o_gv + ob * 128 + 4 * (lane - 32)) = v; st4bf(P.Vc + (size_t)kr * 128 + 4 * (lane - 32), v); } }
            { const f32x4 v = CV4(r_qd);
              st4bf(P.Qd_raw + (size_t)kr * 256 + ci, v * QS);
              const f32x4 r = ROPE64(v);
              if (samp) st4bf(P.Qd_rot + (size_t)kr * 256 + ci, r * QS); }
            { const f32x4 v = CV4(r_kvd);
              const f32x4 r = ROPE64(v);
              if (lane < 32) { if (!samp) *(f32x4*)(P.o_sk + ob * 128 + ci) = v; st4bf(P.Kd + (size_t)kr * 128 + ci, samp ? r : v); }
              else { if (!samp) *(f32x4*)(P.o_sv + ob * 128 + 4 * (lane - 32)) = v; st4bf(P.Vd + (size_t)kr * 128 + 4 * (lane - 32), v); } }
#undef CV4
#undef ROPE64
        } else {
            const int ci = row - NTOK, b = ci >> 9, j = ci & 511, kr = NPR + b * 2560 + 2048 + j;
            const size_t cb = (size_t)((b * 2 + l) * 512 + j);
            f32x4 z = (f32x4){0.f, 0.f, 0.f, 0.f}; asm volatile("" : "+v"(z));
            if (lane < 48) st4bf(P.A2 + (size_t)kr * 384 + 4 * lane, z);
            if (lane < 32) st4bf(P.A2 + (size_t)kr * 384 + 192 + 4 * lane, *(const f32x4*)(P.c_ckv + cb * 128 + 4 * lane));
            else if (lane < 48) st4bf(P.A2 + (size_t)kr * 384 + 320 + 4 * (lane - 32), z);
            if (lane < 8) st4bf(P.KPE + (size_t)kr * 32 + 4 * lane, *(const f32x4*)(P.c_kpe + cb * 32 + 4 * lane));
            if (lane < 32) { st4bf(P.Kc + (size_t)kr * 128 + 4 * lane, *(const f32x4*)(P.c_gk + cb * 128 + 4 * lane));
                             st4bf(P.Kd + (size_t)kr * 128 + 4 * lane, *(const f32x4*)(P.c_sk + cb * 128 + 4 * lane)); }
            else { st4bf(P.Vc + (size_t)kr * 128 + 4 * (lane - 32), *(const f32x4*)(P.c_gv + cb * 128 + 4 * (lane - 32)));
                   st4bf(P.Vd + (size_t)kr * 128 + 4 * (lane - 32), *(const f32x4*)(P.c_sv + cb * 128 + 4 * (lane - 32))); }
        }
    }
}

struct AttnSrc {
    const bf16* Qraw; const bf16* Qrot; int qpitch;
    const bf16* K0; int k0pitch; const bf16* K1;
    const bf16* V; int vpitch;
    bf16* Y; int outcol;
    int krbase, rowbase, q0, lo, hi, nctx;
    bool samp, window; float m0; bool sink;
    const float* rope;
};
template <int DK>
__device__ __forceinline__ void attn_unit(const AttnSrc& S, LAS unsigned char* lds, int tid, int lane, int wave) {
    constexpr int KP = DK + 8, VP = 68, KS = DK / 32, CPK = DK / 8;
    LAS bf16* Ks = (LAS bf16*)lds;
    LAS bf16* Vt = (LAS bf16*)(lds + 2 * 64 * KP * 2);
    const int g = lane >> 4, fr = lane & 15;
    const int qpos = S.q0 + wave * 16 + fr;
    const size_t qkr = (size_t)(S.krbase + qpos);
    bf16x8 qraw[KS], qrot[KS];
#pragma unroll
    for (int ks = 0; ks < KS; ++ks) { qraw[ks] = *(const bf16x8*)(S.Qraw + qkr * S.qpitch + ks * 32 + g * 8); qrot[ks] = qraw[ks]; }
    if (S.samp) {
        if (DK == 96) {
            const bf16x8 own = qraw[KS - 1], par = *(const bf16x8*)(S.Qraw + qkr * S.qpitch + 64 + (g ^ 1) * 8);
            const int pos = g < 2 ? (qpos >> 6) : (qpos & 63);
            const float sg = (g & 1) ? 1.f : -1.f;
            const float* ct = S.rope + 2048 + pos * 8; const float* st = S.rope + 2560 + pos * 8;
            bf16x8 r;
#pragma unroll
            for (int e = 0; e < 8; ++e) { const float o = bflo((unsigned)(unsigned short)own[e]), p = bflo((unsigned)(unsigned short)par[e]);
                r[e] = (short)f2bf(o * ct[e] + p * st[e] * sg); }
            qrot[KS - 1] = r;
        } else {
#pragma unroll
            for (int ks = 0; ks < KS; ++ks) qrot[ks] = *(const bf16x8*)(S.Qrot + qkr * S.qpitch + ks * 32 + g * 8);
        }
    }
    bf16x8 qc[KS];
#pragma unroll
    for (int ks = 0; ks < KS; ++ks) qc[ks] = S.samp ? qrot[ks] : qraw[ks];
    float m = S.m0, l = (S.sink && g == 0) ? 1.f : 0.f;
    f32x4 o[4];
#pragma unroll
    for (int d = 0; d < 4; ++d) o[d] = (f32x4){0.f, 0.f, 0.f, 0.f};
    const int nloc = S.hi - S.lo, ntile = nloc + S.nctx;
    u32x4 kreg0, kreg1, vreg;
    const int kc0 = tid, kc1 = tid + NT;
    const int key0 = kc0 / CPK, part0 = kc0 % CPK, key1 = kc1 / CPK, part1 = kc1 % CPK;
    const int vkey = tid & 63, vdc = tid >> 6;
    auto gload = [&](int j) {
        const int tile = j < nloc ? S.lo + j : 32 + (j - nloc);
        const size_t kr = (size_t)(S.krbase + tile * 64);
        if (DK == 64) { kreg0 = *(const u32x4*)(S.K0 + (kr + key0) * S.k0pitch + part0 * 8); }
        else {
            kreg0 = part0 < 8 ? *(const u32x4*)(S.K0 + (kr + key0) * S.k0pitch + part0 * 8) : *(const u32x4*)(S.K1 + (kr + key0) * 32 + (part0 - 8) * 8);
            if (kc1 < 64 * CPK) kreg1 = part1 < 8 ? *(const u32x4*)(S.K0 + (kr + key1) * S.k0pitch + part1 * 8) : *(const u32x4*)(S.K1 + (kr + key1) * 32 + (part1 - 8) * 8);
        }
        vreg = *(const u32x4*)(S.V + (kr + vkey) * S.vpitch + vdc * 8);
    };
    auto lstore = [&](int buf) {
        LAS bf16* kb = Ks + buf * 64 * KP; LAS bf16* vb = Vt + buf * 64 * VP;
        *(LAS u32x4*)(kb + key0 * KP + part0 * 8) = kreg0;
        if (DK == 96) { if (kc1 < 64 * CPK) *(LAS u32x4*)(kb + key1 * KP + part1 * 8) = kreg1; }
        LAS bf16* vp = vb + (vdc * 8) * VP + vkey;
        vp[0 * VP] = (bf16)(vreg.x & 0xffffu); vp[1 * VP] = (bf16)(vreg.x >> 16); vp[2 * VP] = (bf16)(vreg.y & 0xffffu); vp[3 * VP] = (bf16)(vreg.y >> 16);
        vp[4 * VP] = (bf16)(vreg.z & 0xffffu); vp[5 * VP] = (bf16)(vreg.z >> 16); vp[6 * VP] = (bf16)(vreg.w & 0xffffu); vp[7 * VP] = (bf16)(vreg.w >> 16);
    };
    gload(0); lstore(0);
    __syncthreads();
    for (int j = 0; j < ntile; ++j) {
        const int buf = j & 1;
        if (j + 1 < ntile) gload(j + 1);
        const bool loc = j < nloc;
        if (j == nloc) {
#pragma unroll
            for (int ks = 0; ks < KS; ++ks) qc[ks] = qraw[ks]; }
        const LAS bf16* kb = Ks + buf * 64 * KP; const LAS bf16* vb = Vt + buf * 64 * VP;
        f32x4 s[4];
#pragma unroll
        for (int kk = 0; kk < 4; ++kk) { s[kk] = (f32x4){0.f, 0.f, 0.f, 0.f};
#pragma unroll
            for (int ks = 0; ks < KS; ++ks) { const bf16x8 af = *(const LAS bf16x8*)(kb + (kk * 16 + fr) * KP + ks * 32 + g * 8);
                s[kk] = __builtin_amdgcn_mfma_f32_16x16x32_bf16(af, qc[ks], s[kk], 0, 0, 0); } }
        if (S.window && loc) {
            const int kp0 = (S.lo + j) * 64 + g * 4;
#pragma unroll
            for (int kk = 0; kk < 4; ++kk)
#pragma unroll
                for (int i = 0; i < 4; ++i) { const int d = kp0 + kk * 16 + i - qpos; if (d > 128 || d < -128) s[kk][i] = -INFINITY; }
        }
        float mx = -INFINITY;
#pragma unroll
        for (int kk = 0; kk < 4; ++kk) mx = fmaxf(mx, fmaxf(fmaxf(s[kk][0], s[kk][1]), fmaxf(s[kk][2], s[kk][3])));
        mx = fmaxf(mx, shx(mx, 16, lane)); mx = fmaxf(mx, shx(mx, 32, lane));
        const float mn = fmaxf(m, mx), alpha = __builtin_amdgcn_exp2f(m - mn);
        m = mn;
        float ls = 0.f;
#pragma unroll
        for (int kk = 0; kk < 4; ++kk)
#pragma unroll
            for (int i = 0; i < 4; ++i) { const float p = __builtin_amdgcn_exp2f(s[kk][i] - mn); s[kk][i] = p; ls += p; }
        l = l * alpha + ls;
#pragma unroll
        for (int d = 0; d < 4; ++d) o[d] = o[d] * alpha;
        bf16x8 pf[2];
#pragma unroll
        for (int pp = 0; pp < 2; ++pp) {
            const unsigned w0 = pk2(s[2 * pp][0], s[2 * pp][1]), w1 = pk2(s[2 * pp][2], s[2 * pp][3]), w2 = pk2(s[2 * pp + 1][0], s[2 * pp + 1][1]), w3 = pk2(s[2 * pp + 1][2], s[2 * pp + 1][3]);
            pf[pp] = __builtin_bit_cast(bf16x8, (u32x4){w0, w1, w2, w3});
        }
#pragma unroll
        for (int d = 0; d < 4; ++d)
#pragma unroll
            for (int pp = 0; pp < 2; ++pp) {
                const LAS bf16* vr = vb + (d * 16 + fr) * VP + pp * 32 + g * 4;
                const u32x2 lo = *(const LAS u32x2*)vr, hi = *(const LAS u32x2*)(vr + 16);
                const bf16x8 af = __builtin_bit_cast(bf16x8, (u32x4){lo.x, lo.y, hi.x, hi.y});
                o[d] = __builtin_amdgcn_mfma_f32_16x16x32_bf16(af, pf[pp], o[d], 0, 0, 0);
            }
        if (j + 1 < ntile) lstore(buf ^ 1);
        __syncthreads();
    }
    float lt = l + shx(l, 16, lane); lt += shx(lt, 32, lane);
    const float inv = 1.f / lt;
    bf16* yr = S.Y + (size_t)(S.rowbase + qpos) * DM + S.outcol + g * 4;
#pragma unroll
    for (int d = 0; d < 4; ++d) st4bf(yr + d * 16, o[d] * inv);
}

struct AttnBufs { const bf16 *MQKV, *KPE, *Qc_rot, *Qc_raw, *Kc, *Vc, *Qd_rot, *Qd_raw, *Kd, *Vd; bf16* YCAT; const float* sink; const float* rope; unsigned* ctr; };
constexpr int ATT_NU = 384 + 768;
__device__ __forceinline__ void attn_phase(const AttnBufs& B, LAS unsigned char* lds, int tid, int lane, int wave) {
    volatile LAS unsigned* shu = (volatile LAS unsigned*)(lds + LDS_CTL);
    for (;;) {
        if (tid == 0) *shu = atomicAdd(B.ctr, 1u);
        __syncthreads();
        const int u = (int)*shu;
        if (u >= ATT_NU) break;
        int type, b, h, qt; bool samp;
        if (u < 384) { type = u >> 7; const int v = u & 127; b = v >> 6; h = (v >> 4) & 3; qt = v & 15; samp = true; }
        else { const int w = u - 384; type = w >> 8; const int v = w & 255; b = v >> 3; h = (v >> 1) & 3; qt = v & 1; samp = false; }
        AttnSrc S;
        S.samp = samp; S.q0 = qt * 128; S.rope = B.rope; S.Y = B.YCAT;
        S.krbase = samp ? NPR + b * 2560 : b * 256; S.rowbase = samp ? NPR + b * 2048 : b * 256;
        S.window = false; S.sink = false; S.m0 = -1e30f;
        if (!samp) { S.lo = 0; S.hi = 4; S.nctx = 0; }
        else { S.lo = 0; S.hi = 32; S.nctx = 8; }
        if (type == 0) {
            S.Qraw = B.MQKV + h * 96; S.Qrot = S.Qraw; S.qpitch = 1024; S.K0 = B.MQKV + 384 + h * 128; S.k0pitch = 1024; S.K1 = B.KPE; S.V = B.MQKV + 384 + h * 128 + 64; S.vpitch = 1024; S.outcol = 256 + h * 64;
            attn_unit<96>(S, lds, tid, lane, wave);
        } else {
            if (type == 1) { S.Qraw = B.Qc_raw + h * 64; S.Qrot = B.Qc_rot + h * 64; S.K0 = B.Kc + (h >> 1) * 64; S.V = B.Vc + (h >> 1) * 64; S.outcol = 512 + h * 64; }
            else { S.Qraw = B.Qd_raw + h * 64; S.Qrot = B.Qd_rot + h * 64; S.K0 = B.Kd + (h >> 1) * 64; S.V = B.Vd + (h >> 1) * 64; S.outcol = 768 + h * 64;
                   S.sink = true; S.m0 = B.sink[h] * LOG2E;
                   if (samp) { S.window = true; const int lo = (S.q0 - 128) / 64; S.lo = lo < 0 ? 0 : lo; const int hi = (S.q0 + 256) / 64; S.hi = hi > 32 ? 32 : hi; } }
            S.qpitch = 256; S.k0pitch = 128; S.K1 = nullptr; S.vpitch = 128;
            attn_unit<64>(S, lds, tid, lane, wave);
        }
    }
}

__device__ __forceinline__ void load8(const bf16* p, float (&o)[8]) { const u32x4 u = *(const u32x4*)p; o[0] = bflo(u.x); o[1] = bfhi(u.x); o[2] = bflo(u.y); o[3] = bfhi(u.y); o[4] = bflo(u.z); o[5] = bfhi(u.z); o[6] = bflo(u.w); o[7] = bfhi(u.w); }
__device__ __forceinline__ void convgate_phase(const bf16* U, const float* cf, bf16* ACT, int gt, int NGT) {
    constexpr int NCH = DFF / 8, RG = 8;
    for (int it = gt; it < (NTOK / RG) * NCH; it += NGT) {
        const int rg = it / NCH, cc = it % NCH, r0 = rg * RG, col = cc * 8;
        const bool samp = r0 >= NPR; const int t0 = samp ? ((r0 - NPR) & 2047) : (r0 & 255), T = samp ? 2048 : 256;
        const bf16* up = U + (size_t)r0 * DUP + col;
        u32x4 ra[RG + 2], rb[RG + 2];
        const u32x4 z4 = (u32x4){0u, 0u, 0u, 0u};
        ra[0] = z4; rb[0] = z4; ra[RG + 1] = z4; rb[RG + 1] = z4;
        if (t0 > 0) { ra[0] = *(const u32x4*)(up - DUP); rb[0] = *(const u32x4*)(up - DUP + DFF); }
#pragma unroll
        for (int i = 0; i < RG; ++i) { ra[i + 1] = *(const u32x4*)(up + (size_t)i * DUP); rb[i + 1] = *(const u32x4*)(up + (size_t)i * DUP + DFF); }
        if (t0 + RG < T) { ra[RG + 1] = *(const u32x4*)(up + (size_t)RG * DUP); rb[RG + 1] = *(const u32x4*)(up + (size_t)RG * DUP + DFF); }
        float wa[3][8], wb[3][8];
#pragma unroll
        for (int k = 0; k < 3; ++k) { const f32x4 a0 = *(const f32x4*)(cf + k * DUP + col), a1 = *(const f32x4*)(cf + k * DUP + col + 4), b0 = *(const f32x4*)(cf + k * DUP + DFF + col), b1 = *(const f32x4*)(cf + k * DUP + DFF + col + 4);
#pragma unroll
            for (int e = 0; e < 4; ++e) { wa[k][e] = a0[e]; wa[k][4 + e] = a1[e]; wb[k][e] = b0[e]; wb[k][4 + e] = b1[e]; } }
#pragma unroll
        for (int i = 0; i < RG; ++i) {
            float r[8];
#pragma unroll
            for (int h = 0; h < 4; ++h) {
                const unsigned pa = ra[i][h], ca = ra[i + 1][h], na = ra[i + 2][h], pb = rb[i][h], cb = rb[i + 1][h], nb = rb[i + 2][h];
                const float xa0 = wa[0][2 * h] * bflo(pa) + wa[1][2 * h] * bflo(ca) + wa[2][2 * h] * bflo(na), xb0 = wb[0][2 * h] * bflo(pb) + wb[1][2 * h] * bflo(cb) + wb[2][2 * h] * bflo(nb);
                const float xa1 = wa[0][2 * h + 1] * bfhi(pa) + wa[1][2 * h + 1] * bfhi(ca) + wa[2][2 * h + 1] * bfhi(na), xb1 = wb[0][2 * h + 1] * bfhi(pb) + wb[1][2 * h + 1] * bfhi(cb) + wb[2][2 * h + 1] * bfhi(nb);
                r[2 * h] = xa0 * __builtin_amdgcn_rcpf(1.f + __builtin_amdgcn_exp2f(-xa0 * LOG2E)) * xb0;
                r[2 * h + 1] = xa1 * __builtin_amdgcn_rcpf(1.f + __builtin_amdgcn_exp2f(-xa1 * LOG2E)) * xb1;
            }
            u32x4 w; w.x = pk2(r[0], r[1]); w.y = pk2(r[2], r[3]); w.z = pk2(r[4], r[5]); w.w = pk2(r[6], r[7]);
            *(u32x4*)(ACT + (size_t)(r0 + i) * DFF + col) = w;
        }
    }
}

#define XB_TMO      128
#define XB_XCNT(j)  (256  + 64 * (j))
#define XB_XSUB(j)  (1280 + 64 * (j))
#define XB_XGEN(j)  (2304 + 64 * (j))
#define XB_TOP      3328
#define XB_TOPGEN   3392
#define XCD_BAR_WORDS 3456
#define XB_SPIN_CAP (1u << 20)
__device__ __forceinline__ unsigned xb_ld(unsigned* p)              { return __hip_atomic_load(p, __ATOMIC_RELAXED, __HIP_MEMORY_SCOPE_AGENT); }
__device__ __forceinline__ unsigned xb_add(unsigned* p, unsigned v) { return __hip_atomic_fetch_add(p, v, __ATOMIC_RELAXED, __HIP_MEMORY_SCOPE_AGENT); }
__device__ __forceinline__ unsigned xb_xcc_id() { return (unsigned)__builtin_amdgcn_s_getreg((3 << 11) | 20) & 0xFu; }
#define XB_SPIN(cond, bar) do { unsigned _sp = 0; while (cond) { __builtin_amdgcn_s_sleep(1); \
    if ((++_sp & 255u) == 0u) { if (xb_ld(&(bar)[XB_TMO])) break; if (_sp > XB_SPIN_CAP) { atomicAdd(&(bar)[XB_TMO], 1u); break; } } } } while (0)
struct XcdBarrier { unsigned* bar; unsigned x; volatile LAS unsigned* st; };
__device__ __forceinline__ void xcd_barrier_complete(unsigned* bar, unsigned x, unsigned& nloc, unsigned& nx) {
    const unsigned G = gridDim.x * gridDim.y * gridDim.z;
    unsigned sum, cnt, mine, sp = 0u;
    for (;;) {
        sum = 0u; cnt = 0u; mine = 0u;
#pragma unroll
        for (unsigned j = 0; j < 16; ++j) { const unsigned c = xb_ld(&bar[XB_XCNT(j)]); sum += c; cnt += (c > 0u) ? 1u : 0u; mine = (j == x) ? c : mine; }
        if (sum == G) break;
        __builtin_amdgcn_s_sleep(1);
        if ((++sp & 255u) == 0u) { if (xb_ld(&bar[XB_TMO])) break; if (sp > XB_SPIN_CAP) { atomicAdd(&bar[XB_TMO], 1u); break; } }
    }
    nloc = mine > 0u ? mine : 1u; nx = cnt > 0u ? cnt : 1u;
}
__device__ __forceinline__ void xcd_barrier(const XcdBarrier& b, const int tid_) {
    asm volatile("s_waitcnt vmcnt(0)" ::: "memory");
    __syncthreads();
    if (tid_ == 0) {
        unsigned* bar = b.bar;
        __builtin_amdgcn_s_waitcnt(0);
        unsigned nloc = b.st[0], nx = b.st[1];
        if (nloc == 0u) { xcd_barrier_complete(bar, b.x, nloc, nx); b.st[0] = nloc; b.st[1] = nx; }
        const unsigned old = xb_add(&bar[XB_XSUB(b.x)], 1u);
        const unsigned gen = old / nloc;
        if (old + 1u == (gen + 1u) * nloc) {
            __builtin_amdgcn_fence(__ATOMIC_RELEASE, "agent");
            asm volatile("s_waitcnt vmcnt(0)" ::: "memory");
            const unsigned og = xb_add(&bar[XB_TOP], 1u);
            const unsigned tg = og / nx;
            if (og + 1u == (tg + 1u) * nx) xb_add(&bar[XB_TOPGEN], 1u);
            else XB_SPIN(xb_ld(&bar[XB_TOPGEN]) == tg, bar);
            __builtin_amdgcn_fence(__ATOMIC_ACQUIRE, "agent");
            xb_add(&bar[XB_XGEN(b.x)], 1u);
            asm volatile("s_waitcnt vmcnt(0)" ::: "memory");
        } else {
            XB_SPIN(xb_ld(&bar[XB_XGEN(b.x)]) == gen, bar);
            __builtin_amdgcn_fence(__ATOMIC_ACQUIRE, "agent");
            asm volatile("s_waitcnt vmcnt(0)" ::: "memory");
        }
    }
    __syncthreads();
}

__device__ __forceinline__ int lane_id_volatile() { int l; asm volatile("v_mbcnt_lo_u32_b32 %0, -1, 0\n\tv_mbcnt_hi_u32_b32 %0, -1, %0" : "=v"(l)); return l; }

#ifndef PH
#define PH 0xFFFF
#endif
#define ON(k) ((PH >> (k)) & 1)
#ifndef REP
#define REP 0
#endif
#define NREP(k) (1 + ((REP >> (k)) & 1))
__global__ void __launch_bounds__(NT, 2) mega_fwd(Args a_unused) {
    extern __shared__ __attribute__((aligned(16))) unsigned char lds[];
    cg::grid_group grid = cg::this_grid();
    const int G = gridDim.x, bid = blockIdx.x;
    const int wave_s = __builtin_amdgcn_readfirstlane(threadIdx.x >> 6);
    PG8_LAS unsigned char* ring = (PG8_LAS unsigned char*)lds;
#define PHASE_BEGIN int tid = wave_s * 64 + lane_id_volatile(); asm volatile("" : "+v"(tid)); const CAS Args* ap_ = (const CAS Args*)__builtin_amdgcn_kernarg_segment_ptr(); asm volatile("" : "+s"(ap_)); const CAS Args& a = *ap_; unsigned char* ws = a.ws; float* out = a.out; \
    const int lane = tid & 63, wave = __builtin_amdgcn_readfirstlane(tid >> 6); const int gw = bid * NW + wave, NGW = G * NW, gt = bid * NT + tid, NGT = G * NT; \
    (void)lane; (void)wave; (void)gw; (void)NGW; (void)gt; (void)NGT; (void)out; \
    const float* mod = (const float*)(ws + WS_MOD); const float* rope = (const float*)(ws + WS_ROPE); (void)mod; (void)rope; \
    bf16* XN = (bf16*)(ws + WS_XN); bf16* PROJ = (bf16*)(ws + WS_PROJ); bf16* A2 = (bf16*)(ws + WS_A2); bf16* MQKV = (bf16*)(ws + WS_MQKV); \
    bf16* KPE = (bf16*)(ws + WS_KPE); bf16* YCAT = (bf16*)(ws + WS_YCAT); bf16* ACT = (bf16*)(ws + WS_ACT); bf16* U = (bf16*)(ws + WS_U); \
    bf16* Qc_rot = (bf16*)(ws + WS_QC); bf16* Qc_raw = (bf16*)(ws + WS_QC + QSZ); bf16* Kc = (bf16*)(ws + WS_QC + 2 * QSZ); bf16* Vc = (bf16*)(ws + WS_QC + 2 * QSZ + KSZ); \
    bf16* Qd_rot = (bf16*)(ws + WS_QC + 2 * QSZ + 2 * KSZ); bf16* Qd_raw = Qd_rot + (size_t)NKR * 256; bf16* Kd = Qd_raw + (size_t)NKR * 256; bf16* Vd = Kd + (size_t)NKR * 128; \
    (void)XN; (void)PROJ; (void)A2; (void)MQKV; (void)KPE; (void)YCAT; (void)ACT; (void)U; (void)Qc_rot; (void)Qc_raw; (void)Kc; (void)Vc; (void)Qd_rot; (void)Qd_raw; (void)Kd; (void)Vd;
#define GSYNC() do { const CAS Args* bp_ = (const CAS Args*)__builtin_amdgcn_kernarg_segment_ptr(); asm volatile("" : "+s"(bp_)); XcdBarrier xb_; xb_.bar = (unsigned*)(bp_->ws + WS_BAR); xb_.x = xb_xcc_id(); \
    xb_.st = (volatile LAS unsigned*)((LAS unsigned char*)lds + LDS_CTL + 32); xcd_barrier(xb_, wave_s * 64 + lane_id_volatile()); } while (0)
#define LAYER_VALS const float* modl = mod + (size_t)l * 3 * 6144; unsigned char* wl = ws + WS_W + l * W_LSTRIDE; (void)modl; (void)wl; \
    const float* x0 = l == 0 ? a.in[0] : out; const float* x1 = l == 0 ? a.in[1] : out + (size_t)NPR * DM; (void)x0; (void)x1;

    if (threadIdx.x < 16) ((volatile LAS unsigned*)((LAS unsigned char*)lds + LDS_CTL))[threadIdx.x] = 0u;
    __syncthreads();
    for (int rep = 0; rep < NREP(0); ++rep) {
    if (ON(0)) { PHASE_BEGIN phase0(a, (LAS unsigned char*)lds, tid, lane, wave); }
    if (rep == 0) { grid.sync(); { PHASE_BEGIN if (tid == 0) (void)xb_add((unsigned*)(ws + WS_BAR) + XB_XCNT(xb_xcc_id()), 1u); } } else GSYNC(); }

    if (ON(1)) { PHASE_BEGIN bias_phase(ws, lane, gw, NGW);
        prep_phase(a.in[0], a.in[1], a.in[12], mod, 1024, XN, (float*)(ws + WS_SS1), lane, gw, NGW); }
    GSYNC();
#pragma unroll
    for (int l = 0; l < 2; ++l) {
        for (int rep = 0; rep < NREP(2); ++rep) {
        if (ON(2)) { PHASE_BEGIN LAYER_VALS pg8::Gemm g{XN, (const bf16*)(wl + W_IN), NTOK, INP, DM}; pg8::StaticOrder S; S.init(NTOK, INP, G, bid);
          pg8::EpiBf16RS E{PROJ, INP, (const float*)(ws + WS_SS1), (const float*)(ws + WS_BIAS) + (size_t)l * 3 * NBIAS, NBIAS};
          pg8::gemm_phase<pg8::EpiBf16RS, pg8::StaticOrder, true, true>(ring, g, S, E, tid); }
        GSYNC(); }
        for (int rep = 0; rep < NREP(3); ++rep) {
        if (ON(3)) { PHASE_BEGIN P3Ptrs P; P.PROJ = PROJ; P.A2 = A2; P.KPE = KPE; P.YCAT = YCAT; P.Qc_rot = Qc_rot; P.Qc_raw = Qc_raw; P.Kc = Kc; P.Vc = Vc; P.Qd_rot = Qd_rot; P.Qd_raw = Qd_raw; P.Kd = Kd; P.Vd = Vd;
          P.conv_a = a.in[14]; P.gq_mla = a.in[15]; P.gkv_mla = a.in[17]; P.gq = a.in[19]; P.gk = a.in[20]; P.rope = rope;
          P.c_ckv = a.in[2]; P.c_kpe = a.in[3]; P.c_gk = a.in[4]; P.c_gv = a.in[5]; P.c_sk = a.in[6]; P.c_sv = a.in[7];
          P.o_ckv = out + 12582912; P.o_kpe = out + 14680064; P.o_gk = out + 15204352; P.o_gv = out + 17301504; P.o_sk = out + 19398656; P.o_sv = out + 21495808; P.l = l;
          p3_phase(P, lane, gw, NGW); }
        GSYNC(); }
        for (int rep = 0; rep < NREP(4); ++rep) {
        if (ON(4)) { PHASE_BEGIN LAYER_VALS pg8::Gemm g{A2, (const bf16*)(wl + W_B2), NKR, 1024, 384}; pg8::StaticOrder S; S.init(NKR, 1024, G, bid); pg8::EpiBf16 E{MQKV, 1024};
          pg8::gemm_phase<pg8::EpiBf16, pg8::StaticOrder, true, true>(ring, g, S, E, tid); }
        GSYNC(); }
        for (int rep = 0; rep < NREP(5); ++rep) {
        if (ON(5)) { PHASE_BEGIN AttnBufs B; B.MQKV = MQKV; B.KPE = KPE; B.Qc_rot = Qc_rot; B.Qc_raw = Qc_raw; B.Kc = Kc; B.Vc = Vc; B.Qd_rot = Qd_rot; B.Qd_raw = Qd_raw; B.Kd = Kd; B.Vd = Vd; B.YCAT = YCAT;
          B.sink = a.in[21] + l * 4; B.rope = rope; B.ctr = (unsigned*)(ws + WS_CTL) + 64 * l + 128 * rep;
          attn_phase(B, (LAS unsigned char*)lds, tid, lane, wave); }
        GSYNC(); }
        if (ON(6)) { PHASE_BEGIN LAYER_VALS pg8::Gemm g{YCAT, (const bf16*)(wl + W_OUT), NTOK, DM, DM}; pg8::StaticOrder S; S.init(NTOK, DM, G, bid);
          pg8::EpiResid E{x0, x1, out, modl + 2048, XN, (float*)(ws + WS_SS2), a.in[23] + l * DM, modl + 4096};
          pg8::gemm_phase<pg8::EpiResid, pg8::StaticOrder, true, true>(ring, g, S, E, tid); }
        GSYNC();
        for (int rep = 0; rep < NREP(8); ++rep) {
        if (ON(8)) { PHASE_BEGIN LAYER_VALS pg8::Gemm g{XN, (const bf16*)(wl + W_UP), NTOK, DUP, DM}; pg8::StaticOrder S; S.init(NTOK, DUP, G, bid);
          pg8::EpiBf16RS E{U, DUP, (const float*)(ws + WS_SS2), (const float*)(ws + WS_BIAS) + (size_t)l * 3 * NBIAS + 2304, NBIAS};
          pg8::gemm_phase<pg8::EpiBf16RS, pg8::StaticOrder, true, true>(ring, g, S, E, tid); }
        GSYNC(); }
        for (int rep = 0; rep < NREP(9); ++rep) {
        if (ON(9)) { PHASE_BEGIN convgate_phase(U, a.in[25] + (size_t)l * 3 * DUP, ACT, gt, NGT); }
        GSYNC(); }
        if (ON(10)) { PHASE_BEGIN LAYER_VALS pg8::Gemm g{ACT, (const bf16*)(wl + W_DOWN), NTOK, DM, DFF}; pg8::StaticOrder S; S.init(NTOK, DM, G, bid);
          pg8::EpiResid E{out, out + (size_t)NPR * DM, out, modl + 5120, l == 0 ? XN : nullptr, (float*)(ws + WS_SS1), a.in[12] + DM, mod + (size_t)3 * 6144 + 1024};
          pg8::gemm_phase<pg8::EpiResid, pg8::StaticOrder, true, true>(ring, g, S, E, tid); }
        GSYNC();
    }
#ifdef XSYNC
    for (int i = 0; i < XSYNC; ++i) GSYNC();
#endif
    { PHASE_BEGIN
    for (int row = gw; row < NTOK; row += NGW) {
        float* xr = out + (size_t)row * DM;
        f32x4 v[4]; float ss = 0.f;
#pragma unroll
        for (int j = 0; j < 4; ++j) { v[j] = *(const f32x4*)(xr + 4 * (lane + 64 * j)); ss += dot4(v[j]); }
        const float rs = rsqrtf(wave_sum(ss, lane) * (1.f / DM) + EPS);
#pragma unroll
        for (int j = 0; j < 4; ++j) { const int col = 4 * (lane + 64 * j); *(f32x4*)(xr + col) = v[j] * rs * *(const f32x4*)(a.in[27] + col); }
    } }
}

extern "C" void kernel_launch(void* const* d_in, const int* in_sizes, int n_in, void* d_out, int out_size, void* d_ws, size_t ws_size, hipStream_t stream) {
    static int grid = 0;
    if (grid == 0) {
        if (n_in != 28 || ws_size < WS_END) { fprintf(stderr, "kernel_launch: unexpected n_in %d / ws %zu\n", n_in, ws_size); grid = -1; return; }
        int dev = 0, cus = 0, per_cu = 0;
        hipGetDevice(&dev); hipDeviceGetAttribute(&cus, hipDeviceAttributeMultiprocessorCount, dev);
        hipFuncSetAttribute((const void*)mega_fwd, hipFuncAttributeMaxDynamicSharedMemorySize, LDS_BYTES);
        hipOccupancyMaxActiveBlocksPerMultiprocessor(&per_cu, (const void*)mega_fwd, NT, LDS_BYTES);
        if (per_cu < 1) per_cu = 1;
        grid = cus * per_cu;
        (void)hipGetLastError();
    }
    if (grid < 0) return;
    Args a{};
    for (int i = 0; i < 28; ++i) a.in[i] = (const float*)d_in[i];
    a.out = (float*)d_out; a.ws = (unsigned char*)d_ws;
    void* args[] = {&a};
    hipError_t e = hipLaunchCooperativeKernel((const void*)mega_fwd, dim3(grid), dim3(NT), args, LDS_BYTES, stream);
    if (e != hipSuccess) fprintf(stderr, "cooperative launch failed: %s (grid %d)\n", hipGetErrorString(e), grid);
}
```

```cpp
#include <hip/hip_runtime.h>
#include <hip/hip_cooperative_groups.h>
#include <cstdio>
#include <cstdint>
namespace cg = cooperative_groups;

namespace pg8 {
#define PG8_LAS __attribute__((address_space(3)))
typedef unsigned short bf16_t;
typedef short bf16x8 __attribute__((ext_vector_type(8)));
typedef float f32x4 __attribute__((ext_vector_type(4)));
typedef unsigned u32x4 __attribute__((ext_vector_type(4)));
constexpr int BM = 256, BK = 64, HALF = 128, HTB = HALF * BK * 2, STAGE_BYTES = 8 * HTB, NXCD = 8, WGM = 8;

__host__ __device__ __forceinline__ int lds_byte(int r, int c) { const int st = (r >> 4) * 2 + (c >> 5), rr = r & 15, cc = c & 31, ob = rr * 64 + cc * 2; return st * 1024 + (ob ^ (((ob >> 9) & 1) << 5)); }
__host__ __device__ __forceinline__ void stage_rc(int b, int& R, int& C) { const int st = b / 1024, sb = b % 1024, swz = sb ^ (((sb >> 9) & 1) << 5); R = (st >> 1) * 16 + swz / 64; C = (st & 1) * 32 + (swz % 64) / 2; }
__host__ __device__ __forceinline__ int perm32(int rho) { const int n = rho >> 4, i = rho & 15; return 8 * (i >> 2) + 4 * n + (i & 3); }

struct Unit { int pm, pn; };
struct Gemm { const bf16_t* A; const bf16_t* Bt; int M, N, K; size_t bstep, bhalf; };

struct StaticOrder {
    int nM, nN, nwg, G, c;
    __host__ __device__ __forceinline__ void init(int M, int N, int G_, int c_) { nM = M / BM; nN = N / BM; nwg = nM * nN; G = G_; c = c_; }
    __host__ __device__ __forceinline__ bool next(int i, Unit& u) const {
        const long L = (long)i * G + c; if (L >= nwg) return false;
        int wgid = (int)L; { const int q = nwg / NXCD, r = nwg % NXCD, xcd = wgid % NXCD, off = wgid / NXCD; wgid = (xcd < r ? xcd * (q + 1) : r * (q + 1) + (xcd - r) * q) + off; }
        const int nig = WGM * nN, gid = wgid / nig, fm = gid * WGM, gsz = (nM - fm) < WGM ? (nM - fm) : WGM;
        u.pm = fm + ((wgid % nig) % gsz); u.pn = (wgid % nig) / gsz; return true;
    }
    __device__ __forceinline__ void a_ready(const Unit&) const {}
    __device__ __forceinline__ void done(const Unit&) const {}
};

__device__ __forceinline__ unsigned cvt_pk_bf16(float lo, float hi) { unsigned r; asm volatile("v_cvt_pk_bf16_f32 %0, %1, %2" : "=v"(r) : "v"(lo), "v"(hi)); return r; }

struct EpiBf16 {
    static constexpr bool PERM = true, AFTER_DRAIN = false;
    bf16_t* O; int ldc;
    __device__ __forceinline__ void operator()(const f32x4 (&acc)[2][2][4][2], const Unit& u, int wr, int wc, int fr, int fq) const {
        asm volatile("" : "+v"(fr), "+v"(fq));
        const int row0 = u.pm * BM + wr * 64 + fr; const int col0 = u.pn * BM + wc * 32 + 8 * fq;
#pragma unroll
        for (int ai = 0; ai < 2; ++ai)
#pragma unroll
            for (int m = 0; m < 4; ++m) { bf16_t* rowp = O + (size_t)(row0 + ai * HALF + m * 16) * ldc + col0;
#pragma unroll
                for (int bj = 0; bj < 2; ++bj) { const f32x4 v0 = acc[ai][bj][m][0], v1 = acc[ai][bj][m][1];
                    u32x4 w; w.x = cvt_pk_bf16(v0[0], v0[1]); w.y = cvt_pk_bf16(v0[2], v0[3]); w.z = cvt_pk_bf16(v1[0], v1[1]); w.w = cvt_pk_bf16(v1[2], v1[3]);
                    *(u32x4*)(rowp + bj * HALF) = w; } }
    }
};
__device__ __forceinline__ float shx_(float v, int m, int lane) { return __builtin_bit_cast(float, __builtin_amdgcn_ds_bpermute((lane ^ m) << 2, __builtin_bit_cast(int, v))); }
__device__ __forceinline__ void row_scales(const float* SS, int row0, int fr, int fq, float (&rs)[8]) {
    f32x4 t[8];
#pragma unroll
    for (int q = 0; q < 8; ++q) t[q] = *(const f32x4*)(SS + (size_t)(row0 + (q >> 2) * HALF + (q & 3) * 16) * 16 + 4 * fq);
    const int lane = fq * 16 + fr;
#pragma unroll
    for (int q = 0; q < 8; ++q) { float v = (t[q][0] + t[q][1]) + (t[q][2] + t[q][3]); v += shx_(v, 16, lane); v += shx_(v, 32, lane); rs[q] = __builtin_amdgcn_rsqf(v * (1.f / 1024.f) + 1e-6f); }
}
struct EpiBf16RS {
    static constexpr bool PERM = true, AFTER_DRAIN = false;
    bf16_t* O; int ldc; const float* SS; const float* bias; int ldb;
    __device__ __forceinline__ void operator()(const f32x4 (&acc)[2][2][4][2], const Unit& u, int wr, int wc, int fr, int fq) const {
        asm volatile("" : "+v"(fr), "+v"(fq));
        const int cnd = u.pm < 32 ? 0 : 1 + ((u.pm - 32) >> 3);
        const int row0 = u.pm * BM + wr * 64 + fr; const int col0 = u.pn * BM + wc * 32 + 8 * fq;
        const float* bp = bias + (size_t)cnd * ldb + col0;
        f32x4 bv[2][2];
#pragma unroll
        for (int bj = 0; bj < 2; ++bj)
#pragma unroll
            for (int n = 0; n < 2; ++n) bv[bj][n] = *(const f32x4*)(bp + bj * HALF + 4 * n);
        float rsv[8]; row_scales(SS, row0, fr, fq, rsv);
#pragma unroll
        for (int ai = 0; ai < 2; ++ai)
#pragma unroll
            for (int m = 0; m < 4; ++m) { const int row = row0 + ai * HALF + m * 16; const float rs = rsv[ai * 4 + m];
                bf16_t* rowp = O + (size_t)row * ldc + col0;
#pragma unroll
                for (int bj = 0; bj < 2; ++bj) { const f32x4 v0 = acc[ai][bj][m][0] * rs + bv[bj][0], v1 = acc[ai][bj][m][1] * rs + bv[bj][1];
                    u32x4 w; w.x = cvt_pk_bf16(v0[0], v0[1]); w.y = cvt_pk_bf16(v0[2], v0[3]); w.z = cvt_pk_bf16(v1[0], v1[1]); w.w = cvt_pk_bf16(v1[2], v1[3]);
                    *(u32x4*)(rowp + bj * HALF) = w; } }
    }
};
struct EpiResid {
    static constexpr bool PERM = false, AFTER_DRAIN = false;
    const float* r0; const float* r1; float* out; const float* gate;
    bf16_t* XN; float* SS; const float* nrm; const float* sc;
    __device__ __forceinline__ void operator()(const f32x4 (&acc)[2][2][4][2], const Unit& u, int wr, int wc, int fr, int fq) const {
        asm volatile("" : "+v"(fr), "+v"(fq));
        const int cnd = u.pm < 32 ? 0 : 1 + ((u.pm - 32) >> 3);
        const float* gp = gate + cnd * 6144;
        const int col0 = u.pn * BM + wc * 32 + 4 * fq;
        const int rowb = u.pm * BM + wr * 64 + fr;
        const float* rs = (u.pm < 32 ? r0 + (size_t)rowb * 1024 : r1 + (size_t)(rowb - 8192) * 1024) + col0;
        float* op = out + (size_t)rowb * 1024 + col0;
        const bool prep = XN != nullptr;
        f32x4 gv[2][2], hv[2][2];
#pragma unroll
        for (int bj = 0; bj < 2; ++bj)
#pragma unroll
            for (int n = 0; n < 2; ++n) { gv[bj][n] = *(const f32x4*)(gp + col0 + bj * HALF + n * 16);
                hv[bj][n] = (f32x4){0.f, 0.f, 0.f, 0.f};
                if (prep) hv[bj][n] = *(const f32x4*)(nrm + col0 + bj * HALF + n * 16) * (1.f + *(const f32x4*)(sc + cnd * 6144 + col0 + bj * HALF + n * 16)); }
        f32x4 xc[2][2], xn[2][2];
#pragma unroll
        for (int bj = 0; bj < 2; ++bj)
#pragma unroll
            for (int n = 0; n < 2; ++n) xc[bj][n] = *(const f32x4*)(rs + bj * HALF + n * 16);
#pragma unroll
        for (int it = 0; it < 8; ++it) { const int ai = it >> 2, m = it & 3; const size_t ro = (size_t)(ai * HALF + m * 16) * 1024;
            if (it < 7) { const int ai2 = (it + 1) >> 2, m2 = (it + 1) & 3; const size_t ro2 = (size_t)(ai2 * HALF + m2 * 16) * 1024;
#pragma unroll
                for (int bj = 0; bj < 2; ++bj)
#pragma unroll
                    for (int n = 0; n < 2; ++n) xn[bj][n] = *(const f32x4*)(rs + ro2 + bj * HALF + n * 16); }
            float ssq = 0.f;
#pragma unroll
            for (int bj = 0; bj < 2; ++bj)
#pragma unroll
                for (int n = 0; n < 2; ++n) { const f32x4 v = xc[bj][n] + gv[bj][n] * acc[ai][bj][m][n];
                    *(f32x4*)(op + ro + bj * HALF + n * 16) = v;
                    if (prep) { ssq += (v[0] * v[0] + v[1] * v[1]) + (v[2] * v[2] + v[3] * v[3]); const f32x4 h = v * hv[bj][n];
                        unsigned w0 = cvt_pk_bf16(h[0], h[1]), w1 = cvt_pk_bf16(h[2], h[3]);
                        typedef unsigned u32x2_ __attribute__((ext_vector_type(2)));
                        *(u32x2_*)(XN + (size_t)(rowb + ai * HALF + m * 16) * 1024 + col0 + bj * HALF + n * 16) = (u32x2_){w0, w1}; } }
            if (prep) { const int lane = fq * 16 + fr; ssq += shx_(ssq, 16, lane); ssq += shx_(ssq, 32, lane);
                if (fq == 0) SS[(size_t)(rowb + ai * HALF + m * 16) * 16 + u.pn * 4 + wc] = ssq; }
#pragma unroll
            for (int bj = 0; bj < 2; ++bj)
#pragma unroll
                for (int n = 0; n < 2; ++n) xc[bj][n] = xn[bj][n];
        }
    }
};

__device__ __forceinline__ float dpp_ror1(float v) { return __builtin_bit_cast(float, __builtin_amdgcn_mov_dpp(__builtin_bit_cast(int, v), 0x121, 0xf, 0xf, false)); }
__device__ __forceinline__ float dpp_ror15(float v) { return __builtin_bit_cast(float, __builtin_amdgcn_mov_dpp(__builtin_bit_cast(int, v), 0x12f, 0xf, 0xf, false)); }
struct EpiUpGate {
    static constexpr bool PERM = true, AFTER_DRAIN = false;
    bf16_t* ACT; const float* SS; const float* bias; int ldb; const float* cw; float* HALO; PG8_LAS unsigned char* xb;
    __device__ __forceinline__ void operator()(f32x4 (&acc)[2][2][4][2], const Unit& u, int wr, int wc, int fr, int fq) const {
        asm volatile("" : "+v"(fr), "+v"(fq));
        const int cnd = u.pm < 32 ? 0 : 1 + ((u.pm - 32) >> 3);
        const bool samp = u.pm >= 32;
        const int j0 = u.pn * HALF + wc * 32 + 8 * fq;
        const int row0 = u.pm * BM + wr * 64 + fr;
        { const float* bp = bias + (size_t)cnd * ldb + j0;
          f32x4 bv[2][2];
#pragma unroll
          for (int bj = 0; bj < 2; ++bj)
#pragma unroll
              for (int n = 0; n < 2; ++n) bv[bj][n] = *(const f32x4*)(bp + bj * 2816 + 4 * n);
          float rsv[8]; row_scales(SS, row0, fr, fq, rsv);
#pragma unroll
          for (int ai = 0; ai < 2; ++ai)
#pragma unroll
              for (int m = 0; m < 4; ++m) { const float rs = rsv[ai * 4 + m];
#pragma unroll
                  for (int bj = 0; bj < 2; ++bj)
#pragma unroll
                      for (int n = 0; n < 2; ++n) acc[ai][bj][m][n] = acc[ai][bj][m][n] * rs + bv[bj][n]; } }
        PG8_LAS f32x4* WL = (PG8_LAS f32x4*)(xb + 8192);
        if (fr == 0) {
            f32x4 wt[2][2][3];
#pragma unroll
            for (int n = 0; n < 2; ++n)
#pragma unroll
                for (int bj = 0; bj < 2; ++bj)
#pragma unroll
                    for (int k = 0; k < 3; ++k) wt[n][bj][k] = *(const f32x4*)(cw + k * 5632 + bj * 2816 + j0 + 4 * n);
#pragma unroll
            for (int n = 0; n < 2; ++n)
#pragma unroll
                for (int bj = 0; bj < 2; ++bj)
#pragma unroll
                    for (int k = 0; k < 3; ++k) WL[((((wr * 4 + wc) * 4 + fq) * 2 + n) * 2 + bj) * 3 + k] = wt[n][bj][k];
        }
        PG8_LAS f32x4* XB = (PG8_LAS f32x4*)xb;
        const int wv = wr * 4 + wc, pw = (wr ^ 1) * 4 + wc;
        if (fr == 0) {
#pragma unroll
            for (int ai = 0; ai < 2; ++ai)
#pragma unroll
                for (int bj = 0; bj < 2; ++bj)
#pragma unroll
                    for (int n = 0; n < 2; ++n) XB[((wv * 4 + ai * 2) * 2 + bj) * 8 + 2 * fq + n] = acc[ai][bj][0][n]; }
        if (fr == 15) {
#pragma unroll
            for (int ai = 0; ai < 2; ++ai)
#pragma unroll
                for (int bj = 0; bj < 2; ++bj)
#pragma unroll
                    for (int n = 0; n < 2; ++n) XB[((wv * 4 + ai * 2 + 1) * 2 + bj) * 8 + 2 * fq + n] = acc[ai][bj][3][n]; }
        asm volatile("s_waitcnt lgkmcnt(0)" ::: "memory"); __builtin_amdgcn_s_barrier(); asm volatile("" ::: "memory");
        float* hb = HALO + (size_t)(samp ? u.pm - 32 : 0) * 4 * 5632;
#pragma unroll
        for (int ai = 0; ai < 2; ++ai) {
            const bool has_ab = !(wr == 0 && ai == 0), has_bl = !(wr == 1 && ai == 1);
            const int wab = (wr == 0) ? 1 : (ai == 0 ? 1 : 3), wbl = (wr == 0) ? (ai == 0 ? 0 : 2) : 2;
            unsigned pk[4][4];
#pragma unroll
            for (int n = 0; n < 2; ++n) {
                f32x4 ca[4];
#pragma unroll
                for (int bj = 0; bj < 2; ++bj) {
                    const PG8_LAS f32x4* wlp = WL + ((((wr * 4 + wc) * 4 + fq) * 2 + n) * 2 + bj) * 3;
                    const f32x4 w0 = wlp[0], w1 = wlp[1], w2 = wlp[2];
                    f32x4 ab = (f32x4){0.f, 0.f, 0.f, 0.f}, bl = ab;
                    if (has_ab) ab = XB[((pw * 4 + wab) * 2 + bj) * 8 + 2 * fq + n];
                    if (has_bl) bl = XB[((pw * 4 + wbl) * 2 + bj) * 8 + 2 * fq + n];
#pragma unroll
                    for (int m = 0; m < 4; ++m) {
                        f32x4 cvm;
#pragma unroll
                        for (int i = 0; i < 4; ++i) {
                            const float cur = acc[ai][bj][m][n][i];
                            const float pv = m == 0 ? ab[i] : acc[ai][bj][m == 0 ? 0 : m - 1][n][i];
                            const float nx = m == 3 ? bl[i] : acc[ai][bj][m == 3 ? 3 : m + 1][n][i];
                            const float up = dpp_ror1(fr == 15 ? pv : cur), dn = dpp_ror15(fr == 0 ? nx : cur);
                            cvm[i] = w0[i] * up + w1[i] * cur + w2[i] * dn;
                        }
                        if (samp) {
                            if (m == 0 && wr == 0 && ai == 0 && fr == 0) { *(f32x4*)(hb + 0 * 5632 + bj * 2816 + j0 + 4 * n) = acc[ai][bj][0][n]; *(f32x4*)(hb + 1 * 5632 + bj * 2816 + j0 + 4 * n) = cvm; }
                            if (m == 3 && wr == 1 && ai == 1 && fr == 15) { *(f32x4*)(hb + 2 * 5632 + bj * 2816 + j0 + 4 * n) = acc[ai][bj][3][n]; *(f32x4*)(hb + 3 * 5632 + bj * 2816 + j0 + 4 * n) = cvm; }
                        }
                        if (bj == 0) ca[m] = cvm;
                        else { float r[4];
#pragma unroll
                            for (int i = 0; i < 4; ++i) { const float xa = ca[m][i]; r[i] = xa * __builtin_amdgcn_rcpf(1.f + __builtin_amdgcn_exp2f(-xa * 1.4426950408889634f)) * cvm[i]; }
                            pk[m][2 * n] = cvt_pk_bf16(r[0], r[1]); pk[m][2 * n + 1] = cvt_pk_bf16(r[2], r[3]); }
                    }
                }
                __builtin_amdgcn_sched_barrier(0);
            }
#pragma unroll
            for (int m = 0; m < 4; ++m) *(u32x4*)(ACT + (size_t)(row0 + ai * HALF + m * 16) * 2816 + j0) = (u32x4){pk[m][0], pk[m][1], pk[m][2], pk[m][3]};
        }
    }
};

template <class Epi, class Sched, bool ALIGN_EPI = false, bool SP2 = false>
__device__ __forceinline__ void gemm_phase(PG8_LAS unsigned char* lds, const Gemm g, const Sched& S, const Epi& E, const int tid) {
    const int wid = __builtin_amdgcn_readfirstlane(tid >> 6), lane = tid & 63, wr = wid >> 2, wc = wid & 3, fr = lane & 15, fq = lane >> 4;
    const int K = g.K, nt = K / BK;
    unsigned voffA[2], voffB[2];
#pragma unroll
    for (int i = 0; i < 2; ++i) { int R, C; stage_rc(tid * 16 + i * 8192, R, C); const int Rb = Epi::PERM ? ((R & ~31) + perm32(R & 31)) : R;
        voffA[i] = (unsigned)(R * K + C) * 2u; voffB[i] = (unsigned)(Rb * K + C) * 2u; }
    const size_t kstep = (size_t)(BK * 2);
    const size_t hstep = (size_t)HALF * K * 2;
    const size_t tstep = 2 * hstep;
    const size_t bstep = g.bstep ? g.bstep : tstep, bh = g.bhalf ? g.bhalf : hstep;
    const unsigned ldsw = (unsigned)wid * 1024u;
    const int aoff = lds_byte(wr * 64 + fr, fq * 8), boff = lds_byte(wc * 32 + fr, fq * 8);
#define PG8_SA(b, h) (((b) * 2 + (h)) * HTB)
#define PG8_SB(b, h) ((4 + (b) * 2 + (h)) * HTB)
#define PG8_STAGE(bufoff, gbase, voff) do { _Pragma("unroll") for (int _i = 0; _i < 2; ++_i) \
        __builtin_amdgcn_global_load_lds((const unsigned*)((const char*)(gbase) + (voff)[_i]), (PG8_LAS unsigned*)(lds + (bufoff) + ldsw + _i * 8192), 16, 0, 0); } while (0)
#define PG8_LDA(dst, b, h) do { _Pragma("unroll") for (int m = 0; m < 4; ++m) _Pragma("unroll") for (int k = 0; k < 2; ++k) dst[m][k] = *(const PG8_LAS bf16x8*)(lds + PG8_SA(b, h) + aoff + m * 2048 + k * 1024); } while (0)
#define PG8_LDB(dst, b, h) do { _Pragma("unroll") for (int n = 0; n < 2; ++n) _Pragma("unroll") for (int k = 0; k < 2; ++k) dst[n][k] = *(const PG8_LAS bf16x8*)(lds + PG8_SB(b, h) + boff + n * 2048 + k * 1024); } while (0)
#define PG8_MMA(ai, bj, At, Bt) do { __builtin_amdgcn_s_setprio(1); _Pragma("unroll") for (int m = 0; m < 4; ++m) _Pragma("unroll") for (int n = 0; n < 2; ++n) _Pragma("unroll") for (int k = 0; k < 2; ++k) \
        acc[ai][bj][m][n] = __builtin_amdgcn_mfma_f32_16x16x32_bf16(Bt[n][k], At[m][k], acc[ai][bj][m][n], 0, 0, 0); __builtin_amdgcn_s_setprio(0); } while (0)
#define PG8_WAIT_V(n) asm volatile("s_waitcnt vmcnt(" #n ")" ::: "memory")
#define PG8_WAIT_L(n) asm volatile("s_waitcnt lgkmcnt(" #n ")" ::: "memory")
#define PG8_BAR __builtin_amdgcn_s_barrier()
#define PG8_SCHED __builtin_amdgcn_sched_barrier(0)
    Unit cur, nxt; int ui = 0;
    if (!S.next(0, cur)) return;
    f32x4 acc[2][2][4][2];
#pragma unroll
    for (int a = 0; a < 2; ++a)
#pragma unroll
        for (int b = 0; b < 2; ++b)
#pragma unroll
            for (int m = 0; m < 4; ++m)
#pragma unroll
                for (int n = 0; n < 2; ++n) acc[a][b][m][n] = (f32x4){0.f, 0.f, 0.f, 0.f};
    bf16x8 At[4][2], B0[2][2], B1[2][2];
    const char* cA = (const char*)g.A + (size_t)cur.pm * tstep; const char* cB = (const char*)g.Bt + (size_t)cur.pn * bstep;
    S.a_ready(cur);
    if constexpr (SP2) {
        PG8_STAGE(PG8_SB(0, 0), cB, voffB); PG8_STAGE(PG8_SB(0, 1), cB + bh, voffB); PG8_STAGE(PG8_SA(0, 0), cA, voffA); PG8_STAGE(PG8_SA(0, 1), cA + hstep, voffA);
        if (wr == 1) PG8_BAR;
        PG8_WAIT_V(2); PG8_BAR;
        PG8_STAGE(PG8_SB(1, 0), cB + kstep, voffB); PG8_STAGE(PG8_SA(1, 0), cA + kstep, voffA); PG8_STAGE(PG8_SB(1, 1), cB + bh + kstep, voffB);
        PG8_WAIT_V(6); PG8_BAR;
    } else {
        PG8_STAGE(PG8_SB(0, 0), cB, voffB); PG8_STAGE(PG8_SA(0, 0), cA, voffA); PG8_STAGE(PG8_SB(0, 1), cB + bh, voffB); PG8_STAGE(PG8_SA(0, 1), cA + hstep, voffA);
        if (wr == 1) PG8_BAR;
        PG8_WAIT_V(4); PG8_BAR;
        PG8_STAGE(PG8_SB(1, 0), cB + kstep, voffB); PG8_STAGE(PG8_SA(1, 0), cA + kstep, voffA); PG8_STAGE(PG8_SB(1, 1), cB + bh + kstep, voffB);
        PG8_WAIT_V(6); PG8_BAR;
    }
    for (;;) {
        const bool has_next = S.next(ui + 1, nxt);
        const char* nA = has_next ? (const char*)g.A + (size_t)nxt.pm * tstep : cA; const char* nB = has_next ? (const char*)g.Bt + (size_t)nxt.pn * bstep : cB;
        for (int t = 0; t < nt; t += 2) {
            const bool last = (t == nt - 2);
            const char* a1 = cA + (size_t)(t + 1) * kstep;
            const char* a2 = last ? nA : cA + (size_t)(t + 2) * kstep; const char* b2 = last ? nB : cB + (size_t)(t + 2) * kstep;
            const char* a3 = a2 + kstep; const char* b3 = b2 + kstep;
            if (last && has_next) S.a_ready(nxt);
            if constexpr (SP2) {
            PG8_LDB(B0, 0, 0); PG8_LDB(B1, 0, 1); PG8_SCHED; PG8_LDA(At, 0, 0); PG8_STAGE(PG8_SA(1, 1), a1 + hstep, voffA);
            PG8_WAIT_V(8); PG8_WAIT_L(0); PG8_BAR; PG8_MMA(0, 0, At, B0); PG8_MMA(0, 1, At, B1); PG8_BAR; PG8_SCHED;
            PG8_LDA(At, 0, 1); PG8_STAGE(PG8_SB(0, 0), b2, voffB); PG8_STAGE(PG8_SB(0, 1), b2 + bh, voffB); PG8_STAGE(PG8_SA(0, 0), a2, voffA);
            PG8_WAIT_V(8); PG8_WAIT_L(0); PG8_BAR; PG8_MMA(1, 0, At, B0); PG8_MMA(1, 1, At, B1); PG8_BAR; PG8_SCHED;
            PG8_LDB(B0, 1, 0); PG8_LDB(B1, 1, 1); PG8_SCHED; PG8_LDA(At, 1, 0); PG8_STAGE(PG8_SA(0, 1), a2 + hstep, voffA);
            PG8_WAIT_V(8); PG8_WAIT_L(0); PG8_BAR; PG8_MMA(0, 0, At, B0); PG8_MMA(0, 1, At, B1); PG8_BAR; PG8_SCHED;
            PG8_LDA(At, 1, 1); PG8_STAGE(PG8_SB(1, 0), b3, voffB); PG8_STAGE(PG8_SB(1, 1), b3 + bh, voffB); PG8_STAGE(PG8_SA(1, 0), a3, voffA);
            PG8_WAIT_V(8); PG8_WAIT_L(0); PG8_BAR; PG8_MMA(1, 0, At, B0); PG8_MMA(1, 1, At, B1); PG8_BAR; PG8_SCHED;
            } else {
            PG8_LDB(B0, 0, 0); PG8_SCHED; PG8_LDA(At, 0, 0); PG8_STAGE(PG8_SA(1, 1), a1 + hstep, voffA);
            PG8_WAIT_L(8); PG8_BAR; PG8_WAIT_L(0); PG8_MMA(0, 0, At, B0); PG8_BAR; PG8_SCHED;
            PG8_LDB(B1, 0, 1); PG8_STAGE(PG8_SB(0, 0), b2, voffB);
            PG8_BAR; PG8_WAIT_L(0); PG8_MMA(0, 1, At, B1); PG8_BAR;
            PG8_LDA(At, 0, 1); PG8_STAGE(PG8_SA(0, 0), a2, voffA);
            PG8_BAR; PG8_WAIT_L(0); PG8_MMA(1, 0, At, B0); PG8_BAR; PG8_SCHED;
            PG8_STAGE(PG8_SB(0, 1), b2 + bh, voffB);
            PG8_WAIT_V(6); PG8_BAR; PG8_MMA(1, 1, At, B1); PG8_BAR;
            PG8_LDB(B0, 1, 0); PG8_SCHED; PG8_LDA(At, 1, 0); PG8_STAGE(PG8_SA(0, 1), a2 + hstep, voffA);
            PG8_WAIT_L(8); PG8_BAR; PG8_WAIT_L(0); PG8_MMA(0, 0, At, B0); PG8_BAR; PG8_SCHED;
            PG8_LDB(B1, 1, 1); PG8_STAGE(PG8_SB(1, 0), b3, voffB);
            PG8_BAR; PG8_WAIT_L(0); PG8_MMA(0, 1, At, B1); PG8_BAR;
            PG8_LDA(At, 1, 1); PG8_STAGE(PG8_SA(1, 0), a3, voffA);
            PG8_BAR; PG8_WAIT_L(0); PG8_MMA(1, 0, At, B0); PG8_BAR; PG8_SCHED;
            PG8_STAGE(PG8_SB(1, 1), b3 + bh, voffB);
            PG8_WAIT_V(6); PG8_BAR; PG8_MMA(1, 1, At, B1); PG8_BAR;
            }
        }
        if constexpr (ALIGN_EPI) { if (wr == 0) PG8_BAR; }
        if constexpr (!Epi::AFTER_DRAIN) { E(acc, cur, wr, wc, fr, fq); S.done(cur); }
        if (!has_next) break;
#pragma unroll
        for (int a = 0; a < 2; ++a)
#pragma unroll
            for (int b = 0; b < 2; ++b)
#pragma unroll
                for (int m = 0; m < 4; ++m)
#pragma unroll
                    for (int n = 0; n < 2; ++n) acc[a][b][m][n] = (f32x4){0.f, 0.f, 0.f, 0.f};
        cur = nxt; cA = nA; cB = nB; ++ui;
        if constexpr (ALIGN_EPI) { if (wr == 1) PG8_BAR; }
    }
    PG8_WAIT_V(0);
    if constexpr (!ALIGN_EPI) { if (wr == 0) PG8_BAR; }
    PG8_BAR;
#undef PG8_SA
#undef PG8_SB
#undef PG8_STAGE
#undef PG8_LDA
#undef PG8_LDB
#undef PG8_MMA
#undef PG8_WAIT_V
#undef PG8_WAIT_L
#undef PG8_BAR
#undef PG8_SCHED
}
}

#define LAS __attribute__((address_space(3)))
#define CAS __attribute__((address_space(4)))
typedef unsigned short bf16;
typedef float f32x4 __attribute__((ext_vector_type(4)));
typedef short bf16x8 __attribute__((ext_vector_type(8)));
typedef unsigned u32x4 __attribute__((ext_vector_type(4)));
typedef unsigned u32x2 __attribute__((ext_vector_type(2)));

constexpr int NW = 8, NT = 512;
constexpr int DM = 1024, NTOK = 12288, NPR = 8192, NKR = 13312, INC = 2144, INP = 2304, DFF = 2816, DUP = 5632;
constexpr float EPS = 1e-6f, LOG2E = 1.4426950408889634f;
constexpr float QS = 0.125f * LOG2E;
constexpr float MLAQS = 0.10206207261596575f * LOG2E;

constexpr size_t MiB = 1u << 20;
constexpr size_t WS_CTL = 0, WS_MOD = 1 * MiB, WS_ROPE = 1 * MiB + 256 * 1024, WS_W = 2 * MiB, W_LSTRIDE = 24 * MiB;
constexpr size_t W_IN = 0, W_OUT = 4718592, W_UP = W_OUT + 2097152, W_DOWN = W_UP + 11534336, W_B2 = W_DOWN + 5767168;
static_assert(W_B2 + 786432 <= W_LSTRIDE, "weights");
constexpr size_t WS_XN = 50 * MiB, WS_PROJ = 74 * MiB, WS_A2 = 128 * MiB, WS_MQKV = 138 * MiB, WS_QC = 164 * MiB, WS_KPE = 203 * MiB, WS_YCAT = 204 * MiB;
constexpr size_t WS_ACT = 116 * MiB, WS_U = 116 * MiB, WS_SS1 = 248 * MiB, WS_SS2 = 249 * MiB, WS_HALO = 250 * MiB, WS_END = 252 * MiB;
constexpr size_t WS_BIAS = 65536;
constexpr int NBIAS = 2304 + 5632;
constexpr size_t QSZ = (size_t)NKR * 256 * 2, KSZ = (size_t)NKR * 128 * 2;
constexpr int LDS_BYTES = 163840, LDS_CTL = 163840 - 256;
constexpr size_t WS_BAR = 16384;

struct Args { const float* in[28]; float* out; unsigned char* ws; };

__device__ __forceinline__ unsigned f2bf(float f) { unsigned u = __builtin_bit_cast(unsigned, f); return (u + 0x7fffu + ((u >> 16) & 1u)) >> 16; }
__device__ __forceinline__ unsigned pk2(float lo, float hi) { unsigned r; asm("v_cvt_pk_bf16_f32 %0, %1, %2" : "=v"(r) : "v"(lo), "v"(hi)); return r; }
__device__ __forceinline__ float bflo(unsigned u) { return __builtin_bit_cast(float, u << 16); }
__device__ __forceinline__ float bfhi(unsigned u) { return __builtin_bit_cast(float, u & 0xffff0000u); }
__device__ __forceinline__ f32x4 ld4bf(const bf16* p) { const u32x2 u = *(const u32x2*)p; return (f32x4){bflo(u.x), bfhi(u.x), bflo(u.y), bfhi(u.y)}; }
__device__ __forceinline__ void st4bf(bf16* p, f32x4 v) { u32x2 u; u.x = pk2(v[0], v[1]); u.y = pk2(v[2], v[3]); *(u32x2*)p = u; }
__device__ __forceinline__ float shx(float v, int m, int lane) { return __builtin_bit_cast(float, __builtin_amdgcn_ds_bpermute((lane ^ m) << 2, __builtin_bit_cast(int, v))); }
#define DPPF(v, ctrl) __builtin_bit_cast(float, __builtin_amdgcn_mov_dpp(__builtin_bit_cast(int, (v)), (ctrl), 0xf, 0xf, false))
__device__ __forceinline__ float sum16(float v, int) { v += DPPF(v, 0x121); v += DPPF(v, 0x122); v += DPPF(v, 0x124); v += DPPF(v, 0x128); return v; }
__device__ __forceinline__ float wave_sum(float v, int lane) {
    v = sum16(v, lane);
    const int iv = __builtin_bit_cast(int, v);
    const float a = __builtin_bit_cast(float, __builtin_amdgcn_readlane(iv, 0)), b = __builtin_bit_cast(float, __builtin_amdgcn_readlane(iv, 16)),
                c = __builtin_bit_cast(float, __builtin_amdgcn_readlane(iv, 32)), d = __builtin_bit_cast(float, __builtin_amdgcn_readlane(iv, 48));
    return (a + b) + (c + d);
}
__device__ __forceinline__ float dot4(f32x4 a) { return (a[0] * a[0] + a[1] * a[1]) + (a[2] * a[2] + a[3] * a[3]); }
__device__ __forceinline__ f32x4 shfl4(f32x4 v, int m, int lane) { return (f32x4){shx(v[0], m, lane), shx(v[1], m, lane), shx(v[2], m, lane), shx(v[3], m, lane)}; }

__device__ __forceinline__ void transpose_item(const float* W, int N, bf16* WT, int ldk, int row_off, int k_off, float scale, LAS float* scr, int item, int lane) {
    const int nblk = (N + 63) / 64, kb = item / nblk, nb = item % nblk, k0 = 64 * kb, n0 = 64 * nb;
    const bool act = n0 + lane < N;
    const float* wp = W + (size_t)k0 * N + n0 + lane;
    float v[64];
#pragma unroll
    for (int i = 0; i < 64; ++i) v[i] = act ? wp[(size_t)i * N] : 0.f;
#pragma unroll
    for (int i = 0; i < 64; ++i) scr[i * 65 + lane] = v[i] * scale;
    asm volatile("s_waitcnt lgkmcnt(0)" ::: "memory");
    const int c = lane & 7;
#pragma unroll
    for (int j = 0; j < 8; ++j) { const int n = (lane >> 3) + 8 * j; const LAS float* s = scr + (8 * c) * 65 + n;
        u32x4 o; o.x = pk2(s[0 * 65], s[1 * 65]); o.y = pk2(s[2 * 65], s[3 * 65]); o.z = pk2(s[4 * 65], s[5 * 65]); o.w = pk2(s[6 * 65], s[7 * 65]);
        if (n0 + n < N) *(u32x4*)(WT + (size_t)(row_off + n0 + n) * ldk + k_off + k0 + 8 * c) = o; }
    asm volatile("s_waitcnt lgkmcnt(0)" ::: "memory");
}

template <class ArgsRef>
__device__ __forceinline__ void wconv(const ArgsRef& a, unsigned char* ws, int l, int sel, int w, int nwk, LAS float* scr, int lane) {
    constexpr int I_IN = 16 * 34, I_OUT = 16 * 16, I_UP = 16 * 88, I_DN = 44 * 16, I_Q = 3 * 6, I_KV = 2 * 8;
    const int n_in = (sel & 1) ? I_IN : 0, n_out = (sel & 2) ? I_OUT : 0, n_up = (sel & 4) ? I_UP : 0, n_dn = (sel & 8) ? I_DN : 0, n_q = (sel & 16) ? I_Q : 0, n_kv = (sel & 32) ? I_KV : 0;
    const int total = n_in + n_out + n_up + n_dn + n_q + n_kv;
    unsigned char* wl = ws + WS_W + l * W_LSTRIDE;
    for (int it = w; it < total; it += nwk) {
        int r = it;
        if (r < n_in) { transpose_item(a.in[13] + (size_t)l * 1024 * INC, INC, (bf16*)(wl + W_IN), 1024, 0, 0, 1.f, scr, r, lane); continue; } r -= n_in;
        if (r < n_out) { transpose_item(a.in[22] + (size_t)l * 1024 * 1024, 1024, (bf16*)(wl + W_OUT), 1024, 0, 0, 1.f, scr, r, lane); continue; } r -= n_out;
        if (r < n_up) { transpose_item(a.in[24] + (size_t)l * 1024 * DUP, DUP, (bf16*)(wl + W_UP), 1024, 0, 0, 1.f, scr, r, lane); continue; } r -= n_up;
        if (r < n_dn) { transpose_item(a.in[26] + (size_t)l * DFF * 1024, 1024, (bf16*)(wl + W_DOWN), DFF, 0, 0, 1.f, scr, r, lane); continue; } r -= n_dn;
        if (r < n_q) { transpose_item(a.in[16] + (size_t)l * 192 * 384, 384, (bf16*)(wl + W_B2), 384, 0, 0, MLAQS, scr, r, lane); continue; } r -= n_q;
        transpose_item(a.in[18] + (size_t)l * 128 * 512, 512, (bf16*)(wl + W_B2), 384, 384, 192, 1.f, scr, r, lane);
    }
}
template <class ArgsRef>
__device__ __forceinline__ void phase0(const ArgsRef& a, LAS unsigned char* lds, int tid, int lane, int wave) {
    unsigned char* ws = a.ws;
    const int G = gridDim.x, bid = blockIdx.x;
    if (bid < 96) {
        LAS float* sl = (LAS float*)(lds + 16384);
        for (int e = tid; e < 3072; e += NT) { const int c = e >> 10, k = e & 1023; const float v = c == 0 ? a.in[9][k] : a.in[8][(c - 1) * 1024 + k]; sl[e] = v / (1.f + __expf(-v)); }
        __syncthreads();
    }
    for (int it = bid; it < 96; it += G) {
        const int l = it / 48, n0 = (it % 48) * 128;
        const float* wa = a.in[10] + (size_t)l * 1024 * 6144;
        const LAS float* sl = (const LAS float*)(lds + 16384);
        float acc[3][2] = {{0.f, 0.f}, {0.f, 0.f}, {0.f, 0.f}};
        const int kb = wave * 128;
#pragma unroll 16
        for (int k = 0; k < 128; ++k) {
            const int kk = kb + k;
            const float2 w = *(const float2*)(wa + (size_t)kk * 6144 + n0 + 2 * lane);
            const float s0 = sl[kk], s1 = sl[1024 + kk], s2 = sl[2048 + kk];
            acc[0][0] += s0 * w.x; acc[0][1] += s0 * w.y; acc[1][0] += s1 * w.x; acc[1][1] += s1 * w.y; acc[2][0] += s2 * w.x; acc[2][1] += s2 * w.y;
        }
        LAS float* red = (LAS float*)lds;
#pragma unroll
        for (int c = 0; c < 3; ++c) { red[(wave * 3 + c) * 128 + 2 * lane] = acc[c][0]; red[(wave * 3 + c) * 128 + 2 * lane + 1] = acc[c][1]; }
        __syncthreads();
        if (tid < 384) { const int c = tid / 128, n = tid % 128; float s = 0.f;
#pragma unroll
            for (int w = 0; w < 8; ++w) s += red[(w * 3 + c) * 128 + n];
            ((float*)(ws + WS_MOD))[(size_t)(l * 3 + c) * 6144 + n0 + n] = s + a.in[11][(size_t)l * 6144 + n0 + n]; }
        __syncthreads();
    }
    if (bid == G - 1) {
        float* rt = (float*)(ws + WS_ROPE);
        for (int e = tid; e < 1024; e += NT) { const int pos = e >> 4, i = e & 15; const float inv = exp2f(-(float)(2 * i) / 32.f * 13.287712379549449f); const float ang = (float)pos * inv;
            rt[e] = __cosf(ang); rt[1024 + e] = __sinf(ang); }
        for (int e = tid; e < 512; e += NT) { const int pos = e >> 3, i = e & 7; const float inv = exp2f(-(float)(2 * i) / 16.f * 13.287712379549449f); const float ang = (float)pos * inv;
            rt[2048 + e] = __cosf(ang); rt[2560 + e] = __sinf(ang); }
    }
    const int gt = bid * NT + tid, NGT = G * NT;
    if (gt < 256) ((unsigned*)(ws + WS_CTL))[gt] = 0u;
    if (gt < 3456) ((unsigned*)(ws + WS_BAR))[gt] = 0u;
    for (int l = 0; l < 2; ++l) {
        bf16* b2 = (bf16*)(ws + WS_W + l * W_LSTRIDE + W_B2);
        for (int ch = gt; ch < 1024 * 48; ch += NGT) { const int n = ch / 48, k = (ch % 48) * 8;
            const bool data = (n < 384 && k < 192) || (n >= 384 && n < 896 && k >= 192 && k < 320);
            if (!data) *(u32x4*)(b2 + (size_t)n * 384 + k) = (u32x4){0u, 0u, 0u, 0u}; }
        bf16* wi = (bf16*)(ws + WS_W + l * W_LSTRIDE + W_IN) + (size_t)INC * 1024;
        for (int ch = gt; ch < 160 * 128; ch += NGT) *(u32x4*)(wi + (size_t)ch * 8) = (u32x4){0u, 0u, 0u, 0u};
    }
    LAS float* scr = (LAS float*)(lds + 28672 + wave * 16640);
    wconv(a, ws, 0, 1 | 2 | 16 | 32, bid * NW + wave, G * NW, scr, lane);
}

__device__ __forceinline__ void prep_phase(const float* x0, const float* x1, const float* nw, const float* mod, int sc_off, bf16* XN, float* SS, int lane, int gw, int NGW) {
    for (int row = gw; row < NTOK; row += NGW) {
        const float* xr = row < NPR ? x0 + (size_t)row * DM : x1 + (size_t)(row - NPR) * DM;
        const int c = row < NPR ? 0 : 1 + ((row - NPR) >> 11);
        const float* mp = mod + c * 6144;
        f32x4 v[4]; float ss = 0.f;
#pragma unroll
        for (int j = 0; j < 4; ++j) { v[j] = *(const f32x4*)(xr + 4 * (lane + 64 * j)); ss += dot4(v[j]); }
        ss = wave_sum(ss, lane);
#pragma unroll
        for (int j = 0; j < 4; ++j) { const int col = 4 * (lane + 64 * j);
            const f32x4 g = *(const f32x4*)(nw + col), sc = *(const f32x4*)(mp + sc_off + col);
            st4bf(XN + (size_t)row * DM + col, v[j] * g * (1.f + sc)); }
        if (lane < 16) SS[(size_t)row * 16 + lane] = lane == 0 ? ss : 0.f;
    }
}
template <class ArgsRef>
__device__ __forceinline__ void bias_phase(const ArgsRef& a, unsigned char* ws, LAS unsigned char* lds, int tid, int lane, int wave) {
    const float* mod = (const float*)(ws + WS_MOD);
    float* BIAS = (float*)(ws + WS_BIAS);
    for (int it = blockIdx.x; it < 62; it += gridDim.x) {
        const int l = it / 31, r = it % 31; const bool up = r >= 9;
        const int N = up ? DUP : INC, n0 = (up ? r - 9 : r) * 256 + 4 * lane;
        const float* W = up ? a.in[24] + (size_t)l * 1024 * DUP : a.in[13] + (size_t)l * 1024 * INC;
        const float* shp = mod + (size_t)l * 3 * 6144 + (up ? 3072 : 0);
        LAS float* sl = (LAS float*)(lds + 32768);
        for (int e = tid; e < 3072; e += NT) sl[e] = shp[(e >> 10) * 6144 + (e & 1023)];
        __syncthreads();
        const bool act = n0 < N;
        f32x4 acc[3] = {(f32x4){0.f, 0.f, 0.f, 0.f}, (f32x4){0.f, 0.f, 0.f, 0.f}, (f32x4){0.f, 0.f, 0.f, 0.f}};
        const int kb = wave * 128;
#pragma unroll 16
        for (int k = 0; k < 128; ++k) { const int kk = kb + k;
            const f32x4 w = act ? *(const f32x4*)(W + (size_t)kk * N + n0) : (f32x4){0.f, 0.f, 0.f, 0.f};
            acc[0] += w * sl[kk]; acc[1] += w * sl[1024 + kk]; acc[2] += w * sl[2048 + kk]; }
        LAS f32x4* red = (LAS f32x4*)lds;
#pragma unroll
        for (int c = 0; c < 3; ++c) red[(wave * 3 + c) * 64 + lane] = acc[c];
        __syncthreads();
        if (tid < 192) { const int c = tid >> 6, ln = tid & 63; f32x4 t = red[c * 64 + ln];
#pragma unroll
            for (int w = 1; w < 8; ++w) t += red[(w * 3 + c) * 64 + ln];
            const int nn = (up ? r - 9 : r) * 256 + 4 * ln;
            if (nn < N) *(f32x4*)(BIAS + (size_t)(l * 3 + c) * NBIAS + (up ? 2304 : 0) + nn) = t;
            else if (!up && nn < 2304) *(f32x4*)(BIAS + (size_t)(l * 3 + c) * NBIAS + nn) = (f32x4){0.f, 0.f, 0.f, 0.f}; }
        __syncthreads();
    }
}

struct P3Ptrs {
    const bf16* PROJ; bf16 *A2, *KPE, *YCAT, *Qc_rot, *Qc_raw, *Kc, *Vc, *Qd_rot, *Qd_raw, *Kd, *Vd;
    const float *conv_a, *gq_mla, *gkv_mla, *gq, *gk, *rope;
    const float *c_ckv, *c_kpe, *c_gk, *c_gv, *c_sk, *c_sv;
    float *o_ckv, *o_kpe, *o_gk, *o_gv, *o_sk, *o_sv;
    int l;
};
__device__ __forceinline__ f32x4 rope64(f32x4 v, int jl, int prow, int pcol, const float* rt, int lane) {
    const f32x4 pr = shfl4(v, 4, lane);
    const int pos = jl < 8 ? prow : pcol, fi = 4 * (jl & 3);
    const f32x4 c = *(const f32x4*)(rt + pos * 16 + fi), s = *(const f32x4*)(rt + 1024 + pos * 16 + fi);
    const float sg = (jl & 4) ? 1.f : -1.f;
    return v * c + pr * s * sg;
}
__device__ __forceinline__ void p3_phase(const P3Ptrs& P, int lane, int gw, int NGW) {
    const int l = P.l;
    for (int row = gw; row < NKR; row += NGW) {
        if (row < NTOK) {
            const bool samp = row >= NPR;
            int b, t, kr, T;
            if (!samp) { b = row >> 8; t = row & 255; kr = row; T = 256; } else { b = (row - NPR) >> 11; t = (row - NPR) & 2047; kr = NPR + b * 2560 + t; T = 2048; }
            const int prow = t >> 6, pcol = t & 63;
            const bf16* pr = P.PROJ + (size_t)row * INP;
            const size_t ob = (size_t)((b * 2 + l) * 256 + t);
            const int ci = 4 * lane, jl = lane & 15;
            const u32x2 z2 = (u32x2){0u, 0u};
            const bool hp = t > 0, hn = t < T - 1;
            const u32x2 r_xa = *(const u32x2*)(pr + ci), r_gb = *(const u32x2*)(pr + 256 + ci), r_gc = *(const u32x2*)(pr + 512 + ci);
            const u32x2 r_pxa = hp ? *(const u32x2*)(pr - INP + ci) : z2, r_pgc = hp ? *(const u32x2*)(pr - INP + 512 + ci) : z2;
            const u32x2 r_nxa = hn ? *(const u32x2*)(pr + INP + ci) : z2, r_ngc = hn ? *(const u32x2*)(pr + INP + 512 + ci) : z2;
            const u32x2 r_cq = lane < 48 ? *(const u32x2*)(pr + 768 + ci) : z2, r_ckv = lane < 32 ? *(const u32x2*)(pr + 960 + ci) : z2, r_kpe = lane < 8 ? *(const u32x2*)(pr + 1088 + ci) : z2;
            const u32x2 r_qc = *(const u32x2*)(pr + 1120 + ci), r_kvc = *(const u32x2*)(pr + 1376 + ci), r_qd = *(const u32x2*)(pr + 1632 + ci), r_kvd = *(const u32x2*)(pr + 1888 + ci);
            const float* cw = P.conv_a + (size_t)l * 768;
            const f32x4 w0 = *(const f32x4*)(cw + ci), w1 = *(const f32x4*)(cw + 256 + ci), w2 = *(const f32x4*)(cw + 512 + ci);
            const f32x4 g_qm = lane < 48 ? *(const f32x4*)(P.gq_mla + l * 192 + ci) : (f32x4){0.f, 0.f, 0.f, 0.f}, g_kvm = lane < 32 ? *(const f32x4*)(P.gkv_mla + l * 128 + ci) : (f32x4){0.f, 0.f, 0.f, 0.f};
            const f32x4 g_q = *(const f32x4*)(P.gq + l * 64 + 4 * jl), g_k = *(const f32x4*)(P.gk + l * 64 + 4 * jl);
            const int pos64 = jl < 8 ? prow : pcol, fi64 = 4 * (jl & 3);
            const f32x4 c64 = *(const f32x4*)(P.rope + pos64 * 16 + fi64), s64 = *(const f32x4*)(P.rope + 1024 + pos64 * 16 + fi64);
            const int pos32 = (lane & 7) < 4 ? prow : pcol, fi32 = 4 * (lane & 1);
            const f32x4 c32 = *(const f32x4*)(P.rope + 2048 + pos32 * 8 + fi32), s32 = *(const f32x4*)(P.rope + 2560 + pos32 * 8 + fi32);
#define CV4(u) ((f32x4){bflo((u).x), bfhi((u).x), bflo((u).y), bfhi((u).y)})
#define ROPE64(v) ((v) * c64 + shfl4((v), 4, lane) * s64 * ((jl & 4) ? 1.f : -1.f))
            { const f32x4 ya = CV4(r_gb) * (w0 * (CV4(r_pxa) * CV4(r_pgc)) + w1 * (CV4(r_xa) * CV4(r_gc)) + w2 * (CV4(r_nxa) * CV4(r_ngc)));
              st4bf(P.YCAT + (size_t)row * DM + ci, ya); }
            { const f32x4 v = CV4(r_cq);
              const float rs = rsqrtf(wave_sum(dot4(v), lane) * (1.f / 192.f) + EPS);
              if (lane < 48) st4bf(P.A2 + (size_t)kr * 384 + ci, v * rs * g_qm); }
            { const f32x4 v = CV4(r_ckv);
              const float rs = rsqrtf(wave_sum(dot4(v), lane) * (1.f / 128.f) + EPS);
              if (lane < 32) { const f32x4 o = v * rs * g_kvm;
                  st4bf(P.A2 + (size_t)kr * 384 + 192 + ci, o);
                  if (!samp) *(f32x4*)(P.o_ckv + ob * 128 + ci) = o; }
              else if (lane < 48) { unsigned zz = 0u; asm volatile("" : "+v"(zz)); *(u32x2*)(P.A2 + (size_t)kr * 384 + 320 + 4 * (lane - 32)) = (u32x2){zz, zz}; } }
            { const f32x4 v = CV4(r_kpe);
              const f32x4 r = v * c32 + shfl4(v, 2, lane) * s32 * ((lane & 2) ? 1.f : -1.f);
              if (lane < 8) { if (!samp) *(f32x4*)(P.o_kpe + ob * 32 + ci) = v; st4bf(P.KPE + (size_t)kr * 32 + ci, samp ? r : v); } }
            { f32x4 v = CV4(r_qc);
              const float rs = rsqrtf(sum16(dot4(v), lane) * (1.f / 64.f) + EPS);
              v = v * rs * g_q;
              st4bf(P.Qc_raw + (size_t)kr * 256 + ci, v * QS);
              const f32x4 r = ROPE64(v);
              if (samp) st4bf(P.Qc_rot + (size_t)kr * 256 + ci, r * QS); }
            { const f32x4 v = CV4(r_kvc);
              const float rs = rsqrtf(sum16(dot4(v), lane) * (1.f / 64.f) + EPS);
              const f32x4 kn = v * rs * g_k;
              const f32x4 r = ROPE64(kn);
              if (lane < 32) { if (!samp) *(f32x4*)(P.o_gk + ob * 128 + ci) = kn; st4bf(P.Kc + (size_t)kr * 128 + ci, samp ? r : kn); }
              else { if (!samp) *(f32x4*)(P.o_gv + ob * 128 + 4 * (lane - 32)) = v; st4bf(P.Vc + (size_t)kr * 128 + 4 * (lane - 32), v); } }
            { const f32x4 v = CV4(r_qd);
              st4bf(P.Qd_raw + (size_t)kr * 256 + ci, v * QS);
              const f32x4 r = ROPE64(v);
              if (samp) st4bf(P.Qd_rot + (size_t)kr * 256 + ci, r * QS); }
            { const f32x4 v = CV4(r_kvd);
              const f32x4 r = ROPE64(v);
              if (lane < 32) { if (!samp) *(f32x4*)(P.o_sk + ob * 128 + ci) = v; st4bf(P.Kd + (size_t)kr * 128 + ci, samp ? r : v); }
              else { if (!samp) *(f32x4*)(P.o_sv + ob * 128 + 4 * (lane - 32)) = v; st4bf(P.Vd + (size_t)kr * 128 + 4 * (lane - 32), v); } }
#undef CV4
#undef ROPE64
        } else {
            const int ci = row - NTOK, b = ci >> 9, j = ci & 511, kr = NPR + b * 2560 + 2048 + j;
            const size_t cb = (size_t)((b * 2 + l) * 512 + j);
            f32x4 z = (f32x4){0.f, 0.f, 0.f, 0.f}; asm volatile("" : "+v"(z));
            if (lane < 48) st4bf(P.A2 + (size_t)kr * 384 + 4 * lane, z);
            if (lane < 32) st4bf(P.A2 + (size_t)kr * 384 + 192 + 4 * lane, *(const f32x4*)(P.c_ckv + cb * 128 + 4 * lane));
            else if (lane < 48) st4bf(P.A2 + (size_t)kr * 384 + 320 + 4 * (lane - 32), z);
            if (lane < 8) st4bf(P.KPE + (size_t)kr * 32 + 4 * lane, *(const f32x4*)(P.c_kpe + cb * 32 + 4 * lane));
            if (lane < 32) { st4bf(P.Kc + (size_t)kr * 128 + 4 * lane, *(const f32x4*)(P.c_gk + cb * 128 + 4 * lane));
                             st4bf(P.Kd + (size_t)kr * 128 + 4 * lane, *(const f32x4*)(P.c_sk + cb * 128 + 4 * lane)); }
            else { st4bf(P.Vc + (size_t)kr * 128 + 4 * (lane - 32), *(const f32x4*)(P.c_gv + cb * 128 + 4 * (lane - 32)));
                   st4bf(P.Vd + (size_t)kr * 128 + 4 * (lane - 32), *(const f32x4*)(P.c_sv + cb * 128 + 4 * (lane - 32))); }
        }
    }
}

struct AttnSrc {
    const bf16* Qraw; const bf16* Qrot; int qpitch;
    const bf16* K0; int k0pitch; const bf16* K1;
    const bf16* V; int vpitch;
    bf16* Y; int outcol;
    int krbase, rowbase, q0, lo, hi, nctx;
    bool samp, window; float m0; bool sink;
    const float* rope;
};
template <int DK>
__device__ __forceinline__ void attn_unit(const AttnSrc& S, LAS unsigned char* lds, int tid, int lane, int wave) {
    constexpr int TK = 128, NKB = TK / 16, NPP = TK / 32;
    constexpr int KP = DK + 8, VP = TK + 8, KS = DK / 32, CPK = DK / 8;
    constexpr int NKC = TK * CPK / NT, NVC = TK * 8 / NT;
    LAS bf16* Ks = (LAS bf16*)lds;
    LAS bf16* Vt = (LAS bf16*)(lds + 2 * TK * KP * 2);
    const int g = lane >> 4, fr = lane & 15;
    const int qpos = S.q0 + wave * 16 + fr;
    const size_t qkr = (size_t)(S.krbase + qpos);
    bf16x8 qraw[KS], qrot[KS];
#pragma unroll
    for (int ks = 0; ks < KS; ++ks) { qraw[ks] = *(const bf16x8*)(S.Qraw + qkr * S.qpitch + ks * 32 + g * 8); qrot[ks] = qraw[ks]; }
    if (S.samp) {
        if (DK == 96) {
            const bf16x8 own = qraw[KS - 1], par = *(const bf16x8*)(S.Qraw + qkr * S.qpitch + 64 + (g ^ 1) * 8);
            const int pos = g < 2 ? (qpos >> 6) : (qpos & 63);
            const float sg = (g & 1) ? 1.f : -1.f;
            const float* ct = S.rope + 2048 + pos * 8; const float* st = S.rope + 2560 + pos * 8;
            bf16x8 r;
#pragma unroll
            for (int e = 0; e < 8; ++e) { const float o = bflo((unsigned)(unsigned short)own[e]), p = bflo((unsigned)(unsigned short)par[e]);
                r[e] = (short)f2bf(o * ct[e] + p * st[e] * sg); }
            qrot[KS - 1] = r;
        } else {
#pragma unroll
            for (int ks = 0; ks < KS; ++ks) qrot[ks] = *(const bf16x8*)(S.Qrot + qkr * S.qpitch + ks * 32 + g * 8);
        }
    }
    bf16x8 qc[KS];
#pragma unroll
    for (int ks = 0; ks < KS; ++ks) qc[ks] = S.samp ? qrot[ks] : qraw[ks];
    float m = S.m0, l = (S.sink && g == 0) ? 1.f : 0.f;
    f32x4 o[4];
#pragma unroll
    for (int d = 0; d < 4; ++d) o[d] = (f32x4){0.f, 0.f, 0.f, 0.f};
    const int nloc = S.hi - S.lo, ntile = nloc + S.nctx;
    u32x4 kreg[NKC], vreg[NVC];
    auto gload = [&](int j) {
        const int tile = j < nloc ? S.lo + j : (2048 / TK) + (j - nloc);
        const size_t kr = (size_t)(S.krbase + tile * TK);
#pragma unroll
        for (int c = 0; c < NKC; ++c) { const int ch = tid + c * NT, key = ch / CPK, part = ch % CPK;
            if (DK == 64) kreg[c] = *(const u32x4*)(S.K0 + (kr + key) * S.k0pitch + part * 8);
            else kreg[c] = part < 8 ? *(const u32x4*)(S.K0 + (kr + key) * S.k0pitch + part * 8) : *(const u32x4*)(S.K1 + (kr + key) * 32 + (part - 8) * 8); }
#pragma unroll
        for (int c = 0; c < NVC; ++c) { const int ch = tid + c * NT, vkey = ch & (TK - 1), vdc = ch / TK;
            vreg[c] = *(const u32x4*)(S.V + (kr + vkey) * S.vpitch + vdc * 8); }
    };
    auto lstore = [&](int buf) {
        LAS bf16* kb = Ks + buf * TK * KP; LAS bf16* vb = Vt + buf * 64 * VP;
#pragma unroll
        for (int c = 0; c < NKC; ++c) { const int ch = tid + c * NT, key = ch / CPK, part = ch % CPK; *(LAS u32x4*)(kb + key * KP + part * 8) = kreg[c]; }
#pragma unroll
        for (int c = 0; c < NVC; ++c) { const int ch = tid + c * NT, vkey = ch & (TK - 1), vdc = ch / TK;
            LAS bf16* vp = vb + (vdc * 8) * VP + vkey; const u32x4 v = vreg[c];
            vp[0 * VP] = (bf16)(v.x & 0xffffu); vp[1 * VP] = (bf16)(v.x >> 16); vp[2 * VP] = (bf16)(v.y & 0xffffu); vp[3 * VP] = (bf16)(v.y >> 16);
            vp[4 * VP] = (bf16)(v.z & 0xffffu); vp[5 * VP] = (bf16)(v.z >> 16); vp[6 * VP] = (bf16)(v.w & 0xffffu); vp[7 * VP] = (bf16)(v.w >> 16); }
    };
    gload(0); lstore(0);
    __syncthreads();
    for (int j = 0; j < ntile; ++j) {
        const int buf = j & 1;
        if (j + 1 < ntile) gload(j + 1);
        const bool loc = j < nloc;
        if (j == nloc) {
#pragma unroll
            for (int ks = 0; ks < KS; ++ks) qc[ks] = qraw[ks]; }
        const LAS bf16* kb = Ks + buf * TK * KP; const LAS bf16* vb = Vt + buf * 64 * VP;
        f32x4 s[NKB];
#pragma unroll
        for (int kk = 0; kk < NKB; ++kk) { s[kk] = (f32x4){0.f, 0.f, 0.f, 0.f};
#pragma unroll
            for (int ks = 0; ks < KS; ++ks) { const bf16x8 af = *(const LAS bf16x8*)(kb + (kk * 16 + fr) * KP + ks * 32 + g * 8);
                s[kk] = __builtin_amdgcn_mfma_f32_16x16x32_bf16(af, qc[ks], s[kk], 0, 0, 0); } }
        if (S.window && loc) {
            const int kp0 = (S.lo + j) * TK + g * 4;
#pragma unroll
            for (int kk = 0; kk < NKB; ++kk)
#pragma unroll
                for (int i = 0; i < 4; ++i) { const int d = kp0 + kk * 16 + i - qpos; if (d > 128 || d < -128) s[kk][i] = -INFINITY; }
        }
        float mx = -INFINITY;
#pragma unroll
        for (int kk = 0; kk < NKB; ++kk) mx = fmaxf(mx, fmaxf(fmaxf(s[kk][0], s[kk][1]), fmaxf(s[kk][2], s[kk][3])));
        mx = fmaxf(mx, shx(mx, 16, lane)); mx = fmaxf(mx, shx(mx, 32, lane));
        const float mn = fmaxf(m, mx), alpha = __builtin_amdgcn_exp2f(m - mn);
        m = mn;
        float ls = 0.f;
#pragma unroll
        for (int kk = 0; kk < NKB; ++kk)
#pragma unroll
            for (int i = 0; i < 4; ++i) { const float p = __builtin_amdgcn_exp2f(s[kk][i] - mn); s[kk][i] = p; ls += p; }
        l = l * alpha + ls;
#pragma unroll
        for (int d = 0; d < 4; ++d) o[d] = o[d] * alpha;
        bf16x8 pf[NPP];
#pragma unroll
        for (int pp = 0; pp < NPP; ++pp) {
            const unsigned w0 = pk2(s[2 * pp][0], s[2 * pp][1]), w1 = pk2(s[2 * pp][2], s[2 * pp][3]), w2 = pk2(s[2 * pp + 1][0], s[2 * pp + 1][1]), w3 = pk2(s[2 * pp + 1][2], s[2 * pp + 1][3]);
            pf[pp] = __builtin_bit_cast(bf16x8, (u32x4){w0, w1, w2, w3});
        }
#pragma unroll
        for (int d = 0; d < 4; ++d)
#pragma unroll
            for (int pp = 0; pp < NPP; ++pp) {
                const LAS bf16* vr = vb + (d * 16 + fr) * VP + pp * 32 + g * 4;
                const u32x2 lo = *(const LAS u32x2*)vr, hi = *(const LAS u32x2*)(vr + 16);
                const bf16x8 af = __builtin_bit_cast(bf16x8, (u32x4){lo.x, lo.y, hi.x, hi.y});
                o[d] = __builtin_amdgcn_mfma_f32_16x16x32_bf16(af, pf[pp], o[d], 0, 0, 0);
            }
        if (j + 1 < ntile) lstore(buf ^ 1);
        __syncthreads();
    }
    float lt = l + shx(l, 16, lane); lt += shx(lt, 32, lane);
    const float inv = 1.f / lt;
    bf16* yr = S.Y + (size_t)(S.rowbase + qpos) * DM + S.outcol + g * 4;
#pragma unroll
    for (int d = 0; d < 4; ++d) st4bf(yr + d * 16, o[d] * inv);
}

struct AttnBufs { const bf16 *MQKV, *KPE, *Qc_rot, *Qc_raw, *Kc, *Vc, *Qd_rot, *Qd_raw, *Kd, *Vd; bf16* YCAT; const float* sink; const float* rope; unsigned* ctr; };
constexpr int ATT_NU = 384 + 768;
__device__ __forceinline__ void attn_phase(const AttnBufs& B, LAS unsigned char* lds, int tid, int lane, int wave) {
    volatile LAS unsigned* shu = (volatile LAS unsigned*)(lds + LDS_CTL);
    for (;;) {
        if (tid == 0) *shu = atomicAdd(B.ctr, 1u);
        __syncthreads();
        const int u = (int)*shu;
        if (u >= ATT_NU) break;
        int type, b, h, qt; bool samp;
        if (u < 384) { type = u >> 7; const int v = u & 127; b = v >> 6; h = (v >> 4) & 3; qt = v & 15; samp = true; }
        else { const int w = u - 384; type = w >> 8; const int v = w & 255; b = v >> 3; h = (v >> 1) & 3; qt = v & 1; samp = false; }
        AttnSrc S;
        S.samp = samp; S.q0 = qt * 128; S.rope = B.rope; S.Y = B.YCAT;
        S.krbase = samp ? NPR + b * 2560 : b * 256; S.rowbase = samp ? NPR + b * 2048 : b * 256;
        S.window = false; S.sink = false; S.m0 = -1e30f;
        if (!samp) { S.lo = 0; S.hi = 2; S.nctx = 0; }
        else { S.lo = 0; S.hi = 16; S.nctx = 4; }
        if (type == 0) {
            S.Qraw = B.MQKV + h * 96; S.Qrot = S.Qraw; S.qpitch = 1024; S.K0 = B.MQKV + 384 + h * 128; S.k0pitch = 1024; S.K1 = B.KPE; S.V = B.MQKV + 384 + h * 128 + 64; S.vpitch = 1024; S.outcol = 256 + h * 64;
            attn_unit<96>(S, lds, tid, lane, wave);
        } else {
            if (type == 1) { S.Qraw = B.Qc_raw + h * 64; S.Qrot = B.Qc_rot + h * 64; S.K0 = B.Kc + (h >> 1) * 64; S.V = B.Vc + (h >> 1) * 64; S.outcol = 512 + h * 64; }
            else { S.Qraw = B.Qd_raw + h * 64; S.Qrot = B.Qd_rot + h * 64; S.K0 = B.Kd + (h >> 1) * 64; S.V = B.Vd + (h >> 1) * 64; S.outcol = 768 + h * 64;
                   S.sink = true; S.m0 = B.sink[h] * LOG2E;
                   if (samp) { S.window = true; const int lo = S.q0 / 128 - 1; S.lo = lo < 0 ? 0 : lo; const int hi = S.q0 / 128 + 2; S.hi = hi > 16 ? 16 : hi; } }
            S.qpitch = 256; S.k0pitch = 128; S.K1 = nullptr; S.vpitch = 128;
            attn_unit<64>(S, lds, tid, lane, wave);
        }
    }
}

__device__ __forceinline__ void load8(const bf16* p, float (&o)[8]) { const u32x4 u = *(const u32x4*)p; o[0] = bflo(u.x); o[1] = bfhi(u.x); o[2] = bflo(u.y); o[3] = bfhi(u.y); o[4] = bflo(u.z); o[5] = bfhi(u.z); o[6] = bflo(u.w); o[7] = bfhi(u.w); }
__device__ __forceinline__ void convgate_phase(const bf16* U, const float* cf, bf16* ACT, int gt, int NGT) {
    constexpr int NCH = DFF / 8, RG = 8;
    for (int it = gt; it < (NTOK / RG) * NCH; it += NGT) {
        const int rg = it / NCH, cc = it % NCH, r0 = rg * RG, col = cc * 8;
        const bool samp = r0 >= NPR; const int t0 = samp ? ((r0 - NPR) & 2047) : (r0 & 255), T = samp ? 2048 : 256;
        const bf16* up = U + (size_t)r0 * DUP + col;
        u32x4 ra[RG + 2], rb[RG + 2];
        const u32x4 z4 = (u32x4){0u, 0u, 0u, 0u};
        ra[0] = z4; rb[0] = z4; ra[RG + 1] = z4; rb[RG + 1] = z4;
        if (t0 > 0) { ra[0] = *(const u32x4*)(up - DUP); rb[0] = *(const u32x4*)(up - DUP + DFF); }
#pragma unroll
        for (int i = 0; i < RG; ++i) { ra[i + 1] = *(const u32x4*)(up + (size_t)i * DUP); rb[i + 1] = *(const u32x4*)(up + (size_t)i * DUP + DFF); }
        if (t0 + RG < T) { ra[RG + 1] = *(const u32x4*)(up + (size_t)RG * DUP); rb[RG + 1] = *(const u32x4*)(up + (size_t)RG * DUP + DFF); }
        float wa[3][8], wb[3][8];
#pragma unroll
        for (int k = 0; k < 3; ++k) { const f32x4 a0 = *(const f32x4*)(cf + k * DUP + col), a1 = *(const f32x4*)(cf + k * DUP + col + 4), b0 = *(const f32x4*)(cf + k * DUP + DFF + col), b1 = *(const f32x4*)(cf + k * DUP + DFF + col + 4);
#pragma unroll
            for (int e = 0; e < 4; ++e) { wa[k][e] = a0[e]; wa[k][4 + e] = a1[e]; wb[k][e] = b0[e]; wb[k][4 + e] = b1[e]; } }
#pragma unroll
        for (int i = 0; i < RG; ++i) {
            float r[8];
#pragma unroll
            for (int h = 0; h < 4; ++h) {
                const unsigned pa = ra[i][h], ca = ra[i + 1][h], na = ra[i + 2][h], pb = rb[i][h], cb = rb[i + 1][h], nb = rb[i + 2][h];
                const float xa0 = wa[0][2 * h] * bflo(pa) + wa[1][2 * h] * bflo(ca) + wa[2][2 * h] * bflo(na), xb0 = wb[0][2 * h] * bflo(pb) + wb[1][2 * h] * bflo(cb) + wb[2][2 * h] * bflo(nb);
                const float xa1 = wa[0][2 * h + 1] * bfhi(pa) + wa[1][2 * h + 1] * bfhi(ca) + wa[2][2 * h + 1] * bfhi(na), xb1 = wb[0][2 * h + 1] * bfhi(pb) + wb[1][2 * h + 1] * bfhi(cb) + wb[2][2 * h + 1] * bfhi(nb);
                r[2 * h] = xa0 * __builtin_amdgcn_rcpf(1.f + __builtin_amdgcn_exp2f(-xa0 * LOG2E)) * xb0;
                r[2 * h + 1] = xa1 * __builtin_amdgcn_rcpf(1.f + __builtin_amdgcn_exp2f(-xa1 * LOG2E)) * xb1;
            }
            u32x4 w; w.x = pk2(r[0], r[1]); w.y = pk2(r[2], r[3]); w.z = pk2(r[4], r[5]); w.w = pk2(r[6], r[7]);
            *(u32x4*)(ACT + (size_t)(r0 + i) * DFF + col) = w;
        }
    }
}

#define XB_TMO      128
#define XB_XCNT(j)  (256  + 64 * (j))
#define XB_XSUB(j)  (1280 + 64 * (j))
#define XB_XGEN(j)  (2304 + 64 * (j))
#define XB_TOP      3328
#define XB_TOPGEN   3392
#define XCD_BAR_WORDS 3456
#define XB_SPIN_CAP (1u << 20)
__device__ __forceinline__ unsigned xb_ld(unsigned* p)              { return __hip_atomic_load(p, __ATOMIC_RELAXED, __HIP_MEMORY_SCOPE_AGENT); }
__device__ __forceinline__ unsigned xb_add(unsigned* p, unsigned v) { return __hip_atomic_fetch_add(p, v, __ATOMIC_RELAXED, __HIP_MEMORY_SCOPE_AGENT); }
__device__ __forceinline__ unsigned xb_xcc_id() { return (unsigned)__builtin_amdgcn_s_getreg((3 << 11) | 20) & 0xFu; }
#define XB_SPIN(cond, bar) do { unsigned _sp = 0; while (cond) { __builtin_amdgcn_s_sleep(1); \
    if ((++_sp & 255u) == 0u) { if (xb_ld(&(bar)[XB_TMO])) break; if (_sp > XB_SPIN_CAP) { atomicAdd(&(bar)[XB_TMO], 1u); break; } } } } while (0)
struct XcdBarrier { unsigned* bar; unsigned x; volatile LAS unsigned* st; };
__device__ __forceinline__ void xcd_barrier_complete(unsigned* bar, unsigned x, unsigned& nloc, unsigned& nx) {
    const unsigned G = gridDim.x * gridDim.y * gridDim.z;
    unsigned sum, cnt, mine, sp = 0u;
    for (;;) {
        sum = 0u; cnt = 0u; mine = 0u;
#pragma unroll
        for (unsigned j = 0; j < 16; ++j) { const unsigned c = xb_ld(&bar[XB_XCNT(j)]); sum += c; cnt += (c > 0u) ? 1u : 0u; mine = (j == x) ? c : mine; }
        if (sum == G) break;
        __builtin_amdgcn_s_sleep(1);
        if ((++sp & 255u) == 0u) { if (xb_ld(&bar[XB_TMO])) break; if (sp > XB_SPIN_CAP) { atomicAdd(&bar[XB_TMO], 1u); break; } }
    }
    nloc = mine > 0u ? mine : 1u; nx = cnt > 0u ? cnt : 1u;
}
__device__ __forceinline__ void xcd_barrier(const XcdBarrier& b, const int tid_) {
    asm volatile("s_waitcnt vmcnt(0)" ::: "memory");
    __syncthreads();
    if (tid_ == 0) {
        unsigned* bar = b.bar;
        __builtin_amdgcn_s_waitcnt(0);
        unsigned nloc = b.st[0], nx = b.st[1];
        if (nloc == 0u) { xcd_barrier_complete(bar, b.x, nloc, nx); b.st[0] = nloc; b.st[1] = nx; }
        const unsigned old = xb_add(&bar[XB_XSUB(b.x)], 1u);
        const unsigned gen = old / nloc;
        if (old + 1u == (gen + 1u) * nloc) {
            __builtin_amdgcn_fence(__ATOMIC_RELEASE, "agent");
            asm volatile("s_waitcnt vmcnt(0)" ::: "memory");
            const unsigned og = xb_add(&bar[XB_TOP], 1u);
            const unsigned tg = og / nx;
            if (og + 1u == (tg + 1u) * nx) xb_add(&bar[XB_TOPGEN], 1u);
            else XB_SPIN(xb_ld(&bar[XB_TOPGEN]) == tg, bar);
            __builtin_amdgcn_fence(__ATOMIC_ACQUIRE, "agent");
            xb_add(&bar[XB_XGEN(b.x)], 1u);
            asm volatile("s_waitcnt vmcnt(0)" ::: "memory");
        } else {
            XB_SPIN(xb_ld(&bar[XB_XGEN(b.x)]) == gen, bar);
            __builtin_amdgcn_fence(__ATOMIC_ACQUIRE, "agent");
            asm volatile("s_waitcnt vmcnt(0)" ::: "memory");
        }
    }
    __syncthreads();
}

__device__ __forceinline__ int lane_id_volatile() { int l; asm volatile("v_mbcnt_lo_u32_b32 %0, -1, 0\n\tv_mbcnt_hi_u32_b32 %0, -1, %0" : "=v"(l)); return l; }

#ifndef PH
#define PH 0xFFFF
#endif
#define ON(k) ((PH >> (k)) & 1)
#ifndef REP
#define REP 0
#endif
#define NREP(k) (1 + ((REP >> (k)) & 1))
__global__ void __launch_bounds__(NT, 2) mega_fwd(Args a_unused) {
    extern __shared__ __attribute__((aligned(16))) unsigned char lds[];
    cg::grid_group grid = cg::this_grid();
    const int G = gridDim.x, bid = blockIdx.x;
    const int wave_s = __builtin_amdgcn_readfirstlane(threadIdx.x >> 6);
    PG8_LAS unsigned char* ring = (PG8_LAS unsigned char*)lds;
#define PHASE_BEGIN int tid = wave_s * 64 + lane_id_volatile(); asm volatile("" : "+v"(tid)); const CAS Args* ap_ = (const CAS Args*)__builtin_amdgcn_kernarg_segment_ptr(); asm volatile("" : "+s"(ap_)); const CAS Args& a = *ap_; unsigned char* ws = a.ws; float* out = a.out; \
    const int lane = tid & 63, wave = __builtin_amdgcn_readfirstlane(tid >> 6); const int gw = bid * NW + wave, NGW = G * NW, gt = bid * NT + tid, NGT = G * NT; \
    (void)lane; (void)wave; (void)gw; (void)NGW; (void)gt; (void)NGT; (void)out; \
    const float* mod = (const float*)(ws + WS_MOD); const float* rope = (const float*)(ws + WS_ROPE); (void)mod; (void)rope; \
    bf16* XN = (bf16*)(ws + WS_XN); bf16* PROJ = (bf16*)(ws + WS_PROJ); bf16* A2 = (bf16*)(ws + WS_A2); bf16* MQKV = (bf16*)(ws + WS_MQKV); \
    bf16* KPE = (bf16*)(ws + WS_KPE); bf16* YCAT = (bf16*)(ws + WS_YCAT); bf16* ACT = (bf16*)(ws + WS_ACT); bf16* U = (bf16*)(ws + WS_U); \
    bf16* Qc_rot = (bf16*)(ws + WS_QC); bf16* Qc_raw = (bf16*)(ws + WS_QC + QSZ); bf16* Kc = (bf16*)(ws + WS_QC + 2 * QSZ); bf16* Vc = (bf16*)(ws + WS_QC + 2 * QSZ + KSZ); \
    bf16* Qd_rot = (bf16*)(ws + WS_QC + 2 * QSZ + 2 * KSZ); bf16* Qd_raw = Qd_rot + (size_t)NKR * 256; bf16* Kd = Qd_raw + (size_t)NKR * 256; bf16* Vd = Kd + (size_t)NKR * 128; \
    (void)XN; (void)PROJ; (void)A2; (void)MQKV; (void)KPE; (void)YCAT; (void)ACT; (void)U; (void)Qc_rot; (void)Qc_raw; (void)Kc; (void)Vc; (void)Qd_rot; (void)Qd_raw; (void)Kd; (void)Vd;
#define GSYNC() do { const CAS Args* bp_ = (const CAS Args*)__builtin_amdgcn_kernarg_segment_ptr(); asm volatile("" : "+s"(bp_)); XcdBarrier xb_; xb_.bar = (unsigned*)(bp_->ws + WS_BAR); xb_.x = xb_xcc_id(); \
    xb_.st = (volatile LAS unsigned*)((LAS unsigned char*)lds + LDS_CTL + 32); xcd_barrier(xb_, wave_s * 64 + lane_id_volatile()); } while (0)
#define LAYER_VALS const float* modl = mod + (size_t)l * 3 * 6144; unsigned char* wl = ws + WS_W + l * W_LSTRIDE; (void)modl; (void)wl; \
    const float* x0 = l == 0 ? a.in[0] : out; const float* x1 = l == 0 ? a.in[1] : out + (size_t)NPR * DM; (void)x0; (void)x1;

    if (threadIdx.x < 16) ((volatile LAS unsigned*)((LAS unsigned char*)lds + LDS_CTL))[threadIdx.x] = 0u;
    __syncthreads();
    for (int rep = 0; rep < NREP(0); ++rep) {
    if (ON(0)) { PHASE_BEGIN phase0(a, (LAS unsigned char*)lds, tid, lane, wave); }
    if (rep == 0) { grid.sync(); { PHASE_BEGIN if (tid == 0) (void)xb_add((unsigned*)(ws + WS_BAR) + XB_XCNT(xb_xcc_id()), 1u); } } else GSYNC(); }

    if (ON(1)) { PHASE_BEGIN bias_phase(a, ws, (LAS unsigned char*)lds, tid, lane, wave);
        prep_phase(a.in[0], a.in[1], a.in[12], mod, 1024, XN, (float*)(ws + WS_SS1), lane, gw, NGW); }
    GSYNC();
#pragma unroll
    for (int l = 0; l < 2; ++l) {
        for (int rep = 0; rep < NREP(2); ++rep) {
        if (ON(2)) { PHASE_BEGIN LAYER_VALS pg8::Gemm g{XN, (const bf16*)(wl + W_IN), NTOK, INP, DM, 0, 0}; pg8::StaticOrder S; S.init(NTOK, INP, G, bid);
          pg8::EpiBf16RS E{PROJ, INP, (const float*)(ws + WS_SS1), (const float*)(ws + WS_BIAS) + (size_t)l * 3 * NBIAS, NBIAS};
          pg8::gemm_phase<pg8::EpiBf16RS, pg8::StaticOrder, true, true>(ring, g, S, E, tid); }
        GSYNC(); }
        for (int rep = 0; rep < NREP(3); ++rep) {
        if (ON(3)) { PHASE_BEGIN P3Ptrs P; P.PROJ = PROJ; P.A2 = A2; P.KPE = KPE; P.YCAT = YCAT; P.Qc_rot = Qc_rot; P.Qc_raw = Qc_raw; P.Kc = Kc; P.Vc = Vc; P.Qd_rot = Qd_rot; P.Qd_raw = Qd_raw; P.Kd = Kd; P.Vd = Vd;
          P.conv_a = a.in[14]; P.gq_mla = a.in[15]; P.gkv_mla = a.in[17]; P.gq = a.in[19]; P.gk = a.in[20]; P.rope = rope;
          P.c_ckv = a.in[2]; P.c_kpe = a.in[3]; P.c_gk = a.in[4]; P.c_gv = a.in[5]; P.c_sk = a.in[6]; P.c_sv = a.in[7];
          P.o_ckv = out + 12582912; P.o_kpe = out + 14680064; P.o_gk = out + 15204352; P.o_gv = out + 17301504; P.o_sk = out + 19398656; P.o_sv = out + 21495808; P.l = l;
          p3_phase(P, lane, gw, NGW); }
        GSYNC(); }
        for (int rep = 0; rep < NREP(4); ++rep) {
        if (ON(4)) { PHASE_BEGIN LAYER_VALS pg8::Gemm g{A2, (const bf16*)(wl + W_B2), NKR, 1024, 384, 0, 0}; pg8::StaticOrder S; S.init(NKR, 1024, G, bid); pg8::EpiBf16 E{MQKV, 1024};
          pg8::gemm_phase<pg8::EpiBf16, pg8::StaticOrder, true, true>(ring, g, S, E, tid); }
        GSYNC(); }
        for (int rep = 0; rep < NREP(5); ++rep) {
        if (ON(5)) { PHASE_BEGIN AttnBufs B; B.MQKV = MQKV; B.KPE = KPE; B.Qc_rot = Qc_rot; B.Qc_raw = Qc_raw; B.Kc = Kc; B.Vc = Vc; B.Qd_rot = Qd_rot; B.Qd_raw = Qd_raw; B.Kd = Kd; B.Vd = Vd; B.YCAT = YCAT;
          B.sink = a.in[21] + l * 4; B.rope = rope; B.ctr = (unsigned*)(ws + WS_CTL) + 64 * l + 128 * rep;
          attn_phase(B, (LAS unsigned char*)lds, tid, lane, wave); }
        GSYNC(); }
        if (ON(6)) { PHASE_BEGIN LAYER_VALS pg8::Gemm g{YCAT, (const bf16*)(wl + W_OUT), NTOK, DM, DM, 0, 0}; pg8::StaticOrder S; S.init(NTOK, DM, G, bid);
          pg8::EpiResid E{x0, x1, out, modl + 2048, XN, (float*)(ws + WS_SS2), a.in[23] + l * DM, modl + 4096};
          pg8::gemm_phase<pg8::EpiResid, pg8::StaticOrder, true, true>(ring, g, S, E, tid);
          if (l == 0) { const int wk = G > 192 ? bid - 192 : bid, nwk = G > 192 ? G - 192 : G;
            if (wk >= 0) wconv(a, ws, 0, 4 | 8, wk * NW + wave, nwk * NW, (LAS float*)((LAS unsigned char*)lds + wave * 16640), lane); } }
        GSYNC();
        for (int rep = 0; rep < NREP(8); ++rep) {
        if (ON(8)) { PHASE_BEGIN LAYER_VALS pg8::Gemm g{XN, (const bf16*)(wl + W_UP), NTOK, DUP, DM, (size_t)128 * DM * 2, (size_t)DFF * DM * 2}; pg8::StaticOrder S; S.init(NTOK, DUP, G, bid);
          pg8::EpiUpGate E{ACT, (const float*)(ws + WS_SS2), (const float*)(ws + WS_BIAS) + (size_t)l * 3 * NBIAS + 2304, NBIAS, a.in[25] + (size_t)l * 3 * DUP, (float*)(ws + WS_HALO), ring + 131072};
          pg8::gemm_phase<pg8::EpiUpGate, pg8::StaticOrder, true, true>(ring, g, S, E, tid); }
        GSYNC(); }
        if (ON(10)) { PHASE_BEGIN LAYER_VALS pg8::Gemm g{ACT, (const bf16*)(wl + W_DOWN), NTOK, DM, DFF, 0, 0}; pg8::StaticOrder S; S.init(NTOK, DM, G, bid);
          {
            const float* cwl = a.in[25] + (size_t)l * 3 * DUP; const float* HALO = (const float*)(ws + WS_HALO); pg8::Unit hu;
            for (int ui = 0; S.next(ui, hu); ++ui) { if (hu.pm < 32) continue; const int k = hu.pm - 32, pos = k & 7;
                for (int idx = tid; idx < 2 * DFF; idx += NT) { const int which = idx >= DFF ? 1 : 0, j = idx - which * DFF;
                    if (which == 0 ? pos == 0 : pos == 7) continue;
                    const float* Pp = HALO + (size_t)(k * 4 + (which ? 3 : 1)) * DUP; const float* Ep = HALO + (size_t)((which ? k + 1 : k - 1) * 4 + (which ? 0 : 2)) * DUP; const float* wp = cwl + (which ? 2 : 0) * DUP;
                    const float ca = Pp[j] + wp[j] * Ep[j], cb = Pp[DFF + j] + wp[DFF + j] * Ep[DFF + j];
                    const float r = ca * __builtin_amdgcn_rcpf(1.f + __builtin_amdgcn_exp2f(-ca * LOG2E)) * cb;
                    ACT[(size_t)(hu.pm * 256 + (which ? 255 : 0)) * DFF + j] = (bf16)(pk2(r, r) & 0xffffu); } }
            asm volatile("s_waitcnt vmcnt(0)" ::: "memory"); __builtin_amdgcn_fence(__ATOMIC_RELEASE, "agent"); __builtin_amdgcn_fence(__ATOMIC_ACQUIRE, "agent"); __syncthreads(); }
          pg8::EpiResid E{out, out + (size_t)NPR * DM, out, modl + 5120, l == 0 ? XN : nullptr, (float*)(ws + WS_SS1), a.in[12] + DM, mod + (size_t)3 * 6144 + 1024};
          pg8::gemm_phase<pg8::EpiResid, pg8::StaticOrder, true, true>(ring, g, S, E, tid);
          if (l == 0) { const int wk = G > 192 ? bid - 192 : bid, nwk = G > 192 ? G - 192 : G;
            if (wk >= 0) wconv(a, ws, 1, 63, wk * NW + wave, nwk * NW, (LAS float*)((LAS unsigned char*)lds + wave * 16640), lane); } }
        GSYNC();
    }
#ifdef XSYNC
    for (int i = 0; i < XSYNC; ++i) GSYNC();
#endif
    { PHASE_BEGIN
    for (int row = gw; row < NTOK; row += NGW) {
        float* xr = out + (size_t)row * DM;
        f32x4 v[4]; float ss = 0.f;
#pragma unroll
        for (int j = 0; j < 4; ++j) { v[j] = *(const f32x4*)(xr + 4 * (lane + 64 * j)); ss += dot4(v[j]); }
        const float rs = rsqrtf(wave_sum(ss, lane) * (1.f / DM) + EPS);
#pragma unroll
        for (int j = 0; j < 4; ++j) { const int col = 4 * (lane + 64 * j); *(f32x4*)(xr + col) = v[j] * rs * *(const f32x4*)(a.in[27] + col); }
    } }
}

extern "C" void kernel_launch(void* const* d_in, const int* in_sizes, int n_in, void* d_out, int out_size, void* d_ws, size_t ws_size, hipStream_t stream) {
    static int grid = 0;
    if (grid == 0) {
        if (n_in != 28 || ws_size < WS_END) { fprintf(stderr, "kernel_launch: unexpected n_in %d / ws %zu\n", n_in, ws_size); grid = -1; return; }
        int dev = 0, cus = 0, per_cu = 0;
        hipGetDevice(&dev); hipDeviceGetAttribute(&cus, hipDeviceAttributeMultiprocessorCount, dev);
        hipFuncSetAttribute((const void*)mega_fwd, hipFuncAttributeMaxDynamicSharedMemorySize, LDS_BYTES);
        hipOccupancyMaxActiveBlocksPerMultiprocessor(&per_cu, (const void*)mega_fwd, NT, LDS_BYTES);
        if (per_cu < 1) per_cu = 1;
        grid = cus * per_cu;
        (void)hipGetLastError();
    }
    if (grid < 0) return;
    Args a{};
    for (int i = 0; i < 28; ++i) a.in[i] = (const float*)d_in[i];
    a.out = (float*)d_out; a.ws = (unsigned char*)d_ws;
    void* args[] = {&a};
    hipError_t e = hipLaunchCooperativeKernel((const void*)mega_fwd, dim3(grid), dim3(NT), args, LDS_BYTES, stream);
    if (e != hipSuccess) fprintf(stderr, "cooperative launch failed: %s (grid %d)\n", hipGetErrorString(e), grid);
}
```

```cpp
#include <hip/hip_runtime.h>
#include <hip/hip_cooperative_groups.h>
#include <cstdio>
#include <cstdint>
namespace cg = cooperative_groups;

namespace pg8 {
#define PG8_LAS __attribute__((address_space(3)))
typedef unsigned short bf16_t;
typedef short bf16x8 __attribute__((ext_vector_type(8)));
typedef float f32x4 __attribute__((ext_vector_type(4)));
typedef unsigned u32x4 __attribute__((ext_vector_type(4)));
constexpr int BM = 256, BK = 64, HALF = 128, HTB = HALF * BK * 2, STAGE_BYTES = 8 * HTB, NXCD = 8, WGM = 8;

__host__ __device__ __forceinline__ int lds_byte(int r, int c) { const int st = (r >> 4) * 2 + (c >> 5), rr = r & 15, cc = c & 31, ob = rr * 64 + cc * 2; return st * 1024 + (ob ^ (((ob >> 9) & 1) << 5)); }
__host__ __device__ __forceinline__ void stage_rc(int b, int& R, int& C) { const int st = b / 1024, sb = b % 1024, swz = sb ^ (((sb >> 9) & 1) << 5); R = (st >> 1) * 16 + swz / 64; C = (st & 1) * 32 + (swz % 64) / 2; }
__host__ __device__ __forceinline__ int perm32(int rho) { const int n = rho >> 4, i = rho & 15; return 8 * (i >> 2) + 4 * n + (i & 3); }

struct Unit { int pm, pn; };
struct Gemm { const bf16_t* A; const bf16_t* Bt; int M, N, K; size_t bstep, bhalf; };

struct StaticOrder {
    int nM, nN, nwg, G, c;
    __host__ __device__ __forceinline__ void init(int M, int N, int G_, int c_) { nM = M / BM; nN = N / BM; nwg = nM * nN; G = G_; c = c_; }
    __host__ __device__ __forceinline__ bool next(int i, Unit& u) const {
        const long L = (long)i * G + c; if (L >= nwg) return false;
        int wgid = (int)L; { const int q = nwg / NXCD, r = nwg % NXCD, xcd = wgid % NXCD, off = wgid / NXCD; wgid = (xcd < r ? xcd * (q + 1) : r * (q + 1) + (xcd - r) * q) + off; }
        const int nig = WGM * nN, gid = wgid / nig, fm = gid * WGM, gsz = (nM - fm) < WGM ? (nM - fm) : WGM;
        u.pm = fm + ((wgid % nig) % gsz); u.pn = (wgid % nig) / gsz; return true;
    }
    __device__ __forceinline__ void a_ready(const Unit&) const {}
    __device__ __forceinline__ void done(const Unit&) const {}
};

__device__ __forceinline__ unsigned cvt_pk_bf16(float lo, float hi) { unsigned r; asm volatile("v_cvt_pk_bf16_f32 %0, %1, %2" : "=v"(r) : "v"(lo), "v"(hi)); return r; }

struct EpiBf16 {
    static constexpr bool PERM = true, AFTER_DRAIN = false;
    bf16_t* O; int ldc;
    __device__ __forceinline__ void operator()(const f32x4 (&acc)[2][2][4][2], const Unit& u, int wr, int wc, int fr, int fq) const {
        asm volatile("" : "+v"(fr), "+v"(fq));
        const int row0 = u.pm * BM + wr * 64 + fr; const int col0 = u.pn * BM + wc * 32 + 8 * fq;
#pragma unroll
        for (int ai = 0; ai < 2; ++ai)
#pragma unroll
            for (int m = 0; m < 4; ++m) { bf16_t* rowp = O + (size_t)(row0 + ai * HALF + m * 16) * ldc + col0;
#pragma unroll
                for (int bj = 0; bj < 2; ++bj) { const f32x4 v0 = acc[ai][bj][m][0], v1 = acc[ai][bj][m][1];
                    u32x4 w; w.x = cvt_pk_bf16(v0[0], v0[1]); w.y = cvt_pk_bf16(v0[2], v0[3]); w.z = cvt_pk_bf16(v1[0], v1[1]); w.w = cvt_pk_bf16(v1[2], v1[3]);
                    *(u32x4*)(rowp + bj * HALF) = w; } }
    }
};
__device__ __forceinline__ float shx_(float v, int m, int lane) { return __builtin_bit_cast(float, __builtin_amdgcn_ds_bpermute((lane ^ m) << 2, __builtin_bit_cast(int, v))); }
__device__ __forceinline__ void row_scales(const float* SS, int row0, int fr, int fq, float (&rs)[8]) {
    f32x4 t[8];
#pragma unroll
    for (int q = 0; q < 8; ++q) t[q] = *(const f32x4*)(SS + (size_t)(row0 + (q >> 2) * HALF + (q & 3) * 16) * 16 + 4 * fq);
    const int lane = fq * 16 + fr;
#pragma unroll
    for (int q = 0; q < 8; ++q) { float v = (t[q][0] + t[q][1]) + (t[q][2] + t[q][3]); v += shx_(v, 16, lane); v += shx_(v, 32, lane); rs[q] = __builtin_amdgcn_rsqf(v * (1.f / 1024.f) + 1e-6f); }
}
struct EpiBf16RS {
    static constexpr bool PERM = true, AFTER_DRAIN = false;
    bf16_t* O; int ldc; const float* SS; const float* bias; int ldb;
    __device__ __forceinline__ void operator()(const f32x4 (&acc)[2][2][4][2], const Unit& u, int wr, int wc, int fr, int fq) const {
        asm volatile("" : "+v"(fr), "+v"(fq));
        const int cnd = u.pm < 32 ? 0 : 1 + ((u.pm - 32) >> 3);
        const int row0 = u.pm * BM + wr * 64 + fr; const int col0 = u.pn * BM + wc * 32 + 8 * fq;
        const float* bp = bias + (size_t)cnd * ldb + col0;
        f32x4 bv[2][2];
#pragma unroll
        for (int bj = 0; bj < 2; ++bj)
#pragma unroll
            for (int n = 0; n < 2; ++n) bv[bj][n] = *(const f32x4*)(bp + bj * HALF + 4 * n);
        float rsv[8]; row_scales(SS, row0, fr, fq, rsv);
#pragma unroll
        for (int ai = 0; ai < 2; ++ai)
#pragma unroll
            for (int m = 0; m < 4; ++m) { const int row = row0 + ai * HALF + m * 16; const float rs = rsv[ai * 4 + m];
                bf16_t* rowp = O + (size_t)row * ldc + col0;
#pragma unroll
                for (int bj = 0; bj < 2; ++bj) { const f32x4 v0 = acc[ai][bj][m][0] * rs + bv[bj][0], v1 = acc[ai][bj][m][1] * rs + bv[bj][1];
                    u32x4 w; w.x = cvt_pk_bf16(v0[0], v0[1]); w.y = cvt_pk_bf16(v0[2], v0[3]); w.z = cvt_pk_bf16(v1[0], v1[1]); w.w = cvt_pk_bf16(v1[2], v1[3]);
                    *(u32x4*)(rowp + bj * HALF) = w; } }
    }
};
struct EpiResid {
    static constexpr bool PERM = false, AFTER_DRAIN = false;
    const float* r0; const float* r1; float* out; const float* gate;
    bf16_t* XN; float* SS; const float* nrm; const float* sc;
    __device__ __forceinline__ void operator()(const f32x4 (&acc)[2][2][4][2], const Unit& u, int wr, int wc, int fr, int fq) const {
        asm volatile("" : "+v"(fr), "+v"(fq));
        const int cnd = u.pm < 32 ? 0 : 1 + ((u.pm - 32) >> 3);
        const float* gp = gate + cnd * 6144;
        const int col0 = u.pn * BM + wc * 32 + 4 * fq;
        const int rowb = u.pm * BM + wr * 64 + fr;
        const float* rs = (u.pm < 32 ? r0 + (size_t)rowb * 1024 : r1 + (size_t)(rowb - 8192) * 1024) + col0;
        float* op = out + (size_t)rowb * 1024 + col0;
        const bool prep = XN != nullptr;
        f32x4 gv[2][2], hv[2][2];
#pragma unroll
        for (int bj = 0; bj < 2; ++bj)
#pragma unroll
            for (int n = 0; n < 2; ++n) { gv[bj][n] = *(const f32x4*)(gp + col0 + bj * HALF + n * 16);
                hv[bj][n] = (f32x4){0.f, 0.f, 0.f, 0.f};
                if (prep) hv[bj][n] = *(const f32x4*)(nrm + col0 + bj * HALF + n * 16) * (1.f + *(const f32x4*)(sc + cnd * 6144 + col0 + bj * HALF + n * 16)); }
        f32x4 xc[2][2], xn[2][2];
#pragma unroll
        for (int bj = 0; bj < 2; ++bj)
#pragma unroll
            for (int n = 0; n < 2; ++n) xc[bj][n] = *(const f32x4*)(rs + bj * HALF + n * 16);
#pragma unroll
        for (int it = 0; it < 8; ++it) { const int ai = it >> 2, m = it & 3; const size_t ro = (size_t)(ai * HALF + m * 16) * 1024;
            if (it < 7) { const int ai2 = (it + 1) >> 2, m2 = (it + 1) & 3; const size_t ro2 = (size_t)(ai2 * HALF + m2 * 16) * 1024;
#pragma unroll
                for (int bj = 0; bj < 2; ++bj)
#pragma unroll
                    for (int n = 0; n < 2; ++n) xn[bj][n] = *(const f32x4*)(rs + ro2 + bj * HALF + n * 16); }
            float ssq = 0.f;
#pragma unroll
            for (int bj = 0; bj < 2; ++bj)
#pragma unroll
                for (int n = 0; n < 2; ++n) { const f32x4 v = xc[bj][n] + gv[bj][n] * acc[ai][bj][m][n];
                    *(f32x4*)(op + ro + bj * HALF + n * 16) = v;
                    if (prep) { ssq += (v[0] * v[0] + v[1] * v[1]) + (v[2] * v[2] + v[3] * v[3]); const f32x4 h = v * hv[bj][n];
                        unsigned w0 = cvt_pk_bf16(h[0], h[1]), w1 = cvt_pk_bf16(h[2], h[3]);
                        typedef unsigned u32x2_ __attribute__((ext_vector_type(2)));
                        *(u32x2_*)(XN + (size_t)(rowb + ai * HALF + m * 16) * 1024 + col0 + bj * HALF + n * 16) = (u32x2_){w0, w1}; } }
            if (prep) { const int lane = fq * 16 + fr; ssq += shx_(ssq, 16, lane); ssq += shx_(ssq, 32, lane);
                if (fq == 0) SS[(size_t)(rowb + ai * HALF + m * 16) * 16 + u.pn * 4 + wc] = ssq; }
#pragma unroll
            for (int bj = 0; bj < 2; ++bj)
#pragma unroll
                for (int n = 0; n < 2; ++n) xc[bj][n] = xn[bj][n];
        }
    }
};

struct EpiResidFinal {
    static constexpr bool PERM = false, AFTER_DRAIN = false;
    const float* res; float* out; const float* gate; float* SS; const float* fw; unsigned* cnt;
    __device__ __forceinline__ void operator()(f32x4 (&acc)[2][2][4][2], const Unit& u, int wr, int wc, int fr, int fq) const {
        asm volatile("" : "+v"(fr), "+v"(fq));
        const int cnd = u.pm < 32 ? 0 : 1 + ((u.pm - 32) >> 3);
        const float* gp = gate + cnd * 6144;
        const int col0 = u.pn * BM + wc * 32 + 4 * fq;
        const int rowb = u.pm * BM + wr * 64 + fr;
        const float* rs = res + (size_t)rowb * 1024 + col0;
        f32x4 gv[2][2];
#pragma unroll
        for (int bj = 0; bj < 2; ++bj)
#pragma unroll
            for (int n = 0; n < 2; ++n) gv[bj][n] = *(const f32x4*)(gp + col0 + bj * HALF + n * 16);
        f32x4 xc[2][2], xn[2][2];
#pragma unroll
        for (int bj = 0; bj < 2; ++bj)
#pragma unroll
            for (int n = 0; n < 2; ++n) xc[bj][n] = *(const f32x4*)(rs + bj * HALF + n * 16);
#pragma unroll
        for (int it = 0; it < 8; ++it) { const int ai = it >> 2, m = it & 3;
            if (it < 7) { const int ai2 = (it + 1) >> 2, m2 = (it + 1) & 3; const size_t ro2 = (size_t)(ai2 * HALF + m2 * 16) * 1024;
#pragma unroll
                for (int bj = 0; bj < 2; ++bj)
#pragma unroll
                    for (int n = 0; n < 2; ++n) xn[bj][n] = *(const f32x4*)(rs + ro2 + bj * HALF + n * 16); }
            float ssq = 0.f;
#pragma unroll
            for (int bj = 0; bj < 2; ++bj)
#pragma unroll
                for (int n = 0; n < 2; ++n) { const f32x4 v = xc[bj][n] + gv[bj][n] * acc[ai][bj][m][n]; acc[ai][bj][m][n] = v;
                    ssq += (v[0] * v[0] + v[1] * v[1]) + (v[2] * v[2] + v[3] * v[3]); }
            { const int lane = fq * 16 + fr; ssq += shx_(ssq, 16, lane); ssq += shx_(ssq, 32, lane);
              if (fq == 0) __hip_atomic_store(SS + (size_t)(rowb + ai * HALF + m * 16) * 16 + u.pn * 4 + wc, ssq, __ATOMIC_RELAXED, __HIP_MEMORY_SCOPE_AGENT); }
#pragma unroll
            for (int bj = 0; bj < 2; ++bj)
#pragma unroll
                for (int n = 0; n < 2; ++n) xc[bj][n] = xn[bj][n];
        }
        asm volatile("s_waitcnt vmcnt(0)" ::: "memory"); __builtin_amdgcn_s_barrier(); asm volatile("" ::: "memory");
        if (wr == 0 && wc == 0 && fr == 0 && fq == 0) {
            __builtin_amdgcn_fence(__ATOMIC_RELEASE, "agent"); asm volatile("s_waitcnt vmcnt(0)" ::: "memory");
            __hip_atomic_fetch_add(cnt + u.pm, 1u, __ATOMIC_RELAXED, __HIP_MEMORY_SCOPE_AGENT);
            unsigned sp = 0;
            while (__hip_atomic_load(cnt + u.pm, __ATOMIC_RELAXED, __HIP_MEMORY_SCOPE_AGENT) < 4u) { __builtin_amdgcn_s_sleep(1); if (++sp > (1u << 22)) break; }
            __builtin_amdgcn_fence(__ATOMIC_ACQUIRE, "agent"); asm volatile("s_waitcnt vmcnt(0)" ::: "memory");
        }
        __builtin_amdgcn_s_barrier(); asm volatile("" ::: "memory");
        float rsv[8];
        { f32x4 t[8];
#pragma unroll
          for (int q = 0; q < 8; ++q) { const float* sp = SS + (size_t)(rowb + (q >> 2) * HALF + (q & 3) * 16) * 16 + 4 * fq;
              t[q] = (f32x4){__hip_atomic_load(sp, __ATOMIC_RELAXED, __HIP_MEMORY_SCOPE_AGENT), __hip_atomic_load(sp + 1, __ATOMIC_RELAXED, __HIP_MEMORY_SCOPE_AGENT),
                             __hip_atomic_load(sp + 2, __ATOMIC_RELAXED, __HIP_MEMORY_SCOPE_AGENT), __hip_atomic_load(sp + 3, __ATOMIC_RELAXED, __HIP_MEMORY_SCOPE_AGENT)}; }
          const int lane = fq * 16 + fr;
#pragma unroll
          for (int q = 0; q < 8; ++q) { float v = (t[q][0] + t[q][1]) + (t[q][2] + t[q][3]); v += shx_(v, 16, lane); v += shx_(v, 32, lane); rsv[q] = __builtin_amdgcn_rsqf(v * (1.f / 1024.f) + 1e-6f); } }
        f32x4 wv[2][2];
#pragma unroll
        for (int bj = 0; bj < 2; ++bj)
#pragma unroll
            for (int n = 0; n < 2; ++n) wv[bj][n] = *(const f32x4*)(fw + col0 + bj * HALF + n * 16);
        float* op = out + (size_t)rowb * 1024 + col0;
#pragma unroll
        for (int it = 0; it < 8; ++it) { const int ai = it >> 2, m = it & 3; const size_t ro = (size_t)(ai * HALF + m * 16) * 1024;
#pragma unroll
            for (int bj = 0; bj < 2; ++bj)
#pragma unroll
                for (int n = 0; n < 2; ++n) *(f32x4*)(op + ro + bj * HALF + n * 16) = acc[ai][bj][m][n] * rsv[it] * wv[bj][n]; }
    }
};

__device__ __forceinline__ float dpp_ror1(float v) { return __builtin_bit_cast(float, __builtin_amdgcn_mov_dpp(__builtin_bit_cast(int, v), 0x121, 0xf, 0xf, false)); }
__device__ __forceinline__ float dpp_ror15(float v) { return __builtin_bit_cast(float, __builtin_amdgcn_mov_dpp(__builtin_bit_cast(int, v), 0x12f, 0xf, 0xf, false)); }
struct EpiUpGate {
    static constexpr bool PERM = true, AFTER_DRAIN = false;
    bf16_t* ACT; const float* SS; const float* bias; int ldb; const float* cw; float* HALO; PG8_LAS unsigned char* xb;
    __device__ __forceinline__ void operator()(f32x4 (&acc)[2][2][4][2], const Unit& u, int wr, int wc, int fr, int fq) const {
        asm volatile("" : "+v"(fr), "+v"(fq));
        const int cnd = u.pm < 32 ? 0 : 1 + ((u.pm - 32) >> 3);
        const bool samp = u.pm >= 32;
        const int j0 = u.pn * HALF + wc * 32 + 8 * fq;
        const int row0 = u.pm * BM + wr * 64 + fr;
        { const float* bp = bias + (size_t)cnd * ldb + j0;
          f32x4 bv[2][2];
#pragma unroll
          for (int bj = 0; bj < 2; ++bj)
#pragma unroll
              for (int n = 0; n < 2; ++n) bv[bj][n] = *(const f32x4*)(bp + bj * 2816 + 4 * n);
          float rsv[8]; row_scales(SS, row0, fr, fq, rsv);
#pragma unroll
          for (int ai = 0; ai < 2; ++ai)
#pragma unroll
              for (int m = 0; m < 4; ++m) { const float rs = rsv[ai * 4 + m];
#pragma unroll
                  for (int bj = 0; bj < 2; ++bj)
#pragma unroll
                      for (int n = 0; n < 2; ++n) acc[ai][bj][m][n] = acc[ai][bj][m][n] * rs + bv[bj][n]; } }
        PG8_LAS f32x4* WL = (PG8_LAS f32x4*)(xb + 8192);
        if (fr == 0) {
            f32x4 wt[2][2][3];
#pragma unroll
            for (int n = 0; n < 2; ++n)
#pragma unroll
                for (int bj = 0; bj < 2; ++bj)
#pragma unroll
                    for (int k = 0; k < 3; ++k) wt[n][bj][k] = *(const f32x4*)(cw + k * 5632 + bj * 2816 + j0 + 4 * n);
#pragma unroll
            for (int n = 0; n < 2; ++n)
#pragma unroll
                for (int bj = 0; bj < 2; ++bj)
#pragma unroll
                    for (int k = 0; k < 3; ++k) WL[((((wr * 4 + wc) * 4 + fq) * 2 + n) * 2 + bj) * 3 + k] = wt[n][bj][k];
        }
        PG8_LAS f32x4* XB = (PG8_LAS f32x4*)xb;
        const int wv = wr * 4 + wc, pw = (wr ^ 1) * 4 + wc;
        if (fr == 0) {
#pragma unroll
            for (int ai = 0; ai < 2; ++ai)
#pragma unroll
                for (int bj = 0; bj < 2; ++bj)
#pragma unroll
                    for (int n = 0; n < 2; ++n) XB[((wv * 4 + ai * 2) * 2 + bj) * 8 + 2 * fq + n] = acc[ai][bj][0][n]; }
        if (fr == 15) {
#pragma unroll
            for (int ai = 0; ai < 2; ++ai)
#pragma unroll
                for (int bj = 0; bj < 2; ++bj)
#pragma unroll
                    for (int n = 0; n < 2; ++n) XB[((wv * 4 + ai * 2 + 1) * 2 + bj) * 8 + 2 * fq + n] = acc[ai][bj][3][n]; }
        asm volatile("s_waitcnt lgkmcnt(0)" ::: "memory"); __builtin_amdgcn_s_barrier(); asm volatile("" ::: "memory");
        float* hb = HALO + (size_t)(samp ? u.pm - 32 : 0) * 4 * 5632;
#pragma unroll
        for (int ai = 0; ai < 2; ++ai) {
            const bool has_ab = !(wr == 0 && ai == 0), has_bl = !(wr == 1 && ai == 1);
            const int wab = (wr == 0) ? 1 : (ai == 0 ? 1 : 3), wbl = (wr == 0) ? (ai == 0 ? 0 : 2) : 2;
            unsigned pk[4][4];
#pragma unroll
            for (int n = 0; n < 2; ++n) {
                f32x4 ca[4];
#pragma unroll
                for (int bj = 0; bj < 2; ++bj) {
                    const PG8_LAS f32x4* wlp = WL + ((((wr * 4 + wc) * 4 + fq) * 2 + n) * 2 + bj) * 3;
                    const f32x4 w0 = wlp[0], w1 = wlp[1], w2 = wlp[2];
                    f32x4 ab = (f32x4){0.f, 0.f, 0.f, 0.f}, bl = ab;
                    if (has_ab) ab = XB[((pw * 4 + wab) * 2 + bj) * 8 + 2 * fq + n];
                    if (has_bl) bl = XB[((pw * 4 + wbl) * 2 + bj) * 8 + 2 * fq + n];
#pragma unroll
                    for (int m = 0; m < 4; ++m) {
                        f32x4 cvm;
#pragma unroll
                        for (int i = 0; i < 4; ++i) {
                            const float cur = acc[ai][bj][m][n][i];
                            const float pv = m == 0 ? ab[i] : acc[ai][bj][m == 0 ? 0 : m - 1][n][i];
                            const float nx = m == 3 ? bl[i] : acc[ai][bj][m == 3 ? 3 : m + 1][n][i];
                            const float up = dpp_ror1(fr == 15 ? pv : cur), dn = dpp_ror15(fr == 0 ? nx : cur);
                            cvm[i] = w0[i] * up + w1[i] * cur + w2[i] * dn;
                        }
                        if (samp) {
                            if (m == 0 && wr == 0 && ai == 0 && fr == 0) { *(f32x4*)(hb + 0 * 5632 + bj * 2816 + j0 + 4 * n) = acc[ai][bj][0][n]; *(f32x4*)(hb + 1 * 5632 + bj * 2816 + j0 + 4 * n) = cvm; }
                            if (m == 3 && wr == 1 && ai == 1 && fr == 15) { *(f32x4*)(hb + 2 * 5632 + bj * 2816 + j0 + 4 * n) = acc[ai][bj][3][n]; *(f32x4*)(hb + 3 * 5632 + bj * 2816 + j0 + 4 * n) = cvm; }
                        }
                        if (bj == 0) ca[m] = cvm;
                        else { float r[4];
#pragma unroll
                            for (int i = 0; i < 4; ++i) { const float xa = ca[m][i]; r[i] = xa * __builtin_amdgcn_rcpf(1.f + __builtin_amdgcn_exp2f(-xa * 1.4426950408889634f)) * cvm[i]; }
                            pk[m][2 * n] = cvt_pk_bf16(r[0], r[1]); pk[m][2 * n + 1] = cvt_pk_bf16(r[2], r[3]); }
                    }
                }
                __builtin_amdgcn_sched_barrier(0);
            }
#pragma unroll
            for (int m = 0; m < 4; ++m) *(u32x4*)(ACT + (size_t)(row0 + ai * HALF + m * 16) * 2816 + j0) = (u32x4){pk[m][0], pk[m][1], pk[m][2], pk[m][3]};
        }
    }
};

template <class Epi, class Sched, bool ALIGN_EPI = false, bool SP2 = false>
__device__ __forceinline__ void gemm_phase(PG8_LAS unsigned char* lds, const Gemm g, const Sched& S, const Epi& E, const int tid) {
    const int wid = __builtin_amdgcn_readfirstlane(tid >> 6), lane = tid & 63, wr = wid >> 2, wc = wid & 3, fr = lane & 15, fq = lane >> 4;
    const int K = g.K, nt = K / BK;
    unsigned voffA[2], voffB[2];
#pragma unroll
    for (int i = 0; i < 2; ++i) { int R, C; stage_rc(tid * 16 + i * 8192, R, C); const int Rb = Epi::PERM ? ((R & ~31) + perm32(R & 31)) : R;
        voffA[i] = (unsigned)(R * K + C) * 2u; voffB[i] = (unsigned)(Rb * K + C) * 2u; }
    const size_t kstep = (size_t)(BK * 2);
    const size_t hstep = (size_t)HALF * K * 2;
    const size_t tstep = 2 * hstep;
    const size_t bstep = g.bstep ? g.bstep : tstep, bh = g.bhalf ? g.bhalf : hstep;
    const unsigned ldsw = (unsigned)wid * 1024u;
    const int aoff = lds_byte(wr * 64 + fr, fq * 8), boff = lds_byte(wc * 32 + fr, fq * 8);
#define PG8_SA(b, h) (((b) * 2 + (h)) * HTB)
#define PG8_SB(b, h) ((4 + (b) * 2 + (h)) * HTB)
#define PG8_STAGE(bufoff, gbase, voff) do { _Pragma("unroll") for (int _i = 0; _i < 2; ++_i) \
        __builtin_amdgcn_global_load_lds((const unsigned*)((const char*)(gbase) + (voff)[_i]), (PG8_LAS unsigned*)(lds + (bufoff) + ldsw + _i * 8192), 16, 0, 0); } while (0)
#define PG8_LDA(dst, b, h) do { _Pragma("unroll") for (int m = 0; m < 4; ++m) _Pragma("unroll") for (int k = 0; k < 2; ++k) dst[m][k] = *(const PG8_LAS bf16x8*)(lds + PG8_SA(b, h) + aoff + m * 2048 + k * 1024); } while (0)
#define PG8_LDB(dst, b, h) do { _Pragma("unroll") for (int n = 0; n < 2; ++n) _Pragma("unroll") for (int k = 0; k < 2; ++k) dst[n][k] = *(const PG8_LAS bf16x8*)(lds + PG8_SB(b, h) + boff + n * 2048 + k * 1024); } while (0)
#define PG8_MMA(ai, bj, At, Bt) do { __builtin_amdgcn_s_setprio(1); _Pragma("unroll") for (int m = 0; m < 4; ++m) _Pragma("unroll") for (int n = 0; n < 2; ++n) _Pragma("unroll") for (int k = 0; k < 2; ++k) \
        acc[ai][bj][m][n] = __builtin_amdgcn_mfma_f32_16x16x32_bf16(Bt[n][k], At[m][k], acc[ai][bj][m][n], 0, 0, 0); __builtin_amdgcn_s_setprio(0); } while (0)
#define PG8_WAIT_V(n) asm volatile("s_waitcnt vmcnt(" #n ")" ::: "memory")
#define PG8_WAIT_L(n) asm volatile("s_waitcnt lgkmcnt(" #n ")" ::: "memory")
#define PG8_BAR __builtin_amdgcn_s_barrier()
#define PG8_SCHED __builtin_amdgcn_sched_barrier(0)
    Unit cur, nxt; int ui = 0;
    if (!S.next(0, cur)) return;
    f32x4 acc[2][2][4][2];
#pragma unroll
    for (int a = 0; a < 2; ++a)
#pragma unroll
        for (int b = 0; b < 2; ++b)
#pragma unroll
            for (int m = 0; m < 4; ++m)
#pragma unroll
                for (int n = 0; n < 2; ++n) acc[a][b][m][n] = (f32x4){0.f, 0.f, 0.f, 0.f};
    bf16x8 At[4][2], B0[2][2], B1[2][2];
    const char* cA = (const char*)g.A + (size_t)cur.pm * tstep; const char* cB = (const char*)g.Bt + (size_t)cur.pn * bstep;
    S.a_ready(cur);
    if constexpr (SP2) {
        PG8_STAGE(PG8_SB(0, 0), cB, voffB); PG8_STAGE(PG8_SB(0, 1), cB + bh, voffB); PG8_STAGE(PG8_SA(0, 0), cA, voffA); PG8_STAGE(PG8_SA(0, 1), cA + hstep, voffA);
        if (wr == 1) PG8_BAR;
        PG8_WAIT_V(2); PG8_BAR;
        PG8_STAGE(PG8_SB(1, 0), cB + kstep, voffB); PG8_STAGE(PG8_SA(1, 0), cA + kstep, voffA); PG8_STAGE(PG8_SB(1, 1), cB + bh + kstep, voffB);
        PG8_WAIT_V(6); PG8_BAR;
    } else {
        PG8_STAGE(PG8_SB(0, 0), cB, voffB); PG8_STAGE(PG8_SA(0, 0), cA, voffA); PG8_STAGE(PG8_SB(0, 1), cB + bh, voffB); PG8_STAGE(PG8_SA(0, 1), cA + hstep, voffA);
        if (wr == 1) PG8_BAR;
        PG8_WAIT_V(4); PG8_BAR;
        PG8_STAGE(PG8_SB(1, 0), cB + kstep, voffB); PG8_STAGE(PG8_SA(1, 0), cA + kstep, voffA); PG8_STAGE(PG8_SB(1, 1), cB + bh + kstep, voffB);
        PG8_WAIT_V(6); PG8_BAR;
    }
    for (;;) {
        const bool has_next = S.next(ui + 1, nxt);
        const char* nA = has_next ? (const char*)g.A + (size_t)nxt.pm * tstep : cA; const char* nB = has_next ? (const char*)g.Bt + (size_t)nxt.pn * bstep : cB;
        for (int t = 0; t < nt; t += 2) {
            const bool last = (t == nt - 2);
            const char* a1 = cA + (size_t)(t + 1) * kstep;
            const char* a2 = last ? nA : cA + (size_t)(t + 2) * kstep; const char* b2 = last ? nB : cB + (size_t)(t + 2) * kstep;
            const char* a3 = a2 + kstep; const char* b3 = b2 + kstep;
            if (last && has_next) S.a_ready(nxt);
            if constexpr (SP2) {
            PG8_LDB(B0, 0, 0); PG8_LDB(B1, 0, 1); PG8_SCHED; PG8_LDA(At, 0, 0); PG8_STAGE(PG8_SA(1, 1), a1 + hstep, voffA);
            PG8_WAIT_V(8); PG8_WAIT_L(0); PG8_BAR; PG8_MMA(0, 0, At, B0); PG8_MMA(0, 1, At, B1); PG8_BAR; PG8_SCHED;
            PG8_LDA(At, 0, 1); PG8_STAGE(PG8_SB(0, 0), b2, voffB); PG8_STAGE(PG8_SB(0, 1), b2 + bh, voffB); PG8_STAGE(PG8_SA(0, 0), a2, voffA);
            PG8_WAIT_V(8); PG8_WAIT_L(0); PG8_BAR; PG8_MMA(1, 0, At, B0); PG8_MMA(1, 1, At, B1); PG8_BAR; PG8_SCHED;
            PG8_LDB(B0, 1, 0); PG8_LDB(B1, 1, 1); PG8_SCHED; PG8_LDA(At, 1, 0); PG8_STAGE(PG8_SA(0, 1), a2 + hstep, voffA);
            PG8_WAIT_V(8); PG8_WAIT_L(0); PG8_BAR; PG8_MMA(0, 0, At, B0); PG8_MMA(0, 1, At, B1); PG8_BAR; PG8_SCHED;
            PG8_LDA(At, 1, 1); PG8_STAGE(PG8_SB(1, 0), b3, voffB); PG8_STAGE(PG8_SB(1, 1), b3 + bh, voffB); PG8_STAGE(PG8_SA(1, 0), a3, voffA);
            PG8_WAIT_V(8); PG8_WAIT_L(0); PG8_BAR; PG8_MMA(1, 0, At, B0); PG8_MMA(1, 1, At, B1); PG8_BAR; PG8_SCHED;
            } else {
            PG8_LDB(B0, 0, 0); PG8_SCHED; PG8_LDA(At, 0, 0); PG8_STAGE(PG8_SA(1, 1), a1 + hstep, voffA);
            PG8_WAIT_L(8); PG8_BAR; PG8_WAIT_L(0); PG8_MMA(0, 0, At, B0); PG8_BAR; PG8_SCHED;
            PG8_LDB(B1, 0, 1); PG8_STAGE(PG8_SB(0, 0), b2, voffB);
            PG8_BAR; PG8_WAIT_L(0); PG8_MMA(0, 1, At, B1); PG8_BAR;
            PG8_LDA(At, 0, 1); PG8_STAGE(PG8_SA(0, 0), a2, voffA);
            PG8_BAR; PG8_WAIT_L(0); PG8_MMA(1, 0, At, B0); PG8_BAR; PG8_SCHED;
            PG8_STAGE(PG8_SB(0, 1), b2 + bh, voffB);
            PG8_WAIT_V(6); PG8_BAR; PG8_MMA(1, 1, At, B1); PG8_BAR;
            PG8_LDB(B0, 1, 0); PG8_SCHED; PG8_LDA(At, 1, 0); PG8_STAGE(PG8_SA(0, 1), a2 + hstep, voffA);
            PG8_WAIT_L(8); PG8_BAR; PG8_WAIT_L(0); PG8_MMA(0, 0, At, B0); PG8_BAR; PG8_SCHED;
            PG8_LDB(B1, 1, 1); PG8_STAGE(PG8_SB(1, 0), b3, voffB);
            PG8_BAR; PG8_WAIT_L(0); PG8_MMA(0, 1, At, B1); PG8_BAR;
            PG8_LDA(At, 1, 1); PG8_STAGE(PG8_SA(1, 0), a3, voffA);
            PG8_BAR; PG8_WAIT_L(0); PG8_MMA(1, 0, At, B0); PG8_BAR; PG8_SCHED;
            PG8_STAGE(PG8_SB(1, 1), b3 + bh, voffB);
            PG8_WAIT_V(6); PG8_BAR; PG8_MMA(1, 1, At, B1); PG8_BAR;
            }
        }
        if constexpr (ALIGN_EPI) { if (wr == 0) PG8_BAR; }
        if constexpr (!Epi::AFTER_DRAIN) { E(acc, cur, wr, wc, fr, fq); S.done(cur); }
        if (!has_next) break;
#pragma unroll
        for (int a = 0; a < 2; ++a)
#pragma unroll
            for (int b = 0; b < 2; ++b)
#pragma unroll
                for (int m = 0; m < 4; ++m)
#pragma unroll
                    for (int n = 0; n < 2; ++n) acc[a][b][m][n] = (f32x4){0.f, 0.f, 0.f, 0.f};
        cur = nxt; cA = nA; cB = nB; ++ui;
        if constexpr (ALIGN_EPI) { if (wr == 1) PG8_BAR; }
    }
    PG8_WAIT_V(0);
    if constexpr (!ALIGN_EPI) { if (wr == 0) PG8_BAR; }
    PG8_BAR;
#undef PG8_SA
#undef PG8_SB
#undef PG8_STAGE
#undef PG8_LDA
#undef PG8_LDB
#undef PG8_MMA
#undef PG8_WAIT_V
#undef PG8_WAIT_L
#undef PG8_BAR
#undef PG8_SCHED
}
}

#define LAS __attribute__((address_space(3)))
#define CAS __attribute__((address_space(4)))
typedef unsigned short bf16;
typedef float f32x4 __attribute__((ext_vector_type(4)));
typedef short bf16x8 __attribute__((ext_vector_type(8)));
typedef unsigned u32x4 __attribute__((ext_vector_type(4)));
typedef unsigned u32x2 __attribute__((ext_vector_type(2)));

constexpr int NW = 8, NT = 512;
constexpr int DM = 1024, NTOK = 12288, NPR = 8192, NKR = 13312, INC = 2144, INP = 2304, DFF = 2816, DUP = 5632;
constexpr float EPS = 1e-6f, LOG2E = 1.4426950408889634f;
constexpr float QS = 0.125f * LOG2E;
constexpr float MLAQS = 0.10206207261596575f * LOG2E;

constexpr size_t MiB = 1u << 20;
constexpr size_t WS_CTL = 0, WS_MOD = 1 * MiB, WS_ROPE = 1 * MiB + 256 * 1024, WS_W = 2 * MiB, W_LSTRIDE = 24 * MiB;
constexpr size_t W_IN = 0, W_OUT = 4718592, W_UP = W_OUT + 2097152, W_DOWN = W_UP + 11534336, W_B2 = W_DOWN + 5767168;
static_assert(W_B2 + 786432 <= W_LSTRIDE, "weights");
constexpr size_t WS_XN = 50 * MiB, WS_PROJ = 74 * MiB, WS_A2 = 128 * MiB, WS_MQKV = 138 * MiB, WS_QC = 164 * MiB, WS_KPE = 203 * MiB, WS_YCAT = 204 * MiB;
constexpr size_t WS_ACT = 116 * MiB, WS_U = 116 * MiB, WS_SS1 = 248 * MiB, WS_SS2 = 249 * MiB, WS_HALO = 250 * MiB, WS_END = 252 * MiB;
constexpr size_t WS_BIAS = 65536;
constexpr int NBIAS = 2304 + 5632;
constexpr size_t QSZ = (size_t)NKR * 256 * 2, KSZ = (size_t)NKR * 128 * 2;
constexpr int LDS_BYTES = 163840, LDS_CTL = 163840 - 256;
constexpr size_t WS_BAR = 16384;

struct Args { const float* in[28]; float* out; unsigned char* ws; };

__device__ __forceinline__ unsigned f2bf(float f) { unsigned u = __builtin_bit_cast(unsigned, f); return (u + 0x7fffu + ((u >> 16) & 1u)) >> 16; }
__device__ __forceinline__ unsigned pk2(float lo, float hi) { unsigned r; asm("v_cvt_pk_bf16_f32 %0, %1, %2" : "=v"(r) : "v"(lo), "v"(hi)); return r; }
__device__ __forceinline__ float bflo(unsigned u) { return __builtin_bit_cast(float, u << 16); }
__device__ __forceinline__ float bfhi(unsigned u) { return __builtin_bit_cast(float, u & 0xffff0000u); }
__device__ __forceinline__ f32x4 ld4bf(const bf16* p) { const u32x2 u = *(const u32x2*)p; return (f32x4){bflo(u.x), bfhi(u.x), bflo(u.y), bfhi(u.y)}; }
__device__ __forceinline__ void st4bf(bf16* p, f32x4 v) { u32x2 u; u.x = pk2(v[0], v[1]); u.y = pk2(v[2], v[3]); *(u32x2*)p = u; }
__device__ __forceinline__ float shx(float v, int m, int lane) { return __builtin_bit_cast(float, __builtin_amdgcn_ds_bpermute((lane ^ m) << 2, __builtin_bit_cast(int, v))); }
#define DPPF(v, ctrl) __builtin_bit_cast(float, __builtin_amdgcn_mov_dpp(__builtin_bit_cast(int, (v)), (ctrl), 0xf, 0xf, false))
__device__ __forceinline__ float sum16(float v, int) { v += DPPF(v, 0x121); v += DPPF(v, 0x122); v += DPPF(v, 0x124); v += DPPF(v, 0x128); return v; }
__device__ __forceinline__ float wave_sum(float v, int lane) {
    v = sum16(v, lane);
    const int iv = __builtin_bit_cast(int, v);
    const float a = __builtin_bit_cast(float, __builtin_amdgcn_readlane(iv, 0)), b = __builtin_bit_cast(float, __builtin_amdgcn_readlane(iv, 16)),
                c = __builtin_bit_cast(float, __builtin_amdgcn_readlane(iv, 32)), d = __builtin_bit_cast(float, __builtin_amdgcn_readlane(iv, 48));
    return (a + b) + (c + d);
}
__device__ __forceinline__ float dot4(f32x4 a) { return (a[0] * a[0] + a[1] * a[1]) + (a[2] * a[2] + a[3] * a[3]); }
__device__ __forceinline__ f32x4 shfl4(f32x4 v, int m, int lane) { return (f32x4){shx(v[0], m, lane), shx(v[1], m, lane), shx(v[2], m, lane), shx(v[3], m, lane)}; }

__device__ __forceinline__ void transpose_item(const float* W, int N, bf16* WT, int ldk, int row_off, int k_off, float scale, LAS float* scr, int item, int lane) {
    const int nblk = (N + 63) / 64, kb = item / nblk, nb = item % nblk, k0 = 64 * kb, n0 = 64 * nb;
    const bool act = n0 + lane < N;
    const float* wp = W + (size_t)k0 * N + n0 + lane;
    float v[64];
#pragma unroll
    for (int i = 0; i < 64; ++i) v[i] = act ? wp[(size_t)i * N] : 0.f;
#pragma unroll
    for (int i = 0; i < 64; ++i) scr[i * 65 + lane] = v[i] * scale;
    asm volatile("s_waitcnt lgkmcnt(0)" ::: "memory");
    const int c = lane & 7;
#pragma unroll
    for (int j = 0; j < 8; ++j) { const int n = (lane >> 3) + 8 * j; const LAS float* s = scr + (8 * c) * 65 + n;
        u32x4 o; o.x = pk2(s[0 * 65], s[1 * 65]); o.y = pk2(s[2 * 65], s[3 * 65]); o.z = pk2(s[4 * 65], s[5 * 65]); o.w = pk2(s[6 * 65], s[7 * 65]);
        if (n0 + n < N) *(u32x4*)(WT + (size_t)(row_off + n0 + n) * ldk + k_off + k0 + 8 * c) = o; }
    asm volatile("s_waitcnt lgkmcnt(0)" ::: "memory");
}

template <class ArgsRef>
__device__ __forceinline__ void wconv(const ArgsRef& a, unsigned char* ws, int l, int sel, int w, int nwk, LAS float* scr, int lane) {
    constexpr int I_IN = 16 * 34, I_OUT = 16 * 16, I_UP = 16 * 88, I_DN = 44 * 16, I_Q = 3 * 6, I_KV = 2 * 8;
    const int n_in = (sel & 1) ? I_IN : 0, n_out = (sel & 2) ? I_OUT : 0, n_up = (sel & 4) ? I_UP : 0, n_dn = (sel & 8) ? I_DN : 0, n_q = (sel & 16) ? I_Q : 0, n_kv = (sel & 32) ? I_KV : 0;
    const int total = n_in + n_out + n_up + n_dn + n_q + n_kv;
    unsigned char* wl = ws + WS_W + l * W_LSTRIDE;
    for (int it = w; it < total; it += nwk) {
        int r = it;
        if (r < n_in) { transpose_item(a.in[13] + (size_t)l * 1024 * INC, INC, (bf16*)(wl + W_IN), 1024, 0, 0, 1.f, scr, r, lane); continue; } r -= n_in;
        if (r < n_out) { transpose_item(a.in[22] + (size_t)l * 1024 * 1024, 1024, (bf16*)(wl + W_OUT), 1024, 0, 0, 1.f, scr, r, lane); continue; } r -= n_out;
        if (r < n_up) { transpose_item(a.in[24] + (size_t)l * 1024 * DUP, DUP, (bf16*)(wl + W_UP), 1024, 0, 0, 1.f, scr, r, lane); continue; } r -= n_up;
        if (r < n_dn) { transpose_item(a.in[26] + (size_t)l * DFF * 1024, 1024, (bf16*)(wl + W_DOWN), DFF, 0, 0, 1.f, scr, r, lane); continue; } r -= n_dn;
        if (r < n_q) { transpose_item(a.in[16] + (size_t)l * 192 * 384, 384, (bf16*)(wl + W_B2), 384, 0, 0, MLAQS, scr, r, lane); continue; } r -= n_q;
        transpose_item(a.in[18] + (size_t)l * 128 * 512, 512, (bf16*)(wl + W_B2), 384, 384, 192, 1.f, scr, r, lane);
    }
}
template <class ArgsRef>
__device__ __forceinline__ void phase0(const ArgsRef& a, LAS unsigned char* lds, int tid, int lane, int wave) {
    unsigned char* ws = a.ws;
    const int G = gridDim.x, bid = blockIdx.x;
    if (bid < 96) {
        LAS float* sl = (LAS float*)(lds + 16384);
        for (int e = tid; e < 3072; e += NT) { const int c = e >> 10, k = e & 1023; const float v = c == 0 ? a.in[9][k] : a.in[8][(c - 1) * 1024 + k]; sl[e] = v / (1.f + __expf(-v)); }
        __syncthreads();
    }
    for (int it = bid; it < 96; it += G) {
        const int l = it / 48, n0 = (it % 48) * 128;
        const float* wa = a.in[10] + (size_t)l * 1024 * 6144;
        const LAS float* sl = (const LAS float*)(lds + 16384);
        float acc[3][2] = {{0.f, 0.f}, {0.f, 0.f}, {0.f, 0.f}};
        const int kb = wave * 128;
#pragma unroll 16
        for (int k = 0; k < 128; ++k) {
            const int kk = kb + k;
            const float2 w = *(const float2*)(wa + (size_t)kk * 6144 + n0 + 2 * lane);
            const float s0 = sl[kk], s1 = sl[1024 + kk], s2 = sl[2048 + kk];
            acc[0][0] += s0 * w.x; acc[0][1] += s0 * w.y; acc[1][0] += s1 * w.x; acc[1][1] += s1 * w.y; acc[2][0] += s2 * w.x; acc[2][1] += s2 * w.y;
        }
        LAS float* red = (LAS float*)lds;
#pragma unroll
        for (int c = 0; c < 3; ++c) { red[(wave * 3 + c) * 128 + 2 * lane] = acc[c][0]; red[(wave * 3 + c) * 128 + 2 * lane + 1] = acc[c][1]; }
        __syncthreads();
        if (tid < 384) { const int c = tid / 128, n = tid % 128; float s = 0.f;
#pragma unroll
            for (int w = 0; w < 8; ++w) s += red[(w * 3 + c) * 128 + n];
            ((float*)(ws + WS_MOD))[(size_t)(l * 3 + c) * 6144 + n0 + n] = s + a.in[11][(size_t)l * 6144 + n0 + n]; }
        __syncthreads();
    }
    if (bid == G - 1) {
        float* rt = (float*)(ws + WS_ROPE);
        for (int e = tid; e < 1024; e += NT) { const int pos = e >> 4, i = e & 15; const float inv = exp2f(-(float)(2 * i) / 32.f * 13.287712379549449f); const float ang = (float)pos * inv;
            rt[e] = __cosf(ang); rt[1024 + e] = __sinf(ang); }
        for (int e = tid; e < 512; e += NT) { const int pos = e >> 3, i = e & 7; const float inv = exp2f(-(float)(2 * i) / 16.f * 13.287712379549449f); const float ang = (float)pos * inv;
            rt[2048 + e] = __cosf(ang); rt[2560 + e] = __sinf(ang); }
    }
    const int gt = bid * NT + tid, NGT = G * NT;
    if (gt < 256) ((unsigned*)(ws + WS_CTL))[gt] = 0u;
    if (gt < 64) ((unsigned*)(ws + WS_CTL))[2048 + gt] = 0u;
    for (int l = 0; l < 2; ++l) {
        bf16* b2 = (bf16*)(ws + WS_W + l * W_LSTRIDE + W_B2);
        for (int ch = gt; ch < 1024 * 48; ch += NGT) { const int n = ch / 48, k = (ch % 48) * 8;
            const bool data = (n < 384 && k < 192) || (n >= 384 && n < 896 && k >= 192 && k < 320);
            if (!data) *(u32x4*)(b2 + (size_t)n * 384 + k) = (u32x4){0u, 0u, 0u, 0u}; }
        bf16* wi = (bf16*)(ws + WS_W + l * W_LSTRIDE + W_IN) + (size_t)INC * 1024;
        for (int ch = gt; ch < 160 * 128; ch += NGT) *(u32x4*)(wi + (size_t)ch * 8) = (u32x4){0u, 0u, 0u, 0u};
    }
    LAS float* scr = (LAS float*)(lds + 28672 + wave * 16640);
    wconv(a, ws, 0, 1 | 2 | 16 | 32, bid * NW + wave, G * NW, scr, lane);
}

__device__ __forceinline__ void prep_phase(const float* x0, const float* x1, const float* nw, const float* mod, int sc_off, bf16* XN, float* SS, int lane, int gw, int NGW) {
    for (int row = gw; row < NTOK; row += NGW) {
        const float* xr = row < NPR ? x0 + (size_t)row * DM : x1 + (size_t)(row - NPR) * DM;
        const int c = row < NPR ? 0 : 1 + ((row - NPR) >> 11);
        const float* mp = mod + c * 6144;
        f32x4 v[4]; float ss = 0.f;
#pragma unroll
        for (int j = 0; j < 4; ++j) { v[j] = *(const f32x4*)(xr + 4 * (lane + 64 * j)); ss += dot4(v[j]); }
        ss = wave_sum(ss, lane);
#pragma unroll
        for (int j = 0; j < 4; ++j) { const int col = 4 * (lane + 64 * j);
            const f32x4 g = *(const f32x4*)(nw + col), sc = *(const f32x4*)(mp + sc_off + col);
            st4bf(XN + (size_t)row * DM + col, v[j] * g * (1.f + sc)); }
        if (lane < 16) SS[(size_t)row * 16 + lane] = lane == 0 ? ss : 0.f;
    }
}
template <class ArgsRef>
__device__ __forceinline__ void bias_phase(const ArgsRef& a, unsigned char* ws, LAS unsigned char* lds, int tid, int lane, int wave) {
    const float* mod = (const float*)(ws + WS_MOD);
    float* BIAS = (float*)(ws + WS_BIAS);
    for (int it = blockIdx.x; it < 62; it += gridDim.x) {
        const int l = it / 31, r = it % 31; const bool up = r >= 9;
        const int N = up ? DUP : INC, n0 = (up ? r - 9 : r) * 256 + 4 * lane;
        const float* W = up ? a.in[24] + (size_t)l * 1024 * DUP : a.in[13] + (size_t)l * 1024 * INC;
        const float* shp = mod + (size_t)l * 3 * 6144 + (up ? 3072 : 0);
        LAS float* sl = (LAS float*)(lds + 32768);
        for (int e = tid; e < 3072; e += NT) sl[e] = shp[(e >> 10) * 6144 + (e & 1023)];
        __syncthreads();
        const bool act = n0 < N;
        f32x4 acc[3] = {(f32x4){0.f, 0.f, 0.f, 0.f}, (f32x4){0.f, 0.f, 0.f, 0.f}, (f32x4){0.f, 0.f, 0.f, 0.f}};
        const int kb = wave * 128;
#pragma unroll 16
        for (int k = 0; k < 128; ++k) { const int kk = kb + k;
            const f32x4 w = act ? *(const f32x4*)(W + (size_t)kk * N + n0) : (f32x4){0.f, 0.f, 0.f, 0.f};
            acc[0] += w * sl[kk]; acc[1] += w * sl[1024 + kk]; acc[2] += w * sl[2048 + kk]; }
        LAS f32x4* red = (LAS f32x4*)lds;
#pragma unroll
        for (int c = 0; c < 3; ++c) red[(wave * 3 + c) * 64 + lane] = acc[c];
        __syncthreads();
        if (tid < 192) { const int c = tid >> 6, ln = tid & 63; f32x4 t = red[c * 64 + ln];
#pragma unroll
            for (int w = 1; w < 8; ++w) t += red[(w * 3 + c) * 64 + ln];
            const int nn = (up ? r - 9 : r) * 256 + 4 * ln;
            if (nn < N) *(f32x4*)(BIAS + (size_t)(l * 3 + c) * NBIAS + (up ? 2304 : 0) + nn) = t;
            else if (!up && nn < 2304) *(f32x4*)(BIAS + (size_t)(l * 3 + c) * NBIAS + nn) = (f32x4){0.f, 0.f, 0.f, 0.f}; }
        __syncthreads();
    }
}

struct P3Ptrs {
    const bf16* PROJ; bf16 *A2, *KPE, *YCAT, *Qc_rot, *Qc_raw, *Kc, *Vc, *Qd_rot, *Qd_raw, *Kd, *Vd;
    const float *conv_a, *gq_mla, *gkv_mla, *gq, *gk, *rope;
    const float *c_ckv, *c_kpe, *c_gk, *c_gv, *c_sk, *c_sv;
    float *o_ckv, *o_kpe, *o_gk, *o_gv, *o_sk, *o_sv;
    int l;
};
__device__ __forceinline__ f32x4 rope64(f32x4 v, int jl, int prow, int pcol, const float* rt, int lane) {
    const f32x4 pr = shfl4(v, 4, lane);
    const int pos = jl < 8 ? prow : pcol, fi = 4 * (jl & 3);
    const f32x4 c = *(const f32x4*)(rt + pos * 16 + fi), s = *(const f32x4*)(rt + 1024 + pos * 16 + fi);
    const float sg = (jl & 4) ? 1.f : -1.f;
    return v * c + pr * s * sg;
}
__device__ __forceinline__ void p3_phase(const P3Ptrs& P, int lane, int gw, int NGW) {
    const int l = P.l;
    for (int row = gw; row < NKR; row += NGW) {
        if (row < NTOK) {
            const bool samp = row >= NPR;
            int b, t, kr, T;
            if (!samp) { b = row >> 8; t = row & 255; kr = row; T = 256; } else { b = (row - NPR) >> 11; t = (row - NPR) & 2047; kr = NPR + b * 2560 + t; T = 2048; }
            const int prow = t >> 6, pcol = t & 63;
            const bf16* pr = P.PROJ + (size_t)row * INP;
            const size_t ob = (size_t)((b * 2 + l) * 256 + t);
            const int ci = 4 * lane, jl = lane & 15;
            const u32x2 z2 = (u32x2){0u, 0u};
            const bool hp = t > 0, hn = t < T - 1;
            const u32x2 r_xa = *(const u32x2*)(pr + ci), r_gb = *(const u32x2*)(pr + 256 + ci), r_gc = *(const u32x2*)(pr + 512 + ci);
            const u32x2 r_pxa = hp ? *(const u32x2*)(pr - INP + ci) : z2, r_pgc = hp ? *(const u32x2*)(pr - INP + 512 + ci) : z2;
            const u32x2 r_nxa = hn ? *(const u32x2*)(pr + INP + ci) : z2, r_ngc = hn ? *(const u32x2*)(pr + INP + 512 + ci) : z2;
            const u32x2 r_cq = lane < 48 ? *(const u32x2*)(pr + 768 + ci) : z2, r_ckv = lane < 32 ? *(const u32x2*)(pr + 960 + ci) : z2, r_kpe = lane < 8 ? *(const u32x2*)(pr + 1088 + ci) : z2;
            const u32x2 r_qc = *(const u32x2*)(pr + 1120 + ci), r_kvc = *(const u32x2*)(pr + 1376 + ci), r_qd = *(const u32x2*)(pr + 1632 + ci), r_kvd = *(const u32x2*)(pr + 1888 + ci);
            const float* cw = P.conv_a + (size_t)l * 768;
            const f32x4 w0 = *(const f32x4*)(cw + ci), w1 = *(const f32x4*)(cw + 256 + ci), w2 = *(const f32x4*)(cw + 512 + ci);
            const f32x4 g_qm = lane < 48 ? *(const f32x4*)(P.gq_mla + l * 192 + ci) : (f32x4){0.f, 0.f, 0.f, 0.f}, g_kvm = lane < 32 ? *(const f32x4*)(P.gkv_mla + l * 128 + ci) : (f32x4){0.f, 0.f, 0.f, 0.f};
            const f32x4 g_q = *(const f32x4*)(P.gq + l * 64 + 4 * jl), g_k = *(const f32x4*)(P.gk + l * 64 + 4 * jl);
            const int pos64 = jl < 8 ? prow : pcol, fi64 = 4 * (jl & 3);
            const f32x4 c64 = *(const f32x4*)(P.rope + pos64 * 16 + fi64), s64 = *(const f32x4*)(P.rope + 1024 + pos64 * 16 + fi64);
            const int pos32 = (lane & 7) < 4 ? prow : pcol, fi32 = 4 * (lane & 1);
            const f32x4 c32 = *(const f32x4*)(P.rope + 2048 + pos32 * 8 + fi32), s32 = *(const f32x4*)(P.rope + 2560 + pos32 * 8 + fi32);
#define CV4(u) ((f32x4){bflo((u).x), bfhi((u).x), bflo((u).y), bfhi((u).y)})
#define ROPE64(v) ((v) * c64 + shfl4((v), 4, lane) * s64 * ((jl & 4) ? 1.f : -1.f))
            { const f32x4 ya = CV4(r_gb) * (w0 * (CV4(r_pxa) * CV4(r_pgc)) + w1 * (CV4(r_xa) * CV4(r_gc)) + w2 * (CV4(r_nxa) * CV4(r_ngc)));
              st4bf(P.YCAT + (size_t)row * DM + ci, ya); }
            { const f32x4 v = CV4(r_cq);
              const float rs = rsqrtf(wave_sum(dot4(v), lane) * (1.f / 192.f) + EPS);
              if (lane < 48) st4bf(P.A2 + (size_t)kr * 384 + ci, v * rs * g_qm); }
            { const f32x4 v = CV4(r_ckv);
              const float rs = rsqrtf(wave_sum(dot4(v), lane) * (1.f / 128.f) + EPS);
              if (lane < 32) { const f32x4 o = v * rs * g_kvm;
                  st4bf(P.A2 + (size_t)kr * 384 + 192 + ci, o);
                  if (!samp) *(f32x4*)(P.o_ckv + ob * 128 + ci) = o; }
              else if (lane < 48) { unsigned zz = 0u; asm volatile("" : "+v"(zz)); *(u32x2*)(P.A2 + (size_t)kr * 384 + 320 + 4 * (lane - 32)) = (u32x2){zz, zz}; } }
            { const f32x4 v = CV4(r_kpe);
              const f32x4 r = v * c32 + shfl4(v, 2, lane) * s32 * ((lane & 2) ? 1.f : -1.f);
              if (lane < 8) { if (!samp) *(f32x4*)(P.o_kpe + ob * 32 + ci) = v; st4bf(P.KPE + (size_t)kr * 32 + ci, samp ? r : v); } }
            { f32x4 v = CV4(r_qc);
              const float rs = rsqrtf(sum16(dot4(v), lane) * (1.f / 64.f) + EPS);
              v = v * rs * g_q;
              st4bf(P.Qc_raw + (size_t)kr * 256 + ci, v * QS);
              const f32x4 r = ROPE64(v);
              if (samp) st4bf(P.Qc_rot + (size_t)kr * 256 + ci, r * QS); }
            { const f32x4 v = CV4(r_kvc);
              const float rs = rsqrtf(sum16(dot4(v), lane) * (1.f / 64.f) + EPS);
              const f32x4 kn = v * rs * g_k;
              const f32x4 r = ROPE64(kn);
              if (lane < 32) { if (!samp) *(f32x4*)(P.o_gk + ob * 128 + ci) = kn; st4bf(P.Kc + (size_t)kr * 128 + ci, samp ? r : kn); }
              else { if (!samp) *(f32x4*)(P.o_gv + ob * 128 + 4 * (lane - 32)) = v; st4bf(P.Vc + (size_t)kr * 128 + 4 * (lane - 32), v); } }
            { const f32x4 v = CV4(r_qd);
              st4bf(P.Qd_raw + (size_t)kr * 256 + ci, v * QS);
              const f32x4 r = ROPE64(v);
              if (samp) st4bf(P.Qd_rot + (size_t)kr * 256 + ci, r * QS); }
            { const f32x4 v = CV4(r_kvd);
              const f32x4 r = ROPE64(v);
              if (lane < 32) { if (!samp) *(f32x4*)(P.o_sk + ob * 128 + ci) = v; st4bf(P.Kd + (size_t)kr * 128 + ci, samp ? r : v); }
              else { if (!samp) *(f32x4*)(P.o_sv + ob * 128 + 4 * (lane - 32)) = v; st4bf(P.Vd + (size_t)kr * 128 + 4 * (lane - 32), v); } }
#undef CV4
#undef ROPE64
        } else {
            const int ci = row - NTOK, b = ci >> 9, j = ci & 511, kr = NPR + b * 2560 + 2048 + j;
            const size_t cb = (size_t)((b * 2 + l) * 512 + j);
            f32x4 z = (f32x4){0.f, 0.f, 0.f, 0.f}; asm volatile("" : "+v"(z));
            if (lane < 48) st4bf(P.A2 + (size_t)kr * 384 + 4 * lane, z);
            if (lane < 32) st4bf(P.A2 + (size_t)kr * 384 + 192 + 4 * lane, *(const f32x4*)(P.c_ckv + cb * 128 + 4 * lane));
            else if (lane < 48) st4bf(P.A2 + (size_t)kr * 384 + 320 + 4 * (lane - 32), z);
            if (lane < 8) st4bf(P.KPE + (size_t)kr * 32 + 4 * lane, *(const f32x4*)(P.c_kpe + cb * 32 + 4 * lane));
            if (lane < 32) { st4bf(P.Kc + (size_t)kr * 128 + 4 * lane, *(const f32x4*)(P.c_gk + cb * 128 + 4 * lane));
                             st4bf(P.Kd + (size_t)kr * 128 + 4 * lane, *(const f32x4*)(P.c_sk + cb * 128 + 4 * lane)); }
            else { st4bf(P.Vc + (size_t)kr * 128 + 4 * (lane - 32), *(const f32x4*)(P.c_gv + cb * 128 + 4 * (lane - 32)));
                   st4bf(P.Vd + (size_t)kr * 128 + 4 * (lane - 32), *(const f32x4*)(P.c_sv + cb * 128 + 4 * (lane - 32))); }
        }
    }
}

struct AttnSrc {
    const bf16* Qraw; const bf16* Qrot; int qpitch;
    const bf16* K0; int k0pitch; const bf16* K1;
    const bf16* V; int vpitch;
    bf16* Y; int outcol;
    int krbase, rowbase, q0, lo, hi, nctx;
    bool samp, window; float m0; bool sink;
    const float* rope;
};
template <int DK>
__device__ __forceinline__ void attn_unit(const AttnSrc& S, LAS unsigned char* lds, int tid, int lane, int wave) {
    constexpr int TK = 128, NKB = TK / 16, NPP = TK / 32;
    constexpr int KP = DK + 8, VP = TK + 8, KS = DK / 32, CPK = DK / 8;
    constexpr int NKC = TK * CPK / NT, NVC = TK * 8 / NT;
    LAS bf16* Ks = (LAS bf16*)lds;
    LAS bf16* Vt = (LAS bf16*)(lds + 2 * TK * KP * 2);
    const int g = lane >> 4, fr = lane & 15;
    const int qpos = S.q0 + wave * 16 + fr;
    const size_t qkr = (size_t)(S.krbase + qpos);
    bf16x8 qraw[KS], qrot[KS];
#pragma unroll
    for (int ks = 0; ks < KS; ++ks) { qraw[ks] = *(const bf16x8*)(S.Qraw + qkr * S.qpitch + ks * 32 + g * 8); qrot[ks] = qraw[ks]; }
    if (S.samp) {
        if (DK == 96) {
            const bf16x8 own = qraw[KS - 1], par = *(const bf16x8*)(S.Qraw + qkr * S.qpitch + 64 + (g ^ 1) * 8);
            const int pos = g < 2 ? (qpos >> 6) : (qpos & 63);
            const float sg = (g & 1) ? 1.f : -1.f;
            const float* ct = S.rope + 2048 + pos * 8; const float* st = S.rope + 2560 + pos * 8;
            bf16x8 r;
#pragma unroll
            for (int e = 0; e < 8; ++e) { const float o = bflo((unsigned)(unsigned short)own[e]), p = bflo((unsigned)(unsigned short)par[e]);
                r[e] = (short)f2bf(o * ct[e] + p * st[e] * sg); }
            qrot[KS - 1] = r;
        } else {
#pragma unroll
            for (int ks = 0; ks < KS; ++ks) qrot[ks] = *(const bf16x8*)(S.Qrot + qkr * S.qpitch + ks * 32 + g * 8);
        }
    }
    bf16x8 qc[KS];
#pragma unroll
    for (int ks = 0; ks < KS; ++ks) qc[ks] = S.samp ? qrot[ks] : qraw[ks];
    float m = S.m0, l = (S.sink && g == 0) ? 1.f : 0.f;
    f32x4 o[4];
#pragma unroll
    for (int d = 0; d < 4; ++d) o[d] = (f32x4){0.f, 0.f, 0.f, 0.f};
    const int nloc = S.hi - S.lo, ntile = nloc + S.nctx;
    u32x4 kreg[NKC], vreg[NVC];
    auto gload = [&](int j) {
        const int tile = j < nloc ? S.lo + j : (2048 / TK) + (j - nloc);
        const size_t kr = (size_t)(S.krbase + tile * TK);
#pragma unroll
        for (int c = 0; c < NKC; ++c) { const int ch = tid + c * NT, key = ch / CPK, part = ch % CPK;
            if (DK == 64) kreg[c] = *(const u32x4*)(S.K0 + (kr + key) * S.k0pitch + part * 8);
            else kreg[c] = part < 8 ? *(const u32x4*)(S.K0 + (kr + key) * S.k0pitch + part * 8) : *(const u32x4*)(S.K1 + (kr + key) * 32 + (part - 8) * 8); }
#pragma unroll
        for (int c = 0; c < NVC; ++c) { const int ch = tid + c * NT, vkey = ch & (TK - 1), vdc = ch / TK;
            vreg[c] = *(const u32x4*)(S.V + (kr + vkey) * S.vpitch + vdc * 8); }
    };
    auto lstore = [&](int buf) {
        LAS bf16* kb = Ks + buf * TK * KP; LAS bf16* vb = Vt + buf * 64 * VP;
#pragma unroll
        for (int c = 0; c < NKC; ++c) { const int ch = tid + c * NT, key = ch / CPK, part = ch % CPK; *(LAS u32x4*)(kb + key * KP + part * 8) = kreg[c]; }
#pragma unroll
        for (int c = 0; c < NVC; ++c) { const int ch = tid + c * NT, vkey = ch & (TK - 1), vdc = ch / TK;
            LAS bf16* vp = vb + (vdc * 8) * VP + vkey; const u32x4 v = vreg[c];
            vp[0 * VP] = (bf16)(v.x & 0xffffu); vp[1 * VP] = (bf16)(v.x >> 16); vp[2 * VP] = (bf16)(v.y & 0xffffu); vp[3 * VP] = (bf16)(v.y >> 16);
            vp[4 * VP] = (bf16)(v.z & 0xffffu); vp[5 * VP] = (bf16)(v.z >> 16); vp[6 * VP] = (bf16)(v.w & 0xffffu); vp[7 * VP] = (bf16)(v.w >> 16); }
    };
    gload(0); lstore(0);
    __syncthreads();
    for (int j = 0; j < ntile; ++j) {
        const int buf = j & 1;
        if (j + 1 < ntile) gload(j + 1);
        const bool loc = j < nloc;
        if (j == nloc) {
#pragma unroll
            for (int ks = 0; ks < KS; ++ks) qc[ks] = qraw[ks]; }
        const LAS bf16* kb = Ks + buf * TK * KP; const LAS bf16* vb = Vt + buf * 64 * VP;
        f32x4 s[NKB];
#pragma unroll
        for (int kk = 0; kk < NKB; ++kk) { s[kk] = (f32x4){0.f, 0.f, 0.f, 0.f};
#pragma unroll
            for (int ks = 0; ks < KS; ++ks) { const bf16x8 af = *(const LAS bf16x8*)(kb + (kk * 16 + fr) * KP + ks * 32 + g * 8);
                s[kk] = __builtin_amdgcn_mfma_f32_16x16x32_bf16(af, qc[ks], s[kk], 0, 0, 0); } }
        if (S.window && loc) {
            const int kp0 = (S.lo + j) * TK + g * 4;
#pragma unroll
            for (int kk = 0; kk < NKB; ++kk)
#pragma unroll
                for (int i = 0; i < 4; ++i) { const int d = kp0 + kk * 16 + i - qpos; if (d > 128 || d < -128) s[kk][i] = -INFINITY; }
        }
        float mx = -INFINITY;
#pragma unroll
        for (int kk = 0; kk < NKB; ++kk) mx = fmaxf(mx, fmaxf(fmaxf(s[kk][0], s[kk][1]), fmaxf(s[kk][2], s[kk][3])));
        mx = fmaxf(mx, shx(mx, 16, lane)); mx = fmaxf(mx, shx(mx, 32, lane));
        const float mn = fmaxf(m, mx), alpha = __builtin_amdgcn_exp2f(m - mn);
        m = mn;
        float ls = 0.f;
#pragma unroll
        for (int kk = 0; kk < NKB; ++kk)
#pragma unroll
            for (int i = 0; i < 4; ++i) { const float p = __builtin_amdgcn_exp2f(s[kk][i] - mn); s[kk][i] = p; ls += p; }
        l = l * alpha + ls;
#pragma unroll
        for (int d = 0; d < 4; ++d) o[d] = o[d] * alpha;
        bf16x8 pf[NPP];
#pragma unroll
        for (int pp = 0; pp < NPP; ++pp) {
            const unsigned w0 = pk2(s[2 * pp][0], s[2 * pp][1]), w1 = pk2(s[2 * pp][2], s[2 * pp][3]), w2 = pk2(s[2 * pp + 1][0], s[2 * pp + 1][1]), w3 = pk2(s[2 * pp + 1][2], s[2 * pp + 1][3]);
            pf[pp] = __builtin_bit_cast(bf16x8, (u32x4){w0, w1, w2, w3});
        }
#pragma unroll
        for (int d = 0; d < 4; ++d)
#pragma unroll
            for (int pp = 0; pp < NPP; ++pp) {
                const LAS bf16* vr = vb + (d * 16 + fr) * VP + pp * 32 + g * 4;
                const u32x2 lo = *(const LAS u32x2*)vr, hi = *(const LAS u32x2*)(vr + 16);
                const bf16x8 af = __builtin_bit_cast(bf16x8, (u32x4){lo.x, lo.y, hi.x, hi.y});
                o[d] = __builtin_amdgcn_mfma_f32_16x16x32_bf16(af, pf[pp], o[d], 0, 0, 0);
            }
        if (j + 1 < ntile) lstore(buf ^ 1);
        __syncthreads();
    }
    float lt = l + shx(l, 16, lane); lt += shx(lt, 32, lane);
    const float inv = 1.f / lt;
    bf16* yr = S.Y + (size_t)(S.rowbase + qpos) * DM + S.outcol + g * 4;
#pragma unroll
    for (int d = 0; d < 4; ++d) st4bf(yr + d * 16, o[d] * inv);
}

struct AttnBufs { const bf16 *MQKV, *KPE, *Qc_rot, *Qc_raw, *Kc, *Vc, *Qd_rot, *Qd_raw, *Kd, *Vd; bf16* YCAT; const float* sink; const float* rope; unsigned* ctr; };
constexpr int ATT_NU = 384 + 768;
__device__ __forceinline__ void attn_phase(const AttnBufs& B, LAS unsigned char* lds, int tid, int lane, int wave) {
    volatile LAS unsigned* shu = (volatile LAS unsigned*)(lds + LDS_CTL);
    for (;;) {
        if (tid == 0) *shu = atomicAdd(B.ctr, 1u);
        __syncthreads();
        const int u = (int)*shu;
        if (u >= ATT_NU) break;
        int type, b, h, qt; bool samp;
        if (u < 384) { type = u >> 7; const int v = u & 127; b = v >> 6; h = (v >> 4) & 3; qt = v & 15; samp = true; }
        else { const int w = u - 384; type = w >> 8; const int v = w & 255; b = v >> 3; h = (v >> 1) & 3; qt = v & 1; samp = false; }
        AttnSrc S;
        S.samp = samp; S.q0 = qt * 128; S.rope = B.rope; S.Y = B.YCAT;
        S.krbase = samp ? NPR + b * 2560 : b * 256; S.rowbase = samp ? NPR + b * 2048 : b * 256;
        S.window = false; S.sink = false; S.m0 = -1e30f;
        if (!samp) { S.lo = 0; S.hi = 2; S.nctx = 0; }
        else { S.lo = 0; S.hi = 16; S.nctx = 4; }
        if (type == 0) {
            S.Qraw = B.MQKV + h * 96; S.Qrot = S.Qraw; S.qpitch = 1024; S.K0 = B.MQKV + 384 + h * 128; S.k0pitch = 1024; S.K1 = B.KPE; S.V = B.MQKV + 384 + h * 128 + 64; S.vpitch = 1024; S.outcol = 256 + h * 64;
            attn_unit<96>(S, lds, tid, lane, wave);
        } else {
            if (type == 1) { S.Qraw = B.Qc_raw + h * 64; S.Qrot = B.Qc_rot + h * 64; S.K0 = B.Kc + (h >> 1) * 64; S.V = B.Vc + (h >> 1) * 64; S.outcol = 512 + h * 64; }
            else { S.Qraw = B.Qd_raw + h * 64; S.Qrot = B.Qd_rot + h * 64; S.K0 = B.Kd + (h >> 1) * 64; S.V = B.Vd + (h >> 1) * 64; S.outcol = 768 + h * 64;
                   S.sink = true; S.m0 = B.sink[h] * LOG2E;
                   if (samp) { S.window = true; const int lo = S.q0 / 128 - 1; S.lo = lo < 0 ? 0 : lo; const int hi = S.q0 / 128 + 2; S.hi = hi > 16 ? 16 : hi; } }
            S.qpitch = 256; S.k0pitch = 128; S.K1 = nullptr; S.vpitch = 128;
            attn_unit<64>(S, lds, tid, lane, wave);
        }
    }
}

__device__ __forceinline__ void load8(const bf16* p, float (&o)[8]) { const u32x4 u = *(const u32x4*)p; o[0] = bflo(u.x); o[1] = bfhi(u.x); o[2] = bflo(u.y); o[3] = bfhi(u.y); o[4] = bflo(u.z); o[5] = bfhi(u.z); o[6] = bflo(u.w); o[7] = bfhi(u.w); }
__device__ __forceinline__ void convgate_phase(const bf16* U, const float* cf, bf16* ACT, int gt, int NGT) {
    constexpr int NCH = DFF / 8, RG = 8;
    for (int it = gt; it < (NTOK / RG) * NCH; it += NGT) {
        const int rg = it / NCH, cc = it % NCH, r0 = rg * RG, col = cc * 8;
        const bool samp = r0 >= NPR; const int t0 = samp ? ((r0 - NPR) & 2047) : (r0 & 255), T = samp ? 2048 : 256;
        const bf16* up = U + (size_t)r0 * DUP + col;
        u32x4 ra[RG + 2], rb[RG + 2];
        const u32x4 z4 = (u32x4){0u, 0u, 0u, 0u};
        ra[0] = z4; rb[0] = z4; ra[RG + 1] = z4; rb[RG + 1] = z4;
        if (t0 > 0) { ra[0] = *(const u32x4*)(up - DUP); rb[0] = *(const u32x4*)(up - DUP + DFF); }
#pragma unroll
        for (int i = 0; i < RG; ++i) { ra[i + 1] = *(const u32x4*)(up + (size_t)i * DUP); rb[i + 1] = *(const u32x4*)(up + (size_t)i * DUP + DFF); }
        if (t0 + RG < T) { ra[RG + 1] = *(const u32x4*)(up + (size_t)RG * DUP); rb[RG + 1] = *(const u32x4*)(up + (size_t)RG * DUP + DFF); }
        float wa[3][8], wb[3][8];
#pragma unroll
        for (int k = 0; k < 3; ++k) { const f32x4 a0 = *(const f32x4*)(cf + k * DUP + col), a1 = *(const f32x4*)(cf + k * DUP + col + 4), b0 = *(const f32x4*)(cf + k * DUP + DFF + col), b1 = *(const f32x4*)(cf + k * DUP + DFF + col + 4);
#pragma unroll
            for (int e = 0; e < 4; ++e) { wa[k][e] = a0[e]; wa[k][4 + e] = a1[e]; wb[k][e] = b0[e]; wb[k][4 + e] = b1[e]; } }
#pragma unroll
        for (int i = 0; i < RG; ++i) {
            float r[8];
#pragma unroll
            for (int h = 0; h < 4; ++h) {
                const unsigned pa = ra[i][h], ca = ra[i + 1][h], na = ra[i + 2][h], pb = rb[i][h], cb = rb[i + 1][h], nb = rb[i + 2][h];
                const float xa0 = wa[0][2 * h] * bflo(pa) + wa[1][2 * h] * bflo(ca) + wa[2][2 * h] * bflo(na), xb0 = wb[0][2 * h] * bflo(pb) + wb[1][2 * h] * bflo(cb) + wb[2][2 * h] * bflo(nb);
                const float xa1 = wa[0][2 * h + 1] * bfhi(pa) + wa[1][2 * h + 1] * bfhi(ca) + wa[2][2 * h + 1] * bfhi(na), xb1 = wb[0][2 * h + 1] * bfhi(pb) + wb[1][2 * h + 1] * bfhi(cb) + wb[2][2 * h + 1] * bfhi(nb);
                r[2 * h] = xa0 * __builtin_amdgcn_rcpf(1.f + __builtin_amdgcn_exp2f(-xa0 * LOG2E)) * xb0;
                r[2 * h + 1] = xa1 * __builtin_amdgcn_rcpf(1.f + __builtin_amdgcn_exp2f(-xa1 * LOG2E)) * xb1;
            }
            u32x4 w; w.x = pk2(r[0], r[1]); w.y = pk2(r[2], r[3]); w.z = pk2(r[4], r[5]); w.w = pk2(r[6], r[7]);
            *(u32x4*)(ACT + (size_t)(r0 + i) * DFF + col) = w;
        }
    }
}

#define XB_TMO      128
#define XB_XCNT(j)  (256  + 64 * (j))
#define XB_XSUB(j)  (1280 + 64 * (j))
#define XB_XGEN(j)  (2304 + 64 * (j))
#define XB_TOP      3328
#define XB_TOPGEN   3392
#define XCD_BAR_WORDS 3456
#define XB_SPIN_CAP (1u << 20)
__device__ __forceinline__ unsigned xb_ld(unsigned* p)              { return __hip_atomic_load(p, __ATOMIC_RELAXED, __HIP_MEMORY_SCOPE_AGENT); }
__device__ __forceinline__ unsigned xb_add(unsigned* p, unsigned v) { return __hip_atomic_fetch_add(p, v, __ATOMIC_RELAXED, __HIP_MEMORY_SCOPE_AGENT); }
__device__ __forceinline__ unsigned xb_xcc_id() { return (unsigned)__builtin_amdgcn_s_getreg((3 << 11) | 20) & 0xFu; }
#define XB_SPIN(cond, bar) do { unsigned _sp = 0; while (cond) { __builtin_amdgcn_s_sleep(1); \
    if ((++_sp & 255u) == 0u) { if (xb_ld(&(bar)[XB_TMO])) break; if (_sp > XB_SPIN_CAP) { atomicAdd(&(bar)[XB_TMO], 1u); break; } } } } while (0)
struct XcdBarrier { unsigned* bar; unsigned x; volatile LAS unsigned* st; };
__device__ __forceinline__ void xcd_barrier_complete(unsigned* bar, unsigned x, unsigned& nloc, unsigned& nx) {
    const unsigned G = gridDim.x * gridDim.y * gridDim.z;
    unsigned sum, cnt, mine, sp = 0u;
    for (;;) {
        sum = 0u; cnt = 0u; mine = 0u;
#pragma unroll
        for (unsigned j = 0; j < 16; ++j) { const unsigned c = xb_ld(&bar[XB_XCNT(j)]); sum += c; cnt += (c > 0u) ? 1u : 0u; mine = (j == x) ? c : mine; }
        if (sum == G) break;
        __builtin_amdgcn_s_sleep(1);
        if ((++sp & 255u) == 0u) { if (xb_ld(&bar[XB_TMO])) break; if (sp > XB_SPIN_CAP) { atomicAdd(&bar[XB_TMO], 1u); break; } }
    }
    nloc = mine > 0u ? mine : 1u; nx = cnt > 0u ? cnt : 1u;
}
__device__ __forceinline__ void xcd_barrier(const XcdBarrier& b, const int tid_) {
    asm volatile("s_waitcnt vmcnt(0)" ::: "memory");
    __syncthreads();
    if (tid_ == 0) {
        unsigned* bar = b.bar;
        __builtin_amdgcn_s_waitcnt(0);
        unsigned nloc = b.st[0], nx = b.st[1];
        if (nloc == 0u) { xcd_barrier_complete(bar, b.x, nloc, nx); b.st[0] = nloc; b.st[1] = nx; }
        const unsigned old = xb_add(&bar[XB_XSUB(b.x)], 1u);
        const unsigned gen = old / nloc;
        if (old + 1u == (gen + 1u) * nloc) {
            __builtin_amdgcn_fence(__ATOMIC_RELEASE, "agent");
            asm volatile("s_waitcnt vmcnt(0)" ::: "memory");
            const unsigned og = xb_add(&bar[XB_TOP], 1u);
            const unsigned tg = og / nx;
            if (og + 1u == (tg + 1u) * nx) xb_add(&bar[XB_TOPGEN], 1u);
            else XB_SPIN(xb_ld(&bar[XB_TOPGEN]) == tg, bar);
            __builtin_amdgcn_fence(__ATOMIC_ACQUIRE, "agent");
            xb_add(&bar[XB_XGEN(b.x)], 1u);
            asm volatile("s_waitcnt vmcnt(0)" ::: "memory");
        } else {
            XB_SPIN(xb_ld(&bar[XB_XGEN(b.x)]) == gen, bar);
            __builtin_amdgcn_fence(__ATOMIC_ACQUIRE, "agent");
            asm volatile("s_waitcnt vmcnt(0)" ::: "memory");
        }
    }
    __syncthreads();
}

__device__ __forceinline__ int lane_id_volatile() { int l; asm volatile("v_mbcnt_lo_u32_b32 %0, -1, 0\n\tv_mbcnt_hi_u32_b32 %0, -1, %0" : "=v"(l)); return l; }

#ifndef PH
#define PH 0xFFFF
#endif
#define ON(k) ((PH >> (k)) & 1)
#ifndef REP
#define REP 0
#endif
#define NREP(k) (1 + ((REP >> (k)) & 1))
__global__ void __launch_bounds__(NT, 2) mega_fwd(Args a_unused) {
    extern __shared__ __attribute__((aligned(16))) unsigned char lds[];
    cg::grid_group grid = cg::this_grid();
    const int G = gridDim.x, bid = blockIdx.x;
    const int wave_s = __builtin_amdgcn_readfirstlane(threadIdx.x >> 6);
    PG8_LAS unsigned char* ring = (PG8_LAS unsigned char*)lds;
#define PHASE_BEGIN int tid = wave_s * 64 + lane_id_volatile(); asm volatile("" : "+v"(tid)); const CAS Args* ap_ = (const CAS Args*)__builtin_amdgcn_kernarg_segment_ptr(); asm volatile("" : "+s"(ap_)); const CAS Args& a = *ap_; unsigned char* ws = a.ws; float* out = a.out; \
    const int lane = tid & 63, wave = __builtin_amdgcn_readfirstlane(tid >> 6); const int gw = bid * NW + wave, NGW = G * NW, gt = bid * NT + tid, NGT = G * NT; \
    (void)lane; (void)wave; (void)gw; (void)NGW; (void)gt; (void)NGT; (void)out; \
    const float* mod = (const float*)(ws + WS_MOD); const float* rope = (const float*)(ws + WS_ROPE); (void)mod; (void)rope; \
    bf16* XN = (bf16*)(ws + WS_XN); bf16* PROJ = (bf16*)(ws + WS_PROJ); bf16* A2 = (bf16*)(ws + WS_A2); bf16* MQKV = (bf16*)(ws + WS_MQKV); \
    bf16* KPE = (bf16*)(ws + WS_KPE); bf16* YCAT = (bf16*)(ws + WS_YCAT); bf16* ACT = (bf16*)(ws + WS_ACT); bf16* U = (bf16*)(ws + WS_U); \
    bf16* Qc_rot = (bf16*)(ws + WS_QC); bf16* Qc_raw = (bf16*)(ws + WS_QC + QSZ); bf16* Kc = (bf16*)(ws + WS_QC + 2 * QSZ); bf16* Vc = (bf16*)(ws + WS_QC + 2 * QSZ + KSZ); \
    bf16* Qd_rot = (bf16*)(ws + WS_QC + 2 * QSZ + 2 * KSZ); bf16* Qd_raw = Qd_rot + (size_t)NKR * 256; bf16* Kd = Qd_raw + (size_t)NKR * 256; bf16* Vd = Kd + (size_t)NKR * 128; \
    (void)XN; (void)PROJ; (void)A2; (void)MQKV; (void)KPE; (void)YCAT; (void)ACT; (void)U; (void)Qc_rot; (void)Qc_raw; (void)Kc; (void)Vc; (void)Qd_rot; (void)Qd_raw; (void)Kd; (void)Vd;
#define GSYNC() do { const CAS Args* bp_ = (const CAS Args*)__builtin_amdgcn_kernarg_segment_ptr(); asm volatile("" : "+s"(bp_)); XcdBarrier xb_; xb_.bar = (unsigned*)(bp_->ws + WS_BAR); xb_.x = xb_xcc_id(); \
    xb_.st = (volatile LAS unsigned*)((LAS unsigned char*)lds + LDS_CTL + 32); xcd_barrier(xb_, wave_s * 64 + lane_id_volatile()); } while (0)
#define LAYER_VALS const float* modl = mod + (size_t)l * 3 * 6144; unsigned char* wl = ws + WS_W + l * W_LSTRIDE; (void)modl; (void)wl; \
    const float* x0 = l == 0 ? a.in[0] : out; const float* x1 = l == 0 ? a.in[1] : out + (size_t)NPR * DM; (void)x0; (void)x1;

    if (threadIdx.x < 16) ((volatile LAS unsigned*)((LAS unsigned char*)lds + LDS_CTL))[threadIdx.x] = 0u;
    __syncthreads();
    { PHASE_BEGIN if (tid == 0) (void)xb_add((unsigned*)(ws + WS_BAR) + XB_XCNT(xb_xcc_id()), 1u);
      if (ws == nullptr) grid.sync(); }
    for (int rep = 0; rep < NREP(0); ++rep) {
    if (ON(0)) { PHASE_BEGIN phase0(a, (LAS unsigned char*)lds, tid, lane, wave); }
    GSYNC(); }

    if (ON(1)) { PHASE_BEGIN
        if (G > 124) {
            if (bid < 62) bias_phase(a, ws, (LAS unsigned char*)lds, tid, lane, wave);
            else prep_phase(a.in[0], a.in[1], a.in[12], mod, 1024, XN, (float*)(ws + WS_SS1), lane, (bid - 62) * NW + wave, (G - 62) * NW);
        } else { bias_phase(a, ws, (LAS unsigned char*)lds, tid, lane, wave);
            prep_phase(a.in[0], a.in[1], a.in[12], mod, 1024, XN, (float*)(ws + WS_SS1), lane, gw, NGW); } }
    GSYNC();
#pragma unroll
    for (int l = 0; l < 2; ++l) {
        for (int rep = 0; rep < NREP(2); ++rep) {
        if (ON(2)) { PHASE_BEGIN LAYER_VALS pg8::Gemm g{XN, (const bf16*)(wl + W_IN), NTOK, INP, DM, 0, 0}; pg8::StaticOrder S; S.init(NTOK, INP, G, bid);
          pg8::EpiBf16RS E{PROJ, INP, (const float*)(ws + WS_SS1), (const float*)(ws + WS_BIAS) + (size_t)l * 3 * NBIAS, NBIAS};
          pg8::gemm_phase<pg8::EpiBf16RS, pg8::StaticOrder, true, true>(ring, g, S, E, tid); }
        GSYNC(); }
        for (int rep = 0; rep < NREP(3); ++rep) {
        if (ON(3)) { PHASE_BEGIN P3Ptrs P; P.PROJ = PROJ; P.A2 = A2; P.KPE = KPE; P.YCAT = YCAT; P.Qc_rot = Qc_rot; P.Qc_raw = Qc_raw; P.Kc = Kc; P.Vc = Vc; P.Qd_rot = Qd_rot; P.Qd_raw = Qd_raw; P.Kd = Kd; P.Vd = Vd;
          P.conv_a = a.in[14]; P.gq_mla = a.in[15]; P.gkv_mla = a.in[17]; P.gq = a.in[19]; P.gk = a.in[20]; P.rope = rope;
          P.c_ckv = a.in[2]; P.c_kpe = a.in[3]; P.c_gk = a.in[4]; P.c_gv = a.in[5]; P.c_sk = a.in[6]; P.c_sv = a.in[7];
          P.o_ckv = out + 12582912; P.o_kpe = out + 14680064; P.o_gk = out + 15204352; P.o_gv = out + 17301504; P.o_sk = out + 19398656; P.o_sv = out + 21495808; P.l = l;
          p3_phase(P, lane, gw, NGW); }
        GSYNC(); }
        for (int rep = 0; rep < NREP(4); ++rep) {
        if (ON(4)) { PHASE_BEGIN LAYER_VALS pg8::Gemm g{A2, (const bf16*)(wl + W_B2), NKR, 1024, 384, 0, 0}; pg8::StaticOrder S; S.init(NKR, 1024, G, bid); pg8::EpiBf16 E{MQKV, 1024};
          pg8::gemm_phase<pg8::EpiBf16, pg8::StaticOrder, true, true>(ring, g, S, E, tid); }
        GSYNC(); }
        for (int rep = 0; rep < NREP(5); ++rep) {
        if (ON(5)) { PHASE_BEGIN AttnBufs B; B.MQKV = MQKV; B.KPE = KPE; B.Qc_rot = Qc_rot; B.Qc_raw = Qc_raw; B.Kc = Kc; B.Vc = Vc; B.Qd_rot = Qd_rot; B.Qd_raw = Qd_raw; B.Kd = Kd; B.Vd = Vd; B.YCAT = YCAT;
          B.sink = a.in[21] + l * 4; B.rope = rope; B.ctr = (unsigned*)(ws + WS_CTL) + 64 * l + 128 * rep;
          attn_phase(B, (LAS unsigned char*)lds, tid, lane, wave); }
        GSYNC(); }
        if (ON(6)) { PHASE_BEGIN LAYER_VALS pg8::Gemm g{YCAT, (const bf16*)(wl + W_OUT), NTOK, DM, DM, 0, 0}; pg8::StaticOrder S; S.init(NTOK, DM, G, bid);
          pg8::EpiResid E{x0, x1, out, modl + 2048, XN, (float*)(ws + WS_SS2), a.in[23] + l * DM, modl + 4096};
          pg8::gemm_phase<pg8::EpiResid, pg8::StaticOrder, true, true>(ring, g, S, E, tid);
          if (l == 0) { const int wk = G > 192 ? bid - 192 : bid, nwk = G > 192 ? G - 192 : G;
            if (wk >= 0) wconv(a, ws, 0, 4 | 8, wk * NW + wave, nwk * NW, (LAS float*)((LAS unsigned char*)lds + wave * 16640), lane); } }
        GSYNC();
        for (int rep = 0; rep < NREP(8); ++rep) {
        if (ON(8)) { PHASE_BEGIN LAYER_VALS pg8::Gemm g{XN, (const bf16*)(wl + W_UP), NTOK, DUP, DM, (size_t)128 * DM * 2, (size_t)DFF * DM * 2}; pg8::StaticOrder S; S.init(NTOK, DUP, G, bid);
          pg8::EpiUpGate E{ACT, (const float*)(ws + WS_SS2), (const float*)(ws + WS_BIAS) + (size_t)l * 3 * NBIAS + 2304, NBIAS, a.in[25] + (size_t)l * 3 * DUP, (float*)(ws + WS_HALO), ring + 131072};
          pg8::gemm_phase<pg8::EpiUpGate, pg8::StaticOrder, true, true>(ring, g, S, E, tid); }
        GSYNC(); }
        if (ON(10)) { PHASE_BEGIN LAYER_VALS pg8::Gemm g{ACT, (const bf16*)(wl + W_DOWN), NTOK, DM, DFF, 0, 0}; pg8::StaticOrder S; S.init(NTOK, DM, G, bid);
          {
            const float* cwl = a.in[25] + (size_t)l * 3 * DUP; const float* HALO = (const float*)(ws + WS_HALO); pg8::Unit hu;
            for (int ui = 0; S.next(ui, hu); ++ui) { if (hu.pm < 32) continue; const int k = hu.pm - 32, pos = k & 7;
                for (int idx = tid; idx < 2 * DFF; idx += NT) { const int which = idx >= DFF ? 1 : 0, j = idx - which * DFF;
                    if (which == 0 ? pos == 0 : pos == 7) continue;
                    const float* Pp = HALO + (size_t)(k * 4 + (which ? 3 : 1)) * DUP; const float* Ep = HALO + (size_t)((which ? k + 1 : k - 1) * 4 + (which ? 0 : 2)) * DUP; const float* wp = cwl + (which ? 2 : 0) * DUP;
                    const float ca = Pp[j] + wp[j] * Ep[j], cb = Pp[DFF + j] + wp[DFF + j] * Ep[DFF + j];
                    const float r = ca * __builtin_amdgcn_rcpf(1.f + __builtin_amdgcn_exp2f(-ca * LOG2E)) * cb;
                    ACT[(size_t)(hu.pm * 256 + (which ? 255 : 0)) * DFF + j] = (bf16)(pk2(r, r) & 0xffffu); } }
            asm volatile("s_waitcnt vmcnt(0)" ::: "memory"); __builtin_amdgcn_fence(__ATOMIC_RELEASE, "agent"); __builtin_amdgcn_fence(__ATOMIC_ACQUIRE, "agent"); __syncthreads(); }
          if (l == 1 && G >= 192) {
            pg8::EpiResidFinal E{out, out, modl + 5120, (float*)(ws + WS_SS1), a.in[27], (unsigned*)(ws + WS_CTL) + 2048};
            pg8::gemm_phase<pg8::EpiResidFinal, pg8::StaticOrder, true, true>(ring, g, S, E, tid);
          } else {
          pg8::EpiResid E{out, out + (size_t)NPR * DM, out, modl + 5120, l == 0 ? XN : nullptr, (float*)(ws + WS_SS1), a.in[12] + DM, mod + (size_t)3 * 6144 + 1024};
          pg8::gemm_phase<pg8::EpiResid, pg8::StaticOrder, true, true>(ring, g, S, E, tid); }
          if (l == 0) { const int wk = G > 192 ? bid - 192 : bid, nwk = G > 192 ? G - 192 : G;
            if (wk >= 0) wconv(a, ws, 1, 63, wk * NW + wave, nwk * NW, (LAS float*)((LAS unsigned char*)lds + wave * 16640), lane); } }
        if (!(l == 1 && G >= 192)) GSYNC();
    }
#ifdef XSYNC
    for (int i = 0; i < XSYNC; ++i) GSYNC();
#endif
    if (G < 192) { PHASE_BEGIN
    for (int row = gw; row < NTOK; row += NGW) {
        float* xr = out + (size_t)row * DM;
        f32x4 v[4]; float ss = 0.f;
#pragma unroll
        for (int j = 0; j < 4; ++j) { v[j] = *(const f32x4*)(xr + 4 * (lane + 64 * j)); ss += dot4(v[j]); }
        const float rs = rsqrtf(wave_sum(ss, lane) * (1.f / DM) + EPS);
#pragma unroll
        for (int j = 0; j < 4; ++j) { const int col = 4 * (lane + 64 * j); *(f32x4*)(xr + col) = v[j] * rs * *(const f32x4*)(a.in[27] + col); }
    } }
}

extern "C" void kernel_launch(void* const* d_in, const int* in_sizes, int n_in, void* d_out, int out_size, void* d_ws, size_t ws_size, hipStream_t stream) {
    static int grid = 0;
    if (grid == 0) {
        if (n_in != 28 || ws_size < WS_END) { fprintf(stderr, "kernel_launch: unexpected n_in %d / ws %zu\n", n_in, ws_size); grid = -1; return; }
        int dev = 0, cus = 0, per_cu = 0;
        hipGetDevice(&dev); hipDeviceGetAttribute(&cus, hipDeviceAttributeMultiprocessorCount, dev);
        hipFuncSetAttribute((const void*)mega_fwd, hipFuncAttributeMaxDynamicSharedMemorySize, LDS_BYTES);
        hipOccupancyMaxActiveBlocksPerMultiprocessor(&per_cu, (const void*)mega_fwd, NT, LDS_BYTES);
        if (per_cu < 1) per_cu = 1;
        grid = cus * per_cu;
        (void)hipGetLastError();
    }
    if (grid < 0) return;
    if (hipMemsetAsync((char*)d_ws + WS_BAR, 0, XCD_BAR_WORDS * 4, stream) != hipSuccess) { fprintf(stderr, "kernel_launch: memset of the barrier words failed\n"); return; }
    Args a{};
    for (int i = 0; i < 28; ++i) a.in[i] = (const float*)d_in[i];
    a.out = (float*)d_out; a.ws = (unsigned char*)d_ws;
    void* args[] = {&a};
    hipError_t e = hipLaunchCooperativeKernel((const void*)mega_fwd, dim3(grid), dim3(NT), args, LDS_BYTES, stream);
    if (e != hipSuccess) fprintf(stderr, "cooperative launch failed: %s (grid %d)\n", hipGetErrorString(e), grid);
}
```

```cpp
#include <hip/hip_runtime.h>
#include <hip/hip_cooperative_groups.h>
#include <cstdio>
#include <cstdint>
namespace cg = cooperative_groups;

namespace pg8 {
#define PG8_LAS __attribute__((address_space(3)))
typedef unsigned short bf16_t;
typedef short bf16x8 __attribute__((ext_vector_type(8)));
typedef float f32x4 __attribute__((ext_vector_type(4)));
typedef unsigned u32x4 __attribute__((ext_vector_type(4)));
constexpr int BM = 256, BK = 64, HALF = 128, HTB = HALF * BK * 2, STAGE_BYTES = 8 * HTB, NXCD = 8, WGM = 8;

__host__ __device__ __forceinline__ int lds_byte(int r, int c) { const int st = (r >> 4) * 2 + (c >> 5), rr = r & 15, cc = c & 31, ob = rr * 64 + cc * 2; return st * 1024 + (ob ^ (((ob >> 9) & 1) << 5)); }
__host__ __device__ __forceinline__ void stage_rc(int b, int& R, int& C) { const int st = b / 1024, sb = b % 1024, swz = sb ^ (((sb >> 9) & 1) << 5); R = (st >> 1) * 16 + swz / 64; C = (st & 1) * 32 + (swz % 64) / 2; }
__host__ __device__ __forceinline__ int perm32(int rho) { const int n = rho >> 4, i = rho & 15; return 8 * (i >> 2) + 4 * n + (i & 3); }

struct Unit { int pm, pn; };
struct Gemm { const bf16_t* A; const bf16_t* Bt; int M, N, K; size_t bstep, bhalf; };

struct StaticOrder {
    int nM, nN, nwg, G, c;
    __host__ __device__ __forceinline__ void init(int M, int N, int G_, int c_) { nM = M / BM; nN = N / BM; nwg = nM * nN; G = G_; c = c_; }
    __host__ __device__ __forceinline__ bool next(int i, Unit& u) const {
        const long L = (long)i * G + c; if (L >= nwg) return false;
        int wgid = (int)L; { const int q = nwg / NXCD, r = nwg % NXCD, xcd = wgid % NXCD, off = wgid / NXCD; wgid = (xcd < r ? xcd * (q + 1) : r * (q + 1) + (xcd - r) * q) + off; }
        const int nig = WGM * nN, gid = wgid / nig, fm = gid * WGM, gsz = (nM - fm) < WGM ? (nM - fm) : WGM;
        u.pm = fm + ((wgid % nig) % gsz); u.pn = (wgid % nig) / gsz; return true;
    }
    __device__ __forceinline__ void a_ready(const Unit&) const {}
    __device__ __forceinline__ void done(const Unit&) const {}
};

__device__ __forceinline__ unsigned cvt_pk_bf16(float lo, float hi) { unsigned r; asm volatile("v_cvt_pk_bf16_f32 %0, %1, %2" : "=v"(r) : "v"(lo), "v"(hi)); return r; }

struct EpiBf16 {
    static constexpr bool PERM = true, AFTER_DRAIN = false;
    bf16_t* O; int ldc;
    __device__ __forceinline__ void operator()(const f32x4 (&acc)[2][2][4][2], const Unit& u, int wr, int wc, int fr, int fq) const {
        asm volatile("" : "+v"(fr), "+v"(fq));
        const int row0 = u.pm * BM + wr * 64 + fr; const int col0 = u.pn * BM + wc * 32 + 8 * fq;
#pragma unroll
        for (int ai = 0; ai < 2; ++ai)
#pragma unroll
            for (int m = 0; m < 4; ++m) { bf16_t* rowp = O + (size_t)(row0 + ai * HALF + m * 16) * ldc + col0;
#pragma unroll
                for (int bj = 0; bj < 2; ++bj) { const f32x4 v0 = acc[ai][bj][m][0], v1 = acc[ai][bj][m][1];
                    u32x4 w; w.x = cvt_pk_bf16(v0[0], v0[1]); w.y = cvt_pk_bf16(v0[2], v0[3]); w.z = cvt_pk_bf16(v1[0], v1[1]); w.w = cvt_pk_bf16(v1[2], v1[3]);
                    *(u32x4*)(rowp + bj * HALF) = w; } }
    }
};
__device__ __forceinline__ float shx_(float v, int m, int lane) { return __builtin_bit_cast(float, __builtin_amdgcn_ds_bpermute((lane ^ m) << 2, __builtin_bit_cast(int, v))); }
__device__ __forceinline__ void row_scales(const float* SS, int row0, int fr, int fq, float (&rs)[8]) {
    f32x4 t[8];
#pragma unroll
    for (int q = 0; q < 8; ++q) t[q] = *(const f32x4*)(SS + (size_t)(row0 + (q >> 2) * HALF + (q & 3) * 16) * 16 + 4 * fq);
    const int lane = fq * 16 + fr;
#pragma unroll
    for (int q = 0; q < 8; ++q) { float v = (t[q][0] + t[q][1]) + (t[q][2] + t[q][3]); v += shx_(v, 16, lane); v += shx_(v, 32, lane); rs[q] = __builtin_amdgcn_rsqf(v * (1.f / 1024.f) + 1e-6f); }
}
struct EpiBf16RS {
    static constexpr bool PERM = true, AFTER_DRAIN = false;
    bf16_t* O; int ldc; const float* SS; const float* bias; int ldb;
    __device__ __forceinline__ void operator()(const f32x4 (&acc)[2][2][4][2], const Unit& u, int wr, int wc, int fr, int fq) const {
        asm volatile("" : "+v"(fr), "+v"(fq));
        const int cnd = u.pm < 32 ? 0 : 1 + ((u.pm - 32) >> 3);
        const int row0 = u.pm * BM + wr * 64 + fr; const int col0 = u.pn * BM + wc * 32 + 8 * fq;
        const float* bp = bias + (size_t)cnd * ldb + col0;
        f32x4 bv[2][2];
#pragma unroll
        for (int bj = 0; bj < 2; ++bj)
#pragma unroll
            for (int n = 0; n < 2; ++n) bv[bj][n] = *(const f32x4*)(bp + bj * HALF + 4 * n);
        float rsv[8]; row_scales(SS, row0, fr, fq, rsv);
#pragma unroll
        for (int ai = 0; ai < 2; ++ai)
#pragma unroll
            for (int m = 0; m < 4; ++m) { const int row = row0 + ai * HALF + m * 16; const float rs = rsv[ai * 4 + m];
                bf16_t* rowp = O + (size_t)row * ldc + col0;
#pragma unroll
                for (int bj = 0; bj < 2; ++bj) { const f32x4 v0 = acc[ai][bj][m][0] * rs + bv[bj][0], v1 = acc[ai][bj][m][1] * rs + bv[bj][1];
                    u32x4 w; w.x = cvt_pk_bf16(v0[0], v0[1]); w.y = cvt_pk_bf16(v0[2], v0[3]); w.z = cvt_pk_bf16(v1[0], v1[1]); w.w = cvt_pk_bf16(v1[2], v1[3]);
                    *(u32x4*)(rowp + bj * HALF) = w; } }
    }
};
struct EpiResid {
    static constexpr bool PERM = false, AFTER_DRAIN = false;
    const float* r0; const float* r1; bf16_t* XR; const float* gate;
    bf16_t* XN; float* SS; const float* nrm; const float* sc;
    __device__ __forceinline__ void operator()(const f32x4 (&acc)[2][2][4][2], const Unit& u, int wr, int wc, int fr, int fq) const {
        asm volatile("" : "+v"(fr), "+v"(fq));
        typedef unsigned u32x2_ __attribute__((ext_vector_type(2)));
        const int cnd = u.pm < 32 ? 0 : 1 + ((u.pm - 32) >> 3);
        const float* gp = gate + cnd * 6144;
        const int col0 = u.pn * BM + wc * 32 + 4 * fq;
        const int rowb = u.pm * BM + wr * 64 + fr;
        const bool inf = r0 != nullptr;
        const float* rs = (u.pm < 32 ? r0 + (size_t)rowb * 1024 : r1 + (size_t)(rowb - 8192) * 1024) + col0;
        bf16_t* op = XR + (size_t)rowb * 1024 + col0;
#define LDX(off) (inf ? *(const f32x4*)(rs + (off)) : ({ const u32x2_ t_ = *(const u32x2_*)(op + (off)); (f32x4){__builtin_bit_cast(float, t_.x << 16), __builtin_bit_cast(float, t_.x & 0xffff0000u), __builtin_bit_cast(float, t_.y << 16), __builtin_bit_cast(float, t_.y & 0xffff0000u)}; }))
        const bool prep = XN != nullptr;
        f32x4 gv[2][2], hv[2][2];
#pragma unroll
        for (int bj = 0; bj < 2; ++bj)
#pragma unroll
            for (int n = 0; n < 2; ++n) { gv[bj][n] = *(const f32x4*)(gp + col0 + bj * HALF + n * 16);
                hv[bj][n] = (f32x4){0.f, 0.f, 0.f, 0.f};
                if (prep) hv[bj][n] = *(const f32x4*)(nrm + col0 + bj * HALF + n * 16) * (1.f + *(const f32x4*)(sc + cnd * 6144 + col0 + bj * HALF + n * 16)); }
        f32x4 xc[2][2], xn[2][2];
#pragma unroll
        for (int bj = 0; bj < 2; ++bj)
#pragma unroll
            for (int n = 0; n < 2; ++n) xc[bj][n] = LDX(bj * HALF + n * 16);
#pragma unroll
        for (int it = 0; it < 8; ++it) { const int ai = it >> 2, m = it & 3; const size_t ro = (size_t)(ai * HALF + m * 16) * 1024;
            if (it < 7) { const int ai2 = (it + 1) >> 2, m2 = (it + 1) & 3; const size_t ro2 = (size_t)(ai2 * HALF + m2 * 16) * 1024;
#pragma unroll
                for (int bj = 0; bj < 2; ++bj)
#pragma unroll
                    for (int n = 0; n < 2; ++n) xn[bj][n] = LDX(ro2 + bj * HALF + n * 16); }
            float ssq = 0.f;
#pragma unroll
            for (int bj = 0; bj < 2; ++bj)
#pragma unroll
                for (int n = 0; n < 2; ++n) { const f32x4 v = xc[bj][n] + gv[bj][n] * acc[ai][bj][m][n];
                    *(u32x2_*)(op + ro + bj * HALF + n * 16) = (u32x2_){cvt_pk_bf16(v[0], v[1]), cvt_pk_bf16(v[2], v[3])};
                    if (prep) { ssq += (v[0] * v[0] + v[1] * v[1]) + (v[2] * v[2] + v[3] * v[3]); const f32x4 h = v * hv[bj][n];
                        unsigned w0 = cvt_pk_bf16(h[0], h[1]), w1 = cvt_pk_bf16(h[2], h[3]);
                        *(u32x2_*)(XN + (size_t)(rowb + ai * HALF + m * 16) * 1024 + col0 + bj * HALF + n * 16) = (u32x2_){w0, w1}; } }
            if (prep) { const int lane = fq * 16 + fr; ssq += shx_(ssq, 16, lane); ssq += shx_(ssq, 32, lane);
                if (fq == 0) SS[(size_t)(rowb + ai * HALF + m * 16) * 16 + u.pn * 4 + wc] = ssq; }
#pragma unroll
            for (int bj = 0; bj < 2; ++bj)
#pragma unroll
                for (int n = 0; n < 2; ++n) xc[bj][n] = xn[bj][n];
        }
    }
#undef LDX
};

struct EpiResidFinal {
    static constexpr bool PERM = false, AFTER_DRAIN = false;
    const bf16_t* res; float* out; const float* gate; float* SS; const float* fw; unsigned* cnt;
    __device__ __forceinline__ void operator()(f32x4 (&acc)[2][2][4][2], const Unit& u, int wr, int wc, int fr, int fq) const {
        asm volatile("" : "+v"(fr), "+v"(fq));
        const int cnd = u.pm < 32 ? 0 : 1 + ((u.pm - 32) >> 3);
        const float* gp = gate + cnd * 6144;
        const int col0 = u.pn * BM + wc * 32 + 4 * fq;
        const int rowb = u.pm * BM + wr * 64 + fr;
        typedef unsigned u32x2_ __attribute__((ext_vector_type(2)));
        const bf16_t* rs = res + (size_t)rowb * 1024 + col0;
#define LDXF(off) ({ const u32x2_ t_ = *(const u32x2_*)(rs + (off)); (f32x4){__builtin_bit_cast(float, t_.x << 16), __builtin_bit_cast(float, t_.x & 0xffff0000u), __builtin_bit_cast(float, t_.y << 16), __builtin_bit_cast(float, t_.y & 0xffff0000u)}; })
        f32x4 gv[2][2];
#pragma unroll
        for (int bj = 0; bj < 2; ++bj)
#pragma unroll
            for (int n = 0; n < 2; ++n) gv[bj][n] = *(const f32x4*)(gp + col0 + bj * HALF + n * 16);
        f32x4 xc[2][2], xn[2][2];
#pragma unroll
        for (int bj = 0; bj < 2; ++bj)
#pragma unroll
            for (int n = 0; n < 2; ++n) xc[bj][n] = LDXF(bj * HALF + n * 16);
#pragma unroll
        for (int it = 0; it < 8; ++it) { const int ai = it >> 2, m = it & 3;
            if (it < 7) { const int ai2 = (it + 1) >> 2, m2 = (it + 1) & 3; const size_t ro2 = (size_t)(ai2 * HALF + m2 * 16) * 1024;
#pragma unroll
                for (int bj = 0; bj < 2; ++bj)
#pragma unroll
                    for (int n = 0; n < 2; ++n) xn[bj][n] = LDXF(ro2 + bj * HALF + n * 16); }
            float ssq = 0.f;
#pragma unroll
            for (int bj = 0; bj < 2; ++bj)
#pragma unroll
                for (int n = 0; n < 2; ++n) { const f32x4 v = xc[bj][n] + gv[bj][n] * acc[ai][bj][m][n]; acc[ai][bj][m][n] = v;
                    ssq += (v[0] * v[0] + v[1] * v[1]) + (v[2] * v[2] + v[3] * v[3]); }
            { const int lane = fq * 16 + fr; ssq += shx_(ssq, 16, lane); ssq += shx_(ssq, 32, lane);
              if (fq == 0) __hip_atomic_store(SS + (size_t)(rowb + ai * HALF + m * 16) * 16 + u.pn * 4 + wc, ssq, __ATOMIC_RELAXED, __HIP_MEMORY_SCOPE_AGENT); }
#pragma unroll
            for (int bj = 0; bj < 2; ++bj)
#pragma unroll
                for (int n = 0; n < 2; ++n) xc[bj][n] = xn[bj][n];
        }
        asm volatile("s_waitcnt vmcnt(0)" ::: "memory"); __builtin_amdgcn_s_barrier(); asm volatile("" ::: "memory");
        if (wr == 0 && wc == 0 && fr == 0 && fq == 0) {
            __builtin_amdgcn_fence(__ATOMIC_RELEASE, "agent"); asm volatile("s_waitcnt vmcnt(0)" ::: "memory");
            __hip_atomic_fetch_add(cnt + u.pm, 1u, __ATOMIC_RELAXED, __HIP_MEMORY_SCOPE_AGENT);
            unsigned sp = 0;
            while (__hip_atomic_load(cnt + u.pm, __ATOMIC_RELAXED, __HIP_MEMORY_SCOPE_AGENT) < 4u) { __builtin_amdgcn_s_sleep(1); if (++sp > (1u << 22)) break; }
            __builtin_amdgcn_fence(__ATOMIC_ACQUIRE, "agent"); asm volatile("s_waitcnt vmcnt(0)" ::: "memory");
        }
        __builtin_amdgcn_s_barrier(); asm volatile("" ::: "memory");
        float rsv[8];
        { f32x4 t[8];
#pragma unroll
          for (int q = 0; q < 8; ++q) { const float* sp = SS + (size_t)(rowb + (q >> 2) * HALF + (q & 3) * 16) * 16 + 4 * fq;
              t[q] = (f32x4){__hip_atomic_load(sp, __ATOMIC_RELAXED, __HIP_MEMORY_SCOPE_AGENT), __hip_atomic_load(sp + 1, __ATOMIC_RELAXED, __HIP_MEMORY_SCOPE_AGENT),
                             __hip_atomic_load(sp + 2, __ATOMIC_RELAXED, __HIP_MEMORY_SCOPE_AGENT), __hip_atomic_load(sp + 3, __ATOMIC_RELAXED, __HIP_MEMORY_SCOPE_AGENT)}; }
          const int lane = fq * 16 + fr;
#pragma unroll
          for (int q = 0; q < 8; ++q) { float v = (t[q][0] + t[q][1]) + (t[q][2] + t[q][3]); v += shx_(v, 16, lane); v += shx_(v, 32, lane); rsv[q] = __builtin_amdgcn_rsqf(v * (1.f / 1024.f) + 1e-6f); } }
        f32x4 wv[2][2];
#pragma unroll
        for (int bj = 0; bj < 2; ++bj)
#pragma unroll
            for (int n = 0; n < 2; ++n) wv[bj][n] = *(const f32x4*)(fw + col0 + bj * HALF + n * 16);
        float* op = out + (size_t)rowb * 1024 + col0;
#pragma unroll
        for (int it = 0; it < 8; ++it) { const int ai = it >> 2, m = it & 3; const size_t ro = (size_t)(ai * HALF + m * 16) * 1024;
#pragma unroll
            for (int bj = 0; bj < 2; ++bj)
#pragma unroll
                for (int n = 0; n < 2; ++n) *(f32x4*)(op + ro + bj * HALF + n * 16) = acc[ai][bj][m][n] * rsv[it] * wv[bj][n]; }
    }
};

__device__ __forceinline__ float dpp_ror1(float v) { return __builtin_bit_cast(float, __builtin_amdgcn_mov_dpp(__builtin_bit_cast(int, v), 0x121, 0xf, 0xf, false)); }
__device__ __forceinline__ float dpp_ror15(float v) { return __builtin_bit_cast(float, __builtin_amdgcn_mov_dpp(__builtin_bit_cast(int, v), 0x12f, 0xf, 0xf, false)); }
struct EpiUpGate {
    static constexpr bool PERM = true, AFTER_DRAIN = false;
    bf16_t* ACT; const float* SS; const float* bias; int ldb; const float* cw; float* HALO; PG8_LAS unsigned char* xb;
    __device__ __forceinline__ void operator()(f32x4 (&acc)[2][2][4][2], const Unit& u, int wr, int wc, int fr, int fq) const {
        asm volatile("" : "+v"(fr), "+v"(fq));
        const int cnd = u.pm < 32 ? 0 : 1 + ((u.pm - 32) >> 3);
        const bool samp = u.pm >= 32;
        const int j0 = u.pn * HALF + wc * 32 + 8 * fq;
        const int row0 = u.pm * BM + wr * 64 + fr;
        { const float* bp = bias + (size_t)cnd * ldb + j0;
          f32x4 bv[2][2];
#pragma unroll
          for (int bj = 0; bj < 2; ++bj)
#pragma unroll
              for (int n = 0; n < 2; ++n) bv[bj][n] = *(const f32x4*)(bp + bj * 2816 + 4 * n);
          float rsv[8]; row_scales(SS, row0, fr, fq, rsv);
#pragma unroll
          for (int ai = 0; ai < 2; ++ai)
#pragma unroll
              for (int m = 0; m < 4; ++m) { const float rs = rsv[ai * 4 + m];
#pragma unroll
                  for (int bj = 0; bj < 2; ++bj)
#pragma unroll
                      for (int n = 0; n < 2; ++n) acc[ai][bj][m][n] = acc[ai][bj][m][n] * rs + bv[bj][n]; } }
        PG8_LAS f32x4* WL = (PG8_LAS f32x4*)(xb + 8192);
        if (fr == 0) {
            f32x4 wt[2][2][3];
#pragma unroll
            for (int n = 0; n < 2; ++n)
#pragma unroll
                for (int bj = 0; bj < 2; ++bj)
#pragma unroll
                    for (int k = 0; k < 3; ++k) wt[n][bj][k] = *(const f32x4*)(cw + k * 5632 + bj * 2816 + j0 + 4 * n);
#pragma unroll
            for (int n = 0; n < 2; ++n)
#pragma unroll
                for (int bj = 0; bj < 2; ++bj)
#pragma unroll
                    for (int k = 0; k < 3; ++k) WL[((((wr * 4 + wc) * 4 + fq) * 2 + n) * 2 + bj) * 3 + k] = wt[n][bj][k];
        }
        PG8_LAS f32x4* XB = (PG8_LAS f32x4*)xb;
        const int wv = wr * 4 + wc, pw = (wr ^ 1) * 4 + wc;
        if (fr == 0) {
#pragma unroll
            for (int ai = 0; ai < 2; ++ai)
#pragma unroll
                for (int bj = 0; bj < 2; ++bj)
#pragma unroll
                    for (int n = 0; n < 2; ++n) XB[((wv * 4 + ai * 2) * 2 + bj) * 8 + 2 * fq + n] = acc[ai][bj][0][n]; }
        if (fr == 15) {
#pragma unroll
            for (int ai = 0; ai < 2; ++ai)
#pragma unroll
                for (int bj = 0; bj < 2; ++bj)
#pragma unroll
                    for (int n = 0; n < 2; ++n) XB[((wv * 4 + ai * 2 + 1) * 2 + bj) * 8 + 2 * fq + n] = acc[ai][bj][3][n]; }
        asm volatile("s_waitcnt lgkmcnt(0)" ::: "memory"); __builtin_amdgcn_s_barrier(); asm volatile("" ::: "memory");
        float* hb = HALO + (size_t)(samp ? u.pm - 32 : 0) * 4 * 5632;
#pragma unroll
        for (int ai = 0; ai < 2; ++ai) {
            const bool has_ab = !(wr == 0 && ai == 0), has_bl = !(wr == 1 && ai == 1);
            const int wab = (wr == 0) ? 1 : (ai == 0 ? 1 : 3), wbl = (wr == 0) ? (ai == 0 ? 0 : 2) : 2;
            unsigned pk[4][4];
#pragma unroll
            for (int n = 0; n < 2; ++n) {
                f32x4 ca[4];
#pragma unroll
                for (int bj = 0; bj < 2; ++bj) {
                    const PG8_LAS f32x4* wlp = WL + ((((wr * 4 + wc) * 4 + fq) * 2 + n) * 2 + bj) * 3;
                    const f32x4 w0 = wlp[0], w1 = wlp[1], w2 = wlp[2];
                    f32x4 ab = (f32x4){0.f, 0.f, 0.f, 0.f}, bl = ab;
                    if (has_ab) ab = XB[((pw * 4 + wab) * 2 + bj) * 8 + 2 * fq + n];
                    if (has_bl) bl = XB[((pw * 4 + wbl) * 2 + bj) * 8 + 2 * fq + n];
#pragma unroll
                    for (int m = 0; m < 4; ++m) {
                        f32x4 cvm;
#pragma unroll
                        for (int i = 0; i < 4; ++i) {
                            const float cur = acc[ai][bj][m][n][i];
                            const float pv = m == 0 ? ab[i] : acc[ai][bj][m == 0 ? 0 : m - 1][n][i];
                            const float nx = m == 3 ? bl[i] : acc[ai][bj][m == 3 ? 3 : m + 1][n][i];
                            const float up = dpp_ror1(fr == 15 ? pv : cur), dn = dpp_ror15(fr == 0 ? nx : cur);
                            cvm[i] = w0[i] * up + w1[i] * cur + w2[i] * dn;
                        }
                        if (samp) {
                            if (m == 0 && wr == 0 && ai == 0 && fr == 0) { *(f32x4*)(hb + 0 * 5632 + bj * 2816 + j0 + 4 * n) = acc[ai][bj][0][n]; *(f32x4*)(hb + 1 * 5632 + bj * 2816 + j0 + 4 * n) = cvm; }
                            if (m == 3 && wr == 1 && ai == 1 && fr == 15) { *(f32x4*)(hb + 2 * 5632 + bj * 2816 + j0 + 4 * n) = acc[ai][bj][3][n]; *(f32x4*)(hb + 3 * 5632 + bj * 2816 + j0 + 4 * n) = cvm; }
                        }
                        if (bj == 0) ca[m] = cvm;
                        else { float r[4];
#pragma unroll
                            for (int i = 0; i < 4; ++i) { const float xa = ca[m][i]; r[i] = xa * __builtin_amdgcn_rcpf(1.f + __builtin_amdgcn_exp2f(-xa * 1.4426950408889634f)) * cvm[i]; }
                            pk[m][2 * n] = cvt_pk_bf16(r[0], r[1]); pk[m][2 * n + 1] = cvt_pk_bf16(r[2], r[3]); }
                    }
                }
                __builtin_amdgcn_sched_barrier(0);
            }
#pragma unroll
            for (int m = 0; m < 4; ++m) *(u32x4*)(ACT + (size_t)(row0 + ai * HALF + m * 16) * 2816 + j0) = (u32x4){pk[m][0], pk[m][1], pk[m][2], pk[m][3]};
        }
    }
};

template <class Epi, class Sched, bool ALIGN_EPI = false, bool SP2 = false>
__device__ __forceinline__ void gemm_phase(PG8_LAS unsigned char* lds, const Gemm g, const Sched& S, const Epi& E, const int tid) {
    const int wid = __builtin_amdgcn_readfirstlane(tid >> 6), lane = tid & 63, wr = wid >> 2, wc = wid & 3, fr = lane & 15, fq = lane >> 4;
    const int K = g.K, nt = K / BK;
    unsigned voffA[2], voffB[2];
#pragma unroll
    for (int i = 0; i < 2; ++i) { int R, C; stage_rc(tid * 16 + i * 8192, R, C); const int Rb = Epi::PERM ? ((R & ~31) + perm32(R & 31)) : R;
        voffA[i] = (unsigned)(R * K + C) * 2u; voffB[i] = (unsigned)(Rb * K + C) * 2u; }
    const size_t kstep = (size_t)(BK * 2);
    const size_t hstep = (size_t)HALF * K * 2;
    const size_t tstep = 2 * hstep;
    const size_t bstep = g.bstep ? g.bstep : tstep, bh = g.bhalf ? g.bhalf : hstep;
    const unsigned ldsw = (unsigned)wid * 1024u;
    const int aoff = lds_byte(wr * 64 + fr, fq * 8), boff = lds_byte(wc * 32 + fr, fq * 8);
#define PG8_SA(b, h) (((b) * 2 + (h)) * HTB)
#define PG8_SB(b, h) ((4 + (b) * 2 + (h)) * HTB)
#define PG8_STAGE(bufoff, gbase, voff) do { _Pragma("unroll") for (int _i = 0; _i < 2; ++_i) \
        __builtin_amdgcn_global_load_lds((const unsigned*)((const char*)(gbase) + (voff)[_i]), (PG8_LAS unsigned*)(lds + (bufoff) + ldsw + _i * 8192), 16, 0, 0); } while (0)
#define PG8_LDA(dst, b, h) do { _Pragma("unroll") for (int m = 0; m < 4; ++m) _Pragma("unroll") for (int k = 0; k < 2; ++k) dst[m][k] = *(const PG8_LAS bf16x8*)(lds + PG8_SA(b, h) + aoff + m * 2048 + k * 1024); } while (0)
#define PG8_LDB(dst, b, h) do { _Pragma("unroll") for (int n = 0; n < 2; ++n) _Pragma("unroll") for (int k = 0; k < 2; ++k) dst[n][k] = *(const PG8_LAS bf16x8*)(lds + PG8_SB(b, h) + boff + n * 2048 + k * 1024); } while (0)
#define PG8_MMA(ai, bj, At, Bt) do { __builtin_amdgcn_s_setprio(1); _Pragma("unroll") for (int m = 0; m < 4; ++m) _Pragma("unroll") for (int n = 0; n < 2; ++n) _Pragma("unroll") for (int k = 0; k < 2; ++k) \
        acc[ai][bj][m][n] = __builtin_amdgcn_mfma_f32_16x16x32_bf16(Bt[n][k], At[m][k], acc[ai][bj][m][n], 0, 0, 0); __builtin_amdgcn_s_setprio(0); } while (0)
#define PG8_WAIT_V(n) asm volatile("s_waitcnt vmcnt(" #n ")" ::: "memory")
#define PG8_WAIT_L(n) asm volatile("s_waitcnt lgkmcnt(" #n ")" ::: "memory")
#define PG8_BAR __builtin_amdgcn_s_barrier()
#define PG8_SCHED __builtin_amdgcn_sched_barrier(0)
    Unit cur, nxt; int ui = 0;
    if (!S.next(0, cur)) return;
    f32x4 acc[2][2][4][2];
#pragma unroll
    for (int a = 0; a < 2; ++a)
#pragma unroll
        for (int b = 0; b < 2; ++b)
#pragma unroll
            for (int m = 0; m < 4; ++m)
#pragma unroll
                for (int n = 0; n < 2; ++n) acc[a][b][m][n] = (f32x4){0.f, 0.f, 0.f, 0.f};
    bf16x8 At[4][2], B0[2][2], B1[2][2];
    const char* cA = (const char*)g.A + (size_t)cur.pm * tstep; const char* cB = (const char*)g.Bt + (size_t)cur.pn * bstep;
    S.a_ready(cur);
    if constexpr (SP2) {
        PG8_STAGE(PG8_SB(0, 0), cB, voffB); PG8_STAGE(PG8_SB(0, 1), cB + bh, voffB); PG8_STAGE(PG8_SA(0, 0), cA, voffA); PG8_STAGE(PG8_SA(0, 1), cA + hstep, voffA);
        if (wr == 1) PG8_BAR;
        PG8_WAIT_V(2); PG8_BAR;
        PG8_STAGE(PG8_SB(1, 0), cB + kstep, voffB); PG8_STAGE(PG8_SA(1, 0), cA + kstep, voffA); PG8_STAGE(PG8_SB(1, 1), cB + bh + kstep, voffB);
        PG8_WAIT_V(6); PG8_BAR;
    } else {
        PG8_STAGE(PG8_SB(0, 0), cB, voffB); PG8_STAGE(PG8_SA(0, 0), cA, voffA); PG8_STAGE(PG8_SB(0, 1), cB + bh, voffB); PG8_STAGE(PG8_SA(0, 1), cA + hstep, voffA);
        if (wr == 1) PG8_BAR;
        PG8_WAIT_V(4); PG8_BAR;
        PG8_STAGE(PG8_SB(1, 0), cB + kstep, voffB); PG8_STAGE(PG8_SA(1, 0), cA + kstep, voffA); PG8_STAGE(PG8_SB(1, 1), cB + bh + kstep, voffB);
        PG8_WAIT_V(6); PG8_BAR;
    }
    for (;;) {
        const bool has_next = S.next(ui + 1, nxt);
        const char* nA = has_next ? (const char*)g.A + (size_t)nxt.pm * tstep : cA; const char* nB = has_next ? (const char*)g.Bt + (size_t)nxt.pn * bstep : cB;
        for (int t = 0; t < nt; t += 2) {
            const bool last = (t == nt - 2);
            const char* a1 = cA + (size_t)(t + 1) * kstep;
            const char* a2 = last ? nA : cA + (size_t)(t + 2) * kstep; const char* b2 = last ? nB : cB + (size_t)(t + 2) * kstep;
            const char* a3 = a2 + kstep; const char* b3 = b2 + kstep;
            if (last && has_next) S.a_ready(nxt);
            if constexpr (SP2) {
            PG8_LDB(B0, 0, 0); PG8_LDB(B1, 0, 1); PG8_SCHED; PG8_LDA(At, 0, 0); PG8_STAGE(PG8_SA(1, 1), a1 + hstep, voffA);
            PG8_WAIT_V(8); PG8_WAIT_L(0); PG8_BAR; PG8_MMA(0, 0, At, B0); PG8_MMA(0, 1, At, B1); PG8_BAR; PG8_SCHED;
            PG8_LDA(At, 0, 1); PG8_STAGE(PG8_SB(0, 0), b2, voffB); PG8_STAGE(PG8_SB(0, 1), b2 + bh, voffB); PG8_STAGE(PG8_SA(0, 0), a2, voffA);
            PG8_WAIT_V(8); PG8_WAIT_L(0); PG8_BAR; PG8_MMA(1, 0, At, B0); PG8_MMA(1, 1, At, B1); PG8_BAR; PG8_SCHED;
            PG8_LDB(B0, 1, 0); PG8_LDB(B1, 1, 1); PG8_SCHED; PG8_LDA(At, 1, 0); PG8_STAGE(PG8_SA(0, 1), a2 + hstep, voffA);
            PG8_WAIT_V(8); PG8_WAIT_L(0); PG8_BAR; PG8_MMA(0, 0, At, B0); PG8_MMA(0, 1, At, B1); PG8_BAR; PG8_SCHED;
            PG8_LDA(At, 1, 1); PG8_STAGE(PG8_SB(1, 0), b3, voffB); PG8_STAGE(PG8_SB(1, 1), b3 + bh, voffB); PG8_STAGE(PG8_SA(1, 0), a3, voffA);
            PG8_WAIT_V(8); PG8_WAIT_L(0); PG8_BAR; PG8_MMA(1, 0, At, B0); PG8_MMA(1, 1, At, B1); PG8_BAR; PG8_SCHED;
            } else {
            PG8_LDB(B0, 0, 0); PG8_SCHED; PG8_LDA(At, 0, 0); PG8_STAGE(PG8_SA(1, 1), a1 + hstep, voffA);
            PG8_WAIT_L(8); PG8_BAR; PG8_WAIT_L(0); PG8_MMA(0, 0, At, B0); PG8_BAR; PG8_SCHED;
            PG8_LDB(B1, 0, 1); PG8_STAGE(PG8_SB(0, 0), b2, voffB);
            PG8_BAR; PG8_WAIT_L(0); PG8_MMA(0, 1, At, B1); PG8_BAR;
            PG8_LDA(At, 0, 1); PG8_STAGE(PG8_SA(0, 0), a2, voffA);
            PG8_BAR; PG8_WAIT_L(0); PG8_MMA(1, 0, At, B0); PG8_BAR; PG8_SCHED;
            PG8_STAGE(PG8_SB(0, 1), b2 + bh, voffB);
            PG8_WAIT_V(6); PG8_BAR; PG8_MMA(1, 1, At, B1); PG8_BAR;
            PG8_LDB(B0, 1, 0); PG8_SCHED; PG8_LDA(At, 1, 0); PG8_STAGE(PG8_SA(0, 1), a2 + hstep, voffA);
            PG8_WAIT_L(8); PG8_BAR; PG8_WAIT_L(0); PG8_MMA(0, 0, At, B0); PG8_BAR; PG8_SCHED;
            PG8_LDB(B1, 1, 1); PG8_STAGE(PG8_SB(1, 0), b3, voffB);
            PG8_BAR; PG8_WAIT_L(0); PG8_MMA(0, 1, At, B1); PG8_BAR;
            PG8_LDA(At, 1, 1); PG8_STAGE(PG8_SA(1, 0), a3, voffA);
            PG8_BAR; PG8_WAIT_L(0); PG8_MMA(1, 0, At, B0); PG8_BAR; PG8_SCHED;
            PG8_STAGE(PG8_SB(1, 1), b3 + bh, voffB);
            PG8_WAIT_V(6); PG8_BAR; PG8_MMA(1, 1, At, B1); PG8_BAR;
            }
        }
        if constexpr (ALIGN_EPI) { if (wr == 0) PG8_BAR; }
        if constexpr (!Epi::AFTER_DRAIN) { E(acc, cur, wr, wc, fr, fq); S.done(cur); }
        if (!has_next) break;
#pragma unroll
        for (int a = 0; a < 2; ++a)
#pragma unroll
            for (int b = 0; b < 2; ++b)
#pragma unroll
                for (int m = 0; m < 4; ++m)
#pragma unroll
                    for (int n = 0; n < 2; ++n) acc[a][b][m][n] = (f32x4){0.f, 0.f, 0.f, 0.f};
        cur = nxt; cA = nA; cB = nB; ++ui;
        if constexpr (ALIGN_EPI) { if (wr == 1) PG8_BAR; }
    }
    PG8_WAIT_V(0);
    if constexpr (!ALIGN_EPI) { if (wr == 0) PG8_BAR; }
    PG8_BAR;
#undef PG8_SA
#undef PG8_SB
#undef PG8_STAGE
#undef PG8_LDA
#undef PG8_LDB
#undef PG8_MMA
#undef PG8_WAIT_V
#undef PG8_WAIT_L
#undef PG8_BAR
#undef PG8_SCHED
}
}

#define LAS __attribute__((address_space(3)))
#define CAS __attribute__((address_space(4)))
typedef unsigned short bf16;
typedef float f32x4 __attribute__((ext_vector_type(4)));
typedef short bf16x8 __attribute__((ext_vector_type(8)));
typedef unsigned u32x4 __attribute__((ext_vector_type(4)));
typedef unsigned u32x2 __attribute__((ext_vector_type(2)));

constexpr int NW = 8, NT = 512;
constexpr int DM = 1024, NTOK = 12288, NPR = 8192, NKR = 13312, INC = 2144, INP = 2304, DFF = 2816, DUP = 5632;
constexpr float EPS = 1e-6f, LOG2E = 1.4426950408889634f;
constexpr float QS = 0.125f * LOG2E;
constexpr float MLAQS = 0.10206207261596575f * LOG2E;

constexpr size_t MiB = 1u << 20;
constexpr size_t WS_CTL = 0, WS_MOD = 1 * MiB, WS_ROPE = 1 * MiB + 256 * 1024, WS_W = 2 * MiB, W_LSTRIDE = 24 * MiB;
constexpr size_t W_IN = 0, W_OUT = 4718592, W_UP = W_OUT + 2097152, W_DOWN = W_UP + 11534336, W_B2 = W_DOWN + 5767168;
static_assert(W_B2 + 786432 <= W_LSTRIDE, "weights");
constexpr size_t WS_XN = 50 * MiB, WS_PROJ = 74 * MiB, WS_A2 = 128 * MiB, WS_MQKV = 138 * MiB, WS_QC = 164 * MiB, WS_KPE = 203 * MiB, WS_YCAT = 204 * MiB;
constexpr size_t WS_ACT = 116 * MiB, WS_U = 116 * MiB, WS_SS1 = 228 * MiB, WS_SS2 = 229 * MiB, WS_HALO = 230 * MiB, WS_XRES = 232 * MiB, WS_END = 256 * MiB;
constexpr size_t WS_BIAS = 65536;
constexpr int NBIAS = 2304 + 5632;
constexpr size_t QSZ = (size_t)NKR * 256 * 2, KSZ = (size_t)NKR * 128 * 2;
constexpr int LDS_BYTES = 163840, LDS_CTL = 163840 - 256;
constexpr size_t WS_BAR = 16384;

struct Args { const float* in[28]; float* out; unsigned char* ws; };

__device__ __forceinline__ unsigned f2bf(float f) { unsigned u = __builtin_bit_cast(unsigned, f); return (u + 0x7fffu + ((u >> 16) & 1u)) >> 16; }
__device__ __forceinline__ unsigned pk2(float lo, float hi) { unsigned r; asm("v_cvt_pk_bf16_f32 %0, %1, %2" : "=v"(r) : "v"(lo), "v"(hi)); return r; }
__device__ __forceinline__ float bflo(unsigned u) { return __builtin_bit_cast(float, u << 16); }
__device__ __forceinline__ float bfhi(unsigned u) { return __builtin_bit_cast(float, u & 0xffff0000u); }
__device__ __forceinline__ f32x4 ld4bf(const bf16* p) { const u32x2 u = *(const u32x2*)p; return (f32x4){bflo(u.x), bfhi(u.x), bflo(u.y), bfhi(u.y)}; }
__device__ __forceinline__ void st4bf(bf16* p, f32x4 v) { u32x2 u; u.x = pk2(v[0], v[1]); u.y = pk2(v[2], v[3]); *(u32x2*)p = u; }
__device__ __forceinline__ float shx(float v, int m, int lane) { return __builtin_bit_cast(float, __builtin_amdgcn_ds_bpermute((lane ^ m) << 2, __builtin_bit_cast(int, v))); }
#define DPPF(v, ctrl) __builtin_bit_cast(float, __builtin_amdgcn_mov_dpp(__builtin_bit_cast(int, (v)), (ctrl), 0xf, 0xf, false))
__device__ __forceinline__ float sum16(float v, int) { v += DPPF(v, 0x121); v += DPPF(v, 0x122); v += DPPF(v, 0x124); v += DPPF(v, 0x128); return v; }
__device__ __forceinline__ float wave_sum(float v, int lane) {
    v = sum16(v, lane);
    const int iv = __builtin_bit_cast(int, v);
    const float a = __builtin_bit_cast(float, __builtin_amdgcn_readlane(iv, 0)), b = __builtin_bit_cast(float, __builtin_amdgcn_readlane(iv, 16)),
                c = __builtin_bit_cast(float, __builtin_amdgcn_readlane(iv, 32)), d = __builtin_bit_cast(float, __builtin_amdgcn_readlane(iv, 48));
    return (a + b) + (c + d);
}
__device__ __forceinline__ float dot4(f32x4 a) { return (a[0] * a[0] + a[1] * a[1]) + (a[2] * a[2] + a[3] * a[3]); }
__device__ __forceinline__ f32x4 shfl4(f32x4 v, int m, int lane) { return (f32x4){shx(v[0], m, lane), shx(v[1], m, lane), shx(v[2], m, lane), shx(v[3], m, lane)}; }

__device__ __forceinline__ void transpose_item(const float* W, int N, bf16* WT, int ldk, int row_off, int k_off, float scale, LAS float* scr, int item, int lane) {
    const int nblk = (N + 63) / 64, kb = item / nblk, nb = item % nblk, k0 = 64 * kb, n0 = 64 * nb;
    const bool act = n0 + lane < N;
    const float* wp = W + (size_t)k0 * N + n0 + lane;
    float v[64];
#pragma unroll
    for (int i = 0; i < 64; ++i) v[i] = act ? wp[(size_t)i * N] : 0.f;
#pragma unroll
    for (int i = 0; i < 64; ++i) scr[i * 65 + lane] = v[i] * scale;
    asm volatile("s_waitcnt lgkmcnt(0)" ::: "memory");
    const int c = lane & 7;
#pragma unroll
    for (int j = 0; j < 8; ++j) { const int n = (lane >> 3) + 8 * j; const LAS float* s = scr + (8 * c) * 65 + n;
        u32x4 o; o.x = pk2(s[0 * 65], s[1 * 65]); o.y = pk2(s[2 * 65], s[3 * 65]); o.z = pk2(s[4 * 65], s[5 * 65]); o.w = pk2(s[6 * 65], s[7 * 65]);
        if (n0 + n < N) *(u32x4*)(WT + (size_t)(row_off + n0 + n) * ldk + k_off + k0 + 8 * c) = o; }
    asm volatile("s_waitcnt lgkmcnt(0)" ::: "memory");
}

template <class ArgsRef>
__device__ __forceinline__ void wconv(const ArgsRef& a, unsigned char* ws, int l, int sel, int w, int nwk, LAS float* scr, int lane) {
    constexpr int I_IN = 16 * 34, I_OUT = 16 * 16, I_UP = 16 * 88, I_DN = 44 * 16, I_Q = 3 * 6, I_KV = 2 * 8;
    const int n_in = (sel & 1) ? I_IN : 0, n_out = (sel & 2) ? I_OUT : 0, n_up = (sel & 4) ? I_UP : 0, n_dn = (sel & 8) ? I_DN : 0, n_q = (sel & 16) ? I_Q : 0, n_kv = (sel & 32) ? I_KV : 0;
    const int total = n_in + n_out + n_up + n_dn + n_q + n_kv;
    unsigned char* wl = ws + WS_W + l * W_LSTRIDE;
    for (int it = w; it < total; it += nwk) {
        int r = it;
        if (r < n_in) { transpose_item(a.in[13] + (size_t)l * 1024 * INC, INC, (bf16*)(wl + W_IN), 1024, 0, 0, 1.f, scr, r, lane); continue; } r -= n_in;
        if (r < n_out) { transpose_item(a.in[22] + (size_t)l * 1024 * 1024, 1024, (bf16*)(wl + W_OUT), 1024, 0, 0, 1.f, scr, r, lane); continue; } r -= n_out;
        if (r < n_up) { transpose_item(a.in[24] + (size_t)l * 1024 * DUP, DUP, (bf16*)(wl + W_UP), 1024, 0, 0, 1.f, scr, r, lane); continue; } r -= n_up;
        if (r < n_dn) { transpose_item(a.in[26] + (size_t)l * DFF * 1024, 1024, (bf16*)(wl + W_DOWN), DFF, 0, 0, 1.f, scr, r, lane); continue; } r -= n_dn;
        if (r < n_q) { transpose_item(a.in[16] + (size_t)l * 192 * 384, 384, (bf16*)(wl + W_B2), 384, 0, 0, MLAQS, scr, r, lane); continue; } r -= n_q;
        transpose_item(a.in[18] + (size_t)l * 128 * 512, 512, (bf16*)(wl + W_B2), 384, 384, 192, 1.f, scr, r, lane);
    }
}
template <class ArgsRef>
__device__ __forceinline__ void phase0(const ArgsRef& a, LAS unsigned char* lds, int tid, int lane, int wave) {
    unsigned char* ws = a.ws;
    const int G = gridDim.x, bid = blockIdx.x;
    if (bid < 96) {
        LAS float* sl = (LAS float*)(lds + 16384);
        for (int e = tid; e < 3072; e += NT) { const int c = e >> 10, k = e & 1023; const float v = c == 0 ? a.in[9][k] : a.in[8][(c - 1) * 1024 + k]; sl[e] = v / (1.f + __expf(-v)); }
        __syncthreads();
    }
    for (int it = bid; it < 96; it += G) {
        const int l = it / 48, n0 = (it % 48) * 128;
        const float* wa = a.in[10] + (size_t)l * 1024 * 6144;
        const LAS float* sl = (const LAS float*)(lds + 16384);
        float acc[3][2] = {{0.f, 0.f}, {0.f, 0.f}, {0.f, 0.f}};
        const int kb = wave * 128;
#pragma unroll 16
        for (int k = 0; k < 128; ++k) {
            const int kk = kb + k;
            const float2 w = *(const float2*)(wa + (size_t)kk * 6144 + n0 + 2 * lane);
            const float s0 = sl[kk], s1 = sl[1024 + kk], s2 = sl[2048 + kk];
            acc[0][0] += s0 * w.x; acc[0][1] += s0 * w.y; acc[1][0] += s1 * w.x; acc[1][1] += s1 * w.y; acc[2][0] += s2 * w.x; acc[2][1] += s2 * w.y;
        }
        LAS float* red = (LAS float*)lds;
#pragma unroll
        for (int c = 0; c < 3; ++c) { red[(wave * 3 + c) * 128 + 2 * lane] = acc[c][0]; red[(wave * 3 + c) * 128 + 2 * lane + 1] = acc[c][1]; }
        __syncthreads();
        if (tid < 384) { const int c = tid / 128, n = tid % 128; float s = 0.f;
#pragma unroll
            for (int w = 0; w < 8; ++w) s += red[(w * 3 + c) * 128 + n];
            ((float*)(ws + WS_MOD))[(size_t)(l * 3 + c) * 6144 + n0 + n] = s + a.in[11][(size_t)l * 6144 + n0 + n]; }
        __syncthreads();
    }
    if (bid == G - 1) {
        float* rt = (float*)(ws + WS_ROPE);
        for (int e = tid; e < 1024; e += NT) { const int pos = e >> 4, i = e & 15; const float inv = exp2f(-(float)(2 * i) / 32.f * 13.287712379549449f); const float ang = (float)pos * inv;
            rt[e] = __cosf(ang); rt[1024 + e] = __sinf(ang); }
        for (int e = tid; e < 512; e += NT) { const int pos = e >> 3, i = e & 7; const float inv = exp2f(-(float)(2 * i) / 16.f * 13.287712379549449f); const float ang = (float)pos * inv;
            rt[2048 + e] = __cosf(ang); rt[2560 + e] = __sinf(ang); }
    }
    const int gt = bid * NT + tid, NGT = G * NT;
    if (gt < 256) ((unsigned*)(ws + WS_CTL))[gt] = 0u;
    if (gt < 64) ((unsigned*)(ws + WS_CTL))[2048 + gt] = 0u;
    for (int l = 0; l < 2; ++l) {
        bf16* b2 = (bf16*)(ws + WS_W + l * W_LSTRIDE + W_B2);
        for (int ch = gt; ch < 1024 * 48; ch += NGT) { const int n = ch / 48, k = (ch % 48) * 8;
            const bool data = (n < 384 && k < 192) || (n >= 384 && n < 896 && k >= 192 && k < 320);
            if (!data) *(u32x4*)(b2 + (size_t)n * 384 + k) = (u32x4){0u, 0u, 0u, 0u}; }
        bf16* wi = (bf16*)(ws + WS_W + l * W_LSTRIDE + W_IN) + (size_t)INC * 1024;
        for (int ch = gt; ch < 160 * 128; ch += NGT) *(u32x4*)(wi + (size_t)ch * 8) = (u32x4){0u, 0u, 0u, 0u};
    }
    LAS float* scr = (LAS float*)(lds + 28672 + wave * 16640);
    wconv(a, ws, 0, 1 | 2 | 16 | 32, bid * NW + wave, G * NW, scr, lane);
}

__device__ __forceinline__ void prep_phase(const float* x0, const float* x1, const float* nw, const float* mod, int sc_off, bf16* XN, float* SS, int lane, int gw, int NGW) {
    for (int row = gw; row < NTOK; row += NGW) {
        const float* xr = row < NPR ? x0 + (size_t)row * DM : x1 + (size_t)(row - NPR) * DM;
        const int c = row < NPR ? 0 : 1 + ((row - NPR) >> 11);
        const float* mp = mod + c * 6144;
        f32x4 v[4]; float ss = 0.f;
#pragma unroll
        for (int j = 0; j < 4; ++j) { v[j] = *(const f32x4*)(xr + 4 * (lane + 64 * j)); ss += dot4(v[j]); }
        ss = wave_sum(ss, lane);
#pragma unroll
        for (int j = 0; j < 4; ++j) { const int col = 4 * (lane + 64 * j);
            const f32x4 g = *(const f32x4*)(nw + col), sc = *(const f32x4*)(mp + sc_off + col);
            st4bf(XN + (size_t)row * DM + col, v[j] * g * (1.f + sc)); }
        if (lane < 16) SS[(size_t)row * 16 + lane] = lane == 0 ? ss : 0.f;
    }
}
template <class ArgsRef>
__device__ __forceinline__ void bias_phase(const ArgsRef& a, unsigned char* ws, LAS unsigned char* lds, int tid, int lane, int wave) {
    const float* mod = (const float*)(ws + WS_MOD);
    float* BIAS = (float*)(ws + WS_BIAS);
    for (int it = blockIdx.x; it < 62; it += gridDim.x) {
        const int l = it / 31, r = it % 31; const bool up = r >= 9;
        const int N = up ? DUP : INC, n0 = (up ? r - 9 : r) * 256 + 4 * lane;
        const float* W = up ? a.in[24] + (size_t)l * 1024 * DUP : a.in[13] + (size_t)l * 1024 * INC;
        const float* shp = mod + (size_t)l * 3 * 6144 + (up ? 3072 : 0);
        LAS float* sl = (LAS float*)(lds + 32768);
        for (int e = tid; e < 3072; e += NT) sl[e] = shp[(e >> 10) * 6144 + (e & 1023)];
        __syncthreads();
        const bool act = n0 < N;
        f32x4 acc[3] = {(f32x4){0.f, 0.f, 0.f, 0.f}, (f32x4){0.f, 0.f, 0.f, 0.f}, (f32x4){0.f, 0.f, 0.f, 0.f}};
        const int kb = wave * 128;
#pragma unroll 16
        for (int k = 0; k < 128; ++k) { const int kk = kb + k;
            const f32x4 w = act ? *(const f32x4*)(W + (size_t)kk * N + n0) : (f32x4){0.f, 0.f, 0.f, 0.f};
            acc[0] += w * sl[kk]; acc[1] += w * sl[1024 + kk]; acc[2] += w * sl[2048 + kk]; }
        LAS f32x4* red = (LAS f32x4*)lds;
#pragma unroll
        for (int c = 0; c < 3; ++c) red[(wave * 3 + c) * 64 + lane] = acc[c];
        __syncthreads();
        if (tid < 192) { const int c = tid >> 6, ln = tid & 63; f32x4 t = red[c * 64 + ln];
#pragma unroll
            for (int w = 1; w < 8; ++w) t += red[(w * 3 + c) * 64 + ln];
            const int nn = (up ? r - 9 : r) * 256 + 4 * ln;
            if (nn < N) *(f32x4*)(BIAS + (size_t)(l * 3 + c) * NBIAS + (up ? 2304 : 0) + nn) = t;
            else if (!up && nn < 2304) *(f32x4*)(BIAS + (size_t)(l * 3 + c) * NBIAS + nn) = (f32x4){0.f, 0.f, 0.f, 0.f}; }
        __syncthreads();
    }
}

struct P3Ptrs {
    const bf16* PROJ; bf16 *A2, *KPE, *YCAT, *Qc_rot, *Qc_raw, *Kc, *Vc, *Qd_rot, *Qd_raw, *Kd, *Vd;
    const float *conv_a, *gq_mla, *gkv_mla, *gq, *gk, *rope;
    const float *c_ckv, *c_kpe, *c_gk, *c_gv, *c_sk, *c_sv;
    float *o_ckv, *o_kpe, *o_gk, *o_gv, *o_sk, *o_sv;
    int l;
};
__device__ __forceinline__ f32x4 rope64(f32x4 v, int jl, int prow, int pcol, const float* rt, int lane) {
    const f32x4 pr = shfl4(v, 4, lane);
    const int pos = jl < 8 ? prow : pcol, fi = 4 * (jl & 3);
    const f32x4 c = *(const f32x4*)(rt + pos * 16 + fi), s = *(const f32x4*)(rt + 1024 + pos * 16 + fi);
    const float sg = (jl & 4) ? 1.f : -1.f;
    return v * c + pr * s * sg;
}
__device__ __forceinline__ void p3_phase(const P3Ptrs& P, int lane, int gw, int NGW) {
    const int l = P.l;
    for (int row = gw; row < NKR; row += NGW) {
        if (row < NTOK) {
            const bool samp = row >= NPR;
            int b, t, kr, T;
            if (!samp) { b = row >> 8; t = row & 255; kr = row; T = 256; } else { b = (row - NPR) >> 11; t = (row - NPR) & 2047; kr = NPR + b * 2560 + t; T = 2048; }
            const int prow = t >> 6, pcol = t & 63;
            const bf16* pr = P.PROJ + (size_t)row * INP;
            const size_t ob = (size_t)((b * 2 + l) * 256 + t);
            const int ci = 4 * lane, jl = lane & 15;
            const u32x2 z2 = (u32x2){0u, 0u};
            const bool hp = t > 0, hn = t < T - 1;
            const u32x2 r_xa = *(const u32x2*)(pr + ci), r_gb = *(const u32x2*)(pr + 256 + ci), r_gc = *(const u32x2*)(pr + 512 + ci);
            const u32x2 r_pxa = hp ? *(const u32x2*)(pr - INP + ci) : z2, r_pgc = hp ? *(const u32x2*)(pr - INP + 512 + ci) : z2;
            const u32x2 r_nxa = hn ? *(const u32x2*)(pr + INP + ci) : z2, r_ngc = hn ? *(const u32x2*)(pr + INP + 512 + ci) : z2;
            const u32x2 r_cq = lane < 48 ? *(const u32x2*)(pr + 768 + ci) : z2, r_ckv = lane < 32 ? *(const u32x2*)(pr + 960 + ci) : z2, r_kpe = lane < 8 ? *(const u32x2*)(pr + 1088 + ci) : z2;
            const u32x2 r_qc = *(const u32x2*)(pr + 1120 + ci), r_kvc = *(const u32x2*)(pr + 1376 + ci), r_qd = *(const u32x2*)(pr + 1632 + ci), r_kvd = *(const u32x2*)(pr + 1888 + ci);
            const float* cw = P.conv_a + (size_t)l * 768;
            const f32x4 w0 = *(const f32x4*)(cw + ci), w1 = *(const f32x4*)(cw + 256 + ci), w2 = *(const f32x4*)(cw + 512 + ci);
            const f32x4 g_qm = lane < 48 ? *(const f32x4*)(P.gq_mla + l * 192 + ci) : (f32x4){0.f, 0.f, 0.f, 0.f}, g_kvm = lane < 32 ? *(const f32x4*)(P.gkv_mla + l * 128 + ci) : (f32x4){0.f, 0.f, 0.f, 0.f};
            const f32x4 g_q = *(const f32x4*)(P.gq + l * 64 + 4 * jl), g_k = *(const f32x4*)(P.gk + l * 64 + 4 * jl);
            const int pos64 = jl < 8 ? prow : pcol, fi64 = 4 * (jl & 3);
            const f32x4 c64 = *(const f32x4*)(P.rope + pos64 * 16 + fi64), s64 = *(const f32x4*)(P.rope + 1024 + pos64 * 16 + fi64);
            const int pos32 = (lane & 7) < 4 ? prow : pcol, fi32 = 4 * (lane & 1);
            const f32x4 c32 = *(const f32x4*)(P.rope + 2048 + pos32 * 8 + fi32), s32 = *(const f32x4*)(P.rope + 2560 + pos32 * 8 + fi32);
#define CV4(u) ((f32x4){bflo((u).x), bfhi((u).x), bflo((u).y), bfhi((u).y)})
#define ROPE64(v) ((v) * c64 + shfl4((v), 4, lane) * s64 * ((jl & 4) ? 1.f : -1.f))
            { const f32x4 ya = CV4(r_gb) * (w0 * (CV4(r_pxa) * CV4(r_pgc)) + w1 * (CV4(r_xa) * CV4(r_gc)) + w2 * (CV4(r_nxa) * CV4(r_ngc)));
              st4bf(P.YCAT + (size_t)row * DM + ci, ya); }
            { const f32x4 v = CV4(r_cq);
              const float rs = rsqrtf(wave_sum(dot4(v), lane) * (1.f / 192.f) + EPS);
              if (lane < 48) st4bf(P.A2 + (size_t)kr * 384 + ci, v * rs * g_qm); }
            { const f32x4 v = CV4(r_ckv);
              const float rs = rsqrtf(wave_sum(dot4(v), lane) * (1.f / 128.f) + EPS);
              if (lane < 32) { const f32x4 o = v * rs * g_kvm;
                  st4bf(P.A2 + (size_t)kr * 384 + 192 + ci, o);
                  if (!samp) *(f32x4*)(P.o_ckv + ob * 128 + ci) = o; }
              else if (lane < 48) { unsigned zz = 0u; asm volatile("" : "+v"(zz)); *(u32x2*)(P.A2 + (size_t)kr * 384 + 320 + 4 * (lane - 32)) = (u32x2){zz, zz}; } }
            { const f32x4 v = CV4(r_kpe);
              const f32x4 r = v * c32 + shfl4(v, 2, lane) * s32 * ((lane & 2) ? 1.f : -1.f);
              if (lane < 8) { if (!samp) *(f32x4*)(P.o_kpe + ob * 32 + ci) = v; st4bf(P.KPE + (size_t)kr * 32 + ci, samp ? r : v); } }
            { f32x4 v = CV4(r_qc);
              const float rs = rsqrtf(sum16(dot4(v), lane) * (1.f / 64.f) + EPS);
              v = v * rs * g_q;
              st4bf(P.Qc_raw + (size_t)kr * 256 + ci, v * QS);
              const f32x4 r = ROPE64(v);
              if (samp) st4bf(P.Qc_rot + (size_t)kr * 256 + ci, r * QS); }
            { const f32x4 v = CV4(r_kvc);
              const float rs = rsqrtf(sum16(dot4(v), lane) * (1.f / 64.f) + EPS);
              const f32x4 kn = v * rs * g_k;
              const f32x4 r = ROPE64(kn);
              if (lane < 32) { if (!samp) *(f32x4*)(P.o_gk + ob * 128 + ci) = kn; st4bf(P.Kc + (size_t)kr * 128 + ci, samp ? r : kn); }
              else { if (!samp) *(f32x4*)(P.o_gv + ob * 128 + 4 * (lane - 32)) = v; st4bf(P.Vc + (size_t)kr * 128 + 4 * (lane - 32), v); } }
            { const f32x4 v = CV4(r_qd);
              st4bf(P.Qd_raw + (size_t)kr * 256 + ci, v * QS);
              const f32x4 r = ROPE64(v);
              if (samp) st4bf(P.Qd_rot + (size_t)kr * 256 + ci, r * QS); }
            { const f32x4 v = CV4(r_kvd);
              const f32x4 r = ROPE64(v);
              if (lane < 32) { if (!samp) *(f32x4*)(P.o_sk + ob * 128 + ci) = v; st4bf(P.Kd + (size_t)kr * 128 + ci, samp ? r : v); }
              else { if (!samp) *(f32x4*)(P.o_sv + ob * 128 + 4 * (lane - 32)) = v; st4bf(P.Vd + (size_t)kr * 128 + 4 * (lane - 32), v); } }
#undef CV4
#undef ROPE64
        } else {
            const int ci = row - NTOK, b = ci >> 9, j = ci & 511, kr = NPR + b * 2560 + 2048 + j;
            const size_t cb = (size_t)((b * 2 + l) * 512 + j);
            f32x4 z = (f32x4){0.f, 0.f, 0.f, 0.f}; asm volatile("" : "+v"(z));
            if (lane < 48) st4bf(P.A2 + (size_t)kr * 384 + 4 * lane, z);
            if (lane < 32) st4bf(P.A2 + (size_t)kr * 384 + 192 + 4 * lane, *(const f32x4*)(P.c_ckv + cb * 128 + 4 * lane));
            else if (lane < 48) st4bf(P.A2 + (size_t)kr * 384 + 320 + 4 * (lane - 32), z);
            if (lane < 8) st4bf(P.KPE + (size_t)kr * 32 + 4 * lane, *(const f32x4*)(P.c_kpe + cb * 32 + 4 * lane));
            if (lane < 32) { st4bf(P.Kc + (size_t)kr * 128 + 4 * lane, *(const f32x4*)(P.c_gk + cb * 128 + 4 * lane));
                             st4bf(P.Kd + (size_t)kr * 128 + 4 * lane, *(const f32x4*)(P.c_sk + cb * 128 + 4 * lane)); }
            else { st4bf(P.Vc + (size_t)kr * 128 + 4 * (lane - 32), *(const f32x4*)(P.c_gv + cb * 128 + 4 * (lane - 32)));
                   st4bf(P.Vd + (size_t)kr * 128 + 4 * (lane - 32), *(const f32x4*)(P.c_sv + cb * 128 + 4 * (lane - 32))); }
        }
    }
}

struct AttnSrc {
    const bf16* Qraw; const bf16* Qrot; int qpitch;
    const bf16* K0; int k0pitch; const bf16* K1;
    const bf16* V; int vpitch;
    bf16* Y; int outcol;
    int krbase, rowbase, q0, lo, hi, nctx;
    bool samp, window; float m0; bool sink;
    const float* rope;
};
template <int DK>
__device__ __forceinline__ void attn_unit(const AttnSrc& S, LAS unsigned char* lds, int tid, int lane, int wave) {
    constexpr int TK = 128, NKB = TK / 16, NPP = TK / 32;
    constexpr int KP = DK + 8, VP = TK + 8, KS = DK / 32, CPK = DK / 8;
    constexpr int NKC = TK * CPK / NT, NVC = TK * 8 / NT;
    LAS bf16* Ks = (LAS bf16*)lds;
    LAS bf16* Vt = (LAS bf16*)(lds + 2 * TK * KP * 2);
    const int g = lane >> 4, fr = lane & 15;
    const int qpos = S.q0 + wave * 16 + fr;
    const size_t qkr = (size_t)(S.krbase + qpos);
    bf16x8 qraw[KS], qrot[KS];
#pragma unroll
    for (int ks = 0; ks < KS; ++ks) { qraw[ks] = *(const bf16x8*)(S.Qraw + qkr * S.qpitch + ks * 32 + g * 8); qrot[ks] = qraw[ks]; }
    if (S.samp) {
        if (DK == 96) {
            const bf16x8 own = qraw[KS - 1], par = *(const bf16x8*)(S.Qraw + qkr * S.qpitch + 64 + (g ^ 1) * 8);
            const int pos = g < 2 ? (qpos >> 6) : (qpos & 63);
            const float sg = (g & 1) ? 1.f : -1.f;
            const float* ct = S.rope + 2048 + pos * 8; const float* st = S.rope + 2560 + pos * 8;
            bf16x8 r;
#pragma unroll
            for (int e = 0; e < 8; ++e) { const float o = bflo((unsigned)(unsigned short)own[e]), p = bflo((unsigned)(unsigned short)par[e]);
                r[e] = (short)f2bf(o * ct[e] + p * st[e] * sg); }
            qrot[KS - 1] = r;
        } else {
#pragma unroll
            for (int ks = 0; ks < KS; ++ks) qrot[ks] = *(const bf16x8*)(S.Qrot + qkr * S.qpitch + ks * 32 + g * 8);
        }
    }
    bf16x8 qc[KS];
#pragma unroll
    for (int ks = 0; ks < KS; ++ks) qc[ks] = S.samp ? qrot[ks] : qraw[ks];
    float m = S.m0, l = (S.sink && g == 0) ? 1.f : 0.f;
    f32x4 o[4];
#pragma unroll
    for (int d = 0; d < 4; ++d) o[d] = (f32x4){0.f, 0.f, 0.f, 0.f};
    const int nloc = S.hi - S.lo, ntile = nloc + S.nctx;
    u32x4 kreg[NKC], vreg[NVC];
    auto gload = [&](int j) {
        const int tile = j < nloc ? S.lo + j : (2048 / TK) + (j - nloc);
        const size_t kr = (size_t)(S.krbase + tile * TK);
#pragma unroll
        for (int c = 0; c < NKC; ++c) { const int ch = tid + c * NT, key = ch / CPK, part = ch % CPK;
            if (DK == 64) kreg[c] = *(const u32x4*)(S.K0 + (kr + key) * S.k0pitch + part * 8);
            else kreg[c] = part < 8 ? *(const u32x4*)(S.K0 + (kr + key) * S.k0pitch + part * 8) : *(const u32x4*)(S.K1 + (kr + key) * 32 + (part - 8) * 8); }
#pragma unroll
        for (int c = 0; c < NVC; ++c) { const int ch = tid + c * NT, vkey = ch & (TK - 1), vdc = ch / TK;
            vreg[c] = *(const u32x4*)(S.V + (kr + vkey) * S.vpitch + vdc * 8); }
    };
    auto lstore = [&](int buf) {
        LAS bf16* kb = Ks + buf * TK * KP; LAS bf16* vb = Vt + buf * 64 * VP;
#pragma unroll
        for (int c = 0; c < NKC; ++c) { const int ch = tid + c * NT, key = ch / CPK, part = ch % CPK; *(LAS u32x4*)(kb + key * KP + part * 8) = kreg[c]; }
#pragma unroll
        for (int c = 0; c < NVC; ++c) { const int ch = tid + c * NT, vkey = ch & (TK - 1), vdc = ch / TK;
            LAS bf16* vp = vb + (vdc * 8) * VP + vkey; const u32x4 v = vreg[c];
            vp[0 * VP] = (bf16)(v.x & 0xffffu); vp[1 * VP] = (bf16)(v.x >> 16); vp[2 * VP] = (bf16)(v.y & 0xffffu); vp[3 * VP] = (bf16)(v.y >> 16);
            vp[4 * VP] = (bf16)(v.z & 0xffffu); vp[5 * VP] = (bf16)(v.z >> 16); vp[6 * VP] = (bf16)(v.w & 0xffffu); vp[7 * VP] = (bf16)(v.w >> 16); }
    };
    gload(0); lstore(0);
    __syncthreads();
    for (int j = 0; j < ntile; ++j) {
        const int buf = j & 1;
        if (j + 1 < ntile) gload(j + 1);
        const bool loc = j < nloc;
        if (j == nloc) {
#pragma unroll
            for (int ks = 0; ks < KS; ++ks) qc[ks] = qraw[ks]; }
        const LAS bf16* kb = Ks + buf * TK * KP; const LAS bf16* vb = Vt + buf * 64 * VP;
        f32x4 s[NKB];
#pragma unroll
        for (int kk = 0; kk < NKB; ++kk) { s[kk] = (f32x4){0.f, 0.f, 0.f, 0.f};
#pragma unroll
            for (int ks = 0; ks < KS; ++ks) { const bf16x8 af = *(const LAS bf16x8*)(kb + (kk * 16 + fr) * KP + ks * 32 + g * 8);
                s[kk] = __builtin_amdgcn_mfma_f32_16x16x32_bf16(af, qc[ks], s[kk], 0, 0, 0); } }
        if (S.window && loc) {
            const int kp0 = (S.lo + j) * TK + g * 4;
#pragma unroll
            for (int kk = 0; kk < NKB; ++kk)
#pragma unroll
                for (int i = 0; i < 4; ++i) { const int d = kp0 + kk * 16 + i - qpos; if (d > 128 || d < -128) s[kk][i] = -INFINITY; }
        }
        float mx = -INFINITY;
#pragma unroll
        for (int kk = 0; kk < NKB; ++kk) mx = fmaxf(mx, fmaxf(fmaxf(s[kk][0], s[kk][1]), fmaxf(s[kk][2], s[kk][3])));
        mx = fmaxf(mx, shx(mx, 16, lane)); mx = fmaxf(mx, shx(mx, 32, lane));
        const float mn = fmaxf(m, mx), alpha = __builtin_amdgcn_exp2f(m - mn);
        m = mn;
        float ls = 0.f;
#pragma unroll
        for (int kk = 0; kk < NKB; ++kk)
#pragma unroll
            for (int i = 0; i < 4; ++i) { const float p = __builtin_amdgcn_exp2f(s[kk][i] - mn); s[kk][i] = p; ls += p; }
        l = l * alpha + ls;
#pragma unroll
        for (int d = 0; d < 4; ++d) o[d] = o[d] * alpha;
        bf16x8 pf[NPP];
#pragma unroll
        for (int pp = 0; pp < NPP; ++pp) {
            const unsigned w0 = pk2(s[2 * pp][0], s[2 * pp][1]), w1 = pk2(s[2 * pp][2], s[2 * pp][3]), w2 = pk2(s[2 * pp + 1][0], s[2 * pp + 1][1]), w3 = pk2(s[2 * pp + 1][2], s[2 * pp + 1][3]);
            pf[pp] = __builtin_bit_cast(bf16x8, (u32x4){w0, w1, w2, w3});
        }
#pragma unroll
        for (int d = 0; d < 4; ++d)
#pragma unroll
            for (int pp = 0; pp < NPP; ++pp) {
                const LAS bf16* vr = vb + (d * 16 + fr) * VP + pp * 32 + g * 4;
                const u32x2 lo = *(const LAS u32x2*)vr, hi = *(const LAS u32x2*)(vr + 16);
                const bf16x8 af = __builtin_bit_cast(bf16x8, (u32x4){lo.x, lo.y, hi.x, hi.y});
                o[d] = __builtin_amdgcn_mfma_f32_16x16x32_bf16(af, pf[pp], o[d], 0, 0, 0);
            }
        if (j + 1 < ntile) lstore(buf ^ 1);
        __syncthreads();
    }
    float lt = l + shx(l, 16, lane); lt += shx(lt, 32, lane);
    const float inv = 1.f / lt;
    bf16* yr = S.Y + (size_t)(S.rowbase + qpos) * DM + S.outcol + g * 4;
#pragma unroll
    for (int d = 0; d < 4; ++d) st4bf(yr + d * 16, o[d] * inv);
}

struct AttnBufs { const bf16 *MQKV, *KPE, *Qc_rot, *Qc_raw, *Kc, *Vc, *Qd_rot, *Qd_raw, *Kd, *Vd; bf16* YCAT; const float* sink; const float* rope; unsigned* ctr; };
constexpr int ATT_NU = 384 + 768;
__device__ __forceinline__ void attn_phase(const AttnBufs& B, LAS unsigned char* lds, int tid, int lane, int wave) {
    volatile LAS unsigned* shu = (volatile LAS unsigned*)(lds + LDS_CTL);
    for (;;) {
        if (tid == 0) *shu = atomicAdd(B.ctr, 1u);
        __syncthreads();
        const int u = (int)*shu;
        if (u >= ATT_NU) break;
        int type, b, h, qt; bool samp;
        if (u < 384) { type = u >> 7; const int v = u & 127; b = v >> 6; h = (v >> 4) & 3; qt = v & 15; samp = true; }
        else { const int w = u - 384; type = w >> 8; const int v = w & 255; b = v >> 3; h = (v >> 1) & 3; qt = v & 1; samp = false; }
        AttnSrc S;
        S.samp = samp; S.q0 = qt * 128; S.rope = B.rope; S.Y = B.YCAT;
        S.krbase = samp ? NPR + b * 2560 : b * 256; S.rowbase = samp ? NPR + b * 2048 : b * 256;
        S.window = false; S.sink = false; S.m0 = -1e30f;
        if (!samp) { S.lo = 0; S.hi = 2; S.nctx = 0; }
        else { S.lo = 0; S.hi = 16; S.nctx = 4; }
        if (type == 0) {
            S.Qraw = B.MQKV + h * 96; S.Qrot = S.Qraw; S.qpitch = 1024; S.K0 = B.MQKV + 384 + h * 128; S.k0pitch = 1024; S.K1 = B.KPE; S.V = B.MQKV + 384 + h * 128 + 64; S.vpitch = 1024; S.outcol = 256 + h * 64;
            attn_unit<96>(S, lds, tid, lane, wave);
        } else {
            if (type == 1) { S.Qraw = B.Qc_raw + h * 64; S.Qrot = B.Qc_rot + h * 64; S.K0 = B.Kc + (h >> 1) * 64; S.V = B.Vc + (h >> 1) * 64; S.outcol = 512 + h * 64; }
            else { S.Qraw = B.Qd_raw + h * 64; S.Qrot = B.Qd_rot + h * 64; S.K0 = B.Kd + (h >> 1) * 64; S.V = B.Vd + (h >> 1) * 64; S.outcol = 768 + h * 64;
                   S.sink = true; S.m0 = B.sink[h] * LOG2E;
                   if (samp) { S.window = true; const int lo = S.q0 / 128 - 1; S.lo = lo < 0 ? 0 : lo; const int hi = S.q0 / 128 + 2; S.hi = hi > 16 ? 16 : hi; } }
            S.qpitch = 256; S.k0pitch = 128; S.K1 = nullptr; S.vpitch = 128;
            attn_unit<64>(S, lds, tid, lane, wave);
        }
    }
}

__device__ __forceinline__ void load8(const bf16* p, float (&o)[8]) { const u32x4 u = *(const u32x4*)p; o[0] = bflo(u.x); o[1] = bfhi(u.x); o[2] = bflo(u.y); o[3] = bfhi(u.y); o[4] = bflo(u.z); o[5] = bfhi(u.z); o[6] = bflo(u.w); o[7] = bfhi(u.w); }
__device__ __forceinline__ void convgate_phase(const bf16* U, const float* cf, bf16* ACT, int gt, int NGT) {
    constexpr int NCH = DFF / 8, RG = 8;
    for (int it = gt; it < (NTOK / RG) * NCH; it += NGT) {
        const int rg = it / NCH, cc = it % NCH, r0 = rg * RG, col = cc * 8;
        const bool samp = r0 >= NPR; const int t0 = samp ? ((r0 - NPR) & 2047) : (r0 & 255), T = samp ? 2048 : 256;
        const bf16* up = U + (size_t)r0 * DUP + col;
        u32x4 ra[RG + 2], rb[RG + 2];
        const u32x4 z4 = (u32x4){0u, 0u, 0u, 0u};
        ra[0] = z4; rb[0] = z4; ra[RG + 1] = z4; rb[RG + 1] = z4;
        if (t0 > 0) { ra[0] = *(const u32x4*)(up - DUP); rb[0] = *(const u32x4*)(up - DUP + DFF); }
#pragma unroll
        for (int i = 0; i < RG; ++i) { ra[i + 1] = *(const u32x4*)(up + (size_t)i * DUP); rb[i + 1] = *(const u32x4*)(up + (size_t)i * DUP + DFF); }
        if (t0 + RG < T) { ra[RG + 1] = *(const u32x4*)(up + (size_t)RG * DUP); rb[RG + 1] = *(const u32x4*)(up + (size_t)RG * DUP + DFF); }
        float wa[3][8], wb[3][8];
#pragma unroll
        for (int k = 0; k < 3; ++k) { const f32x4 a0 = *(const f32x4*)(cf + k * DUP + col), a1 = *(const f32x4*)(cf + k * DUP + col + 4), b0 = *(const f32x4*)(cf + k * DUP + DFF + col), b1 = *(const f32x4*)(cf + k * DUP + DFF + col + 4);
#pragma unroll
            for (int e = 0; e < 4; ++e) { wa[k][e] = a0[e]; wa[k][4 + e] = a1[e]; wb[k][e] = b0[e]; wb[k][4 + e] = b1[e]; } }
#pragma unroll
        for (int i = 0; i < RG; ++i) {
            float r[8];
#pragma unroll
            for (int h = 0; h < 4; ++h) {
                const unsigned pa = ra[i][h], ca = ra[i + 1][h], na = ra[i + 2][h], pb = rb[i][h], cb = rb[i + 1][h], nb = rb[i + 2][h];
                const float xa0 = wa[0][2 * h] * bflo(pa) + wa[1][2 * h] * bflo(ca) + wa[2][2 * h] * bflo(na), xb0 = wb[0][2 * h] * bflo(pb) + wb[1][2 * h] * bflo(cb) + wb[2][2 * h] * bflo(nb);
                const float xa1 = wa[0][2 * h + 1] * bfhi(pa) + wa[1][2 * h + 1] * bfhi(ca) + wa[2][2 * h + 1] * bfhi(na), xb1 = wb[0][2 * h + 1] * bfhi(pb) + wb[1][2 * h + 1] * bfhi(cb) + wb[2][2 * h + 1] * bfhi(nb);
                r[2 * h] = xa0 * __builtin_amdgcn_rcpf(1.f + __builtin_amdgcn_exp2f(-xa0 * LOG2E)) * xb0;
                r[2 * h + 1] = xa1 * __builtin_amdgcn_rcpf(1.f + __builtin_amdgcn_exp2f(-xa1 * LOG2E)) * xb1;
            }
            u32x4 w; w.x = pk2(r[0], r[1]); w.y = pk2(r[2], r[3]); w.z = pk2(r[4], r[5]); w.w = pk2(r[6], r[7]);
            *(u32x4*)(ACT + (size_t)(r0 + i) * DFF + col) = w;
        }
    }
}

#define XB_TMO      128
#define XB_XCNT(j)  (256  + 64 * (j))
#define XB_XSUB(j)  (1280 + 64 * (j))
#define XB_XGEN(j)  (2304 + 64 * (j))
#define XB_TOP      3328
#define XB_TOPGEN   3392
#define XCD_BAR_WORDS 3456
#define XB_SPIN_CAP (1u << 20)
__device__ __forceinline__ unsigned xb_ld(unsigned* p)              { return __hip_atomic_load(p, __ATOMIC_RELAXED, __HIP_MEMORY_SCOPE_AGENT); }
__device__ __forceinline__ unsigned xb_add(unsigned* p, unsigned v) { return __hip_atomic_fetch_add(p, v, __ATOMIC_RELAXED, __HIP_MEMORY_SCOPE_AGENT); }
__device__ __forceinline__ unsigned xb_xcc_id() { return (unsigned)__builtin_amdgcn_s_getreg((3 << 11) | 20) & 0xFu; }
#define XB_SPIN(cond, bar) do { unsigned _sp = 0; while (cond) { __builtin_amdgcn_s_sleep(1); \
    if ((++_sp & 255u) == 0u) { if (xb_ld(&(bar)[XB_TMO])) break; if (_sp > XB_SPIN_CAP) { atomicAdd(&(bar)[XB_TMO], 1u); break; } } } } while (0)
struct XcdBarrier { unsigned* bar; unsigned x; volatile LAS unsigned* st; };
__device__ __forceinline__ void xcd_barrier_complete(unsigned* bar, unsigned x, unsigned& nloc, unsigned& nx) {
    const unsigned G = gridDim.x * gridDim.y * gridDim.z;
    unsigned sum, cnt, mine, sp = 0u;
    for (;;) {
        sum = 0u; cnt = 0u; mine = 0u;
#pragma unroll
        for (unsigned j = 0; j < 16; ++j) { const unsigned c = xb_ld(&bar[XB_XCNT(j)]); sum += c; cnt += (c > 0u) ? 1u : 0u; mine = (j == x) ? c : mine; }
        if (sum == G) break;
        __builtin_amdgcn_s_sleep(1);
        if ((++sp & 255u) == 0u) { if (xb_ld(&bar[XB_TMO])) break; if (sp > XB_SPIN_CAP) { atomicAdd(&bar[XB_TMO], 1u); break; } }
    }
    nloc = mine > 0u ? mine : 1u; nx = cnt > 0u ? cnt : 1u;
}
__device__ __forceinline__ void xcd_barrier(const XcdBarrier& b, const int tid_) {
    asm volatile("s_waitcnt vmcnt(0)" ::: "memory");
    __syncthreads();
    if (tid_ == 0) {
        unsigned* bar = b.bar;
        __builtin_amdgcn_s_waitcnt(0);
        unsigned nloc = b.st[0], nx = b.st[1];
        if (nloc == 0u) { xcd_barrier_complete(bar, b.x, nloc, nx); b.st[0] = nloc; b.st[1] = nx; }
        const unsigned old = xb_add(&bar[XB_XSUB(b.x)], 1u);
        const unsigned gen = old / nloc;
        if (old + 1u == (gen + 1u) * nloc) {
            __builtin_amdgcn_fence(__ATOMIC_RELEASE, "agent");
            asm volatile("s_waitcnt vmcnt(0)" ::: "memory");
            const unsigned og = xb_add(&bar[XB_TOP], 1u);
            const unsigned tg = og / nx;
            if (og + 1u == (tg + 1u) * nx) xb_add(&bar[XB_TOPGEN], 1u);
            else XB_SPIN(xb_ld(&bar[XB_TOPGEN]) == tg, bar);
            __builtin_amdgcn_fence(__ATOMIC_ACQUIRE, "agent");
            xb_add(&bar[XB_XGEN(b.x)], 1u);
            asm volatile("s_waitcnt vmcnt(0)" ::: "memory");
        } else {
            XB_SPIN(xb_ld(&bar[XB_XGEN(b.x)]) == gen, bar);
            __builtin_amdgcn_fence(__ATOMIC_ACQUIRE, "agent");
            asm volatile("s_waitcnt vmcnt(0)" ::: "memory");
        }
    }
    __syncthreads();
}

__device__ __forceinline__ int lane_id_volatile() { int l; asm volatile("v_mbcnt_lo_u32_b32 %0, -1, 0\n\tv_mbcnt_hi_u32_b32 %0, -1, %0" : "=v"(l)); return l; }

#ifndef PH
#define PH 0xFFFF
#endif
#define ON(k) ((PH >> (k)) & 1)
#ifndef REP
#define REP 0
#endif
#define NREP(k) (1 + ((REP >> (k)) & 1))
__global__ void __launch_bounds__(NT, 2) mega_fwd(Args a_unused) {
    extern __shared__ __attribute__((aligned(16))) unsigned char lds[];
    cg::grid_group grid = cg::this_grid();
    const int G = gridDim.x, bid = blockIdx.x;
    const int wave_s = __builtin_amdgcn_readfirstlane(threadIdx.x >> 6);
    PG8_LAS unsigned char* ring = (PG8_LAS unsigned char*)lds;
#define PHASE_BEGIN int tid = wave_s * 64 + lane_id_volatile(); asm volatile("" : "+v"(tid)); const CAS Args* ap_ = (const CAS Args*)__builtin_amdgcn_kernarg_segment_ptr(); asm volatile("" : "+s"(ap_)); const CAS Args& a = *ap_; unsigned char* ws = a.ws; float* out = a.out; \
    const int lane = tid & 63, wave = __builtin_amdgcn_readfirstlane(tid >> 6); const int gw = bid * NW + wave, NGW = G * NW, gt = bid * NT + tid, NGT = G * NT; \
    (void)lane; (void)wave; (void)gw; (void)NGW; (void)gt; (void)NGT; (void)out; \
    const float* mod = (const float*)(ws + WS_MOD); const float* rope = (const float*)(ws + WS_ROPE); (void)mod; (void)rope; \
    bf16* XN = (bf16*)(ws + WS_XN); bf16* PROJ = (bf16*)(ws + WS_PROJ); bf16* A2 = (bf16*)(ws + WS_A2); bf16* MQKV = (bf16*)(ws + WS_MQKV); \
    bf16* KPE = (bf16*)(ws + WS_KPE); bf16* YCAT = (bf16*)(ws + WS_YCAT); bf16* ACT = (bf16*)(ws + WS_ACT); bf16* U = (bf16*)(ws + WS_U); \
    bf16* Qc_rot = (bf16*)(ws + WS_QC); bf16* Qc_raw = (bf16*)(ws + WS_QC + QSZ); bf16* Kc = (bf16*)(ws + WS_QC + 2 * QSZ); bf16* Vc = (bf16*)(ws + WS_QC + 2 * QSZ + KSZ); \
    bf16* Qd_rot = (bf16*)(ws + WS_QC + 2 * QSZ + 2 * KSZ); bf16* Qd_raw = Qd_rot + (size_t)NKR * 256; bf16* Kd = Qd_raw + (size_t)NKR * 256; bf16* Vd = Kd + (size_t)NKR * 128; \
    (void)XN; (void)PROJ; (void)A2; (void)MQKV; (void)KPE; (void)YCAT; (void)ACT; (void)U; (void)Qc_rot; (void)Qc_raw; (void)Kc; (void)Vc; (void)Qd_rot; (void)Qd_raw; (void)Kd; (void)Vd;
#define GSYNC() do { const CAS Args* bp_ = (const CAS Args*)__builtin_amdgcn_kernarg_segment_ptr(); asm volatile("" : "+s"(bp_)); XcdBarrier xb_; xb_.bar = (unsigned*)(bp_->ws + WS_BAR); xb_.x = xb_xcc_id(); \
    xb_.st = (volatile LAS unsigned*)((LAS unsigned char*)lds + LDS_CTL + 32); xcd_barrier(xb_, wave_s * 64 + lane_id_volatile()); } while (0)
#define LAYER_VALS const float* modl = mod + (size_t)l * 3 * 6144; unsigned char* wl = ws + WS_W + l * W_LSTRIDE; (void)modl; (void)wl; \
    const float* x0 = l == 0 ? a.in[0] : nullptr; const float* x1 = l == 0 ? a.in[1] : nullptr; (void)x0; (void)x1; bf16* XRES = (bf16*)(ws + WS_XRES); (void)XRES;

    if (threadIdx.x < 16) ((volatile LAS unsigned*)((LAS unsigned char*)lds + LDS_CTL))[threadIdx.x] = 0u;
    __syncthreads();
    { PHASE_BEGIN if (tid == 0) (void)xb_add((unsigned*)(ws + WS_BAR) + XB_XCNT(xb_xcc_id()), 1u);
      if (ws == nullptr) grid.sync(); }
    for (int rep = 0; rep < NREP(0); ++rep) {
    if (ON(0)) { PHASE_BEGIN phase0(a, (LAS unsigned char*)lds, tid, lane, wave); }
    GSYNC(); }

    if (ON(1)) { PHASE_BEGIN
        if (G > 124) {
            if (bid < 62) bias_phase(a, ws, (LAS unsigned char*)lds, tid, lane, wave);
            else prep_phase(a.in[0], a.in[1], a.in[12], mod, 1024, XN, (float*)(ws + WS_SS1), lane, (bid - 62) * NW + wave, (G - 62) * NW);
        } else { bias_phase(a, ws, (LAS unsigned char*)lds, tid, lane, wave);
            prep_phase(a.in[0], a.in[1], a.in[12], mod, 1024, XN, (float*)(ws + WS_SS1), lane, gw, NGW); } }
    GSYNC();
#pragma unroll
    for (int l = 0; l < 2; ++l) {
        for (int rep = 0; rep < NREP(2); ++rep) {
        if (ON(2)) { PHASE_BEGIN LAYER_VALS pg8::Gemm g{XN, (const bf16*)(wl + W_IN), NTOK, INP, DM, 0, 0}; pg8::StaticOrder S; S.init(NTOK, INP, G, bid);
          pg8::EpiBf16RS E{PROJ, INP, (const float*)(ws + WS_SS1), (const float*)(ws + WS_BIAS) + (size_t)l * 3 * NBIAS, NBIAS};
          pg8::gemm_phase<pg8::EpiBf16RS, pg8::StaticOrder, true, true>(ring, g, S, E, tid); }
        GSYNC(); }
        for (int rep = 0; rep < NREP(3); ++rep) {
        if (ON(3)) { PHASE_BEGIN P3Ptrs P; P.PROJ = PROJ; P.A2 = A2; P.KPE = KPE; P.YCAT = YCAT; P.Qc_rot = Qc_rot; P.Qc_raw = Qc_raw; P.Kc = Kc; P.Vc = Vc; P.Qd_rot = Qd_rot; P.Qd_raw = Qd_raw; P.Kd = Kd; P.Vd = Vd;
          P.conv_a = a.in[14]; P.gq_mla = a.in[15]; P.gkv_mla = a.in[17]; P.gq = a.in[19]; P.gk = a.in[20]; P.rope = rope;
          P.c_ckv = a.in[2]; P.c_kpe = a.in[3]; P.c_gk = a.in[4]; P.c_gv = a.in[5]; P.c_sk = a.in[6]; P.c_sv = a.in[7];
          P.o_ckv = out + 12582912; P.o_kpe = out + 14680064; P.o_gk = out + 15204352; P.o_gv = out + 17301504; P.o_sk = out + 19398656; P.o_sv = out + 21495808; P.l = l;
          p3_phase(P, lane, gw, NGW); }
        GSYNC(); }
        for (int rep = 0; rep < NREP(4); ++rep) {
        if (ON(4)) { PHASE_BEGIN LAYER_VALS pg8::Gemm g{A2, (const bf16*)(wl + W_B2), NKR, 1024, 384, 0, 0}; pg8::StaticOrder S; S.init(NKR, 1024, G, bid); pg8::EpiBf16 E{MQKV, 1024};
          pg8::gemm_phase<pg8::EpiBf16, pg8::StaticOrder, true, true>(ring, g, S, E, tid); }
        GSYNC(); }
        for (int rep = 0; rep < NREP(5); ++rep) {
        if (ON(5)) { PHASE_BEGIN AttnBufs B; B.MQKV = MQKV; B.KPE = KPE; B.Qc_rot = Qc_rot; B.Qc_raw = Qc_raw; B.Kc = Kc; B.Vc = Vc; B.Qd_rot = Qd_rot; B.Qd_raw = Qd_raw; B.Kd = Kd; B.Vd = Vd; B.YCAT = YCAT;
          B.sink = a.in[21] + l * 4; B.rope = rope; B.ctr = (unsigned*)(ws + WS_CTL) + 64 * l + 128 * rep;
          attn_phase(B, (LAS unsigned char*)lds, tid, lane, wave); }
        GSYNC(); }
        if (ON(6)) { PHASE_BEGIN LAYER_VALS pg8::Gemm g{YCAT, (const bf16*)(wl + W_OUT), NTOK, DM, DM, 0, 0}; pg8::StaticOrder S; S.init(NTOK, DM, G, bid);
          pg8::EpiResid E{x0, x1, XRES, modl + 2048, XN, (float*)(ws + WS_SS2), a.in[23] + l * DM, modl + 4096};
          pg8::gemm_phase<pg8::EpiResid, pg8::StaticOrder, true, true>(ring, g, S, E, tid);
          if (l == 0) { const int wk = G > 192 ? bid - 192 : bid, nwk = G > 192 ? G - 192 : G;
            if (wk >= 0) wconv(a, ws, 0, 4 | 8, wk * NW + wave, nwk * NW, (LAS float*)((LAS unsigned char*)lds + wave * 16640), lane); } }
        GSYNC();
        for (int rep = 0; rep < NREP(8); ++rep) {
        if (ON(8)) { PHASE_BEGIN LAYER_VALS pg8::Gemm g{XN, (const bf16*)(wl + W_UP), NTOK, DUP, DM, (size_t)128 * DM * 2, (size_t)DFF * DM * 2}; pg8::StaticOrder S; S.init(NTOK, DUP, G, bid);
          pg8::EpiUpGate E{ACT, (const float*)(ws + WS_SS2), (const float*)(ws + WS_BIAS) + (size_t)l * 3 * NBIAS + 2304, NBIAS, a.in[25] + (size_t)l * 3 * DUP, (float*)(ws + WS_HALO), ring + 131072};
          pg8::gemm_phase<pg8::EpiUpGate, pg8::StaticOrder, true, true>(ring, g, S, E, tid); }
        GSYNC(); }
        if (ON(10)) { PHASE_BEGIN LAYER_VALS pg8::Gemm g{ACT, (const bf16*)(wl + W_DOWN), NTOK, DM, DFF, 0, 0}; pg8::StaticOrder S; S.init(NTOK, DM, G, bid);
          {
            const float* cwl = a.in[25] + (size_t)l * 3 * DUP; const float* HALO = (const float*)(ws + WS_HALO); pg8::Unit hu;
            for (int ui = 0; S.next(ui, hu); ++ui) { if (hu.pm < 32) continue; const int k = hu.pm - 32, pos = k & 7;
                for (int idx = tid; idx < 2 * DFF; idx += NT) { const int which = idx >= DFF ? 1 : 0, j = idx - which * DFF;
                    if (which == 0 ? pos == 0 : pos == 7) continue;
                    const float* Pp = HALO + (size_t)(k * 4 + (which ? 3 : 1)) * DUP; const float* Ep = HALO + (size_t)((which ? k + 1 : k - 1) * 4 + (which ? 0 : 2)) * DUP; const float* wp = cwl + (which ? 2 : 0) * DUP;
                    const float ca = Pp[j] + wp[j] * Ep[j], cb = Pp[DFF + j] + wp[DFF + j] * Ep[DFF + j];
                    const float r = ca * __builtin_amdgcn_rcpf(1.f + __builtin_amdgcn_exp2f(-ca * LOG2E)) * cb;
                    ACT[(size_t)(hu.pm * 256 + (which ? 255 : 0)) * DFF + j] = (bf16)(pk2(r, r) & 0xffffu); } }
            asm volatile("s_waitcnt vmcnt(0)" ::: "memory"); __builtin_amdgcn_fence(__ATOMIC_RELEASE, "agent"); __builtin_amdgcn_fence(__ATOMIC_ACQUIRE, "agent"); __syncthreads(); }
          if (l == 1 && G >= 192) {
            pg8::EpiResidFinal E{XRES, out, modl + 5120, (float*)(ws + WS_SS1), a.in[27], (unsigned*)(ws + WS_CTL) + 2048};
            pg8::gemm_phase<pg8::EpiResidFinal, pg8::StaticOrder, true, true>(ring, g, S, E, tid);
          } else {
          pg8::EpiResid E{nullptr, nullptr, XRES, modl + 5120, l == 0 ? XN : nullptr, (float*)(ws + WS_SS1), a.in[12] + DM, mod + (size_t)3 * 6144 + 1024};
          pg8::gemm_phase<pg8::EpiResid, pg8::StaticOrder, true, true>(ring, g, S, E, tid); }
          if (l == 0) { const int wk = G > 192 ? bid - 192 : bid, nwk = G > 192 ? G - 192 : G;
            if (wk >= 0) wconv(a, ws, 1, 63, wk * NW + wave, nwk * NW, (LAS float*)((LAS unsigned char*)lds + wave * 16640), lane); } }
        if (!(l == 1 && G >= 192)) GSYNC();
    }
#ifdef XSYNC
    for (int i = 0; i < XSYNC; ++i) GSYNC();
#endif
    if (G < 192) { PHASE_BEGIN
    const bf16* XRES = (const bf16*)(ws + WS_XRES);
    for (int row = gw; row < NTOK; row += NGW) {
        float* xr = out + (size_t)row * DM;
        f32x4 v[4]; float ss = 0.f;
#pragma unroll
        for (int j = 0; j < 4; ++j) { v[j] = ld4bf(XRES + (size_t)row * DM + 4 * (lane + 64 * j)); ss += dot4(v[j]); }
        const float rs = rsqrtf(wave_sum(ss, lane) * (1.f / DM) + EPS);
#pragma unroll
        for (int j = 0; j < 4; ++j) { const int col = 4 * (lane + 64 * j); *(f32x4*)(xr + col) = v[j] * rs * *(const f32x4*)(a.in[27] + col); }
    } }
}

extern "C" void kernel_launch(void* const* d_in, const int* in_sizes, int n_in, void* d_out, int out_size, void* d_ws, size_t ws_size, hipStream_t stream) {
    static int grid = 0;
    if (grid == 0) {
        if (n_in != 28 || ws_size < WS_END) { fprintf(stderr, "kernel_launch: unexpected n_in %d / ws %zu\n", n_in, ws_size); grid = -1; return; }
        int dev = 0, cus = 0, per_cu = 0;
        hipGetDevice(&dev); hipDeviceGetAttribute(&cus, hipDeviceAttributeMultiprocessorCount, dev);
        hipFuncSetAttribute((const void*)mega_fwd, hipFuncAttributeMaxDynamicSharedMemorySize, LDS_BYTES);
        hipOccupancyMaxActiveBlocksPerMultiprocessor(&per_cu, (const void*)mega_fwd, NT, LDS_BYTES);
        if (per_cu < 1) per_cu = 1;
        grid = cus * per_cu;
        (void)hipGetLastError();
    }
    if (grid < 0) return;
    if (hipMemsetAsync((char*)d_ws + WS_BAR, 0, XCD_BAR_WORDS * 4, stream) != hipSuccess) { fprintf(stderr, "kernel_launch: memset of the barrier words failed\n"); return; }
    Args a{};
    for (int i = 0; i < 28; ++i) a.in[i] = (const float*)d_in[i];
    a.out = (float*)d_out; a.ws = (unsigned char*)d_ws;
    void* args[] = {&a};
    hipError_t e = hipLaunchCooperativeKernel((const void*)mega_fwd, dim3(grid), dim3(NT), args, LDS_BYTES, stream);
    if (e != hipSuccess) fprintf(stderr, "cooperative launch failed: %s (grid %d)\n", hipGetErrorString(e), grid);
}
```

```cpp
#include <hip/hip_runtime.h>
#include <hip/hip_cooperative_groups.h>
#include <cstdio>
#include <cstdint>
namespace cg = cooperative_groups;

namespace pg8 {
#define PG8_LAS __attribute__((address_space(3)))
typedef unsigned short bf16_t;
typedef short bf16x8 __attribute__((ext_vector_type(8)));
typedef float f32x4 __attribute__((ext_vector_type(4)));
typedef unsigned u32x4 __attribute__((ext_vector_type(4)));
constexpr int BM = 256, BK = 64, HALF = 128, HTB = HALF * BK * 2, STAGE_BYTES = 8 * HTB, NXCD = 8, WGM = 8;

__host__ __device__ __forceinline__ int lds_byte(int r, int c) { const int st = (r >> 4) * 2 + (c >> 5), rr = r & 15, cc = c & 31, ob = rr * 64 + cc * 2; return st * 1024 + (ob ^ (((ob >> 9) & 1) << 5)); }
__host__ __device__ __forceinline__ void stage_rc(int b, int& R, int& C) { const int st = b / 1024, sb = b % 1024, swz = sb ^ (((sb >> 9) & 1) << 5); R = (st >> 1) * 16 + swz / 64; C = (st & 1) * 32 + (swz % 64) / 2; }
__host__ __device__ __forceinline__ int perm32(int rho) { const int n = rho >> 4, i = rho & 15; return 8 * (i >> 2) + 4 * n + (i & 3); }

struct Unit { int pm, pn; };
struct Gemm { const bf16_t* A; const bf16_t* Bt; int M, N, K; size_t bstep, bhalf; };

struct StaticOrder {
    int nM, nN, nwg, G, c;
    __host__ __device__ __forceinline__ void init(int M, int N, int G_, int c_) { nM = M / BM; nN = N / BM; nwg = nM * nN; G = G_; c = c_; }
    __host__ __device__ __forceinline__ bool next(int i, Unit& u) const {
        const long L = (long)i * G + c; if (L >= nwg) return false;
        int wgid = (int)L; { const int q = nwg / NXCD, r = nwg % NXCD, xcd = wgid % NXCD, off = wgid / NXCD; wgid = (xcd < r ? xcd * (q + 1) : r * (q + 1) + (xcd - r) * q) + off; }
        const int nig = WGM * nN, gid = wgid / nig, fm = gid * WGM, gsz = (nM - fm) < WGM ? (nM - fm) : WGM;
        u.pm = fm + ((wgid % nig) % gsz); u.pn = (wgid % nig) / gsz; return true;
    }
    __device__ __forceinline__ void a_ready(const Unit&) const {}
    __device__ __forceinline__ void done(const Unit&) const {}
};

__device__ __forceinline__ unsigned cvt_pk_bf16(float lo, float hi) { unsigned r; asm volatile("v_cvt_pk_bf16_f32 %0, %1, %2" : "=v"(r) : "v"(lo), "v"(hi)); return r; }

struct EpiBf16 {
    static constexpr bool PERM = true, AFTER_DRAIN = false;
    bf16_t* O; int ldc;
    __device__ __forceinline__ void operator()(const f32x4 (&acc)[2][2][4][2], const Unit& u, int wr, int wc, int fr, int fq) const {
        asm volatile("" : "+v"(fr), "+v"(fq));
        const int row0 = u.pm * BM + wr * 64 + fr; const int col0 = u.pn * BM + wc * 32 + 8 * fq;
#pragma unroll
        for (int ai = 0; ai < 2; ++ai)
#pragma unroll
            for (int m = 0; m < 4; ++m) { bf16_t* rowp = O + (size_t)(row0 + ai * HALF + m * 16) * ldc + col0;
#pragma unroll
                for (int bj = 0; bj < 2; ++bj) { const f32x4 v0 = acc[ai][bj][m][0], v1 = acc[ai][bj][m][1];
                    u32x4 w; w.x = cvt_pk_bf16(v0[0], v0[1]); w.y = cvt_pk_bf16(v0[2], v0[3]); w.z = cvt_pk_bf16(v1[0], v1[1]); w.w = cvt_pk_bf16(v1[2], v1[3]);
                    *(u32x4*)(rowp + bj * HALF) = w; } }
    }
};
__device__ __forceinline__ float shx_(float v, int m, int lane) { return __builtin_bit_cast(float, __builtin_amdgcn_ds_bpermute((lane ^ m) << 2, __builtin_bit_cast(int, v))); }
__device__ __forceinline__ void row_scales(const float* SS, int row0, int fr, int fq, float (&rs)[8]) {
    f32x4 t[8];
#pragma unroll
    for (int q = 0; q < 8; ++q) t[q] = *(const f32x4*)(SS + (size_t)(row0 + (q >> 2) * HALF + (q & 3) * 16) * 16 + 4 * fq);
    const int lane = fq * 16 + fr;
#pragma unroll
    for (int q = 0; q < 8; ++q) { float v = (t[q][0] + t[q][1]) + (t[q][2] + t[q][3]); v += shx_(v, 16, lane); v += shx_(v, 32, lane); rs[q] = __builtin_amdgcn_rsqf(v * (1.f / 1024.f) + 1e-6f); }
}
struct EpiBf16RS {
    static constexpr bool PERM = true, AFTER_DRAIN = false;
    bf16_t* O; int ldc; const float* SS; const float* bias; int ldb;
    __device__ __forceinline__ void operator()(const f32x4 (&acc)[2][2][4][2], const Unit& u, int wr, int wc, int fr, int fq) const {
        asm volatile("" : "+v"(fr), "+v"(fq));
        const int cnd = u.pm < 32 ? 0 : 1 + ((u.pm - 32) >> 3);
        const int row0 = u.pm * BM + wr * 64 + fr; const int col0 = u.pn * BM + wc * 32 + 8 * fq;
        const float* bp = bias + (size_t)cnd * ldb + col0;
        f32x4 bv[2][2];
#pragma unroll
        for (int bj = 0; bj < 2; ++bj)
#pragma unroll
            for (int n = 0; n < 2; ++n) bv[bj][n] = *(const f32x4*)(bp + bj * HALF + 4 * n);
        float rsv[8]; row_scales(SS, row0, fr, fq, rsv);
#pragma unroll
        for (int ai = 0; ai < 2; ++ai)
#pragma unroll
            for (int m = 0; m < 4; ++m) { const int row = row0 + ai * HALF + m * 16; const float rs = rsv[ai * 4 + m];
                bf16_t* rowp = O + (size_t)row * ldc + col0;
#pragma unroll
                for (int bj = 0; bj < 2; ++bj) { const f32x4 v0 = acc[ai][bj][m][0] * rs + bv[bj][0], v1 = acc[ai][bj][m][1] * rs + bv[bj][1];
                    u32x4 w; w.x = cvt_pk_bf16(v0[0], v0[1]); w.y = cvt_pk_bf16(v0[2], v0[3]); w.z = cvt_pk_bf16(v1[0], v1[1]); w.w = cvt_pk_bf16(v1[2], v1[3]);
                    *(u32x4*)(rowp + bj * HALF) = w; } }
    }
};
struct EpiResid {
    static constexpr bool PERM = false, AFTER_DRAIN = false;
    const float* r0; const float* r1; bf16_t* XR; const float* gate;
    bf16_t* XN; float* SS; const float* nrm; const float* sc;
    __device__ __forceinline__ void operator()(const f32x4 (&acc)[2][2][4][2], const Unit& u, int wr, int wc, int fr, int fq) const {
        asm volatile("" : "+v"(fr), "+v"(fq));
        typedef unsigned u32x2_ __attribute__((ext_vector_type(2)));
        const int cnd = u.pm < 32 ? 0 : 1 + ((u.pm - 32) >> 3);
        const float* gp = gate + cnd * 6144;
        const int col0 = u.pn * BM + wc * 32 + 4 * fq;
        const int rowb = u.pm * BM + wr * 64 + fr;
        const bool inf = r0 != nullptr;
        const float* rs = (u.pm < 32 ? r0 + (size_t)rowb * 1024 : r1 + (size_t)(rowb - 8192) * 1024) + col0;
        bf16_t* op = XR + (size_t)rowb * 1024 + col0;
#define LDX(off) (inf ? *(const f32x4*)(rs + (off)) : ({ const u32x2_ t_ = *(const u32x2_*)(op + (off)); (f32x4){__builtin_bit_cast(float, t_.x << 16), __builtin_bit_cast(float, t_.x & 0xffff0000u), __builtin_bit_cast(float, t_.y << 16), __builtin_bit_cast(float, t_.y & 0xffff0000u)}; }))
        const bool prep = XN != nullptr;
        f32x4 gv[2][2], hv[2][2];
#pragma unroll
        for (int bj = 0; bj < 2; ++bj)
#pragma unroll
            for (int n = 0; n < 2; ++n) { gv[bj][n] = *(const f32x4*)(gp + col0 + bj * HALF + n * 16);
                hv[bj][n] = (f32x4){0.f, 0.f, 0.f, 0.f};
                if (prep) hv[bj][n] = *(const f32x4*)(nrm + col0 + bj * HALF + n * 16) * (1.f + *(const f32x4*)(sc + cnd * 6144 + col0 + bj * HALF + n * 16)); }
        f32x4 xc[2][2], xn[2][2];
#pragma unroll
        for (int bj = 0; bj < 2; ++bj)
#pragma unroll
            for (int n = 0; n < 2; ++n) xc[bj][n] = LDX(bj * HALF + n * 16);
#pragma unroll
        for (int it = 0; it < 8; ++it) { const int ai = it >> 2, m = it & 3; const size_t ro = (size_t)(ai * HALF + m * 16) * 1024;
            if (it < 7) { const int ai2 = (it + 1) >> 2, m2 = (it + 1) & 3; const size_t ro2 = (size_t)(ai2 * HALF + m2 * 16) * 1024;
#pragma unroll
                for (int bj = 0; bj < 2; ++bj)
#pragma unroll
                    for (int n = 0; n < 2; ++n) xn[bj][n] = LDX(ro2 + bj * HALF + n * 16); }
            float ssq = 0.f;
#pragma unroll
            for (int bj = 0; bj < 2; ++bj)
#pragma unroll
                for (int n = 0; n < 2; ++n) { const f32x4 v = xc[bj][n] + gv[bj][n] * acc[ai][bj][m][n];
                    *(u32x2_*)(op + ro + bj * HALF + n * 16) = (u32x2_){cvt_pk_bf16(v[0], v[1]), cvt_pk_bf16(v[2], v[3])};
                    if (prep) { ssq += (v[0] * v[0] + v[1] * v[1]) + (v[2] * v[2] + v[3] * v[3]); const f32x4 h = v * hv[bj][n];
                        unsigned w0 = cvt_pk_bf16(h[0], h[1]), w1 = cvt_pk_bf16(h[2], h[3]);
                        *(u32x2_*)(XN + (size_t)(rowb + ai * HALF + m * 16) * 1024 + col0 + bj * HALF + n * 16) = (u32x2_){w0, w1}; } }
            if (prep) { const int lane = fq * 16 + fr; ssq += shx_(ssq, 16, lane); ssq += shx_(ssq, 32, lane);
                if (fq == 0) SS[(size_t)(rowb + ai * HALF + m * 16) * 16 + u.pn * 4 + wc] = ssq; }
#pragma unroll
            for (int bj = 0; bj < 2; ++bj)
#pragma unroll
                for (int n = 0; n < 2; ++n) xc[bj][n] = xn[bj][n];
        }
    }
#undef LDX
};

struct EpiResidFinal {
    static constexpr bool PERM = false, AFTER_DRAIN = false;
    const bf16_t* res; float* out; const float* gate; float* SS; const float* fw; unsigned* cnt;
    __device__ __forceinline__ void operator()(f32x4 (&acc)[2][2][4][2], const Unit& u, int wr, int wc, int fr, int fq) const {
        asm volatile("" : "+v"(fr), "+v"(fq));
        const int cnd = u.pm < 32 ? 0 : 1 + ((u.pm - 32) >> 3);
        const float* gp = gate + cnd * 6144;
        const int col0 = u.pn * BM + wc * 32 + 4 * fq;
        const int rowb = u.pm * BM + wr * 64 + fr;
        typedef unsigned u32x2_ __attribute__((ext_vector_type(2)));
        const bf16_t* rs = res + (size_t)rowb * 1024 + col0;
#define LDXF(off) ({ const u32x2_ t_ = *(const u32x2_*)(rs + (off)); (f32x4){__builtin_bit_cast(float, t_.x << 16), __builtin_bit_cast(float, t_.x & 0xffff0000u), __builtin_bit_cast(float, t_.y << 16), __builtin_bit_cast(float, t_.y & 0xffff0000u)}; })
        f32x4 gv[2][2];
#pragma unroll
        for (int bj = 0; bj < 2; ++bj)
#pragma unroll
            for (int n = 0; n < 2; ++n) gv[bj][n] = *(const f32x4*)(gp + col0 + bj * HALF + n * 16);
        f32x4 xc[2][2], xn[2][2];
#pragma unroll
        for (int bj = 0; bj < 2; ++bj)
#pragma unroll
            for (int n = 0; n < 2; ++n) xc[bj][n] = LDXF(bj * HALF + n * 16);
#pragma unroll
        for (int it = 0; it < 8; ++it) { const int ai = it >> 2, m = it & 3;
            if (it < 7) { const int ai2 = (it + 1) >> 2, m2 = (it + 1) & 3; const size_t ro2 = (size_t)(ai2 * HALF + m2 * 16) * 1024;
#pragma unroll
                for (int bj = 0; bj < 2; ++bj)
#pragma unroll
                    for (int n = 0; n < 2; ++n) xn[bj][n] = LDXF(ro2 + bj * HALF + n * 16); }
            float ssq = 0.f;
#pragma unroll
            for (int bj = 0; bj < 2; ++bj)
#pragma unroll
                for (int n = 0; n < 2; ++n) { const f32x4 v = xc[bj][n] + gv[bj][n] * acc[ai][bj][m][n]; acc[ai][bj][m][n] = v;
                    ssq += (v[0] * v[0] + v[1] * v[1]) + (v[2] * v[2] + v[3] * v[3]); }
            { const int lane = fq * 16 + fr; ssq += shx_(ssq, 16, lane); ssq += shx_(ssq, 32, lane);
              if (fq == 0) __hip_atomic_store(SS + (size_t)(rowb + ai * HALF + m * 16) * 16 + u.pn * 4 + wc, ssq, __ATOMIC_RELAXED, __HIP_MEMORY_SCOPE_AGENT); }
#pragma unroll
            for (int bj = 0; bj < 2; ++bj)
#pragma unroll
                for (int n = 0; n < 2; ++n) xc[bj][n] = xn[bj][n];
        }
        asm volatile("s_waitcnt vmcnt(0)" ::: "memory"); __builtin_amdgcn_s_barrier(); asm volatile("" ::: "memory");
        if (wr == 0 && wc == 0 && fr == 0 && fq == 0) {
            __builtin_amdgcn_fence(__ATOMIC_RELEASE, "agent"); asm volatile("s_waitcnt vmcnt(0)" ::: "memory");
            __hip_atomic_fetch_add(cnt + u.pm, 1u, __ATOMIC_RELAXED, __HIP_MEMORY_SCOPE_AGENT);
            unsigned sp = 0;
            while (__hip_atomic_load(cnt + u.pm, __ATOMIC_RELAXED, __HIP_MEMORY_SCOPE_AGENT) < 4u) { __builtin_amdgcn_s_sleep(1); if (++sp > (1u << 22)) break; }
            __builtin_amdgcn_fence(__ATOMIC_ACQUIRE, "agent"); asm volatile("s_waitcnt vmcnt(0)" ::: "memory");
        }
        __builtin_amdgcn_s_barrier(); asm volatile("" ::: "memory");
        float rsv[8];
        { f32x4 t[8];
#pragma unroll
          for (int q = 0; q < 8; ++q) { const float* sp = SS + (size_t)(rowb + (q >> 2) * HALF + (q & 3) * 16) * 16 + 4 * fq;
              t[q] = (f32x4){__hip_atomic_load(sp, __ATOMIC_RELAXED, __HIP_MEMORY_SCOPE_AGENT), __hip_atomic_load(sp + 1, __ATOMIC_RELAXED, __HIP_MEMORY_SCOPE_AGENT),
                             __hip_atomic_load(sp + 2, __ATOMIC_RELAXED, __HIP_MEMORY_SCOPE_AGENT), __hip_atomic_load(sp + 3, __ATOMIC_RELAXED, __HIP_MEMORY_SCOPE_AGENT)}; }
          const int lane = fq * 16 + fr;
#pragma unroll
          for (int q = 0; q < 8; ++q) { float v = (t[q][0] + t[q][1]) + (t[q][2] + t[q][3]); v += shx_(v, 16, lane); v += shx_(v, 32, lane); rsv[q] = __builtin_amdgcn_rsqf(v * (1.f / 1024.f) + 1e-6f); } }
        f32x4 wv[2][2];
#pragma unroll
        for (int bj = 0; bj < 2; ++bj)
#pragma unroll
            for (int n = 0; n < 2; ++n) wv[bj][n] = *(const f32x4*)(fw + col0 + bj * HALF + n * 16);
        float* op = out + (size_t)rowb * 1024 + col0;
#pragma unroll
        for (int it = 0; it < 8; ++it) { const int ai = it >> 2, m = it & 3; const size_t ro = (size_t)(ai * HALF + m * 16) * 1024;
#pragma unroll
            for (int bj = 0; bj < 2; ++bj)
#pragma unroll
                for (int n = 0; n < 2; ++n) *(f32x4*)(op + ro + bj * HALF + n * 16) = acc[ai][bj][m][n] * rsv[it] * wv[bj][n]; }
    }
};

__device__ __forceinline__ float dpp_ror1(float v) { return __builtin_bit_cast(float, __builtin_amdgcn_mov_dpp(__builtin_bit_cast(int, v), 0x121, 0xf, 0xf, false)); }
__device__ __forceinline__ float dpp_ror15(float v) { return __builtin_bit_cast(float, __builtin_amdgcn_mov_dpp(__builtin_bit_cast(int, v), 0x12f, 0xf, 0xf, false)); }
struct EpiUpGate {
    static constexpr bool PERM = true, AFTER_DRAIN = false;
    bf16_t* ACT; const float* SS; const float* bias; int ldb; const float* cw; float* HALO; PG8_LAS unsigned char* xb;
    __device__ __forceinline__ void operator()(f32x4 (&acc)[2][2][4][2], const Unit& u, int wr, int wc, int fr, int fq) const {
        asm volatile("" : "+v"(fr), "+v"(fq));
        const int cnd = u.pm < 32 ? 0 : 1 + ((u.pm - 32) >> 3);
        const bool samp = u.pm >= 32;
        const int j0 = u.pn * HALF + wc * 32 + 8 * fq;
        const int row0 = u.pm * BM + wr * 64 + fr;
        { const float* bp = bias + (size_t)cnd * ldb + j0;
          f32x4 bv[2][2];
#pragma unroll
          for (int bj = 0; bj < 2; ++bj)
#pragma unroll
              for (int n = 0; n < 2; ++n) bv[bj][n] = *(const f32x4*)(bp + bj * 2816 + 4 * n);
          float rsv[8]; row_scales(SS, row0, fr, fq, rsv);
#pragma unroll
          for (int ai = 0; ai < 2; ++ai)
#pragma unroll
              for (int m = 0; m < 4; ++m) { const float rs = rsv[ai * 4 + m];
#pragma unroll
                  for (int bj = 0; bj < 2; ++bj)
#pragma unroll
                      for (int n = 0; n < 2; ++n) acc[ai][bj][m][n] = acc[ai][bj][m][n] * rs + bv[bj][n]; } }
        PG8_LAS f32x4* WL = (PG8_LAS f32x4*)(xb + 8192);
        if (fr == 0) {
            f32x4 wt[2][2][3];
#pragma unroll
            for (int n = 0; n < 2; ++n)
#pragma unroll
                for (int bj = 0; bj < 2; ++bj)
#pragma unroll
                    for (int k = 0; k < 3; ++k) wt[n][bj][k] = *(const f32x4*)(cw + k * 5632 + bj * 2816 + j0 + 4 * n);
#pragma unroll
            for (int n = 0; n < 2; ++n)
#pragma unroll
                for (int bj = 0; bj < 2; ++bj)
#pragma unroll
                    for (int k = 0; k < 3; ++k) WL[((((wr * 4 + wc) * 4 + fq) * 2 + n) * 2 + bj) * 3 + k] = wt[n][bj][k];
        }
        PG8_LAS f32x4* XB = (PG8_LAS f32x4*)xb;
        const int wv = wr * 4 + wc, pw = (wr ^ 1) * 4 + wc;
        if (fr == 0) {
#pragma unroll
            for (int ai = 0; ai < 2; ++ai)
#pragma unroll
                for (int bj = 0; bj < 2; ++bj)
#pragma unroll
                    for (int n = 0; n < 2; ++n) XB[((wv * 4 + ai * 2) * 2 + bj) * 8 + 2 * fq + n] = acc[ai][bj][0][n]; }
        if (fr == 15) {
#pragma unroll
            for (int ai = 0; ai < 2; ++ai)
#pragma unroll
                for (int bj = 0; bj < 2; ++bj)
#pragma unroll
                    for (int n = 0; n < 2; ++n) XB[((wv * 4 + ai * 2 + 1) * 2 + bj) * 8 + 2 * fq + n] = acc[ai][bj][3][n]; }
        asm volatile("s_waitcnt lgkmcnt(0)" ::: "memory"); __builtin_amdgcn_s_barrier(); asm volatile("" ::: "memory");
        float* hb = HALO + (size_t)(samp ? u.pm - 32 : 0) * 4 * 5632;
#pragma unroll
        for (int ai = 0; ai < 2; ++ai) {
            const bool has_ab = !(wr == 0 && ai == 0), has_bl = !(wr == 1 && ai == 1);
            const int wab = (wr == 0) ? 1 : (ai == 0 ? 1 : 3), wbl = (wr == 0) ? (ai == 0 ? 0 : 2) : 2;
            unsigned pk[4][4];
#pragma unroll
            for (int n = 0; n < 2; ++n) {
                f32x4 ca[4];
#pragma unroll
                for (int bj = 0; bj < 2; ++bj) {
                    const PG8_LAS f32x4* wlp = WL + ((((wr * 4 + wc) * 4 + fq) * 2 + n) * 2 + bj) * 3;
                    const f32x4 w0 = wlp[0], w1 = wlp[1], w2 = wlp[2];
                    f32x4 ab = (f32x4){0.f, 0.f, 0.f, 0.f}, bl = ab;
                    if (has_ab) ab = XB[((pw * 4 + wab) * 2 + bj) * 8 + 2 * fq + n];
                    if (has_bl) bl = XB[((pw * 4 + wbl) * 2 + bj) * 8 + 2 * fq + n];
#pragma unroll
                    for (int m = 0; m < 4; ++m) {
                        f32x4 cvm;
#pragma unroll
                        for (int i = 0; i < 4; ++i) {
                            const float cur = acc[ai][bj][m][n][i];
                            const float pv = m == 0 ? ab[i] : acc[ai][bj][m == 0 ? 0 : m - 1][n][i];
                            const float nx = m == 3 ? bl[i] : acc[ai][bj][m == 3 ? 3 : m + 1][n][i];
                            const float up = dpp_ror1(fr == 15 ? pv : cur), dn = dpp_ror15(fr == 0 ? nx : cur);
                            cvm[i] = w0[i] * up + w1[i] * cur + w2[i] * dn;
                        }
                        if (samp) {
                            if (m == 0 && wr == 0 && ai == 0 && fr == 0) { *(f32x4*)(hb + 0 * 5632 + bj * 2816 + j0 + 4 * n) = acc[ai][bj][0][n]; *(f32x4*)(hb + 1 * 5632 + bj * 2816 + j0 + 4 * n) = cvm; }
                            if (m == 3 && wr == 1 && ai == 1 && fr == 15) { *(f32x4*)(hb + 2 * 5632 + bj * 2816 + j0 + 4 * n) = acc[ai][bj][3][n]; *(f32x4*)(hb + 3 * 5632 + bj * 2816 + j0 + 4 * n) = cvm; }
                        }
                        if (bj == 0) ca[m] = cvm;
                        else { float r[4];
#pragma unroll
                            for (int i = 0; i < 4; ++i) { const float xa = ca[m][i]; r[i] = xa * __builtin_amdgcn_rcpf(1.f + __builtin_amdgcn_exp2f(-xa * 1.4426950408889634f)) * cvm[i]; }
                            pk[m][2 * n] = cvt_pk_bf16(r[0], r[1]); pk[m][2 * n + 1] = cvt_pk_bf16(r[2], r[3]); }
                    }
                }
                __builtin_amdgcn_sched_barrier(0);
            }
#pragma unroll
            for (int m = 0; m < 4; ++m) *(u32x4*)(ACT + (size_t)(row0 + ai * HALF + m * 16) * 2816 + j0) = (u32x4){pk[m][0], pk[m][1], pk[m][2], pk[m][3]};
        }
    }
};

template <class Epi, class Sched, bool ALIGN_EPI = false, bool SP2 = false>
__device__ __forceinline__ void gemm_phase(PG8_LAS unsigned char* lds, const Gemm g, const Sched& S, const Epi& E, const int tid) {
    const int wid = __builtin_amdgcn_readfirstlane(tid >> 6), lane = tid & 63, wr = wid >> 2, wc = wid & 3, fr = lane & 15, fq = lane >> 4;
    const int K = g.K, nt = K / BK;
    unsigned voffA[2], voffB[2];
#pragma unroll
    for (int i = 0; i < 2; ++i) { int R, C; stage_rc(tid * 16 + i * 8192, R, C); const int Rb = Epi::PERM ? ((R & ~31) + perm32(R & 31)) : R;
        voffA[i] = (unsigned)(R * K + C) * 2u; voffB[i] = (unsigned)(Rb * K + C) * 2u; }
    const size_t kstep = (size_t)(BK * 2);
    const size_t hstep = (size_t)HALF * K * 2;
    const size_t tstep = 2 * hstep;
    const size_t bstep = g.bstep ? g.bstep : tstep, bh = g.bhalf ? g.bhalf : hstep;
    const unsigned ldsw = (unsigned)wid * 1024u;
    const int aoff = lds_byte(wr * 64 + fr, fq * 8), boff = lds_byte(wc * 32 + fr, fq * 8);
#define PG8_SA(b, h) (((b) * 2 + (h)) * HTB)
#define PG8_SB(b, h) ((4 + (b) * 2 + (h)) * HTB)
#define PG8_STAGE(bufoff, gbase, voff) do { _Pragma("unroll") for (int _i = 0; _i < 2; ++_i) \
        __builtin_amdgcn_global_load_lds((const unsigned*)((const char*)(gbase) + (voff)[_i]), (PG8_LAS unsigned*)(lds + (bufoff) + ldsw + _i * 8192), 16, 0, 0); } while (0)
#define PG8_LDA(dst, b, h) do { _Pragma("unroll") for (int m = 0; m < 4; ++m) _Pragma("unroll") for (int k = 0; k < 2; ++k) dst[m][k] = *(const PG8_LAS bf16x8*)(lds + PG8_SA(b, h) + aoff + m * 2048 + k * 1024); } while (0)
#define PG8_LDB(dst, b, h) do { _Pragma("unroll") for (int n = 0; n < 2; ++n) _Pragma("unroll") for (int k = 0; k < 2; ++k) dst[n][k] = *(const PG8_LAS bf16x8*)(lds + PG8_SB(b, h) + boff + n * 2048 + k * 1024); } while (0)
#define PG8_MMA(ai, bj, At, Bt) do { __builtin_amdgcn_s_setprio(1); _Pragma("unroll") for (int m = 0; m < 4; ++m) _Pragma("unroll") for (int n = 0; n < 2; ++n) _Pragma("unroll") for (int k = 0; k < 2; ++k) \
        acc[ai][bj][m][n] = __builtin_amdgcn_mfma_f32_16x16x32_bf16(Bt[n][k], At[m][k], acc[ai][bj][m][n], 0, 0, 0); __builtin_amdgcn_s_setprio(0); } while (0)
#define PG8_WAIT_V(n) asm volatile("s_waitcnt vmcnt(" #n ")" ::: "memory")
#define PG8_WAIT_L(n) asm volatile("s_waitcnt lgkmcnt(" #n ")" ::: "memory")
#define PG8_BAR __builtin_amdgcn_s_barrier()
#define PG8_SCHED __builtin_amdgcn_sched_barrier(0)
    Unit cur, nxt; int ui = 0;
    if (!S.next(0, cur)) return;
    f32x4 acc[2][2][4][2];
#pragma unroll
    for (int a = 0; a < 2; ++a)
#pragma unroll
        for (int b = 0; b < 2; ++b)
#pragma unroll
            for (int m = 0; m < 4; ++m)
#pragma unroll
                for (int n = 0; n < 2; ++n) acc[a][b][m][n] = (f32x4){0.f, 0.f, 0.f, 0.f};
    bf16x8 At[4][2], B0[2][2], B1[2][2];
    const char* cA = (const char*)g.A + (size_t)cur.pm * tstep; const char* cB = (const char*)g.Bt + (size_t)cur.pn * bstep;
    S.a_ready(cur);
    if constexpr (SP2) {
        PG8_STAGE(PG8_SB(0, 0), cB, voffB); PG8_STAGE(PG8_SB(0, 1), cB + bh, voffB); PG8_STAGE(PG8_SA(0, 0), cA, voffA); PG8_STAGE(PG8_SA(0, 1), cA + hstep, voffA);
        if (wr == 1) PG8_BAR;
        PG8_WAIT_V(2); PG8_BAR;
        PG8_STAGE(PG8_SB(1, 0), cB + kstep, voffB); PG8_STAGE(PG8_SA(1, 0), cA + kstep, voffA); PG8_STAGE(PG8_SB(1, 1), cB + bh + kstep, voffB);
        PG8_WAIT_V(6); PG8_BAR;
    } else {
        PG8_STAGE(PG8_SB(0, 0), cB, voffB); PG8_STAGE(PG8_SA(0, 0), cA, voffA); PG8_STAGE(PG8_SB(0, 1), cB + bh, voffB); PG8_STAGE(PG8_SA(0, 1), cA + hstep, voffA);
        if (wr == 1) PG8_BAR;
        PG8_WAIT_V(4); PG8_BAR;
        PG8_STAGE(PG8_SB(1, 0), cB + kstep, voffB); PG8_STAGE(PG8_SA(1, 0), cA + kstep, voffA); PG8_STAGE(PG8_SB(1, 1), cB + bh + kstep, voffB);
        PG8_WAIT_V(6); PG8_BAR;
    }
    for (;;) {
        const bool has_next = S.next(ui + 1, nxt);
        const char* nA = has_next ? (const char*)g.A + (size_t)nxt.pm * tstep : cA; const char* nB = has_next ? (const char*)g.Bt + (size_t)nxt.pn * bstep : cB;
        for (int t = 0; t < nt; t += 2) {
            const bool last = (t == nt - 2);
            const char* a1 = cA + (size_t)(t + 1) * kstep;
            const char* a2 = last ? nA : cA + (size_t)(t + 2) * kstep; const char* b2 = last ? nB : cB + (size_t)(t + 2) * kstep;
            const char* a3 = a2 + kstep; const char* b3 = b2 + kstep;
            if (last && has_next) S.a_ready(nxt);
            if constexpr (SP2) {
            PG8_LDB(B0, 0, 0); PG8_LDB(B1, 0, 1); PG8_SCHED; PG8_LDA(At, 0, 0); PG8_STAGE(PG8_SA(1, 1), a1 + hstep, voffA);
            PG8_WAIT_V(8); PG8_WAIT_L(0); PG8_BAR; PG8_MMA(0, 0, At, B0); PG8_MMA(0, 1, At, B1); PG8_BAR; PG8_SCHED;
            PG8_LDA(At, 0, 1); PG8_STAGE(PG8_SB(0, 0), b2, voffB); PG8_STAGE(PG8_SB(0, 1), b2 + bh, voffB); PG8_STAGE(PG8_SA(0, 0), a2, voffA);
            PG8_WAIT_V(8); PG8_WAIT_L(0); PG8_BAR; PG8_MMA(1, 0, At, B0); PG8_MMA(1, 1, At, B1); PG8_BAR; PG8_SCHED;
            PG8_LDB(B0, 1, 0); PG8_LDB(B1, 1, 1); PG8_SCHED; PG8_LDA(At, 1, 0); PG8_STAGE(PG8_SA(0, 1), a2 + hstep, voffA);
            PG8_WAIT_V(8); PG8_WAIT_L(0); PG8_BAR; PG8_MMA(0, 0, At, B0); PG8_MMA(0, 1, At, B1); PG8_BAR; PG8_SCHED;
            PG8_LDA(At, 1, 1); PG8_STAGE(PG8_SB(1, 0), b3, voffB); PG8_STAGE(PG8_SB(1, 1), b3 + bh, voffB); PG8_STAGE(PG8_SA(1, 0), a3, voffA);
            PG8_WAIT_V(8); PG8_WAIT_L(0); PG8_BAR; PG8_MMA(1, 0, At, B0); PG8_MMA(1, 1, At, B1); PG8_BAR; PG8_SCHED;
            } else {
            PG8_LDB(B0, 0, 0); PG8_SCHED; PG8_LDA(At, 0, 0); PG8_STAGE(PG8_SA(1, 1), a1 + hstep, voffA);
            PG8_WAIT_L(8); PG8_BAR; PG8_WAIT_L(0); PG8_MMA(0, 0, At, B0); PG8_BAR; PG8_SCHED;
            PG8_LDB(B1, 0, 1); PG8_STAGE(PG8_SB(0, 0), b2, voffB);
            PG8_BAR; PG8_WAIT_L(0); PG8_MMA(0, 1, At, B1); PG8_BAR;
            PG8_LDA(At, 0, 1); PG8_STAGE(PG8_SA(0, 0), a2, voffA);
            PG8_BAR; PG8_WAIT_L(0); PG8_MMA(1, 0, At, B0); PG8_BAR; PG8_SCHED;
            PG8_STAGE(PG8_SB(0, 1), b2 + bh, voffB);
            PG8_WAIT_V(6); PG8_BAR; PG8_MMA(1, 1, At, B1); PG8_BAR;
            PG8_LDB(B0, 1, 0); PG8_SCHED; PG8_LDA(At, 1, 0); PG8_STAGE(PG8_SA(0, 1), a2 + hstep, voffA);
            PG8_WAIT_L(8); PG8_BAR; PG8_WAIT_L(0); PG8_MMA(0, 0, At, B0); PG8_BAR; PG8_SCHED;
            PG8_LDB(B1, 1, 1); PG8_STAGE(PG8_SB(1, 0), b3, voffB);
            PG8_BAR; PG8_WAIT_L(0); PG8_MMA(0, 1, At, B1); PG8_BAR;
            PG8_LDA(At, 1, 1); PG8_STAGE(PG8_SA(1, 0), a3, voffA);
            PG8_BAR; PG8_WAIT_L(0); PG8_MMA(1, 0, At, B0); PG8_BAR; PG8_SCHED;
            PG8_STAGE(PG8_SB(1, 1), b3 + bh, voffB);
            PG8_WAIT_V(6); PG8_BAR; PG8_MMA(1, 1, At, B1); PG8_BAR;
            }
        }
        if constexpr (ALIGN_EPI) { if (wr == 0) PG8_BAR; }
        if constexpr (!Epi::AFTER_DRAIN) { E(acc, cur, wr, wc, fr, fq); S.done(cur); }
        if (!has_next) break;
#pragma unroll
        for (int a = 0; a < 2; ++a)
#pragma unroll
            for (int b = 0; b < 2; ++b)
#pragma unroll
                for (int m = 0; m < 4; ++m)
#pragma unroll
                    for (int n = 0; n < 2; ++n) acc[a][b][m][n] = (f32x4){0.f, 0.f, 0.f, 0.f};
        cur = nxt; cA = nA; cB = nB; ++ui;
        if constexpr (ALIGN_EPI) { if (wr == 1) PG8_BAR; }
    }
    PG8_WAIT_V(0);
    if constexpr (!ALIGN_EPI) { if (wr == 0) PG8_BAR; }
    PG8_BAR;
#undef PG8_SA
#undef PG8_SB
#undef PG8_STAGE
#undef PG8_LDA
#undef PG8_LDB
#undef PG8_MMA
#undef PG8_WAIT_V
#undef PG8_WAIT_L
#undef PG8_BAR
#undef PG8_SCHED
}
}

#define LAS __attribute__((address_space(3)))
#define CAS __attribute__((address_space(4)))
typedef unsigned short bf16;
typedef float f32x4 __attribute__((ext_vector_type(4)));
typedef short bf16x8 __attribute__((ext_vector_type(8)));
typedef unsigned u32x4 __attribute__((ext_vector_type(4)));
typedef unsigned u32x2 __attribute__((ext_vector_type(2)));

constexpr int NW = 8, NT = 512;
constexpr int DM = 1024, NTOK = 12288, NPR = 8192, NKR = 13312, INC = 2144, INP = 2304, DFF = 2816, DUP = 5632;
constexpr float EPS = 1e-6f, LOG2E = 1.4426950408889634f;
constexpr float QS = 0.125f * LOG2E;
constexpr float MLAQS = 0.10206207261596575f * LOG2E;

constexpr size_t MiB = 1u << 20;
constexpr size_t WS_CTL = 0, WS_MOD = 1 * MiB, WS_ROPE = 1 * MiB + 256 * 1024, WS_W = 2 * MiB, W_LSTRIDE = 24 * MiB;
constexpr size_t W_IN = 0, W_OUT = 4718592, W_UP = W_OUT + 2097152, W_DOWN = W_UP + 11534336, W_B2 = W_DOWN + 5767168;
static_assert(W_B2 + 786432 <= W_LSTRIDE, "weights");
constexpr size_t WS_XN = 50 * MiB, WS_PROJ = 74 * MiB, WS_A2 = 128 * MiB, WS_MQKV = 138 * MiB, WS_QC = 164 * MiB, WS_KPE = 203 * MiB, WS_YCAT = 204 * MiB;
constexpr size_t WS_ACT = 116 * MiB, WS_U = 116 * MiB, WS_SS1 = 228 * MiB, WS_SS2 = 229 * MiB, WS_HALO = 230 * MiB, WS_XRES = 232 * MiB, WS_END = 256 * MiB;
constexpr size_t WS_BIAS = 65536;
constexpr int NBIAS = 2304 + 5632;
constexpr size_t QSZ = (size_t)NKR * 256 * 2, KSZ = (size_t)NKR * 128 * 2;
constexpr int LDS_BYTES = 163840, LDS_CTL = 163840 - 256;
constexpr size_t WS_BAR = 16384;

struct Args { const float* in[28]; float* out; unsigned char* ws; };

__device__ __forceinline__ unsigned f2bf(float f) { unsigned u = __builtin_bit_cast(unsigned, f); return (u + 0x7fffu + ((u >> 16) & 1u)) >> 16; }
__device__ __forceinline__ unsigned pk2(float lo, float hi) { unsigned r; asm("v_cvt_pk_bf16_f32 %0, %1, %2" : "=v"(r) : "v"(lo), "v"(hi)); return r; }
__device__ __forceinline__ float bflo(unsigned u) { return __builtin_bit_cast(float, u << 16); }
__device__ __forceinline__ float bfhi(unsigned u) { return __builtin_bit_cast(float, u & 0xffff0000u); }
__device__ __forceinline__ f32x4 ld4bf(const bf16* p) { const u32x2 u = *(const u32x2*)p; return (f32x4){bflo(u.x), bfhi(u.x), bflo(u.y), bfhi(u.y)}; }
__device__ __forceinline__ void st4bf(bf16* p, f32x4 v) { u32x2 u; u.x = pk2(v[0], v[1]); u.y = pk2(v[2], v[3]); *(u32x2*)p = u; }
__device__ __forceinline__ float shx(float v, int m, int lane) { return __builtin_bit_cast(float, __builtin_amdgcn_ds_bpermute((lane ^ m) << 2, __builtin_bit_cast(int, v))); }
#define DPPF(v, ctrl) __builtin_bit_cast(float, __builtin_amdgcn_mov_dpp(__builtin_bit_cast(int, (v)), (ctrl), 0xf, 0xf, false))
__device__ __forceinline__ float sum16(float v, int) { v += DPPF(v, 0x121); v += DPPF(v, 0x122); v += DPPF(v, 0x124); v += DPPF(v, 0x128); return v; }
__device__ __forceinline__ float wave_sum(float v, int lane) {
    v = sum16(v, lane);
    const int iv = __builtin_bit_cast(int, v);
    const float a = __builtin_bit_cast(float, __builtin_amdgcn_readlane(iv, 0)), b = __builtin_bit_cast(float, __builtin_amdgcn_readlane(iv, 16)),
                c = __builtin_bit_cast(float, __builtin_amdgcn_readlane(iv, 32)), d = __builtin_bit_cast(float, __builtin_amdgcn_readlane(iv, 48));
    return (a + b) + (c + d);
}
__device__ __forceinline__ float dot4(f32x4 a) { return (a[0] * a[0] + a[1] * a[1]) + (a[2] * a[2] + a[3] * a[3]); }
__device__ __forceinline__ f32x4 shfl4(f32x4 v, int m, int lane) { return (f32x4){shx(v[0], m, lane), shx(v[1], m, lane), shx(v[2], m, lane), shx(v[3], m, lane)}; }

__device__ __forceinline__ void transpose_item(const float* W, int N, bf16* WT, int ldk, int row_off, int k_off, float scale, LAS float* scr, int item, int lane) {
    const int nblk = (N + 63) / 64, kb = item / nblk, nb = item % nblk, k0 = 64 * kb, n0 = 64 * nb;
    const bool act = n0 + lane < N;
    const float* wp = W + (size_t)k0 * N + n0 + lane;
    float v[64];
#pragma unroll
    for (int i = 0; i < 64; ++i) v[i] = act ? wp[(size_t)i * N] : 0.f;
#pragma unroll
    for (int i = 0; i < 64; ++i) scr[i * 65 + lane] = v[i] * scale;
    asm volatile("s_waitcnt lgkmcnt(0)" ::: "memory");
    const int c = lane & 7;
#pragma unroll
    for (int j = 0; j < 8; ++j) { const int n = (lane >> 3) + 8 * j; const LAS float* s = scr + (8 * c) * 65 + n;
        u32x4 o; o.x = pk2(s[0 * 65], s[1 * 65]); o.y = pk2(s[2 * 65], s[3 * 65]); o.z = pk2(s[4 * 65], s[5 * 65]); o.w = pk2(s[6 * 65], s[7 * 65]);
        if (n0 + n < N) *(u32x4*)(WT + (size_t)(row_off + n0 + n) * ldk + k_off + k0 + 8 * c) = o; }
    asm volatile("s_waitcnt lgkmcnt(0)" ::: "memory");
}

template <class ArgsRef>
__device__ __forceinline__ void wconv(const ArgsRef& a, unsigned char* ws, int l, int sel, int w, int nwk, LAS float* scr, int lane) {
    constexpr int I_IN = 16 * 34, I_OUT = 16 * 16, I_UP = 16 * 88, I_DN = 44 * 16, I_Q = 3 * 6, I_KV = 2 * 8;
    const int n_in = (sel & 1) ? I_IN : 0, n_out = (sel & 2) ? I_OUT : 0, n_up = (sel & 4) ? I_UP : 0, n_dn = (sel & 8) ? I_DN : 0, n_q = (sel & 16) ? I_Q : 0, n_kv = (sel & 32) ? I_KV : 0;
    const int total = n_in + n_out + n_up + n_dn + n_q + n_kv;
    unsigned char* wl = ws + WS_W + l * W_LSTRIDE;
    for (int it = w; it < total; it += nwk) {
        int r = it;
        if (r < n_in) { transpose_item(a.in[13] + (size_t)l * 1024 * INC, INC, (bf16*)(wl + W_IN), 1024, 0, 0, 1.f, scr, r, lane); continue; } r -= n_in;
        if (r < n_out) { transpose_item(a.in[22] + (size_t)l * 1024 * 1024, 1024, (bf16*)(wl + W_OUT), 1024, 0, 0, 1.f, scr, r, lane); continue; } r -= n_out;
        if (r < n_up) { transpose_item(a.in[24] + (size_t)l * 1024 * DUP, DUP, (bf16*)(wl + W_UP), 1024, 0, 0, 1.f, scr, r, lane); continue; } r -= n_up;
        if (r < n_dn) { transpose_item(a.in[26] + (size_t)l * DFF * 1024, 1024, (bf16*)(wl + W_DOWN), DFF, 0, 0, 1.f, scr, r, lane); continue; } r -= n_dn;
        if (r < n_q) { transpose_item(a.in[16] + (size_t)l * 192 * 384, 384, (bf16*)(wl + W_B2), 384, 0, 0, MLAQS, scr, r, lane); continue; } r -= n_q;
        transpose_item(a.in[18] + (size_t)l * 128 * 512, 512, (bf16*)(wl + W_B2), 384, 384, 192, 1.f, scr, r, lane);
    }
}
template <class ArgsRef>
__device__ __forceinline__ void phase0(const ArgsRef& a, LAS unsigned char* lds, int tid, int lane, int wave) {
    unsigned char* ws = a.ws;
    const int G = gridDim.x, bid = blockIdx.x;
    if (bid < 96) {
        LAS float* sl = (LAS float*)(lds + 16384);
        for (int e = tid; e < 3072; e += NT) { const int c = e >> 10, k = e & 1023; const float v = c == 0 ? a.in[9][k] : a.in[8][(c - 1) * 1024 + k]; sl[e] = v / (1.f + __expf(-v)); }
        __syncthreads();
    }
    for (int it = bid; it < 96; it += G) {
        const int l = it / 48, n0 = (it % 48) * 128;
        const float* wa = a.in[10] + (size_t)l * 1024 * 6144;
        const LAS float* sl = (const LAS float*)(lds + 16384);
        float acc[3][2] = {{0.f, 0.f}, {0.f, 0.f}, {0.f, 0.f}};
        const int kb = wave * 128;
#pragma unroll 16
        for (int k = 0; k < 128; ++k) {
            const int kk = kb + k;
            const float2 w = *(const float2*)(wa + (size_t)kk * 6144 + n0 + 2 * lane);
            const float s0 = sl[kk], s1 = sl[1024 + kk], s2 = sl[2048 + kk];
            acc[0][0] += s0 * w.x; acc[0][1] += s0 * w.y; acc[1][0] += s1 * w.x; acc[1][1] += s1 * w.y; acc[2][0] += s2 * w.x; acc[2][1] += s2 * w.y;
        }
        LAS float* red = (LAS float*)lds;
#pragma unroll
        for (int c = 0; c < 3; ++c) { red[(wave * 3 + c) * 128 + 2 * lane] = acc[c][0]; red[(wave * 3 + c) * 128 + 2 * lane + 1] = acc[c][1]; }
        __syncthreads();
        if (tid < 384) { const int c = tid / 128, n = tid % 128; float s = 0.f;
#pragma unroll
            for (int w = 0; w < 8; ++w) s += red[(w * 3 + c) * 128 + n];
            ((float*)(ws + WS_MOD))[(size_t)(l * 3 + c) * 6144 + n0 + n] = s + a.in[11][(size_t)l * 6144 + n0 + n]; }
        __syncthreads();
    }
    if (bid == G - 1) {
        float* rt = (float*)(ws + WS_ROPE);
        for (int e = tid; e < 1024; e += NT) { const int pos = e >> 4, i = e & 15; const float inv = exp2f(-(float)(2 * i) / 32.f * 13.287712379549449f); const float ang = (float)pos * inv;
            rt[e] = __cosf(ang); rt[1024 + e] = __sinf(ang); }
        for (int e = tid; e < 512; e += NT) { const int pos = e >> 3, i = e & 7; const float inv = exp2f(-(float)(2 * i) / 16.f * 13.287712379549449f); const float ang = (float)pos * inv;
            rt[2048 + e] = __cosf(ang); rt[2560 + e] = __sinf(ang); }
    }
    const int gt = bid * NT + tid, NGT = G * NT;
    if (gt < 256) ((unsigned*)(ws + WS_CTL))[gt] = 0u;
    if (gt < 64) ((unsigned*)(ws + WS_CTL))[2048 + gt] = 0u;
    for (int l = 0; l < 2; ++l) {
        bf16* b2 = (bf16*)(ws + WS_W + l * W_LSTRIDE + W_B2);
        for (int ch = gt; ch < 1024 * 48; ch += NGT) { const int n = ch / 48, k = (ch % 48) * 8;
            const bool data = (n < 384 && k < 192) || (n >= 384 && n < 896 && k >= 192 && k < 320);
            if (!data) *(u32x4*)(b2 + (size_t)n * 384 + k) = (u32x4){0u, 0u, 0u, 0u}; }
        bf16* wi = (bf16*)(ws + WS_W + l * W_LSTRIDE + W_IN) + (size_t)INC * 1024;
        for (int ch = gt; ch < 160 * 128; ch += NGT) *(u32x4*)(wi + (size_t)ch * 8) = (u32x4){0u, 0u, 0u, 0u};
    }
    LAS float* scr = (LAS float*)(lds + 28672 + wave * 16640);
    wconv(a, ws, 0, 1 | 2 | 16 | 32, bid * NW + wave, G * NW, scr, lane);
}

__device__ __forceinline__ void prep_phase(const float* x0, const float* x1, const float* nw, const float* mod, int sc_off, bf16* XN, float* SS, int lane, int gw, int NGW) {
    for (int row = gw; row < NTOK; row += NGW) {
        const float* xr = row < NPR ? x0 + (size_t)row * DM : x1 + (size_t)(row - NPR) * DM;
        const int c = row < NPR ? 0 : 1 + ((row - NPR) >> 11);
        const float* mp = mod + c * 6144;
        f32x4 v[4]; float ss = 0.f;
#pragma unroll
        for (int j = 0; j < 4; ++j) { v[j] = *(const f32x4*)(xr + 4 * (lane + 64 * j)); ss += dot4(v[j]); }
        ss = wave_sum(ss, lane);
#pragma unroll
        for (int j = 0; j < 4; ++j) { const int col = 4 * (lane + 64 * j);
            const f32x4 g = *(const f32x4*)(nw + col), sc = *(const f32x4*)(mp + sc_off + col);
            st4bf(XN + (size_t)row * DM + col, v[j] * g * (1.f + sc)); }
        if (lane < 16) SS[(size_t)row * 16 + lane] = lane == 0 ? ss : 0.f;
    }
}
template <class ArgsRef>
__device__ __forceinline__ void bias_phase(const ArgsRef& a, unsigned char* ws, LAS unsigned char* lds, int tid, int lane, int wave) {
    const float* mod = (const float*)(ws + WS_MOD);
    float* BIAS = (float*)(ws + WS_BIAS);
    for (int it = blockIdx.x; it < 62; it += gridDim.x) {
        const int l = it / 31, r = it % 31; const bool up = r >= 9;
        const int N = up ? DUP : INC, n0 = (up ? r - 9 : r) * 256 + 4 * lane;
        const float* W = up ? a.in[24] + (size_t)l * 1024 * DUP : a.in[13] + (size_t)l * 1024 * INC;
        const float* shp = mod + (size_t)l * 3 * 6144 + (up ? 3072 : 0);
        LAS float* sl = (LAS float*)(lds + 32768);
        for (int e = tid; e < 3072; e += NT) sl[e] = shp[(e >> 10) * 6144 + (e & 1023)];
        __syncthreads();
        const bool act = n0 < N;
        f32x4 acc[3] = {(f32x4){0.f, 0.f, 0.f, 0.f}, (f32x4){0.f, 0.f, 0.f, 0.f}, (f32x4){0.f, 0.f, 0.f, 0.f}};
        const int kb = wave * 128;
#pragma unroll 16
        for (int k = 0; k < 128; ++k) { const int kk = kb + k;
            const f32x4 w = act ? *(const f32x4*)(W + (size_t)kk * N + n0) : (f32x4){0.f, 0.f, 0.f, 0.f};
            acc[0] += w * sl[kk]; acc[1] += w * sl[1024 + kk]; acc[2] += w * sl[2048 + kk]; }
        LAS f32x4* red = (LAS f32x4*)lds;
#pragma unroll
        for (int c = 0; c < 3; ++c) red[(wave * 3 + c) * 64 + lane] = acc[c];
        __syncthreads();
        if (tid < 192) { const int c = tid >> 6, ln = tid & 63; f32x4 t = red[c * 64 + ln];
#pragma unroll
            for (int w = 1; w < 8; ++w) t += red[(w * 3 + c) * 64 + ln];
            const int nn = (up ? r - 9 : r) * 256 + 4 * ln;
            if (nn < N) *(f32x4*)(BIAS + (size_t)(l * 3 + c) * NBIAS + (up ? 2304 : 0) + nn) = t;
            else if (!up && nn < 2304) *(f32x4*)(BIAS + (size_t)(l * 3 + c) * NBIAS + nn) = (f32x4){0.f, 0.f, 0.f, 0.f}; }
        __syncthreads();
    }
}

struct P3Ptrs {
    const bf16* PROJ; bf16 *A2, *KPE, *YCAT, *Qc_rot, *Qc_raw, *Kc, *Vc, *Qd_rot, *Qd_raw, *Kd, *Vd;
    const float *conv_a, *gq_mla, *gkv_mla, *gq, *gk, *rope;
    const float *c_ckv, *c_kpe, *c_gk, *c_gv, *c_sk, *c_sv;
    float *o_ckv, *o_kpe, *o_gk, *o_gv, *o_sk, *o_sv;
    int l;
};
__device__ __forceinline__ f32x4 rope64(f32x4 v, int jl, int prow, int pcol, const float* rt, int lane) {
    const f32x4 pr = shfl4(v, 4, lane);
    const int pos = jl < 8 ? prow : pcol, fi = 4 * (jl & 3);
    const f32x4 c = *(const f32x4*)(rt + pos * 16 + fi), s = *(const f32x4*)(rt + 1024 + pos * 16 + fi);
    const float sg = (jl & 4) ? 1.f : -1.f;
    return v * c + pr * s * sg;
}
__device__ __forceinline__ void p3_phase(const P3Ptrs& P, int lane, int gw, int NGW) {
    const int l = P.l;
    for (int row = gw; row < NKR; row += NGW) {
        if (row < NTOK) {
            const bool samp = row >= NPR;
            int b, t, kr, T;
            if (!samp) { b = row >> 8; t = row & 255; kr = row; T = 256; } else { b = (row - NPR) >> 11; t = (row - NPR) & 2047; kr = NPR + b * 2560 + t; T = 2048; }
            const int prow = t >> 6, pcol = t & 63;
            const bf16* pr = P.PROJ + (size_t)row * INP;
            const size_t ob = (size_t)((b * 2 + l) * 256 + t);
            const int ci = 4 * lane, jl = lane & 15;
            const u32x2 z2 = (u32x2){0u, 0u};
            const bool hp = t > 0, hn = t < T - 1;
            const u32x2 r_xa = *(const u32x2*)(pr + ci), r_gb = *(const u32x2*)(pr + 256 + ci), r_gc = *(const u32x2*)(pr + 512 + ci);
            const u32x2 r_pxa = hp ? *(const u32x2*)(pr - INP + ci) : z2, r_pgc = hp ? *(const u32x2*)(pr - INP + 512 + ci) : z2;
            const u32x2 r_nxa = hn ? *(const u32x2*)(pr + INP + ci) : z2, r_ngc = hn ? *(const u32x2*)(pr + INP + 512 + ci) : z2;
            const u32x2 r_cq = lane < 48 ? *(const u32x2*)(pr + 768 + ci) : z2, r_ckv = lane < 32 ? *(const u32x2*)(pr + 960 + ci) : z2, r_kpe = lane < 8 ? *(const u32x2*)(pr + 1088 + ci) : z2;
            const u32x2 r_qc = *(const u32x2*)(pr + 1120 + ci), r_kvc = *(const u32x2*)(pr + 1376 + ci), r_qd = *(const u32x2*)(pr + 1632 + ci), r_kvd = *(const u32x2*)(pr + 1888 + ci);
            const float* cw = P.conv_a + (size_t)l * 768;
            const f32x4 w0 = *(const f32x4*)(cw + ci), w1 = *(const f32x4*)(cw + 256 + ci), w2 = *(const f32x4*)(cw + 512 + ci);
            const f32x4 g_qm = lane < 48 ? *(const f32x4*)(P.gq_mla + l * 192 + ci) : (f32x4){0.f, 0.f, 0.f, 0.f}, g_kvm = lane < 32 ? *(const f32x4*)(P.gkv_mla + l * 128 + ci) : (f32x4){0.f, 0.f, 0.f, 0.f};
            const f32x4 g_q = *(const f32x4*)(P.gq + l * 64 + 4 * jl), g_k = *(const f32x4*)(P.gk + l * 64 + 4 * jl);
            const int pos64 = jl < 8 ? prow : pcol, fi64 = 4 * (jl & 3);
            const f32x4 c64 = *(const f32x4*)(P.rope + pos64 * 16 + fi64), s64 = *(const f32x4*)(P.rope + 1024 + pos64 * 16 + fi64);
            const int pos32 = (lane & 7) < 4 ? prow : pcol, fi32 = 4 * (lane & 1);
            const f32x4 c32 = *(const f32x4*)(P.rope + 2048 + pos32 * 8 + fi32), s32 = *(const f32x4*)(P.rope + 2560 + pos32 * 8 + fi32);
#define CV4(u) ((f32x4){bflo((u).x), bfhi((u).x), bflo((u).y), bfhi((u).y)})
#define ROPE64(v) ((v) * c64 + shfl4((v), 4, lane) * s64 * ((jl & 4) ? 1.f : -1.f))
            { const f32x4 ya = CV4(r_gb) * (w0 * (CV4(r_pxa) * CV4(r_pgc)) + w1 * (CV4(r_xa) * CV4(r_gc)) + w2 * (CV4(r_nxa) * CV4(r_ngc)));
              st4bf(P.YCAT + (size_t)row * DM + ci, ya); }
            { const f32x4 v = CV4(r_cq);
              const float rs = rsqrtf(wave_sum(dot4(v), lane) * (1.f / 192.f) + EPS);
              if (lane < 48) st4bf(P.A2 + (size_t)kr * 384 + ci, v * rs * g_qm); }
            { const f32x4 v = CV4(r_ckv);
              const float rs = rsqrtf(wave_sum(dot4(v), lane) * (1.f / 128.f) + EPS);
              if (lane < 32) { const f32x4 o = v * rs * g_kvm;
                  st4bf(P.A2 + (size_t)kr * 384 + 192 + ci, o);
                  if (!samp) *(f32x4*)(P.o_ckv + ob * 128 + ci) = o; }
              else if (lane < 48) { unsigned zz = 0u; asm volatile("" : "+v"(zz)); *(u32x2*)(P.A2 + (size_t)kr * 384 + 320 + 4 * (lane - 32)) = (u32x2){zz, zz}; } }
            { const f32x4 v = CV4(r_kpe);
              const f32x4 r = v * c32 + shfl4(v, 2, lane) * s32 * ((lane & 2) ? 1.f : -1.f);
              if (lane < 8) { if (!samp) *(f32x4*)(P.o_kpe + ob * 32 + ci) = v; st4bf(P.KPE + (size_t)kr * 32 + ci, samp ? r : v); } }
            { f32x4 v = CV4(r_qc);
              const float rs = rsqrtf(sum16(dot4(v), lane) * (1.f / 64.f) + EPS);
              v = v * rs * g_q;
              st4bf(P.Qc_raw + (size_t)kr * 256 + ci, v * QS);
              const f32x4 r = ROPE64(v);
              if (samp) st4bf(P.Qc_rot + (size_t)kr * 256 + ci, r * QS); }
            { const f32x4 v = CV4(r_kvc);
              const float rs = rsqrtf(sum16(dot4(v), lane) * (1.f / 64.f) + EPS);
              const f32x4 kn = v * rs * g_k;
              const f32x4 r = ROPE64(kn);
              if (lane < 32) { if (!samp) *(f32x4*)(P.o_gk + ob * 128 + ci) = kn; st4bf(P.Kc + (size_t)kr * 128 + ci, samp ? r : kn); }
              else { if (!samp) *(f32x4*)(P.o_gv + ob * 128 + 4 * (lane - 32)) = v; st4bf(P.Vc + (size_t)kr * 128 + 4 * (lane - 32), v); } }
            { const f32x4 v = CV4(r_qd);
              st4bf(P.Qd_raw + (size_t)kr * 256 + ci, v * QS);
              const f32x4 r = ROPE64(v);
              if (samp) st4bf(P.Qd_rot + (size_t)kr * 256 + ci, r * QS); }
            { const f32x4 v = CV4(r_kvd);
              const f32x4 r = ROPE64(v);
              if (lane < 32) { if (!samp) *(f32x4*)(P.o_sk + ob * 128 + ci) = v; st4bf(P.Kd + (size_t)kr * 128 + ci, samp ? r : v); }
              else { if (!samp) *(f32x4*)(P.o_sv + ob * 128 + 4 * (lane - 32)) = v; st4bf(P.Vd + (size_t)kr * 128 + 4 * (lane - 32), v); } }
#undef CV4
#undef ROPE64
        } else {
            const int ci = row - NTOK, b = ci >> 9, j = ci & 511, kr = NPR + b * 2560 + 2048 + j;
            const size_t cb = (size_t)((b * 2 + l) * 512 + j);
            f32x4 z = (f32x4){0.f, 0.f, 0.f, 0.f}; asm volatile("" : "+v"(z));
            if (lane < 48) st4bf(P.A2 + (size_t)kr * 384 + 4 * lane, z);
            if (lane < 32) st4bf(P.A2 + (size_t)kr * 384 + 192 + 4 * lane, *(const f32x4*)(P.c_ckv + cb * 128 + 4 * lane));
            else if (lane < 48) st4bf(P.A2 + (size_t)kr * 384 + 320 + 4 * (lane - 32), z);
            if (lane < 8) st4bf(P.KPE + (size_t)kr * 32 + 4 * lane, *(const f32x4*)(P.c_kpe + cb * 32 + 4 * lane));
            if (lane < 32) { st4bf(P.Kc + (size_t)kr * 128 + 4 * lane, *(const f32x4*)(P.c_gk + cb * 128 + 4 * lane));
                             st4bf(P.Kd + (size_t)kr * 128 + 4 * lane, *(const f32x4*)(P.c_sk + cb * 128 + 4 * lane)); }
            else { st4bf(P.Vc + (size_t)kr * 128 + 4 * (lane - 32), *(const f32x4*)(P.c_gv + cb * 128 + 4 * (lane - 32)));
                   st4bf(P.Vd + (size_t)kr * 128 + 4 * (lane - 32), *(const f32x4*)(P.c_sv + cb * 128 + 4 * (lane - 32))); }
        }
    }
}

struct AttnSrc {
    const bf16* Qraw; const bf16* Qrot; int qpitch;
    const bf16* K0; int k0pitch; const bf16* K1;
    const bf16* V; int vpitch;
    bf16* Y; int outcol;
    int krbase, rowbase, q0, lo, hi, nctx;
    bool samp, window; float m0; bool sink;
    const float* rope;
};
template <int DK>
__device__ __forceinline__ void attn_unit(const AttnSrc& S, LAS unsigned char* lds, int tid, int lane, int wave) {
    constexpr int TK = 128, NKB = TK / 16, NPP = TK / 32;
    constexpr int KP = DK + 8, VP = TK + 8, KS = DK / 32, CPK = DK / 8;
    constexpr int NKC = TK * CPK / NT, NVC = TK * 8 / NT;
    LAS bf16* Ks = (LAS bf16*)lds;
    LAS bf16* Vt = (LAS bf16*)(lds + 2 * TK * KP * 2);
    const int g = lane >> 4, fr = lane & 15;
    const int qpos = S.q0 + wave * 16 + fr;
    const size_t qkr = (size_t)(S.krbase + qpos);
    bf16x8 qraw[KS], qrot[KS];
#pragma unroll
    for (int ks = 0; ks < KS; ++ks) { qraw[ks] = *(const bf16x8*)(S.Qraw + qkr * S.qpitch + ks * 32 + g * 8); qrot[ks] = qraw[ks]; }
    if (S.samp) {
        if (DK == 96) {
            const bf16x8 own = qraw[KS - 1], par = *(const bf16x8*)(S.Qraw + qkr * S.qpitch + 64 + (g ^ 1) * 8);
            const int pos = g < 2 ? (qpos >> 6) : (qpos & 63);
            const float sg = (g & 1) ? 1.f : -1.f;
            const float* ct = S.rope + 2048 + pos * 8; const float* st = S.rope + 2560 + pos * 8;
            bf16x8 r;
#pragma unroll
            for (int e = 0; e < 8; ++e) { const float o = bflo((unsigned)(unsigned short)own[e]), p = bflo((unsigned)(unsigned short)par[e]);
                r[e] = (short)f2bf(o * ct[e] + p * st[e] * sg); }
            qrot[KS - 1] = r;
        } else {
#pragma unroll
            for (int ks = 0; ks < KS; ++ks) qrot[ks] = *(const bf16x8*)(S.Qrot + qkr * S.qpitch + ks * 32 + g * 8);
        }
    }
    bf16x8 qc[KS];
#pragma unroll
    for (int ks = 0; ks < KS; ++ks) qc[ks] = S.samp ? qrot[ks] : qraw[ks];
    float m = S.m0, l = (S.sink && g == 0) ? 1.f : 0.f;
    f32x4 o[4];
#pragma unroll
    for (int d = 0; d < 4; ++d) o[d] = (f32x4){0.f, 0.f, 0.f, 0.f};
    const int nloc = S.hi - S.lo, ntile = nloc + S.nctx;
    u32x4 kreg[NKC], vreg[NVC];
    auto gload = [&](int j) {
        const int tile = j < nloc ? S.lo + j : (2048 / TK) + (j - nloc);
        const size_t kr = (size_t)(S.krbase + tile * TK);
#pragma unroll
        for (int c = 0; c < NKC; ++c) { const int ch = tid + c * NT, key = ch / CPK, part = ch % CPK;
            if (DK == 64) kreg[c] = *(const u32x4*)(S.K0 + (kr + key) * S.k0pitch + part * 8);
            else kreg[c] = part < 8 ? *(const u32x4*)(S.K0 + (kr + key) * S.k0pitch + part * 8) : *(const u32x4*)(S.K1 + (kr + key) * 32 + (part - 8) * 8); }
#pragma unroll
        for (int c = 0; c < NVC; ++c) { const int ch = tid + c * NT, vkey = ch & (TK - 1), vdc = ch / TK;
            vreg[c] = *(const u32x4*)(S.V + (kr + vkey) * S.vpitch + vdc * 8); }
    };
    auto lstore = [&](int buf) {
        LAS bf16* kb = Ks + buf * TK * KP; LAS bf16* vb = Vt + buf * 64 * VP;
#pragma unroll
        for (int c = 0; c < NKC; ++c) { const int ch = tid + c * NT, key = ch / CPK, part = ch % CPK; *(LAS u32x4*)(kb + key * KP + part * 8) = kreg[c]; }
#pragma unroll
        for (int c = 0; c < NVC; ++c) { const int ch = tid + c * NT, vkey = ch & (TK - 1), vdc = ch / TK;
            LAS bf16* vp = vb + (vdc * 8) * VP + vkey; const u32x4 v = vreg[c];
            vp[0 * VP] = (bf16)(v.x & 0xffffu); vp[1 * VP] = (bf16)(v.x >> 16); vp[2 * VP] = (bf16)(v.y & 0xffffu); vp[3 * VP] = (bf16)(v.y >> 16);
            vp[4 * VP] = (bf16)(v.z & 0xffffu); vp[5 * VP] = (bf16)(v.z >> 16); vp[6 * VP] = (bf16)(v.w & 0xffffu); vp[7 * VP] = (bf16)(v.w >> 16); }
    };
    gload(0); lstore(0);
    __syncthreads();
    for (int j = 0; j < ntile; ++j) {
        const int buf = j & 1;
        if (j + 1 < ntile) gload(j + 1);
        const bool loc = j < nloc;
        if (j == nloc) {
#pragma unroll
            for (int ks = 0; ks < KS; ++ks) qc[ks] = qraw[ks]; }
        const LAS bf16* kb = Ks + buf * TK * KP; const LAS bf16* vb = Vt + buf * 64 * VP;
        f32x4 s[NKB];
#pragma unroll
        for (int kk = 0; kk < NKB; ++kk) { s[kk] = (f32x4){0.f, 0.f, 0.f, 0.f};
#pragma unroll
            for (int ks = 0; ks < KS; ++ks) { const bf16x8 af = *(const LAS bf16x8*)(kb + (kk * 16 + fr) * KP + ks * 32 + g * 8);
                s[kk] = __builtin_amdgcn_mfma_f32_16x16x32_bf16(af, qc[ks], s[kk], 0, 0, 0); } }
        if (S.window && loc) {
            const int kp0 = (S.lo + j) * TK + g * 4;
#pragma unroll
            for (int kk = 0; kk < NKB; ++kk)
#pragma unroll
                for (int i = 0; i < 4; ++i) { const int d = kp0 + kk * 16 + i - qpos; if (d > 128 || d < -128) s[kk][i] = -INFINITY; }
        }
        float mx = -INFINITY;
#pragma unroll
        for (int kk = 0; kk < NKB; ++kk) mx = fmaxf(mx, fmaxf(fmaxf(s[kk][0], s[kk][1]), fmaxf(s[kk][2], s[kk][3])));
        mx = fmaxf(mx, shx(mx, 16, lane)); mx = fmaxf(mx, shx(mx, 32, lane));
        const float mn = fmaxf(m, mx), alpha = __builtin_amdgcn_exp2f(m - mn);
        m = mn;
        float ls = 0.f;
#pragma unroll
        for (int kk = 0; kk < NKB; ++kk)
#pragma unroll
            for (int i = 0; i < 4; ++i) { const float p = __builtin_amdgcn_exp2f(s[kk][i] - mn); s[kk][i] = p; ls += p; }
        l = l * alpha + ls;
#pragma unroll
        for (int d = 0; d < 4; ++d) o[d] = o[d] * alpha;
        bf16x8 pf[NPP];
#pragma unroll
        for (int pp = 0; pp < NPP; ++pp) {
            const unsigned w0 = pk2(s[2 * pp][0], s[2 * pp][1]), w1 = pk2(s[2 * pp][2], s[2 * pp][3]), w2 = pk2(s[2 * pp + 1][0], s[2 * pp + 1][1]), w3 = pk2(s[2 * pp + 1][2], s[2 * pp + 1][3]);
            pf[pp] = __builtin_bit_cast(bf16x8, (u32x4){w0, w1, w2, w3});
        }
#pragma unroll
        for (int d = 0; d < 4; ++d)
#pragma unroll
            for (int pp = 0; pp < NPP; ++pp) {
                const LAS bf16* vr = vb + (d * 16 + fr) * VP + pp * 32 + g * 4;
                const u32x2 lo = *(const LAS u32x2*)vr, hi = *(const LAS u32x2*)(vr + 16);
                const bf16x8 af = __builtin_bit_cast(bf16x8, (u32x4){lo.x, lo.y, hi.x, hi.y});
                o[d] = __builtin_amdgcn_mfma_f32_16x16x32_bf16(af, pf[pp], o[d], 0, 0, 0);
            }
        if (j + 1 < ntile) lstore(buf ^ 1);
        __syncthreads();
    }
    float lt = l + shx(l, 16, lane); lt += shx(lt, 32, lane);
    const float inv = 1.f / lt;
    bf16* yr = S.Y + (size_t)(S.rowbase + qpos) * DM + S.outcol + g * 4;
#pragma unroll
    for (int d = 0; d < 4; ++d) st4bf(yr + d * 16, o[d] * inv);
}

struct AttnBufs { const bf16 *MQKV, *KPE, *Qc_rot, *Qc_raw, *Kc, *Vc, *Qd_rot, *Qd_raw, *Kd, *Vd; bf16* YCAT; const float* sink; const float* rope; unsigned* ctr; };
constexpr int ATT_NU = 384 + 768;
__device__ __forceinline__ void attn_phase(const AttnBufs& B, LAS unsigned char* lds, int tid, int lane, int wave) {
    volatile LAS unsigned* shu = (volatile LAS unsigned*)(lds + LDS_CTL);
    for (;;) {
        if (tid == 0) *shu = atomicAdd(B.ctr, 1u);
        __syncthreads();
        const int u = (int)*shu;
        if (u >= ATT_NU) break;
        int type, b, h, qt; bool samp;
        if (u < 384) { type = u >> 7; const int v = u & 127; b = v >> 6; h = (v >> 4) & 3; qt = v & 15; samp = true; }
        else { const int w = u - 384; type = w >> 8; const int v = w & 255; b = v >> 3; h = (v >> 1) & 3; qt = v & 1; samp = false; }
        AttnSrc S;
        S.samp = samp; S.q0 = qt * 128; S.rope = B.rope; S.Y = B.YCAT;
        S.krbase = samp ? NPR + b * 2560 : b * 256; S.rowbase = samp ? NPR + b * 2048 : b * 256;
        S.window = false; S.sink = false; S.m0 = -1e30f;
        if (!samp) { S.lo = 0; S.hi = 2; S.nctx = 0; }
        else { S.lo = 0; S.hi = 16; S.nctx = 4; }
        if (type == 0) {
            S.Qraw = B.MQKV + h * 96; S.Qrot = S.Qraw; S.qpitch = 1024; S.K0 = B.MQKV + 384 + h * 128; S.k0pitch = 1024; S.K1 = B.KPE; S.V = B.MQKV + 384 + h * 128 + 64; S.vpitch = 1024; S.outcol = 256 + h * 64;
            attn_unit<96>(S, lds, tid, lane, wave);
        } else {
            if (type == 1) { S.Qraw = B.Qc_raw + h * 64; S.Qrot = B.Qc_rot + h * 64; S.K0 = B.Kc + (h >> 1) * 64; S.V = B.Vc + (h >> 1) * 64; S.outcol = 512 + h * 64; }
            else { S.Qraw = B.Qd_raw + h * 64; S.Qrot = B.Qd_rot + h * 64; S.K0 = B.Kd + (h >> 1) * 64; S.V = B.Vd + (h >> 1) * 64; S.outcol = 768 + h * 64;
                   S.sink = true; S.m0 = B.sink[h] * LOG2E;
                   if (samp) { S.window = true; const int lo = S.q0 / 128 - 1; S.lo = lo < 0 ? 0 : lo; const int hi = S.q0 / 128 + 2; S.hi = hi > 16 ? 16 : hi; } }
            S.qpitch = 256; S.k0pitch = 128; S.K1 = nullptr; S.vpitch = 128;
            attn_unit<64>(S, lds, tid, lane, wave);
        }
    }
}

__device__ __forceinline__ void load8(const bf16* p, float (&o)[8]) { const u32x4 u = *(const u32x4*)p; o[0] = bflo(u.x); o[1] = bfhi(u.x); o[2] = bflo(u.y); o[3] = bfhi(u.y); o[4] = bflo(u.z); o[5] = bfhi(u.z); o[6] = bflo(u.w); o[7] = bfhi(u.w); }
__device__ __forceinline__ void convgate_phase(const bf16* U, const float* cf, bf16* ACT, int gt, int NGT) {
    constexpr int NCH = DFF / 8, RG = 8;
    for (int it = gt; it < (NTOK / RG) * NCH; it += NGT) {
        const int rg = it / NCH, cc = it % NCH, r0 = rg * RG, col = cc * 8;
        const bool samp = r0 >= NPR; const int t0 = samp ? ((r0 - NPR) & 2047) : (r0 & 255), T = samp ? 2048 : 256;
        const bf16* up = U + (size_t)r0 * DUP + col;
        u32x4 ra[RG + 2], rb[RG + 2];
        const u32x4 z4 = (u32x4){0u, 0u, 0u, 0u};
        ra[0] = z4; rb[0] = z4; ra[RG + 1] = z4; rb[RG + 1] = z4;
        if (t0 > 0) { ra[0] = *(const u32x4*)(up - DUP); rb[0] = *(const u32x4*)(up - DUP + DFF); }
#pragma unroll
        for (int i = 0; i < RG; ++i) { ra[i + 1] = *(const u32x4*)(up + (size_t)i * DUP); rb[i + 1] = *(const u32x4*)(up + (size_t)i * DUP + DFF); }
        if (t0 + RG < T) { ra[RG + 1] = *(const u32x4*)(up + (size_t)RG * DUP); rb[RG + 1] = *(const u32x4*)(up + (size_t)RG * DUP + DFF); }
        float wa[3][8], wb[3][8];
#pragma unroll
        for (int k = 0; k < 3; ++k) { const f32x4 a0 = *(const f32x4*)(cf + k * DUP + col), a1 = *(const f32x4*)(cf + k * DUP + col + 4), b0 = *(const f32x4*)(cf + k * DUP + DFF + col), b1 = *(const f32x4*)(cf + k * DUP + DFF + col + 4);
#pragma unroll
            for (int e = 0; e < 4; ++e) { wa[k][e] = a0[e]; wa[k][4 + e] = a1[e]; wb[k][e] = b0[e]; wb[k][4 + e] = b1[e]; } }
#pragma unroll
        for (int i = 0; i < RG; ++i) {
            float r[8];
#pragma unroll
            for (int h = 0; h < 4; ++h) {
                const unsigned pa = ra[i][h], ca = ra[i + 1][h], na = ra[i + 2][h], pb = rb[i][h], cb = rb[i + 1][h], nb = rb[i + 2][h];
                const float xa0 = wa[0][2 * h] * bflo(pa) + wa[1][2 * h] * bflo(ca) + wa[2][2 * h] * bflo(na), xb0 = wb[0][2 * h] * bflo(pb) + wb[1][2 * h] * bflo(cb) + wb[2][2 * h] * bflo(nb);
                const float xa1 = wa[0][2 * h + 1] * bfhi(pa) + wa[1][2 * h + 1] * bfhi(ca) + wa[2][2 * h + 1] * bfhi(na), xb1 = wb[0][2 * h + 1] * bfhi(pb) + wb[1][2 * h + 1] * bfhi(cb) + wb[2][2 * h + 1] * bfhi(nb);
                r[2 * h] = xa0 * __builtin_amdgcn_rcpf(1.f + __builtin_amdgcn_exp2f(-xa0 * LOG2E)) * xb0;
                r[2 * h + 1] = xa1 * __builtin_amdgcn_rcpf(1.f + __builtin_amdgcn_exp2f(-xa1 * LOG2E)) * xb1;
            }
            u32x4 w; w.x = pk2(r[0], r[1]); w.y = pk2(r[2], r[3]); w.z = pk2(r[4], r[5]); w.w = pk2(r[6], r[7]);
            *(u32x4*)(ACT + (size_t)(r0 + i) * DFF + col) = w;
        }
    }
}

#define XB_TMO      128
#define XB_XCNT(j)  (256  + 64 * (j))
#define XB_XSUB(j)  (1280 + 64 * (j))
#define XB_XGEN(j)  (2304 + 64 * (j))
#define XB_TOP      3328
#define XB_TOPGEN   3392
#define XCD_BAR_WORDS 3456
#define XB_SPIN_CAP (1u << 20)
__device__ __forceinline__ unsigned xb_ld(unsigned* p)              { return __hip_atomic_load(p, __ATOMIC_RELAXED, __HIP_MEMORY_SCOPE_AGENT); }
__device__ __forceinline__ unsigned xb_add(unsigned* p, unsigned v) { return __hip_atomic_fetch_add(p, v, __ATOMIC_RELAXED, __HIP_MEMORY_SCOPE_AGENT); }
__device__ __forceinline__ unsigned xb_xcc_id() { return (unsigned)__builtin_amdgcn_s_getreg((3 << 11) | 20) & 0xFu; }
#define XB_SPIN(cond, bar) do { unsigned _sp = 0; while (cond) { __builtin_amdgcn_s_sleep(1); \
    if ((++_sp & 255u) == 0u) { if (xb_ld(&(bar)[XB_TMO])) break; if (_sp > XB_SPIN_CAP) { atomicAdd(&(bar)[XB_TMO], 1u); break; } } } } while (0)
struct XcdBarrier { unsigned* bar; unsigned x; volatile LAS unsigned* st; };
__device__ __forceinline__ void xcd_barrier_complete(unsigned* bar, unsigned x, unsigned& nloc, unsigned& nx) {
    const unsigned G = gridDim.x * gridDim.y * gridDim.z;
    unsigned sum, cnt, mine, sp = 0u;
    for (;;) {
        sum = 0u; cnt = 0u; mine = 0u;
#pragma unroll
        for (unsigned j = 0; j < 16; ++j) { const unsigned c = xb_ld(&bar[XB_XCNT(j)]); sum += c; cnt += (c > 0u) ? 1u : 0u; mine = (j == x) ? c : mine; }
        if (sum == G) break;
        __builtin_amdgcn_s_sleep(1);
        if ((++sp & 255u) == 0u) { if (xb_ld(&bar[XB_TMO])) break; if (sp > XB_SPIN_CAP) { atomicAdd(&bar[XB_TMO], 1u); break; } }
    }
    nloc = mine > 0u ? mine : 1u; nx = cnt > 0u ? cnt : 1u;
}
__device__ __forceinline__ void xcd_barrier(const XcdBarrier& b, const int tid_) {
    asm volatile("s_waitcnt vmcnt(0)" ::: "memory");
    __syncthreads();
    if (tid_ == 0) {
        unsigned* bar = b.bar;
        __builtin_amdgcn_s_waitcnt(0);
        unsigned nloc = b.st[0], nx = b.st[1];
        if (nloc == 0u) { xcd_barrier_complete(bar, b.x, nloc, nx); b.st[0] = nloc; b.st[1] = nx; }
        const unsigned old = xb_add(&bar[XB_XSUB(b.x)], 1u);
        const unsigned gen = old / nloc;
        if (old + 1u == (gen + 1u) * nloc) {
            __builtin_amdgcn_fence(__ATOMIC_RELEASE, "agent");
            asm volatile("s_waitcnt vmcnt(0)" ::: "memory");
            const unsigned og = xb_add(&bar[XB_TOP], 1u);
            const unsigned tg = og / nx;
            if (og + 1u == (tg + 1u) * nx) xb_add(&bar[XB_TOPGEN], 1u);
            else XB_SPIN(xb_ld(&bar[XB_TOPGEN]) == tg, bar);
            __builtin_amdgcn_fence(__ATOMIC_ACQUIRE, "agent");
            xb_add(&bar[XB_XGEN(b.x)], 1u);
            asm volatile("s_waitcnt vmcnt(0)" ::: "memory");
        } else {
            XB_SPIN(xb_ld(&bar[XB_XGEN(b.x)]) == gen, bar);
            __builtin_amdgcn_fence(__ATOMIC_ACQUIRE, "agent");
            asm volatile("s_waitcnt vmcnt(0)" ::: "memory");
        }
    }
    __syncthreads();
}

__device__ __forceinline__ int lane_id_volatile() { int l; asm volatile("v_mbcnt_lo_u32_b32 %0, -1, 0\n\tv_mbcnt_hi_u32_b32 %0, -1, %0" : "=v"(l)); return l; }

#ifndef PH
#define PH 0xFFFF
#endif
#define ON(k) ((PH >> (k)) & 1)
#ifndef REP
#define REP 0
#endif
#define NREP(k) (1 + ((REP >> (k)) & 1))
__global__ void __launch_bounds__(NT, 2) mega_fwd(Args a_unused) {
    extern __shared__ __attribute__((aligned(16))) unsigned char lds[];
    cg::grid_group grid = cg::this_grid();
    const int G = gridDim.x, bid = blockIdx.x;
    const int wave_s = __builtin_amdgcn_readfirstlane(threadIdx.x >> 6);
    PG8_LAS unsigned char* ring = (PG8_LAS unsigned char*)lds;
#define PHASE_BEGIN int tid = wave_s * 64 + lane_id_volatile(); asm volatile("" : "+v"(tid)); const CAS Args* ap_ = (const CAS Args*)__builtin_amdgcn_kernarg_segment_ptr(); asm volatile("" : "+s"(ap_)); const CAS Args& a = *ap_; unsigned char* ws = a.ws; float* out = a.out; \
    const int lane = tid & 63, wave = __builtin_amdgcn_readfirstlane(tid >> 6); const int gw = bid * NW + wave, NGW = G * NW, gt = bid * NT + tid, NGT = G * NT; \
    (void)lane; (void)wave; (void)gw; (void)NGW; (void)gt; (void)NGT; (void)out; \
    const float* mod = (const float*)(ws + WS_MOD); const float* rope = (const float*)(ws + WS_ROPE); (void)mod; (void)rope; \
    bf16* XN = (bf16*)(ws + WS_XN); bf16* PROJ = (bf16*)(ws + WS_PROJ); bf16* A2 = (bf16*)(ws + WS_A2); bf16* MQKV = (bf16*)(ws + WS_MQKV); \
    bf16* KPE = (bf16*)(ws + WS_KPE); bf16* YCAT = (bf16*)(ws + WS_YCAT); bf16* ACT = (bf16*)(ws + WS_ACT); bf16* U = (bf16*)(ws + WS_U); \
    bf16* Qc_rot = (bf16*)(ws + WS_QC); bf16* Qc_raw = (bf16*)(ws + WS_QC + QSZ); bf16* Kc = (bf16*)(ws + WS_QC + 2 * QSZ); bf16* Vc = (bf16*)(ws + WS_QC + 2 * QSZ + KSZ); \
    bf16* Qd_rot = (bf16*)(ws + WS_QC + 2 * QSZ + 2 * KSZ); bf16* Qd_raw = Qd_rot + (size_t)NKR * 256; bf16* Kd = Qd_raw + (size_t)NKR * 256; bf16* Vd = Kd + (size_t)NKR * 128; \
    (void)XN; (void)PROJ; (void)A2; (void)MQKV; (void)KPE; (void)YCAT; (void)ACT; (void)U; (void)Qc_rot; (void)Qc_raw; (void)Kc; (void)Vc; (void)Qd_rot; (void)Qd_raw; (void)Kd; (void)Vd;
#define GSYNC() do { const CAS Args* bp_ = (const CAS Args*)__builtin_amdgcn_kernarg_segment_ptr(); asm volatile("" : "+s"(bp_)); XcdBarrier xb_; xb_.bar = (unsigned*)(bp_->ws + WS_BAR); xb_.x = xb_xcc_id(); \
    xb_.st = (volatile LAS unsigned*)((LAS unsigned char*)lds + LDS_CTL + 32); xcd_barrier(xb_, wave_s * 64 + lane_id_volatile()); } while (0)
#define LAYER_VALS const float* modl = mod + (size_t)l * 3 * 6144; unsigned char* wl = ws + WS_W + l * W_LSTRIDE; (void)modl; (void)wl; \
    const float* x0 = l == 0 ? a.in[0] : nullptr; const float* x1 = l == 0 ? a.in[1] : nullptr; (void)x0; (void)x1; bf16* XRES = (bf16*)(ws + WS_XRES); (void)XRES;

    if (threadIdx.x < 16) ((volatile LAS unsigned*)((LAS unsigned char*)lds + LDS_CTL))[threadIdx.x] = 0u;
    __syncthreads();
    { PHASE_BEGIN if (tid == 0) (void)xb_add((unsigned*)(ws + WS_BAR) + XB_XCNT(xb_xcc_id()), 1u);
      if (ws == nullptr) grid.sync(); }
    for (int rep = 0; rep < NREP(0); ++rep) {
    if (ON(0)) { PHASE_BEGIN phase0(a, (LAS unsigned char*)lds, tid, lane, wave); }
    GSYNC(); }

    if (ON(1)) { PHASE_BEGIN
        if (G > 124) {
            if (bid < 62) bias_phase(a, ws, (LAS unsigned char*)lds, tid, lane, wave);
            else prep_phase(a.in[0], a.in[1], a.in[12], mod, 1024, XN, (float*)(ws + WS_SS1), lane, (bid - 62) * NW + wave, (G - 62) * NW);
        } else { bias_phase(a, ws, (LAS unsigned char*)lds, tid, lane, wave);
            prep_phase(a.in[0], a.in[1], a.in[12], mod, 1024, XN, (float*)(ws + WS_SS1), lane, gw, NGW); } }
    GSYNC();
#pragma unroll
    for (int l = 0; l < 2; ++l) {
        for (int rep = 0; rep < NREP(2); ++rep) {
        if (ON(2)) { PHASE_BEGIN LAYER_VALS pg8::Gemm g{XN, (const bf16*)(wl + W_IN), NTOK, INP, DM, 0, 0}; pg8::StaticOrder S; S.init(NTOK, INP, G, bid);
          pg8::EpiBf16RS E{PROJ, INP, (const float*)(ws + WS_SS1), (const float*)(ws + WS_BIAS) + (size_t)l * 3 * NBIAS, NBIAS};
          pg8::gemm_phase<pg8::EpiBf16RS, pg8::StaticOrder, true, true>(ring, g, S, E, tid); }
        GSYNC(); }
        for (int rep = 0; rep < NREP(3); ++rep) {
        if (ON(3)) { PHASE_BEGIN P3Ptrs P; P.PROJ = PROJ; P.A2 = A2; P.KPE = KPE; P.YCAT = YCAT; P.Qc_rot = Qc_rot; P.Qc_raw = Qc_raw; P.Kc = Kc; P.Vc = Vc; P.Qd_rot = Qd_rot; P.Qd_raw = Qd_raw; P.Kd = Kd; P.Vd = Vd;
          P.conv_a = a.in[14]; P.gq_mla = a.in[15]; P.gkv_mla = a.in[17]; P.gq = a.in[19]; P.gk = a.in[20]; P.rope = rope;
          P.c_ckv = a.in[2]; P.c_kpe = a.in[3]; P.c_gk = a.in[4]; P.c_gv = a.in[5]; P.c_sk = a.in[6]; P.c_sv = a.in[7];
          P.o_ckv = out + 12582912; P.o_kpe = out + 14680064; P.o_gk = out + 15204352; P.o_gv = out + 17301504; P.o_sk = out + 19398656; P.o_sv = out + 21495808; P.l = l;
          p3_phase(P, lane, gw, NGW); }
        GSYNC(); }
        for (int rep = 0; rep < NREP(4); ++rep) {
        if (ON(4)) { PHASE_BEGIN LAYER_VALS pg8::Gemm g{A2, (const bf16*)(wl + W_B2), NKR, 1024, 384, 0, 0}; pg8::StaticOrder S; S.init(NKR, 1024, G, bid); pg8::EpiBf16 E{MQKV, 1024};
          pg8::gemm_phase<pg8::EpiBf16, pg8::StaticOrder, true, true>(ring, g, S, E, tid); }
        GSYNC(); }
        for (int rep = 0; rep < NREP(5); ++rep) {
        if (ON(5)) { PHASE_BEGIN AttnBufs B; B.MQKV = MQKV; B.KPE = KPE; B.Qc_rot = Qc_rot; B.Qc_raw = Qc_raw; B.Kc = Kc; B.Vc = Vc; B.Qd_rot = Qd_rot; B.Qd_raw = Qd_raw; B.Kd = Kd; B.Vd = Vd; B.YCAT = YCAT;
          B.sink = a.in[21] + l * 4; B.rope = rope; B.ctr = (unsigned*)(ws + WS_CTL) + 64 * l + 128 * rep;
          attn_phase(B, (LAS unsigned char*)lds, tid, lane, wave); }
        GSYNC(); }
        if (ON(6)) { PHASE_BEGIN LAYER_VALS pg8::Gemm g{YCAT, (const bf16*)(wl + W_OUT), NTOK, DM, DM, 0, 0}; pg8::StaticOrder S; S.init(NTOK, DM, G, bid);
          pg8::EpiResid E{x0, x1, XRES, modl + 2048, XN, (float*)(ws + WS_SS2), a.in[23] + l * DM, modl + 4096};
          pg8::gemm_phase<pg8::EpiResid, pg8::StaticOrder, true, true>(ring, g, S, E, tid);
          if (l == 0) { const int wk = G > 192 ? bid - 192 : bid, nwk = G > 192 ? G - 192 : G;
            if (wk >= 0) wconv(a, ws, 0, 4 | 8, wk * NW + wave, nwk * NW, (LAS float*)((LAS unsigned char*)lds + wave * 16640), lane); } }
        GSYNC();
        for (int rep = 0; rep < NREP(8); ++rep) {
        if (ON(8)) { PHASE_BEGIN LAYER_VALS pg8::Gemm g{XN, (const bf16*)(wl + W_UP), NTOK, DUP, DM, (size_t)128 * DM * 2, (size_t)DFF * DM * 2}; pg8::StaticOrder S; S.init(NTOK, DUP, G, bid);
          pg8::EpiUpGate E{ACT, (const float*)(ws + WS_SS2), (const float*)(ws + WS_BIAS) + (size_t)l * 3 * NBIAS + 2304, NBIAS, a.in[25] + (size_t)l * 3 * DUP, (float*)(ws + WS_HALO), ring + 131072};
          pg8::gemm_phase<pg8::EpiUpGate, pg8::StaticOrder, true, true>(ring, g, S, E, tid); }
        GSYNC(); }
        if (ON(10)) { PHASE_BEGIN LAYER_VALS pg8::Gemm g{ACT, (const bf16*)(wl + W_DOWN), NTOK, DM, DFF, 0, 0}; pg8::StaticOrder S; S.init(NTOK, DM, G, bid);
          {
            const float* cwl = a.in[25] + (size_t)l * 3 * DUP; const float* HALO = (const float*)(ws + WS_HALO); pg8::Unit hu;
            bool fixed = false;
            for (int ui = 0; S.next(ui, hu); ++ui) { if (hu.pm < 32) continue; fixed = true; const int k = hu.pm - 32, pos = k & 7;
                for (int idx = tid; idx < 2 * DFF; idx += NT) { const int which = idx >= DFF ? 1 : 0, j = idx - which * DFF;
                    if (which == 0 ? pos == 0 : pos == 7) continue;
                    const float* Pp = HALO + (size_t)(k * 4 + (which ? 3 : 1)) * DUP; const float* Ep = HALO + (size_t)((which ? k + 1 : k - 1) * 4 + (which ? 0 : 2)) * DUP; const float* wp = cwl + (which ? 2 : 0) * DUP;
                    const float ca = Pp[j] + wp[j] * Ep[j], cb = Pp[DFF + j] + wp[DFF + j] * Ep[DFF + j];
                    const float r = ca * __builtin_amdgcn_rcpf(1.f + __builtin_amdgcn_exp2f(-ca * LOG2E)) * cb;
                    ACT[(size_t)(hu.pm * 256 + (which ? 255 : 0)) * DFF + j] = (bf16)(pk2(r, r) & 0xffffu); } }
            if (fixed) { asm volatile("s_waitcnt vmcnt(0)" ::: "memory"); __syncthreads();
                if (tid == 0) { __builtin_amdgcn_fence(__ATOMIC_RELEASE, "agent"); __builtin_amdgcn_fence(__ATOMIC_ACQUIRE, "agent"); asm volatile("s_waitcnt vmcnt(0)" ::: "memory"); }
                __syncthreads(); } }
          if (l == 1 && G >= 192) {
            pg8::EpiResidFinal E{XRES, out, modl + 5120, (float*)(ws + WS_SS1), a.in[27], (unsigned*)(ws + WS_CTL) + 2048};
            pg8::gemm_phase<pg8::EpiResidFinal, pg8::StaticOrder, true, true>(ring, g, S, E, tid);
          } else {
          pg8::EpiResid E{nullptr, nullptr, XRES, modl + 5120, l == 0 ? XN : nullptr, (float*)(ws + WS_SS1), a.in[12] + DM, mod + (size_t)3 * 6144 + 1024};
          pg8::gemm_phase<pg8::EpiResid, pg8::StaticOrder, true, true>(ring, g, S, E, tid); }
          if (l == 0) { const int wk = G > 192 ? bid - 192 : bid, nwk = G > 192 ? G - 192 : G;
            if (wk >= 0) wconv(a, ws, 1, 63, wk * NW + wave, nwk * NW, (LAS float*)((LAS unsigned char*)lds + wave * 16640), lane); } }
        if (!(l == 1 && G >= 192)) GSYNC();
    }
#ifdef XSYNC
    for (int i = 0; i < XSYNC; ++i) GSYNC();
#endif
    if (G < 192) { PHASE_BEGIN
    const bf16* XRES = (const bf16*)(ws + WS_XRES);
    for (int row = gw; row < NTOK; row += NGW) {
        float* xr = out + (size_t)row * DM;
        f32x4 v[4]; float ss = 0.f;
#pragma unroll
        for (int j = 0; j < 4; ++j) { v[j] = ld4bf(XRES + (size_t)row * DM + 4 * (lane + 64 * j)); ss += dot4(v[j]); }
        const float rs = rsqrtf(wave_sum(ss, lane) * (1.f / DM) + EPS);
#pragma unroll
        for (int j = 0; j < 4; ++j) { const int col = 4 * (lane + 64 * j); *(f32x4*)(xr + col) = v[j] * rs * *(const f32x4*)(a.in[27] + col); }
    } }
}

extern "C" void kernel_launch(void* const* d_in, const int* in_sizes, int n_in, void* d_out, int out_size, void* d_ws, size_t ws_size, hipStream_t stream) {
    static int grid = 0;
    if (grid == 0) {
        if (n_in != 28 || ws_size < WS_END) { fprintf(stderr, "kernel_launch: unexpected n_in %d / ws %zu\n", n_in, ws_size); grid = -1; return; }
        int dev = 0, cus = 0, per_cu = 0;
        hipGetDevice(&dev); hipDeviceGetAttribute(&cus, hipDeviceAttributeMultiprocessorCount, dev);
        hipFuncSetAttribute((const void*)mega_fwd, hipFuncAttributeMaxDynamicSharedMemorySize, LDS_BYTES);
        hipOccupancyMaxActiveBlocksPerMultiprocessor(&per_cu, (const void*)mega_fwd, NT, LDS_BYTES);
        if (per_cu < 1) per_cu = 1;
        grid = cus * per_cu;
        (void)hipGetLastError();
    }
    if (grid < 0) return;
    if (hipMemsetAsync((char*)d_ws + WS_BAR, 0, XCD_BAR_WORDS * 4, stream) != hipSuccess) { fprintf(stderr, "kernel_launch: memset of the barrier words failed\n"); return; }
    Args a{};
    for (int i = 0; i < 28; ++i) a.in[i] = (const float*)d_in[i];
    a.out = (float*)d_out; a.ws = (unsigned char*)d_ws;
    void* args[] = {&a};
    hipError_t e = hipLaunchCooperativeKernel((const void*)mega_fwd, dim3(grid), dim3(NT), args, LDS_BYTES, stream);
    if (e != hipSuccess) fprintf(stderr, "cooperative launch failed: %s (grid %d)\n", hipGetErrorString(e), grid);
}
```

```cpp
#include <hip/hip_runtime.h>
#include <hip/hip_cooperative_groups.h>
#include <cstdio>
#include <cstdint>
namespace cg = cooperative_groups;

namespace pg8 {
#define PG8_LAS __attribute__((address_space(3)))
typedef unsigned short bf16_t;
typedef short bf16x8 __attribute__((ext_vector_type(8)));
typedef float f32x4 __attribute__((ext_vector_type(4)));
typedef unsigned u32x4 __attribute__((ext_vector_type(4)));
constexpr int BM = 256, BK = 64, HALF = 128, HTB = HALF * BK * 2, STAGE_BYTES = 8 * HTB, NXCD = 8, WGM = 8;

__host__ __device__ __forceinline__ int lds_byte(int r, int c) { const int st = (r >> 4) * 2 + (c >> 5), rr = r & 15, cc = c & 31, ob = rr * 64 + cc * 2; return st * 1024 + (ob ^ (((ob >> 9) & 1) << 5)); }
__host__ __device__ __forceinline__ void stage_rc(int b, int& R, int& C) { const int st = b / 1024, sb = b % 1024, swz = sb ^ (((sb >> 9) & 1) << 5); R = (st >> 1) * 16 + swz / 64; C = (st & 1) * 32 + (swz % 64) / 2; }
__host__ __device__ __forceinline__ int perm32(int rho) { const int n = rho >> 4, i = rho & 15; return 8 * (i >> 2) + 4 * n + (i & 3); }

struct Unit { int pm, pn; };
struct Gemm { const bf16_t* A; const bf16_t* Bt; int M, N, K; size_t bstep, bhalf; };

struct StaticOrder {
    int nM, nN, nwg, G, c;
    __host__ __device__ __forceinline__ void init(int M, int N, int G_, int c_) { nM = M / BM; nN = N / BM; nwg = nM * nN; G = G_; c = c_; }
    __host__ __device__ __forceinline__ bool next(int i, Unit& u) const {
        const long L = (long)i * G + c; if (L >= nwg) return false;
        int wgid = (int)L; { const int q = nwg / NXCD, r = nwg % NXCD, xcd = wgid % NXCD, off = wgid / NXCD; wgid = (xcd < r ? xcd * (q + 1) : r * (q + 1) + (xcd - r) * q) + off; }
        const int nig = WGM * nN, gid = wgid / nig, fm = gid * WGM, gsz = (nM - fm) < WGM ? (nM - fm) : WGM;
        u.pm = fm + ((wgid % nig) % gsz); u.pn = (wgid % nig) / gsz; return true;
    }
    __device__ __forceinline__ void a_ready(const Unit&) const {}
    __device__ __forceinline__ void done(const Unit&) const {}
};

__device__ __forceinline__ unsigned cvt_pk_bf16(float lo, float hi) { unsigned r; asm volatile("v_cvt_pk_bf16_f32 %0, %1, %2" : "=v"(r) : "v"(lo), "v"(hi)); return r; }

struct EpiBf16 {
    static constexpr bool PERM = true, AFTER_DRAIN = false;
    bf16_t* O; int ldc;
    __device__ __forceinline__ void operator()(const f32x4 (&acc)[2][2][4][2], const Unit& u, int wr, int wc, int fr, int fq) const {
        asm volatile("" : "+v"(fr), "+v"(fq));
        const int row0 = u.pm * BM + wr * 64 + fr; const int col0 = u.pn * BM + wc * 32 + 8 * fq;
#pragma unroll
        for (int ai = 0; ai < 2; ++ai)
#pragma unroll
            for (int m = 0; m < 4; ++m) { bf16_t* rowp = O + (size_t)(row0 + ai * HALF + m * 16) * ldc + col0;
#pragma unroll
                for (int bj = 0; bj < 2; ++bj) { const f32x4 v0 = acc[ai][bj][m][0], v1 = acc[ai][bj][m][1];
                    u32x4 w; w.x = cvt_pk_bf16(v0[0], v0[1]); w.y = cvt_pk_bf16(v0[2], v0[3]); w.z = cvt_pk_bf16(v1[0], v1[1]); w.w = cvt_pk_bf16(v1[2], v1[3]);
                    *(u32x4*)(rowp + bj * HALF) = w; } }
    }
};
__device__ __forceinline__ float shx_(float v, int m, int lane) { return __builtin_bit_cast(float, __builtin_amdgcn_ds_bpermute((lane ^ m) << 2, __builtin_bit_cast(int, v))); }
__device__ __forceinline__ void row_scales(const float* SS, int row0, int fr, int fq, float (&rs)[8]) {
    f32x4 t[8];
#pragma unroll
    for (int q = 0; q < 8; ++q) t[q] = *(const f32x4*)(SS + (size_t)(row0 + (q >> 2) * HALF + (q & 3) * 16) * 16 + 4 * fq);
    const int lane = fq * 16 + fr;
#pragma unroll
    for (int q = 0; q < 8; ++q) { float v = (t[q][0] + t[q][1]) + (t[q][2] + t[q][3]); v += shx_(v, 16, lane); v += shx_(v, 32, lane); rs[q] = __builtin_amdgcn_rsqf(v * (1.f / 1024.f) + 1e-6f); }
}
struct EpiBf16RS {
    static constexpr bool PERM = true, AFTER_DRAIN = false;
    bf16_t* O; int ldc; const float* SS; const float* bias; int ldb;
    __device__ __forceinline__ void operator()(const f32x4 (&acc)[2][2][4][2], const Unit& u, int wr, int wc, int fr, int fq) const {
        asm volatile("" : "+v"(fr), "+v"(fq));
        const int cnd = u.pm < 32 ? 0 : 1 + ((u.pm - 32) >> 3);
        const int row0 = u.pm * BM + wr * 64 + fr; const int col0 = u.pn * BM + wc * 32 + 8 * fq;
        const float* bp = bias + (size_t)cnd * ldb + col0;
        f32x4 bv[2][2];
#pragma unroll
        for (int bj = 0; bj < 2; ++bj)
#pragma unroll
            for (int n = 0; n < 2; ++n) bv[bj][n] = *(const f32x4*)(bp + bj * HALF + 4 * n);
        float rsv[8]; row_scales(SS, row0, fr, fq, rsv);
#pragma unroll
        for (int ai = 0; ai < 2; ++ai)
#pragma unroll
            for (int m = 0; m < 4; ++m) { const int row = row0 + ai * HALF + m * 16; const float rs = rsv[ai * 4 + m];
                bf16_t* rowp = O + (size_t)row * ldc + col0;
#pragma unroll
                for (int bj = 0; bj < 2; ++bj) { const f32x4 v0 = acc[ai][bj][m][0] * rs + bv[bj][0], v1 = acc[ai][bj][m][1] * rs + bv[bj][1];
                    u32x4 w; w.x = cvt_pk_bf16(v0[0], v0[1]); w.y = cvt_pk_bf16(v0[2], v0[3]); w.z = cvt_pk_bf16(v1[0], v1[1]); w.w = cvt_pk_bf16(v1[2], v1[3]);
                    *(u32x4*)(rowp + bj * HALF) = w; } }
    }
};
struct EpiResid {
    static constexpr bool PERM = false, AFTER_DRAIN = false;
    const float* r0; const float* r1; bf16_t* XR; const float* gate;
    bf16_t* XN; float* SS; const float* nrm; const float* sc;
    __device__ __forceinline__ void operator()(const f32x4 (&acc)[2][2][4][2], const Unit& u, int wr, int wc, int fr, int fq) const {
        asm volatile("" : "+v"(fr), "+v"(fq));
        typedef unsigned u32x2_ __attribute__((ext_vector_type(2)));
        const int cnd = u.pm < 32 ? 0 : 1 + ((u.pm - 32) >> 3);
        const float* gp = gate + cnd * 6144;
        const int col0 = u.pn * BM + wc * 32 + 4 * fq;
        const int rowb = u.pm * BM + wr * 64 + fr;
        const bool inf = r0 != nullptr;
        const float* rs = (u.pm < 32 ? r0 + (size_t)rowb * 1024 : r1 + (size_t)(rowb - 8192) * 1024) + col0;
        bf16_t* op = XR + (size_t)rowb * 1024 + col0;
#define LDX(off) (inf ? *(const f32x4*)(rs + (off)) : ({ const u32x2_ t_ = *(const u32x2_*)(op + (off)); (f32x4){__builtin_bit_cast(float, t_.x << 16), __builtin_bit_cast(float, t_.x & 0xffff0000u), __builtin_bit_cast(float, t_.y << 16), __builtin_bit_cast(float, t_.y & 0xffff0000u)}; }))
        const bool prep = XN != nullptr;
        f32x4 gv[2][2], hv[2][2];
#pragma unroll
        for (int bj = 0; bj < 2; ++bj)
#pragma unroll
            for (int n = 0; n < 2; ++n) { gv[bj][n] = *(const f32x4*)(gp + col0 + bj * HALF + n * 16);
                hv[bj][n] = (f32x4){0.f, 0.f, 0.f, 0.f};
                if (prep) hv[bj][n] = *(const f32x4*)(nrm + col0 + bj * HALF + n * 16) * (1.f + *(const f32x4*)(sc + cnd * 6144 + col0 + bj * HALF + n * 16)); }
        f32x4 xc[2][2], xn[2][2];
#pragma unroll
        for (int bj = 0; bj < 2; ++bj)
#pragma unroll
            for (int n = 0; n < 2; ++n) xc[bj][n] = LDX(bj * HALF + n * 16);
#pragma unroll
        for (int it = 0; it < 8; ++it) { const int ai = it >> 2, m = it & 3; const size_t ro = (size_t)(ai * HALF + m * 16) * 1024;
            if (it < 7) { const int ai2 = (it + 1) >> 2, m2 = (it + 1) & 3; const size_t ro2 = (size_t)(ai2 * HALF + m2 * 16) * 1024;
#pragma unroll
                for (int bj = 0; bj < 2; ++bj)
#pragma unroll
                    for (int n = 0; n < 2; ++n) xn[bj][n] = LDX(ro2 + bj * HALF + n * 16); }
            float ssq = 0.f;
#pragma unroll
            for (int bj = 0; bj < 2; ++bj)
#pragma unroll
                for (int n = 0; n < 2; ++n) { const f32x4 v = xc[bj][n] + gv[bj][n] * acc[ai][bj][m][n];
                    *(u32x2_*)(op + ro + bj * HALF + n * 16) = (u32x2_){cvt_pk_bf16(v[0], v[1]), cvt_pk_bf16(v[2], v[3])};
                    if (prep) { ssq += (v[0] * v[0] + v[1] * v[1]) + (v[2] * v[2] + v[3] * v[3]); const f32x4 h = v * hv[bj][n];
                        unsigned w0 = cvt_pk_bf16(h[0], h[1]), w1 = cvt_pk_bf16(h[2], h[3]);
                        *(u32x2_*)(XN + (size_t)(rowb + ai * HALF + m * 16) * 1024 + col0 + bj * HALF + n * 16) = (u32x2_){w0, w1}; } }
            if (prep) { const int lane = fq * 16 + fr; ssq += shx_(ssq, 16, lane); ssq += shx_(ssq, 32, lane);
                if (fq == 0) SS[(size_t)(rowb + ai * HALF + m * 16) * 16 + u.pn * 4 + wc] = ssq; }
#pragma unroll
            for (int bj = 0; bj < 2; ++bj)
#pragma unroll
                for (int n = 0; n < 2; ++n) xc[bj][n] = xn[bj][n];
        }
    }
#undef LDX
};

struct EpiResidFinal {
    static constexpr bool PERM = false, AFTER_DRAIN = false;
    const bf16_t* res; float* out; const float* gate; float* SS; const float* fw; unsigned* cnt;
    __device__ __forceinline__ void operator()(f32x4 (&acc)[2][2][4][2], const Unit& u, int wr, int wc, int fr, int fq) const {
        asm volatile("" : "+v"(fr), "+v"(fq));
        const int cnd = u.pm < 32 ? 0 : 1 + ((u.pm - 32) >> 3);
        const float* gp = gate + cnd * 6144;
        const int col0 = u.pn * BM + wc * 32 + 4 * fq;
        const int rowb = u.pm * BM + wr * 64 + fr;
        typedef unsigned u32x2_ __attribute__((ext_vector_type(2)));
        const bf16_t* rs = res + (size_t)rowb * 1024 + col0;
#define LDXF(off) ({ const u32x2_ t_ = *(const u32x2_*)(rs + (off)); (f32x4){__builtin_bit_cast(float, t_.x << 16), __builtin_bit_cast(float, t_.x & 0xffff0000u), __builtin_bit_cast(float, t_.y << 16), __builtin_bit_cast(float, t_.y & 0xffff0000u)}; })
        f32x4 gv[2][2];
#pragma unroll
        for (int bj = 0; bj < 2; ++bj)
#pragma unroll
            for (int n = 0; n < 2; ++n) gv[bj][n] = *(const f32x4*)(gp + col0 + bj * HALF + n * 16);
        f32x4 xc[2][2], xn[2][2];
#pragma unroll
        for (int bj = 0; bj < 2; ++bj)
#pragma unroll
            for (int n = 0; n < 2; ++n) xc[bj][n] = LDXF(bj * HALF + n * 16);
#pragma unroll
        for (int it = 0; it < 8; ++it) { const int ai = it >> 2, m = it & 3;
            if (it < 7) { const int ai2 = (it + 1) >> 2, m2 = (it + 1) & 3; const size_t ro2 = (size_t)(ai2 * HALF + m2 * 16) * 1024;
#pragma unroll
                for (int bj = 0; bj < 2; ++bj)
#pragma unroll
                    for (int n = 0; n < 2; ++n) xn[bj][n] = LDXF(ro2 + bj * HALF + n * 16); }
            float ssq = 0.f;
#pragma unroll
            for (int bj = 0; bj < 2; ++bj)
#pragma unroll
                for (int n = 0; n < 2; ++n) { const f32x4 v = xc[bj][n] + gv[bj][n] * acc[ai][bj][m][n]; acc[ai][bj][m][n] = v;
                    ssq += (v[0] * v[0] + v[1] * v[1]) + (v[2] * v[2] + v[3] * v[3]); }
            { const int lane = fq * 16 + fr; ssq += shx_(ssq, 16, lane); ssq += shx_(ssq, 32, lane);
              if (fq == 0) __hip_atomic_store(SS + (size_t)(rowb + ai * HALF + m * 16) * 16 + u.pn * 4 + wc, ssq, __ATOMIC_RELAXED, __HIP_MEMORY_SCOPE_AGENT); }
#pragma unroll
            for (int bj = 0; bj < 2; ++bj)
#pragma unroll
                for (int n = 0; n < 2; ++n) xc[bj][n] = xn[bj][n];
        }
        asm volatile("s_waitcnt vmcnt(0)" ::: "memory"); __builtin_amdgcn_s_barrier(); asm volatile("" ::: "memory");
        if (wr == 0 && wc == 0 && fr == 0 && fq == 0) {
            __builtin_amdgcn_fence(__ATOMIC_RELEASE, "agent"); asm volatile("s_waitcnt vmcnt(0)" ::: "memory");
            __hip_atomic_fetch_add(cnt + u.pm, 1u, __ATOMIC_RELAXED, __HIP_MEMORY_SCOPE_AGENT);
            unsigned sp = 0;
            while (__hip_atomic_load(cnt + u.pm, __ATOMIC_RELAXED, __HIP_MEMORY_SCOPE_AGENT) < 4u) { __builtin_amdgcn_s_sleep(1); if (++sp > (1u << 22)) break; }
            __builtin_amdgcn_fence(__ATOMIC_ACQUIRE, "agent"); asm volatile("s_waitcnt vmcnt(0)" ::: "memory");
        }
        __builtin_amdgcn_s_barrier(); asm volatile("" ::: "memory");
        float rsv[8];
        { f32x4 t[8];
#pragma unroll
          for (int q = 0; q < 8; ++q) { const float* sp = SS + (size_t)(rowb + (q >> 2) * HALF + (q & 3) * 16) * 16 + 4 * fq;
              t[q] = (f32x4){__hip_atomic_load(sp, __ATOMIC_RELAXED, __HIP_MEMORY_SCOPE_AGENT), __hip_atomic_load(sp + 1, __ATOMIC_RELAXED, __HIP_MEMORY_SCOPE_AGENT),
                             __hip_atomic_load(sp + 2, __ATOMIC_RELAXED, __HIP_MEMORY_SCOPE_AGENT), __hip_atomic_load(sp + 3, __ATOMIC_RELAXED, __HIP_MEMORY_SCOPE_AGENT)}; }
          const int lane = fq * 16 + fr;
#pragma unroll
          for (int q = 0; q < 8; ++q) { float v = (t[q][0] + t[q][1]) + (t[q][2] + t[q][3]); v += shx_(v, 16, lane); v += shx_(v, 32, lane); rsv[q] = __builtin_amdgcn_rsqf(v * (1.f / 1024.f) + 1e-6f); } }
        f32x4 wv[2][2];
#pragma unroll
        for (int bj = 0; bj < 2; ++bj)
#pragma unroll
            for (int n = 0; n < 2; ++n) wv[bj][n] = *(const f32x4*)(fw + col0 + bj * HALF + n * 16);
        float* op = out + (size_t)rowb * 1024 + col0;
#pragma unroll
        for (int it = 0; it < 8; ++it) { const int ai = it >> 2, m = it & 3; const size_t ro = (size_t)(ai * HALF + m * 16) * 1024;
#pragma unroll
            for (int bj = 0; bj < 2; ++bj)
#pragma unroll
                for (int n = 0; n < 2; ++n) *(f32x4*)(op + ro + bj * HALF + n * 16) = acc[ai][bj][m][n] * rsv[it] * wv[bj][n]; }
    }
};

__device__ __forceinline__ float dpp_ror1(float v) { return __builtin_bit_cast(float, __builtin_amdgcn_mov_dpp(__builtin_bit_cast(int, v), 0x121, 0xf, 0xf, false)); }
__device__ __forceinline__ float dpp_ror15(float v) { return __builtin_bit_cast(float, __builtin_amdgcn_mov_dpp(__builtin_bit_cast(int, v), 0x12f, 0xf, 0xf, false)); }
struct EpiUpGate {
    static constexpr bool PERM = true, AFTER_DRAIN = false;
    bf16_t* ACT; const float* SS; const float* bias; int ldb; const float* cw; float* HALO; PG8_LAS unsigned char* xb;
    __device__ __forceinline__ void operator()(f32x4 (&acc)[2][2][4][2], const Unit& u, int wr, int wc, int fr, int fq) const {
        asm volatile("" : "+v"(fr), "+v"(fq));
        const int cnd = u.pm < 32 ? 0 : 1 + ((u.pm - 32) >> 3);
        const bool samp = u.pm >= 32;
        const int j0 = u.pn * HALF + wc * 32 + 8 * fq;
        const int row0 = u.pm * BM + wr * 64 + fr;
        { const float* bp = bias + (size_t)cnd * ldb + j0;
          f32x4 bv[2][2];
#pragma unroll
          for (int bj = 0; bj < 2; ++bj)
#pragma unroll
              for (int n = 0; n < 2; ++n) bv[bj][n] = *(const f32x4*)(bp + bj * 2816 + 4 * n);
          float rsv[8]; row_scales(SS, row0, fr, fq, rsv);
#pragma unroll
          for (int ai = 0; ai < 2; ++ai)
#pragma unroll
              for (int m = 0; m < 4; ++m) { const float rs = rsv[ai * 4 + m];
#pragma unroll
                  for (int bj = 0; bj < 2; ++bj)
#pragma unroll
                      for (int n = 0; n < 2; ++n) acc[ai][bj][m][n] = acc[ai][bj][m][n] * rs + bv[bj][n]; } }
        PG8_LAS f32x4* WL = (PG8_LAS f32x4*)(xb + 8192);
        if (fr == 0) {
            f32x4 wt[2][2][3];
#pragma unroll
            for (int n = 0; n < 2; ++n)
#pragma unroll
                for (int bj = 0; bj < 2; ++bj)
#pragma unroll
                    for (int k = 0; k < 3; ++k) wt[n][bj][k] = *(const f32x4*)(cw + k * 5632 + bj * 2816 + j0 + 4 * n);
#pragma unroll
            for (int n = 0; n < 2; ++n)
#pragma unroll
                for (int bj = 0; bj < 2; ++bj)
#pragma unroll
                    for (int k = 0; k < 3; ++k) WL[((((wr * 4 + wc) * 4 + fq) * 2 + n) * 2 + bj) * 3 + k] = wt[n][bj][k];
        }
        PG8_LAS f32x4* XB = (PG8_LAS f32x4*)xb;
        const int wv = wr * 4 + wc, pw = (wr ^ 1) * 4 + wc;
        if (fr == 0) {
#pragma unroll
            for (int ai = 0; ai < 2; ++ai)
#pragma unroll
                for (int bj = 0; bj < 2; ++bj)
#pragma unroll
                    for (int n = 0; n < 2; ++n) XB[((wv * 4 + ai * 2) * 2 + bj) * 8 + 2 * fq + n] = acc[ai][bj][0][n]; }
        if (fr == 15) {
#pragma unroll
            for (int ai = 0; ai < 2; ++ai)
#pragma unroll
                for (int bj = 0; bj < 2; ++bj)
#pragma unroll
                    for (int n = 0; n < 2; ++n) XB[((wv * 4 + ai * 2 + 1) * 2 + bj) * 8 + 2 * fq + n] = acc[ai][bj][3][n]; }
        asm volatile("s_waitcnt lgkmcnt(0)" ::: "memory"); __builtin_amdgcn_s_barrier(); asm volatile("" ::: "memory");
        float* hb = HALO + (size_t)(samp ? u.pm - 32 : 0) * 4 * 5632;
#pragma unroll
        for (int ai = 0; ai < 2; ++ai) {
            const bool has_ab = !(wr == 0 && ai == 0), has_bl = !(wr == 1 && ai == 1);
            const int wab = (wr == 0) ? 1 : (ai == 0 ? 1 : 3), wbl = (wr == 0) ? (ai == 0 ? 0 : 2) : 2;
            unsigned pk[4][4];
#pragma unroll
            for (int n = 0; n < 2; ++n) {
                f32x4 ca[4];
#pragma unroll
                for (int bj = 0; bj < 2; ++bj) {
                    const PG8_LAS f32x4* wlp = WL + ((((wr * 4 + wc) * 4 + fq) * 2 + n) * 2 + bj) * 3;
                    const f32x4 w0 = wlp[0], w1 = wlp[1], w2 = wlp[2];
                    f32x4 ab = (f32x4){0.f, 0.f, 0.f, 0.f}, bl = ab;
                    if (has_ab) ab = XB[((pw * 4 + wab) * 2 + bj) * 8 + 2 * fq + n];
                    if (has_bl) bl = XB[((pw * 4 + wbl) * 2 + bj) * 8 + 2 * fq + n];
#pragma unroll
                    for (int m = 0; m < 4; ++m) {
                        f32x4 cvm;
#pragma unroll
                        for (int i = 0; i < 4; ++i) {
                            const float cur = acc[ai][bj][m][n][i];
                            const float pv = m == 0 ? ab[i] : acc[ai][bj][m == 0 ? 0 : m - 1][n][i];
                            const float nx = m == 3 ? bl[i] : acc[ai][bj][m == 3 ? 3 : m + 1][n][i];
                            const float up = dpp_ror1(fr == 15 ? pv : cur), dn = dpp_ror15(fr == 0 ? nx : cur);
                            cvm[i] = w0[i] * up + w1[i] * cur + w2[i] * dn;
                        }
                        if (samp) {
                            if (m == 0 && wr == 0 && ai == 0 && fr == 0) { *(f32x4*)(hb + 0 * 5632 + bj * 2816 + j0 + 4 * n) = acc[ai][bj][0][n]; *(f32x4*)(hb + 1 * 5632 + bj * 2816 + j0 + 4 * n) = cvm; }
                            if (m == 3 && wr == 1 && ai == 1 && fr == 15) { *(f32x4*)(hb + 2 * 5632 + bj * 2816 + j0 + 4 * n) = acc[ai][bj][3][n]; *(f32x4*)(hb + 3 * 5632 + bj * 2816 + j0 + 4 * n) = cvm; }
                        }
                        if (bj == 0) ca[m] = cvm;
                        else { float r[4];
#pragma unroll
                            for (int i = 0; i < 4; ++i) { const float xa = ca[m][i]; r[i] = xa * __builtin_amdgcn_rcpf(1.f + __builtin_amdgcn_exp2f(-xa * 1.4426950408889634f)) * cvm[i]; }
                            pk[m][2 * n] = cvt_pk_bf16(r[0], r[1]); pk[m][2 * n + 1] = cvt_pk_bf16(r[2], r[3]); }
                    }
                }
                __builtin_amdgcn_sched_barrier(0);
            }
#pragma unroll
            for (int m = 0; m < 4; ++m) *(u32x4*)(ACT + (size_t)(row0 + ai * HALF + m * 16) * 2816 + j0) = (u32x4){pk[m][0], pk[m][1], pk[m][2], pk[m][3]};
        }
    }
};

template <class Epi, class Sched, bool ALIGN_EPI = false, bool SP2 = false>
__device__ __forceinline__ void gemm_phase(PG8_LAS unsigned char* lds, const Gemm g, const Sched& S, const Epi& E, const int tid) {
    const int wid = __builtin_amdgcn_readfirstlane(tid >> 6), lane = tid & 63, wr = wid >> 2, wc = wid & 3, fr = lane & 15, fq = lane >> 4;
    const int K = g.K, nt = K / BK;
    unsigned voffA[2], voffB[2];
#pragma unroll
    for (int i = 0; i < 2; ++i) { int R, C; stage_rc(tid * 16 + i * 8192, R, C); const int Rb = Epi::PERM ? ((R & ~31) + perm32(R & 31)) : R;
        voffA[i] = (unsigned)(R * K + C) * 2u; voffB[i] = (unsigned)(Rb * K + C) * 2u; }
    const size_t kstep = (size_t)(BK * 2);
    const size_t hstep = (size_t)HALF * K * 2;
    const size_t tstep = 2 * hstep;
    const size_t bstep = g.bstep ? g.bstep : tstep, bh = g.bhalf ? g.bhalf : hstep;
    const unsigned ldsw = (unsigned)wid * 1024u;
    const int aoff = lds_byte(wr * 64 + fr, fq * 8), boff = lds_byte(wc * 32 + fr, fq * 8);
#define PG8_SA(b, h) (((b) * 2 + (h)) * HTB)
#define PG8_SB(b, h) ((4 + (b) * 2 + (h)) * HTB)
#define PG8_STAGE(bufoff, gbase, voff) do { _Pragma("unroll") for (int _i = 0; _i < 2; ++_i) \
        __builtin_amdgcn_global_load_lds((const unsigned*)((const char*)(gbase) + (voff)[_i]), (PG8_LAS unsigned*)(lds + (bufoff) + ldsw + _i * 8192), 16, 0, 0); } while (0)
#define PG8_LDA(dst, b, h) do { _Pragma("unroll") for (int m = 0; m < 4; ++m) _Pragma("unroll") for (int k = 0; k < 2; ++k) dst[m][k] = *(const PG8_LAS bf16x8*)(lds + PG8_SA(b, h) + aoff + m * 2048 + k * 1024); } while (0)
#define PG8_LDB(dst, b, h) do { _Pragma("unroll") for (int n = 0; n < 2; ++n) _Pragma("unroll") for (int k = 0; k < 2; ++k) dst[n][k] = *(const PG8_LAS bf16x8*)(lds + PG8_SB(b, h) + boff + n * 2048 + k * 1024); } while (0)
#define PG8_MMA(ai, bj, At, Bt) do { __builtin_amdgcn_s_setprio(1); _Pragma("unroll") for (int m = 0; m < 4; ++m) _Pragma("unroll") for (int n = 0; n < 2; ++n) _Pragma("unroll") for (int k = 0; k < 2; ++k) \
        acc[ai][bj][m][n] = __builtin_amdgcn_mfma_f32_16x16x32_bf16(Bt[n][k], At[m][k], acc[ai][bj][m][n], 0, 0, 0); __builtin_amdgcn_s_setprio(0); } while (0)
#define PG8_WAIT_V(n) asm volatile("s_waitcnt vmcnt(" #n ")" ::: "memory")
#define PG8_WAIT_L(n) asm volatile("s_waitcnt lgkmcnt(" #n ")" ::: "memory")
#define PG8_BAR __builtin_amdgcn_s_barrier()
#define PG8_SCHED __builtin_amdgcn_sched_barrier(0)
    Unit cur, nxt; int ui = 0;
    if (!S.next(0, cur)) return;
    f32x4 acc[2][2][4][2];
#pragma unroll
    for (int a = 0; a < 2; ++a)
#pragma unroll
        for (int b = 0; b < 2; ++b)
#pragma unroll
            for (int m = 0; m < 4; ++m)
#pragma unroll
                for (int n = 0; n < 2; ++n) acc[a][b][m][n] = (f32x4){0.f, 0.f, 0.f, 0.f};
    bf16x8 At[4][2], B0[2][2], B1[2][2];
    const char* cA = (const char*)g.A + (size_t)cur.pm * tstep; const char* cB = (const char*)g.Bt + (size_t)cur.pn * bstep;
    S.a_ready(cur);
    if constexpr (SP2) {
        PG8_STAGE(PG8_SB(0, 0), cB, voffB); PG8_STAGE(PG8_SB(0, 1), cB + bh, voffB); PG8_STAGE(PG8_SA(0, 0), cA, voffA); PG8_STAGE(PG8_SA(0, 1), cA + hstep, voffA);
        if (wr == 1) PG8_BAR;
        PG8_WAIT_V(2); PG8_BAR;
        PG8_STAGE(PG8_SB(1, 0), cB + kstep, voffB); PG8_STAGE(PG8_SA(1, 0), cA + kstep, voffA); PG8_STAGE(PG8_SB(1, 1), cB + bh + kstep, voffB);
        PG8_WAIT_V(6); PG8_BAR;
    } else {
        PG8_STAGE(PG8_SB(0, 0), cB, voffB); PG8_STAGE(PG8_SA(0, 0), cA, voffA); PG8_STAGE(PG8_SB(0, 1), cB + bh, voffB); PG8_STAGE(PG8_SA(0, 1), cA + hstep, voffA);
        if (wr == 1) PG8_BAR;
        PG8_WAIT_V(4); PG8_BAR;
        PG8_STAGE(PG8_SB(1, 0), cB + kstep, voffB); PG8_STAGE(PG8_SA(1, 0), cA + kstep, voffA); PG8_STAGE(PG8_SB(1, 1), cB + bh + kstep, voffB);
        PG8_WAIT_V(6); PG8_BAR;
    }
    for (;;) {
        const bool has_next = S.next(ui + 1, nxt);
        const char* nA = has_next ? (const char*)g.A + (size_t)nxt.pm * tstep : cA; const char* nB = has_next ? (const char*)g.Bt + (size_t)nxt.pn * bstep : cB;
        for (int t = 0; t < nt; t += 2) {
            const bool last = (t == nt - 2);
            const char* a1 = cA + (size_t)(t + 1) * kstep;
            const char* a2 = last ? nA : cA + (size_t)(t + 2) * kstep; const char* b2 = last ? nB : cB + (size_t)(t + 2) * kstep;
            const char* a3 = a2 + kstep; const char* b3 = b2 + kstep;
            if (last && has_next) S.a_ready(nxt);
            if constexpr (SP2) {
            PG8_LDB(B0, 0, 0); PG8_LDB(B1, 0, 1); PG8_SCHED; PG8_LDA(At, 0, 0); PG8_STAGE(PG8_SA(1, 1), a1 + hstep, voffA);
            PG8_WAIT_V(8); PG8_WAIT_L(0); PG8_BAR; PG8_MMA(0, 0, At, B0); PG8_MMA(0, 1, At, B1); PG8_BAR; PG8_SCHED;
            PG8_LDA(At, 0, 1); PG8_STAGE(PG8_SB(0, 0), b2, voffB); PG8_STAGE(PG8_SB(0, 1), b2 + bh, voffB); PG8_STAGE(PG8_SA(0, 0), a2, voffA);
            PG8_WAIT_V(8); PG8_WAIT_L(0); PG8_BAR; PG8_MMA(1, 0, At, B0); PG8_MMA(1, 1, At, B1); PG8_BAR; PG8_SCHED;
            PG8_LDB(B0, 1, 0); PG8_LDB(B1, 1, 1); PG8_SCHED; PG8_LDA(At, 1, 0); PG8_STAGE(PG8_SA(0, 1), a2 + hstep, voffA);
            PG8_WAIT_V(8); PG8_WAIT_L(0); PG8_BAR; PG8_MMA(0, 0, At, B0); PG8_MMA(0, 1, At, B1); PG8_BAR; PG8_SCHED;
            PG8_LDA(At, 1, 1); PG8_STAGE(PG8_SB(1, 0), b3, voffB); PG8_STAGE(PG8_SB(1, 1), b3 + bh, voffB); PG8_STAGE(PG8_SA(1, 0), a3, voffA);
            PG8_WAIT_V(8); PG8_WAIT_L(0); PG8_BAR; PG8_MMA(1, 0, At, B0); PG8_MMA(1, 1, At, B1); PG8_BAR; PG8_SCHED;
            } else {
            PG8_LDB(B0, 0, 0); PG8_SCHED; PG8_LDA(At, 0, 0); PG8_STAGE(PG8_SA(1, 1), a1 + hstep, voffA);
            PG8_WAIT_L(8); PG8_BAR; PG8_WAIT_L(0); PG8_MMA(0, 0, At, B0); PG8_BAR; PG8_SCHED;
            PG8_LDB(B1, 0, 1); PG8_STAGE(PG8_SB(0, 0), b2, voffB);
            PG8_BAR; PG8_WAIT_L(0); PG8_MMA(0, 1, At, B1); PG8_BAR;
            PG8_LDA(At, 0, 1); PG8_STAGE(PG8_SA(0, 0), a2, voffA);
            PG8_BAR; PG8_WAIT_L(0); PG8_MMA(1, 0, At, B0); PG8_BAR; PG8_SCHED;
            PG8_STAGE(PG8_SB(0, 1), b2 + bh, voffB);
            PG8_WAIT_V(6); PG8_BAR; PG8_MMA(1, 1, At, B1); PG8_BAR;
            PG8_LDB(B0, 1, 0); PG8_SCHED; PG8_LDA(At, 1, 0); PG8_STAGE(PG8_SA(0, 1), a2 + hstep, voffA);
            PG8_WAIT_L(8); PG8_BAR; PG8_WAIT_L(0); PG8_MMA(0, 0, At, B0); PG8_BAR; PG8_SCHED;
            PG8_LDB(B1, 1, 1); PG8_STAGE(PG8_SB(1, 0), b3, voffB);
            PG8_BAR; PG8_WAIT_L(0); PG8_MMA(0, 1, At, B1); PG8_BAR;
            PG8_LDA(At, 1, 1); PG8_STAGE(PG8_SA(1, 0), a3, voffA);
            PG8_BAR; PG8_WAIT_L(0); PG8_MMA(1, 0, At, B0); PG8_BAR; PG8_SCHED;
            PG8_STAGE(PG8_SB(1, 1), b3 + bh, voffB);
            PG8_WAIT_V(6); PG8_BAR; PG8_MMA(1, 1, At, B1); PG8_BAR;
            }
        }
        if constexpr (ALIGN_EPI) { if (wr == 0) PG8_BAR; }
        if constexpr (!Epi::AFTER_DRAIN) { E(acc, cur, wr, wc, fr, fq); S.done(cur); }
        if (!has_next) break;
#pragma unroll
        for (int a = 0; a < 2; ++a)
#pragma unroll
            for (int b = 0; b < 2; ++b)
#pragma unroll
                for (int m = 0; m < 4; ++m)
#pragma unroll
                    for (int n = 0; n < 2; ++n) acc[a][b][m][n] = (f32x4){0.f, 0.f, 0.f, 0.f};
        cur = nxt; cA = nA; cB = nB; ++ui;
        if constexpr (ALIGN_EPI) { if (wr == 1) PG8_BAR; }
    }
    PG8_WAIT_V(0);
    if constexpr (!ALIGN_EPI) { if (wr == 0) PG8_BAR; }
    PG8_BAR;
#undef PG8_SA
#undef PG8_SB
#undef PG8_STAGE
#undef PG8_LDA
#undef PG8_LDB
#undef PG8_MMA
#undef PG8_WAIT_V
#undef PG8_WAIT_L
#undef PG8_BAR
#undef PG8_SCHED
}
}

#define LAS __attribute__((address_space(3)))
#define CAS __attribute__((address_space(4)))
typedef unsigned short bf16;
typedef float f32x4 __attribute__((ext_vector_type(4)));
typedef short bf16x8 __attribute__((ext_vector_type(8)));
typedef unsigned u32x4 __attribute__((ext_vector_type(4)));
typedef unsigned u32x2 __attribute__((ext_vector_type(2)));

constexpr int NW = 8, NT = 512;
constexpr int DM = 1024, NTOK = 12288, NPR = 8192, NKR = 13312, INC = 2144, INP = 2304, DFF = 2816, DUP = 5632;
constexpr float EPS = 1e-6f, LOG2E = 1.4426950408889634f;
constexpr float QS = 0.125f * LOG2E;
constexpr float MLAQS = 0.10206207261596575f * LOG2E;

constexpr size_t MiB = 1u << 20;
constexpr size_t WS_CTL = 0, WS_MOD = 1 * MiB, WS_ROPE = 1 * MiB + 256 * 1024, WS_W = 2 * MiB, W_LSTRIDE = 24 * MiB;
constexpr size_t W_IN = 0, W_OUT = 4718592, W_UP = W_OUT + 2097152, W_DOWN = W_UP + 11534336, W_B2 = W_DOWN + 5767168;
static_assert(W_B2 + 786432 <= W_LSTRIDE, "weights");
constexpr size_t WS_XN = 50 * MiB, WS_PROJ = 74 * MiB, WS_A2 = 128 * MiB, WS_MQKV = 138 * MiB, WS_QC = 164 * MiB, WS_KPE = 203 * MiB, WS_YCAT = 204 * MiB;
constexpr size_t WS_ACT = 116 * MiB, WS_U = 116 * MiB, WS_SS1 = 228 * MiB, WS_SS2 = 229 * MiB, WS_HALO = 230 * MiB, WS_XRES = 232 * MiB, WS_END = 256 * MiB;
constexpr size_t WS_BIAS = 65536;
constexpr int NBIAS = 2304 + 5632;
constexpr size_t QSZ = (size_t)NKR * 256 * 2, KSZ = (size_t)NKR * 128 * 2;
constexpr int LDS_BYTES = 163840, LDS_CTL = 163840 - 256;
constexpr size_t WS_BAR = 16384;

struct Args { const float* in[28]; float* out; unsigned char* ws; };

__device__ __forceinline__ unsigned f2bf(float f) { unsigned u = __builtin_bit_cast(unsigned, f); return (u + 0x7fffu + ((u >> 16) & 1u)) >> 16; }
__device__ __forceinline__ unsigned pk2(float lo, float hi) { unsigned r; asm("v_cvt_pk_bf16_f32 %0, %1, %2" : "=v"(r) : "v"(lo), "v"(hi)); return r; }
__device__ __forceinline__ float bflo(unsigned u) { return __builtin_bit_cast(float, u << 16); }
__device__ __forceinline__ float bfhi(unsigned u) { return __builtin_bit_cast(float, u & 0xffff0000u); }
__device__ __forceinline__ f32x4 ld4bf(const bf16* p) { const u32x2 u = *(const u32x2*)p; return (f32x4){bflo(u.x), bfhi(u.x), bflo(u.y), bfhi(u.y)}; }
__device__ __forceinline__ void st4bf(bf16* p, f32x4 v) { u32x2 u; u.x = pk2(v[0], v[1]); u.y = pk2(v[2], v[3]); *(u32x2*)p = u; }
__device__ __forceinline__ float shx(float v, int m, int lane) { return __builtin_bit_cast(float, __builtin_amdgcn_ds_bpermute((lane ^ m) << 2, __builtin_bit_cast(int, v))); }
#define DPPF(v, ctrl) __builtin_bit_cast(float, __builtin_amdgcn_mov_dpp(__builtin_bit_cast(int, (v)), (ctrl), 0xf, 0xf, false))
__device__ __forceinline__ float sum16(float v, int) { v += DPPF(v, 0x121); v += DPPF(v, 0x122); v += DPPF(v, 0x124); v += DPPF(v, 0x128); return v; }
__device__ __forceinline__ float wave_sum(float v, int lane) {
    v = sum16(v, lane);
    const int iv = __builtin_bit_cast(int, v);
    const float a = __builtin_bit_cast(float, __builtin_amdgcn_readlane(iv, 0)), b = __builtin_bit_cast(float, __builtin_amdgcn_readlane(iv, 16)),
                c = __builtin_bit_cast(float, __builtin_amdgcn_readlane(iv, 32)), d = __builtin_bit_cast(float, __builtin_amdgcn_readlane(iv, 48));
    return (a + b) + (c + d);
}
__device__ __forceinline__ float dot4(f32x4 a) { return (a[0] * a[0] + a[1] * a[1]) + (a[2] * a[2] + a[3] * a[3]); }
__device__ __forceinline__ f32x4 shfl4(f32x4 v, int m, int lane) { return (f32x4){shx(v[0], m, lane), shx(v[1], m, lane), shx(v[2], m, lane), shx(v[3], m, lane)}; }

__device__ __forceinline__ void transpose_item(const float* W, int N, bf16* WT, int ldk, int row_off, int k_off, float scale, LAS float* scr, int item, int lane) {
    const int nblk = (N + 63) / 64, kb = item / nblk, nb = item % nblk, k0 = 64 * kb, n0 = 64 * nb;
    const bool act = n0 + lane < N;
    const float* wp = W + (size_t)k0 * N + n0 + lane;
    float v[64];
#pragma unroll
    for (int i = 0; i < 64; ++i) v[i] = act ? wp[(size_t)i * N] : 0.f;
#pragma unroll
    for (int i = 0; i < 64; ++i) scr[i * 65 + lane] = v[i] * scale;
    asm volatile("s_waitcnt lgkmcnt(0)" ::: "memory");
    const int c = lane & 7;
#pragma unroll
    for (int j = 0; j < 8; ++j) { const int n = (lane >> 3) + 8 * j; const LAS float* s = scr + (8 * c) * 65 + n;
        u32x4 o; o.x = pk2(s[0 * 65], s[1 * 65]); o.y = pk2(s[2 * 65], s[3 * 65]); o.z = pk2(s[4 * 65], s[5 * 65]); o.w = pk2(s[6 * 65], s[7 * 65]);
        if (n0 + n < N) *(u32x4*)(WT + (size_t)(row_off + n0 + n) * ldk + k_off + k0 + 8 * c) = o; }
    asm volatile("s_waitcnt lgkmcnt(0)" ::: "memory");
}

template <class ArgsRef>
__device__ __forceinline__ void wconv(const ArgsRef& a, unsigned char* ws, int l, int sel, int w, int nwk, LAS float* scr, int lane) {
    constexpr int I_IN = 16 * 34, I_OUT = 16 * 16, I_UP = 16 * 88, I_DN = 44 * 16, I_Q = 3 * 6, I_KV = 2 * 8;
    const int n_in = (sel & 1) ? I_IN : 0, n_out = (sel & 2) ? I_OUT : 0, n_up = (sel & 4) ? I_UP : 0, n_dn = (sel & 8) ? I_DN : 0, n_q = (sel & 16) ? I_Q : 0, n_kv = (sel & 32) ? I_KV : 0;
    const int total = n_in + n_out + n_up + n_dn + n_q + n_kv;
    unsigned char* wl = ws + WS_W + l * W_LSTRIDE;
    for (int it = w; it < total; it += nwk) {
        int r = it;
        if (r < n_in) { transpose_item(a.in[13] + (size_t)l * 1024 * INC, INC, (bf16*)(wl + W_IN), 1024, 0, 0, 1.f, scr, r, lane); continue; } r -= n_in;
        if (r < n_out) { transpose_item(a.in[22] + (size_t)l * 1024 * 1024, 1024, (bf16*)(wl + W_OUT), 1024, 0, 0, 1.f, scr, r, lane); continue; } r -= n_out;
        if (r < n_up) { transpose_item(a.in[24] + (size_t)l * 1024 * DUP, DUP, (bf16*)(wl + W_UP), 1024, 0, 0, 1.f, scr, r, lane); continue; } r -= n_up;
        if (r < n_dn) { transpose_item(a.in[26] + (size_t)l * DFF * 1024, 1024, (bf16*)(wl + W_DOWN), DFF, 0, 0, 1.f, scr, r, lane); continue; } r -= n_dn;
        if (r < n_q) { transpose_item(a.in[16] + (size_t)l * 192 * 384, 384, (bf16*)(wl + W_B2), 384, 0, 0, MLAQS, scr, r, lane); continue; } r -= n_q;
        transpose_item(a.in[18] + (size_t)l * 128 * 512, 512, (bf16*)(wl + W_B2), 384, 384, 192, 1.f, scr, r, lane);
    }
}
template <class ArgsRef>
__device__ __forceinline__ void phase0(const ArgsRef& a, LAS unsigned char* lds, int tid, int lane, int wave) {
    unsigned char* ws = a.ws;
    const int G = gridDim.x, bid = blockIdx.x;
    if (bid < 96) {
        LAS float* sl = (LAS float*)(lds + 16384);
        for (int e = tid; e < 3072; e += NT) { const int c = e >> 10, k = e & 1023; const float v = c == 0 ? a.in[9][k] : a.in[8][(c - 1) * 1024 + k]; sl[e] = v / (1.f + __expf(-v)); }
        __syncthreads();
    }
    for (int it = bid; it < 96; it += G) {
        const int l = it / 48, n0 = (it % 48) * 128;
        const float* wa = a.in[10] + (size_t)l * 1024 * 6144;
        const LAS float* sl = (const LAS float*)(lds + 16384);
        float acc[3][2] = {{0.f, 0.f}, {0.f, 0.f}, {0.f, 0.f}};
        const int kb = wave * 128;
#pragma unroll 16
        for (int k = 0; k < 128; ++k) {
            const int kk = kb + k;
            const float2 w = *(const float2*)(wa + (size_t)kk * 6144 + n0 + 2 * lane);
            const float s0 = sl[kk], s1 = sl[1024 + kk], s2 = sl[2048 + kk];
            acc[0][0] += s0 * w.x; acc[0][1] += s0 * w.y; acc[1][0] += s1 * w.x; acc[1][1] += s1 * w.y; acc[2][0] += s2 * w.x; acc[2][1] += s2 * w.y;
        }
        LAS float* red = (LAS float*)lds;
#pragma unroll
        for (int c = 0; c < 3; ++c) { red[(wave * 3 + c) * 128 + 2 * lane] = acc[c][0]; red[(wave * 3 + c) * 128 + 2 * lane + 1] = acc[c][1]; }
        __syncthreads();
        if (tid < 384) { const int c = tid / 128, n = tid % 128; float s = 0.f;
#pragma unroll
            for (int w = 0; w < 8; ++w) s += red[(w * 3 + c) * 128 + n];
            ((float*)(ws + WS_MOD))[(size_t)(l * 3 + c) * 6144 + n0 + n] = s + a.in[11][(size_t)l * 6144 + n0 + n]; }
        __syncthreads();
    }
    if (bid == G - 1) {
        float* rt = (float*)(ws + WS_ROPE);
        for (int e = tid; e < 1024; e += NT) { const int pos = e >> 4, i = e & 15; const float inv = exp2f(-(float)(2 * i) / 32.f * 13.287712379549449f); const float ang = (float)pos * inv;
            rt[e] = __cosf(ang); rt[1024 + e] = __sinf(ang); }
        for (int e = tid; e < 512; e += NT) { const int pos = e >> 3, i = e & 7; const float inv = exp2f(-(float)(2 * i) / 16.f * 13.287712379549449f); const float ang = (float)pos * inv;
            rt[2048 + e] = __cosf(ang); rt[2560 + e] = __sinf(ang); }
    }
    const int gt = bid * NT + tid, NGT = G * NT;
    if (gt < 256) ((unsigned*)(ws + WS_CTL))[gt] = 0u;
    if (gt < 64) ((unsigned*)(ws + WS_CTL))[2048 + gt] = 0u;
    for (int l = 0; l < 2; ++l) {
        bf16* b2 = (bf16*)(ws + WS_W + l * W_LSTRIDE + W_B2);
        for (int ch = gt; ch < 1024 * 48; ch += NGT) { const int n = ch / 48, k = (ch % 48) * 8;
            const bool data = (n < 384 && k < 192) || (n >= 384 && n < 896 && k >= 192 && k < 320);
            if (!data) *(u32x4*)(b2 + (size_t)n * 384 + k) = (u32x4){0u, 0u, 0u, 0u}; }
        bf16* wi = (bf16*)(ws + WS_W + l * W_LSTRIDE + W_IN) + (size_t)INC * 1024;
        for (int ch = gt; ch < 160 * 128; ch += NGT) *(u32x4*)(wi + (size_t)ch * 8) = (u32x4){0u, 0u, 0u, 0u};
    }
    LAS float* scr = (LAS float*)(lds + 28672 + wave * 16640);
    wconv(a, ws, 0, 1 | 2 | 16 | 32, bid * NW + wave, G * NW, scr, lane);
}

__device__ __forceinline__ void prep_phase(const float* x0, const float* x1, const float* nw, const float* mod, int sc_off, bf16* XN, float* SS, int lane, int gw, int NGW) {
    for (int row = gw; row < NTOK; row += NGW) {
        const float* xr = row < NPR ? x0 + (size_t)row * DM : x1 + (size_t)(row - NPR) * DM;
        const int c = row < NPR ? 0 : 1 + ((row - NPR) >> 11);
        const float* mp = mod + c * 6144;
        f32x4 v[4]; float ss = 0.f;
#pragma unroll
        for (int j = 0; j < 4; ++j) { v[j] = *(const f32x4*)(xr + 4 * (lane + 64 * j)); ss += dot4(v[j]); }
        ss = wave_sum(ss, lane);
#pragma unroll
        for (int j = 0; j < 4; ++j) { const int col = 4 * (lane + 64 * j);
            const f32x4 g = *(const f32x4*)(nw + col), sc = *(const f32x4*)(mp + sc_off + col);
            st4bf(XN + (size_t)row * DM + col, v[j] * g * (1.f + sc)); }
        if (lane < 16) SS[(size_t)row * 16 + lane] = lane == 0 ? ss : 0.f;
    }
}
template <class ArgsRef>
__device__ __forceinline__ void bias_phase(const ArgsRef& a, unsigned char* ws, LAS unsigned char* lds, int tid, int lane, int wave) {
    const float* mod = (const float*)(ws + WS_MOD);
    float* BIAS = (float*)(ws + WS_BIAS);
    for (int it = blockIdx.x; it < 62; it += gridDim.x) {
        const int l = it / 31, r = it % 31; const bool up = r >= 9;
        const int N = up ? DUP : INC, n0 = (up ? r - 9 : r) * 256 + 4 * lane;
        const float* W = up ? a.in[24] + (size_t)l * 1024 * DUP : a.in[13] + (size_t)l * 1024 * INC;
        const float* shp = mod + (size_t)l * 3 * 6144 + (up ? 3072 : 0);
        LAS float* sl = (LAS float*)(lds + 32768);
        for (int e = tid; e < 3072; e += NT) sl[e] = shp[(e >> 10) * 6144 + (e & 1023)];
        __syncthreads();
        const bool act = n0 < N;
        f32x4 acc[3] = {(f32x4){0.f, 0.f, 0.f, 0.f}, (f32x4){0.f, 0.f, 0.f, 0.f}, (f32x4){0.f, 0.f, 0.f, 0.f}};
        const int kb = wave * 128;
#pragma unroll 16
        for (int k = 0; k < 128; ++k) { const int kk = kb + k;
            const f32x4 w = act ? *(const f32x4*)(W + (size_t)kk * N + n0) : (f32x4){0.f, 0.f, 0.f, 0.f};
            acc[0] += w * sl[kk]; acc[1] += w * sl[1024 + kk]; acc[2] += w * sl[2048 + kk]; }
        LAS f32x4* red = (LAS f32x4*)lds;
#pragma unroll
        for (int c = 0; c < 3; ++c) red[(wave * 3 + c) * 64 + lane] = acc[c];
        __syncthreads();
        if (tid < 192) { const int c = tid >> 6, ln = tid & 63; f32x4 t = red[c * 64 + ln];
#pragma unroll
            for (int w = 1; w < 8; ++w) t += red[(w * 3 + c) * 64 + ln];
            const int nn = (up ? r - 9 : r) * 256 + 4 * ln;
            if (nn < N) *(f32x4*)(BIAS + (size_t)(l * 3 + c) * NBIAS + (up ? 2304 : 0) + nn) = t;
            else if (!up && nn < 2304) *(f32x4*)(BIAS + (size_t)(l * 3 + c) * NBIAS + nn) = (f32x4){0.f, 0.f, 0.f, 0.f}; }
        __syncthreads();
    }
}

struct P3Ptrs {
    const bf16* PROJ; bf16 *A2, *KPE, *YCAT, *Qc_rot, *Qc_raw, *Kc, *Vc, *Qd_rot, *Qd_raw, *Kd, *Vd;
    const float *conv_a, *gq_mla, *gkv_mla, *gq, *gk, *rope;
    const float *c_ckv, *c_kpe, *c_gk, *c_gv, *c_sk, *c_sv;
    float *o_ckv, *o_kpe, *o_gk, *o_gv, *o_sk, *o_sv;
    int l;
};
__device__ __forceinline__ f32x4 rope64(f32x4 v, int jl, int prow, int pcol, const float* rt, int lane) {
    const f32x4 pr = shfl4(v, 4, lane);
    const int pos = jl < 8 ? prow : pcol, fi = 4 * (jl & 3);
    const f32x4 c = *(const f32x4*)(rt + pos * 16 + fi), s = *(const f32x4*)(rt + 1024 + pos * 16 + fi);
    const float sg = (jl & 4) ? 1.f : -1.f;
    return v * c + pr * s * sg;
}
__device__ __forceinline__ void p3_phase(const P3Ptrs& P, int lane, int gw, int NGW) {
    const int l = P.l;
    for (int row = gw; row < NKR; row += NGW) {
        if (row < NTOK) {
            const bool samp = row >= NPR;
            int b, t, kr, T;
            if (!samp) { b = row >> 8; t = row & 255; kr = row; T = 256; } else { b = (row - NPR) >> 11; t = (row - NPR) & 2047; kr = NPR + b * 2560 + t; T = 2048; }
            const int prow = t >> 6, pcol = t & 63;
            const bf16* pr = P.PROJ + (size_t)row * INP;
            const size_t ob = (size_t)((b * 2 + l) * 256 + t);
            const int ci = 4 * lane, jl = lane & 15;
            const u32x2 z2 = (u32x2){0u, 0u};
            const bool hp = t > 0, hn = t < T - 1;
            const u32x2 r_xa = *(const u32x2*)(pr + ci), r_gb = *(const u32x2*)(pr + 256 + ci), r_gc = *(const u32x2*)(pr + 512 + ci);
            const u32x2 r_pxa = hp ? *(const u32x2*)(pr - INP + ci) : z2, r_pgc = hp ? *(const u32x2*)(pr - INP + 512 + ci) : z2;
            const u32x2 r_nxa = hn ? *(const u32x2*)(pr + INP + ci) : z2, r_ngc = hn ? *(const u32x2*)(pr + INP + 512 + ci) : z2;
            const u32x2 r_cq = lane < 48 ? *(const u32x2*)(pr + 768 + ci) : z2, r_ckv = lane < 32 ? *(const u32x2*)(pr + 960 + ci) : z2, r_kpe = lane < 8 ? *(const u32x2*)(pr + 1088 + ci) : z2;
            const u32x2 r_qc = *(const u32x2*)(pr + 1120 + ci), r_kvc = *(const u32x2*)(pr + 1376 + ci), r_qd = *(const u32x2*)(pr + 1632 + ci), r_kvd = *(const u32x2*)(pr + 1888 + ci);
            const float* cw = P.conv_a + (size_t)l * 768;
            const f32x4 w0 = *(const f32x4*)(cw + ci), w1 = *(const f32x4*)(cw + 256 + ci), w2 = *(const f32x4*)(cw + 512 + ci);
            const f32x4 g_qm = lane < 48 ? *(const f32x4*)(P.gq_mla + l * 192 + ci) : (f32x4){0.f, 0.f, 0.f, 0.f}, g_kvm = lane < 32 ? *(const f32x4*)(P.gkv_mla + l * 128 + ci) : (f32x4){0.f, 0.f, 0.f, 0.f};
            const f32x4 g_q = *(const f32x4*)(P.gq + l * 64 + 4 * jl), g_k = *(const f32x4*)(P.gk + l * 64 + 4 * jl);
            const int pos64 = jl < 8 ? prow : pcol, fi64 = 4 * (jl & 3);
            const f32x4 c64 = *(const f32x4*)(P.rope + pos64 * 16 + fi64), s64 = *(const f32x4*)(P.rope + 1024 + pos64 * 16 + fi64);
            const int pos32 = (lane & 7) < 4 ? prow : pcol, fi32 = 4 * (lane & 1);
            const f32x4 c32 = *(const f32x4*)(P.rope + 2048 + pos32 * 8 + fi32), s32 = *(const f32x4*)(P.rope + 2560 + pos32 * 8 + fi32);
#define CV4(u) ((f32x4){bflo((u).x), bfhi((u).x), bflo((u).y), bfhi((u).y)})
#define ROPE64(v) ((v) * c64 + shfl4((v), 4, lane) * s64 * ((jl & 4) ? 1.f : -1.f))
            { const f32x4 ya = CV4(r_gb) * (w0 * (CV4(r_pxa) * CV4(r_pgc)) + w1 * (CV4(r_xa) * CV4(r_gc)) + w2 * (CV4(r_nxa) * CV4(r_ngc)));
              st4bf(P.YCAT + (size_t)row * DM + ci, ya); }
            { const f32x4 v = CV4(r_cq);
              const float rs = rsqrtf(wave_sum(dot4(v), lane) * (1.f / 192.f) + EPS);
              if (lane < 48) st4bf(P.A2 + (size_t)kr * 384 + ci, v * rs * g_qm); }
            { const f32x4 v = CV4(r_ckv);
              const float rs = rsqrtf(wave_sum(dot4(v), lane) * (1.f / 128.f) + EPS);
              if (lane < 32) { const f32x4 o = v * rs * g_kvm;
                  st4bf(P.A2 + (size_t)kr * 384 + 192 + ci, o);
                  if (!samp) *(f32x4*)(P.o_ckv + ob * 128 + ci) = o; }
              else if (lane < 48) { unsigned zz = 0u; asm volatile("" : "+v"(zz)); *(u32x2*)(P.A2 + (size_t)kr * 384 + 320 + 4 * (lane - 32)) = (u32x2){zz, zz}; } }
            { const f32x4 v = CV4(r_kpe);
              const f32x4 r = v * c32 + shfl4(v, 2, lane) * s32 * ((lane & 2) ? 1.f : -1.f);
              if (lane < 8) { if (!samp) *(f32x4*)(P.o_kpe + ob * 32 + ci) = v; st4bf(P.KPE + (size_t)kr * 32 + ci, samp ? r : v); } }
            { f32x4 v = CV4(r_qc);
              const float rs = rsqrtf(sum16(dot4(v), lane) * (1.f / 64.f) + EPS);
              v = v * rs * g_q;
              st4bf(P.Qc_raw + (size_t)kr * 256 + ci, v * QS);
              const f32x4 r = ROPE64(v);
              if (samp) st4bf(P.Qc_rot + (size_t)kr * 256 + ci, r * QS); }
            { const f32x4 v = CV4(r_kvc);
              const float rs = rsqrtf(sum16(dot4(v), lane) * (1.f / 64.f) + EPS);
              const f32x4 kn = v * rs * g_k;
              const f32x4 r = ROPE64(kn);
              if (lane < 32) { if (!samp) *(f32x4*)(P.o_gk + ob * 128 + ci) = kn; st4bf(P.Kc + (size_t)kr * 128 + ci, samp ? r : kn); }
              else { if (!samp) *(f32x4*)(P.o_gv + ob * 128 + 4 * (lane - 32)) = v; st4bf(P.Vc + (size_t)kr * 128 + 4 * (lane - 32), v); } }
            { const f32x4 v = CV4(r_qd);
              st4bf(P.Qd_raw + (size_t)kr * 256 + ci, v * QS);
              const f32x4 r = ROPE64(v);
              if (samp) st4bf(P.Qd_rot + (size_t)kr * 256 + ci, r * QS); }
            { const f32x4 v = CV4(r_kvd);
              const f32x4 r = ROPE64(v);
              if (lane < 32) { if (!samp) *(f32x4*)(P.o_sk + ob * 128 + ci) = v; st4bf(P.Kd + (size_t)kr * 128 + ci, samp ? r : v); }
              else { if (!samp) *(f32x4*)(P.o_sv + ob * 128 + 4 * (lane - 32)) = v; st4bf(P.Vd + (size_t)kr * 128 + 4 * (lane - 32), v); } }
#undef CV4
#undef ROPE64
        } else {
            const int ci = row - NTOK, b = ci >> 9, j = ci & 511, kr = NPR + b * 2560 + 2048 + j;
            const size_t cb = (size_t)((b * 2 + l) * 512 + j);
            f32x4 z = (f32x4){0.f, 0.f, 0.f, 0.f}; asm volatile("" : "+v"(z));
            if (lane < 48) st4bf(P.A2 + (size_t)kr * 384 + 4 * lane, z);
            if (lane < 32) st4bf(P.A2 + (size_t)kr * 384 + 192 + 4 * lane, *(const f32x4*)(P.c_ckv + cb * 128 + 4 * lane));
            else if (lane < 48) st4bf(P.A2 + (size_t)kr * 384 + 320 + 4 * (lane - 32), z);
            if (lane < 8) st4bf(P.KPE + (size_t)kr * 32 + 4 * lane, *(const f32x4*)(P.c_kpe + cb * 32 + 4 * lane));
            if (lane < 32) { st4bf(P.Kc + (size_t)kr * 128 + 4 * lane, *(const f32x4*)(P.c_gk + cb * 128 + 4 * lane));
                             st4bf(P.Kd + (size_t)kr * 128 + 4 * lane, *(const f32x4*)(P.c_sk + cb * 128 + 4 * lane)); }
            else { st4bf(P.Vc + (size_t)kr * 128 + 4 * (lane - 32), *(const f32x4*)(P.c_gv + cb * 128 + 4 * (lane - 32)));
                   st4bf(P.Vd + (size_t)kr * 128 + 4 * (lane - 32), *(const f32x4*)(P.c_sv + cb * 128 + 4 * (lane - 32))); }
        }
    }
}

struct AttnSrc {
    const bf16* Qraw; const bf16* Qrot; int qpitch;
    const bf16* K0; int k0pitch; const bf16* K1;
    const bf16* V; int vpitch;
    bf16* Y; int outcol;
    int krbase, rowbase, q0, lo, hi, nctx;
    bool samp, window; float m0; bool sink;
    const float* rope;
};
template <int DK>
__device__ __forceinline__ void attn_unit(const AttnSrc& S, LAS unsigned char* lds, int tid, int lane, int wave, unsigned* ctr, unsigned& nxt_u) {
    constexpr int TK = 128, NKB = TK / 16, NPP = TK / 32;
    constexpr int KP = DK + 8, VP = TK + 8, KS = DK / 32, CPK = DK / 8;
    constexpr int NKC = TK * CPK / NT, NVC = TK * 8 / NT;
    LAS bf16* Ks = (LAS bf16*)lds;
    LAS bf16* Vt = (LAS bf16*)(lds + 2 * TK * KP * 2);
    const int g = lane >> 4, fr = lane & 15;
    const int qpos = S.q0 + wave * 16 + fr;
    const size_t qkr = (size_t)(S.krbase + qpos);
    bf16x8 qraw[KS], qrot[KS];
#pragma unroll
    for (int ks = 0; ks < KS; ++ks) { qraw[ks] = *(const bf16x8*)(S.Qraw + qkr * S.qpitch + ks * 32 + g * 8); qrot[ks] = qraw[ks]; }
    if (S.samp) {
        if (DK == 96) {
            const bf16x8 own = qraw[KS - 1], par = *(const bf16x8*)(S.Qraw + qkr * S.qpitch + 64 + (g ^ 1) * 8);
            const int pos = g < 2 ? (qpos >> 6) : (qpos & 63);
            const float sg = (g & 1) ? 1.f : -1.f;
            const float* ct = S.rope + 2048 + pos * 8; const float* st = S.rope + 2560 + pos * 8;
            bf16x8 r;
#pragma unroll
            for (int e = 0; e < 8; ++e) { const float o = bflo((unsigned)(unsigned short)own[e]), p = bflo((unsigned)(unsigned short)par[e]);
                r[e] = (short)f2bf(o * ct[e] + p * st[e] * sg); }
            qrot[KS - 1] = r;
        } else {
#pragma unroll
            for (int ks = 0; ks < KS; ++ks) qrot[ks] = *(const bf16x8*)(S.Qrot + qkr * S.qpitch + ks * 32 + g * 8);
        }
    }
    bf16x8 qc[KS];
#pragma unroll
    for (int ks = 0; ks < KS; ++ks) qc[ks] = S.samp ? qrot[ks] : qraw[ks];
    float m = S.m0, l = (S.sink && g == 0) ? 1.f : 0.f;
    f32x4 o[4];
#pragma unroll
    for (int d = 0; d < 4; ++d) o[d] = (f32x4){0.f, 0.f, 0.f, 0.f};
    const int nloc = S.hi - S.lo, ntile = nloc + S.nctx;
    u32x4 kreg[NKC], vreg[NVC];
    auto gload = [&](int j) {
        const int tile = j < nloc ? S.lo + j : (2048 / TK) + (j - nloc);
        const size_t kr = (size_t)(S.krbase + tile * TK);
#pragma unroll
        for (int c = 0; c < NKC; ++c) { const int ch = tid + c * NT, key = ch / CPK, part = ch % CPK;
            if (DK == 64) kreg[c] = *(const u32x4*)(S.K0 + (kr + key) * S.k0pitch + part * 8);
            else kreg[c] = part < 8 ? *(const u32x4*)(S.K0 + (kr + key) * S.k0pitch + part * 8) : *(const u32x4*)(S.K1 + (kr + key) * 32 + (part - 8) * 8); }
#pragma unroll
        for (int c = 0; c < NVC; ++c) { const int ch = tid + c * NT, vkey = ch & (TK - 1), vdc = ch / TK;
            vreg[c] = *(const u32x4*)(S.V + (kr + vkey) * S.vpitch + vdc * 8); }
    };
    auto lstore = [&](int buf) {
        LAS bf16* kb = Ks + buf * TK * KP; LAS bf16* vb = Vt + buf * 64 * VP;
#pragma unroll
        for (int c = 0; c < NKC; ++c) { const int ch = tid + c * NT, key = ch / CPK, part = ch % CPK; *(LAS u32x4*)(kb + key * KP + part * 8) = kreg[c]; }
#pragma unroll
        for (int c = 0; c < NVC; ++c) { const int ch = tid + c * NT, vkey = ch & (TK - 1), vdc = ch / TK;
            LAS bf16* vp = vb + (vdc * 8) * VP + vkey; const u32x4 v = vreg[c];
            vp[0 * VP] = (bf16)(v.x & 0xffffu); vp[1 * VP] = (bf16)(v.x >> 16); vp[2 * VP] = (bf16)(v.y & 0xffffu); vp[3 * VP] = (bf16)(v.y >> 16);
            vp[4 * VP] = (bf16)(v.z & 0xffffu); vp[5 * VP] = (bf16)(v.z >> 16); vp[6 * VP] = (bf16)(v.w & 0xffffu); vp[7 * VP] = (bf16)(v.w >> 16); }
    };
    gload(0); lstore(0);
    __syncthreads();
    for (int j = 0; j < ntile; ++j) {
        const int buf = j & 1;
        if (j + 1 < ntile) gload(j + 1);
        else if (tid == 0) nxt_u = atomicAdd(ctr, 1u);
        const bool loc = j < nloc;
        if (j == nloc) {
#pragma unroll
            for (int ks = 0; ks < KS; ++ks) qc[ks] = qraw[ks]; }
        const LAS bf16* kb = Ks + buf * TK * KP; const LAS bf16* vb = Vt + buf * 64 * VP;
        f32x4 s[NKB];
#pragma unroll
        for (int kk = 0; kk < NKB; ++kk) { s[kk] = (f32x4){0.f, 0.f, 0.f, 0.f};
#pragma unroll
            for (int ks = 0; ks < KS; ++ks) { const bf16x8 af = *(const LAS bf16x8*)(kb + (kk * 16 + fr) * KP + ks * 32 + g * 8);
                s[kk] = __builtin_amdgcn_mfma_f32_16x16x32_bf16(af, qc[ks], s[kk], 0, 0, 0); } }
        if (S.window && loc) {
            const int kp0 = (S.lo + j) * TK + g * 4;
#pragma unroll
            for (int kk = 0; kk < NKB; ++kk)
#pragma unroll
                for (int i = 0; i < 4; ++i) { const int d = kp0 + kk * 16 + i - qpos; if (d > 128 || d < -128) s[kk][i] = -INFINITY; }
        }
        float mx = -INFINITY;
#pragma unroll
        for (int kk = 0; kk < NKB; ++kk) mx = fmaxf(mx, fmaxf(fmaxf(s[kk][0], s[kk][1]), fmaxf(s[kk][2], s[kk][3])));
        mx = fmaxf(mx, shx(mx, 16, lane)); mx = fmaxf(mx, shx(mx, 32, lane));
        const float mn = fmaxf(m, mx), alpha = __builtin_amdgcn_exp2f(m - mn);
        m = mn;
        float ls = 0.f;
#pragma unroll
        for (int kk = 0; kk < NKB; ++kk)
#pragma unroll
            for (int i = 0; i < 4; ++i) { const float p = __builtin_amdgcn_exp2f(s[kk][i] - mn); s[kk][i] = p; ls += p; }
        l = l * alpha + ls;
#pragma unroll
        for (int d = 0; d < 4; ++d) o[d] = o[d] * alpha;
        bf16x8 pf[NPP];
#pragma unroll
        for (int pp = 0; pp < NPP; ++pp) {
            const unsigned w0 = pk2(s[2 * pp][0], s[2 * pp][1]), w1 = pk2(s[2 * pp][2], s[2 * pp][3]), w2 = pk2(s[2 * pp + 1][0], s[2 * pp + 1][1]), w3 = pk2(s[2 * pp + 1][2], s[2 * pp + 1][3]);
            pf[pp] = __builtin_bit_cast(bf16x8, (u32x4){w0, w1, w2, w3});
        }
#pragma unroll
        for (int d = 0; d < 4; ++d)
#pragma unroll
            for (int pp = 0; pp < NPP; ++pp) {
                const LAS bf16* vr = vb + (d * 16 + fr) * VP + pp * 32 + g * 4;
                const u32x2 lo = *(const LAS u32x2*)vr, hi = *(const LAS u32x2*)(vr + 16);
                const bf16x8 af = __builtin_bit_cast(bf16x8, (u32x4){lo.x, lo.y, hi.x, hi.y});
                o[d] = __builtin_amdgcn_mfma_f32_16x16x32_bf16(af, pf[pp], o[d], 0, 0, 0);
            }
        if (j + 1 < ntile) lstore(buf ^ 1);
        __syncthreads();
    }
    float lt = l + shx(l, 16, lane); lt += shx(lt, 32, lane);
    const float inv = 1.f / lt;
    bf16* yr = S.Y + (size_t)(S.rowbase + qpos) * DM + S.outcol + g * 4;
#pragma unroll
    for (int d = 0; d < 4; ++d) st4bf(yr + d * 16, o[d] * inv);
}

struct AttnBufs { const bf16 *MQKV, *KPE, *Qc_rot, *Qc_raw, *Kc, *Vc, *Qd_rot, *Qd_raw, *Kd, *Vd; bf16* YCAT; const float* sink; const float* rope; unsigned* ctr; };
constexpr int ATT_NU = 384 + 768;
__device__ __forceinline__ void attn_phase(const AttnBufs& B, LAS unsigned char* lds, int tid, int lane, int wave) {
    volatile LAS unsigned* shu = (volatile LAS unsigned*)(lds + LDS_CTL);
    if (tid == 0) *shu = atomicAdd(B.ctr, 1u);
    __syncthreads();
    for (;;) {
        const int u = (int)*shu;
        if (u >= ATT_NU) break;
        unsigned nxt_u = 0u;
        int type, b, h, qt; bool samp;
        if (u < 384) { type = u >> 7; const int v = u & 127; b = v >> 6; h = (v >> 4) & 3; qt = v & 15; samp = true; }
        else { const int w = u - 384; type = w >> 8; const int v = w & 255; b = v >> 3; h = (v >> 1) & 3; qt = v & 1; samp = false; }
        AttnSrc S;
        S.samp = samp; S.q0 = qt * 128; S.rope = B.rope; S.Y = B.YCAT;
        S.krbase = samp ? NPR + b * 2560 : b * 256; S.rowbase = samp ? NPR + b * 2048 : b * 256;
        S.window = false; S.sink = false; S.m0 = -1e30f;
        if (!samp) { S.lo = 0; S.hi = 2; S.nctx = 0; }
        else { S.lo = 0; S.hi = 16; S.nctx = 4; }
        if (type == 0) {
            S.Qraw = B.MQKV + h * 96; S.Qrot = S.Qraw; S.qpitch = 1024; S.K0 = B.MQKV + 384 + h * 128; S.k0pitch = 1024; S.K1 = B.KPE; S.V = B.MQKV + 384 + h * 128 + 64; S.vpitch = 1024; S.outcol = 256 + h * 64;
            attn_unit<96>(S, lds, tid, lane, wave, B.ctr, nxt_u);
        } else {
            if (type == 1) { S.Qraw = B.Qc_raw + h * 64; S.Qrot = B.Qc_rot + h * 64; S.K0 = B.Kc + (h >> 1) * 64; S.V = B.Vc + (h >> 1) * 64; S.outcol = 512 + h * 64; }
            else { S.Qraw = B.Qd_raw + h * 64; S.Qrot = B.Qd_rot + h * 64; S.K0 = B.Kd + (h >> 1) * 64; S.V = B.Vd + (h >> 1) * 64; S.outcol = 768 + h * 64;
                   S.sink = true; S.m0 = B.sink[h] * LOG2E;
                   if (samp) { S.window = true; const int lo = S.q0 / 128 - 1; S.lo = lo < 0 ? 0 : lo; const int hi = S.q0 / 128 + 2; S.hi = hi > 16 ? 16 : hi; } }
            S.qpitch = 256; S.k0pitch = 128; S.K1 = nullptr; S.vpitch = 128;
            attn_unit<64>(S, lds, tid, lane, wave, B.ctr, nxt_u);
        }
        if (tid == 0) *shu = nxt_u;
        __syncthreads();
    }
}

__device__ __forceinline__ void load8(const bf16* p, float (&o)[8]) { const u32x4 u = *(const u32x4*)p; o[0] = bflo(u.x); o[1] = bfhi(u.x); o[2] = bflo(u.y); o[3] = bfhi(u.y); o[4] = bflo(u.z); o[5] = bfhi(u.z); o[6] = bflo(u.w); o[7] = bfhi(u.w); }
__device__ __forceinline__ void convgate_phase(const bf16* U, const float* cf, bf16* ACT, int gt, int NGT) {
    constexpr int NCH = DFF / 8, RG = 8;
    for (int it = gt; it < (NTOK / RG) * NCH; it += NGT) {
        const int rg = it / NCH, cc = it % NCH, r0 = rg * RG, col = cc * 8;
        const bool samp = r0 >= NPR; const int t0 = samp ? ((r0 - NPR) & 2047) : (r0 & 255), T = samp ? 2048 : 256;
        const bf16* up = U + (size_t)r0 * DUP + col;
        u32x4 ra[RG + 2], rb[RG + 2];
        const u32x4 z4 = (u32x4){0u, 0u, 0u, 0u};
        ra[0] = z4; rb[0] = z4; ra[RG + 1] = z4; rb[RG + 1] = z4;
        if (t0 > 0) { ra[0] = *(const u32x4*)(up - DUP); rb[0] = *(const u32x4*)(up - DUP + DFF); }
#pragma unroll
        for (int i = 0; i < RG; ++i) { ra[i + 1] = *(const u32x4*)(up + (size_t)i * DUP); rb[i + 1] = *(const u32x4*)(up + (size_t)i * DUP + DFF); }
        if (t0 + RG < T) { ra[RG + 1] = *(const u32x4*)(up + (size_t)RG * DUP); rb[RG + 1] = *(const u32x4*)(up + (size_t)RG * DUP + DFF); }
        float wa[3][8], wb[3][8];
#pragma unroll
        for (int k = 0; k < 3; ++k) { const f32x4 a0 = *(const f32x4*)(cf + k * DUP + col), a1 = *(const f32x4*)(cf + k * DUP + col + 4), b0 = *(const f32x4*)(cf + k * DUP + DFF + col), b1 = *(const f32x4*)(cf + k * DUP + DFF + col + 4);
#pragma unroll
            for (int e = 0; e < 4; ++e) { wa[k][e] = a0[e]; wa[k][4 + e] = a1[e]; wb[k][e] = b0[e]; wb[k][4 + e] = b1[e]; } }
#pragma unroll
        for (int i = 0; i < RG; ++i) {
            float r[8];
#pragma unroll
            for (int h = 0; h < 4; ++h) {
                const unsigned pa = ra[i][h], ca = ra[i + 1][h], na = ra[i + 2][h], pb = rb[i][h], cb = rb[i + 1][h], nb = rb[i + 2][h];
                const float xa0 = wa[0][2 * h] * bflo(pa) + wa[1][2 * h] * bflo(ca) + wa[2][2 * h] * bflo(na), xb0 = wb[0][2 * h] * bflo(pb) + wb[1][2 * h] * bflo(cb) + wb[2][2 * h] * bflo(nb);
                const float xa1 = wa[0][2 * h + 1] * bfhi(pa) + wa[1][2 * h + 1] * bfhi(ca) + wa[2][2 * h + 1] * bfhi(na), xb1 = wb[0][2 * h + 1] * bfhi(pb) + wb[1][2 * h + 1] * bfhi(cb) + wb[2][2 * h + 1] * bfhi(nb);
                r[2 * h] = xa0 * __builtin_amdgcn_rcpf(1.f + __builtin_amdgcn_exp2f(-xa0 * LOG2E)) * xb0;
                r[2 * h + 1] = xa1 * __builtin_amdgcn_rcpf(1.f + __builtin_amdgcn_exp2f(-xa1 * LOG2E)) * xb1;
            }
            u32x4 w; w.x = pk2(r[0], r[1]); w.y = pk2(r[2], r[3]); w.z = pk2(r[4], r[5]); w.w = pk2(r[6], r[7]);
            *(u32x4*)(ACT + (size_t)(r0 + i) * DFF + col) = w;
        }
    }
}

#define XB_TMO      128
#define XB_XCNT(j)  (256  + 64 * (j))
#define XB_XSUB(j)  (1280 + 64 * (j))
#define XB_XGEN(j)  (2304 + 64 * (j))
#define XB_TOP      3328
#define XB_TOPGEN   3392
#define XCD_BAR_WORDS 3456
#define XB_SPIN_CAP (1u << 20)
__device__ __forceinline__ unsigned xb_ld(unsigned* p)              { return __hip_atomic_load(p, __ATOMIC_RELAXED, __HIP_MEMORY_SCOPE_AGENT); }
__device__ __forceinline__ unsigned xb_add(unsigned* p, unsigned v) { return __hip_atomic_fetch_add(p, v, __ATOMIC_RELAXED, __HIP_MEMORY_SCOPE_AGENT); }
__device__ __forceinline__ unsigned xb_xcc_id() { return (unsigned)__builtin_amdgcn_s_getreg((3 << 11) | 20) & 0xFu; }
#define XB_SPIN(cond, bar) do { unsigned _sp = 0; while (cond) { __builtin_amdgcn_s_sleep(1); \
    if ((++_sp & 255u) == 0u) { if (xb_ld(&(bar)[XB_TMO])) break; if (_sp > XB_SPIN_CAP) { atomicAdd(&(bar)[XB_TMO], 1u); break; } } } } while (0)
struct XcdBarrier { unsigned* bar; unsigned x; volatile LAS unsigned* st; };
__device__ __forceinline__ void xcd_barrier_complete(unsigned* bar, unsigned x, unsigned& nloc, unsigned& nx) {
    const unsigned G = gridDim.x * gridDim.y * gridDim.z;
    unsigned sum, cnt, mine, sp = 0u;
    for (;;) {
        sum = 0u; cnt = 0u; mine = 0u;
#pragma unroll
        for (unsigned j = 0; j < 16; ++j) { const unsigned c = xb_ld(&bar[XB_XCNT(j)]); sum += c; cnt += (c > 0u) ? 1u : 0u; mine = (j == x) ? c : mine; }
        if (sum == G) break;
        __builtin_amdgcn_s_sleep(1);
        if ((++sp & 255u) == 0u) { if (xb_ld(&bar[XB_TMO])) break; if (sp > XB_SPIN_CAP) { atomicAdd(&bar[XB_TMO], 1u); break; } }
    }
    nloc = mine > 0u ? mine : 1u; nx = cnt > 0u ? cnt : 1u;
}
__device__ __forceinline__ void xcd_barrier(const XcdBarrier& b, const int tid_) {
    asm volatile("s_waitcnt vmcnt(0)" ::: "memory");
    __syncthreads();
    if (tid_ == 0) {
        unsigned* bar = b.bar;
        __builtin_amdgcn_s_waitcnt(0);
        unsigned nloc = b.st[0], nx = b.st[1];
        if (nloc == 0u) { xcd_barrier_complete(bar, b.x, nloc, nx); b.st[0] = nloc; b.st[1] = nx; }
        const unsigned old = xb_add(&bar[XB_XSUB(b.x)], 1u);
        const unsigned gen = old / nloc;
        if (old + 1u == (gen + 1u) * nloc) {
            __builtin_amdgcn_fence(__ATOMIC_RELEASE, "agent");
            asm volatile("s_waitcnt vmcnt(0)" ::: "memory");
            const unsigned og = xb_add(&bar[XB_TOP], 1u);
            const unsigned tg = og / nx;
            if (og + 1u == (tg + 1u) * nx) xb_add(&bar[XB_TOPGEN], 1u);
            else XB_SPIN(xb_ld(&bar[XB_TOPGEN]) == tg, bar);
            __builtin_amdgcn_fence(__ATOMIC_ACQUIRE, "agent");
            xb_add(&bar[XB_XGEN(b.x)], 1u);
            asm volatile("s_waitcnt vmcnt(0)" ::: "memory");
        } else {
            XB_SPIN(xb_ld(&bar[XB_XGEN(b.x)]) == gen, bar);
            __builtin_amdgcn_fence(__ATOMIC_ACQUIRE, "agent");
            asm volatile("s_waitcnt vmcnt(0)" ::: "memory");
        }
    }
    __syncthreads();
}

__device__ __forceinline__ int lane_id_volatile() { int l; asm volatile("v_mbcnt_lo_u32_b32 %0, -1, 0\n\tv_mbcnt_hi_u32_b32 %0, -1, %0" : "=v"(l)); return l; }

#ifndef PH
#define PH 0xFFFF
#endif
#define ON(k) ((PH >> (k)) & 1)
#ifndef REP
#define REP 0
#endif
#define NREP(k) (1 + ((REP >> (k)) & 1))
__global__ void __launch_bounds__(NT, 2) mega_fwd(Args a_unused) {
    extern __shared__ __attribute__((aligned(16))) unsigned char lds[];
    cg::grid_group grid = cg::this_grid();
    const int G = gridDim.x, bid = blockIdx.x;
    const int wave_s = __builtin_amdgcn_readfirstlane(threadIdx.x >> 6);
    PG8_LAS unsigned char* ring = (PG8_LAS unsigned char*)lds;
#define PHASE_BEGIN int tid = wave_s * 64 + lane_id_volatile(); asm volatile("" : "+v"(tid)); const CAS Args* ap_ = (const CAS Args*)__builtin_amdgcn_kernarg_segment_ptr(); asm volatile("" : "+s"(ap_)); const CAS Args& a = *ap_; unsigned char* ws = a.ws; float* out = a.out; \
    const int lane = tid & 63, wave = __builtin_amdgcn_readfirstlane(tid >> 6); const int gw = bid * NW + wave, NGW = G * NW, gt = bid * NT + tid, NGT = G * NT; \
    (void)lane; (void)wave; (void)gw; (void)NGW; (void)gt; (void)NGT; (void)out; \
    const float* mod = (const float*)(ws + WS_MOD); const float* rope = (const float*)(ws + WS_ROPE); (void)mod; (void)rope; \
    bf16* XN = (bf16*)(ws + WS_XN); bf16* PROJ = (bf16*)(ws + WS_PROJ); bf16* A2 = (bf16*)(ws + WS_A2); bf16* MQKV = (bf16*)(ws + WS_MQKV); \
    bf16* KPE = (bf16*)(ws + WS_KPE); bf16* YCAT = (bf16*)(ws + WS_YCAT); bf16* ACT = (bf16*)(ws + WS_ACT); bf16* U = (bf16*)(ws + WS_U); \
    bf16* Qc_rot = (bf16*)(ws + WS_QC); bf16* Qc_raw = (bf16*)(ws + WS_QC + QSZ); bf16* Kc = (bf16*)(ws + WS_QC + 2 * QSZ); bf16* Vc = (bf16*)(ws + WS_QC + 2 * QSZ + KSZ); \
    bf16* Qd_rot = (bf16*)(ws + WS_QC + 2 * QSZ + 2 * KSZ); bf16* Qd_raw = Qd_rot + (size_t)NKR * 256; bf16* Kd = Qd_raw + (size_t)NKR * 256; bf16* Vd = Kd + (size_t)NKR * 128; \
    (void)XN; (void)PROJ; (void)A2; (void)MQKV; (void)KPE; (void)YCAT; (void)ACT; (void)U; (void)Qc_rot; (void)Qc_raw; (void)Kc; (void)Vc; (void)Qd_rot; (void)Qd_raw; (void)Kd; (void)Vd;
#define GSYNC() do { const CAS Args* bp_ = (const CAS Args*)__builtin_amdgcn_kernarg_segment_ptr(); asm volatile("" : "+s"(bp_)); XcdBarrier xb_; xb_.bar = (unsigned*)(bp_->ws + WS_BAR); xb_.x = xb_xcc_id(); \
    xb_.st = (volatile LAS unsigned*)((LAS unsigned char*)lds + LDS_CTL + 32); xcd_barrier(xb_, wave_s * 64 + lane_id_volatile()); } while (0)
#define LAYER_VALS const float* modl = mod + (size_t)l * 3 * 6144; unsigned char* wl = ws + WS_W + l * W_LSTRIDE; (void)modl; (void)wl; \
    const float* x0 = l == 0 ? a.in[0] : nullptr; const float* x1 = l == 0 ? a.in[1] : nullptr; (void)x0; (void)x1; bf16* XRES = (bf16*)(ws + WS_XRES); (void)XRES;

    if (threadIdx.x < 16) ((volatile LAS unsigned*)((LAS unsigned char*)lds + LDS_CTL))[threadIdx.x] = 0u;
    __syncthreads();
    { PHASE_BEGIN if (tid == 0) (void)xb_add((unsigned*)(ws + WS_BAR) + XB_XCNT(xb_xcc_id()), 1u);
      if (ws == nullptr) grid.sync(); }
    for (int rep = 0; rep < NREP(0); ++rep) {
    if (ON(0)) { PHASE_BEGIN phase0(a, (LAS unsigned char*)lds, tid, lane, wave); }
    GSYNC(); }

    if (ON(1)) { PHASE_BEGIN
        if (G > 124) {
            if (bid < 62) bias_phase(a, ws, (LAS unsigned char*)lds, tid, lane, wave);
            else prep_phase(a.in[0], a.in[1], a.in[12], mod, 1024, XN, (float*)(ws + WS_SS1), lane, (bid - 62) * NW + wave, (G - 62) * NW);
        } else { bias_phase(a, ws, (LAS unsigned char*)lds, tid, lane, wave);
            prep_phase(a.in[0], a.in[1], a.in[12], mod, 1024, XN, (float*)(ws + WS_SS1), lane, gw, NGW); } }
    GSYNC();
#pragma unroll
    for (int l = 0; l < 2; ++l) {
        for (int rep = 0; rep < NREP(2); ++rep) {
        if (ON(2)) { PHASE_BEGIN LAYER_VALS pg8::Gemm g{XN, (const bf16*)(wl + W_IN), NTOK, INP, DM, 0, 0}; pg8::StaticOrder S; S.init(NTOK, INP, G, bid);
          pg8::EpiBf16RS E{PROJ, INP, (const float*)(ws + WS_SS1), (const float*)(ws + WS_BIAS) + (size_t)l * 3 * NBIAS, NBIAS};
          pg8::gemm_phase<pg8::EpiBf16RS, pg8::StaticOrder, true, true>(ring, g, S, E, tid); }
        GSYNC(); }
        for (int rep = 0; rep < NREP(3); ++rep) {
        if (ON(3)) { PHASE_BEGIN P3Ptrs P; P.PROJ = PROJ; P.A2 = A2; P.KPE = KPE; P.YCAT = YCAT; P.Qc_rot = Qc_rot; P.Qc_raw = Qc_raw; P.Kc = Kc; P.Vc = Vc; P.Qd_rot = Qd_rot; P.Qd_raw = Qd_raw; P.Kd = Kd; P.Vd = Vd;
          P.conv_a = a.in[14]; P.gq_mla = a.in[15]; P.gkv_mla = a.in[17]; P.gq = a.in[19]; P.gk = a.in[20]; P.rope = rope;
          P.c_ckv = a.in[2]; P.c_kpe = a.in[3]; P.c_gk = a.in[4]; P.c_gv = a.in[5]; P.c_sk = a.in[6]; P.c_sv = a.in[7];
          P.o_ckv = out + 12582912; P.o_kpe = out + 14680064; P.o_gk = out + 15204352; P.o_gv = out + 17301504; P.o_sk = out + 19398656; P.o_sv = out + 21495808; P.l = l;
          p3_phase(P, lane, gw, NGW); }
        GSYNC(); }
        for (int rep = 0; rep < NREP(4); ++rep) {
        if (ON(4)) { PHASE_BEGIN LAYER_VALS pg8::Gemm g{A2, (const bf16*)(wl + W_B2), NKR, 1024, 384, 0, 0}; pg8::StaticOrder S; S.init(NKR, 1024, G, bid); pg8::EpiBf16 E{MQKV, 1024};
          pg8::gemm_phase<pg8::EpiBf16, pg8::StaticOrder, true, true>(ring, g, S, E, tid); }
        GSYNC(); }
        for (int rep = 0; rep < NREP(5); ++rep) {
        if (ON(5)) { PHASE_BEGIN AttnBufs B; B.MQKV = MQKV; B.KPE = KPE; B.Qc_rot = Qc_rot; B.Qc_raw = Qc_raw; B.Kc = Kc; B.Vc = Vc; B.Qd_rot = Qd_rot; B.Qd_raw = Qd_raw; B.Kd = Kd; B.Vd = Vd; B.YCAT = YCAT;
          B.sink = a.in[21] + l * 4; B.rope = rope; B.ctr = (unsigned*)(ws + WS_CTL) + 64 * l + 128 * rep;
          attn_phase(B, (LAS unsigned char*)lds, tid, lane, wave); }
        GSYNC(); }
        if (ON(6)) { PHASE_BEGIN LAYER_VALS pg8::Gemm g{YCAT, (const bf16*)(wl + W_OUT), NTOK, DM, DM, 0, 0}; pg8::StaticOrder S; S.init(NTOK, DM, G, bid);
          pg8::EpiResid E{x0, x1, XRES, modl + 2048, XN, (float*)(ws + WS_SS2), a.in[23] + l * DM, modl + 4096};
          pg8::gemm_phase<pg8::EpiResid, pg8::StaticOrder, true, true>(ring, g, S, E, tid);
          if (l == 0) { const int wk = G > 192 ? bid - 192 : bid, nwk = G > 192 ? G - 192 : G;
            if (wk >= 0) wconv(a, ws, 0, 4 | 8, wk * NW + wave, nwk * NW, (LAS float*)((LAS unsigned char*)lds + wave * 16640), lane); } }
        GSYNC();
        for (int rep = 0; rep < NREP(8); ++rep) {
        if (ON(8)) { PHASE_BEGIN LAYER_VALS pg8::Gemm g{XN, (const bf16*)(wl + W_UP), NTOK, DUP, DM, (size_t)128 * DM * 2, (size_t)DFF * DM * 2}; pg8::StaticOrder S; S.init(NTOK, DUP, G, bid);
          pg8::EpiUpGate E{ACT, (const float*)(ws + WS_SS2), (const float*)(ws + WS_BIAS) + (size_t)l * 3 * NBIAS + 2304, NBIAS, a.in[25] + (size_t)l * 3 * DUP, (float*)(ws + WS_HALO), ring + 131072};
          pg8::gemm_phase<pg8::EpiUpGate, pg8::StaticOrder, true, true>(ring, g, S, E, tid); }
        GSYNC(); }
        if (ON(10)) { PHASE_BEGIN LAYER_VALS pg8::Gemm g{ACT, (const bf16*)(wl + W_DOWN), NTOK, DM, DFF, 0, 0}; pg8::StaticOrder S; S.init(NTOK, DM, G, bid);
          {
            const float* cwl = a.in[25] + (size_t)l * 3 * DUP; const float* HALO = (const float*)(ws + WS_HALO); pg8::Unit hu;
            bool fixed = false;
            for (int ui = 0; S.next(ui, hu); ++ui) { if (hu.pm < 32) continue; fixed = true; const int k = hu.pm - 32, pos = k & 7;
                for (int idx = tid; idx < 2 * DFF; idx += NT) { const int which = idx >= DFF ? 1 : 0, j = idx - which * DFF;
                    if (which == 0 ? pos == 0 : pos == 7) continue;
                    const float* Pp = HALO + (size_t)(k * 4 + (which ? 3 : 1)) * DUP; const float* Ep = HALO + (size_t)((which ? k + 1 : k - 1) * 4 + (which ? 0 : 2)) * DUP; const float* wp = cwl + (which ? 2 : 0) * DUP;
                    const float ca = Pp[j] + wp[j] * Ep[j], cb = Pp[DFF + j] + wp[DFF + j] * Ep[DFF + j];
                    const float r = ca * __builtin_amdgcn_rcpf(1.f + __builtin_amdgcn_exp2f(-ca * LOG2E)) * cb;
                    ACT[(size_t)(hu.pm * 256 + (which ? 255 : 0)) * DFF + j] = (bf16)(pk2(r, r) & 0xffffu); } }
            if (fixed) { asm volatile("s_waitcnt vmcnt(0)" ::: "memory"); __syncthreads();
                if (tid == 0) { __builtin_amdgcn_fence(__ATOMIC_RELEASE, "agent"); __builtin_amdgcn_fence(__ATOMIC_ACQUIRE, "agent"); asm volatile("s_waitcnt vmcnt(0)" ::: "memory"); }
                __syncthreads(); } }
          if (l == 1 && G >= 192) {
            pg8::EpiResidFinal E{XRES, out, modl + 5120, (float*)(ws + WS_SS1), a.in[27], (unsigned*)(ws + WS_CTL) + 2048};
            pg8::gemm_phase<pg8::EpiResidFinal, pg8::StaticOrder, true, true>(ring, g, S, E, tid);
          } else {
          pg8::EpiResid E{nullptr, nullptr, XRES, modl + 5120, l == 0 ? XN : nullptr, (float*)(ws + WS_SS1), a.in[12] + DM, mod + (size_t)3 * 6144 + 1024};
          pg8::gemm_phase<pg8::EpiResid, pg8::StaticOrder, true, true>(ring, g, S, E, tid); }
          if (l == 0) { const int wk = G > 192 ? bid - 192 : bid, nwk = G > 192 ? G - 192 : G;
            if (wk >= 0) wconv(a, ws, 1, 63, wk * NW + wave, nwk * NW, (LAS float*)((LAS unsigned char*)lds + wave * 16640), lane); } }
        if (!(l == 1 && G >= 192)) GSYNC();
    }
#ifdef XSYNC
    for (int i = 0; i < XSYNC; ++i) GSYNC();
#endif
    if (G < 192) { PHASE_BEGIN
    const bf16* XRES = (const bf16*)(ws + WS_XRES);
    for (int row = gw; row < NTOK; row += NGW) {
        float* xr = out + (size_t)row * DM;
        f32x4 v[4]; float ss = 0.f;
#pragma unroll
        for (int j = 0; j < 4; ++j) { v[j] = ld4bf(XRES + (size_t)row * DM + 4 * (lane + 64 * j)); ss += dot4(v[j]); }
        const float rs = rsqrtf(wave_sum(ss, lane) * (1.f / DM) + EPS);
#pragma unroll
        for (int j = 0; j < 4; ++j) { const int col = 4 * (lane + 64 * j); *(f32x4*)(xr + col) = v[j] * rs * *(const f32x4*)(a.in[27] + col); }
    } }
}

extern "C" void kernel_launch(void* const* d_in, const int* in_sizes, int n_in, void* d_out, int out_size, void* d_ws, size_t ws_size, hipStream_t stream) {
    static int grid = 0;
    if (grid == 0) {
        if (n_in != 28 || ws_size < WS_END) { fprintf(stderr, "kernel_launch: unexpected n_in %d / ws %zu\n", n_in, ws_size); grid = -1; return; }
        int dev = 0, cus = 0, per_cu = 0;
        hipGetDevice(&dev); hipDeviceGetAttribute(&cus, hipDeviceAttributeMultiprocessorCount, dev);
        hipFuncSetAttribute((const void*)mega_fwd, hipFuncAttributeMaxDynamicSharedMemorySize, LDS_BYTES);
        hipOccupancyMaxActiveBlocksPerMultiprocessor(&per_cu, (const void*)mega_fwd, NT, LDS_BYTES);
        if (per_cu < 1) per_cu = 1;
        grid = cus * per_cu;
        (void)hipGetLastError();
    }
    if (grid < 0) return;
    if (hipMemsetAsync((char*)d_ws + WS_BAR, 0, XCD_BAR_WORDS * 4, stream) != hipSuccess) { fprintf(stderr, "kernel_launch: memset of the barrier words failed\n"); return; }
    Args a{};
    for (int i = 0; i < 28; ++i) a.in[i] = (const float*)d_in[i];
    a.out = (float*)d_out; a.ws = (unsigned char*)d_ws;
    void* args[] = {&a};
    hipError_t e = hipLaunchCooperativeKernel((const void*)mega_fwd, dim3(grid), dim3(NT), args, LDS_BYTES, stream);
    if (e != hipSuccess) fprintf(stderr, "cooperative launch failed: %s (grid %d)\n", hipGetErrorString(e), grid);
}
```

```cpp
#include <hip/hip_runtime.h>
#include <hip/hip_cooperative_groups.h>
#include <cstdio>
#include <cstdint>
namespace cg = cooperative_groups;

namespace pg8 {
#define PG8_LAS __attribute__((address_space(3)))
typedef unsigned short bf16_t;
typedef short bf16x8 __attribute__((ext_vector_type(8)));
typedef float f32x4 __attribute__((ext_vector_type(4)));
typedef unsigned u32x4 __attribute__((ext_vector_type(4)));
constexpr int BM = 256, BK = 64, HALF = 128, HTB = HALF * BK * 2, STAGE_BYTES = 8 * HTB, NXCD = 8, WGM = 8;

__host__ __device__ __forceinline__ int lds_byte(int r, int c) { const int st = (r >> 4) * 2 + (c >> 5), rr = r & 15, cc = c & 31, ob = rr * 64 + cc * 2; return st * 1024 + (ob ^ (((ob >> 9) & 1) << 5)); }
__host__ __device__ __forceinline__ void stage_rc(int b, int& R, int& C) { const int st = b / 1024, sb = b % 1024, swz = sb ^ (((sb >> 9) & 1) << 5); R = (st >> 1) * 16 + swz / 64; C = (st & 1) * 32 + (swz % 64) / 2; }
__host__ __device__ __forceinline__ int perm32(int rho) { const int n = rho >> 4, i = rho & 15; return 8 * (i >> 2) + 4 * n + (i & 3); }

struct Unit { int pm, pn; };
struct Gemm { const bf16_t* A; const bf16_t* Bt; int M, N, K; size_t bstep, bhalf; };

struct StaticOrder {
    int nM, nN, nwg, G, c;
    __host__ __device__ __forceinline__ void init(int M, int N, int G_, int c_) { nM = M / BM; nN = N / BM; nwg = nM * nN; G = G_; c = c_; }
    __host__ __device__ __forceinline__ bool next(int i, Unit& u) const {
        const long L = (long)i * G + c; if (L >= nwg) return false;
        int wgid = (int)L; { const int q = nwg / NXCD, r = nwg % NXCD, xcd = wgid % NXCD, off = wgid / NXCD; wgid = (xcd < r ? xcd * (q + 1) : r * (q + 1) + (xcd - r) * q) + off; }
        const int nig = WGM * nN, gid = wgid / nig, fm = gid * WGM, gsz = (nM - fm) < WGM ? (nM - fm) : WGM;
        u.pm = fm + ((wgid % nig) % gsz); u.pn = (wgid % nig) / gsz; return true;
    }
    __device__ __forceinline__ void a_ready(const Unit&) const {}
    __device__ __forceinline__ void done(const Unit&) const {}
};

__device__ __forceinline__ unsigned cvt_pk_bf16(float lo, float hi) { unsigned r; asm volatile("v_cvt_pk_bf16_f32 %0, %1, %2" : "=v"(r) : "v"(lo), "v"(hi)); return r; }

struct EpiBf16 {
    static constexpr bool PERM = true, AFTER_DRAIN = false;
    bf16_t* O; int ldc;
    __device__ __forceinline__ void operator()(const f32x4 (&acc)[2][2][4][2], const Unit& u, int wr, int wc, int fr, int fq) const {
        asm volatile("" : "+v"(fr), "+v"(fq));
        const int row0 = u.pm * BM + wr * 64 + fr; const int col0 = u.pn * BM + wc * 32 + 8 * fq;
#pragma unroll
        for (int ai = 0; ai < 2; ++ai)
#pragma unroll
            for (int m = 0; m < 4; ++m) { bf16_t* rowp = O + (size_t)(row0 + ai * HALF + m * 16) * ldc + col0;
#pragma unroll
                for (int bj = 0; bj < 2; ++bj) { const f32x4 v0 = acc[ai][bj][m][0], v1 = acc[ai][bj][m][1];
                    u32x4 w; w.x = cvt_pk_bf16(v0[0], v0[1]); w.y = cvt_pk_bf16(v0[2], v0[3]); w.z = cvt_pk_bf16(v1[0], v1[1]); w.w = cvt_pk_bf16(v1[2], v1[3]);
                    *(u32x4*)(rowp + bj * HALF) = w; } }
    }
};
__device__ __forceinline__ float shx_(float v, int m, int lane) { return __builtin_bit_cast(float, __builtin_amdgcn_ds_bpermute((lane ^ m) << 2, __builtin_bit_cast(int, v))); }
__device__ __forceinline__ void row_scales(const float* SS, int row0, int fr, int fq, float (&rs)[8]) {
    f32x4 t[8];
#pragma unroll
    for (int q = 0; q < 8; ++q) t[q] = *(const f32x4*)(SS + (size_t)(row0 + (q >> 2) * HALF + (q & 3) * 16) * 16 + 4 * fq);
    const int lane = fq * 16 + fr;
#pragma unroll
    for (int q = 0; q < 8; ++q) { float v = (t[q][0] + t[q][1]) + (t[q][2] + t[q][3]); v += shx_(v, 16, lane); v += shx_(v, 32, lane); rs[q] = __builtin_amdgcn_rsqf(v * (1.f / 1024.f) + 1e-6f); }
}
struct EpiBf16RS {
    static constexpr bool PERM = true, AFTER_DRAIN = false;
    bf16_t* O; int ldc; const float* SS; const float* bias; int ldb;
    __device__ __forceinline__ void operator()(const f32x4 (&acc)[2][2][4][2], const Unit& u, int wr, int wc, int fr, int fq) const {
        asm volatile("" : "+v"(fr), "+v"(fq));
        const int cnd = u.pm < 32 ? 0 : 1 + ((u.pm - 32) >> 3);
        const int row0 = u.pm * BM + wr * 64 + fr; const int col0 = u.pn * BM + wc * 32 + 8 * fq;
        const float* bp = bias + (size_t)cnd * ldb + col0;
        f32x4 bv[2][2];
#pragma unroll
        for (int bj = 0; bj < 2; ++bj)
#pragma unroll
            for (int n = 0; n < 2; ++n) bv[bj][n] = *(const f32x4*)(bp + bj * HALF + 4 * n);
        float rsv[8]; row_scales(SS, row0, fr, fq, rsv);
#pragma unroll
        for (int ai = 0; ai < 2; ++ai)
#pragma unroll
            for (int m = 0; m < 4; ++m) { const int row = row0 + ai * HALF + m * 16; const float rs = rsv[ai * 4 + m];
                bf16_t* rowp = O + (size_t)row * ldc + col0;
#pragma unroll
                for (int bj = 0; bj < 2; ++bj) { const f32x4 v0 = acc[ai][bj][m][0] * rs + bv[bj][0], v1 = acc[ai][bj][m][1] * rs + bv[bj][1];
                    u32x4 w; w.x = cvt_pk_bf16(v0[0], v0[1]); w.y = cvt_pk_bf16(v0[2], v0[3]); w.z = cvt_pk_bf16(v1[0], v1[1]); w.w = cvt_pk_bf16(v1[2], v1[3]);
                    *(u32x4*)(rowp + bj * HALF) = w; } }
    }
};
struct EpiResid {
    static constexpr bool PERM = false, AFTER_DRAIN = false;
    const float* r0; const float* r1; bf16_t* XR; const float* gate;
    bf16_t* XN; float* SS; const float* nrm; const float* sc;
    __device__ __forceinline__ void operator()(const f32x4 (&acc)[2][2][4][2], const Unit& u, int wr, int wc, int fr, int fq) const {
        asm volatile("" : "+v"(fr), "+v"(fq));
        typedef unsigned u32x2_ __attribute__((ext_vector_type(2)));
        const int cnd = u.pm < 32 ? 0 : 1 + ((u.pm - 32) >> 3);
        const float* gp = gate + cnd * 6144;
        const int col0 = u.pn * BM + wc * 32 + 4 * fq;
        const int rowb = u.pm * BM + wr * 64 + fr;
        const bool inf = r0 != nullptr;
        const float* rs = (u.pm < 32 ? r0 + (size_t)rowb * 1024 : r1 + (size_t)(rowb - 8192) * 1024) + col0;
        bf16_t* op = XR + (size_t)rowb * 1024 + col0;
#define LDX(off) (inf ? __builtin_nontemporal_load((const f32x4*)(rs + (off))) : ({ const u32x2_ t_ = *(const u32x2_*)(op + (off)); (f32x4){__builtin_bit_cast(float, t_.x << 16), __builtin_bit_cast(float, t_.x & 0xffff0000u), __builtin_bit_cast(float, t_.y << 16), __builtin_bit_cast(float, t_.y & 0xffff0000u)}; }))
        const bool prep = XN != nullptr;
        f32x4 gv[2][2], hv[2][2];
#pragma unroll
        for (int bj = 0; bj < 2; ++bj)
#pragma unroll
            for (int n = 0; n < 2; ++n) { gv[bj][n] = *(const f32x4*)(gp + col0 + bj * HALF + n * 16);
                hv[bj][n] = (f32x4){0.f, 0.f, 0.f, 0.f};
                if (prep) hv[bj][n] = *(const f32x4*)(nrm + col0 + bj * HALF + n * 16) * (1.f + *(const f32x4*)(sc + cnd * 6144 + col0 + bj * HALF + n * 16)); }
        f32x4 xc[2][2], xn[2][2];
#pragma unroll
        for (int bj = 0; bj < 2; ++bj)
#pragma unroll
            for (int n = 0; n < 2; ++n) xc[bj][n] = LDX(bj * HALF + n * 16);
#pragma unroll
        for (int it = 0; it < 8; ++it) { const int ai = it >> 2, m = it & 3; const size_t ro = (size_t)(ai * HALF + m * 16) * 1024;
            if (it < 7) { const int ai2 = (it + 1) >> 2, m2 = (it + 1) & 3; const size_t ro2 = (size_t)(ai2 * HALF + m2 * 16) * 1024;
#pragma unroll
                for (int bj = 0; bj < 2; ++bj)
#pragma unroll
                    for (int n = 0; n < 2; ++n) xn[bj][n] = LDX(ro2 + bj * HALF + n * 16); }
            float ssq = 0.f;
#pragma unroll
            for (int bj = 0; bj < 2; ++bj)
#pragma unroll
                for (int n = 0; n < 2; ++n) { const f32x4 v = xc[bj][n] + gv[bj][n] * acc[ai][bj][m][n];
                    *(u32x2_*)(op + ro + bj * HALF + n * 16) = (u32x2_){cvt_pk_bf16(v[0], v[1]), cvt_pk_bf16(v[2], v[3])};
                    if (prep) { ssq += (v[0] * v[0] + v[1] * v[1]) + (v[2] * v[2] + v[3] * v[3]); const f32x4 h = v * hv[bj][n];
                        unsigned w0 = cvt_pk_bf16(h[0], h[1]), w1 = cvt_pk_bf16(h[2], h[3]);
                        *(u32x2_*)(XN + (size_t)(rowb + ai * HALF + m * 16) * 1024 + col0 + bj * HALF + n * 16) = (u32x2_){w0, w1}; } }
            if (prep) { const int lane = fq * 16 + fr; ssq += shx_(ssq, 16, lane); ssq += shx_(ssq, 32, lane);
                if (fq == 0) SS[(size_t)(rowb + ai * HALF + m * 16) * 16 + u.pn * 4 + wc] = ssq; }
#pragma unroll
            for (int bj = 0; bj < 2; ++bj)
#pragma unroll
                for (int n = 0; n < 2; ++n) xc[bj][n] = xn[bj][n];
        }
    }
#undef LDX
};

struct EpiResidFinal {
    static constexpr bool PERM = false, AFTER_DRAIN = false;
    const bf16_t* res; float* out; const float* gate; float* SS; const float* fw; unsigned* cnt;
    __device__ __forceinline__ void operator()(f32x4 (&acc)[2][2][4][2], const Unit& u, int wr, int wc, int fr, int fq) const {
        asm volatile("" : "+v"(fr), "+v"(fq));
        const int cnd = u.pm < 32 ? 0 : 1 + ((u.pm - 32) >> 3);
        const float* gp = gate + cnd * 6144;
        const int col0 = u.pn * BM + wc * 32 + 4 * fq;
        const int rowb = u.pm * BM + wr * 64 + fr;
        typedef unsigned u32x2_ __attribute__((ext_vector_type(2)));
        const bf16_t* rs = res + (size_t)rowb * 1024 + col0;
#define LDXF(off) ({ const u32x2_ t_ = *(const u32x2_*)(rs + (off)); (f32x4){__builtin_bit_cast(float, t_.x << 16), __builtin_bit_cast(float, t_.x & 0xffff0000u), __builtin_bit_cast(float, t_.y << 16), __builtin_bit_cast(float, t_.y & 0xffff0000u)}; })
        f32x4 gv[2][2];
#pragma unroll
        for (int bj = 0; bj < 2; ++bj)
#pragma unroll
            for (int n = 0; n < 2; ++n) gv[bj][n] = *(const f32x4*)(gp + col0 + bj * HALF + n * 16);
        f32x4 xc[2][2], xn[2][2];
#pragma unroll
        for (int bj = 0; bj < 2; ++bj)
#pragma unroll
            for (int n = 0; n < 2; ++n) xc[bj][n] = LDXF(bj * HALF + n * 16);
#pragma unroll
        for (int it = 0; it < 8; ++it) { const int ai = it >> 2, m = it & 3;
            if (it < 7) { const int ai2 = (it + 1) >> 2, m2 = (it + 1) & 3; const size_t ro2 = (size_t)(ai2 * HALF + m2 * 16) * 1024;
#pragma unroll
                for (int bj = 0; bj < 2; ++bj)
#pragma unroll
                    for (int n = 0; n < 2; ++n) xn[bj][n] = LDXF(ro2 + bj * HALF + n * 16); }
            float ssq = 0.f;
#pragma unroll
            for (int bj = 0; bj < 2; ++bj)
#pragma unroll
                for (int n = 0; n < 2; ++n) { const f32x4 v = xc[bj][n] + gv[bj][n] * acc[ai][bj][m][n]; acc[ai][bj][m][n] = v;
                    ssq += (v[0] * v[0] + v[1] * v[1]) + (v[2] * v[2] + v[3] * v[3]); }
            { const int lane = fq * 16 + fr; ssq += shx_(ssq, 16, lane); ssq += shx_(ssq, 32, lane);
              if (fq == 0) __hip_atomic_store(SS + (size_t)(rowb + ai * HALF + m * 16) * 16 + u.pn * 4 + wc, ssq, __ATOMIC_RELAXED, __HIP_MEMORY_SCOPE_AGENT); }
#pragma unroll
            for (int bj = 0; bj < 2; ++bj)
#pragma unroll
                for (int n = 0; n < 2; ++n) xc[bj][n] = xn[bj][n];
        }
        asm volatile("s_waitcnt vmcnt(0)" ::: "memory"); __builtin_amdgcn_s_barrier(); asm volatile("" ::: "memory");
        if (wr == 0 && wc == 0 && fr == 0 && fq == 0) {
            __builtin_amdgcn_fence(__ATOMIC_RELEASE, "agent"); asm volatile("s_waitcnt vmcnt(0)" ::: "memory");
            __hip_atomic_fetch_add(cnt + u.pm, 1u, __ATOMIC_RELAXED, __HIP_MEMORY_SCOPE_AGENT);
            unsigned sp = 0;
            while (__hip_atomic_load(cnt + u.pm, __ATOMIC_RELAXED, __HIP_MEMORY_SCOPE_AGENT) < 4u) { __builtin_amdgcn_s_sleep(1); if (++sp > (1u << 22)) break; }
            __builtin_amdgcn_fence(__ATOMIC_ACQUIRE, "agent"); asm volatile("s_waitcnt vmcnt(0)" ::: "memory");
        }
        __builtin_amdgcn_s_barrier(); asm volatile("" ::: "memory");
        float rsv[8];
        { f32x4 t[8];
#pragma unroll
          for (int q = 0; q < 8; ++q) { const float* sp = SS + (size_t)(rowb + (q >> 2) * HALF + (q & 3) * 16) * 16 + 4 * fq;
              t[q] = (f32x4){__hip_atomic_load(sp, __ATOMIC_RELAXED, __HIP_MEMORY_SCOPE_AGENT), __hip_atomic_load(sp + 1, __ATOMIC_RELAXED, __HIP_MEMORY_SCOPE_AGENT),
                             __hip_atomic_load(sp + 2, __ATOMIC_RELAXED, __HIP_MEMORY_SCOPE_AGENT), __hip_atomic_load(sp + 3, __ATOMIC_RELAXED, __HIP_MEMORY_SCOPE_AGENT)}; }
          const int lane = fq * 16 + fr;
#pragma unroll
          for (int q = 0; q < 8; ++q) { float v = (t[q][0] + t[q][1]) + (t[q][2] + t[q][3]); v += shx_(v, 16, lane); v += shx_(v, 32, lane); rsv[q] = __builtin_amdgcn_rsqf(v * (1.f / 1024.f) + 1e-6f); } }
        f32x4 wv[2][2];
#pragma unroll
        for (int bj = 0; bj < 2; ++bj)
#pragma unroll
            for (int n = 0; n < 2; ++n) wv[bj][n] = *(const f32x4*)(fw + col0 + bj * HALF + n * 16);
        float* op = out + (size_t)rowb * 1024 + col0;
#pragma unroll
        for (int it = 0; it < 8; ++it) { const int ai = it >> 2, m = it & 3; const size_t ro = (size_t)(ai * HALF + m * 16) * 1024;
#pragma unroll
            for (int bj = 0; bj < 2; ++bj)
#pragma unroll
                for (int n = 0; n < 2; ++n) __builtin_nontemporal_store(acc[ai][bj][m][n] * rsv[it] * wv[bj][n], (f32x4*)(op + ro + bj * HALF + n * 16)); }
    }
};

__device__ __forceinline__ float dpp_ror1(float v) { return __builtin_bit_cast(float, __builtin_amdgcn_mov_dpp(__builtin_bit_cast(int, v), 0x121, 0xf, 0xf, false)); }
__device__ __forceinline__ float dpp_ror15(float v) { return __builtin_bit_cast(float, __builtin_amdgcn_mov_dpp(__builtin_bit_cast(int, v), 0x12f, 0xf, 0xf, false)); }
struct EpiUpGate {
    static constexpr bool PERM = true, AFTER_DRAIN = false;
    bf16_t* ACT; const float* SS; const float* bias; int ldb; const float* cw; float* HALO; PG8_LAS unsigned char* xb;
    __device__ __forceinline__ void operator()(f32x4 (&acc)[2][2][4][2], const Unit& u, int wr, int wc, int fr, int fq) const {
        asm volatile("" : "+v"(fr), "+v"(fq));
        const int cnd = u.pm < 32 ? 0 : 1 + ((u.pm - 32) >> 3);
        const bool samp = u.pm >= 32;
        const int j0 = u.pn * HALF + wc * 32 + 8 * fq;
        const int row0 = u.pm * BM + wr * 64 + fr;
        { const float* bp = bias + (size_t)cnd * ldb + j0;
          f32x4 bv[2][2];
#pragma unroll
          for (int bj = 0; bj < 2; ++bj)
#pragma unroll
              for (int n = 0; n < 2; ++n) bv[bj][n] = *(const f32x4*)(bp + bj * 2816 + 4 * n);
          float rsv[8]; row_scales(SS, row0, fr, fq, rsv);
#pragma unroll
          for (int ai = 0; ai < 2; ++ai)
#pragma unroll
              for (int m = 0; m < 4; ++m) { const float rs = rsv[ai * 4 + m];
#pragma unroll
                  for (int bj = 0; bj < 2; ++bj)
#pragma unroll
                      for (int n = 0; n < 2; ++n) acc[ai][bj][m][n] = acc[ai][bj][m][n] * rs + bv[bj][n]; } }
        PG8_LAS f32x4* WL = (PG8_LAS f32x4*)(xb + 8192);
        if (fr == 0) {
            f32x4 wt[2][2][3];
#pragma unroll
            for (int n = 0; n < 2; ++n)
#pragma unroll
                for (int bj = 0; bj < 2; ++bj)
#pragma unroll
                    for (int k = 0; k < 3; ++k) wt[n][bj][k] = *(const f32x4*)(cw + k * 5632 + bj * 2816 + j0 + 4 * n);
#pragma unroll
            for (int n = 0; n < 2; ++n)
#pragma unroll
                for (int bj = 0; bj < 2; ++bj)
#pragma unroll
                    for (int k = 0; k < 3; ++k) WL[((((wr * 4 + wc) * 4 + fq) * 2 + n) * 2 + bj) * 3 + k] = wt[n][bj][k];
        }
        PG8_LAS f32x4* XB = (PG8_LAS f32x4*)xb;
        const int wv = wr * 4 + wc, pw = (wr ^ 1) * 4 + wc;
        if (fr == 0) {
#pragma unroll
            for (int ai = 0; ai < 2; ++ai)
#pragma unroll
                for (int bj = 0; bj < 2; ++bj)
#pragma unroll
                    for (int n = 0; n < 2; ++n) XB[((wv * 4 + ai * 2) * 2 + bj) * 8 + 2 * fq + n] = acc[ai][bj][0][n]; }
        if (fr == 15) {
#pragma unroll
            for (int ai = 0; ai < 2; ++ai)
#pragma unroll
                for (int bj = 0; bj < 2; ++bj)
#pragma unroll
                    for (int n = 0; n < 2; ++n) XB[((wv * 4 + ai * 2 + 1) * 2 + bj) * 8 + 2 * fq + n] = acc[ai][bj][3][n]; }
        asm volatile("s_waitcnt lgkmcnt(0)" ::: "memory"); __builtin_amdgcn_s_barrier(); asm volatile("" ::: "memory");
        float* hb = HALO + (size_t)(samp ? u.pm - 32 : 0) * 4 * 5632;
#pragma unroll
        for (int ai = 0; ai < 2; ++ai) {
            const bool has_ab = !(wr == 0 && ai == 0), has_bl = !(wr == 1 && ai == 1);
            const int wab = (wr == 0) ? 1 : (ai == 0 ? 1 : 3), wbl = (wr == 0) ? (ai == 0 ? 0 : 2) : 2;
            unsigned pk[4][4];
#pragma unroll
            for (int n = 0; n < 2; ++n) {
                f32x4 ca[4];
#pragma unroll
                for (int bj = 0; bj < 2; ++bj) {
                    const PG8_LAS f32x4* wlp = WL + ((((wr * 4 + wc) * 4 + fq) * 2 + n) * 2 + bj) * 3;
                    const f32x4 w0 = wlp[0], w1 = wlp[1], w2 = wlp[2];
                    f32x4 ab = (f32x4){0.f, 0.f, 0.f, 0.f}, bl = ab;
                    if (has_ab) ab = XB[((pw * 4 + wab) * 2 + bj) * 8 + 2 * fq + n];
                    if (has_bl) bl = XB[((pw * 4 + wbl) * 2 + bj) * 8 + 2 * fq + n];
#pragma unroll
                    for (int m = 0; m < 4; ++m) {
                        f32x4 cvm;
#pragma unroll
                        for (int i = 0; i < 4; ++i) {
                            const float cur = acc[ai][bj][m][n][i];
                            const float pv = m == 0 ? ab[i] : acc[ai][bj][m == 0 ? 0 : m - 1][n][i];
                            const float nx = m == 3 ? bl[i] : acc[ai][bj][m == 3 ? 3 : m + 1][n][i];
                            const float up = dpp_ror1(fr == 15 ? pv : cur), dn = dpp_ror15(fr == 0 ? nx : cur);
                            cvm[i] = w0[i] * up + w1[i] * cur + w2[i] * dn;
                        }
                        if (samp) {
                            if (m == 0 && wr == 0 && ai == 0 && fr == 0) { *(f32x4*)(hb + 0 * 5632 + bj * 2816 + j0 + 4 * n) = acc[ai][bj][0][n]; *(f32x4*)(hb + 1 * 5632 + bj * 2816 + j0 + 4 * n) = cvm; }
                            if (m == 3 && wr == 1 && ai == 1 && fr == 15) { *(f32x4*)(hb + 2 * 5632 + bj * 2816 + j0 + 4 * n) = acc[ai][bj][3][n]; *(f32x4*)(hb + 3 * 5632 + bj * 2816 + j0 + 4 * n) = cvm; }
                        }
                        if (bj == 0) ca[m] = cvm;
                        else { float r[4];
#pragma unroll
                            for (int i = 0; i < 4; ++i) { const float xa = ca[m][i]; r[i] = xa * __builtin_amdgcn_rcpf(1.f + __builtin_amdgcn_exp2f(-xa * 1.4426950408889634f)) * cvm[i]; }
                            pk[m][2 * n] = cvt_pk_bf16(r[0], r[1]); pk[m][2 * n + 1] = cvt_pk_bf16(r[2], r[3]); }
                    }
                }
                __builtin_amdgcn_sched_barrier(0);
            }
#pragma unroll
            for (int m = 0; m < 4; ++m) *(u32x4*)(ACT + (size_t)(row0 + ai * HALF + m * 16) * 2816 + j0) = (u32x4){pk[m][0], pk[m][1], pk[m][2], pk[m][3]};
        }
    }
};

template <class Epi, class Sched, bool ALIGN_EPI = false, bool SP2 = false>
__device__ __forceinline__ void gemm_phase(PG8_LAS unsigned char* lds, const Gemm g, const Sched& S, const Epi& E, const int tid) {
    const int wid = __builtin_amdgcn_readfirstlane(tid >> 6), lane = tid & 63, wr = wid >> 2, wc = wid & 3, fr = lane & 15, fq = lane >> 4;
    const int K = g.K, nt = K / BK;
    unsigned voffA[2], voffB[2];
#pragma unroll
    for (int i = 0; i < 2; ++i) { int R, C; stage_rc(tid * 16 + i * 8192, R, C); const int Rb = Epi::PERM ? ((R & ~31) + perm32(R & 31)) : R;
        voffA[i] = (unsigned)(R * K + C) * 2u; voffB[i] = (unsigned)(Rb * K + C) * 2u; }
    const size_t kstep = (size_t)(BK * 2);
    const size_t hstep = (size_t)HALF * K * 2;
    const size_t tstep = 2 * hstep;
    const size_t bstep = g.bstep ? g.bstep : tstep, bh = g.bhalf ? g.bhalf : hstep;
    const unsigned ldsw = (unsigned)wid * 1024u;
    const int aoff = lds_byte(wr * 64 + fr, fq * 8), boff = lds_byte(wc * 32 + fr, fq * 8);
#define PG8_SA(b, h) (((b) * 2 + (h)) * HTB)
#define PG8_SB(b, h) ((4 + (b) * 2 + (h)) * HTB)
#define PG8_STAGE(bufoff, gbase, voff) do { _Pragma("unroll") for (int _i = 0; _i < 2; ++_i) \
        __builtin_amdgcn_global_load_lds((const unsigned*)((const char*)(gbase) + (voff)[_i]), (PG8_LAS unsigned*)(lds + (bufoff) + ldsw + _i * 8192), 16, 0, 0); } while (0)
#define PG8_LDA(dst, b, h) do { _Pragma("unroll") for (int m = 0; m < 4; ++m) _Pragma("unroll") for (int k = 0; k < 2; ++k) dst[m][k] = *(const PG8_LAS bf16x8*)(lds + PG8_SA(b, h) + aoff + m * 2048 + k * 1024); } while (0)
#define PG8_LDB(dst, b, h) do { _Pragma("unroll") for (int n = 0; n < 2; ++n) _Pragma("unroll") for (int k = 0; k < 2; ++k) dst[n][k] = *(const PG8_LAS bf16x8*)(lds + PG8_SB(b, h) + boff + n * 2048 + k * 1024); } while (0)
#define PG8_MMA(ai, bj, At, Bt) do { __builtin_amdgcn_s_setprio(1); _Pragma("unroll") for (int m = 0; m < 4; ++m) _Pragma("unroll") for (int n = 0; n < 2; ++n) _Pragma("unroll") for (int k = 0; k < 2; ++k) \
        acc[ai][bj][m][n] = __builtin_amdgcn_mfma_f32_16x16x32_bf16(Bt[n][k], At[m][k], acc[ai][bj][m][n], 0, 0, 0); __builtin_amdgcn_s_setprio(0); } while (0)
#define PG8_WAIT_V(n) asm volatile("s_waitcnt vmcnt(" #n ")" ::: "memory")
#define PG8_WAIT_L(n) asm volatile("s_waitcnt lgkmcnt(" #n ")" ::: "memory")
#define PG8_BAR __builtin_amdgcn_s_barrier()
#define PG8_SCHED __builtin_amdgcn_sched_barrier(0)
    Unit cur, nxt; int ui = 0;
    if (!S.next(0, cur)) return;
    f32x4 acc[2][2][4][2];
#pragma unroll
    for (int a = 0; a < 2; ++a)
#pragma unroll
        for (int b = 0; b < 2; ++b)
#pragma unroll
            for (int m = 0; m < 4; ++m)
#pragma unroll
                for (int n = 0; n < 2; ++n) acc[a][b][m][n] = (f32x4){0.f, 0.f, 0.f, 0.f};
    bf16x8 At[4][2], B0[2][2], B1[2][2];
    const char* cA = (const char*)g.A + (size_t)cur.pm * tstep; const char* cB = (const char*)g.Bt + (size_t)cur.pn * bstep;
    S.a_ready(cur);
    if constexpr (SP2) {
        PG8_STAGE(PG8_SB(0, 0), cB, voffB); PG8_STAGE(PG8_SB(0, 1), cB + bh, voffB); PG8_STAGE(PG8_SA(0, 0), cA, voffA); PG8_STAGE(PG8_SA(0, 1), cA + hstep, voffA);
        if (wr == 1) PG8_BAR;
        PG8_WAIT_V(2); PG8_BAR;
        PG8_STAGE(PG8_SB(1, 0), cB + kstep, voffB); PG8_STAGE(PG8_SA(1, 0), cA + kstep, voffA); PG8_STAGE(PG8_SB(1, 1), cB + bh + kstep, voffB);
        PG8_WAIT_V(6); PG8_BAR;
    } else {
        PG8_STAGE(PG8_SB(0, 0), cB, voffB); PG8_STAGE(PG8_SA(0, 0), cA, voffA); PG8_STAGE(PG8_SB(0, 1), cB + bh, voffB); PG8_STAGE(PG8_SA(0, 1), cA + hstep, voffA);
        if (wr == 1) PG8_BAR;
        PG8_WAIT_V(4); PG8_BAR;
        PG8_STAGE(PG8_SB(1, 0), cB + kstep, voffB); PG8_STAGE(PG8_SA(1, 0), cA + kstep, voffA); PG8_STAGE(PG8_SB(1, 1), cB + bh + kstep, voffB);
        PG8_WAIT_V(6); PG8_BAR;
    }
    for (;;) {
        const bool has_next = S.next(ui + 1, nxt);
        const char* nA = has_next ? (const char*)g.A + (size_t)nxt.pm * tstep : cA; const char* nB = has_next ? (const char*)g.Bt + (size_t)nxt.pn * bstep : cB;
        for (int t = 0; t < nt; t += 2) {
            const bool last = (t == nt - 2);
            const char* a1 = cA + (size_t)(t + 1) * kstep;
            const char* a2 = last ? nA : cA + (size_t)(t + 2) * kstep; const char* b2 = last ? nB : cB + (size_t)(t + 2) * kstep;
            const char* a3 = a2 + kstep; const char* b3 = b2 + kstep;
            if (last && has_next) S.a_ready(nxt);
            if constexpr (SP2) {
            PG8_LDB(B0, 0, 0); PG8_LDB(B1, 0, 1); PG8_SCHED; PG8_LDA(At, 0, 0); PG8_STAGE(PG8_SA(1, 1), a1 + hstep, voffA);
            PG8_WAIT_V(8); PG8_WAIT_L(0); PG8_BAR; PG8_MMA(0, 0, At, B0); PG8_MMA(0, 1, At, B1); PG8_BAR; PG8_SCHED;
            PG8_LDA(At, 0, 1); PG8_STAGE(PG8_SB(0, 0), b2, voffB); PG8_STAGE(PG8_SB(0, 1), b2 + bh, voffB); PG8_STAGE(PG8_SA(0, 0), a2, voffA);
            PG8_WAIT_V(8); PG8_WAIT_L(0); PG8_BAR; PG8_MMA(1, 0, At, B0); PG8_MMA(1, 1, At, B1); PG8_BAR; PG8_SCHED;
            PG8_LDB(B0, 1, 0); PG8_LDB(B1, 1, 1); PG8_SCHED; PG8_LDA(At, 1, 0); PG8_STAGE(PG8_SA(0, 1), a2 + hstep, voffA);
            PG8_WAIT_V(8); PG8_WAIT_L(0); PG8_BAR; PG8_MMA(0, 0, At, B0); PG8_MMA(0, 1, At, B1); PG8_BAR; PG8_SCHED;
            PG8_LDA(At, 1, 1); PG8_STAGE(PG8_SB(1, 0), b3, voffB); PG8_STAGE(PG8_SB(1, 1), b3 + bh, voffB); PG8_STAGE(PG8_SA(1, 0), a3, voffA);
            PG8_WAIT_V(8); PG8_WAIT_L(0); PG8_BAR; PG8_MMA(1, 0, At, B0); PG8_MMA(1, 1, At, B1); PG8_BAR; PG8_SCHED;
            } else {
            PG8_LDB(B0, 0, 0); PG8_SCHED; PG8_LDA(At, 0, 0); PG8_STAGE(PG8_SA(1, 1), a1 + hstep, voffA);
            PG8_WAIT_L(8); PG8_BAR; PG8_WAIT_L(0); PG8_MMA(0, 0, At, B0); PG8_BAR; PG8_SCHED;
            PG8_LDB(B1, 0, 1); PG8_STAGE(PG8_SB(0, 0), b2, voffB);
            PG8_BAR; PG8_WAIT_L(0); PG8_MMA(0, 1, At, B1); PG8_BAR;
            PG8_LDA(At, 0, 1); PG8_STAGE(PG8_SA(0, 0), a2, voffA);
            PG8_BAR; PG8_WAIT_L(0); PG8_MMA(1, 0, At, B0); PG8_BAR; PG8_SCHED;
            PG8_STAGE(PG8_SB(0, 1), b2 + bh, voffB);
            PG8_WAIT_V(6); PG8_BAR; PG8_MMA(1, 1, At, B1); PG8_BAR;
            PG8_LDB(B0, 1, 0); PG8_SCHED; PG8_LDA(At, 1, 0); PG8_STAGE(PG8_SA(0, 1), a2 + hstep, voffA);
            PG8_WAIT_L(8); PG8_BAR; PG8_WAIT_L(0); PG8_MMA(0, 0, At, B0); PG8_BAR; PG8_SCHED;
            PG8_LDB(B1, 1, 1); PG8_STAGE(PG8_SB(1, 0), b3, voffB);
            PG8_BAR; PG8_WAIT_L(0); PG8_MMA(0, 1, At, B1); PG8_BAR;
            PG8_LDA(At, 1, 1); PG8_STAGE(PG8_SA(1, 0), a3, voffA);
            PG8_BAR; PG8_WAIT_L(0); PG8_MMA(1, 0, At, B0); PG8_BAR; PG8_SCHED;
            PG8_STAGE(PG8_SB(1, 1), b3 + bh, voffB);
            PG8_WAIT_V(6); PG8_BAR; PG8_MMA(1, 1, At, B1); PG8_BAR;
            }
        }
        if constexpr (ALIGN_EPI) { if (wr == 0) PG8_BAR; }
        if constexpr (!Epi::AFTER_DRAIN) { E(acc, cur, wr, wc, fr, fq); S.done(cur); }
        if (!has_next) break;
#pragma unroll
        for (int a = 0; a < 2; ++a)
#pragma unroll
            for (int b = 0; b < 2; ++b)
#pragma unroll
                for (int m = 0; m < 4; ++m)
#pragma unroll
                    for (int n = 0; n < 2; ++n) acc[a][b][m][n] = (f32x4){0.f, 0.f, 0.f, 0.f};
        cur = nxt; cA = nA; cB = nB; ++ui;
        if constexpr (ALIGN_EPI) { if (wr == 1) PG8_BAR; }
    }
    PG8_WAIT_V(0);
    if constexpr (!ALIGN_EPI) { if (wr == 0) PG8_BAR; }
    PG8_BAR;
#undef PG8_SA
#undef PG8_SB
#undef PG8_STAGE
#undef PG8_LDA
#undef PG8_LDB
#undef PG8_MMA
#undef PG8_WAIT_V
#undef PG8_WAIT_L
#undef PG8_BAR
#undef PG8_SCHED
}
}

#define LAS __attribute__((address_space(3)))
#define CAS __attribute__((address_space(4)))
typedef unsigned short bf16;
typedef float f32x4 __attribute__((ext_vector_type(4)));
typedef short bf16x8 __attribute__((ext_vector_type(8)));
typedef unsigned u32x4 __attribute__((ext_vector_type(4)));
typedef unsigned u32x2 __attribute__((ext_vector_type(2)));

constexpr int NW = 8, NT = 512;
constexpr int DM = 1024, NTOK = 12288, NPR = 8192, NKR = 13312, INC = 2144, INP = 2304, DFF = 2816, DUP = 5632;
constexpr float EPS = 1e-6f, LOG2E = 1.4426950408889634f;
constexpr float QS = 0.125f * LOG2E;
constexpr float MLAQS = 0.10206207261596575f * LOG2E;

constexpr size_t MiB = 1u << 20;
constexpr size_t WS_CTL = 0, WS_MOD = 1 * MiB, WS_ROPE = 1 * MiB + 256 * 1024, WS_W = 2 * MiB, W_LSTRIDE = 24 * MiB;
constexpr size_t W_IN = 0, W_OUT = 4718592, W_UP = W_OUT + 2097152, W_DOWN = W_UP + 11534336, W_B2 = W_DOWN + 5767168;
static_assert(W_B2 + 786432 <= W_LSTRIDE, "weights");
constexpr size_t WS_XN = 50 * MiB, WS_PROJ = 74 * MiB, WS_A2 = 128 * MiB, WS_MQKV = 138 * MiB, WS_QC = 164 * MiB, WS_KPE = 203 * MiB, WS_YCAT = 204 * MiB;
constexpr size_t WS_ACT = 116 * MiB, WS_U = 116 * MiB, WS_SS1 = 228 * MiB, WS_SS2 = 229 * MiB, WS_HALO = 230 * MiB, WS_XRES = 232 * MiB, WS_END = 256 * MiB;
constexpr size_t WS_BIAS = 65536;
constexpr int NBIAS = 2304 + 5632;
constexpr size_t QSZ = (size_t)NKR * 256 * 2, KSZ = (size_t)NKR * 128 * 2;
constexpr int LDS_BYTES = 163840, LDS_CTL = 163840 - 256;
constexpr size_t WS_BAR = 16384;

struct Args { const float* in[28]; float* out; unsigned char* ws; };

__device__ __forceinline__ unsigned f2bf(float f) { unsigned u = __builtin_bit_cast(unsigned, f); return (u + 0x7fffu + ((u >> 16) & 1u)) >> 16; }
__device__ __forceinline__ unsigned pk2(float lo, float hi) { unsigned r; asm("v_cvt_pk_bf16_f32 %0, %1, %2" : "=v"(r) : "v"(lo), "v"(hi)); return r; }
__device__ __forceinline__ float bflo(unsigned u) { return __builtin_bit_cast(float, u << 16); }
__device__ __forceinline__ float bfhi(unsigned u) { return __builtin_bit_cast(float, u & 0xffff0000u); }
__device__ __forceinline__ f32x4 ld4bf(const bf16* p) { const u32x2 u = *(const u32x2*)p; return (f32x4){bflo(u.x), bfhi(u.x), bflo(u.y), bfhi(u.y)}; }
__device__ __forceinline__ void st4bf(bf16* p, f32x4 v) { u32x2 u; u.x = pk2(v[0], v[1]); u.y = pk2(v[2], v[3]); *(u32x2*)p = u; }
__device__ __forceinline__ float shx(float v, int m, int lane) { return __builtin_bit_cast(float, __builtin_amdgcn_ds_bpermute((lane ^ m) << 2, __builtin_bit_cast(int, v))); }
#define DPPF(v, ctrl) __builtin_bit_cast(float, __builtin_amdgcn_mov_dpp(__builtin_bit_cast(int, (v)), (ctrl), 0xf, 0xf, false))
__device__ __forceinline__ float sum16(float v, int) { v += DPPF(v, 0x121); v += DPPF(v, 0x122); v += DPPF(v, 0x124); v += DPPF(v, 0x128); return v; }
__device__ __forceinline__ float wave_sum(float v, int lane) {
    v = sum16(v, lane);
    const int iv = __builtin_bit_cast(int, v);
    const float a = __builtin_bit_cast(float, __builtin_amdgcn_readlane(iv, 0)), b = __builtin_bit_cast(float, __builtin_amdgcn_readlane(iv, 16)),
                c = __builtin_bit_cast(float, __builtin_amdgcn_readlane(iv, 32)), d = __builtin_bit_cast(float, __builtin_amdgcn_readlane(iv, 48));
    return (a + b) + (c + d);
}
__device__ __forceinline__ float dot4(f32x4 a) { return (a[0] * a[0] + a[1] * a[1]) + (a[2] * a[2] + a[3] * a[3]); }
__device__ __forceinline__ f32x4 shfl4(f32x4 v, int m, int lane) { return (f32x4){shx(v[0], m, lane), shx(v[1], m, lane), shx(v[2], m, lane), shx(v[3], m, lane)}; }

__device__ __forceinline__ void transpose_item(const float* W, int N, bf16* WT, int ldk, int row_off, int k_off, float scale, LAS float* scr, int item, int lane) {
    const int nblk = (N + 63) / 64, kb = item / nblk, nb = item % nblk, k0 = 64 * kb, n0 = 64 * nb;
    const bool act = n0 + lane < N;
    const float* wp = W + (size_t)k0 * N + n0 + lane;
    float v[64];
#pragma unroll
    for (int i = 0; i < 64; ++i) v[i] = act ? __builtin_nontemporal_load(wp + (size_t)i * N) : 0.f;
#pragma unroll
    for (int i = 0; i < 64; ++i) scr[i * 65 + lane] = v[i] * scale;
    asm volatile("s_waitcnt lgkmcnt(0)" ::: "memory");
    const int c = lane & 7;
#pragma unroll
    for (int j = 0; j < 8; ++j) { const int n = (lane >> 3) + 8 * j; const LAS float* s = scr + (8 * c) * 65 + n;
        u32x4 o; o.x = pk2(s[0 * 65], s[1 * 65]); o.y = pk2(s[2 * 65], s[3 * 65]); o.z = pk2(s[4 * 65], s[5 * 65]); o.w = pk2(s[6 * 65], s[7 * 65]);
        if (n0 + n < N) *(u32x4*)(WT + (size_t)(row_off + n0 + n) * ldk + k_off + k0 + 8 * c) = o; }
    asm volatile("s_waitcnt lgkmcnt(0)" ::: "memory");
}

template <class ArgsRef>
__device__ __forceinline__ void wconv(const ArgsRef& a, unsigned char* ws, int l, int sel, int w, int nwk, LAS float* scr, int lane) {
    constexpr int I_IN = 16 * 34, I_OUT = 16 * 16, I_UP = 16 * 88, I_DN = 44 * 16, I_Q = 3 * 6, I_KV = 2 * 8;
    const int n_in = (sel & 1) ? I_IN : 0, n_out = (sel & 2) ? I_OUT : 0, n_up = (sel & 4) ? I_UP : 0, n_dn = (sel & 8) ? I_DN : 0, n_q = (sel & 16) ? I_Q : 0, n_kv = (sel & 32) ? I_KV : 0;
    const int total = n_in + n_out + n_up + n_dn + n_q + n_kv;
    unsigned char* wl = ws + WS_W + l * W_LSTRIDE;
    for (int it = w; it < total; it += nwk) {
        int r = it;
        if (r < n_in) { transpose_item(a.in[13] + (size_t)l * 1024 * INC, INC, (bf16*)(wl + W_IN), 1024, 0, 0, 1.f, scr, r, lane); continue; } r -= n_in;
        if (r < n_out) { transpose_item(a.in[22] + (size_t)l * 1024 * 1024, 1024, (bf16*)(wl + W_OUT), 1024, 0, 0, 1.f, scr, r, lane); continue; } r -= n_out;
        if (r < n_up) { transpose_item(a.in[24] + (size_t)l * 1024 * DUP, DUP, (bf16*)(wl + W_UP), 1024, 0, 0, 1.f, scr, r, lane); continue; } r -= n_up;
        if (r < n_dn) { transpose_item(a.in[26] + (size_t)l * DFF * 1024, 1024, (bf16*)(wl + W_DOWN), DFF, 0, 0, 1.f, scr, r, lane); continue; } r -= n_dn;
        if (r < n_q) { transpose_item(a.in[16] + (size_t)l * 192 * 384, 384, (bf16*)(wl + W_B2), 384, 0, 0, MLAQS, scr, r, lane); continue; } r -= n_q;
        transpose_item(a.in[18] + (size_t)l * 128 * 512, 512, (bf16*)(wl + W_B2), 384, 384, 192, 1.f, scr, r, lane);
    }
}
template <class ArgsRef>
__device__ __forceinline__ void phase0(const ArgsRef& a, LAS unsigned char* lds, int tid, int lane, int wave) {
    unsigned char* ws = a.ws;
    const int G = gridDim.x, bid = blockIdx.x;
    if (bid < 96) {
        LAS float* sl = (LAS float*)(lds + 16384);
        for (int e = tid; e < 3072; e += NT) { const int c = e >> 10, k = e & 1023; const float v = c == 0 ? a.in[9][k] : a.in[8][(c - 1) * 1024 + k]; sl[e] = v / (1.f + __expf(-v)); }
        __syncthreads();
    }
    for (int it = bid; it < 96; it += G) {
        const int l = it / 48, n0 = (it % 48) * 128;
        const float* wa = a.in[10] + (size_t)l * 1024 * 6144;
        const LAS float* sl = (const LAS float*)(lds + 16384);
        float acc[3][2] = {{0.f, 0.f}, {0.f, 0.f}, {0.f, 0.f}};
        const int kb = wave * 128;
#pragma unroll 16
        for (int k = 0; k < 128; ++k) {
            const int kk = kb + k;
            typedef float f32x2_ __attribute__((ext_vector_type(2)));
            const f32x2_ w = __builtin_nontemporal_load((const f32x2_*)(wa + (size_t)kk * 6144 + n0 + 2 * lane));
            const float s0 = sl[kk], s1 = sl[1024 + kk], s2 = sl[2048 + kk];
            acc[0][0] += s0 * w.x; acc[0][1] += s0 * w.y; acc[1][0] += s1 * w.x; acc[1][1] += s1 * w.y; acc[2][0] += s2 * w.x; acc[2][1] += s2 * w.y;
        }
        LAS float* red = (LAS float*)lds;
#pragma unroll
        for (int c = 0; c < 3; ++c) { red[(wave * 3 + c) * 128 + 2 * lane] = acc[c][0]; red[(wave * 3 + c) * 128 + 2 * lane + 1] = acc[c][1]; }
        __syncthreads();
        if (tid < 384) { const int c = tid / 128, n = tid % 128; float s = 0.f;
#pragma unroll
            for (int w = 0; w < 8; ++w) s += red[(w * 3 + c) * 128 + n];
            ((float*)(ws + WS_MOD))[(size_t)(l * 3 + c) * 6144 + n0 + n] = s + a.in[11][(size_t)l * 6144 + n0 + n]; }
        __syncthreads();
    }
    if (bid == G - 1) {
        float* rt = (float*)(ws + WS_ROPE);
        for (int e = tid; e < 1024; e += NT) { const int pos = e >> 4, i = e & 15; const float inv = exp2f(-(float)(2 * i) / 32.f * 13.287712379549449f); const float ang = (float)pos * inv;
            rt[e] = __cosf(ang); rt[1024 + e] = __sinf(ang); }
        for (int e = tid; e < 512; e += NT) { const int pos = e >> 3, i = e & 7; const float inv = exp2f(-(float)(2 * i) / 16.f * 13.287712379549449f); const float ang = (float)pos * inv;
            rt[2048 + e] = __cosf(ang); rt[2560 + e] = __sinf(ang); }
    }
    const int gt = bid * NT + tid, NGT = G * NT;
    if (gt < 256) ((unsigned*)(ws + WS_CTL))[gt] = 0u;
    if (gt < 64) ((unsigned*)(ws + WS_CTL))[2048 + gt] = 0u;
    for (int l = 0; l < 2; ++l) {
        bf16* b2 = (bf16*)(ws + WS_W + l * W_LSTRIDE + W_B2);
        for (int ch = gt; ch < 1024 * 48; ch += NGT) { const int n = ch / 48, k = (ch % 48) * 8;
            const bool data = (n < 384 && k < 192) || (n >= 384 && n < 896 && k >= 192 && k < 320);
            if (!data) *(u32x4*)(b2 + (size_t)n * 384 + k) = (u32x4){0u, 0u, 0u, 0u}; }
        bf16* wi = (bf16*)(ws + WS_W + l * W_LSTRIDE + W_IN) + (size_t)INC * 1024;
        for (int ch = gt; ch < 160 * 128; ch += NGT) *(u32x4*)(wi + (size_t)ch * 8) = (u32x4){0u, 0u, 0u, 0u};
    }
    LAS float* scr = (LAS float*)(lds + 28672 + wave * 16640);
    wconv(a, ws, 0, 1 | 2 | 16 | 32, bid * NW + wave, G * NW, scr, lane);
}

__device__ __forceinline__ void prep_phase(const float* x0, const float* x1, const float* nw, const float* mod, int sc_off, bf16* XN, float* SS, int lane, int gw, int NGW) {
    for (int row = gw; row < NTOK; row += NGW) {
        const float* xr = row < NPR ? x0 + (size_t)row * DM : x1 + (size_t)(row - NPR) * DM;
        const int c = row < NPR ? 0 : 1 + ((row - NPR) >> 11);
        const float* mp = mod + c * 6144;
        f32x4 v[4]; float ss = 0.f;
#pragma unroll
        for (int j = 0; j < 4; ++j) { v[j] = __builtin_nontemporal_load((const f32x4*)(xr + 4 * (lane + 64 * j))); ss += dot4(v[j]); }
        ss = wave_sum(ss, lane);
#pragma unroll
        for (int j = 0; j < 4; ++j) { const int col = 4 * (lane + 64 * j);
            const f32x4 g = *(const f32x4*)(nw + col), sc = *(const f32x4*)(mp + sc_off + col);
            st4bf(XN + (size_t)row * DM + col, v[j] * g * (1.f + sc)); }
        if (lane < 16) SS[(size_t)row * 16 + lane] = lane == 0 ? ss : 0.f;
    }
}
template <class ArgsRef>
__device__ __forceinline__ void bias_phase(const ArgsRef& a, unsigned char* ws, LAS unsigned char* lds, int tid, int lane, int wave) {
    const float* mod = (const float*)(ws + WS_MOD);
    float* BIAS = (float*)(ws + WS_BIAS);
    for (int it = blockIdx.x; it < 62; it += gridDim.x) {
        const int l = it / 31, r = it % 31; const bool up = r >= 9;
        const int N = up ? DUP : INC, n0 = (up ? r - 9 : r) * 256 + 4 * lane;
        const float* W = up ? a.in[24] + (size_t)l * 1024 * DUP : a.in[13] + (size_t)l * 1024 * INC;
        const float* shp = mod + (size_t)l * 3 * 6144 + (up ? 3072 : 0);
        LAS float* sl = (LAS float*)(lds + 32768);
        for (int e = tid; e < 3072; e += NT) sl[e] = shp[(e >> 10) * 6144 + (e & 1023)];
        __syncthreads();
        const bool act = n0 < N;
        f32x4 acc[3] = {(f32x4){0.f, 0.f, 0.f, 0.f}, (f32x4){0.f, 0.f, 0.f, 0.f}, (f32x4){0.f, 0.f, 0.f, 0.f}};
        const int kb = wave * 128;
#pragma unroll 16
        for (int k = 0; k < 128; ++k) { const int kk = kb + k;
            const f32x4 w = act ? __builtin_nontemporal_load((const f32x4*)(W + (size_t)kk * N + n0)) : (f32x4){0.f, 0.f, 0.f, 0.f};
            acc[0] += w * sl[kk]; acc[1] += w * sl[1024 + kk]; acc[2] += w * sl[2048 + kk]; }
        LAS f32x4* red = (LAS f32x4*)lds;
#pragma unroll
        for (int c = 0; c < 3; ++c) red[(wave * 3 + c) * 64 + lane] = acc[c];
        __syncthreads();
        if (tid < 192) { const int c = tid >> 6, ln = tid & 63; f32x4 t = red[c * 64 + ln];
#pragma unroll
            for (int w = 1; w < 8; ++w) t += red[(w * 3 + c) * 64 + ln];
            const int nn = (up ? r - 9 : r) * 256 + 4 * ln;
            if (nn < N) *(f32x4*)(BIAS + (size_t)(l * 3 + c) * NBIAS + (up ? 2304 : 0) + nn) = t;
            else if (!up && nn < 2304) *(f32x4*)(BIAS + (size_t)(l * 3 + c) * NBIAS + nn) = (f32x4){0.f, 0.f, 0.f, 0.f}; }
        __syncthreads();
    }
}

struct P3Ptrs {
    const bf16* PROJ; bf16 *A2, *KPE, *YCAT, *Qc_rot, *Qc_raw, *Kc, *Vc, *Qd_rot, *Qd_raw, *Kd, *Vd;
    const float *conv_a, *gq_mla, *gkv_mla, *gq, *gk, *rope;
    const float *c_ckv, *c_kpe, *c_gk, *c_gv, *c_sk, *c_sv;
    float *o_ckv, *o_kpe, *o_gk, *o_gv, *o_sk, *o_sv;
    int l;
};
__device__ __forceinline__ f32x4 rope64(f32x4 v, int jl, int prow, int pcol, const float* rt, int lane) {
    const f32x4 pr = shfl4(v, 4, lane);
    const int pos = jl < 8 ? prow : pcol, fi = 4 * (jl & 3);
    const f32x4 c = *(const f32x4*)(rt + pos * 16 + fi), s = *(const f32x4*)(rt + 1024 + pos * 16 + fi);
    const float sg = (jl & 4) ? 1.f : -1.f;
    return v * c + pr * s * sg;
}
__device__ __forceinline__ void p3_phase(const P3Ptrs& P, int lane, int gw, int NGW) {
    const int l = P.l;
    for (int row = gw; row < NKR; row += NGW) {
        if (row < NTOK) {
            const bool samp = row >= NPR;
            int b, t, kr, T;
            if (!samp) { b = row >> 8; t = row & 255; kr = row; T = 256; } else { b = (row - NPR) >> 11; t = (row - NPR) & 2047; kr = NPR + b * 2560 + t; T = 2048; }
            const int prow = t >> 6, pcol = t & 63;
            const bf16* pr = P.PROJ + (size_t)row * INP;
            const size_t ob = (size_t)((b * 2 + l) * 256 + t);
            const int ci = 4 * lane, jl = lane & 15;
            const u32x2 z2 = (u32x2){0u, 0u};
            const bool hp = t > 0, hn = t < T - 1;
            const u32x2 r_xa = *(const u32x2*)(pr + ci), r_gb = *(const u32x2*)(pr + 256 + ci), r_gc = *(const u32x2*)(pr + 512 + ci);
            const u32x2 r_pxa = hp ? *(const u32x2*)(pr - INP + ci) : z2, r_pgc = hp ? *(const u32x2*)(pr - INP + 512 + ci) : z2;
            const u32x2 r_nxa = hn ? *(const u32x2*)(pr + INP + ci) : z2, r_ngc = hn ? *(const u32x2*)(pr + INP + 512 + ci) : z2;
            const u32x2 r_cq = lane < 48 ? *(const u32x2*)(pr + 768 + ci) : z2, r_ckv = lane < 32 ? *(const u32x2*)(pr + 960 + ci) : z2, r_kpe = lane < 8 ? *(const u32x2*)(pr + 1088 + ci) : z2;
            const u32x2 r_qc = *(const u32x2*)(pr + 1120 + ci), r_kvc = *(const u32x2*)(pr + 1376 + ci), r_qd = *(const u32x2*)(pr + 1632 + ci), r_kvd = *(const u32x2*)(pr + 1888 + ci);
            const float* cw = P.conv_a + (size_t)l * 768;
            const f32x4 w0 = *(const f32x4*)(cw + ci), w1 = *(const f32x4*)(cw + 256 + ci), w2 = *(const f32x4*)(cw + 512 + ci);
            const f32x4 g_qm = lane < 48 ? *(const f32x4*)(P.gq_mla + l * 192 + ci) : (f32x4){0.f, 0.f, 0.f, 0.f}, g_kvm = lane < 32 ? *(const f32x4*)(P.gkv_mla + l * 128 + ci) : (f32x4){0.f, 0.f, 0.f, 0.f};
            const f32x4 g_q = *(const f32x4*)(P.gq + l * 64 + 4 * jl), g_k = *(const f32x4*)(P.gk + l * 64 + 4 * jl);
            const int pos64 = jl < 8 ? prow : pcol, fi64 = 4 * (jl & 3);
            const f32x4 c64 = *(const f32x4*)(P.rope + pos64 * 16 + fi64), s64 = *(const f32x4*)(P.rope + 1024 + pos64 * 16 + fi64);
            const int pos32 = (lane & 7) < 4 ? prow : pcol, fi32 = 4 * (lane & 1);
            const f32x4 c32 = *(const f32x4*)(P.rope + 2048 + pos32 * 8 + fi32), s32 = *(const f32x4*)(P.rope + 2560 + pos32 * 8 + fi32);
#define CV4(u) ((f32x4){bflo((u).x), bfhi((u).x), bflo((u).y), bfhi((u).y)})
#define ROPE64(v) ((v) * c64 + shfl4((v), 4, lane) * s64 * ((jl & 4) ? 1.f : -1.f))
            { const f32x4 ya = CV4(r_gb) * (w0 * (CV4(r_pxa) * CV4(r_pgc)) + w1 * (CV4(r_xa) * CV4(r_gc)) + w2 * (CV4(r_nxa) * CV4(r_ngc)));
              st4bf(P.YCAT + (size_t)row * DM + ci, ya); }
            { const f32x4 v = CV4(r_cq);
              const float rs = rsqrtf(wave_sum(dot4(v), lane) * (1.f / 192.f) + EPS);
              if (lane < 48) st4bf(P.A2 + (size_t)kr * 384 + ci, v * rs * g_qm); }
            { const f32x4 v = CV4(r_ckv);
              const float rs = rsqrtf(wave_sum(dot4(v), lane) * (1.f / 128.f) + EPS);
              if (lane < 32) { const f32x4 o = v * rs * g_kvm;
                  st4bf(P.A2 + (size_t)kr * 384 + 192 + ci, o);
                  if (!samp) __builtin_nontemporal_store((f32x4)(o), (f32x4*)(P.o_ckv + ob * 128 + ci)); }
              else if (lane < 48) { unsigned zz = 0u; asm volatile("" : "+v"(zz)); *(u32x2*)(P.A2 + (size_t)kr * 384 + 320 + 4 * (lane - 32)) = (u32x2){zz, zz}; } }
            { const f32x4 v = CV4(r_kpe);
              const f32x4 r = v * c32 + shfl4(v, 2, lane) * s32 * ((lane & 2) ? 1.f : -1.f);
              if (lane < 8) { if (!samp) __builtin_nontemporal_store((f32x4)(v), (f32x4*)(P.o_kpe + ob * 32 + ci)); st4bf(P.KPE + (size_t)kr * 32 + ci, samp ? r : v); } }
            { f32x4 v = CV4(r_qc);
              const float rs = rsqrtf(sum16(dot4(v), lane) * (1.f / 64.f) + EPS);
              v = v * rs * g_q;
              st4bf(P.Qc_raw + (size_t)kr * 256 + ci, v * QS);
              const f32x4 r = ROPE64(v);
              if (samp) st4bf(P.Qc_rot + (size_t)kr * 256 + ci, r * QS); }
            { const f32x4 v = CV4(r_kvc);
              const float rs = rsqrtf(sum16(dot4(v), lane) * (1.f / 64.f) + EPS);
              const f32x4 kn = v * rs * g_k;
              const f32x4 r = ROPE64(kn);
              if (lane < 32) { if (!samp) __builtin_nontemporal_store((f32x4)(kn), (f32x4*)(P.o_gk + ob * 128 + ci)); st4bf(P.Kc + (size_t)kr * 128 + ci, samp ? r : kn); }
              else { if (!samp) __builtin_nontemporal_store((f32x4)(v), (f32x4*)(P.o_gv + ob * 128 + 4 * (lane - 32))); st4bf(P.Vc + (size_t)kr * 128 + 4 * (lane - 32), v); } }
            { const f32x4 v = CV4(r_qd);
              st4bf(P.Qd_raw + (size_t)kr * 256 + ci, v * QS);
              const f32x4 r = ROPE64(v);
              if (samp) st4bf(P.Qd_rot + (size_t)kr * 256 + ci, r * QS); }
            { const f32x4 v = CV4(r_kvd);
              const f32x4 r = ROPE64(v);
              if (lane < 32) { if (!samp) __builtin_nontemporal_store((f32x4)(v), (f32x4*)(P.o_sk + ob * 128 + ci)); st4bf(P.Kd + (size_t)kr * 128 + ci, samp ? r : v); }
              else { if (!samp) __builtin_nontemporal_store((f32x4)(v), (f32x4*)(P.o_sv + ob * 128 + 4 * (lane - 32))); st4bf(P.Vd + (size_t)kr * 128 + 4 * (lane - 32), v); } }
#undef CV4
#undef ROPE64
        } else {
            const int ci = row - NTOK, b = ci >> 9, j = ci & 511, kr = NPR + b * 2560 + 2048 + j;
            const size_t cb = (size_t)((b * 2 + l) * 512 + j);
            f32x4 z = (f32x4){0.f, 0.f, 0.f, 0.f}; asm volatile("" : "+v"(z));
            if (lane < 48) st4bf(P.A2 + (size_t)kr * 384 + 4 * lane, z);
            if (lane < 32) st4bf(P.A2 + (size_t)kr * 384 + 192 + 4 * lane, *(const f32x4*)(P.c_ckv + cb * 128 + 4 * lane));
            else if (lane < 48) st4bf(P.A2 + (size_t)kr * 384 + 320 + 4 * (lane - 32), z);
            if (lane < 8) st4bf(P.KPE + (size_t)kr * 32 + 4 * lane, *(const f32x4*)(P.c_kpe + cb * 32 + 4 * lane));
            if (lane < 32) { st4bf(P.Kc + (size_t)kr * 128 + 4 * lane, *(const f32x4*)(P.c_gk + cb * 128 + 4 * lane));
                             st4bf(P.Kd + (size_t)kr * 128 + 4 * lane, *(const f32x4*)(P.c_sk + cb * 128 + 4 * lane)); }
            else { st4bf(P.Vc + (size_t)kr * 128 + 4 * (lane - 32), *(const f32x4*)(P.c_gv + cb * 128 + 4 * (lane - 32)));
                   st4bf(P.Vd + (size_t)kr * 128 + 4 * (lane - 32), *(const f32x4*)(P.c_sv + cb * 128 + 4 * (lane - 32))); }
        }
    }
}

struct AttnSrc {
    const bf16* Qraw; const bf16* Qrot; int qpitch;
    const bf16* K0; int k0pitch; const bf16* K1;
    const bf16* V; int vpitch;
    bf16* Y; int outcol;
    int krbase, rowbase, q0, lo, hi, nctx;
    bool samp, window; float m0; bool sink;
    const float* rope;
};
template <int DK>
__device__ __forceinline__ void attn_unit(const AttnSrc& S, LAS unsigned char* lds, int tid, int lane, int wave, unsigned* ctr, unsigned& nxt_u) {
    constexpr int TK = 128, NKB = TK / 16, NPP = TK / 32;
    constexpr int KP = DK + 8, VP = TK + 8, KS = DK / 32, CPK = DK / 8;
    constexpr int NKC = TK * CPK / NT, NVC = TK * 8 / NT;
    LAS bf16* Ks = (LAS bf16*)lds;
    LAS bf16* Vt = (LAS bf16*)(lds + 2 * TK * KP * 2);
    const int g = lane >> 4, fr = lane & 15;
    const int qpos = S.q0 + wave * 16 + fr;
    const size_t qkr = (size_t)(S.krbase + qpos);
    bf16x8 qraw[KS], qrot[KS];
#pragma unroll
    for (int ks = 0; ks < KS; ++ks) { qraw[ks] = *(const bf16x8*)(S.Qraw + qkr * S.qpitch + ks * 32 + g * 8); qrot[ks] = qraw[ks]; }
    if (S.samp) {
        if (DK == 96) {
            const bf16x8 own = qraw[KS - 1], par = *(const bf16x8*)(S.Qraw + qkr * S.qpitch + 64 + (g ^ 1) * 8);
            const int pos = g < 2 ? (qpos >> 6) : (qpos & 63);
            const float sg = (g & 1) ? 1.f : -1.f;
            const float* ct = S.rope + 2048 + pos * 8; const float* st = S.rope + 2560 + pos * 8;
            bf16x8 r;
#pragma unroll
            for (int e = 0; e < 8; ++e) { const float o = bflo((unsigned)(unsigned short)own[e]), p = bflo((unsigned)(unsigned short)par[e]);
                r[e] = (short)f2bf(o * ct[e] + p * st[e] * sg); }
            qrot[KS - 1] = r;
        } else {
#pragma unroll
            for (int ks = 0; ks < KS; ++ks) qrot[ks] = *(const bf16x8*)(S.Qrot + qkr * S.qpitch + ks * 32 + g * 8);
        }
    }
    bf16x8 qc[KS];
#pragma unroll
    for (int ks = 0; ks < KS; ++ks) qc[ks] = S.samp ? qrot[ks] : qraw[ks];
    float m = S.m0, l = (S.sink && g == 0) ? 1.f : 0.f;
    f32x4 o[4];
#pragma unroll
    for (int d = 0; d < 4; ++d) o[d] = (f32x4){0.f, 0.f, 0.f, 0.f};
    const int nloc = S.hi - S.lo, ntile = nloc + S.nctx;
    u32x4 kreg[NKC], vreg[NVC];
    auto gload = [&](int j) {
        const int tile = j < nloc ? S.lo + j : (2048 / TK) + (j - nloc);
        const size_t kr = (size_t)(S.krbase + tile * TK);
#pragma unroll
        for (int c = 0; c < NKC; ++c) { const int ch = tid + c * NT, key = ch / CPK, part = ch % CPK;
            if (DK == 64) kreg[c] = *(const u32x4*)(S.K0 + (kr + key) * S.k0pitch + part * 8);
            else kreg[c] = part < 8 ? *(const u32x4*)(S.K0 + (kr + key) * S.k0pitch + part * 8) : *(const u32x4*)(S.K1 + (kr + key) * 32 + (part - 8) * 8); }
#pragma unroll
        for (int c = 0; c < NVC; ++c) { const int ch = tid + c * NT, vkey = ch & (TK - 1), vdc = ch / TK;
            vreg[c] = *(const u32x4*)(S.V + (kr + vkey) * S.vpitch + vdc * 8); }
    };
    auto lstore = [&](int buf) {
        LAS bf16* kb = Ks + buf * TK * KP; LAS bf16* vb = Vt + buf * 64 * VP;
#pragma unroll
        for (int c = 0; c < NKC; ++c) { const int ch = tid + c * NT, key = ch / CPK, part = ch % CPK; *(LAS u32x4*)(kb + key * KP + part * 8) = kreg[c]; }
#pragma unroll
        for (int c = 0; c < NVC; ++c) { const int ch = tid + c * NT, vkey = ch & (TK - 1), vdc = ch / TK;
            LAS bf16* vp = vb + (vdc * 8) * VP + vkey; const u32x4 v = vreg[c];
            vp[0 * VP] = (bf16)(v.x & 0xffffu); vp[1 * VP] = (bf16)(v.x >> 16); vp[2 * VP] = (bf16)(v.y & 0xffffu); vp[3 * VP] = (bf16)(v.y >> 16);
            vp[4 * VP] = (bf16)(v.z & 0xffffu); vp[5 * VP] = (bf16)(v.z >> 16); vp[6 * VP] = (bf16)(v.w & 0xffffu); vp[7 * VP] = (bf16)(v.w >> 16); }
    };
    gload(0); lstore(0);
    __syncthreads();
    for (int j = 0; j < ntile; ++j) {
        const int buf = j & 1;
        if (j + 1 < ntile) gload(j + 1);
        else if (tid == 0) nxt_u = atomicAdd(ctr, 1u);
        const bool loc = j < nloc;
        if (j == nloc) {
#pragma unroll
            for (int ks = 0; ks < KS; ++ks) qc[ks] = qraw[ks]; }
        const LAS bf16* kb = Ks + buf * TK * KP; const LAS bf16* vb = Vt + buf * 64 * VP;
        f32x4 s[NKB];
#pragma unroll
        for (int kk = 0; kk < NKB; ++kk) { s[kk] = (f32x4){0.f, 0.f, 0.f, 0.f};
#pragma unroll
            for (int ks = 0; ks < KS; ++ks) { const bf16x8 af = *(const LAS bf16x8*)(kb + (kk * 16 + fr) * KP + ks * 32 + g * 8);
                s[kk] = __builtin_amdgcn_mfma_f32_16x16x32_bf16(af, qc[ks], s[kk], 0, 0, 0); } }
        if (S.window && loc) {
            const int kp0 = (S.lo + j) * TK + g * 4;
#pragma unroll
            for (int kk = 0; kk < NKB; ++kk)
#pragma unroll
                for (int i = 0; i < 4; ++i) { const int d = kp0 + kk * 16 + i - qpos; if (d > 128 || d < -128) s[kk][i] = -INFINITY; }
        }
        float mx = -INFINITY;
#pragma unroll
        for (int kk = 0; kk < NKB; ++kk) mx = fmaxf(mx, fmaxf(fmaxf(s[kk][0], s[kk][1]), fmaxf(s[kk][2], s[kk][3])));
        mx = fmaxf(mx, shx(mx, 16, lane)); mx = fmaxf(mx, shx(mx, 32, lane));
        const float mn = fmaxf(m, mx), alpha = __builtin_amdgcn_exp2f(m - mn);
        m = mn;
        float ls = 0.f;
#pragma unroll
        for (int kk = 0; kk < NKB; ++kk)
#pragma unroll
            for (int i = 0; i < 4; ++i) { const float p = __builtin_amdgcn_exp2f(s[kk][i] - mn); s[kk][i] = p; ls += p; }
        l = l * alpha + ls;
#pragma unroll
        for (int d = 0; d < 4; ++d) o[d] = o[d] * alpha;
        bf16x8 pf[NPP];
#pragma unroll
        for (int pp = 0; pp < NPP; ++pp) {
            const unsigned w0 = pk2(s[2 * pp][0], s[2 * pp][1]), w1 = pk2(s[2 * pp][2], s[2 * pp][3]), w2 = pk2(s[2 * pp + 1][0], s[2 * pp + 1][1]), w3 = pk2(s[2 * pp + 1][2], s[2 * pp + 1][3]);
            pf[pp] = __builtin_bit_cast(bf16x8, (u32x4){w0, w1, w2, w3});
        }
#pragma unroll
        for (int d = 0; d < 4; ++d)
#pragma unroll
            for (int pp = 0; pp < NPP; ++pp) {
                const LAS bf16* vr = vb + (d * 16 + fr) * VP + pp * 32 + g * 4;
                const u32x2 lo = *(const LAS u32x2*)vr, hi = *(const LAS u32x2*)(vr + 16);
                const bf16x8 af = __builtin_bit_cast(bf16x8, (u32x4){lo.x, lo.y, hi.x, hi.y});
                o[d] = __builtin_amdgcn_mfma_f32_16x16x32_bf16(af, pf[pp], o[d], 0, 0, 0);
            }
        if (j + 1 < ntile) lstore(buf ^ 1);
        __syncthreads();
    }
    float lt = l + shx(l, 16, lane); lt += shx(lt, 32, lane);
    const float inv = 1.f / lt;
    bf16* yr = S.Y + (size_t)(S.rowbase + qpos) * DM + S.outcol + g * 4;
#pragma unroll
    for (int d = 0; d < 4; ++d) st4bf(yr + d * 16, o[d] * inv);
}

struct AttnBufs { const bf16 *MQKV, *KPE, *Qc_rot, *Qc_raw, *Kc, *Vc, *Qd_rot, *Qd_raw, *Kd, *Vd; bf16* YCAT; const float* sink; const float* rope; unsigned* ctr; };
constexpr int ATT_NU = 384 + 768;
__device__ __forceinline__ void attn_phase(const AttnBufs& B, LAS unsigned char* lds, int tid, int lane, int wave) {
    volatile LAS unsigned* shu = (volatile LAS unsigned*)(lds + LDS_CTL);
    if (tid == 0) *shu = atomicAdd(B.ctr, 1u);
    __syncthreads();
    for (;;) {
        const int u = (int)*shu;
        if (u >= ATT_NU) break;
        unsigned nxt_u = 0u;
        int type, b, h, qt; bool samp;
        if (u < 384) { type = u >> 7; const int v = u & 127; b = v >> 6; h = (v >> 4) & 3; qt = v & 15; samp = true; }
        else { const int w = u - 384; type = w >> 8; const int v = w & 255; b = v >> 3; h = (v >> 1) & 3; qt = v & 1; samp = false; }
        AttnSrc S;
        S.samp = samp; S.q0 = qt * 128; S.rope = B.rope; S.Y = B.YCAT;
        S.krbase = samp ? NPR + b * 2560 : b * 256; S.rowbase = samp ? NPR + b * 2048 : b * 256;
        S.window = false; S.sink = false; S.m0 = -1e30f;
        if (!samp) { S.lo = 0; S.hi = 2; S.nctx = 0; }
        else { S.lo = 0; S.hi = 16; S.nctx = 4; }
        if (type == 0) {
            S.Qraw = B.MQKV + h * 96; S.Qrot = S.Qraw; S.qpitch = 1024; S.K0 = B.MQKV + 384 + h * 128; S.k0pitch = 1024; S.K1 = B.KPE; S.V = B.MQKV + 384 + h * 128 + 64; S.vpitch = 1024; S.outcol = 256 + h * 64;
            attn_unit<96>(S, lds, tid, lane, wave, B.ctr, nxt_u);
        } else {
            if (type == 1) { S.Qraw = B.Qc_raw + h * 64; S.Qrot = B.Qc_rot + h * 64; S.K0 = B.Kc + (h >> 1) * 64; S.V = B.Vc + (h >> 1) * 64; S.outcol = 512 + h * 64; }
            else { S.Qraw = B.Qd_raw + h * 64; S.Qrot = B.Qd_rot + h * 64; S.K0 = B.Kd + (h >> 1) * 64; S.V = B.Vd + (h >> 1) * 64; S.outcol = 768 + h * 64;
                   S.sink = true; S.m0 = B.sink[h] * LOG2E;
                   if (samp) { S.window = true; const int lo = S.q0 / 128 - 1; S.lo = lo < 0 ? 0 : lo; const int hi = S.q0 / 128 + 2; S.hi = hi > 16 ? 16 : hi; } }
            S.qpitch = 256; S.k0pitch = 128; S.K1 = nullptr; S.vpitch = 128;
            attn_unit<64>(S, lds, tid, lane, wave, B.ctr, nxt_u);
        }
        if (tid == 0) *shu = nxt_u;
        __syncthreads();
    }
}

__device__ __forceinline__ void load8(const bf16* p, float (&o)[8]) { const u32x4 u = *(const u32x4*)p; o[0] = bflo(u.x); o[1] = bfhi(u.x); o[2] = bflo(u.y); o[3] = bfhi(u.y); o[4] = bflo(u.z); o[5] = bfhi(u.z); o[6] = bflo(u.w); o[7] = bfhi(u.w); }
__device__ __forceinline__ void convgate_phase(const bf16* U, const float* cf, bf16* ACT, int gt, int NGT) {
    constexpr int NCH = DFF / 8, RG = 8;
    for (int it = gt; it < (NTOK / RG) * NCH; it += NGT) {
        const int rg = it / NCH, cc = it % NCH, r0 = rg * RG, col = cc * 8;
        const bool samp = r0 >= NPR; const int t0 = samp ? ((r0 - NPR) & 2047) : (r0 & 255), T = samp ? 2048 : 256;
        const bf16* up = U + (size_t)r0 * DUP + col;
        u32x4 ra[RG + 2], rb[RG + 2];
        const u32x4 z4 = (u32x4){0u, 0u, 0u, 0u};
        ra[0] = z4; rb[0] = z4; ra[RG + 1] = z4; rb[RG + 1] = z4;
        if (t0 > 0) { ra[0] = *(const u32x4*)(up - DUP); rb[0] = *(const u32x4*)(up - DUP + DFF); }
#pragma unroll
        for (int i = 0; i < RG; ++i) { ra[i + 1] = *(const u32x4*)(up + (size_t)i * DUP); rb[i + 1] = *(const u32x4*)(up + (size_t)i * DUP + DFF); }
        if (t0 + RG < T) { ra[RG + 1] = *(const u32x4*)(up + (size_t)RG * DUP); rb[RG + 1] = *(const u32x4*)(up + (size_t)RG * DUP + DFF); }
        float wa[3][8], wb[3][8];
#pragma unroll
        for (int k = 0; k < 3; ++k) { const f32x4 a0 = *(const f32x4*)(cf + k * DUP + col), a1 = *(const f32x4*)(cf + k * DUP + col + 4), b0 = *(const f32x4*)(cf + k * DUP + DFF + col), b1 = *(const f32x4*)(cf + k * DUP + DFF + col + 4);
#pragma unroll
            for (int e = 0; e < 4; ++e) { wa[k][e] = a0[e]; wa[k][4 + e] = a1[e]; wb[k][e] = b0[e]; wb[k][4 + e] = b1[e]; } }
#pragma unroll
        for (int i = 0; i < RG; ++i) {
            float r[8];
#pragma unroll
            for (int h = 0; h < 4; ++h) {
                const unsigned pa = ra[i][h], ca = ra[i + 1][h], na = ra[i + 2][h], pb = rb[i][h], cb = rb[i + 1][h], nb = rb[i + 2][h];
                const float xa0 = wa[0][2 * h] * bflo(pa) + wa[1][2 * h] * bflo(ca) + wa[2][2 * h] * bflo(na), xb0 = wb[0][2 * h] * bflo(pb) + wb[1][2 * h] * bflo(cb) + wb[2][2 * h] * bflo(nb);
                const float xa1 = wa[0][2 * h + 1] * bfhi(pa) + wa[1][2 * h + 1] * bfhi(ca) + wa[2][2 * h + 1] * bfhi(na), xb1 = wb[0][2 * h + 1] * bfhi(pb) + wb[1][2 * h + 1] * bfhi(cb) + wb[2][2 * h + 1] * bfhi(nb);
                r[2 * h] = xa0 * __builtin_amdgcn_rcpf(1.f + __builtin_amdgcn_exp2f(-xa0 * LOG2E)) * xb0;
                r[2 * h + 1] = xa1 * __builtin_amdgcn_rcpf(1.f + __builtin_amdgcn_exp2f(-xa1 * LOG2E)) * xb1;
            }
            u32x4 w; w.x = pk2(r[0], r[1]); w.y = pk2(r[2], r[3]); w.z = pk2(r[4], r[5]); w.w = pk2(r[6], r[7]);
            *(u32x4*)(ACT + (size_t)(r0 + i) * DFF + col) = w;
        }
    }
}

#define XB_TMO      128
#define XB_XCNT(j)  (256  + 64 * (j))
#define XB_XSUB(j)  (1280 + 64 * (j))
#define XB_XGEN(j)  (2304 + 64 * (j))
#define XB_TOP      3328
#define XB_TOPGEN   3392
#define XCD_BAR_WORDS 3456
#define XB_SPIN_CAP (1u << 20)
__device__ __forceinline__ unsigned xb_ld(unsigned* p)              { return __hip_atomic_load(p, __ATOMIC_RELAXED, __HIP_MEMORY_SCOPE_AGENT); }
__device__ __forceinline__ unsigned xb_add(unsigned* p, unsigned v) { return __hip_atomic_fetch_add(p, v, __ATOMIC_RELAXED, __HIP_MEMORY_SCOPE_AGENT); }
__device__ __forceinline__ unsigned xb_xcc_id() { return (unsigned)__builtin_amdgcn_s_getreg((3 << 11) | 20) & 0xFu; }
#define XB_SPIN(cond, bar) do { unsigned _sp = 0; while (cond) { __builtin_amdgcn_s_sleep(1); \
    if ((++_sp & 255u) == 0u) { if (xb_ld(&(bar)[XB_TMO])) break; if (_sp > XB_SPIN_CAP) { atomicAdd(&(bar)[XB_TMO], 1u); break; } } } } while (0)
struct XcdBarrier { unsigned* bar; unsigned x; volatile LAS unsigned* st; };
__device__ __forceinline__ void xcd_barrier_complete(unsigned* bar, unsigned x, unsigned& nloc, unsigned& nx) {
    const unsigned G = gridDim.x * gridDim.y * gridDim.z;
    unsigned sum, cnt, mine, sp = 0u;
    for (;;) {
        sum = 0u; cnt = 0u; mine = 0u;
#pragma unroll
        for (unsigned j = 0; j < 16; ++j) { const unsigned c = xb_ld(&bar[XB_XCNT(j)]); sum += c; cnt += (c > 0u) ? 1u : 0u; mine = (j == x) ? c : mine; }
        if (sum == G) break;
        __builtin_amdgcn_s_sleep(1);
        if ((++sp & 255u) == 0u) { if (xb_ld(&bar[XB_TMO])) break; if (sp > XB_SPIN_CAP) { atomicAdd(&bar[XB_TMO], 1u); break; } }
    }
    nloc = mine > 0u ? mine : 1u; nx = cnt > 0u ? cnt : 1u;
}
__device__ __forceinline__ void xcd_barrier(const XcdBarrier& b, const int tid_) {
    asm volatile("s_waitcnt vmcnt(0)" ::: "memory");
    __syncthreads();
    if (tid_ == 0) {
        unsigned* bar = b.bar;
        __builtin_amdgcn_s_waitcnt(0);
        unsigned nloc = b.st[0], nx = b.st[1];
        if (nloc == 0u) { xcd_barrier_complete(bar, b.x, nloc, nx); b.st[0] = nloc; b.st[1] = nx; }
        const unsigned old = xb_add(&bar[XB_XSUB(b.x)], 1u);
        const unsigned gen = old / nloc;
        if (old + 1u == (gen + 1u) * nloc) {
            __builtin_amdgcn_fence(__ATOMIC_RELEASE, "agent");
            asm volatile("s_waitcnt vmcnt(0)" ::: "memory");
            const unsigned og = xb_add(&bar[XB_TOP], 1u);
            const unsigned tg = og / nx;
            if (og + 1u == (tg + 1u) * nx) xb_add(&bar[XB_TOPGEN], 1u);
            else XB_SPIN(xb_ld(&bar[XB_TOPGEN]) == tg, bar);
            __builtin_amdgcn_fence(__ATOMIC_ACQUIRE, "agent");
            xb_add(&bar[XB_XGEN(b.x)], 1u);
            asm volatile("s_waitcnt vmcnt(0)" ::: "memory");
        } else {
            XB_SPIN(xb_ld(&bar[XB_XGEN(b.x)]) == gen, bar);
            __builtin_amdgcn_fence(__ATOMIC_ACQUIRE, "agent");
            asm volatile("s_waitcnt vmcnt(0)" ::: "memory");
        }
    }
    __syncthreads();
}

__device__ __forceinline__ int lane_id_volatile() { int l; asm volatile("v_mbcnt_lo_u32_b32 %0, -1, 0\n\tv_mbcnt_hi_u32_b32 %0, -1, %0" : "=v"(l)); return l; }

#ifndef PH
#define PH 0xFFFF
#endif
#define ON(k) ((PH >> (k)) & 1)
#ifndef REP
#define REP 0
#endif
#define NREP(k) (1 + ((REP >> (k)) & 1))
__global__ void __launch_bounds__(NT, 2) mega_fwd(Args a_unused) {
    extern __shared__ __attribute__((aligned(16))) unsigned char lds[];
    cg::grid_group grid = cg::this_grid();
    const int G = gridDim.x, bid = blockIdx.x;
    const int wave_s = __builtin_amdgcn_readfirstlane(threadIdx.x >> 6);
    PG8_LAS unsigned char* ring = (PG8_LAS unsigned char*)lds;
#define PHASE_BEGIN int tid = wave_s * 64 + lane_id_volatile(); asm volatile("" : "+v"(tid)); const CAS Args* ap_ = (const CAS Args*)__builtin_amdgcn_kernarg_segment_ptr(); asm volatile("" : "+s"(ap_)); const CAS Args& a = *ap_; unsigned char* ws = a.ws; float* out = a.out; \
    const int lane = tid & 63, wave = __builtin_amdgcn_readfirstlane(tid >> 6); const int gw = bid * NW + wave, NGW = G * NW, gt = bid * NT + tid, NGT = G * NT; \
    (void)lane; (void)wave; (void)gw; (void)NGW; (void)gt; (void)NGT; (void)out; \
    const float* mod = (const float*)(ws + WS_MOD); const float* rope = (const float*)(ws + WS_ROPE); (void)mod; (void)rope; \
    bf16* XN = (bf16*)(ws + WS_XN); bf16* PROJ = (bf16*)(ws + WS_PROJ); bf16* A2 = (bf16*)(ws + WS_A2); bf16* MQKV = (bf16*)(ws + WS_MQKV); \
    bf16* KPE = (bf16*)(ws + WS_KPE); bf16* YCAT = (bf16*)(ws + WS_YCAT); bf16* ACT = (bf16*)(ws + WS_ACT); bf16* U = (bf16*)(ws + WS_U); \
    bf16* Qc_rot = (bf16*)(ws + WS_QC); bf16* Qc_raw = (bf16*)(ws + WS_QC + QSZ); bf16* Kc = (bf16*)(ws + WS_QC + 2 * QSZ); bf16* Vc = (bf16*)(ws + WS_QC + 2 * QSZ + KSZ); \
    bf16* Qd_rot = (bf16*)(ws + WS_QC + 2 * QSZ + 2 * KSZ); bf16* Qd_raw = Qd_rot + (size_t)NKR * 256; bf16* Kd = Qd_raw + (size_t)NKR * 256; bf16* Vd = Kd + (size_t)NKR * 128; \
    (void)XN; (void)PROJ; (void)A2; (void)MQKV; (void)KPE; (void)YCAT; (void)ACT; (void)U; (void)Qc_rot; (void)Qc_raw; (void)Kc; (void)Vc; (void)Qd_rot; (void)Qd_raw; (void)Kd; (void)Vd;
#define GSYNC() do { const CAS Args* bp_ = (const CAS Args*)__builtin_amdgcn_kernarg_segment_ptr(); asm volatile("" : "+s"(bp_)); XcdBarrier xb_; xb_.bar = (unsigned*)(bp_->ws + WS_BAR); xb_.x = xb_xcc_id(); \
    xb_.st = (volatile LAS unsigned*)((LAS unsigned char*)lds + LDS_CTL + 32); xcd_barrier(xb_, wave_s * 64 + lane_id_volatile()); } while (0)
#define LAYER_VALS const float* modl = mod + (size_t)l * 3 * 6144; unsigned char* wl = ws + WS_W + l * W_LSTRIDE; (void)modl; (void)wl; \
    const float* x0 = l == 0 ? a.in[0] : nullptr; const float* x1 = l == 0 ? a.in[1] : nullptr; (void)x0; (void)x1; bf16* XRES = (bf16*)(ws + WS_XRES); (void)XRES;

    if (threadIdx.x < 16) ((volatile LAS unsigned*)((LAS unsigned char*)lds + LDS_CTL))[threadIdx.x] = 0u;
    __syncthreads();
    { PHASE_BEGIN if (tid == 0) (void)xb_add((unsigned*)(ws + WS_BAR) + XB_XCNT(xb_xcc_id()), 1u);
      if (ws == nullptr) grid.sync(); }
    for (int rep = 0; rep < NREP(0); ++rep) {
    if (ON(0)) { PHASE_BEGIN phase0(a, (LAS unsigned char*)lds, tid, lane, wave); }
    GSYNC(); }

    if (ON(1)) { PHASE_BEGIN
        if (G > 124) {
            if (bid < 62) bias_phase(a, ws, (LAS unsigned char*)lds, tid, lane, wave);
            else prep_phase(a.in[0], a.in[1], a.in[12], mod, 1024, XN, (float*)(ws + WS_SS1), lane, (bid - 62) * NW + wave, (G - 62) * NW);
        } else { bias_phase(a, ws, (LAS unsigned char*)lds, tid, lane, wave);
            prep_phase(a.in[0], a.in[1], a.in[12], mod, 1024, XN, (float*)(ws + WS_SS1), lane, gw, NGW); } }
    GSYNC();
#pragma unroll
    for (int l = 0; l < 2; ++l) {
        for (int rep = 0; rep < NREP(2); ++rep) {
        if (ON(2)) { PHASE_BEGIN LAYER_VALS pg8::Gemm g{XN, (const bf16*)(wl + W_IN), NTOK, INP, DM, 0, 0}; pg8::StaticOrder S; S.init(NTOK, INP, G, bid);
          pg8::EpiBf16RS E{PROJ, INP, (const float*)(ws + WS_SS1), (const float*)(ws + WS_BIAS) + (size_t)l * 3 * NBIAS, NBIAS};
          pg8::gemm_phase<pg8::EpiBf16RS, pg8::StaticOrder, true, true>(ring, g, S, E, tid); }
        GSYNC(); }
        for (int rep = 0; rep < NREP(3); ++rep) {
        if (ON(3)) { PHASE_BEGIN P3Ptrs P; P.PROJ = PROJ; P.A2 = A2; P.KPE = KPE; P.YCAT = YCAT; P.Qc_rot = Qc_rot; P.Qc_raw = Qc_raw; P.Kc = Kc; P.Vc = Vc; P.Qd_rot = Qd_rot; P.Qd_raw = Qd_raw; P.Kd = Kd; P.Vd = Vd;
          P.conv_a = a.in[14]; P.gq_mla = a.in[15]; P.gkv_mla = a.in[17]; P.gq = a.in[19]; P.gk = a.in[20]; P.rope = rope;
          P.c_ckv = a.in[2]; P.c_kpe = a.in[3]; P.c_gk = a.in[4]; P.c_gv = a.in[5]; P.c_sk = a.in[6]; P.c_sv = a.in[7];
          P.o_ckv = out + 12582912; P.o_kpe = out + 14680064; P.o_gk = out + 15204352; P.o_gv = out + 17301504; P.o_sk = out + 19398656; P.o_sv = out + 21495808; P.l = l;
          p3_phase(P, lane, gw, NGW); }
        GSYNC(); }
        for (int rep = 0; rep < NREP(4); ++rep) {
        if (ON(4)) { PHASE_BEGIN LAYER_VALS pg8::Gemm g{A2, (const bf16*)(wl + W_B2), NKR, 1024, 384, 0, 0}; pg8::StaticOrder S; S.init(NKR, 1024, G, bid); pg8::EpiBf16 E{MQKV, 1024};
          pg8::gemm_phase<pg8::EpiBf16, pg8::StaticOrder, true, true>(ring, g, S, E, tid); }
        GSYNC(); }
        for (int rep = 0; rep < NREP(5); ++rep) {
        if (ON(5)) { PHASE_BEGIN AttnBufs B; B.MQKV = MQKV; B.KPE = KPE; B.Qc_rot = Qc_rot; B.Qc_raw = Qc_raw; B.Kc = Kc; B.Vc = Vc; B.Qd_rot = Qd_rot; B.Qd_raw = Qd_raw; B.Kd = Kd; B.Vd = Vd; B.YCAT = YCAT;
          B.sink = a.in[21] + l * 4; B.rope = rope; B.ctr = (unsigned*)(ws + WS_CTL) + 64 * l + 128 * rep;
          attn_phase(B, (LAS unsigned char*)lds, tid, lane, wave); }
        GSYNC(); }
        if (ON(6)) { PHASE_BEGIN LAYER_VALS pg8::Gemm g{YCAT, (const bf16*)(wl + W_OUT), NTOK, DM, DM, 0, 0}; pg8::StaticOrder S; S.init(NTOK, DM, G, bid);
          pg8::EpiResid E{x0, x1, XRES, modl + 2048, XN, (float*)(ws + WS_SS2), a.in[23] + l * DM, modl + 4096};
          pg8::gemm_phase<pg8::EpiResid, pg8::StaticOrder, true, true>(ring, g, S, E, tid);
          if (l == 0) { const int wk = G > 192 ? bid - 192 : bid, nwk = G > 192 ? G - 192 : G;
            if (wk >= 0) wconv(a, ws, 0, 4 | 8, wk * NW + wave, nwk * NW, (LAS float*)((LAS unsigned char*)lds + wave * 16640), lane); } }
        GSYNC();
        for (int rep = 0; rep < NREP(8); ++rep) {
        if (ON(8)) { PHASE_BEGIN LAYER_VALS pg8::Gemm g{XN, (const bf16*)(wl + W_UP), NTOK, DUP, DM, (size_t)128 * DM * 2, (size_t)DFF * DM * 2}; pg8::StaticOrder S; S.init(NTOK, DUP, G, bid);
          pg8::EpiUpGate E{ACT, (const float*)(ws + WS_SS2), (const float*)(ws + WS_BIAS) + (size_t)l * 3 * NBIAS + 2304, NBIAS, a.in[25] + (size_t)l * 3 * DUP, (float*)(ws + WS_HALO), ring + 131072};
          pg8::gemm_phase<pg8::EpiUpGate, pg8::StaticOrder, true, true>(ring, g, S, E, tid); }
        GSYNC(); }
        if (ON(10)) { PHASE_BEGIN LAYER_VALS pg8::Gemm g{ACT, (const bf16*)(wl + W_DOWN), NTOK, DM, DFF, 0, 0}; pg8::StaticOrder S; S.init(NTOK, DM, G, bid);
          {
            const float* cwl = a.in[25] + (size_t)l * 3 * DUP; const float* HALO = (const float*)(ws + WS_HALO); pg8::Unit hu;
            bool fixed = false;
            for (int ui = 0; S.next(ui, hu); ++ui) { if (hu.pm < 32) continue; fixed = true; const int k = hu.pm - 32, pos = k & 7;
                for (int idx = tid; idx < 2 * DFF; idx += NT) { const int which = idx >= DFF ? 1 : 0, j = idx - which * DFF;
                    if (which == 0 ? pos == 0 : pos == 7) continue;
                    const float* Pp = HALO + (size_t)(k * 4 + (which ? 3 : 1)) * DUP; const float* Ep = HALO + (size_t)((which ? k + 1 : k - 1) * 4 + (which ? 0 : 2)) * DUP; const float* wp = cwl + (which ? 2 : 0) * DUP;
                    const float ca = Pp[j] + wp[j] * Ep[j], cb = Pp[DFF + j] + wp[DFF + j] * Ep[DFF + j];
                    const float r = ca * __builtin_amdgcn_rcpf(1.f + __builtin_amdgcn_exp2f(-ca * LOG2E)) * cb;
                    ACT[(size_t)(hu.pm * 256 + (which ? 255 : 0)) * DFF + j] = (bf16)(pk2(r, r) & 0xffffu); } }
            if (fixed) { asm volatile("s_waitcnt vmcnt(0)" ::: "memory"); __syncthreads();
                if (tid == 0) { __builtin_amdgcn_fence(__ATOMIC_RELEASE, "agent"); __builtin_amdgcn_fence(__ATOMIC_ACQUIRE, "agent"); asm volatile("s_waitcnt vmcnt(0)" ::: "memory"); }
                __syncthreads(); } }
          if (l == 1 && G >= 192) {
            pg8::EpiResidFinal E{XRES, out, modl + 5120, (float*)(ws + WS_SS1), a.in[27], (unsigned*)(ws + WS_CTL) + 2048};
            pg8::gemm_phase<pg8::EpiResidFinal, pg8::StaticOrder, true, true>(ring, g, S, E, tid);
          } else {
          pg8::EpiResid E{nullptr, nullptr, XRES, modl + 5120, l == 0 ? XN : nullptr, (float*)(ws + WS_SS1), a.in[12] + DM, mod + (size_t)3 * 6144 + 1024};
          pg8::gemm_phase<pg8::EpiResid, pg8::StaticOrder, true, true>(ring, g, S, E, tid); }
          if (l == 0) { const int wk = G > 192 ? bid - 192 : bid, nwk = G > 192 ? G - 192 : G;
            if (wk >= 0) wconv(a, ws, 1, 63, wk * NW + wave, nwk * NW, (LAS float*)((LAS unsigned char*)lds + wave * 16640), lane); } }
        if (!(l == 1 && G >= 192)) GSYNC();
    }
#ifdef XSYNC
    for (int i = 0; i < XSYNC; ++i) GSYNC();
#endif
    if (G < 192) { PHASE_BEGIN
    const bf16* XRES = (const bf16*)(ws + WS_XRES);
    for (int row = gw; row < NTOK; row += NGW) {
        float* xr = out + (size_t)row * DM;
        f32x4 v[4]; float ss = 0.f;
#pragma unroll
        for (int j = 0; j < 4; ++j) { v[j] = ld4bf(XRES + (size_t)row * DM + 4 * (lane + 64 * j)); ss += dot4(v[j]); }
        const float rs = rsqrtf(wave_sum(ss, lane) * (1.f / DM) + EPS);
#pragma unroll
        for (int j = 0; j < 4; ++j) { const int col = 4 * (lane + 64 * j); *(f32x4*)(xr + col) = v[j] * rs * *(const f32x4*)(a.in[27] + col); }
    } }
}

extern "C" void kernel_launch(void* const* d_in, const int* in_sizes, int n_in, void* d_out, int out_size, void* d_ws, size_t ws_size, hipStream_t stream) {
    static int grid = 0;
    if (grid == 0) {
        if (n_in != 28 || ws_size < WS_END) { fprintf(stderr, "kernel_launch: unexpected n_in %d / ws %zu\n", n_in, ws_size); grid = -1; return; }
        int dev = 0, cus = 0, per_cu = 0;
        hipGetDevice(&dev); hipDeviceGetAttribute(&cus, hipDeviceAttributeMultiprocessorCount, dev);
        hipFuncSetAttribute((const void*)mega_fwd, hipFuncAttributeMaxDynamicSharedMemorySize, LDS_BYTES);
        hipOccupancyMaxActiveBlocksPerMultiprocessor(&per_cu, (const void*)mega_fwd, NT, LDS_BYTES);
        if (per_cu < 1) per_cu = 1;
        grid = cus * per_cu;
        (void)hipGetLastError();
    }
    if (grid < 0) return;
    if (hipMemsetAsync((char*)d_ws + WS_BAR, 0, XCD_BAR_WORDS * 4, stream) != hipSuccess) { fprintf(stderr, "kernel_launch: memset of the barrier words failed\n"); return; }
    Args a{};
    for (int i = 0; i < 28; ++i) a.in[i] = (const float*)d_in[i];
    a.out = (float*)d_out; a.ws = (unsigned char*)d_ws;
    void* args[] = {&a};
    hipError_t e = hipLaunchCooperativeKernel((const void*)mega_fwd, dim3(grid), dim3(NT), args, LDS_BYTES, stream);
    if (e != hipSuccess) fprintf(stderr, "cooperative launch failed: %s (grid %d)\n", hipGetErrorString(e), grid);
}
```

```cpp
#include <hip/hip_runtime.h>
#include <hip/hip_cooperative_groups.h>
#include <cstdio>
#include <cstdint>
namespace cg = cooperative_groups;

namespace pg8 {
#define PG8_LAS __attribute__((address_space(3)))
typedef unsigned short bf16_t;
typedef short bf16x8 __attribute__((ext_vector_type(8)));
typedef float f32x4 __attribute__((ext_vector_type(4)));
typedef unsigned u32x4 __attribute__((ext_vector_type(4)));
constexpr int BM = 256, BK = 64, HALF = 128, HTB = HALF * BK * 2, STAGE_BYTES = 8 * HTB, NXCD = 8, WGM = 8;

__host__ __device__ __forceinline__ int lds_byte(int r, int c) { const int st = (r >> 4) * 2 + (c >> 5), rr = r & 15, cc = c & 31, ob = rr * 64 + cc * 2; return st * 1024 + (ob ^ (((ob >> 9) & 1) << 5)); }
__host__ __device__ __forceinline__ void stage_rc(int b, int& R, int& C) { const int st = b / 1024, sb = b % 1024, swz = sb ^ (((sb >> 9) & 1) << 5); R = (st >> 1) * 16 + swz / 64; C = (st & 1) * 32 + (swz % 64) / 2; }
__host__ __device__ __forceinline__ int perm32(int rho) { const int n = rho >> 4, i = rho & 15; return 8 * (i >> 2) + 4 * n + (i & 3); }

struct Unit { int pm, pn; };
struct Gemm { const bf16_t* A; const bf16_t* Bt; int M, N, K; size_t bstep, bhalf; };

struct StaticOrder {
    int nM, nN, nwg, G, c;
    __host__ __device__ __forceinline__ void init(int M, int N, int G_, int c_) { nM = M / BM; nN = N / BM; nwg = nM * nN; G = G_; c = c_; }
    __host__ __device__ __forceinline__ bool next(int i, Unit& u) const {
        const long L = (long)i * G + c; if (L >= nwg) return false;
        int wgid = (int)L; { const int q = nwg / NXCD, r = nwg % NXCD, xcd = wgid % NXCD, off = wgid / NXCD; wgid = (xcd < r ? xcd * (q + 1) : r * (q + 1) + (xcd - r) * q) + off; }
        const int nig = WGM * nN, gid = wgid / nig, fm = gid * WGM, gsz = (nM - fm) < WGM ? (nM - fm) : WGM;
        u.pm = fm + ((wgid % nig) % gsz); u.pn = (wgid % nig) / gsz; return true;
    }
    __device__ __forceinline__ void a_ready(const Unit&) const {}
    __device__ __forceinline__ void done(const Unit&) const {}
};

__device__ __forceinline__ unsigned cvt_pk_bf16(float lo, float hi) { unsigned r; asm volatile("v_cvt_pk_bf16_f32 %0, %1, %2" : "=v"(r) : "v"(lo), "v"(hi)); return r; }

struct EpiBf16 {
    static constexpr bool PERM = true, AFTER_DRAIN = false;
    bf16_t* O; int ldc;
    __device__ __forceinline__ void operator()(const f32x4 (&acc)[2][2][4][2], const Unit& u, int wr, int wc, int fr, int fq) const {
        asm volatile("" : "+v"(fr), "+v"(fq));
        const int row0 = u.pm * BM + wr * 64 + fr; const int col0 = u.pn * BM + wc * 32 + 8 * fq;
#pragma unroll
        for (int ai = 0; ai < 2; ++ai)
#pragma unroll
            for (int m = 0; m < 4; ++m) { bf16_t* rowp = O + (size_t)(row0 + ai * HALF + m * 16) * ldc + col0;
#pragma unroll
                for (int bj = 0; bj < 2; ++bj) { const f32x4 v0 = acc[ai][bj][m][0], v1 = acc[ai][bj][m][1];
                    u32x4 w; w.x = cvt_pk_bf16(v0[0], v0[1]); w.y = cvt_pk_bf16(v0[2], v0[3]); w.z = cvt_pk_bf16(v1[0], v1[1]); w.w = cvt_pk_bf16(v1[2], v1[3]);
                    *(u32x4*)(rowp + bj * HALF) = w; } }
    }
};
__device__ __forceinline__ float shx_(float v, int m, int lane) { return __builtin_bit_cast(float, __builtin_amdgcn_ds_bpermute((lane ^ m) << 2, __builtin_bit_cast(int, v))); }
__device__ __forceinline__ void row_scales(const float* SS, int row0, int fr, int fq, float (&rs)[8]) {
    f32x4 t[8];
#pragma unroll
    for (int q = 0; q < 8; ++q) t[q] = *(const f32x4*)(SS + (size_t)(row0 + (q >> 2) * HALF + (q & 3) * 16) * 16 + 4 * fq);
    const int lane = fq * 16 + fr;
#pragma unroll
    for (int q = 0; q < 8; ++q) { float v = (t[q][0] + t[q][1]) + (t[q][2] + t[q][3]); v += shx_(v, 16, lane); v += shx_(v, 32, lane); rs[q] = __builtin_amdgcn_rsqf(v * (1.f / 1024.f) + 1e-6f); }
}
struct EpiBf16RS {
    static constexpr bool PERM = true, AFTER_DRAIN = false;
    bf16_t* O; int ldc; const float* SS; const float* bias; int ldb;
    __device__ __forceinline__ void operator()(const f32x4 (&acc)[2][2][4][2], const Unit& u, int wr, int wc, int fr, int fq) const {
        asm volatile("" : "+v"(fr), "+v"(fq));
        const int cnd = u.pm < 32 ? 0 : 1 + ((u.pm - 32) >> 3);
        const int row0 = u.pm * BM + wr * 64 + fr; const int col0 = u.pn * BM + wc * 32 + 8 * fq;
        const float* bp = bias + (size_t)cnd * ldb + col0;
        f32x4 bv[2][2];
#pragma unroll
        for (int bj = 0; bj < 2; ++bj)
#pragma unroll
            for (int n = 0; n < 2; ++n) bv[bj][n] = *(const f32x4*)(bp + bj * HALF + 4 * n);
        float rsv[8]; row_scales(SS, row0, fr, fq, rsv);
#pragma unroll
        for (int ai = 0; ai < 2; ++ai)
#pragma unroll
            for (int m = 0; m < 4; ++m) { const int row = row0 + ai * HALF + m * 16; const float rs = rsv[ai * 4 + m];
                bf16_t* rowp = O + (size_t)row * ldc + col0;
#pragma unroll
                for (int bj = 0; bj < 2; ++bj) { const f32x4 v0 = acc[ai][bj][m][0] * rs + bv[bj][0], v1 = acc[ai][bj][m][1] * rs + bv[bj][1];
                    u32x4 w; w.x = cvt_pk_bf16(v0[0], v0[1]); w.y = cvt_pk_bf16(v0[2], v0[3]); w.z = cvt_pk_bf16(v1[0], v1[1]); w.w = cvt_pk_bf16(v1[2], v1[3]);
                    *(u32x4*)(rowp + bj * HALF) = w; } }
    }
};
struct EpiResid {
    static constexpr bool PERM = false, AFTER_DRAIN = false;
    const float* r0; const float* r1; bf16_t* XR; const float* gate;
    bf16_t* XN; float* SS; const float* nrm; const float* sc;
    __device__ __forceinline__ void operator()(const f32x4 (&acc)[2][2][4][2], const Unit& u, int wr, int wc, int fr, int fq) const {
        asm volatile("" : "+v"(fr), "+v"(fq));
        typedef unsigned u32x2_ __attribute__((ext_vector_type(2)));
        const int cnd = u.pm < 32 ? 0 : 1 + ((u.pm - 32) >> 3);
        const float* gp = gate + cnd * 6144;
        const int col0 = u.pn * BM + wc * 32 + 4 * fq;
        const int rowb = u.pm * BM + wr * 64 + fr;
        const bool inf = r0 != nullptr;
        const float* rs = (u.pm < 32 ? r0 + (size_t)rowb * 1024 : r1 + (size_t)(rowb - 8192) * 1024) + col0;
        bf16_t* op = XR + (size_t)rowb * 1024 + col0;
#define LDX(off) (inf ? __builtin_nontemporal_load((const f32x4*)(rs + (off))) : ({ const u32x2_ t_ = *(const u32x2_*)(op + (off)); (f32x4){__builtin_bit_cast(float, t_.x << 16), __builtin_bit_cast(float, t_.x & 0xffff0000u), __builtin_bit_cast(float, t_.y << 16), __builtin_bit_cast(float, t_.y & 0xffff0000u)}; }))
        const bool prep = XN != nullptr;
        f32x4 gv[2][2], hv[2][2];
#pragma unroll
        for (int bj = 0; bj < 2; ++bj)
#pragma unroll
            for (int n = 0; n < 2; ++n) { gv[bj][n] = *(const f32x4*)(gp + col0 + bj * HALF + n * 16);
                hv[bj][n] = (f32x4){0.f, 0.f, 0.f, 0.f};
                if (prep) hv[bj][n] = *(const f32x4*)(nrm + col0 + bj * HALF + n * 16) * (1.f + *(const f32x4*)(sc + cnd * 6144 + col0 + bj * HALF + n * 16)); }
        f32x4 xc[2][2], xn[2][2];
#pragma unroll
        for (int bj = 0; bj < 2; ++bj)
#pragma unroll
            for (int n = 0; n < 2; ++n) xc[bj][n] = LDX(bj * HALF + n * 16);
#pragma unroll
        for (int it = 0; it < 8; ++it) { const int ai = it >> 2, m = it & 3; const size_t ro = (size_t)(ai * HALF + m * 16) * 1024;
            if (it < 7) { const int ai2 = (it + 1) >> 2, m2 = (it + 1) & 3; const size_t ro2 = (size_t)(ai2 * HALF + m2 * 16) * 1024;
#pragma unroll
                for (int bj = 0; bj < 2; ++bj)
#pragma unroll
                    for (int n = 0; n < 2; ++n) xn[bj][n] = LDX(ro2 + bj * HALF + n * 16); }
            float ssq = 0.f;
#pragma unroll
            for (int bj = 0; bj < 2; ++bj)
#pragma unroll
                for (int n = 0; n < 2; ++n) { const f32x4 v = xc[bj][n] + gv[bj][n] * acc[ai][bj][m][n];
                    *(u32x2_*)(op + ro + bj * HALF + n * 16) = (u32x2_){cvt_pk_bf16(v[0], v[1]), cvt_pk_bf16(v[2], v[3])};
                    if (prep) { ssq += (v[0] * v[0] + v[1] * v[1]) + (v[2] * v[2] + v[3] * v[3]); const f32x4 h = v * hv[bj][n];
                        unsigned w0 = cvt_pk_bf16(h[0], h[1]), w1 = cvt_pk_bf16(h[2], h[3]);
                        *(u32x2_*)(XN + (size_t)(rowb + ai * HALF + m * 16) * 1024 + col0 + bj * HALF + n * 16) = (u32x2_){w0, w1}; } }
            if (prep) { const int lane = fq * 16 + fr; ssq += shx_(ssq, 16, lane); ssq += shx_(ssq, 32, lane);
                if (fq == 0) SS[(size_t)(rowb + ai * HALF + m * 16) * 16 + u.pn * 4 + wc] = ssq; }
#pragma unroll
            for (int bj = 0; bj < 2; ++bj)
#pragma unroll
                for (int n = 0; n < 2; ++n) xc[bj][n] = xn[bj][n];
        }
    }
#undef LDX
};

struct EpiResidFinal {
    static constexpr bool PERM = false, AFTER_DRAIN = false;
    const bf16_t* res; float* out; const float* gate; float* SS; const float* fw; unsigned* cnt;
    __device__ __forceinline__ void operator()(f32x4 (&acc)[2][2][4][2], const Unit& u, int wr, int wc, int fr, int fq) const {
        asm volatile("" : "+v"(fr), "+v"(fq));
        const int cnd = u.pm < 32 ? 0 : 1 + ((u.pm - 32) >> 3);
        const float* gp = gate + cnd * 6144;
        const int col0 = u.pn * BM + wc * 32 + 4 * fq;
        const int rowb = u.pm * BM + wr * 64 + fr;
        typedef unsigned u32x2_ __attribute__((ext_vector_type(2)));
        const bf16_t* rs = res + (size_t)rowb * 1024 + col0;
#define LDXF(off) ({ const u32x2_ t_ = *(const u32x2_*)(rs + (off)); (f32x4){__builtin_bit_cast(float, t_.x << 16), __builtin_bit_cast(float, t_.x & 0xffff0000u), __builtin_bit_cast(float, t_.y << 16), __builtin_bit_cast(float, t_.y & 0xffff0000u)}; })
        f32x4 gv[2][2];
#pragma unroll
        for (int bj = 0; bj < 2; ++bj)
#pragma unroll
            for (int n = 0; n < 2; ++n) gv[bj][n] = *(const f32x4*)(gp + col0 + bj * HALF + n * 16);
        f32x4 xc[2][2], xn[2][2];
#pragma unroll
        for (int bj = 0; bj < 2; ++bj)
#pragma unroll
            for (int n = 0; n < 2; ++n) xc[bj][n] = LDXF(bj * HALF + n * 16);
#pragma unroll
        for (int it = 0; it < 8; ++it) { const int ai = it >> 2, m = it & 3;
            if (it < 7) { const int ai2 = (it + 1) >> 2, m2 = (it + 1) & 3; const size_t ro2 = (size_t)(ai2 * HALF + m2 * 16) * 1024;
#pragma unroll
                for (int bj = 0; bj < 2; ++bj)
#pragma unroll
                    for (int n = 0; n < 2; ++n) xn[bj][n] = LDXF(ro2 + bj * HALF + n * 16); }
            float ssq = 0.f;
#pragma unroll
            for (int bj = 0; bj < 2; ++bj)
#pragma unroll
                for (int n = 0; n < 2; ++n) { const f32x4 v = xc[bj][n] + gv[bj][n] * acc[ai][bj][m][n]; acc[ai][bj][m][n] = v;
                    ssq += (v[0] * v[0] + v[1] * v[1]) + (v[2] * v[2] + v[3] * v[3]); }
            { const int lane = fq * 16 + fr; ssq += shx_(ssq, 16, lane); ssq += shx_(ssq, 32, lane);
              if (fq == 0) __hip_atomic_store(SS + (size_t)(rowb + ai * HALF + m * 16) * 16 + u.pn * 4 + wc, ssq, __ATOMIC_RELAXED, __HIP_MEMORY_SCOPE_AGENT); }
#pragma unroll
            for (int bj = 0; bj < 2; ++bj)
#pragma unroll
                for (int n = 0; n < 2; ++n) xc[bj][n] = xn[bj][n];
        }
        asm volatile("s_waitcnt vmcnt(0)" ::: "memory"); __builtin_amdgcn_s_barrier(); asm volatile("" ::: "memory");
        if (wr == 0 && wc == 0 && fr == 0 && fq == 0) {
            __builtin_amdgcn_fence(__ATOMIC_RELEASE, "agent"); asm volatile("s_waitcnt vmcnt(0)" ::: "memory");
            __hip_atomic_fetch_add(cnt + u.pm, 1u, __ATOMIC_RELAXED, __HIP_MEMORY_SCOPE_AGENT);
            unsigned sp = 0;
            while (__hip_atomic_load(cnt + u.pm, __ATOMIC_RELAXED, __HIP_MEMORY_SCOPE_AGENT) < 4u) { __builtin_amdgcn_s_sleep(1); if (++sp > (1u << 22)) break; }
            __builtin_amdgcn_fence(__ATOMIC_ACQUIRE, "agent"); asm volatile("s_waitcnt vmcnt(0)" ::: "memory");
        }
        __builtin_amdgcn_s_barrier(); asm volatile("" ::: "memory");
        float rsv[8];
        { f32x4 t[8];
#pragma unroll
          for (int q = 0; q < 8; ++q) { const float* sp = SS + (size_t)(rowb + (q >> 2) * HALF + (q & 3) * 16) * 16 + 4 * fq;
              t[q] = (f32x4){__hip_atomic_load(sp, __ATOMIC_RELAXED, __HIP_MEMORY_SCOPE_AGENT), __hip_atomic_load(sp + 1, __ATOMIC_RELAXED, __HIP_MEMORY_SCOPE_AGENT),
                             __hip_atomic_load(sp + 2, __ATOMIC_RELAXED, __HIP_MEMORY_SCOPE_AGENT), __hip_atomic_load(sp + 3, __ATOMIC_RELAXED, __HIP_MEMORY_SCOPE_AGENT)}; }
          const int lane = fq * 16 + fr;
#pragma unroll
          for (int q = 0; q < 8; ++q) { float v = (t[q][0] + t[q][1]) + (t[q][2] + t[q][3]); v += shx_(v, 16, lane); v += shx_(v, 32, lane); rsv[q] = __builtin_amdgcn_rsqf(v * (1.f / 1024.f) + 1e-6f); } }
        f32x4 wv[2][2];
#pragma unroll
        for (int bj = 0; bj < 2; ++bj)
#pragma unroll
            for (int n = 0; n < 2; ++n) wv[bj][n] = *(const f32x4*)(fw + col0 + bj * HALF + n * 16);
        float* op = out + (size_t)rowb * 1024 + col0;
#pragma unroll
        for (int it = 0; it < 8; ++it) { const int ai = it >> 2, m = it & 3; const size_t ro = (size_t)(ai * HALF + m * 16) * 1024;
#pragma unroll
            for (int bj = 0; bj < 2; ++bj)
#pragma unroll
                for (int n = 0; n < 2; ++n) __builtin_nontemporal_store(acc[ai][bj][m][n] * rsv[it] * wv[bj][n], (f32x4*)(op + ro + bj * HALF + n * 16)); }
    }
};

__device__ __forceinline__ float dpp_ror1(float v) { return __builtin_bit_cast(float, __builtin_amdgcn_mov_dpp(__builtin_bit_cast(int, v), 0x121, 0xf, 0xf, false)); }
__device__ __forceinline__ float dpp_ror15(float v) { return __builtin_bit_cast(float, __builtin_amdgcn_mov_dpp(__builtin_bit_cast(int, v), 0x12f, 0xf, 0xf, false)); }
struct EpiUpGate {
    static constexpr bool PERM = true, AFTER_DRAIN = false;
    bf16_t* ACT; const float* SS; const float* bias; int ldb; const float* cw; float* HALO; PG8_LAS unsigned char* xb;
    __device__ __forceinline__ void operator()(f32x4 (&acc)[2][2][4][2], const Unit& u, int wr, int wc, int fr, int fq) const {
        asm volatile("" : "+v"(fr), "+v"(fq));
        const int cnd = u.pm < 32 ? 0 : 1 + ((u.pm - 32) >> 3);
        const bool samp = u.pm >= 32;
        const int j0 = u.pn * HALF + wc * 32 + 8 * fq;
        const int row0 = u.pm * BM + wr * 64 + fr;
        { const float* bp = bias + (size_t)cnd * ldb + j0;
          f32x4 bv[2][2];
#pragma unroll
          for (int bj = 0; bj < 2; ++bj)
#pragma unroll
              for (int n = 0; n < 2; ++n) bv[bj][n] = *(const f32x4*)(bp + bj * 2816 + 4 * n);
          float rsv[8]; row_scales(SS, row0, fr, fq, rsv);
#pragma unroll
          for (int ai = 0; ai < 2; ++ai)
#pragma unroll
              for (int m = 0; m < 4; ++m) { const float rs = rsv[ai * 4 + m];
#pragma unroll
                  for (int bj = 0; bj < 2; ++bj)
#pragma unroll
                      for (int n = 0; n < 2; ++n) acc[ai][bj][m][n] = acc[ai][bj][m][n] * rs + bv[bj][n]; } }
        PG8_LAS f32x4* WL = (PG8_LAS f32x4*)(xb + 8192);
        if (fr == 0) {
            f32x4 wt[2][2][3];
#pragma unroll
            for (int n = 0; n < 2; ++n)
#pragma unroll
                for (int bj = 0; bj < 2; ++bj)
#pragma unroll
                    for (int k = 0; k < 3; ++k) wt[n][bj][k] = *(const f32x4*)(cw + k * 5632 + bj * 2816 + j0 + 4 * n);
#pragma unroll
            for (int n = 0; n < 2; ++n)
#pragma unroll
                for (int bj = 0; bj < 2; ++bj)
#pragma unroll
                    for (int k = 0; k < 3; ++k) WL[((((wr * 4 + wc) * 4 + fq) * 2 + n) * 2 + bj) * 3 + k] = wt[n][bj][k];
        }
        PG8_LAS f32x4* XB = (PG8_LAS f32x4*)xb;
        const int wv = wr * 4 + wc, pw = (wr ^ 1) * 4 + wc;
        if (fr == 0) {
#pragma unroll
            for (int ai = 0; ai < 2; ++ai)
#pragma unroll
                for (int bj = 0; bj < 2; ++bj)
#pragma unroll
                    for (int n = 0; n < 2; ++n) XB[((wv * 4 + ai * 2) * 2 + bj) * 8 + 2 * fq + n] = acc[ai][bj][0][n]; }
        if (fr == 15) {
#pragma unroll
            for (int ai = 0; ai < 2; ++ai)
#pragma unroll
                for (int bj = 0; bj < 2; ++bj)
#pragma unroll
                    for (int n = 0; n < 2; ++n) XB[((wv * 4 + ai * 2 + 1) * 2 + bj) * 8 + 2 * fq + n] = acc[ai][bj][3][n]; }
        asm volatile("s_waitcnt lgkmcnt(0)" ::: "memory"); __builtin_amdgcn_s_barrier(); asm volatile("" ::: "memory");
        float* hb = HALO + (size_t)(samp ? u.pm - 32 : 0) * 4 * 5632;
#pragma unroll
        for (int ai = 0; ai < 2; ++ai) {
            const bool has_ab = !(wr == 0 && ai == 0), has_bl = !(wr == 1 && ai == 1);
            const int wab = (wr == 0) ? 1 : (ai == 0 ? 1 : 3), wbl = (wr == 0) ? (ai == 0 ? 0 : 2) : 2;
            unsigned pk[4][4];
#pragma unroll
            for (int n = 0; n < 2; ++n) {
                f32x4 ca[4];
#pragma unroll
                for (int bj = 0; bj < 2; ++bj) {
                    const PG8_LAS f32x4* wlp = WL + ((((wr * 4 + wc) * 4 + fq) * 2 + n) * 2 + bj) * 3;
                    const f32x4 w0 = wlp[0], w1 = wlp[1], w2 = wlp[2];
                    f32x4 ab = (f32x4){0.f, 0.f, 0.f, 0.f}, bl = ab;
                    if (has_ab) ab = XB[((pw * 4 + wab) * 2 + bj) * 8 + 2 * fq + n];
                    if (has_bl) bl = XB[((pw * 4 + wbl) * 2 + bj) * 8 + 2 * fq + n];
#pragma unroll
                    for (int m = 0; m < 4; ++m) {
                        f32x4 cvm;
#pragma unroll
                        for (int i = 0; i < 4; ++i) {
                            const float cur = acc[ai][bj][m][n][i];
                            const float pv = m == 0 ? ab[i] : acc[ai][bj][m == 0 ? 0 : m - 1][n][i];
                            const float nx = m == 3 ? bl[i] : acc[ai][bj][m == 3 ? 3 : m + 1][n][i];
                            const float up = dpp_ror1(fr == 15 ? pv : cur), dn = dpp_ror15(fr == 0 ? nx : cur);
                            cvm[i] = w0[i] * up + w1[i] * cur + w2[i] * dn;
                        }
                        if (samp) {
                            if (m == 0 && wr == 0 && ai == 0 && fr == 0) { *(f32x4*)(hb + 0 * 5632 + bj * 2816 + j0 + 4 * n) = acc[ai][bj][0][n]; *(f32x4*)(hb + 1 * 5632 + bj * 2816 + j0 + 4 * n) = cvm; }
                            if (m == 3 && wr == 1 && ai == 1 && fr == 15) { *(f32x4*)(hb + 2 * 5632 + bj * 2816 + j0 + 4 * n) = acc[ai][bj][3][n]; *(f32x4*)(hb + 3 * 5632 + bj * 2816 + j0 + 4 * n) = cvm; }
                        }
                        if (bj == 0) ca[m] = cvm;
                        else { float r[4];
#pragma unroll
                            for (int i = 0; i < 4; ++i) { const float xa = ca[m][i]; r[i] = xa * __builtin_amdgcn_rcpf(1.f + __builtin_amdgcn_exp2f(-xa * 1.4426950408889634f)) * cvm[i]; }
                            pk[m][2 * n] = cvt_pk_bf16(r[0], r[1]); pk[m][2 * n + 1] = cvt_pk_bf16(r[2], r[3]); }
                    }
                }
                __builtin_amdgcn_sched_barrier(0);
            }
#pragma unroll
            for (int m = 0; m < 4; ++m) *(u32x4*)(ACT + (size_t)(row0 + ai * HALF + m * 16) * 2816 + j0) = (u32x4){pk[m][0], pk[m][1], pk[m][2], pk[m][3]};
        }
    }
};

template <class Epi, class Sched, bool ALIGN_EPI = false, bool SP2 = false>
__device__ __forceinline__ void gemm_phase(PG8_LAS unsigned char* lds, const Gemm g, const Sched& S, const Epi& E, const int tid) {
    const int wid = __builtin_amdgcn_readfirstlane(tid >> 6), lane = tid & 63, wr = wid >> 2, wc = wid & 3, fr = lane & 15, fq = lane >> 4;
    const int K = g.K, nt = K / BK;
    unsigned voffA[2], voffB[2];
#pragma unroll
    for (int i = 0; i < 2; ++i) { int R, C; stage_rc(tid * 16 + i * 8192, R, C); const int Rb = Epi::PERM ? ((R & ~31) + perm32(R & 31)) : R;
        voffA[i] = (unsigned)(R * K + C) * 2u; voffB[i] = (unsigned)(Rb * K + C) * 2u; }
    const size_t kstep = (size_t)(BK * 2);
    const size_t hstep = (size_t)HALF * K * 2;
    const size_t tstep = 2 * hstep;
    const size_t bstep = g.bstep ? g.bstep : tstep, bh = g.bhalf ? g.bhalf : hstep;
    const unsigned ldsw = (unsigned)wid * 1024u;
    const int aoff = lds_byte(wr * 64 + fr, fq * 8), boff = lds_byte(wc * 32 + fr, fq * 8);
#define PG8_SA(b, h) (((b) * 2 + (h)) * HTB)
#define PG8_SB(b, h) ((4 + (b) * 2 + (h)) * HTB)
#define PG8_STAGE(bufoff, gbase, voff) do { _Pragma("unroll") for (int _i = 0; _i < 2; ++_i) \
        __builtin_amdgcn_global_load_lds((const unsigned*)((const char*)(gbase) + (voff)[_i]), (PG8_LAS unsigned*)(lds + (bufoff) + ldsw + _i * 8192), 16, 0, 0); } while (0)
#define PG8_LDA(dst, b, h) do { _Pragma("unroll") for (int m = 0; m < 4; ++m) _Pragma("unroll") for (int k = 0; k < 2; ++k) dst[m][k] = *(const PG8_LAS bf16x8*)(lds + PG8_SA(b, h) + aoff + m * 2048 + k * 1024); } while (0)
#define PG8_LDB(dst, b, h) do { _Pragma("unroll") for (int n = 0; n < 2; ++n) _Pragma("unroll") for (int k = 0; k < 2; ++k) dst[n][k] = *(const PG8_LAS bf16x8*)(lds + PG8_SB(b, h) + boff + n * 2048 + k * 1024); } while (0)
#define PG8_MMA(ai, bj, At, Bt) do { __builtin_amdgcn_s_setprio(1); _Pragma("unroll") for (int m = 0; m < 4; ++m) _Pragma("unroll") for (int n = 0; n < 2; ++n) _Pragma("unroll") for (int k = 0; k < 2; ++k) \
        acc[ai][bj][m][n] = __builtin_amdgcn_mfma_f32_16x16x32_bf16(Bt[n][k], At[m][k], acc[ai][bj][m][n], 0, 0, 0); __builtin_amdgcn_s_setprio(0); } while (0)
#define PG8_WAIT_V(n) asm volatile("s_waitcnt vmcnt(" #n ")" ::: "memory")
#define PG8_WAIT_L(n) asm volatile("s_waitcnt lgkmcnt(" #n ")" ::: "memory")
#define PG8_BAR __builtin_amdgcn_s_barrier()
#define PG8_SCHED __builtin_amdgcn_sched_barrier(0)
    Unit cur, nxt; int ui = 0;
    if (!S.next(0, cur)) return;
    f32x4 acc[2][2][4][2];
#pragma unroll
    for (int a = 0; a < 2; ++a)
#pragma unroll
        for (int b = 0; b < 2; ++b)
#pragma unroll
            for (int m = 0; m < 4; ++m)
#pragma unroll
                for (int n = 0; n < 2; ++n) acc[a][b][m][n] = (f32x4){0.f, 0.f, 0.f, 0.f};
    bf16x8 At[4][2], B0[2][2], B1[2][2];
    const char* cA = (const char*)g.A + (size_t)cur.pm * tstep; const char* cB = (const char*)g.Bt + (size_t)cur.pn * bstep;
    S.a_ready(cur);
    if constexpr (SP2) {
        PG8_STAGE(PG8_SB(0, 0), cB, voffB); PG8_STAGE(PG8_SB(0, 1), cB + bh, voffB); PG8_STAGE(PG8_SA(0, 0), cA, voffA); PG8_STAGE(PG8_SA(0, 1), cA + hstep, voffA);
        if (wr == 1) PG8_BAR;
        PG8_WAIT_V(2); PG8_BAR;
        PG8_STAGE(PG8_SB(1, 0), cB + kstep, voffB); PG8_STAGE(PG8_SA(1, 0), cA + kstep, voffA); PG8_STAGE(PG8_SB(1, 1), cB + bh + kstep, voffB);
        PG8_WAIT_V(6); PG8_BAR;
    } else {
        PG8_STAGE(PG8_SB(0, 0), cB, voffB); PG8_STAGE(PG8_SA(0, 0), cA, voffA); PG8_STAGE(PG8_SB(0, 1), cB + bh, voffB); PG8_STAGE(PG8_SA(0, 1), cA + hstep, voffA);
        if (wr == 1) PG8_BAR;
        PG8_WAIT_V(4); PG8_BAR;
        PG8_STAGE(PG8_SB(1, 0), cB + kstep, voffB); PG8_STAGE(PG8_SA(1, 0), cA + kstep, voffA); PG8_STAGE(PG8_SB(1, 1), cB + bh + kstep, voffB);
        PG8_WAIT_V(6); PG8_BAR;
    }
    for (;;) {
        const bool has_next = S.next(ui + 1, nxt);
        const char* nA = has_next ? (const char*)g.A + (size_t)nxt.pm * tstep : cA; const char* nB = has_next ? (const char*)g.Bt + (size_t)nxt.pn * bstep : cB;
        for (int t = 0; t < nt; t += 2) {
            const bool last = (t == nt - 2);
            const char* a1 = cA + (size_t)(t + 1) * kstep;
            const char* a2 = last ? nA : cA + (size_t)(t + 2) * kstep; const char* b2 = last ? nB : cB + (size_t)(t + 2) * kstep;
            const char* a3 = a2 + kstep; const char* b3 = b2 + kstep;
            if (last && has_next) S.a_ready(nxt);
            if constexpr (SP2) {
            PG8_LDB(B0, 0, 0); PG8_LDB(B1, 0, 1); PG8_SCHED; PG8_LDA(At, 0, 0); PG8_STAGE(PG8_SA(1, 1), a1 + hstep, voffA);
            PG8_WAIT_V(8); PG8_WAIT_L(0); PG8_BAR; PG8_MMA(0, 0, At, B0); PG8_MMA(0, 1, At, B1); PG8_BAR; PG8_SCHED;
            PG8_LDA(At, 0, 1); PG8_STAGE(PG8_SB(0, 0), b2, voffB); PG8_STAGE(PG8_SB(0, 1), b2 + bh, voffB); PG8_STAGE(PG8_SA(0, 0), a2, voffA);
            PG8_WAIT_V(8); PG8_WAIT_L(0); PG8_BAR; PG8_MMA(1, 0, At, B0); PG8_MMA(1, 1, At, B1); PG8_BAR; PG8_SCHED;
            PG8_LDB(B0, 1, 0); PG8_LDB(B1, 1, 1); PG8_SCHED; PG8_LDA(At, 1, 0); PG8_STAGE(PG8_SA(0, 1), a2 + hstep, voffA);
            PG8_WAIT_V(8); PG8_WAIT_L(0); PG8_BAR; PG8_MMA(0, 0, At, B0); PG8_MMA(0, 1, At, B1); PG8_BAR; PG8_SCHED;
            PG8_LDA(At, 1, 1); PG8_STAGE(PG8_SB(1, 0), b3, voffB); PG8_STAGE(PG8_SB(1, 1), b3 + bh, voffB); PG8_STAGE(PG8_SA(1, 0), a3, voffA);
            PG8_WAIT_V(8); PG8_WAIT_L(0); PG8_BAR; PG8_MMA(1, 0, At, B0); PG8_MMA(1, 1, At, B1); PG8_BAR; PG8_SCHED;
            } else {
            PG8_LDB(B0, 0, 0); PG8_SCHED; PG8_LDA(At, 0, 0); PG8_STAGE(PG8_SA(1, 1), a1 + hstep, voffA);
            PG8_WAIT_L(8); PG8_BAR; PG8_WAIT_L(0); PG8_MMA(0, 0, At, B0); PG8_BAR; PG8_SCHED;
            PG8_LDB(B1, 0, 1); PG8_STAGE(PG8_SB(0, 0), b2, voffB);
            PG8_BAR; PG8_WAIT_L(0); PG8_MMA(0, 1, At, B1); PG8_BAR;
            PG8_LDA(At, 0, 1); PG8_STAGE(PG8_SA(0, 0), a2, voffA);
            PG8_BAR; PG8_WAIT_L(0); PG8_MMA(1, 0, At, B0); PG8_BAR; PG8_SCHED;
            PG8_STAGE(PG8_SB(0, 1), b2 + bh, voffB);
            PG8_WAIT_V(6); PG8_BAR; PG8_MMA(1, 1, At, B1); PG8_BAR;
            PG8_LDB(B0, 1, 0); PG8_SCHED; PG8_LDA(At, 1, 0); PG8_STAGE(PG8_SA(0, 1), a2 + hstep, voffA);
            PG8_WAIT_L(8); PG8_BAR; PG8_WAIT_L(0); PG8_MMA(0, 0, At, B0); PG8_BAR; PG8_SCHED;
            PG8_LDB(B1, 1, 1); PG8_STAGE(PG8_SB(1, 0), b3, voffB);
            PG8_BAR; PG8_WAIT_L(0); PG8_MMA(0, 1, At, B1); PG8_BAR;
            PG8_LDA(At, 1, 1); PG8_STAGE(PG8_SA(1, 0), a3, voffA);
            PG8_BAR; PG8_WAIT_L(0); PG8_MMA(1, 0, At, B0); PG8_BAR; PG8_SCHED;
            PG8_STAGE(PG8_SB(1, 1), b3 + bh, voffB);
            PG8_WAIT_V(6); PG8_BAR; PG8_MMA(1, 1, At, B1); PG8_BAR;
            }
        }
        if constexpr (ALIGN_EPI) { if (wr == 0) PG8_BAR; }
        if constexpr (!Epi::AFTER_DRAIN) { E(acc, cur, wr, wc, fr, fq); S.done(cur); }
        if (!has_next) break;
#pragma unroll
        for (int a = 0; a < 2; ++a)
#pragma unroll
            for (int b = 0; b < 2; ++b)
#pragma unroll
                for (int m = 0; m < 4; ++m)
#pragma unroll
                    for (int n = 0; n < 2; ++n) acc[a][b][m][n] = (f32x4){0.f, 0.f, 0.f, 0.f};
        cur = nxt; cA = nA; cB = nB; ++ui;
        if constexpr (ALIGN_EPI) { if (wr == 1) PG8_BAR; }
    }
    PG8_WAIT_V(0);
    if constexpr (!ALIGN_EPI) { if (wr == 0) PG8_BAR; }
    PG8_BAR;
#undef PG8_SA
#undef PG8_SB
#undef PG8_STAGE
#undef PG8_LDA
#undef PG8_LDB
#undef PG8_MMA
#undef PG8_WAIT_V
#undef PG8_WAIT_L
#undef PG8_BAR
#undef PG8_SCHED
}
}

#define LAS __attribute__((address_space(3)))
#define CAS __attribute__((address_space(4)))
typedef unsigned short bf16;
typedef float f32x4 __attribute__((ext_vector_type(4)));
typedef short bf16x8 __attribute__((ext_vector_type(8)));
typedef unsigned u32x4 __attribute__((ext_vector_type(4)));
typedef unsigned u32x2 __attribute__((ext_vector_type(2)));

constexpr int NW = 8, NT = 512;
constexpr int DM = 1024, NTOK = 12288, NPR = 8192, NKR = 13312, INC = 2144, INP = 2304, DFF = 2816, DUP = 5632;
constexpr float EPS = 1e-6f, LOG2E = 1.4426950408889634f;
constexpr float QS = 0.125f * LOG2E;
constexpr float MLAQS = 0.10206207261596575f * LOG2E;

constexpr size_t MiB = 1u << 20;
constexpr size_t WS_CTL = 0, WS_MOD = 1 * MiB, WS_ROPE = 1 * MiB + 256 * 1024, WS_W = 2 * MiB, W_LSTRIDE = 24 * MiB;
constexpr size_t W_IN = 0, W_OUT = 4718592, W_UP = W_OUT + 2097152, W_DOWN = W_UP + 11534336, W_B2 = W_DOWN + 5767168;
static_assert(W_B2 + 786432 <= W_LSTRIDE, "weights");
constexpr size_t WS_XN = 50 * MiB, WS_PROJ = 74 * MiB, WS_A2 = 128 * MiB, WS_MQKV = 138 * MiB, WS_QC = 164 * MiB, WS_KPE = 203 * MiB, WS_YCAT = 204 * MiB;
constexpr size_t WS_ACT = 116 * MiB, WS_U = 116 * MiB, WS_SS1 = 228 * MiB, WS_SS2 = 229 * MiB, WS_HALO = 230 * MiB, WS_XRES = 232 * MiB, WS_END = 256 * MiB;
constexpr size_t WS_BIAS = 65536;
constexpr int NBIAS = 2304 + 5632;
constexpr size_t QSZ = (size_t)NKR * 256 * 2, KSZ = (size_t)NKR * 128 * 2;
constexpr int LDS_BYTES = 163840, LDS_CTL = 163840 - 256;
constexpr size_t WS_BAR = 16384;

struct Args { const float* in[28]; float* out; unsigned char* ws; };

__device__ __forceinline__ unsigned f2bf(float f) { unsigned u = __builtin_bit_cast(unsigned, f); return (u + 0x7fffu + ((u >> 16) & 1u)) >> 16; }
__device__ __forceinline__ unsigned pk2(float lo, float hi) { unsigned r; asm("v_cvt_pk_bf16_f32 %0, %1, %2" : "=v"(r) : "v"(lo), "v"(hi)); return r; }
__device__ __forceinline__ float bflo(unsigned u) { return __builtin_bit_cast(float, u << 16); }
__device__ __forceinline__ float bfhi(unsigned u) { return __builtin_bit_cast(float, u & 0xffff0000u); }
__device__ __forceinline__ f32x4 ld4bf(const bf16* p) { const u32x2 u = *(const u32x2*)p; return (f32x4){bflo(u.x), bfhi(u.x), bflo(u.y), bfhi(u.y)}; }
__device__ __forceinline__ void st4bf(bf16* p, f32x4 v) { u32x2 u; u.x = pk2(v[0], v[1]); u.y = pk2(v[2], v[3]); *(u32x2*)p = u; }
__device__ __forceinline__ float shx(float v, int m, int lane) { return __builtin_bit_cast(float, __builtin_amdgcn_ds_bpermute((lane ^ m) << 2, __builtin_bit_cast(int, v))); }
#define DPPF(v, ctrl) __builtin_bit_cast(float, __builtin_amdgcn_mov_dpp(__builtin_bit_cast(int, (v)), (ctrl), 0xf, 0xf, false))
__device__ __forceinline__ float sum16(float v, int) { v += DPPF(v, 0x121); v += DPPF(v, 0x122); v += DPPF(v, 0x124); v += DPPF(v, 0x128); return v; }
__device__ __forceinline__ float wave_sum(float v, int lane) {
    v = sum16(v, lane);
    const int iv = __builtin_bit_cast(int, v);
    const float a = __builtin_bit_cast(float, __builtin_amdgcn_readlane(iv, 0)), b = __builtin_bit_cast(float, __builtin_amdgcn_readlane(iv, 16)),
                c = __builtin_bit_cast(float, __builtin_amdgcn_readlane(iv, 32)), d = __builtin_bit_cast(float, __builtin_amdgcn_readlane(iv, 48));
    return (a + b) + (c + d);
}
__device__ __forceinline__ float dot4(f32x4 a) { return (a[0] * a[0] + a[1] * a[1]) + (a[2] * a[2] + a[3] * a[3]); }
__device__ __forceinline__ f32x4 shfl4(f32x4 v, int m, int lane) { return (f32x4){shx(v[0], m, lane), shx(v[1], m, lane), shx(v[2], m, lane), shx(v[3], m, lane)}; }

__device__ __forceinline__ void transpose_item(const float* W, int N, bf16* WT, int ldk, int row_off, int k_off, float scale, LAS float* scr, int item, int lane) {
    const int nblk = (N + 63) / 64, kb = item / nblk, nb = item % nblk, k0 = 64 * kb, n0 = 64 * nb;
    const bool act = n0 + lane < N;
    const float* wp = W + (size_t)k0 * N + n0 + lane;
    float v[64];
#pragma unroll
    for (int i = 0; i < 64; ++i) v[i] = act ? __builtin_nontemporal_load(wp + (size_t)i * N) : 0.f;
#pragma unroll
    for (int i = 0; i < 64; ++i) scr[i * 65 + lane] = v[i] * scale;
    asm volatile("s_waitcnt lgkmcnt(0)" ::: "memory");
    const int c = lane & 7;
#pragma unroll
    for (int j = 0; j < 8; ++j) { const int n = (lane >> 3) + 8 * j; const LAS float* s = scr + (8 * c) * 65 + n;
        u32x4 o; o.x = pk2(s[0 * 65], s[1 * 65]); o.y = pk2(s[2 * 65], s[3 * 65]); o.z = pk2(s[4 * 65], s[5 * 65]); o.w = pk2(s[6 * 65], s[7 * 65]);
        if (n0 + n < N) *(u32x4*)(WT + (size_t)(row_off + n0 + n) * ldk + k_off + k0 + 8 * c) = o; }
    asm volatile("s_waitcnt lgkmcnt(0)" ::: "memory");
}

template <class ArgsRef>
__device__ __forceinline__ void wconv(const ArgsRef& a, unsigned char* ws, int l, int sel, int w, int nwk, LAS float* scr, int lane) {
    constexpr int I_IN = 16 * 34, I_OUT = 16 * 16, I_UP = 16 * 88, I_DN = 44 * 16, I_Q = 3 * 6, I_KV = 2 * 8;
    const int n_in = (sel & 1) ? I_IN : 0, n_out = (sel & 2) ? I_OUT : 0, n_up = (sel & 4) ? I_UP : 0, n_dn = (sel & 8) ? I_DN : 0, n_q = (sel & 16) ? I_Q : 0, n_kv = (sel & 32) ? I_KV : 0;
    const int total = n_in + n_out + n_up + n_dn + n_q + n_kv;
    unsigned char* wl = ws + WS_W + l * W_LSTRIDE;
    for (int it = w; it < total; it += nwk) {
        int r = it;
        if (r < n_in) { transpose_item(a.in[13] + (size_t)l * 1024 * INC, INC, (bf16*)(wl + W_IN), 1024, 0, 0, 1.f, scr, r, lane); continue; } r -= n_in;
        if (r < n_out) { transpose_item(a.in[22] + (size_t)l * 1024 * 1024, 1024, (bf16*)(wl + W_OUT), 1024, 0, 0, 1.f, scr, r, lane); continue; } r -= n_out;
        if (r < n_up) { transpose_item(a.in[24] + (size_t)l * 1024 * DUP, DUP, (bf16*)(wl + W_UP), 1024, 0, 0, 1.f, scr, r, lane); continue; } r -= n_up;
        if (r < n_dn) { transpose_item(a.in[26] + (size_t)l * DFF * 1024, 1024, (bf16*)(wl + W_DOWN), DFF, 0, 0, 1.f, scr, r, lane); continue; } r -= n_dn;
        if (r < n_q) { transpose_item(a.in[16] + (size_t)l * 192 * 384, 384, (bf16*)(wl + W_B2), 384, 0, 0, MLAQS, scr, r, lane); continue; } r -= n_q;
        transpose_item(a.in[18] + (size_t)l * 128 * 512, 512, (bf16*)(wl + W_B2), 384, 384, 192, 1.f, scr, r, lane);
    }
}
template <class ArgsRef>
__device__ __forceinline__ void phase0(const ArgsRef& a, LAS unsigned char* lds, int tid, int lane, int wave) {
    unsigned char* ws = a.ws;
    const int G = gridDim.x, bid = blockIdx.x;
    if (bid < 96) {
        LAS float* sl = (LAS float*)(lds + 16384);
        for (int e = tid; e < 3072; e += NT) { const int c = e >> 10, k = e & 1023; const float v = c == 0 ? a.in[9][k] : a.in[8][(c - 1) * 1024 + k]; sl[e] = v / (1.f + __expf(-v)); }
        __syncthreads();
    }
    for (int it = bid; it < 96; it += G) {
        const int l = it / 48, n0 = (it % 48) * 128;
        const float* wa = a.in[10] + (size_t)l * 1024 * 6144;
        const LAS float* sl = (const LAS float*)(lds + 16384);
        float acc[3][2] = {{0.f, 0.f}, {0.f, 0.f}, {0.f, 0.f}};
        const int kb = wave * 128;
#pragma unroll 16
        for (int k = 0; k < 128; ++k) {
            const int kk = kb + k;
            typedef float f32x2_ __attribute__((ext_vector_type(2)));
            const f32x2_ w = __builtin_nontemporal_load((const f32x2_*)(wa + (size_t)kk * 6144 + n0 + 2 * lane));
            const float s0 = sl[kk], s1 = sl[1024 + kk], s2 = sl[2048 + kk];
            acc[0][0] += s0 * w.x; acc[0][1] += s0 * w.y; acc[1][0] += s1 * w.x; acc[1][1] += s1 * w.y; acc[2][0] += s2 * w.x; acc[2][1] += s2 * w.y;
        }
        LAS float* red = (LAS float*)lds;
#pragma unroll
        for (int c = 0; c < 3; ++c) { red[(wave * 3 + c) * 128 + 2 * lane] = acc[c][0]; red[(wave * 3 + c) * 128 + 2 * lane + 1] = acc[c][1]; }
        __syncthreads();
        if (tid < 384) { const int c = tid / 128, n = tid % 128; float s = 0.f;
#pragma unroll
            for (int w = 0; w < 8; ++w) s += red[(w * 3 + c) * 128 + n];
            ((float*)(ws + WS_MOD))[(size_t)(l * 3 + c) * 6144 + n0 + n] = s + a.in[11][(size_t)l * 6144 + n0 + n]; }
        __syncthreads();
    }
    if (bid == G - 1) {
        float* rt = (float*)(ws + WS_ROPE);
        for (int e = tid; e < 1024; e += NT) { const int pos = e >> 4, i = e & 15; const float inv = exp2f(-(float)(2 * i) / 32.f * 13.287712379549449f); const float ang = (float)pos * inv;
            rt[e] = __cosf(ang); rt[1024 + e] = __sinf(ang); }
        for (int e = tid; e < 512; e += NT) { const int pos = e >> 3, i = e & 7; const float inv = exp2f(-(float)(2 * i) / 16.f * 13.287712379549449f); const float ang = (float)pos * inv;
            rt[2048 + e] = __cosf(ang); rt[2560 + e] = __sinf(ang); }
    }
    const int gt = bid * NT + tid, NGT = G * NT;
    if (gt < 256) ((unsigned*)(ws + WS_CTL))[gt] = 0u;
    if (gt < 64) ((unsigned*)(ws + WS_CTL))[2048 + gt] = 0u;
    for (int l = 0; l < 2; ++l) {
        bf16* b2 = (bf16*)(ws + WS_W + l * W_LSTRIDE + W_B2);
        for (int ch = gt; ch < 1024 * 48; ch += NGT) { const int n = ch / 48, k = (ch % 48) * 8;
            const bool data = (n < 384 && k < 192) || (n >= 384 && n < 896 && k >= 192 && k < 320);
            if (!data) *(u32x4*)(b2 + (size_t)n * 384 + k) = (u32x4){0u, 0u, 0u, 0u}; }
        bf16* wi = (bf16*)(ws + WS_W + l * W_LSTRIDE + W_IN) + (size_t)INC * 1024;
        for (int ch = gt; ch < 160 * 128; ch += NGT) *(u32x4*)(wi + (size_t)ch * 8) = (u32x4){0u, 0u, 0u, 0u};
    }
    LAS float* scr = (LAS float*)(lds + 28672 + wave * 16640);
    wconv(a, ws, 0, 1 | 2 | 16 | 32, bid * NW + wave, G * NW, scr, lane);
}

__device__ __forceinline__ void prep_phase(const float* x0, const float* x1, const float* nw, const float* mod, int sc_off, bf16* XN, float* SS, int lane, int gw, int NGW) {
    for (int row = gw; row < NTOK; row += NGW) {
        const float* xr = row < NPR ? x0 + (size_t)row * DM : x1 + (size_t)(row - NPR) * DM;
        const int c = row < NPR ? 0 : 1 + ((row - NPR) >> 11);
        const float* mp = mod + c * 6144;
        f32x4 v[4]; float ss = 0.f;
#pragma unroll
        for (int j = 0; j < 4; ++j) { v[j] = __builtin_nontemporal_load((const f32x4*)(xr + 4 * (lane + 64 * j))); ss += dot4(v[j]); }
        ss = wave_sum(ss, lane);
#pragma unroll
        for (int j = 0; j < 4; ++j) { const int col = 4 * (lane + 64 * j);
            const f32x4 g = *(const f32x4*)(nw + col), sc = *(const f32x4*)(mp + sc_off + col);
            st4bf(XN + (size_t)row * DM + col, v[j] * g * (1.f + sc)); }
        if (lane < 16) SS[(size_t)row * 16 + lane] = lane == 0 ? ss : 0.f;
    }
}
template <class ArgsRef>
__device__ __forceinline__ void bias_phase(const ArgsRef& a, unsigned char* ws, LAS unsigned char* lds, int tid, int lane, int wave) {
    const float* mod = (const float*)(ws + WS_MOD);
    float* BIAS = (float*)(ws + WS_BIAS);
    for (int it = blockIdx.x; it < 62; it += gridDim.x) {
        const int l = it / 31, r = it % 31; const bool up = r >= 9;
        const int N = up ? DUP : INC, n0 = (up ? r - 9 : r) * 256 + 4 * lane;
        const float* W = up ? a.in[24] + (size_t)l * 1024 * DUP : a.in[13] + (size_t)l * 1024 * INC;
        const float* shp = mod + (size_t)l * 3 * 6144 + (up ? 3072 : 0);
        LAS float* sl = (LAS float*)(lds + 32768);
        for (int e = tid; e < 3072; e += NT) sl[e] = shp[(e >> 10) * 6144 + (e & 1023)];
        __syncthreads();
        const bool act = n0 < N;
        f32x4 acc[3] = {(f32x4){0.f, 0.f, 0.f, 0.f}, (f32x4){0.f, 0.f, 0.f, 0.f}, (f32x4){0.f, 0.f, 0.f, 0.f}};
        const int kb = wave * 128;
#pragma unroll 16
        for (int k = 0; k < 128; ++k) { const int kk = kb + k;
            const f32x4 w = act ? __builtin_nontemporal_load((const f32x4*)(W + (size_t)kk * N + n0)) : (f32x4){0.f, 0.f, 0.f, 0.f};
            acc[0] += w * sl[kk]; acc[1] += w * sl[1024 + kk]; acc[2] += w * sl[2048 + kk]; }
        LAS f32x4* red = (LAS f32x4*)lds;
#pragma unroll
        for (int c = 0; c < 3; ++c) red[(wave * 3 + c) * 64 + lane] = acc[c];
        __syncthreads();
        if (tid < 192) { const int c = tid >> 6, ln = tid & 63; f32x4 t = red[c * 64 + ln];
#pragma unroll
            for (int w = 1; w < 8; ++w) t += red[(w * 3 + c) * 64 + ln];
            const int nn = (up ? r - 9 : r) * 256 + 4 * ln;
            if (nn < N) *(f32x4*)(BIAS + (size_t)(l * 3 + c) * NBIAS + (up ? 2304 : 0) + nn) = t;
            else if (!up && nn < 2304) *(f32x4*)(BIAS + (size_t)(l * 3 + c) * NBIAS + nn) = (f32x4){0.f, 0.f, 0.f, 0.f}; }
        __syncthreads();
    }
}

struct P3Ptrs {
    const bf16* PROJ; bf16 *A2, *KPE, *YCAT, *Qc_rot, *Qc_raw, *Kc, *Vc, *Qd_rot, *Qd_raw, *Kd, *Vd;
    const float *conv_a, *gq_mla, *gkv_mla, *gq, *gk, *rope;
    const float *c_ckv, *c_kpe, *c_gk, *c_gv, *c_sk, *c_sv;
    float *o_ckv, *o_kpe, *o_gk, *o_gv, *o_sk, *o_sv;
    int l;
};
__device__ __forceinline__ f32x4 rope64(f32x4 v, int jl, int prow, int pcol, const float* rt, int lane) {
    const f32x4 pr = shfl4(v, 4, lane);
    const int pos = jl < 8 ? prow : pcol, fi = 4 * (jl & 3);
    const f32x4 c = *(const f32x4*)(rt + pos * 16 + fi), s = *(const f32x4*)(rt + 1024 + pos * 16 + fi);
    const float sg = (jl & 4) ? 1.f : -1.f;
    return v * c + pr * s * sg;
}
__device__ __forceinline__ void p3_phase(const P3Ptrs& P, int lane, int gw, int NGW) {
    const int l = P.l;
    for (int row = gw; row < NKR; row += NGW) {
        if (row < NTOK) {
            const bool samp = row >= NPR;
            int b, t, kr, T;
            if (!samp) { b = row >> 8; t = row & 255; kr = row; T = 256; } else { b = (row - NPR) >> 11; t = (row - NPR) & 2047; kr = NPR + b * 2560 + t; T = 2048; }
            const int prow = t >> 6, pcol = t & 63;
            const bf16* pr = P.PROJ + (size_t)row * INP;
            const size_t ob = (size_t)((b * 2 + l) * 256 + t);
            const int ci = 4 * lane, jl = lane & 15;
            const u32x2 z2 = (u32x2){0u, 0u};
            const bool hp = t > 0, hn = t < T - 1;
            const u32x2 r_xa = *(const u32x2*)(pr + ci), r_gb = *(const u32x2*)(pr + 256 + ci), r_gc = *(const u32x2*)(pr + 512 + ci);
            const u32x2 r_pxa = hp ? *(const u32x2*)(pr - INP + ci) : z2, r_pgc = hp ? *(const u32x2*)(pr - INP + 512 + ci) : z2;
            const u32x2 r_nxa = hn ? *(const u32x2*)(pr + INP + ci) : z2, r_ngc = hn ? *(const u32x2*)(pr + INP + 512 + ci) : z2;
            const u32x2 r_cq = lane < 48 ? *(const u32x2*)(pr + 768 + ci) : z2, r_ckv = lane < 32 ? *(const u32x2*)(pr + 960 + ci) : z2, r_kpe = lane < 8 ? *(const u32x2*)(pr + 1088 + ci) : z2;
            const u32x2 r_qc = *(const u32x2*)(pr + 1120 + ci), r_kvc = *(const u32x2*)(pr + 1376 + ci), r_qd = *(const u32x2*)(pr + 1632 + ci), r_kvd = *(const u32x2*)(pr + 1888 + ci);
            const float* cw = P.conv_a + (size_t)l * 768;
            const f32x4 w0 = *(const f32x4*)(cw + ci), w1 = *(const f32x4*)(cw + 256 + ci), w2 = *(const f32x4*)(cw + 512 + ci);
            const f32x4 g_qm = lane < 48 ? *(const f32x4*)(P.gq_mla + l * 192 + ci) : (f32x4){0.f, 0.f, 0.f, 0.f}, g_kvm = lane < 32 ? *(const f32x4*)(P.gkv_mla + l * 128 + ci) : (f32x4){0.f, 0.f, 0.f, 0.f};
            const f32x4 g_q = *(const f32x4*)(P.gq + l * 64 + 4 * jl), g_k = *(const f32x4*)(P.gk + l * 64 + 4 * jl);
            const int pos64 = jl < 8 ? prow : pcol, fi64 = 4 * (jl & 3);
            const f32x4 c64 = *(const f32x4*)(P.rope + pos64 * 16 + fi64), s64 = *(const f32x4*)(P.rope + 1024 + pos64 * 16 + fi64);
            const int pos32 = (lane & 7) < 4 ? prow : pcol, fi32 = 4 * (lane & 1);
            const f32x4 c32 = *(const f32x4*)(P.rope + 2048 + pos32 * 8 + fi32), s32 = *(const f32x4*)(P.rope + 2560 + pos32 * 8 + fi32);
#define CV4(u) ((f32x4){bflo((u).x), bfhi((u).x), bflo((u).y), bfhi((u).y)})
#define ROPE64(v) ((v) * c64 + shfl4((v), 4, lane) * s64 * ((jl & 4) ? 1.f : -1.f))
            { const f32x4 ya = CV4(r_gb) * (w0 * (CV4(r_pxa) * CV4(r_pgc)) + w1 * (CV4(r_xa) * CV4(r_gc)) + w2 * (CV4(r_nxa) * CV4(r_ngc)));
              st4bf(P.YCAT + (size_t)row * DM + ci, ya); }
            { const f32x4 v = CV4(r_cq);
              const float rs = rsqrtf(wave_sum(dot4(v), lane) * (1.f / 192.f) + EPS);
              if (lane < 48) st4bf(P.A2 + (size_t)kr * 384 + ci, v * rs * g_qm); }
            { const f32x4 v = CV4(r_ckv);
              const float rs = rsqrtf(wave_sum(dot4(v), lane) * (1.f / 128.f) + EPS);
              if (lane < 32) { const f32x4 o = v * rs * g_kvm;
                  st4bf(P.A2 + (size_t)kr * 384 + 192 + ci, o);
                  if (!samp) __builtin_nontemporal_store((f32x4)(o), (f32x4*)(P.o_ckv + ob * 128 + ci)); }
              else if (lane < 48) { unsigned zz = 0u; asm volatile("" : "+v"(zz)); *(u32x2*)(P.A2 + (size_t)kr * 384 + 320 + 4 * (lane - 32)) = (u32x2){zz, zz}; } }
            { const f32x4 v = CV4(r_kpe);
              const f32x4 r = v * c32 + shfl4(v, 2, lane) * s32 * ((lane & 2) ? 1.f : -1.f);
              if (lane < 8) { if (!samp) __builtin_nontemporal_store((f32x4)(v), (f32x4*)(P.o_kpe + ob * 32 + ci)); st4bf(P.KPE + (size_t)kr * 32 + ci, samp ? r : v); } }
            { f32x4 v = CV4(r_qc);
              const float rs = rsqrtf(sum16(dot4(v), lane) * (1.f / 64.f) + EPS);
              v = v * rs * g_q;
              st4bf(P.Qc_raw + (size_t)kr * 256 + ci, v * QS);
              const f32x4 r = ROPE64(v);
              if (samp) st4bf(P.Qc_rot + (size_t)kr * 256 + ci, r * QS); }
            { const f32x4 v = CV4(r_kvc);
              const float rs = rsqrtf(sum16(dot4(v), lane) * (1.f / 64.f) + EPS);
              const f32x4 kn = v * rs * g_k;
              const f32x4 r = ROPE64(kn);
              if (lane < 32) { if (!samp) __builtin_nontemporal_store((f32x4)(kn), (f32x4*)(P.o_gk + ob * 128 + ci)); st4bf(P.Kc + (size_t)kr * 128 + ci, samp ? r : kn); }
              else { if (!samp) __builtin_nontemporal_store((f32x4)(v), (f32x4*)(P.o_gv + ob * 128 + 4 * (lane - 32))); st4bf(P.Vc + (size_t)kr * 128 + 4 * (lane - 32), v); } }
            { const f32x4 v = CV4(r_qd);
              st4bf(P.Qd_raw + (size_t)kr * 256 + ci, v * QS);
              const f32x4 r = ROPE64(v);
              if (samp) st4bf(P.Qd_rot + (size_t)kr * 256 + ci, r * QS); }
            { const f32x4 v = CV4(r_kvd);
              const f32x4 r = ROPE64(v);
              if (lane < 32) { if (!samp) __builtin_nontemporal_store((f32x4)(v), (f32x4*)(P.o_sk + ob * 128 + ci)); st4bf(P.Kd + (size_t)kr * 128 + ci, samp ? r : v); }
              else { if (!samp) __builtin_nontemporal_store((f32x4)(v), (f32x4*)(P.o_sv + ob * 128 + 4 * (lane - 32))); st4bf(P.Vd + (size_t)kr * 128 + 4 * (lane - 32), v); } }
#undef CV4
#undef ROPE64
        } else {
            const int ci = row - NTOK, b = ci >> 9, j = ci & 511, kr = NPR + b * 2560 + 2048 + j;
            const size_t cb = (size_t)((b * 2 + l) * 512 + j);
            f32x4 z = (f32x4){0.f, 0.f, 0.f, 0.f}; asm volatile("" : "+v"(z));
            if (lane < 48) st4bf(P.A2 + (size_t)kr * 384 + 4 * lane, z);
            if (lane < 32) st4bf(P.A2 + (size_t)kr * 384 + 192 + 4 * lane, *(const f32x4*)(P.c_ckv + cb * 128 + 4 * lane));
            else if (lane < 48) st4bf(P.A2 + (size_t)kr * 384 + 320 + 4 * (lane - 32), z);
            if (lane < 8) st4bf(P.KPE + (size_t)kr * 32 + 4 * lane, *(const f32x4*)(P.c_kpe + cb * 32 + 4 * lane));
            if (lane < 32) { st4bf(P.Kc + (size_t)kr * 128 + 4 * lane, *(const f32x4*)(P.c_gk + cb * 128 + 4 * lane));
                             st4bf(P.Kd + (size_t)kr * 128 + 4 * lane, *(const f32x4*)(P.c_sk + cb * 128 + 4 * lane)); }
            else { st4bf(P.Vc + (size_t)kr * 128 + 4 * (lane - 32), *(const f32x4*)(P.c_gv + cb * 128 + 4 * (lane - 32)));
                   st4bf(P.Vd + (size_t)kr * 128 + 4 * (lane - 32), *(const f32x4*)(P.c_sv + cb * 128 + 4 * (lane - 32))); }
        }
    }
}

struct AttnSrc {
    const bf16* Qraw; const bf16* Qrot; int qpitch;
    const bf16* K0; int k0pitch; const bf16* K1;
    const bf16* V; int vpitch;
    bf16* Y; int outcol;
    int krbase, rowbase, q0, lo, hi, nctx;
    bool samp, window; float m0; bool sink;
    const float* rope;
};
template <int DK>
__device__ __forceinline__ void attn_unit(const AttnSrc& S, LAS unsigned char* lds, int tid, int lane, int wave, unsigned* ctr, unsigned& nxt_u) {
    constexpr int TK = 128, NKB = TK / 16, NPP = TK / 32;
    constexpr int KP = DK + 8, VP = TK + 8, KS = DK / 32, CPK = DK / 8;
    constexpr int NKC = TK * CPK / NT, NVC = TK * 8 / NT;
    LAS bf16* Ks = (LAS bf16*)lds;
    LAS bf16* Vt = (LAS bf16*)(lds + 2 * TK * KP * 2);
    const int g = lane >> 4, fr = lane & 15;
    const int qpos = S.q0 + wave * 16 + fr;
    const size_t qkr = (size_t)(S.krbase + qpos);
    bf16x8 qraw[KS], qrot[KS];
#pragma unroll
    for (int ks = 0; ks < KS; ++ks) { qraw[ks] = *(const bf16x8*)(S.Qraw + qkr * S.qpitch + ks * 32 + g * 8); qrot[ks] = qraw[ks]; }
    if (S.samp) {
        if (DK == 96) {
            const bf16x8 own = qraw[KS - 1], par = *(const bf16x8*)(S.Qraw + qkr * S.qpitch + 64 + (g ^ 1) * 8);
            const int pos = g < 2 ? (qpos >> 6) : (qpos & 63);
            const float sg = (g & 1) ? 1.f : -1.f;
            const float* ct = S.rope + 2048 + pos * 8; const float* st = S.rope + 2560 + pos * 8;
            bf16x8 r;
#pragma unroll
            for (int e = 0; e < 8; ++e) { const float o = bflo((unsigned)(unsigned short)own[e]), p = bflo((unsigned)(unsigned short)par[e]);
                r[e] = (short)f2bf(o * ct[e] + p * st[e] * sg); }
            qrot[KS - 1] = r;
        } else {
#pragma unroll
            for (int ks = 0; ks < KS; ++ks) qrot[ks] = *(const bf16x8*)(S.Qrot + qkr * S.qpitch + ks * 32 + g * 8);
        }
    }
    bf16x8 qc[KS];
#pragma unroll
    for (int ks = 0; ks < KS; ++ks) qc[ks] = S.samp ? qrot[ks] : qraw[ks];
    float m = S.m0, l = (S.sink && g == 0) ? 1.f : 0.f;
    f32x4 o[4];
#pragma unroll
    for (int d = 0; d < 4; ++d) o[d] = (f32x4){0.f, 0.f, 0.f, 0.f};
    const int nloc = S.hi - S.lo, ntile = nloc + S.nctx;
    u32x4 kreg[NKC], vreg[NVC];
    auto gload = [&](int j) {
        const int tile = j < nloc ? S.lo + j : (2048 / TK) + (j - nloc);
        const size_t kr = (size_t)(S.krbase + tile * TK);
#pragma unroll
        for (int c = 0; c < NKC; ++c) { const int ch = tid + c * NT, key = ch / CPK, part = ch % CPK;
            if (DK == 64) kreg[c] = *(const u32x4*)(S.K0 + (kr + key) * S.k0pitch + part * 8);
            else kreg[c] = part < 8 ? *(const u32x4*)(S.K0 + (kr + key) * S.k0pitch + part * 8) : *(const u32x4*)(S.K1 + (kr + key) * 32 + (part - 8) * 8); }
#pragma unroll
        for (int c = 0; c < NVC; ++c) { const int ch = tid + c * NT, vkey = ch & (TK - 1), vdc = ch / TK;
            vreg[c] = *(const u32x4*)(S.V + (kr + vkey) * S.vpitch + vdc * 8); }
    };
    auto lstore = [&](int buf) {
        LAS bf16* kb = Ks + buf * TK * KP; LAS bf16* vb = Vt + buf * 64 * VP;
#pragma unroll
        for (int c = 0; c < NKC; ++c) { const int ch = tid + c * NT, key = ch / CPK, part = ch % CPK; *(LAS u32x4*)(kb + key * KP + part * 8) = kreg[c]; }
#pragma unroll
        for (int c = 0; c < NVC; ++c) { const int ch = tid + c * NT, vkey = ch & (TK - 1), vdc = ch / TK;
            LAS bf16* vp = vb + (vdc * 8) * VP + vkey; const u32x4 v = vreg[c];
            vp[0 * VP] = (bf16)(v.x & 0xffffu); vp[1 * VP] = (bf16)(v.x >> 16); vp[2 * VP] = (bf16)(v.y & 0xffffu); vp[3 * VP] = (bf16)(v.y >> 16);
            vp[4 * VP] = (bf16)(v.z & 0xffffu); vp[5 * VP] = (bf16)(v.z >> 16); vp[6 * VP] = (bf16)(v.w & 0xffffu); vp[7 * VP] = (bf16)(v.w >> 16); }
    };
    gload(0); lstore(0);
    __syncthreads();
    for (int j = 0; j < ntile; ++j) {
        const int buf = j & 1;
        if (j + 1 < ntile) gload(j + 1);
        else if (tid == 0) nxt_u = atomicAdd(ctr, 1u);
        const bool loc = j < nloc;
        if (j == nloc) {
#pragma unroll
            for (int ks = 0; ks < KS; ++ks) qc[ks] = qraw[ks]; }
        const LAS bf16* kb = Ks + buf * TK * KP; const LAS bf16* vb = Vt + buf * 64 * VP;
        f32x4 s[NKB];
#pragma unroll
        for (int kk = 0; kk < NKB; ++kk) { s[kk] = (f32x4){0.f, 0.f, 0.f, 0.f};
#pragma unroll
            for (int ks = 0; ks < KS; ++ks) { const bf16x8 af = *(const LAS bf16x8*)(kb + (kk * 16 + fr) * KP + ks * 32 + g * 8);
                s[kk] = __builtin_amdgcn_mfma_f32_16x16x32_bf16(af, qc[ks], s[kk], 0, 0, 0); } }
        if (S.window && loc) {
            const int kp0 = (S.lo + j) * TK + g * 4;
#pragma unroll
            for (int kk = 0; kk < NKB; ++kk)
#pragma unroll
                for (int i = 0; i < 4; ++i) { const int d = kp0 + kk * 16 + i - qpos; if (d > 128 || d < -128) s[kk][i] = -INFINITY; }
        }
        float mx = -INFINITY;
#pragma unroll
        for (int kk = 0; kk < NKB; ++kk) mx = fmaxf(mx, fmaxf(fmaxf(s[kk][0], s[kk][1]), fmaxf(s[kk][2], s[kk][3])));
        if (__builtin_amdgcn_ballot_w64(mx > m + 8.f) != 0ull) {
            mx = fmaxf(mx, shx(mx, 16, lane)); mx = fmaxf(mx, shx(mx, 32, lane));
            const float mn = fmaxf(m, mx), alpha = __builtin_amdgcn_exp2f(m - mn);
            m = mn; l = l * alpha;
#pragma unroll
            for (int d = 0; d < 4; ++d) o[d] = o[d] * alpha;
        }
        float ls = 0.f;
#pragma unroll
        for (int kk = 0; kk < NKB; ++kk)
#pragma unroll
            for (int i = 0; i < 4; ++i) { const float p = __builtin_amdgcn_exp2f(s[kk][i] - m); s[kk][i] = p; ls += p; }
        l += ls;
        bf16x8 pf[NPP];
#pragma unroll
        for (int pp = 0; pp < NPP; ++pp) {
            const unsigned w0 = pk2(s[2 * pp][0], s[2 * pp][1]), w1 = pk2(s[2 * pp][2], s[2 * pp][3]), w2 = pk2(s[2 * pp + 1][0], s[2 * pp + 1][1]), w3 = pk2(s[2 * pp + 1][2], s[2 * pp + 1][3]);
            pf[pp] = __builtin_bit_cast(bf16x8, (u32x4){w0, w1, w2, w3});
        }
#pragma unroll
        for (int d = 0; d < 4; ++d)
#pragma unroll
            for (int pp = 0; pp < NPP; ++pp) {
                const LAS bf16* vr = vb + (d * 16 + fr) * VP + pp * 32 + g * 4;
                const u32x2 lo = *(const LAS u32x2*)vr, hi = *(const LAS u32x2*)(vr + 16);
                const bf16x8 af = __builtin_bit_cast(bf16x8, (u32x4){lo.x, lo.y, hi.x, hi.y});
                o[d] = __builtin_amdgcn_mfma_f32_16x16x32_bf16(af, pf[pp], o[d], 0, 0, 0);
            }
        if (j + 1 < ntile) lstore(buf ^ 1);
        __syncthreads();
    }
    float lt = l + shx(l, 16, lane); lt += shx(lt, 32, lane);
    const float inv = 1.f / lt;
    bf16* yr = S.Y + (size_t)(S.rowbase + qpos) * DM + S.outcol + g * 4;
#pragma unroll
    for (int d = 0; d < 4; ++d) st4bf(yr + d * 16, o[d] * inv);
}

struct AttnBufs { const bf16 *MQKV, *KPE, *Qc_rot, *Qc_raw, *Kc, *Vc, *Qd_rot, *Qd_raw, *Kd, *Vd; bf16* YCAT; const float* sink; const float* rope; unsigned* ctr; };
constexpr int ATT_NU = 384 + 768;
__device__ __forceinline__ void attn_phase(const AttnBufs& B, LAS unsigned char* lds, int tid, int lane, int wave) {
    volatile LAS unsigned* shu = (volatile LAS unsigned*)(lds + LDS_CTL);
    if (tid == 0) *shu = atomicAdd(B.ctr, 1u);
    __syncthreads();
    for (;;) {
        const int u = (int)*shu;
        if (u >= ATT_NU) break;
        unsigned nxt_u = 0u;
        int type, b, h, qt; bool samp;
        if (u < 384) { type = u >> 7; const int v = u & 127; b = v >> 6; h = (v >> 4) & 3; qt = v & 15; samp = true; }
        else { const int w = u - 384; type = w >> 8; const int v = w & 255; b = v >> 3; h = (v >> 1) & 3; qt = v & 1; samp = false; }
        AttnSrc S;
        S.samp = samp; S.q0 = qt * 128; S.rope = B.rope; S.Y = B.YCAT;
        S.krbase = samp ? NPR + b * 2560 : b * 256; S.rowbase = samp ? NPR + b * 2048 : b * 256;
        S.window = false; S.sink = false; S.m0 = -1e30f;
        if (!samp) { S.lo = 0; S.hi = 2; S.nctx = 0; }
        else { S.lo = 0; S.hi = 16; S.nctx = 4; }
        if (type == 0) {
            S.Qraw = B.MQKV + h * 96; S.Qrot = S.Qraw; S.qpitch = 1024; S.K0 = B.MQKV + 384 + h * 128; S.k0pitch = 1024; S.K1 = B.KPE; S.V = B.MQKV + 384 + h * 128 + 64; S.vpitch = 1024; S.outcol = 256 + h * 64;
            attn_unit<96>(S, lds, tid, lane, wave, B.ctr, nxt_u);
        } else {
            if (type == 1) { S.Qraw = B.Qc_raw + h * 64; S.Qrot = B.Qc_rot + h * 64; S.K0 = B.Kc + (h >> 1) * 64; S.V = B.Vc + (h >> 1) * 64; S.outcol = 512 + h * 64; }
            else { S.Qraw = B.Qd_raw + h * 64; S.Qrot = B.Qd_rot + h * 64; S.K0 = B.Kd + (h >> 1) * 64; S.V = B.Vd + (h >> 1) * 64; S.outcol = 768 + h * 64;
                   S.sink = true; S.m0 = B.sink[h] * LOG2E;
                   if (samp) { S.window = true; const int lo = S.q0 / 128 - 1; S.lo = lo < 0 ? 0 : lo; const int hi = S.q0 / 128 + 2; S.hi = hi > 16 ? 16 : hi; } }
            S.qpitch = 256; S.k0pitch = 128; S.K1 = nullptr; S.vpitch = 128;
            attn_unit<64>(S, lds, tid, lane, wave, B.ctr, nxt_u);
        }
        if (tid == 0) *shu = nxt_u;
        __syncthreads();
    }
}

__device__ __forceinline__ void load8(const bf16* p, float (&o)[8]) { const u32x4 u = *(const u32x4*)p; o[0] = bflo(u.x); o[1] = bfhi(u.x); o[2] = bflo(u.y); o[3] = bfhi(u.y); o[4] = bflo(u.z); o[5] = bfhi(u.z); o[6] = bflo(u.w); o[7] = bfhi(u.w); }
__device__ __forceinline__ void convgate_phase(const bf16* U, const float* cf, bf16* ACT, int gt, int NGT) {
    constexpr int NCH = DFF / 8, RG = 8;
    for (int it = gt; it < (NTOK / RG) * NCH; it += NGT) {
        const int rg = it / NCH, cc = it % NCH, r0 = rg * RG, col = cc * 8;
        const bool samp = r0 >= NPR; const int t0 = samp ? ((r0 - NPR) & 2047) : (r0 & 255), T = samp ? 2048 : 256;
        const bf16* up = U + (size_t)r0 * DUP + col;
        u32x4 ra[RG + 2], rb[RG + 2];
        const u32x4 z4 = (u32x4){0u, 0u, 0u, 0u};
        ra[0] = z4; rb[0] = z4; ra[RG + 1] = z4; rb[RG + 1] = z4;
        if (t0 > 0) { ra[0] = *(const u32x4*)(up - DUP); rb[0] = *(const u32x4*)(up - DUP + DFF); }
#pragma unroll
        for (int i = 0; i < RG; ++i) { ra[i + 1] = *(const u32x4*)(up + (size_t)i * DUP); rb[i + 1] = *(const u32x4*)(up + (size_t)i * DUP + DFF); }
        if (t0 + RG < T) { ra[RG + 1] = *(const u32x4*)(up + (size_t)RG * DUP); rb[RG + 1] = *(const u32x4*)(up + (size_t)RG * DUP + DFF); }
        float wa[3][8], wb[3][8];
#pragma unroll
        for (int k = 0; k < 3; ++k) { const f32x4 a0 = *(const f32x4*)(cf + k * DUP + col), a1 = *(const f32x4*)(cf + k * DUP + col + 4), b0 = *(const f32x4*)(cf + k * DUP + DFF + col), b1 = *(const f32x4*)(cf + k * DUP + DFF + col + 4);
#pragma unroll
            for (int e = 0; e < 4; ++e) { wa[k][e] = a0[e]; wa[k][4 + e] = a1[e]; wb[k][e] = b0[e]; wb[k][4 + e] = b1[e]; } }
#pragma unroll
        for (int i = 0; i < RG; ++i) {
            float r[8];
#pragma unroll
            for (int h = 0; h < 4; ++h) {
                const unsigned pa = ra[i][h], ca = ra[i + 1][h], na = ra[i + 2][h], pb = rb[i][h], cb = rb[i + 1][h], nb = rb[i + 2][h];
                const float xa0 = wa[0][2 * h] * bflo(pa) + wa[1][2 * h] * bflo(ca) + wa[2][2 * h] * bflo(na), xb0 = wb[0][2 * h] * bflo(pb) + wb[1][2 * h] * bflo(cb) + wb[2][2 * h] * bflo(nb);
                const float xa1 = wa[0][2 * h + 1] * bfhi(pa) + wa[1][2 * h + 1] * bfhi(ca) + wa[2][2 * h + 1] * bfhi(na), xb1 = wb[0][2 * h + 1] * bfhi(pb) + wb[1][2 * h + 1] * bfhi(cb) + wb[2][2 * h + 1] * bfhi(nb);
                r[2 * h] = xa0 * __builtin_amdgcn_rcpf(1.f + __builtin_amdgcn_exp2f(-xa0 * LOG2E)) * xb0;
                r[2 * h + 1] = xa1 * __builtin_amdgcn_rcpf(1.f + __builtin_amdgcn_exp2f(-xa1 * LOG2E)) * xb1;
            }
            u32x4 w; w.x = pk2(r[0], r[1]); w.y = pk2(r[2], r[3]); w.z = pk2(r[4], r[5]); w.w = pk2(r[6], r[7]);
            *(u32x4*)(ACT + (size_t)(r0 + i) * DFF + col) = w;
        }
    }
}

#define XB_TMO      128
#define XB_XCNT(j)  (256  + 64 * (j))
#define XB_XSUB(j)  (1280 + 64 * (j))
#define XB_XGEN(j)  (2304 + 64 * (j))
#define XB_TOP      3328
#define XB_TOPGEN   3392
#define XCD_BAR_WORDS 3456
#define XB_SPIN_CAP (1u << 20)
__device__ __forceinline__ unsigned xb_ld(unsigned* p)              { return __hip_atomic_load(p, __ATOMIC_RELAXED, __HIP_MEMORY_SCOPE_AGENT); }
__device__ __forceinline__ unsigned xb_add(unsigned* p, unsigned v) { return __hip_atomic_fetch_add(p, v, __ATOMIC_RELAXED, __HIP_MEMORY_SCOPE_AGENT); }
__device__ __forceinline__ unsigned xb_xcc_id() { return (unsigned)__builtin_amdgcn_s_getreg((3 << 11) | 20) & 0xFu; }
#define XB_SPIN(cond, bar) do { unsigned _sp = 0; while (cond) { __builtin_amdgcn_s_sleep(1); \
    if ((++_sp & 255u) == 0u) { if (xb_ld(&(bar)[XB_TMO])) break; if (_sp > XB_SPIN_CAP) { atomicAdd(&(bar)[XB_TMO], 1u); break; } } } } while (0)
struct XcdBarrier { unsigned* bar; unsigned x; volatile LAS unsigned* st; };
__device__ __forceinline__ void xcd_barrier_complete(unsigned* bar, unsigned x, unsigned& nloc, unsigned& nx) {
    const unsigned G = gridDim.x * gridDim.y * gridDim.z;
    unsigned sum, cnt, mine, sp = 0u;
    for (;;) {
        sum = 0u; cnt = 0u; mine = 0u;
#pragma unroll
        for (unsigned j = 0; j < 16; ++j) { const unsigned c = xb_ld(&bar[XB_XCNT(j)]); sum += c; cnt += (c > 0u) ? 1u : 0u; mine = (j == x) ? c : mine; }
        if (sum == G) break;
        __builtin_amdgcn_s_sleep(1);
        if ((++sp & 255u) == 0u) { if (xb_ld(&bar[XB_TMO])) break; if (sp > XB_SPIN_CAP) { atomicAdd(&bar[XB_TMO], 1u); break; } }
    }
    nloc = mine > 0u ? mine : 1u; nx = cnt > 0u ? cnt : 1u;
}
__device__ __forceinline__ void xcd_barrier(const XcdBarrier& b, const int tid_) {
    asm volatile("s_waitcnt vmcnt(0)" ::: "memory");
    __syncthreads();
    if (tid_ == 0) {
        unsigned* bar = b.bar;
        __builtin_amdgcn_s_waitcnt(0);
        unsigned nloc = b.st[0], nx = b.st[1];
        if (nloc == 0u) { xcd_barrier_complete(bar, b.x, nloc, nx); b.st[0] = nloc; b.st[1] = nx; }
        const unsigned old = xb_add(&bar[XB_XSUB(b.x)], 1u);
        const unsigned gen = old / nloc;
        if (old + 1u == (gen + 1u) * nloc) {
            __builtin_amdgcn_fence(__ATOMIC_RELEASE, "agent");
            asm volatile("s_waitcnt vmcnt(0)" ::: "memory");
            const unsigned og = xb_add(&bar[XB_TOP], 1u);
            const unsigned tg = og / nx;
            if (og + 1u == (tg + 1u) * nx) xb_add(&bar[XB_TOPGEN], 1u);
            else XB_SPIN(xb_ld(&bar[XB_TOPGEN]) == tg, bar);
            __builtin_amdgcn_fence(__ATOMIC_ACQUIRE, "agent");
            xb_add(&bar[XB_XGEN(b.x)], 1u);
            asm volatile("s_waitcnt vmcnt(0)" ::: "memory");
        } else {
            XB_SPIN(xb_ld(&bar[XB_XGEN(b.x)]) == gen, bar);
            __builtin_amdgcn_fence(__ATOMIC_ACQUIRE, "agent");
            asm volatile("s_waitcnt vmcnt(0)" ::: "memory");
        }
    }
    __syncthreads();
}

__device__ __forceinline__ int lane_id_volatile() { int l; asm volatile("v_mbcnt_lo_u32_b32 %0, -1, 0\n\tv_mbcnt_hi_u32_b32 %0, -1, %0" : "=v"(l)); return l; }

#ifndef PH
#define PH 0xFFFF
#endif
#define ON(k) ((PH >> (k)) & 1)
#ifndef REP
#define REP 0
#endif
#define NREP(k) (1 + ((REP >> (k)) & 1))
__global__ void __launch_bounds__(NT, 2) mega_fwd(Args a_unused) {
    extern __shared__ __attribute__((aligned(16))) unsigned char lds[];
    cg::grid_group grid = cg::this_grid();
    const int G = gridDim.x, bid = blockIdx.x;
    const int wave_s = __builtin_amdgcn_readfirstlane(threadIdx.x >> 6);
    PG8_LAS unsigned char* ring = (PG8_LAS unsigned char*)lds;
#define PHASE_BEGIN int tid = wave_s * 64 + lane_id_volatile(); asm volatile("" : "+v"(tid)); const CAS Args* ap_ = (const CAS Args*)__builtin_amdgcn_kernarg_segment_ptr(); asm volatile("" : "+s"(ap_)); const CAS Args& a = *ap_; unsigned char* ws = a.ws; float* out = a.out; \
    const int lane = tid & 63, wave = __builtin_amdgcn_readfirstlane(tid >> 6); const int gw = bid * NW + wave, NGW = G * NW, gt = bid * NT + tid, NGT = G * NT; \
    (void)lane; (void)wave; (void)gw; (void)NGW; (void)gt; (void)NGT; (void)out; \
    const float* mod = (const float*)(ws + WS_MOD); const float* rope = (const float*)(ws + WS_ROPE); (void)mod; (void)rope; \
    bf16* XN = (bf16*)(ws + WS_XN); bf16* PROJ = (bf16*)(ws + WS_PROJ); bf16* A2 = (bf16*)(ws + WS_A2); bf16* MQKV = (bf16*)(ws + WS_MQKV); \
    bf16* KPE = (bf16*)(ws + WS_KPE); bf16* YCAT = (bf16*)(ws + WS_YCAT); bf16* ACT = (bf16*)(ws + WS_ACT); bf16* U = (bf16*)(ws + WS_U); \
    bf16* Qc_rot = (bf16*)(ws + WS_QC); bf16* Qc_raw = (bf16*)(ws + WS_QC + QSZ); bf16* Kc = (bf16*)(ws + WS_QC + 2 * QSZ); bf16* Vc = (bf16*)(ws + WS_QC + 2 * QSZ + KSZ); \
    bf16* Qd_rot = (bf16*)(ws + WS_QC + 2 * QSZ + 2 * KSZ); bf16* Qd_raw = Qd_rot + (size_t)NKR * 256; bf16* Kd = Qd_raw + (size_t)NKR * 256; bf16* Vd = Kd + (size_t)NKR * 128; \
    (void)XN; (void)PROJ; (void)A2; (void)MQKV; (void)KPE; (void)YCAT; (void)ACT; (void)U; (void)Qc_rot; (void)Qc_raw; (void)Kc; (void)Vc; (void)Qd_rot; (void)Qd_raw; (void)Kd; (void)Vd;
#define GSYNC() do { const CAS Args* bp_ = (const CAS Args*)__builtin_amdgcn_kernarg_segment_ptr(); asm volatile("" : "+s"(bp_)); XcdBarrier xb_; xb_.bar = (unsigned*)(bp_->ws + WS_BAR); xb_.x = xb_xcc_id(); \
    xb_.st = (volatile LAS unsigned*)((LAS unsigned char*)lds + LDS_CTL + 32); xcd_barrier(xb_, wave_s * 64 + lane_id_volatile()); } while (0)
#define LAYER_VALS const float* modl = mod + (size_t)l * 3 * 6144; unsigned char* wl = ws + WS_W + l * W_LSTRIDE; (void)modl; (void)wl; \
    const float* x0 = l == 0 ? a.in[0] : nullptr; const float* x1 = l == 0 ? a.in[1] : nullptr; (void)x0; (void)x1; bf16* XRES = (bf16*)(ws + WS_XRES); (void)XRES;

    if (threadIdx.x < 16) ((volatile LAS unsigned*)((LAS unsigned char*)lds + LDS_CTL))[threadIdx.x] = 0u;
    __syncthreads();
    { PHASE_BEGIN if (tid == 0) (void)xb_add((unsigned*)(ws + WS_BAR) + XB_XCNT(xb_xcc_id()), 1u);
      if (ws == nullptr) grid.sync(); }
    for (int rep = 0; rep < NREP(0); ++rep) {
    if (ON(0)) { PHASE_BEGIN phase0(a, (LAS unsigned char*)lds, tid, lane, wave); }
    GSYNC(); }

    if (ON(1)) { PHASE_BEGIN
        if (G > 124) {
            if (bid < 62) bias_phase(a, ws, (LAS unsigned char*)lds, tid, lane, wave);
            else prep_phase(a.in[0], a.in[1], a.in[12], mod, 1024, XN, (float*)(ws + WS_SS1), lane, (bid - 62) * NW + wave, (G - 62) * NW);
        } else { bias_phase(a, ws, (LAS unsigned char*)lds, tid, lane, wave);
            prep_phase(a.in[0], a.in[1], a.in[12], mod, 1024, XN, (float*)(ws + WS_SS1), lane, gw, NGW); } }
    GSYNC();
#pragma unroll
    for (int l = 0; l < 2; ++l) {
        for (int rep = 0; rep < NREP(2); ++rep) {
        if (ON(2)) { PHASE_BEGIN LAYER_VALS pg8::Gemm g{XN, (const bf16*)(wl + W_IN), NTOK, INP, DM, 0, 0}; pg8::StaticOrder S; S.init(NTOK, INP, G, bid);
          pg8::EpiBf16RS E{PROJ, INP, (const float*)(ws + WS_SS1), (const float*)(ws + WS_BIAS) + (size_t)l * 3 * NBIAS, NBIAS};
          pg8::gemm_phase<pg8::EpiBf16RS, pg8::StaticOrder, true, true>(ring, g, S, E, tid); }
        GSYNC(); }
        for (int rep = 0; rep < NREP(3); ++rep) {
        if (ON(3)) { PHASE_BEGIN P3Ptrs P; P.PROJ = PROJ; P.A2 = A2; P.KPE = KPE; P.YCAT = YCAT; P.Qc_rot = Qc_rot; P.Qc_raw = Qc_raw; P.Kc = Kc; P.Vc = Vc; P.Qd_rot = Qd_rot; P.Qd_raw = Qd_raw; P.Kd = Kd; P.Vd = Vd;
          P.conv_a = a.in[14]; P.gq_mla = a.in[15]; P.gkv_mla = a.in[17]; P.gq = a.in[19]; P.gk = a.in[20]; P.rope = rope;
          P.c_ckv = a.in[2]; P.c_kpe = a.in[3]; P.c_gk = a.in[4]; P.c_gv = a.in[5]; P.c_sk = a.in[6]; P.c_sv = a.in[7];
          P.o_ckv = out + 12582912; P.o_kpe = out + 14680064; P.o_gk = out + 15204352; P.o_gv = out + 17301504; P.o_sk = out + 19398656; P.o_sv = out + 21495808; P.l = l;
          p3_phase(P, lane, gw, NGW); }
        GSYNC(); }
        for (int rep = 0; rep < NREP(4); ++rep) {
        if (ON(4)) { PHASE_BEGIN LAYER_VALS pg8::Gemm g{A2, (const bf16*)(wl + W_B2), NKR, 1024, 384, 0, 0}; pg8::StaticOrder S; S.init(NKR, 1024, G, bid); pg8::EpiBf16 E{MQKV, 1024};
          pg8::gemm_phase<pg8::EpiBf16, pg8::StaticOrder, true, true>(ring, g, S, E, tid); }
        GSYNC(); }
        for (int rep = 0; rep < NREP(5); ++rep) {
        if (ON(5)) { PHASE_BEGIN AttnBufs B; B.MQKV = MQKV; B.KPE = KPE; B.Qc_rot = Qc_rot; B.Qc_raw = Qc_raw; B.Kc = Kc; B.Vc = Vc; B.Qd_rot = Qd_rot; B.Qd_raw = Qd_raw; B.Kd = Kd; B.Vd = Vd; B.YCAT = YCAT;
          B.sink = a.in[21] + l * 4; B.rope = rope; B.ctr = (unsigned*)(ws + WS_CTL) + 64 * l + 128 * rep;
          attn_phase(B, (LAS unsigned char*)lds, tid, lane, wave); }
        GSYNC(); }
        if (ON(6)) { PHASE_BEGIN LAYER_VALS pg8::Gemm g{YCAT, (const bf16*)(wl + W_OUT), NTOK, DM, DM, 0, 0}; pg8::StaticOrder S; S.init(NTOK, DM, G, bid);
          pg8::EpiResid E{x0, x1, XRES, modl + 2048, XN, (float*)(ws + WS_SS2), a.in[23] + l * DM, modl + 4096};
          pg8::gemm_phase<pg8::EpiResid, pg8::StaticOrder, true, true>(ring, g, S, E, tid);
          if (l == 0) { const int wk = G > 192 ? bid - 192 : bid, nwk = G > 192 ? G - 192 : G;
            if (wk >= 0) wconv(a, ws, 0, 4 | 8, wk * NW + wave, nwk * NW, (LAS float*)((LAS unsigned char*)lds + wave * 16640), lane); } }
        GSYNC();
        for (int rep = 0; rep < NREP(8); ++rep) {
        if (ON(8)) { PHASE_BEGIN LAYER_VALS pg8::Gemm g{XN, (const bf16*)(wl + W_UP), NTOK, DUP, DM, (size_t)128 * DM * 2, (size_t)DFF * DM * 2}; pg8::StaticOrder S; S.init(NTOK, DUP, G, bid);
          pg8::EpiUpGate E{ACT, (const float*)(ws + WS_SS2), (const float*)(ws + WS_BIAS) + (size_t)l * 3 * NBIAS + 2304, NBIAS, a.in[25] + (size_t)l * 3 * DUP, (float*)(ws + WS_HALO), ring + 131072};
          pg8::gemm_phase<pg8::EpiUpGate, pg8::StaticOrder, true, true>(ring, g, S, E, tid); }
        GSYNC(); }
        if (ON(10)) { PHASE_BEGIN LAYER_VALS pg8::Gemm g{ACT, (const bf16*)(wl + W_DOWN), NTOK, DM, DFF, 0, 0}; pg8::StaticOrder S; S.init(NTOK, DM, G, bid);
          {
            const float* cwl = a.in[25] + (size_t)l * 3 * DUP; const float* HALO = (const float*)(ws + WS_HALO); pg8::Unit hu;
            bool fixed = false;
            for (int ui = 0; S.next(ui, hu); ++ui) { if (hu.pm < 32) continue; fixed = true; const int k = hu.pm - 32, pos = k & 7;
                for (int idx = tid; idx < 2 * DFF; idx += NT) { const int which = idx >= DFF ? 1 : 0, j = idx - which * DFF;
                    if (which == 0 ? pos == 0 : pos == 7) continue;
                    const float* Pp = HALO + (size_t)(k * 4 + (which ? 3 : 1)) * DUP; const float* Ep = HALO + (size_t)((which ? k + 1 : k - 1) * 4 + (which ? 0 : 2)) * DUP; const float* wp = cwl + (which ? 2 : 0) * DUP;
                    const float ca = Pp[j] + wp[j] * Ep[j], cb = Pp[DFF + j] + wp[DFF + j] * Ep[DFF + j];
                    const float r = ca * __builtin_amdgcn_rcpf(1.f + __builtin_amdgcn_exp2f(-ca * LOG2E)) * cb;
                    ACT[(size_t)(hu.pm * 256 + (which ? 255 : 0)) * DFF + j] = (bf16)(pk2(r, r) & 0xffffu); } }
            if (fixed) { asm volatile("s_waitcnt vmcnt(0)" ::: "memory"); __syncthreads();
                if (tid == 0) { __builtin_amdgcn_fence(__ATOMIC_RELEASE, "agent"); __builtin_amdgcn_fence(__ATOMIC_ACQUIRE, "agent"); asm volatile("s_waitcnt vmcnt(0)" ::: "memory"); }
                __syncthreads(); } }
          if (l == 1 && G >= 192) {
            pg8::EpiResidFinal E{XRES, out, modl + 5120, (float*)(ws + WS_SS1), a.in[27], (unsigned*)(ws + WS_CTL) + 2048};
            pg8::gemm_phase<pg8::EpiResidFinal, pg8::StaticOrder, true, true>(ring, g, S, E, tid);
          } else {
          pg8::EpiResid E{nullptr, nullptr, XRES, modl + 5120, l == 0 ? XN : nullptr, (float*)(ws + WS_SS1), a.in[12] + DM, mod + (size_t)3 * 6144 + 1024};
          pg8::gemm_phase<pg8::EpiResid, pg8::StaticOrder, true, true>(ring, g, S, E, tid); }
          if (l == 0) { const int wk = G > 192 ? bid - 192 : bid, nwk = G > 192 ? G - 192 : G;
            if (wk >= 0) wconv(a, ws, 1, 63, wk * NW + wave, nwk * NW, (LAS float*)((LAS unsigned char*)lds + wave * 16640), lane); } }
        if (!(l == 1 && G >= 192)) GSYNC();
    }
#ifdef XSYNC
    for (int i = 0; i < XSYNC; ++i) GSYNC();
#endif
    if (G < 192) { PHASE_BEGIN
    const bf16* XRES = (const bf16*)(ws + WS_XRES);
    for (int row = gw; row < NTOK; row += NGW) {
        float* xr = out + (size_t)row * DM;
        f32x4 v[4]; float ss = 0.f;
#pragma unroll
        for (int j = 0; j < 4; ++j) { v[j] = ld4bf(XRES + (size_t)row * DM + 4 * (lane + 64 * j)); ss += dot4(v[j]); }
        const float rs = rsqrtf(wave_sum(ss, lane) * (1.f / DM) + EPS);
#pragma unroll
        for (int j = 0; j < 4; ++j) { const int col = 4 * (lane + 64 * j); *(f32x4*)(xr + col) = v[j] * rs * *(const f32x4*)(a.in[27] + col); }
    } }
}

extern "C" void kernel_launch(void* const* d_in, const int* in_sizes, int n_in, void* d_out, int out_size, void* d_ws, size_t ws_size, hipStream_t stream) {
    static int grid = 0;
    if (grid == 0) {
        if (n_in != 28 || ws_size < WS_END) { fprintf(stderr, "kernel_launch: unexpected n_in %d / ws %zu\n", n_in, ws_size); grid = -1; return; }
        int dev = 0, cus = 0, per_cu = 0;
        hipGetDevice(&dev); hipDeviceGetAttribute(&cus, hipDeviceAttributeMultiprocessorCount, dev);
        hipFuncSetAttribute((const void*)mega_fwd, hipFuncAttributeMaxDynamicSharedMemorySize, LDS_BYTES);
        hipOccupancyMaxActiveBlocksPerMultiprocessor(&per_cu, (const void*)mega_fwd, NT, LDS_BYTES);
        if (per_cu < 1) per_cu = 1;
        grid = cus * per_cu;
        (void)hipGetLastError();
    }
    if (grid < 0) return;
    if (hipMemsetAsync((char*)d_ws + WS_BAR, 0, XCD_BAR_WORDS * 4, stream) != hipSuccess) { fprintf(stderr, "kernel_launch: memset of the barrier words failed\n"); return; }
    Args a{};
    for (int i = 0; i < 28; ++i) a.in[i] = (const float*)d_in[i];
    a.out = (float*)d_out; a.ws = (unsigned char*)d_ws;
    void* args[] = {&a};
    hipError_t e = hipLaunchCooperativeKernel((const void*)mega_fwd, dim3(grid), dim3(NT), args, LDS_BYTES, stream);
    if (e != hipSuccess) fprintf(stderr, "cooperative launch failed: %s (grid %d)\n", hipGetErrorString(e), grid);
}
```

```cpp
#include <hip/hip_runtime.h>
#include <hip/hip_cooperative_groups.h>
#include <cstdio>
#include <cstdint>
namespace cg = cooperative_groups;

namespace pg8 {
#define PG8_LAS __attribute__((address_space(3)))
typedef unsigned short bf16_t;
typedef short bf16x8 __attribute__((ext_vector_type(8)));
typedef float f32x4 __attribute__((ext_vector_type(4)));
typedef unsigned u32x4 __attribute__((ext_vector_type(4)));
constexpr int BM = 256, BK = 64, HALF = 128, HTB = HALF * BK * 2, STAGE_BYTES = 8 * HTB, NXCD = 8, WGM = 4;

__host__ __device__ __forceinline__ int lds_byte(int r, int c) { const int st = (r >> 4) * 2 + (c >> 5), rr = r & 15, cc = c & 31, ob = rr * 64 + cc * 2; return st * 1024 + (ob ^ (((ob >> 9) & 1) << 5)); }
__host__ __device__ __forceinline__ void stage_rc(int b, int& R, int& C) { const int st = b / 1024, sb = b % 1024, swz = sb ^ (((sb >> 9) & 1) << 5); R = (st >> 1) * 16 + swz / 64; C = (st & 1) * 32 + (swz % 64) / 2; }
__host__ __device__ __forceinline__ int perm32(int rho) { const int n = rho >> 4, i = rho & 15; return 8 * (i >> 2) + 4 * n + (i & 3); }

struct Unit { int pm, pn; };
struct Gemm { const bf16_t* A; const bf16_t* Bt; int M, N, K; size_t bstep, bhalf; };

struct StaticOrder {
    int nM, nN, nwg, G, c;
    __host__ __device__ __forceinline__ void init(int M, int N, int G_, int c_) { nM = M / BM; nN = N / BM; nwg = nM * nN; G = G_; c = c_; }
    __host__ __device__ __forceinline__ bool next(int i, Unit& u) const {
        const long L = (long)i * G + c; if (L >= nwg) return false;
        int wgid = (int)L; { const int q = nwg / NXCD, r = nwg % NXCD, xcd = wgid % NXCD, off = wgid / NXCD; wgid = (xcd < r ? xcd * (q + 1) : r * (q + 1) + (xcd - r) * q) + off; }
        const int nig = WGM * nN, gid = wgid / nig, fm = gid * WGM, gsz = (nM - fm) < WGM ? (nM - fm) : WGM;
        u.pm = fm + ((wgid % nig) % gsz); u.pn = (wgid % nig) / gsz; return true;
    }
    __device__ __forceinline__ void a_ready(const Unit&) const {}
    __device__ __forceinline__ void done(const Unit&) const {}
};

__device__ __forceinline__ unsigned cvt_pk_bf16(float lo, float hi) { unsigned r; asm volatile("v_cvt_pk_bf16_f32 %0, %1, %2" : "=v"(r) : "v"(lo), "v"(hi)); return r; }

struct EpiBf16 {
    static constexpr bool PERM = true, AFTER_DRAIN = false;
    bf16_t* O; int ldc;
    __device__ __forceinline__ void operator()(const f32x4 (&acc)[2][2][4][2], const Unit& u, int wr, int wc, int fr, int fq) const {
        asm volatile("" : "+v"(fr), "+v"(fq));
        const int row0 = u.pm * BM + wr * 64 + fr; const int col0 = u.pn * BM + wc * 32 + 8 * fq;
#pragma unroll
        for (int ai = 0; ai < 2; ++ai)
#pragma unroll
            for (int m = 0; m < 4; ++m) { bf16_t* rowp = O + (size_t)(row0 + ai * HALF + m * 16) * ldc + col0;
#pragma unroll
                for (int bj = 0; bj < 2; ++bj) { const f32x4 v0 = acc[ai][bj][m][0], v1 = acc[ai][bj][m][1];
                    u32x4 w; w.x = cvt_pk_bf16(v0[0], v0[1]); w.y = cvt_pk_bf16(v0[2], v0[3]); w.z = cvt_pk_bf16(v1[0], v1[1]); w.w = cvt_pk_bf16(v1[2], v1[3]);
                    *(u32x4*)(rowp + bj * HALF) = w; } }
    }
};
__device__ __forceinline__ float shx_(float v, int m, int lane) { return __builtin_bit_cast(float, __builtin_amdgcn_ds_bpermute((lane ^ m) << 2, __builtin_bit_cast(int, v))); }
__device__ __forceinline__ void row_scales(const float* SS, int row0, int fr, int fq, float (&rs)[8]) {
    f32x4 t[8];
#pragma unroll
    for (int q = 0; q < 8; ++q) t[q] = *(const f32x4*)(SS + (size_t)(row0 + (q >> 2) * HALF + (q & 3) * 16) * 16 + 4 * fq);
    const int lane = fq * 16 + fr;
#pragma unroll
    for (int q = 0; q < 8; ++q) { float v = (t[q][0] + t[q][1]) + (t[q][2] + t[q][3]); v += shx_(v, 16, lane); v += shx_(v, 32, lane); rs[q] = __builtin_amdgcn_rsqf(v * (1.f / 1024.f) + 1e-6f); }
}
struct EpiBf16RS {
    static constexpr bool PERM = true, AFTER_DRAIN = false;
    bf16_t* O; int ldc; const float* SS; const float* bias; int ldb;
    __device__ __forceinline__ void operator()(const f32x4 (&acc)[2][2][4][2], const Unit& u, int wr, int wc, int fr, int fq) const {
        asm volatile("" : "+v"(fr), "+v"(fq));
        const int cnd = u.pm < 32 ? 0 : 1 + ((u.pm - 32) >> 3);
        const int row0 = u.pm * BM + wr * 64 + fr; const int col0 = u.pn * BM + wc * 32 + 8 * fq;
        const float* bp = bias + (size_t)cnd * ldb + col0;
        f32x4 bv[2][2];
#pragma unroll
        for (int bj = 0; bj < 2; ++bj)
#pragma unroll
            for (int n = 0; n < 2; ++n) bv[bj][n] = *(const f32x4*)(bp + bj * HALF + 4 * n);
        float rsv[8]; row_scales(SS, row0, fr, fq, rsv);
#pragma unroll
        for (int ai = 0; ai < 2; ++ai)
#pragma unroll
            for (int m = 0; m < 4; ++m) { const int row = row0 + ai * HALF + m * 16; const float rs = rsv[ai * 4 + m];
                bf16_t* rowp = O + (size_t)row * ldc + col0;
#pragma unroll
                for (int bj = 0; bj < 2; ++bj) { const f32x4 v0 = acc[ai][bj][m][0] * rs + bv[bj][0], v1 = acc[ai][bj][m][1] * rs + bv[bj][1];
                    u32x4 w; w.x = cvt_pk_bf16(v0[0], v0[1]); w.y = cvt_pk_bf16(v0[2], v0[3]); w.z = cvt_pk_bf16(v1[0], v1[1]); w.w = cvt_pk_bf16(v1[2], v1[3]);
                    *(u32x4*)(rowp + bj * HALF) = w; } }
    }
};
struct EpiResid {
    static constexpr bool PERM = false, AFTER_DRAIN = false;
    const float* r0; const float* r1; bf16_t* XR; const float* gate;
    bf16_t* XN; float* SS; const float* nrm; const float* sc;
    __device__ __forceinline__ void operator()(const f32x4 (&acc)[2][2][4][2], const Unit& u, int wr, int wc, int fr, int fq) const {
        asm volatile("" : "+v"(fr), "+v"(fq));
        typedef unsigned u32x2_ __attribute__((ext_vector_type(2)));
        const int cnd = u.pm < 32 ? 0 : 1 + ((u.pm - 32) >> 3);
        const float* gp = gate + cnd * 6144;
        const int col0 = u.pn * BM + wc * 32 + 4 * fq;
        const int rowb = u.pm * BM + wr * 64 + fr;
        const bool inf = r0 != nullptr;
        const float* rs = (u.pm < 32 ? r0 + (size_t)rowb * 1024 : r1 + (size_t)(rowb - 8192) * 1024) + col0;
        bf16_t* op = XR + (size_t)rowb * 1024 + col0;
#define LDX(off) (inf ? __builtin_nontemporal_load((const f32x4*)(rs + (off))) : ({ const u32x2_ t_ = *(const u32x2_*)(op + (off)); (f32x4){__builtin_bit_cast(float, t_.x << 16), __builtin_bit_cast(float, t_.x & 0xffff0000u), __builtin_bit_cast(float, t_.y << 16), __builtin_bit_cast(float, t_.y & 0xffff0000u)}; }))
        const bool prep = XN != nullptr;
        f32x4 gv[2][2], hv[2][2];
#pragma unroll
        for (int bj = 0; bj < 2; ++bj)
#pragma unroll
            for (int n = 0; n < 2; ++n) { gv[bj][n] = *(const f32x4*)(gp + col0 + bj * HALF + n * 16);
                hv[bj][n] = (f32x4){0.f, 0.f, 0.f, 0.f};
                if (prep) hv[bj][n] = *(const f32x4*)(nrm + col0 + bj * HALF + n * 16) * (1.f + *(const f32x4*)(sc + cnd * 6144 + col0 + bj * HALF + n * 16)); }
        f32x4 xc[2][2], xn[2][2];
#pragma unroll
        for (int bj = 0; bj < 2; ++bj)
#pragma unroll
            for (int n = 0; n < 2; ++n) xc[bj][n] = LDX(bj * HALF + n * 16);
#pragma unroll
        for (int it = 0; it < 8; ++it) { const int ai = it >> 2, m = it & 3; const size_t ro = (size_t)(ai * HALF + m * 16) * 1024;
            if (it < 7) { const int ai2 = (it + 1) >> 2, m2 = (it + 1) & 3; const size_t ro2 = (size_t)(ai2 * HALF + m2 * 16) * 1024;
#pragma unroll
                for (int bj = 0; bj < 2; ++bj)
#pragma unroll
                    for (int n = 0; n < 2; ++n) xn[bj][n] = LDX(ro2 + bj * HALF + n * 16); }
            float ssq = 0.f;
#pragma unroll
            for (int bj = 0; bj < 2; ++bj)
#pragma unroll
                for (int n = 0; n < 2; ++n) { const f32x4 v = xc[bj][n] + gv[bj][n] * acc[ai][bj][m][n];
                    *(u32x2_*)(op + ro + bj * HALF + n * 16) = (u32x2_){cvt_pk_bf16(v[0], v[1]), cvt_pk_bf16(v[2], v[3])};
                    if (prep) { ssq += (v[0] * v[0] + v[1] * v[1]) + (v[2] * v[2] + v[3] * v[3]); const f32x4 h = v * hv[bj][n];
                        unsigned w0 = cvt_pk_bf16(h[0], h[1]), w1 = cvt_pk_bf16(h[2], h[3]);
                        *(u32x2_*)(XN + (size_t)(rowb + ai * HALF + m * 16) * 1024 + col0 + bj * HALF + n * 16) = (u32x2_){w0, w1}; } }
            if (prep) { const int lane = fq * 16 + fr; ssq += shx_(ssq, 16, lane); ssq += shx_(ssq, 32, lane);
                if (fq == 0) SS[(size_t)(rowb + ai * HALF + m * 16) * 16 + u.pn * 4 + wc] = ssq; }
#pragma unroll
            for (int bj = 0; bj < 2; ++bj)
#pragma unroll
                for (int n = 0; n < 2; ++n) xc[bj][n] = xn[bj][n];
        }
    }
#undef LDX
};

struct EpiResidFinal {
    static constexpr bool PERM = false, AFTER_DRAIN = false;
    const bf16_t* res; float* out; const float* gate; float* SS; const float* fw; unsigned* cnt;
    __device__ __forceinline__ void operator()(f32x4 (&acc)[2][2][4][2], const Unit& u, int wr, int wc, int fr, int fq) const {
        asm volatile("" : "+v"(fr), "+v"(fq));
        const int cnd = u.pm < 32 ? 0 : 1 + ((u.pm - 32) >> 3);
        const float* gp = gate + cnd * 6144;
        const int col0 = u.pn * BM + wc * 32 + 4 * fq;
        const int rowb = u.pm * BM + wr * 64 + fr;
        typedef unsigned u32x2_ __attribute__((ext_vector_type(2)));
        const bf16_t* rs = res + (size_t)rowb * 1024 + col0;
#define LDXF(off) ({ const u32x2_ t_ = *(const u32x2_*)(rs + (off)); (f32x4){__builtin_bit_cast(float, t_.x << 16), __builtin_bit_cast(float, t_.x & 0xffff0000u), __builtin_bit_cast(float, t_.y << 16), __builtin_bit_cast(float, t_.y & 0xffff0000u)}; })
        f32x4 gv[2][2];
#pragma unroll
        for (int bj = 0; bj < 2; ++bj)
#pragma unroll
            for (int n = 0; n < 2; ++n) gv[bj][n] = *(const f32x4*)(gp + col0 + bj * HALF + n * 16);
        f32x4 xc[2][2], xn[2][2];
#pragma unroll
        for (int bj = 0; bj < 2; ++bj)
#pragma unroll
            for (int n = 0; n < 2; ++n) xc[bj][n] = LDXF(bj * HALF + n * 16);
#pragma unroll
        for (int it = 0; it < 8; ++it) { const int ai = it >> 2, m = it & 3;
            if (it < 7) { const int ai2 = (it + 1) >> 2, m2 = (it + 1) & 3; const size_t ro2 = (size_t)(ai2 * HALF + m2 * 16) * 1024;
#pragma unroll
                for (int bj = 0; bj < 2; ++bj)
#pragma unroll
                    for (int n = 0; n < 2; ++n) xn[bj][n] = LDXF(ro2 + bj * HALF + n * 16); }
            float ssq = 0.f;
#pragma unroll
            for (int bj = 0; bj < 2; ++bj)
#pragma unroll
                for (int n = 0; n < 2; ++n) { const f32x4 v = xc[bj][n] + gv[bj][n] * acc[ai][bj][m][n]; acc[ai][bj][m][n] = v;
                    ssq += (v[0] * v[0] + v[1] * v[1]) + (v[2] * v[2] + v[3] * v[3]); }
            { const int lane = fq * 16 + fr; ssq += shx_(ssq, 16, lane); ssq += shx_(ssq, 32, lane);
              if (fq == 0) __hip_atomic_store(SS + (size_t)(rowb + ai * HALF + m * 16) * 16 + u.pn * 4 + wc, ssq, __ATOMIC_RELAXED, __HIP_MEMORY_SCOPE_AGENT); }
#pragma unroll
            for (int bj = 0; bj < 2; ++bj)
#pragma unroll
                for (int n = 0; n < 2; ++n) xc[bj][n] = xn[bj][n];
        }
        asm volatile("s_waitcnt vmcnt(0)" ::: "memory"); __builtin_amdgcn_s_barrier(); asm volatile("" ::: "memory");
        if (wr == 0 && wc == 0 && fr == 0 && fq == 0) {
            __builtin_amdgcn_fence(__ATOMIC_RELEASE, "agent"); asm volatile("s_waitcnt vmcnt(0)" ::: "memory");
            __hip_atomic_fetch_add(cnt + u.pm, 1u, __ATOMIC_RELAXED, __HIP_MEMORY_SCOPE_AGENT);
            unsigned sp = 0;
            while (__hip_atomic_load(cnt + u.pm, __ATOMIC_RELAXED, __HIP_MEMORY_SCOPE_AGENT) < 4u) { __builtin_amdgcn_s_sleep(1); if (++sp > (1u << 22)) break; }
            __builtin_amdgcn_fence(__ATOMIC_ACQUIRE, "agent"); asm volatile("s_waitcnt vmcnt(0)" ::: "memory");
        }
        __builtin_amdgcn_s_barrier(); asm volatile("" ::: "memory");
        float rsv[8];
        { f32x4 t[8];
#pragma unroll
          for (int q = 0; q < 8; ++q) { const float* sp = SS + (size_t)(rowb + (q >> 2) * HALF + (q & 3) * 16) * 16 + 4 * fq;
              t[q] = (f32x4){__hip_atomic_load(sp, __ATOMIC_RELAXED, __HIP_MEMORY_SCOPE_AGENT), __hip_atomic_load(sp + 1, __ATOMIC_RELAXED, __HIP_MEMORY_SCOPE_AGENT),
                             __hip_atomic_load(sp + 2, __ATOMIC_RELAXED, __HIP_MEMORY_SCOPE_AGENT), __hip_atomic_load(sp + 3, __ATOMIC_RELAXED, __HIP_MEMORY_SCOPE_AGENT)}; }
          const int lane = fq * 16 + fr;
#pragma unroll
          for (int q = 0; q < 8; ++q) { float v = (t[q][0] + t[q][1]) + (t[q][2] + t[q][3]); v += shx_(v, 16, lane); v += shx_(v, 32, lane); rsv[q] = __builtin_amdgcn_rsqf(v * (1.f / 1024.f) + 1e-6f); } }
        f32x4 wv[2][2];
#pragma unroll
        for (int bj = 0; bj < 2; ++bj)
#pragma unroll
            for (int n = 0; n < 2; ++n) wv[bj][n] = *(const f32x4*)(fw + col0 + bj * HALF + n * 16);
        float* op = out + (size_t)rowb * 1024 + col0;
#pragma unroll
        for (int it = 0; it < 8; ++it) { const int ai = it >> 2, m = it & 3; const size_t ro = (size_t)(ai * HALF + m * 16) * 1024;
#pragma unroll
            for (int bj = 0; bj < 2; ++bj)
#pragma unroll
                for (int n = 0; n < 2; ++n) __builtin_nontemporal_store(acc[ai][bj][m][n] * rsv[it] * wv[bj][n], (f32x4*)(op + ro + bj * HALF + n * 16)); }
    }
};

__device__ __forceinline__ float dpp_ror1(float v) { return __builtin_bit_cast(float, __builtin_amdgcn_mov_dpp(__builtin_bit_cast(int, v), 0x121, 0xf, 0xf, false)); }
__device__ __forceinline__ float dpp_ror15(float v) { return __builtin_bit_cast(float, __builtin_amdgcn_mov_dpp(__builtin_bit_cast(int, v), 0x12f, 0xf, 0xf, false)); }
struct EpiUpGate {
    static constexpr bool PERM = true, AFTER_DRAIN = false;
    bf16_t* ACT; const float* SS; const float* bias; int ldb; const float* cw; float* HALO; PG8_LAS unsigned char* xb;
    __device__ __forceinline__ void operator()(f32x4 (&acc)[2][2][4][2], const Unit& u, int wr, int wc, int fr, int fq) const {
        asm volatile("" : "+v"(fr), "+v"(fq));
        const int cnd = u.pm < 32 ? 0 : 1 + ((u.pm - 32) >> 3);
        const bool samp = u.pm >= 32;
        const int j0 = u.pn * HALF + wc * 32 + 8 * fq;
        const int row0 = u.pm * BM + wr * 64 + fr;
        { const float* bp = bias + (size_t)cnd * ldb + j0;
          f32x4 bv[2][2];
#pragma unroll
          for (int bj = 0; bj < 2; ++bj)
#pragma unroll
              for (int n = 0; n < 2; ++n) bv[bj][n] = *(const f32x4*)(bp + bj * 2816 + 4 * n);
          float rsv[8]; row_scales(SS, row0, fr, fq, rsv);
#pragma unroll
          for (int ai = 0; ai < 2; ++ai)
#pragma unroll
              for (int m = 0; m < 4; ++m) { const float rs = rsv[ai * 4 + m];
#pragma unroll
                  for (int bj = 0; bj < 2; ++bj)
#pragma unroll
                      for (int n = 0; n < 2; ++n) acc[ai][bj][m][n] = acc[ai][bj][m][n] * rs + bv[bj][n]; } }
        PG8_LAS f32x4* WL = (PG8_LAS f32x4*)(xb + 8192);
        if (fr == 0) {
            f32x4 wt[2][2][3];
#pragma unroll
            for (int n = 0; n < 2; ++n)
#pragma unroll
                for (int bj = 0; bj < 2; ++bj)
#pragma unroll
                    for (int k = 0; k < 3; ++k) wt[n][bj][k] = *(const f32x4*)(cw + k * 5632 + bj * 2816 + j0 + 4 * n);
#pragma unroll
            for (int n = 0; n < 2; ++n)
#pragma unroll
                for (int bj = 0; bj < 2; ++bj)
#pragma unroll
                    for (int k = 0; k < 3; ++k) WL[((((wr * 4 + wc) * 4 + fq) * 2 + n) * 2 + bj) * 3 + k] = wt[n][bj][k];
        }
        PG8_LAS f32x4* XB = (PG8_LAS f32x4*)xb;
        const int wv = wr * 4 + wc, pw = (wr ^ 1) * 4 + wc;
        if (fr == 0) {
#pragma unroll
            for (int ai = 0; ai < 2; ++ai)
#pragma unroll
                for (int bj = 0; bj < 2; ++bj)
#pragma unroll
                    for (int n = 0; n < 2; ++n) XB[((wv * 4 + ai * 2) * 2 + bj) * 8 + 2 * fq + n] = acc[ai][bj][0][n]; }
        if (fr == 15) {
#pragma unroll
            for (int ai = 0; ai < 2; ++ai)
#pragma unroll
                for (int bj = 0; bj < 2; ++bj)
#pragma unroll
                    for (int n = 0; n < 2; ++n) XB[((wv * 4 + ai * 2 + 1) * 2 + bj) * 8 + 2 * fq + n] = acc[ai][bj][3][n]; }
        asm volatile("s_waitcnt lgkmcnt(0)" ::: "memory"); __builtin_amdgcn_s_barrier(); asm volatile("" ::: "memory");
        float* hb = HALO + (size_t)(samp ? u.pm - 32 : 0) * 4 * 5632;
#pragma unroll
        for (int ai = 0; ai < 2; ++ai) {
            const bool has_ab = !(wr == 0 && ai == 0), has_bl = !(wr == 1 && ai == 1);
            const int wab = (wr == 0) ? 1 : (ai == 0 ? 1 : 3), wbl = (wr == 0) ? (ai == 0 ? 0 : 2) : 2;
            unsigned pk[4][4];
#pragma unroll
            for (int n = 0; n < 2; ++n) {
                f32x4 ca[4];
#pragma unroll
                for (int bj = 0; bj < 2; ++bj) {
                    const PG8_LAS f32x4* wlp = WL + ((((wr * 4 + wc) * 4 + fq) * 2 + n) * 2 + bj) * 3;
                    const f32x4 w0 = wlp[0], w1 = wlp[1], w2 = wlp[2];
                    f32x4 ab = (f32x4){0.f, 0.f, 0.f, 0.f}, bl = ab;
                    if (has_ab) ab = XB[((pw * 4 + wab) * 2 + bj) * 8 + 2 * fq + n];
                    if (has_bl) bl = XB[((pw * 4 + wbl) * 2 + bj) * 8 + 2 * fq + n];
#pragma unroll
                    for (int m = 0; m < 4; ++m) {
                        f32x4 cvm;
#pragma unroll
                        for (int i = 0; i < 4; ++i) {
                            const float cur = acc[ai][bj][m][n][i];
                            const float pv = m == 0 ? ab[i] : acc[ai][bj][m == 0 ? 0 : m - 1][n][i];
                            const float nx = m == 3 ? bl[i] : acc[ai][bj][m == 3 ? 3 : m + 1][n][i];
                            const float up = dpp_ror1(fr == 15 ? pv : cur), dn = dpp_ror15(fr == 0 ? nx : cur);
                            cvm[i] = w0[i] * up + w1[i] * cur + w2[i] * dn;
                        }
                        if (samp) {
                            if (m == 0 && wr == 0 && ai == 0 && fr == 0) { *(f32x4*)(hb + 0 * 5632 + bj * 2816 + j0 + 4 * n) = acc[ai][bj][0][n]; *(f32x4*)(hb + 1 * 5632 + bj * 2816 + j0 + 4 * n) = cvm; }
                            if (m == 3 && wr == 1 && ai == 1 && fr == 15) { *(f32x4*)(hb + 2 * 5632 + bj * 2816 + j0 + 4 * n) = acc[ai][bj][3][n]; *(f32x4*)(hb + 3 * 5632 + bj * 2816 + j0 + 4 * n) = cvm; }
                        }
                        if (bj == 0) ca[m] = cvm;
                        else { float r[4];
#pragma unroll
                            for (int i = 0; i < 4; ++i) { const float xa = ca[m][i]; r[i] = xa * __builtin_amdgcn_rcpf(1.f + __builtin_amdgcn_exp2f(-xa * 1.4426950408889634f)) * cvm[i]; }
                            pk[m][2 * n] = cvt_pk_bf16(r[0], r[1]); pk[m][2 * n + 1] = cvt_pk_bf16(r[2], r[3]); }
                    }
                }
                __builtin_amdgcn_sched_barrier(0);
            }
#pragma unroll
            for (int m = 0; m < 4; ++m) *(u32x4*)(ACT + (size_t)(row0 + ai * HALF + m * 16) * 2816 + j0) = (u32x4){pk[m][0], pk[m][1], pk[m][2], pk[m][3]};
        }
    }
};

template <class Epi, class Sched, bool ALIGN_EPI = false, bool SP2 = false>
__device__ __forceinline__ void gemm_phase(PG8_LAS unsigned char* lds, const Gemm g, const Sched& S, const Epi& E, const int tid) {
    const int wid = __builtin_amdgcn_readfirstlane(tid >> 6), lane = tid & 63, wr = wid >> 2, wc = wid & 3, fr = lane & 15, fq = lane >> 4;
    const int K = g.K, nt = K / BK;
    unsigned voffA[2], voffB[2];
#pragma unroll
    for (int i = 0; i < 2; ++i) { int R, C; stage_rc(tid * 16 + i * 8192, R, C); const int Rb = Epi::PERM ? ((R & ~31) + perm32(R & 31)) : R;
        voffA[i] = (unsigned)(R * K + C) * 2u; voffB[i] = (unsigned)(Rb * K + C) * 2u; }
    const size_t kstep = (size_t)(BK * 2);
    const size_t hstep = (size_t)HALF * K * 2;
    const size_t tstep = 2 * hstep;
    const size_t bstep = g.bstep ? g.bstep : tstep, bh = g.bhalf ? g.bhalf : hstep;
    const unsigned ldsw = (unsigned)wid * 1024u;
    const int aoff = lds_byte(wr * 64 + fr, fq * 8), boff = lds_byte(wc * 32 + fr, fq * 8);
#define PG8_SA(b, h) (((b) * 2 + (h)) * HTB)
#define PG8_SB(b, h) ((4 + (b) * 2 + (h)) * HTB)
#define PG8_STAGE(bufoff, gbase, voff) do { _Pragma("unroll") for (int _i = 0; _i < 2; ++_i) \
        __builtin_amdgcn_global_load_lds((const unsigned*)((const char*)(gbase) + (voff)[_i]), (PG8_LAS unsigned*)(lds + (bufoff) + ldsw + _i * 8192), 16, 0, 0); } while (0)
#define PG8_LDA(dst, b, h) do { _Pragma("unroll") for (int m = 0; m < 4; ++m) _Pragma("unroll") for (int k = 0; k < 2; ++k) dst[m][k] = *(const PG8_LAS bf16x8*)(lds + PG8_SA(b, h) + aoff + m * 2048 + k * 1024); } while (0)
#define PG8_LDB(dst, b, h) do { _Pragma("unroll") for (int n = 0; n < 2; ++n) _Pragma("unroll") for (int k = 0; k < 2; ++k) dst[n][k] = *(const PG8_LAS bf16x8*)(lds + PG8_SB(b, h) + boff + n * 2048 + k * 1024); } while (0)
#define PG8_MMA(ai, bj, At, Bt) do { __builtin_amdgcn_s_setprio(1); _Pragma("unroll") for (int m = 0; m < 4; ++m) _Pragma("unroll") for (int n = 0; n < 2; ++n) _Pragma("unroll") for (int k = 0; k < 2; ++k) \
        acc[ai][bj][m][n] = __builtin_amdgcn_mfma_f32_16x16x32_bf16(Bt[n][k], At[m][k], acc[ai][bj][m][n], 0, 0, 0); __builtin_amdgcn_s_setprio(0); } while (0)
#define PG8_WAIT_V(n) asm volatile("s_waitcnt vmcnt(" #n ")" ::: "memory")
#define PG8_WAIT_L(n) asm volatile("s_waitcnt lgkmcnt(" #n ")" ::: "memory")
#define PG8_BAR __builtin_amdgcn_s_barrier()
#define PG8_SCHED __builtin_amdgcn_sched_barrier(0)
    Unit cur, nxt; int ui = 0;
    if (!S.next(0, cur)) return;
    f32x4 acc[2][2][4][2];
#pragma unroll
    for (int a = 0; a < 2; ++a)
#pragma unroll
        for (int b = 0; b < 2; ++b)
#pragma unroll
            for (int m = 0; m < 4; ++m)
#pragma unroll
                for (int n = 0; n < 2; ++n) acc[a][b][m][n] = (f32x4){0.f, 0.f, 0.f, 0.f};
    bf16x8 At[4][2], B0[2][2], B1[2][2];
    const char* cA = (const char*)g.A + (size_t)cur.pm * tstep; const char* cB = (const char*)g.Bt + (size_t)cur.pn * bstep;
    S.a_ready(cur);
    if constexpr (SP2) {
        PG8_STAGE(PG8_SB(0, 0), cB, voffB); PG8_STAGE(PG8_SB(0, 1), cB + bh, voffB); PG8_STAGE(PG8_SA(0, 0), cA, voffA); PG8_STAGE(PG8_SA(0, 1), cA + hstep, voffA);
        if (wr == 1) PG8_BAR;
        PG8_WAIT_V(2); PG8_BAR;
        PG8_STAGE(PG8_SB(1, 0), cB + kstep, voffB); PG8_STAGE(PG8_SA(1, 0), cA + kstep, voffA); PG8_STAGE(PG8_SB(1, 1), cB + bh + kstep, voffB);
        PG8_WAIT_V(6); PG8_BAR;
    } else {
        PG8_STAGE(PG8_SB(0, 0), cB, voffB); PG8_STAGE(PG8_SA(0, 0), cA, voffA); PG8_STAGE(PG8_SB(0, 1), cB + bh, voffB); PG8_STAGE(PG8_SA(0, 1), cA + hstep, voffA);
        if (wr == 1) PG8_BAR;
        PG8_WAIT_V(4); PG8_BAR;
        PG8_STAGE(PG8_SB(1, 0), cB + kstep, voffB); PG8_STAGE(PG8_SA(1, 0), cA + kstep, voffA); PG8_STAGE(PG8_SB(1, 1), cB + bh + kstep, voffB);
        PG8_WAIT_V(6); PG8_BAR;
    }
    for (;;) {
        const bool has_next = S.next(ui + 1, nxt);
        const char* nA = has_next ? (const char*)g.A + (size_t)nxt.pm * tstep : cA; const char* nB = has_next ? (const char*)g.Bt + (size_t)nxt.pn * bstep : cB;
        for (int t = 0; t < nt; t += 2) {
            const bool last = (t == nt - 2);
            const char* a1 = cA + (size_t)(t + 1) * kstep;
            const char* a2 = last ? nA : cA + (size_t)(t + 2) * kstep; const char* b2 = last ? nB : cB + (size_t)(t + 2) * kstep;
            const char* a3 = a2 + kstep; const char* b3 = b2 + kstep;
            if (last && has_next) S.a_ready(nxt);
            if constexpr (SP2) {
            PG8_LDB(B0, 0, 0); PG8_LDB(B1, 0, 1); PG8_SCHED; PG8_LDA(At, 0, 0); PG8_STAGE(PG8_SA(1, 1), a1 + hstep, voffA);
            PG8_WAIT_V(8); PG8_WAIT_L(0); PG8_BAR; PG8_MMA(0, 0, At, B0); PG8_MMA(0, 1, At, B1); PG8_BAR; PG8_SCHED;
            PG8_LDA(At, 0, 1); PG8_STAGE(PG8_SB(0, 0), b2, voffB); PG8_STAGE(PG8_SB(0, 1), b2 + bh, voffB); PG8_STAGE(PG8_SA(0, 0), a2, voffA);
            PG8_WAIT_V(8); PG8_WAIT_L(0); PG8_BAR; PG8_MMA(1, 0, At, B0); PG8_MMA(1, 1, At, B1); PG8_BAR; PG8_SCHED;
            PG8_LDB(B0, 1, 0); PG8_LDB(B1, 1, 1); PG8_SCHED; PG8_LDA(At, 1, 0); PG8_STAGE(PG8_SA(0, 1), a2 + hstep, voffA);
            PG8_WAIT_V(8); PG8_WAIT_L(0); PG8_BAR; PG8_MMA(0, 0, At, B0); PG8_MMA(0, 1, At, B1); PG8_BAR; PG8_SCHED;
            PG8_LDA(At, 1, 1); PG8_STAGE(PG8_SB(1, 0), b3, voffB); PG8_STAGE(PG8_SB(1, 1), b3 + bh, voffB); PG8_STAGE(PG8_SA(1, 0), a3, voffA);
            PG8_WAIT_V(8); PG8_WAIT_L(0); PG8_BAR; PG8_MMA(1, 0, At, B0); PG8_MMA(1, 1, At, B1); PG8_BAR; PG8_SCHED;
            } else {
            PG8_LDB(B0, 0, 0); PG8_SCHED; PG8_LDA(At, 0, 0); PG8_STAGE(PG8_SA(1, 1), a1 + hstep, voffA);
            PG8_WAIT_L(8); PG8_BAR; PG8_WAIT_L(0); PG8_MMA(0, 0, At, B0); PG8_BAR; PG8_SCHED;
            PG8_LDB(B1, 0, 1); PG8_STAGE(PG8_SB(0, 0), b2, voffB);
            PG8_BAR; PG8_WAIT_L(0); PG8_MMA(0, 1, At, B1); PG8_BAR;
            PG8_LDA(At, 0, 1); PG8_STAGE(PG8_SA(0, 0), a2, voffA);
            PG8_BAR; PG8_WAIT_L(0); PG8_MMA(1, 0, At, B0); PG8_BAR; PG8_SCHED;
            PG8_STAGE(PG8_SB(0, 1), b2 + bh, voffB);
            PG8_WAIT_V(6); PG8_BAR; PG8_MMA(1, 1, At, B1); PG8_BAR;
            PG8_LDB(B0, 1, 0); PG8_SCHED; PG8_LDA(At, 1, 0); PG8_STAGE(PG8_SA(0, 1), a2 + hstep, voffA);
            PG8_WAIT_L(8); PG8_BAR; PG8_WAIT_L(0); PG8_MMA(0, 0, At, B0); PG8_BAR; PG8_SCHED;
            PG8_LDB(B1, 1, 1); PG8_STAGE(PG8_SB(1, 0), b3, voffB);
            PG8_BAR; PG8_WAIT_L(0); PG8_MMA(0, 1, At, B1); PG8_BAR;
            PG8_LDA(At, 1, 1); PG8_STAGE(PG8_SA(1, 0), a3, voffA);
            PG8_BAR; PG8_WAIT_L(0); PG8_MMA(1, 0, At, B0); PG8_BAR; PG8_SCHED;
            PG8_STAGE(PG8_SB(1, 1), b3 + bh, voffB);
            PG8_WAIT_V(6); PG8_BAR; PG8_MMA(1, 1, At, B1); PG8_BAR;
            }
        }
        if constexpr (ALIGN_EPI) { if (wr == 0) PG8_BAR; }
        if constexpr (!Epi::AFTER_DRAIN) { E(acc, cur, wr, wc, fr, fq); S.done(cur); }
        if (!has_next) break;
#pragma unroll
        for (int a = 0; a < 2; ++a)
#pragma unroll
            for (int b = 0; b < 2; ++b)
#pragma unroll
                for (int m = 0; m < 4; ++m)
#pragma unroll
                    for (int n = 0; n < 2; ++n) acc[a][b][m][n] = (f32x4){0.f, 0.f, 0.f, 0.f};
        cur = nxt; cA = nA; cB = nB; ++ui;
        if constexpr (ALIGN_EPI) { if (wr == 1) PG8_BAR; }
    }
    PG8_WAIT_V(0);
    if constexpr (!ALIGN_EPI) { if (wr == 0) PG8_BAR; }
    PG8_BAR;
#undef PG8_SA
#undef PG8_SB
#undef PG8_STAGE
#undef PG8_LDA
#undef PG8_LDB
#undef PG8_MMA
#undef PG8_WAIT_V
#undef PG8_WAIT_L
#undef PG8_BAR
#undef PG8_SCHED
}
}

#define LAS __attribute__((address_space(3)))
#define CAS __attribute__((address_space(4)))
typedef unsigned short bf16;
typedef float f32x4 __attribute__((ext_vector_type(4)));
typedef short bf16x8 __attribute__((ext_vector_type(8)));
typedef unsigned u32x4 __attribute__((ext_vector_type(4)));
typedef unsigned u32x2 __attribute__((ext_vector_type(2)));

constexpr int NW = 8, NT = 512;
constexpr int DM = 1024, NTOK = 12288, NPR = 8192, NKR = 13312, INC = 2144, INP = 2304, DFF = 2816, DUP = 5632;
constexpr float EPS = 1e-6f, LOG2E = 1.4426950408889634f;
constexpr float QS = 0.125f * LOG2E;
constexpr float MLAQS = 0.10206207261596575f * LOG2E;

constexpr size_t MiB = 1u << 20;
constexpr size_t WS_CTL = 0, WS_MOD = 1 * MiB, WS_ROPE = 1 * MiB + 256 * 1024, WS_W = 2 * MiB, W_LSTRIDE = 24 * MiB;
constexpr size_t W_IN = 0, W_OUT = 4718592, W_UP = W_OUT + 2097152, W_DOWN = W_UP + 11534336, W_B2 = W_DOWN + 5767168;
static_assert(W_B2 + 786432 <= W_LSTRIDE, "weights");
constexpr size_t WS_XN = 50 * MiB, WS_PROJ = 74 * MiB, WS_A2 = 128 * MiB, WS_MQKV = 138 * MiB, WS_QC = 164 * MiB, WS_KPE = 203 * MiB, WS_YCAT = 204 * MiB;
constexpr size_t WS_ACT = 116 * MiB, WS_U = 116 * MiB, WS_SS1 = 228 * MiB, WS_SS2 = 229 * MiB, WS_HALO = 230 * MiB, WS_XRES = 232 * MiB, WS_END = 256 * MiB;
constexpr size_t WS_BIAS = 65536;
constexpr int NBIAS = 2304 + 5632;
constexpr size_t QSZ = (size_t)NKR * 256 * 2, KSZ = (size_t)NKR * 128 * 2;
constexpr int LDS_BYTES = 163840, LDS_CTL = 163840 - 256;
constexpr size_t WS_BAR = 16384;

struct Args { const float* in[28]; float* out; unsigned char* ws; };

__device__ __forceinline__ unsigned f2bf(float f) { unsigned u = __builtin_bit_cast(unsigned, f); return (u + 0x7fffu + ((u >> 16) & 1u)) >> 16; }
__device__ __forceinline__ unsigned pk2(float lo, float hi) { unsigned r; asm("v_cvt_pk_bf16_f32 %0, %1, %2" : "=v"(r) : "v"(lo), "v"(hi)); return r; }
__device__ __forceinline__ float bflo(unsigned u) { return __builtin_bit_cast(float, u << 16); }
__device__ __forceinline__ float bfhi(unsigned u) { return __builtin_bit_cast(float, u & 0xffff0000u); }
__device__ __forceinline__ f32x4 ld4bf(const bf16* p) { const u32x2 u = *(const u32x2*)p; return (f32x4){bflo(u.x), bfhi(u.x), bflo(u.y), bfhi(u.y)}; }
__device__ __forceinline__ void st4bf(bf16* p, f32x4 v) { u32x2 u; u.x = pk2(v[0], v[1]); u.y = pk2(v[2], v[3]); *(u32x2*)p = u; }
__device__ __forceinline__ float shx(float v, int m, int lane) { return __builtin_bit_cast(float, __builtin_amdgcn_ds_bpermute((lane ^ m) << 2, __builtin_bit_cast(int, v))); }
#define DPPF(v, ctrl) __builtin_bit_cast(float, __builtin_amdgcn_mov_dpp(__builtin_bit_cast(int, (v)), (ctrl), 0xf, 0xf, false))
__device__ __forceinline__ float sum16(float v, int) { v += DPPF(v, 0x121); v += DPPF(v, 0x122); v += DPPF(v, 0x124); v += DPPF(v, 0x128); return v; }
__device__ __forceinline__ float wave_sum(float v, int lane) {
    v = sum16(v, lane);
    const int iv = __builtin_bit_cast(int, v);
    const float a = __builtin_bit_cast(float, __builtin_amdgcn_readlane(iv, 0)), b = __builtin_bit_cast(float, __builtin_amdgcn_readlane(iv, 16)),
                c = __builtin_bit_cast(float, __builtin_amdgcn_readlane(iv, 32)), d = __builtin_bit_cast(float, __builtin_amdgcn_readlane(iv, 48));
    return (a + b) + (c + d);
}
__device__ __forceinline__ float dot4(f32x4 a) { return (a[0] * a[0] + a[1] * a[1]) + (a[2] * a[2] + a[3] * a[3]); }
__device__ __forceinline__ f32x4 shfl4(f32x4 v, int m, int lane) { return (f32x4){shx(v[0], m, lane), shx(v[1], m, lane), shx(v[2], m, lane), shx(v[3], m, lane)}; }

__device__ __forceinline__ void transpose_item(const float* W, int N, bf16* WT, int ldk, int row_off, int k_off, float scale, LAS float* scr, int item, int lane) {
    const int nblk = (N + 63) / 64, kb = item / nblk, nb = item % nblk, k0 = 64 * kb, n0 = 64 * nb;
    const bool act = n0 + lane < N;
    const float* wp = W + (size_t)k0 * N + n0 + lane;
    float v[64];
#pragma unroll
    for (int i = 0; i < 64; ++i) v[i] = act ? __builtin_nontemporal_load(wp + (size_t)i * N) : 0.f;
#pragma unroll
    for (int i = 0; i < 64; ++i) scr[i * 65 + lane] = v[i] * scale;
    asm volatile("s_waitcnt lgkmcnt(0)" ::: "memory");
    const int c = lane & 7;
#pragma unroll
    for (int j = 0; j < 8; ++j) { const int n = (lane >> 3) + 8 * j; const LAS float* s = scr + (8 * c) * 65 + n;
        u32x4 o; o.x = pk2(s[0 * 65], s[1 * 65]); o.y = pk2(s[2 * 65], s[3 * 65]); o.z = pk2(s[4 * 65], s[5 * 65]); o.w = pk2(s[6 * 65], s[7 * 65]);
        if (n0 + n < N) *(u32x4*)(WT + (size_t)(row_off + n0 + n) * ldk + k_off + k0 + 8 * c) = o; }
    asm volatile("s_waitcnt lgkmcnt(0)" ::: "memory");
}

template <class ArgsRef>
__device__ __forceinline__ void wconv(const ArgsRef& a, unsigned char* ws, int l, int sel, int w, int nwk, LAS float* scr, int lane) {
    constexpr int I_IN = 16 * 34, I_OUT = 16 * 16, I_UP = 16 * 88, I_DN = 44 * 16, I_Q = 3 * 6, I_KV = 2 * 8;
    const int n_in = (sel & 1) ? I_IN : 0, n_out = (sel & 2) ? I_OUT : 0, n_up = (sel & 4) ? I_UP : 0, n_dn = (sel & 8) ? I_DN : 0, n_q = (sel & 16) ? I_Q : 0, n_kv = (sel & 32) ? I_KV : 0;
    const int total = n_in + n_out + n_up + n_dn + n_q + n_kv;
    unsigned char* wl = ws + WS_W + l * W_LSTRIDE;
    for (int it = w; it < total; it += nwk) {
        int r = it;
        if (r < n_in) { transpose_item(a.in[13] + (size_t)l * 1024 * INC, INC, (bf16*)(wl + W_IN), 1024, 0, 0, 1.f, scr, r, lane); continue; } r -= n_in;
        if (r < n_out) { transpose_item(a.in[22] + (size_t)l * 1024 * 1024, 1024, (bf16*)(wl + W_OUT), 1024, 0, 0, 1.f, scr, r, lane); continue; } r -= n_out;
        if (r < n_up) { transpose_item(a.in[24] + (size_t)l * 1024 * DUP, DUP, (bf16*)(wl + W_UP), 1024, 0, 0, 1.f, scr, r, lane); continue; } r -= n_up;
        if (r < n_dn) { transpose_item(a.in[26] + (size_t)l * DFF * 1024, 1024, (bf16*)(wl + W_DOWN), DFF, 0, 0, 1.f, scr, r, lane); continue; } r -= n_dn;
        if (r < n_q) { transpose_item(a.in[16] + (size_t)l * 192 * 384, 384, (bf16*)(wl + W_B2), 384, 0, 0, MLAQS, scr, r, lane); continue; } r -= n_q;
        transpose_item(a.in[18] + (size_t)l * 128 * 512, 512, (bf16*)(wl + W_B2), 384, 384, 192, 1.f, scr, r, lane);
    }
}
template <class ArgsRef>
__device__ __forceinline__ void phase0(const ArgsRef& a, LAS unsigned char* lds, int tid, int lane, int wave) {
    unsigned char* ws = a.ws;
    const int G = gridDim.x, bid = blockIdx.x;
    if (bid < 96) {
        LAS float* sl = (LAS float*)(lds + 16384);
        for (int e = tid; e < 3072; e += NT) { const int c = e >> 10, k = e & 1023; const float v = c == 0 ? a.in[9][k] : a.in[8][(c - 1) * 1024 + k]; sl[e] = v / (1.f + __expf(-v)); }
        __syncthreads();
    }
    for (int it = bid; it < 96; it += G) {
        const int l = it / 48, n0 = (it % 48) * 128;
        const float* wa = a.in[10] + (size_t)l * 1024 * 6144;
        const LAS float* sl = (const LAS float*)(lds + 16384);
        float acc[3][2] = {{0.f, 0.f}, {0.f, 0.f}, {0.f, 0.f}};
        const int kb = wave * 128;
#pragma unroll 16
        for (int k = 0; k < 128; ++k) {
            const int kk = kb + k;
            typedef float f32x2_ __attribute__((ext_vector_type(2)));
            const f32x2_ w = __builtin_nontemporal_load((const f32x2_*)(wa + (size_t)kk * 6144 + n0 + 2 * lane));
            const float s0 = sl[kk], s1 = sl[1024 + kk], s2 = sl[2048 + kk];
            acc[0][0] += s0 * w.x; acc[0][1] += s0 * w.y; acc[1][0] += s1 * w.x; acc[1][1] += s1 * w.y; acc[2][0] += s2 * w.x; acc[2][1] += s2 * w.y;
        }
        LAS float* red = (LAS float*)lds;
#pragma unroll
        for (int c = 0; c < 3; ++c) { red[(wave * 3 + c) * 128 + 2 * lane] = acc[c][0]; red[(wave * 3 + c) * 128 + 2 * lane + 1] = acc[c][1]; }
        __syncthreads();
        if (tid < 384) { const int c = tid / 128, n = tid % 128; float s = 0.f;
#pragma unroll
            for (int w = 0; w < 8; ++w) s += red[(w * 3 + c) * 128 + n];
            ((float*)(ws + WS_MOD))[(size_t)(l * 3 + c) * 6144 + n0 + n] = s + a.in[11][(size_t)l * 6144 + n0 + n]; }
        __syncthreads();
    }
    if (bid == G - 1) {
        float* rt = (float*)(ws + WS_ROPE);
        for (int e = tid; e < 1024; e += NT) { const int pos = e >> 4, i = e & 15; const float inv = exp2f(-(float)(2 * i) / 32.f * 13.287712379549449f); const float ang = (float)pos * inv;
            rt[e] = __cosf(ang); rt[1024 + e] = __sinf(ang); }
        for (int e = tid; e < 512; e += NT) { const int pos = e >> 3, i = e & 7; const float inv = exp2f(-(float)(2 * i) / 16.f * 13.287712379549449f); const float ang = (float)pos * inv;
            rt[2048 + e] = __cosf(ang); rt[2560 + e] = __sinf(ang); }
    }
    const int gt = bid * NT + tid, NGT = G * NT;
    if (gt < 256) ((unsigned*)(ws + WS_CTL))[gt] = 0u;
    if (gt < 64) ((unsigned*)(ws + WS_CTL))[2048 + gt] = 0u;
    for (int l = 0; l < 2; ++l) {
        bf16* b2 = (bf16*)(ws + WS_W + l * W_LSTRIDE + W_B2);
        for (int ch = gt; ch < 1024 * 48; ch += NGT) { const int n = ch / 48, k = (ch % 48) * 8;
            const bool data = (n < 384 && k < 192) || (n >= 384 && n < 896 && k >= 192 && k < 320);
            if (!data) *(u32x4*)(b2 + (size_t)n * 384 + k) = (u32x4){0u, 0u, 0u, 0u}; }
        bf16* wi = (bf16*)(ws + WS_W + l * W_LSTRIDE + W_IN) + (size_t)INC * 1024;
        for (int ch = gt; ch < 160 * 128; ch += NGT) *(u32x4*)(wi + (size_t)ch * 8) = (u32x4){0u, 0u, 0u, 0u};
    }
    LAS float* scr = (LAS float*)(lds + 28672 + wave * 16640);
    wconv(a, ws, 0, 1 | 2 | 16 | 32, bid * NW + wave, G * NW, scr, lane);
}

__device__ __forceinline__ void prep_phase(const float* x0, const float* x1, const float* nw, const float* mod, int sc_off, bf16* XN, float* SS, int lane, int gw, int NGW) {
    for (int row = gw; row < NTOK; row += NGW) {
        const float* xr = row < NPR ? x0 + (size_t)row * DM : x1 + (size_t)(row - NPR) * DM;
        const int c = row < NPR ? 0 : 1 + ((row - NPR) >> 11);
        const float* mp = mod + c * 6144;
        f32x4 v[4]; float ss = 0.f;
#pragma unroll
        for (int j = 0; j < 4; ++j) { v[j] = __builtin_nontemporal_load((const f32x4*)(xr + 4 * (lane + 64 * j))); ss += dot4(v[j]); }
        ss = wave_sum(ss, lane);
#pragma unroll
        for (int j = 0; j < 4; ++j) { const int col = 4 * (lane + 64 * j);
            const f32x4 g = *(const f32x4*)(nw + col), sc = *(const f32x4*)(mp + sc_off + col);
            st4bf(XN + (size_t)row * DM + col, v[j] * g * (1.f + sc)); }
        if (lane < 16) SS[(size_t)row * 16 + lane] = lane == 0 ? ss : 0.f;
    }
}
template <class ArgsRef>
__device__ __forceinline__ void bias_phase(const ArgsRef& a, unsigned char* ws, LAS unsigned char* lds, int tid, int lane, int wave) {
    const float* mod = (const float*)(ws + WS_MOD);
    float* BIAS = (float*)(ws + WS_BIAS);
    for (int it = blockIdx.x; it < 62; it += gridDim.x) {
        const int l = it / 31, r = it % 31; const bool up = r >= 9;
        const int N = up ? DUP : INC, n0 = (up ? r - 9 : r) * 256 + 4 * lane;
        const float* W = up ? a.in[24] + (size_t)l * 1024 * DUP : a.in[13] + (size_t)l * 1024 * INC;
        const float* shp = mod + (size_t)l * 3 * 6144 + (up ? 3072 : 0);
        LAS float* sl = (LAS float*)(lds + 32768);
        for (int e = tid; e < 3072; e += NT) sl[e] = shp[(e >> 10) * 6144 + (e & 1023)];
        __syncthreads();
        const bool act = n0 < N;
        f32x4 acc[3] = {(f32x4){0.f, 0.f, 0.f, 0.f}, (f32x4){0.f, 0.f, 0.f, 0.f}, (f32x4){0.f, 0.f, 0.f, 0.f}};
        const int kb = wave * 128;
#pragma unroll 16
        for (int k = 0; k < 128; ++k) { const int kk = kb + k;
            const f32x4 w = act ? __builtin_nontemporal_load((const f32x4*)(W + (size_t)kk * N + n0)) : (f32x4){0.f, 0.f, 0.f, 0.f};
            acc[0] += w * sl[kk]; acc[1] += w * sl[1024 + kk]; acc[2] += w * sl[2048 + kk]; }
        LAS f32x4* red = (LAS f32x4*)lds;
#pragma unroll
        for (int c = 0; c < 3; ++c) red[(wave * 3 + c) * 64 + lane] = acc[c];
        __syncthreads();
        if (tid < 192) { const int c = tid >> 6, ln = tid & 63; f32x4 t = red[c * 64 + ln];
#pragma unroll
            for (int w = 1; w < 8; ++w) t += red[(w * 3 + c) * 64 + ln];
            const int nn = (up ? r - 9 : r) * 256 + 4 * ln;
            if (nn < N) *(f32x4*)(BIAS + (size_t)(l * 3 + c) * NBIAS + (up ? 2304 : 0) + nn) = t;
            else if (!up && nn < 2304) *(f32x4*)(BIAS + (size_t)(l * 3 + c) * NBIAS + nn) = (f32x4){0.f, 0.f, 0.f, 0.f}; }
        __syncthreads();
    }
}

struct P3Ptrs {
    const bf16* PROJ; bf16 *A2, *KPE, *YCAT, *Qc_rot, *Qc_raw, *Kc, *Vc, *Qd_rot, *Qd_raw, *Kd, *Vd;
    const float *conv_a, *gq_mla, *gkv_mla, *gq, *gk, *rope;
    const float *c_ckv, *c_kpe, *c_gk, *c_gv, *c_sk, *c_sv;
    float *o_ckv, *o_kpe, *o_gk, *o_gv, *o_sk, *o_sv;
    int l;
};
__device__ __forceinline__ f32x4 rope64(f32x4 v, int jl, int prow, int pcol, const float* rt, int lane) {
    const f32x4 pr = shfl4(v, 4, lane);
    const int pos = jl < 8 ? prow : pcol, fi = 4 * (jl & 3);
    const f32x4 c = *(const f32x4*)(rt + pos * 16 + fi), s = *(const f32x4*)(rt + 1024 + pos * 16 + fi);
    const float sg = (jl & 4) ? 1.f : -1.f;
    return v * c + pr * s * sg;
}
__device__ __forceinline__ void p3_phase(const P3Ptrs& P, int lane, int gw, int NGW) {
    const int l = P.l;
    for (int row = gw; row < NKR; row += NGW) {
        if (row < NTOK) {
            const bool samp = row >= NPR;
            int b, t, kr, T;
            if (!samp) { b = row >> 8; t = row & 255; kr = row; T = 256; } else { b = (row - NPR) >> 11; t = (row - NPR) & 2047; kr = NPR + b * 2560 + t; T = 2048; }
            const int prow = t >> 6, pcol = t & 63;
            const bf16* pr = P.PROJ + (size_t)row * INP;
            const size_t ob = (size_t)((b * 2 + l) * 256 + t);
            const int ci = 4 * lane, jl = lane & 15;
            const u32x2 z2 = (u32x2){0u, 0u};
            const bool hp = t > 0, hn = t < T - 1;
            const u32x2 r_xa = *(const u32x2*)(pr + ci), r_gb = *(const u32x2*)(pr + 256 + ci), r_gc = *(const u32x2*)(pr + 512 + ci);
            const u32x2 r_pxa = hp ? *(const u32x2*)(pr - INP + ci) : z2, r_pgc = hp ? *(const u32x2*)(pr - INP + 512 + ci) : z2;
            const u32x2 r_nxa = hn ? *(const u32x2*)(pr + INP + ci) : z2, r_ngc = hn ? *(const u32x2*)(pr + INP + 512 + ci) : z2;
            const u32x2 r_cq = lane < 48 ? *(const u32x2*)(pr + 768 + ci) : z2, r_ckv = lane < 32 ? *(const u32x2*)(pr + 960 + ci) : z2, r_kpe = lane < 8 ? *(const u32x2*)(pr + 1088 + ci) : z2;
            const u32x2 r_qc = *(const u32x2*)(pr + 1120 + ci), r_kvc = *(const u32x2*)(pr + 1376 + ci), r_qd = *(const u32x2*)(pr + 1632 + ci), r_kvd = *(const u32x2*)(pr + 1888 + ci);
            const float* cw = P.conv_a + (size_t)l * 768;
            const f32x4 w0 = *(const f32x4*)(cw + ci), w1 = *(const f32x4*)(cw + 256 + ci), w2 = *(const f32x4*)(cw + 512 + ci);
            const f32x4 g_qm = lane < 48 ? *(const f32x4*)(P.gq_mla + l * 192 + ci) : (f32x4){0.f, 0.f, 0.f, 0.f}, g_kvm = lane < 32 ? *(const f32x4*)(P.gkv_mla + l * 128 + ci) : (f32x4){0.f, 0.f, 0.f, 0.f};
            const f32x4 g_q = *(const f32x4*)(P.gq + l * 64 + 4 * jl), g_k = *(const f32x4*)(P.gk + l * 64 + 4 * jl);
            const int pos64 = jl < 8 ? prow : pcol, fi64 = 4 * (jl & 3);
            const f32x4 c64 = *(const f32x4*)(P.rope + pos64 * 16 + fi64), s64 = *(const f32x4*)(P.rope + 1024 + pos64 * 16 + fi64);
            const int pos32 = (lane & 7) < 4 ? prow : pcol, fi32 = 4 * (lane & 1);
            const f32x4 c32 = *(const f32x4*)(P.rope + 2048 + pos32 * 8 + fi32), s32 = *(const f32x4*)(P.rope + 2560 + pos32 * 8 + fi32);
#define CV4(u) ((f32x4){bflo((u).x), bfhi((u).x), bflo((u).y), bfhi((u).y)})
#define ROPE64(v) ((v) * c64 + shfl4((v), 4, lane) * s64 * ((jl & 4) ? 1.f : -1.f))
            { const f32x4 ya = CV4(r_gb) * (w0 * (CV4(r_pxa) * CV4(r_pgc)) + w1 * (CV4(r_xa) * CV4(r_gc)) + w2 * (CV4(r_nxa) * CV4(r_ngc)));
              st4bf(P.YCAT + (size_t)row * DM + ci, ya); }
            { const f32x4 v = CV4(r_cq);
              const float rs = rsqrtf(wave_sum(dot4(v), lane) * (1.f / 192.f) + EPS);
              if (lane < 48) st4bf(P.A2 + (size_t)kr * 384 + ci, v * rs * g_qm); }
            { const f32x4 v = CV4(r_ckv);
              const float rs = rsqrtf(wave_sum(dot4(v), lane) * (1.f / 128.f) + EPS);
              if (lane < 32) { const f32x4 o = v * rs * g_kvm;
                  st4bf(P.A2 + (size_t)kr * 384 + 192 + ci, o);
                  if (!samp) __builtin_nontemporal_store((f32x4)(o), (f32x4*)(P.o_ckv + ob * 128 + ci)); }
              else if (lane < 48) { unsigned zz = 0u; asm volatile("" : "+v"(zz)); *(u32x2*)(P.A2 + (size_t)kr * 384 + 320 + 4 * (lane - 32)) = (u32x2){zz, zz}; } }
            { const f32x4 v = CV4(r_kpe);
              const f32x4 r = v * c32 + shfl4(v, 2, lane) * s32 * ((lane & 2) ? 1.f : -1.f);
              if (lane < 8) { if (!samp) __builtin_nontemporal_store((f32x4)(v), (f32x4*)(P.o_kpe + ob * 32 + ci)); st4bf(P.KPE + (size_t)kr * 32 + ci, samp ? r : v); } }
            { f32x4 v = CV4(r_qc);
              const float rs = rsqrtf(sum16(dot4(v), lane) * (1.f / 64.f) + EPS);
              v = v * rs * g_q;
              st4bf(P.Qc_raw + (size_t)kr * 256 + ci, v * QS);
              const f32x4 r = ROPE64(v);
              if (samp) st4bf(P.Qc_rot + (size_t)kr * 256 + ci, r * QS); }
            { const f32x4 v = CV4(r_kvc);
              const float rs = rsqrtf(sum16(dot4(v), lane) * (1.f / 64.f) + EPS);
              const f32x4 kn = v * rs * g_k;
              const f32x4 r = ROPE64(kn);
              if (lane < 32) { if (!samp) __builtin_nontemporal_store((f32x4)(kn), (f32x4*)(P.o_gk + ob * 128 + ci)); st4bf(P.Kc + (size_t)kr * 128 + ci, samp ? r : kn); }
              else { if (!samp) __builtin_nontemporal_store((f32x4)(v), (f32x4*)(P.o_gv + ob * 128 + 4 * (lane - 32))); st4bf(P.Vc + (size_t)kr * 128 + 4 * (lane - 32), v); } }
            { const f32x4 v = CV4(r_qd);
              st4bf(P.Qd_raw + (size_t)kr * 256 + ci, v * QS);
              const f32x4 r = ROPE64(v);
              if (samp) st4bf(P.Qd_rot + (size_t)kr * 256 + ci, r * QS); }
            { const f32x4 v = CV4(r_kvd);
              const f32x4 r = ROPE64(v);
              if (lane < 32) { if (!samp) __builtin_nontemporal_store((f32x4)(v), (f32x4*)(P.o_sk + ob * 128 + ci)); st4bf(P.Kd + (size_t)kr * 128 + ci, samp ? r : v); }
              else { if (!samp) __builtin_nontemporal_store((f32x4)(v), (f32x4*)(P.o_sv + ob * 128 + 4 * (lane - 32))); st4bf(P.Vd + (size_t)kr * 128 + 4 * (lane - 32), v); } }
#undef CV4
#undef ROPE64
        } else {
            const int ci = row - NTOK, b = ci >> 9, j = ci & 511, kr = NPR + b * 2560 + 2048 + j;
            const size_t cb = (size_t)((b * 2 + l) * 512 + j);
            f32x4 z = (f32x4){0.f, 0.f, 0.f, 0.f}; asm volatile("" : "+v"(z));
            if (lane < 48) st4bf(P.A2 + (size_t)kr * 384 + 4 * lane, z);
            if (lane < 32) st4bf(P.A2 + (size_t)kr * 384 + 192 + 4 * lane, *(const f32x4*)(P.c_ckv + cb * 128 + 4 * lane));
            else if (lane < 48) st4bf(P.A2 + (size_t)kr * 384 + 320 + 4 * (lane - 32), z);
            if (lane < 8) st4bf(P.KPE + (size_t)kr * 32 + 4 * lane, *(const f32x4*)(P.c_kpe + cb * 32 + 4 * lane));
            if (lane < 32) { st4bf(P.Kc + (size_t)kr * 128 + 4 * lane, *(const f32x4*)(P.c_gk + cb * 128 + 4 * lane));
                             st4bf(P.Kd + (size_t)kr * 128 + 4 * lane, *(const f32x4*)(P.c_sk + cb * 128 + 4 * lane)); }
            else { st4bf(P.Vc + (size_t)kr * 128 + 4 * (lane - 32), *(const f32x4*)(P.c_gv + cb * 128 + 4 * (lane - 32)));
                   st4bf(P.Vd + (size_t)kr * 128 + 4 * (lane - 32), *(const f32x4*)(P.c_sv + cb * 128 + 4 * (lane - 32))); }
        }
    }
}

struct AttnSrc {
    const bf16* Qraw; const bf16* Qrot; int qpitch;
    const bf16* K0; int k0pitch; const bf16* K1;
    const bf16* V; int vpitch;
    bf16* Y; int outcol;
    int krbase, rowbase, q0, lo, hi, nctx;
    bool samp, window; float m0; bool sink;
    const float* rope;
};
template <int DK>
__device__ __forceinline__ void attn_unit(const AttnSrc& S, LAS unsigned char* lds, int tid, int lane, int wave, unsigned* ctr, unsigned& nxt_u) {
    constexpr int TK = 128, NKB = TK / 16, NPP = TK / 32;
    constexpr int KP = DK + 8, VP = TK + 8, KS = DK / 32, CPK = DK / 8;
    constexpr int NKC = TK * CPK / NT, NVC = TK * 8 / NT;
    LAS bf16* Ks = (LAS bf16*)lds;
    LAS bf16* Vt = (LAS bf16*)(lds + 2 * TK * KP * 2);
    const int g = lane >> 4, fr = lane & 15;
    const int qpos = S.q0 + wave * 16 + fr;
    const size_t qkr = (size_t)(S.krbase + qpos);
    bf16x8 qraw[KS], qrot[KS];
#pragma unroll
    for (int ks = 0; ks < KS; ++ks) { qraw[ks] = *(const bf16x8*)(S.Qraw + qkr * S.qpitch + ks * 32 + g * 8); qrot[ks] = qraw[ks]; }
    if (S.samp) {
        if (DK == 96) {
            const bf16x8 own = qraw[KS - 1], par = *(const bf16x8*)(S.Qraw + qkr * S.qpitch + 64 + (g ^ 1) * 8);
            const int pos = g < 2 ? (qpos >> 6) : (qpos & 63);
            const float sg = (g & 1) ? 1.f : -1.f;
            const float* ct = S.rope + 2048 + pos * 8; const float* st = S.rope + 2560 + pos * 8;
            bf16x8 r;
#pragma unroll
            for (int e = 0; e < 8; ++e) { const float o = bflo((unsigned)(unsigned short)own[e]), p = bflo((unsigned)(unsigned short)par[e]);
                r[e] = (short)f2bf(o * ct[e] + p * st[e] * sg); }
            qrot[KS - 1] = r;
        } else {
#pragma unroll
            for (int ks = 0; ks < KS; ++ks) qrot[ks] = *(const bf16x8*)(S.Qrot + qkr * S.qpitch + ks * 32 + g * 8);
        }
    }
    bf16x8 qc[KS];
#pragma unroll
    for (int ks = 0; ks < KS; ++ks) qc[ks] = S.samp ? qrot[ks] : qraw[ks];
    float m = S.m0, l = (S.sink && g == 0) ? 1.f : 0.f;
    f32x4 o[4];
#pragma unroll
    for (int d = 0; d < 4; ++d) o[d] = (f32x4){0.f, 0.f, 0.f, 0.f};
    const int nloc = S.hi - S.lo, ntile = nloc + S.nctx;
    u32x4 kreg[NKC], vreg[NVC];
    auto gload = [&](int j) {
        const int tile = j < nloc ? S.lo + j : (2048 / TK) + (j - nloc);
        const size_t kr = (size_t)(S.krbase + tile * TK);
#pragma unroll
        for (int c = 0; c < NKC; ++c) { const int ch = tid + c * NT, key = ch / CPK, part = ch % CPK;
            if (DK == 64) kreg[c] = *(const u32x4*)(S.K0 + (kr + key) * S.k0pitch + part * 8);
            else kreg[c] = part < 8 ? *(const u32x4*)(S.K0 + (kr + key) * S.k0pitch + part * 8) : *(const u32x4*)(S.K1 + (kr + key) * 32 + (part - 8) * 8); }
#pragma unroll
        for (int c = 0; c < NVC; ++c) { const int ch = tid + c * NT, vkey = ch & (TK - 1), vdc = ch / TK;
            vreg[c] = *(const u32x4*)(S.V + (kr + vkey) * S.vpitch + vdc * 8); }
    };
    auto lstore = [&](int buf) {
        LAS bf16* kb = Ks + buf * TK * KP; LAS bf16* vb = Vt + buf * 64 * VP;
#pragma unroll
        for (int c = 0; c < NKC; ++c) { const int ch = tid + c * NT, key = ch / CPK, part = ch % CPK; *(LAS u32x4*)(kb + key * KP + part * 8) = kreg[c]; }
#pragma unroll
        for (int c = 0; c < NVC; ++c) { const int ch = tid + c * NT, vkey = ch & (TK - 1), vdc = ch / TK;
            LAS bf16* vp = vb + (vdc * 8) * VP + vkey; const u32x4 v = vreg[c];
            vp[0 * VP] = (bf16)(v.x & 0xffffu); vp[1 * VP] = (bf16)(v.x >> 16); vp[2 * VP] = (bf16)(v.y & 0xffffu); vp[3 * VP] = (bf16)(v.y >> 16);
            vp[4 * VP] = (bf16)(v.z & 0xffffu); vp[5 * VP] = (bf16)(v.z >> 16); vp[6 * VP] = (bf16)(v.w & 0xffffu); vp[7 * VP] = (bf16)(v.w >> 16); }
    };
    gload(0); lstore(0);
    __syncthreads();
    for (int j = 0; j < ntile; ++j) {
        const int buf = j & 1;
        if (j + 1 < ntile) gload(j + 1);
        else if (tid == 0) nxt_u = atomicAdd(ctr, 1u);
        const bool loc = j < nloc;
        if (j == nloc) {
#pragma unroll
            for (int ks = 0; ks < KS; ++ks) qc[ks] = qraw[ks]; }
        const LAS bf16* kb = Ks + buf * TK * KP; const LAS bf16* vb = Vt + buf * 64 * VP;
        f32x4 s[NKB];
#pragma unroll
        for (int kk = 0; kk < NKB; ++kk) { s[kk] = (f32x4){0.f, 0.f, 0.f, 0.f};
#pragma unroll
            for (int ks = 0; ks < KS; ++ks) { const bf16x8 af = *(const LAS bf16x8*)(kb + (kk * 16 + fr) * KP + ks * 32 + g * 8);
                s[kk] = __builtin_amdgcn_mfma_f32_16x16x32_bf16(af, qc[ks], s[kk], 0, 0, 0); } }
        if (S.window && loc) {
            const int kp0 = (S.lo + j) * TK + g * 4;
#pragma unroll
            for (int kk = 0; kk < NKB; ++kk)
#pragma unroll
                for (int i = 0; i < 4; ++i) { const int d = kp0 + kk * 16 + i - qpos; if (d > 128 || d < -128) s[kk][i] = -INFINITY; }
        }
        float mx = -INFINITY;
#pragma unroll
        for (int kk = 0; kk < NKB; ++kk) mx = fmaxf(mx, fmaxf(fmaxf(s[kk][0], s[kk][1]), fmaxf(s[kk][2], s[kk][3])));
        if (__builtin_amdgcn_ballot_w64(mx > m + 8.f) != 0ull) {
            mx = fmaxf(mx, shx(mx, 16, lane)); mx = fmaxf(mx, shx(mx, 32, lane));
            const float mn = fmaxf(m, mx), alpha = __builtin_amdgcn_exp2f(m - mn);
            m = mn; l = l * alpha;
#pragma unroll
            for (int d = 0; d < 4; ++d) o[d] = o[d] * alpha;
        }
        float ls = 0.f;
#pragma unroll
        for (int kk = 0; kk < NKB; ++kk)
#pragma unroll
            for (int i = 0; i < 4; ++i) { const float p = __builtin_amdgcn_exp2f(s[kk][i] - m); s[kk][i] = p; ls += p; }
        l += ls;
        bf16x8 pf[NPP];
#pragma unroll
        for (int pp = 0; pp < NPP; ++pp) {
            const unsigned w0 = pk2(s[2 * pp][0], s[2 * pp][1]), w1 = pk2(s[2 * pp][2], s[2 * pp][3]), w2 = pk2(s[2 * pp + 1][0], s[2 * pp + 1][1]), w3 = pk2(s[2 * pp + 1][2], s[2 * pp + 1][3]);
            pf[pp] = __builtin_bit_cast(bf16x8, (u32x4){w0, w1, w2, w3});
        }
#pragma unroll
        for (int d = 0; d < 4; ++d)
#pragma unroll
            for (int pp = 0; pp < NPP; ++pp) {
                const LAS bf16* vr = vb + (d * 16 + fr) * VP + pp * 32 + g * 4;
                const u32x2 lo = *(const LAS u32x2*)vr, hi = *(const LAS u32x2*)(vr + 16);
                const bf16x8 af = __builtin_bit_cast(bf16x8, (u32x4){lo.x, lo.y, hi.x, hi.y});
                o[d] = __builtin_amdgcn_mfma_f32_16x16x32_bf16(af, pf[pp], o[d], 0, 0, 0);
            }
        if (j + 1 < ntile) lstore(buf ^ 1);
        __syncthreads();
    }
    float lt = l + shx(l, 16, lane); lt += shx(lt, 32, lane);
    const float inv = 1.f / lt;
    bf16* yr = S.Y + (size_t)(S.rowbase + qpos) * DM + S.outcol + g * 4;
#pragma unroll
    for (int d = 0; d < 4; ++d) st4bf(yr + d * 16, o[d] * inv);
}

struct AttnBufs { const bf16 *MQKV, *KPE, *Qc_rot, *Qc_raw, *Kc, *Vc, *Qd_rot, *Qd_raw, *Kd, *Vd; bf16* YCAT; const float* sink; const float* rope; unsigned* ctr; };
constexpr int ATT_NU = 384 + 768;
__device__ __forceinline__ void attn_phase(const AttnBufs& B, LAS unsigned char* lds, int tid, int lane, int wave) {
    volatile LAS unsigned* shu = (volatile LAS unsigned*)(lds + LDS_CTL);
    if (tid == 0) *shu = atomicAdd(B.ctr, 1u);
    __syncthreads();
    for (;;) {
        const int u = (int)*shu;
        if (u >= ATT_NU) break;
        unsigned nxt_u = 0u;
        int type, b, h, qt; bool samp;
        if (u < 384) { type = u >> 7; const int v = u & 127; b = v >> 6; h = (v >> 4) & 3; qt = v & 15; samp = true; }
        else { const int w = u - 384; type = w >> 8; const int v = w & 255; b = v >> 3; h = (v >> 1) & 3; qt = v & 1; samp = false; }
        AttnSrc S;
        S.samp = samp; S.q0 = qt * 128; S.rope = B.rope; S.Y = B.YCAT;
        S.krbase = samp ? NPR + b * 2560 : b * 256; S.rowbase = samp ? NPR + b * 2048 : b * 256;
        S.window = false; S.sink = false; S.m0 = -1e30f;
        if (!samp) { S.lo = 0; S.hi = 2; S.nctx = 0; }
        else { S.lo = 0; S.hi = 16; S.nctx = 4; }
        if (type == 0) {
            S.Qraw = B.MQKV + h * 96; S.Qrot = S.Qraw; S.qpitch = 1024; S.K0 = B.MQKV + 384 + h * 128; S.k0pitch = 1024; S.K1 = B.KPE; S.V = B.MQKV + 384 + h * 128 + 64; S.vpitch = 1024; S.outcol = 256 + h * 64;
            attn_unit<96>(S, lds, tid, lane, wave, B.ctr, nxt_u);
        } else {
            if (type == 1) { S.Qraw = B.Qc_raw + h * 64; S.Qrot = B.Qc_rot + h * 64; S.K0 = B.Kc + (h >> 1) * 64; S.V = B.Vc + (h >> 1) * 64; S.outcol = 512 + h * 64; }
            else { S.Qraw = B.Qd_raw + h * 64; S.Qrot = B.Qd_rot + h * 64; S.K0 = B.Kd + (h >> 1) * 64; S.V = B.Vd + (h >> 1) * 64; S.outcol = 768 + h * 64;
                   S.sink = true; S.m0 = B.sink[h] * LOG2E;
                   if (samp) { S.window = true; const int lo = S.q0 / 128 - 1; S.lo = lo < 0 ? 0 : lo; const int hi = S.q0 / 128 + 2; S.hi = hi > 16 ? 16 : hi; } }
            S.qpitch = 256; S.k0pitch = 128; S.K1 = nullptr; S.vpitch = 128;
            attn_unit<64>(S, lds, tid, lane, wave, B.ctr, nxt_u);
        }
        if (tid == 0) *shu = nxt_u;
        __syncthreads();
    }
}

__device__ __forceinline__ void load8(const bf16* p, float (&o)[8]) { const u32x4 u = *(const u32x4*)p; o[0] = bflo(u.x); o[1] = bfhi(u.x); o[2] = bflo(u.y); o[3] = bfhi(u.y); o[4] = bflo(u.z); o[5] = bfhi(u.z); o[6] = bflo(u.w); o[7] = bfhi(u.w); }
__device__ __forceinline__ void convgate_phase(const bf16* U, const float* cf, bf16* ACT, int gt, int NGT) {
    constexpr int NCH = DFF / 8, RG = 8;
    for (int it = gt; it < (NTOK / RG) * NCH; it += NGT) {
        const int rg = it / NCH, cc = it % NCH, r0 = rg * RG, col = cc * 8;
        const bool samp = r0 >= NPR; const int t0 = samp ? ((r0 - NPR) & 2047) : (r0 & 255), T = samp ? 2048 : 256;
        const bf16* up = U + (size_t)r0 * DUP + col;
        u32x4 ra[RG + 2], rb[RG + 2];
        const u32x4 z4 = (u32x4){0u, 0u, 0u, 0u};
        ra[0] = z4; rb[0] = z4; ra[RG + 1] = z4; rb[RG + 1] = z4;
        if (t0 > 0) { ra[0] = *(const u32x4*)(up - DUP); rb[0] = *(const u32x4*)(up - DUP + DFF); }
#pragma unroll
        for (int i = 0; i < RG; ++i) { ra[i + 1] = *(const u32x4*)(up + (size_t)i * DUP); rb[i + 1] = *(const u32x4*)(up + (size_t)i * DUP + DFF); }
        if (t0 + RG < T) { ra[RG + 1] = *(const u32x4*)(up + (size_t)RG * DUP); rb[RG + 1] = *(const u32x4*)(up + (size_t)RG * DUP + DFF); }
        float wa[3][8], wb[3][8];
#pragma unroll
        for (int k = 0; k < 3; ++k) { const f32x4 a0 = *(const f32x4*)(cf + k * DUP + col), a1 = *(const f32x4*)(cf + k * DUP + col + 4), b0 = *(const f32x4*)(cf + k * DUP + DFF + col), b1 = *(const f32x4*)(cf + k * DUP + DFF + col + 4);
#pragma unroll
            for (int e = 0; e < 4; ++e) { wa[k][e] = a0[e]; wa[k][4 + e] = a1[e]; wb[k][e] = b0[e]; wb[k][4 + e] = b1[e]; } }
#pragma unroll
        for (int i = 0; i < RG; ++i) {
            float r[8];
#pragma unroll
            for (int h = 0; h < 4; ++h) {
                const unsigned pa = ra[i][h], ca = ra[i + 1][h], na = ra[i + 2][h], pb = rb[i][h], cb = rb[i + 1][h], nb = rb[i + 2][h];
                const float xa0 = wa[0][2 * h] * bflo(pa) + wa[1][2 * h] * bflo(ca) + wa[2][2 * h] * bflo(na), xb0 = wb[0][2 * h] * bflo(pb) + wb[1][2 * h] * bflo(cb) + wb[2][2 * h] * bflo(nb);
                const float xa1 = wa[0][2 * h + 1] * bfhi(pa) + wa[1][2 * h + 1] * bfhi(ca) + wa[2][2 * h + 1] * bfhi(na), xb1 = wb[0][2 * h + 1] * bfhi(pb) + wb[1][2 * h + 1] * bfhi(cb) + wb[2][2 * h + 1] * bfhi(nb);
                r[2 * h] = xa0 * __builtin_amdgcn_rcpf(1.f + __builtin_amdgcn_exp2f(-xa0 * LOG2E)) * xb0;
                r[2 * h + 1] = xa1 * __builtin_amdgcn_rcpf(1.f + __builtin_amdgcn_exp2f(-xa1 * LOG2E)) * xb1;
            }
            u32x4 w; w.x = pk2(r[0], r[1]); w.y = pk2(r[2], r[3]); w.z = pk2(r[4], r[5]); w.w = pk2(r[6], r[7]);
            *(u32x4*)(ACT + (size_t)(r0 + i) * DFF + col) = w;
        }
    }
}

#define XB_TMO      128
#define XB_XCNT(j)  (256  + 64 * (j))
#define XB_XSUB(j)  (1280 + 64 * (j))
#define XB_XGEN(j)  (2304 + 64 * (j))
#define XB_TOP      3328
#define XB_TOPGEN   3392
#define XCD_BAR_WORDS 3456
#define XB_SPIN_CAP (1u << 20)
__device__ __forceinline__ unsigned xb_ld(unsigned* p)              { return __hip_atomic_load(p, __ATOMIC_RELAXED, __HIP_MEMORY_SCOPE_AGENT); }
__device__ __forceinline__ unsigned xb_add(unsigned* p, unsigned v) { return __hip_atomic_fetch_add(p, v, __ATOMIC_RELAXED, __HIP_MEMORY_SCOPE_AGENT); }
__device__ __forceinline__ unsigned xb_xcc_id() { return (unsigned)__builtin_amdgcn_s_getreg((3 << 11) | 20) & 0xFu; }
#define XB_SPIN(cond, bar) do { unsigned _sp = 0; while (cond) { __builtin_amdgcn_s_sleep(1); \
    if ((++_sp & 255u) == 0u) { if (xb_ld(&(bar)[XB_TMO])) break; if (_sp > XB_SPIN_CAP) { atomicAdd(&(bar)[XB_TMO], 1u); break; } } } } while (0)
struct XcdBarrier { unsigned* bar; unsigned x; volatile LAS unsigned* st; };
__device__ __forceinline__ void xcd_barrier_complete(unsigned* bar, unsigned x, unsigned& nloc, unsigned& nx) {
    const unsigned G = gridDim.x * gridDim.y * gridDim.z;
    unsigned sum, cnt, mine, sp = 0u;
    for (;;) {
        sum = 0u; cnt = 0u; mine = 0u;
#pragma unroll
        for (unsigned j = 0; j < 16; ++j) { const unsigned c = xb_ld(&bar[XB_XCNT(j)]); sum += c; cnt += (c > 0u) ? 1u : 0u; mine = (j == x) ? c : mine; }
        if (sum == G) break;
        __builtin_amdgcn_s_sleep(1);
        if ((++sp & 255u) == 0u) { if (xb_ld(&bar[XB_TMO])) break; if (sp > XB_SPIN_CAP) { atomicAdd(&bar[XB_TMO], 1u); break; } }
    }
    nloc = mine > 0u ? mine : 1u; nx = cnt > 0u ? cnt : 1u;
}
__device__ __forceinline__ void xcd_barrier(const XcdBarrier& b, const int tid_) {
    asm volatile("s_waitcnt vmcnt(0)" ::: "memory");
    __syncthreads();
    if (tid_ == 0) {
        unsigned* bar = b.bar;
        __builtin_amdgcn_s_waitcnt(0);
        unsigned nloc = b.st[0], nx = b.st[1];
        if (nloc == 0u) { xcd_barrier_complete(bar, b.x, nloc, nx); b.st[0] = nloc; b.st[1] = nx; }
        const unsigned old = xb_add(&bar[XB_XSUB(b.x)], 1u);
        const unsigned gen = old / nloc;
        if (old + 1u == (gen + 1u) * nloc) {
            __builtin_amdgcn_fence(__ATOMIC_RELEASE, "agent");
            asm volatile("s_waitcnt vmcnt(0)" ::: "memory");
            const unsigned og = xb_add(&bar[XB_TOP], 1u);
            const unsigned tg = og / nx;
            if (og + 1u == (tg + 1u) * nx) xb_add(&bar[XB_TOPGEN], 1u);
            else XB_SPIN(xb_ld(&bar[XB_TOPGEN]) == tg, bar);
            __builtin_amdgcn_fence(__ATOMIC_ACQUIRE, "agent");
            xb_add(&bar[XB_XGEN(b.x)], 1u);
            asm volatile("s_waitcnt vmcnt(0)" ::: "memory");
        } else {
            XB_SPIN(xb_ld(&bar[XB_XGEN(b.x)]) == gen, bar);
            __builtin_amdgcn_fence(__ATOMIC_ACQUIRE, "agent");
            asm volatile("s_waitcnt vmcnt(0)" ::: "memory");
        }
    }
    __syncthreads();
}

__device__ __forceinline__ int lane_id_volatile() { int l; asm volatile("v_mbcnt_lo_u32_b32 %0, -1, 0\n\tv_mbcnt_hi_u32_b32 %0, -1, %0" : "=v"(l)); return l; }

#ifndef PH
#define PH 0xFFFF
#endif
#define ON(k) ((PH >> (k)) & 1)
#ifndef REP
#define REP 0
#endif
#define NREP(k) (1 + ((REP >> (k)) & 1))
__global__ void __launch_bounds__(NT, 2) mega_fwd(Args a_unused) {
    extern __shared__ __attribute__((aligned(16))) unsigned char lds[];
    cg::grid_group grid = cg::this_grid();
    const int G = gridDim.x, bid = blockIdx.x;
    const int wave_s = __builtin_amdgcn_readfirstlane(threadIdx.x >> 6);
    PG8_LAS unsigned char* ring = (PG8_LAS unsigned char*)lds;
#define PHASE_BEGIN int tid = wave_s * 64 + lane_id_volatile(); asm volatile("" : "+v"(tid)); const CAS Args* ap_ = (const CAS Args*)__builtin_amdgcn_kernarg_segment_ptr(); asm volatile("" : "+s"(ap_)); const CAS Args& a = *ap_; unsigned char* ws = a.ws; float* out = a.out; \
    const int lane = tid & 63, wave = __builtin_amdgcn_readfirstlane(tid >> 6); const int gw = bid * NW + wave, NGW = G * NW, gt = bid * NT + tid, NGT = G * NT; \
    (void)lane; (void)wave; (void)gw; (void)NGW; (void)gt; (void)NGT; (void)out; \
    const float* mod = (const float*)(ws + WS_MOD); const float* rope = (const float*)(ws + WS_ROPE); (void)mod; (void)rope; \
    bf16* XN = (bf16*)(ws + WS_XN); bf16* PROJ = (bf16*)(ws + WS_PROJ); bf16* A2 = (bf16*)(ws + WS_A2); bf16* MQKV = (bf16*)(ws + WS_MQKV); \
    bf16* KPE = (bf16*)(ws + WS_KPE); bf16* YCAT = (bf16*)(ws + WS_YCAT); bf16* ACT = (bf16*)(ws + WS_ACT); bf16* U = (bf16*)(ws + WS_U); \
    bf16* Qc_rot = (bf16*)(ws + WS_QC); bf16* Qc_raw = (bf16*)(ws + WS_QC + QSZ); bf16* Kc = (bf16*)(ws + WS_QC + 2 * QSZ); bf16* Vc = (bf16*)(ws + WS_QC + 2 * QSZ + KSZ); \
    bf16* Qd_rot = (bf16*)(ws + WS_QC + 2 * QSZ + 2 * KSZ); bf16* Qd_raw = Qd_rot + (size_t)NKR * 256; bf16* Kd = Qd_raw + (size_t)NKR * 256; bf16* Vd = Kd + (size_t)NKR * 128; \
    (void)XN; (void)PROJ; (void)A2; (void)MQKV; (void)KPE; (void)YCAT; (void)ACT; (void)U; (void)Qc_rot; (void)Qc_raw; (void)Kc; (void)Vc; (void)Qd_rot; (void)Qd_raw; (void)Kd; (void)Vd;
#define GSYNC() do { const CAS Args* bp_ = (const CAS Args*)__builtin_amdgcn_kernarg_segment_ptr(); asm volatile("" : "+s"(bp_)); XcdBarrier xb_; xb_.bar = (unsigned*)(bp_->ws + WS_BAR); xb_.x = xb_xcc_id(); \
    xb_.st = (volatile LAS unsigned*)((LAS unsigned char*)lds + LDS_CTL + 32); xcd_barrier(xb_, wave_s * 64 + lane_id_volatile()); } while (0)
#define LAYER_VALS const float* modl = mod + (size_t)l * 3 * 6144; unsigned char* wl = ws + WS_W + l * W_LSTRIDE; (void)modl; (void)wl; \
    const float* x0 = l == 0 ? a.in[0] : nullptr; const float* x1 = l == 0 ? a.in[1] : nullptr; (void)x0; (void)x1; bf16* XRES = (bf16*)(ws + WS_XRES); (void)XRES;

    if (threadIdx.x < 16) ((volatile LAS unsigned*)((LAS unsigned char*)lds + LDS_CTL))[threadIdx.x] = 0u;
    __syncthreads();
    { PHASE_BEGIN if (tid == 0) (void)xb_add((unsigned*)(ws + WS_BAR) + XB_XCNT(xb_xcc_id()), 1u);
      if (ws == nullptr) grid.sync(); }
    for (int rep = 0; rep < NREP(0); ++rep) {
    if (ON(0)) { PHASE_BEGIN phase0(a, (LAS unsigned char*)lds, tid, lane, wave); }
    GSYNC(); }

    if (ON(1)) { PHASE_BEGIN
        if (G > 124) {
            if (bid < 62) bias_phase(a, ws, (LAS unsigned char*)lds, tid, lane, wave);
            else prep_phase(a.in[0], a.in[1], a.in[12], mod, 1024, XN, (float*)(ws + WS_SS1), lane, (bid - 62) * NW + wave, (G - 62) * NW);
        } else { bias_phase(a, ws, (LAS unsigned char*)lds, tid, lane, wave);
            prep_phase(a.in[0], a.in[1], a.in[12], mod, 1024, XN, (float*)(ws + WS_SS1), lane, gw, NGW); } }
    GSYNC();
#pragma unroll
    for (int l = 0; l < 2; ++l) {
        for (int rep = 0; rep < NREP(2); ++rep) {
        if (ON(2)) { PHASE_BEGIN LAYER_VALS pg8::Gemm g{XN, (const bf16*)(wl + W_IN), NTOK, INP, DM, 0, 0}; pg8::StaticOrder S; S.init(NTOK, INP, G, bid);
          pg8::EpiBf16RS E{PROJ, INP, (const float*)(ws + WS_SS1), (const float*)(ws + WS_BIAS) + (size_t)l * 3 * NBIAS, NBIAS};
          pg8::gemm_phase<pg8::EpiBf16RS, pg8::StaticOrder, true, true>(ring, g, S, E, tid); }
        GSYNC(); }
        for (int rep = 0; rep < NREP(3); ++rep) {
        if (ON(3)) { PHASE_BEGIN P3Ptrs P; P.PROJ = PROJ; P.A2 = A2; P.KPE = KPE; P.YCAT = YCAT; P.Qc_rot = Qc_rot; P.Qc_raw = Qc_raw; P.Kc = Kc; P.Vc = Vc; P.Qd_rot = Qd_rot; P.Qd_raw = Qd_raw; P.Kd = Kd; P.Vd = Vd;
          P.conv_a = a.in[14]; P.gq_mla = a.in[15]; P.gkv_mla = a.in[17]; P.gq = a.in[19]; P.gk = a.in[20]; P.rope = rope;
          P.c_ckv = a.in[2]; P.c_kpe = a.in[3]; P.c_gk = a.in[4]; P.c_gv = a.in[5]; P.c_sk = a.in[6]; P.c_sv = a.in[7];
          P.o_ckv = out + 12582912; P.o_kpe = out + 14680064; P.o_gk = out + 15204352; P.o_gv = out + 17301504; P.o_sk = out + 19398656; P.o_sv = out + 21495808; P.l = l;
          p3_phase(P, lane, gw, NGW); }
        GSYNC(); }
        for (int rep = 0; rep < NREP(4); ++rep) {
        if (ON(4)) { PHASE_BEGIN LAYER_VALS pg8::Gemm g{A2, (const bf16*)(wl + W_B2), NKR, 1024, 384, 0, 0}; pg8::StaticOrder S; S.init(NKR, 1024, G, bid); pg8::EpiBf16 E{MQKV, 1024};
          pg8::gemm_phase<pg8::EpiBf16, pg8::StaticOrder, true, true>(ring, g, S, E, tid); }
        GSYNC(); }
        for (int rep = 0; rep < NREP(5); ++rep) {
        if (ON(5)) { PHASE_BEGIN AttnBufs B; B.MQKV = MQKV; B.KPE = KPE; B.Qc_rot = Qc_rot; B.Qc_raw = Qc_raw; B.Kc = Kc; B.Vc = Vc; B.Qd_rot = Qd_rot; B.Qd_raw = Qd_raw; B.Kd = Kd; B.Vd = Vd; B.YCAT = YCAT;
          B.sink = a.in[21] + l * 4; B.rope = rope; B.ctr = (unsigned*)(ws + WS_CTL) + 64 * l + 128 * rep;
          attn_phase(B, (LAS unsigned char*)lds, tid, lane, wave); }
        GSYNC(); }
        if (ON(6)) { PHASE_BEGIN LAYER_VALS pg8::Gemm g{YCAT, (const bf16*)(wl + W_OUT), NTOK, DM, DM, 0, 0}; pg8::StaticOrder S; S.init(NTOK, DM, G, bid);
          pg8::EpiResid E{x0, x1, XRES, modl + 2048, XN, (float*)(ws + WS_SS2), a.in[23] + l * DM, modl + 4096};
          pg8::gemm_phase<pg8::EpiResid, pg8::StaticOrder, true, true>(ring, g, S, E, tid);
          if (l == 0) { const int wk = G > 192 ? bid - 192 : bid, nwk = G > 192 ? G - 192 : G;
            if (wk >= 0) wconv(a, ws, 0, 4 | 8, wk * NW + wave, nwk * NW, (LAS float*)((LAS unsigned char*)lds + wave * 16640), lane); } }
        GSYNC();
        for (int rep = 0; rep < NREP(8); ++rep) {
        if (ON(8)) { PHASE_BEGIN LAYER_VALS pg8::Gemm g{XN, (const bf16*)(wl + W_UP), NTOK, DUP, DM, (size_t)128 * DM * 2, (size_t)DFF * DM * 2}; pg8::StaticOrder S; S.init(NTOK, DUP, G, bid);
          pg8::EpiUpGate E{ACT, (const float*)(ws + WS_SS2), (const float*)(ws + WS_BIAS) + (size_t)l * 3 * NBIAS + 2304, NBIAS, a.in[25] + (size_t)l * 3 * DUP, (float*)(ws + WS_HALO), ring + 131072};
          pg8::gemm_phase<pg8::EpiUpGate, pg8::StaticOrder, true, true>(ring, g, S, E, tid); }
        GSYNC(); }
        if (ON(10)) { PHASE_BEGIN LAYER_VALS pg8::Gemm g{ACT, (const bf16*)(wl + W_DOWN), NTOK, DM, DFF, 0, 0}; pg8::StaticOrder S; S.init(NTOK, DM, G, bid);
          {
            const float* cwl = a.in[25] + (size_t)l * 3 * DUP; const float* HALO = (const float*)(ws + WS_HALO); pg8::Unit hu;
            bool fixed = false;
            for (int ui = 0; S.next(ui, hu); ++ui) { if (hu.pm < 32) continue; fixed = true; const int k = hu.pm - 32, pos = k & 7;
                for (int idx = tid; idx < 2 * DFF; idx += NT) { const int which = idx >= DFF ? 1 : 0, j = idx - which * DFF;
                    if (which == 0 ? pos == 0 : pos == 7) continue;
                    const float* Pp = HALO + (size_t)(k * 4 + (which ? 3 : 1)) * DUP; const float* Ep = HALO + (size_t)((which ? k + 1 : k - 1) * 4 + (which ? 0 : 2)) * DUP; const float* wp = cwl + (which ? 2 : 0) * DUP;
                    const float ca = Pp[j] + wp[j] * Ep[j], cb = Pp[DFF + j] + wp[DFF + j] * Ep[DFF + j];
                    const float r = ca * __builtin_amdgcn_rcpf(1.f + __builtin_amdgcn_exp2f(-ca * LOG2E)) * cb;
                    ACT[(size_t)(hu.pm * 256 + (which ? 255 : 0)) * DFF + j] = (bf16)(pk2(r, r) & 0xffffu); } }
            if (fixed) { asm volatile("s_waitcnt vmcnt(0)" ::: "memory"); __syncthreads();
                if (tid == 0) { __builtin_amdgcn_fence(__ATOMIC_RELEASE, "agent"); __builtin_amdgcn_fence(__ATOMIC_ACQUIRE, "agent"); asm volatile("s_waitcnt vmcnt(0)" ::: "memory"); }
                __syncthreads(); } }
          if (l == 1 && G >= 192) {
            pg8::EpiResidFinal E{XRES, out, modl + 5120, (float*)(ws + WS_SS1), a.in[27], (unsigned*)(ws + WS_CTL) + 2048};
            pg8::gemm_phase<pg8::EpiResidFinal, pg8::StaticOrder, true, true>(ring, g, S, E, tid);
          } else {
          pg8::EpiResid E{nullptr, nullptr, XRES, modl + 5120, l == 0 ? XN : nullptr, (float*)(ws + WS_SS1), a.in[12] + DM, mod + (size_t)3 * 6144 + 1024};
          pg8::gemm_phase<pg8::EpiResid, pg8::StaticOrder, true, true>(ring, g, S, E, tid); }
          if (l == 0) { const int wk = G > 192 ? bid - 192 : bid, nwk = G > 192 ? G - 192 : G;
            if (wk >= 0) wconv(a, ws, 1, 63, wk * NW + wave, nwk * NW, (LAS float*)((LAS unsigned char*)lds + wave * 16640), lane); } }
        if (!(l == 1 && G >= 192)) GSYNC();
    }
#ifdef XSYNC
    for (int i = 0; i < XSYNC; ++i) GSYNC();
#endif
    if (G < 192) { PHASE_BEGIN
    const bf16* XRES = (const bf16*)(ws + WS_XRES);
    for (int row = gw; row < NTOK; row += NGW) {
        float* xr = out + (size_t)row * DM;
        f32x4 v[4]; float ss = 0.f;
#pragma unroll
        for (int j = 0; j < 4; ++j) { v[j] = ld4bf(XRES + (size_t)row * DM + 4 * (lane + 64 * j)); ss += dot4(v[j]); }
        const float rs = rsqrtf(wave_sum(ss, lane) * (1.f / DM) + EPS);
#pragma unroll
        for (int j = 0; j < 4; ++j) { const int col = 4 * (lane + 64 * j); *(f32x4*)(xr + col) = v[j] * rs * *(const f32x4*)(a.in[27] + col); }
    } }
}

extern "C" void kernel_launch(void* const* d_in, const int* in_sizes, int n_in, void* d_out, int out_size, void* d_ws, size_t ws_size, hipStream_t stream) {
    static int grid = 0;
    if (grid == 0) {
        if (n_in != 28 || ws_size < WS_END) { fprintf(stderr, "kernel_launch: unexpected n_in %d / ws %zu\n", n_in, ws_size); grid = -1; return; }
        int dev = 0, cus = 0, per_cu = 0;
        hipGetDevice(&dev); hipDeviceGetAttribute(&cus, hipDeviceAttributeMultiprocessorCount, dev);
        hipFuncSetAttribute((const void*)mega_fwd, hipFuncAttributeMaxDynamicSharedMemorySize, LDS_BYTES);
        hipOccupancyMaxActiveBlocksPerMultiprocessor(&per_cu, (const void*)mega_fwd, NT, LDS_BYTES);
        if (per_cu < 1) per_cu = 1;
        grid = cus * per_cu;
        (void)hipGetLastError();
    }
    if (grid < 0) return;
    if (hipMemsetAsync((char*)d_ws + WS_BAR, 0, XCD_BAR_WORDS * 4, stream) != hipSuccess) { fprintf(stderr, "kernel_launch: memset of the barrier words failed\n"); return; }
    Args a{};
    for (int i = 0; i < 28; ++i) a.in[i] = (const float*)d_in[i];
    a.out = (float*)d_out; a.ws = (unsigned char*)d_ws;
    void* args[] = {&a};
    hipError_t e = hipLaunchCooperativeKernel((const void*)mega_fwd, dim3(grid), dim3(NT), args, LDS_BYTES, stream);
    if (e != hipSuccess) fprintf(stderr, "cooperative launch failed: %s (grid %d)\n", hipGetErrorString(e), grid);
}
```

```cpp
#include <hip/hip_runtime.h>
#include <hip/hip_cooperative_groups.h>
#include <cstdio>
#include <cstdint>
namespace cg = cooperative_groups;

namespace pg8 {
#define PG8_LAS __attribute__((address_space(3)))
typedef unsigned short bf16_t;
typedef short bf16x8 __attribute__((ext_vector_type(8)));
typedef float f32x4 __attribute__((ext_vector_type(4)));
typedef unsigned u32x4 __attribute__((ext_vector_type(4)));
constexpr int BM = 256, BK = 64, HALF = 128, HTB = HALF * BK * 2, STAGE_BYTES = 8 * HTB, NXCD = 8, WGM = 4;

__host__ __device__ __forceinline__ int lds_byte(int r, int c) { const int st = (r >> 4) * 2 + (c >> 5), rr = r & 15, cc = c & 31, ob = rr * 64 + cc * 2; return st * 1024 + (ob ^ (((ob >> 9) & 1) << 5)); }
__host__ __device__ __forceinline__ void stage_rc(int b, int& R, int& C) { const int st = b / 1024, sb = b % 1024, swz = sb ^ (((sb >> 9) & 1) << 5); R = (st >> 1) * 16 + swz / 64; C = (st & 1) * 32 + (swz % 64) / 2; }
__host__ __device__ __forceinline__ int perm32(int rho) { const int n = rho >> 4, i = rho & 15; return 8 * (i >> 2) + 4 * n + (i & 3); }

struct Unit { int pm, pn; };
struct Gemm { const bf16_t* A; const bf16_t* Bt; int M, N, K; size_t bstep, bhalf; };

struct StaticOrder {
    int nM, nN, nwg, G, c;
    __host__ __device__ __forceinline__ void init(int M, int N, int G_, int c_) { nM = M / BM; nN = N / BM; nwg = nM * nN; G = G_; c = c_; }
    __host__ __device__ __forceinline__ bool next(int i, Unit& u) const {
        const long L = (long)i * G + c; if (L >= nwg) return false;
        int wgid = (int)L; { const int q = nwg / NXCD, r = nwg % NXCD, xcd = wgid % NXCD, off = wgid / NXCD; wgid = (xcd < r ? xcd * (q + 1) : r * (q + 1) + (xcd - r) * q) + off; }
        const int nig = WGM * nN, gid = wgid / nig, fm = gid * WGM, gsz = (nM - fm) < WGM ? (nM - fm) : WGM;
        u.pm = fm + ((wgid % nig) % gsz); u.pn = (wgid % nig) / gsz; return true;
    }
    __device__ __forceinline__ void a_ready(const Unit&) const {}
    __device__ __forceinline__ void done(const Unit&) const {}
};

__device__ __forceinline__ unsigned cvt_pk_bf16(float lo, float hi) { unsigned r; asm volatile("v_cvt_pk_bf16_f32 %0, %1, %2" : "=v"(r) : "v"(lo), "v"(hi)); return r; }

struct EpiBf16 {
    static constexpr bool PERM = true, AFTER_DRAIN = false;
    bf16_t* O; int ldc;
    __device__ __forceinline__ void operator()(const f32x4 (&acc)[2][2][4][2], const Unit& u, int wr, int wc, int fr, int fq) const {
        asm volatile("" : "+v"(fr), "+v"(fq));
        const int row0 = u.pm * BM + wr * 64 + fr; const int col0 = u.pn * BM + wc * 32 + 8 * fq;
#pragma unroll
        for (int ai = 0; ai < 2; ++ai)
#pragma unroll
            for (int m = 0; m < 4; ++m) { bf16_t* rowp = O + (size_t)(row0 + ai * HALF + m * 16) * ldc + col0;
#pragma unroll
                for (int bj = 0; bj < 2; ++bj) { const f32x4 v0 = acc[ai][bj][m][0], v1 = acc[ai][bj][m][1];
                    u32x4 w; w.x = cvt_pk_bf16(v0[0], v0[1]); w.y = cvt_pk_bf16(v0[2], v0[3]); w.z = cvt_pk_bf16(v1[0], v1[1]); w.w = cvt_pk_bf16(v1[2], v1[3]);
                    *(u32x4*)(rowp + bj * HALF) = w; } }
    }
};
__device__ __forceinline__ float shx_(float v, int m, int lane) { return __builtin_bit_cast(float, __builtin_amdgcn_ds_bpermute((lane ^ m) << 2, __builtin_bit_cast(int, v))); }
__device__ __forceinline__ void row_scales(const float* SS, int row0, int fr, int fq, float (&rs)[8]) {
    f32x4 t[8];
#pragma unroll
    for (int q = 0; q < 8; ++q) t[q] = *(const f32x4*)(SS + (size_t)(row0 + (q >> 2) * HALF + (q & 3) * 16) * 16 + 4 * fq);
    const int lane = fq * 16 + fr;
#pragma unroll
    for (int q = 0; q < 8; ++q) { float v = (t[q][0] + t[q][1]) + (t[q][2] + t[q][3]); v += shx_(v, 16, lane); v += shx_(v, 32, lane); rs[q] = __builtin_amdgcn_rsqf(v * (1.f / 1024.f) + 1e-6f); }
}
struct EpiBf16RS {
    static constexpr bool PERM = true, AFTER_DRAIN = false;
    bf16_t* O; int ldc; const float* SS; const float* bias; int ldb;
    __device__ __forceinline__ void operator()(const f32x4 (&acc)[2][2][4][2], const Unit& u, int wr, int wc, int fr, int fq) const {
        asm volatile("" : "+v"(fr), "+v"(fq));
        const int cnd = u.pm < 32 ? 0 : 1 + ((u.pm - 32) >> 3);
        const int row0 = u.pm * BM + wr * 64 + fr; const int col0 = u.pn * BM + wc * 32 + 8 * fq;
        const float* bp = bias + (size_t)cnd * ldb + col0;
        f32x4 bv[2][2];
#pragma unroll
        for (int bj = 0; bj < 2; ++bj)
#pragma unroll
            for (int n = 0; n < 2; ++n) bv[bj][n] = *(const f32x4*)(bp + bj * HALF + 4 * n);
        float rsv[8]; row_scales(SS, row0, fr, fq, rsv);
#pragma unroll
        for (int ai = 0; ai < 2; ++ai)
#pragma unroll
            for (int m = 0; m < 4; ++m) { const int row = row0 + ai * HALF + m * 16; const float rs = rsv[ai * 4 + m];
                bf16_t* rowp = O + (size_t)row * ldc + col0;
#pragma unroll
                for (int bj = 0; bj < 2; ++bj) { const f32x4 v0 = acc[ai][bj][m][0] * rs + bv[bj][0], v1 = acc[ai][bj][m][1] * rs + bv[bj][1];
                    u32x4 w; w.x = cvt_pk_bf16(v0[0], v0[1]); w.y = cvt_pk_bf16(v0[2], v0[3]); w.z = cvt_pk_bf16(v1[0], v1[1]); w.w = cvt_pk_bf16(v1[2], v1[3]);
                    *(u32x4*)(rowp + bj * HALF) = w; } }
    }
};
struct EpiResid {
    static constexpr bool PERM = false, AFTER_DRAIN = false;
    const float* r0; const float* r1; bf16_t* XR; const float* gate;
    bf16_t* XN; float* SS; const float* nrm; const float* sc;
    __device__ __forceinline__ void operator()(const f32x4 (&acc)[2][2][4][2], const Unit& u, int wr, int wc, int fr, int fq) const {
        asm volatile("" : "+v"(fr), "+v"(fq));
        typedef unsigned u32x2_ __attribute__((ext_vector_type(2)));
        const int cnd = u.pm < 32 ? 0 : 1 + ((u.pm - 32) >> 3);
        const float* gp = gate + cnd * 6144;
        const int col0 = u.pn * BM + wc * 32 + 4 * fq;
        const int rowb = u.pm * BM + wr * 64 + fr;
        const bool inf = r0 != nullptr;
        const float* rs = (u.pm < 32 ? r0 + (size_t)rowb * 1024 : r1 + (size_t)(rowb - 8192) * 1024) + col0;
        bf16_t* op = XR + (size_t)rowb * 1024 + col0;
#define LDX(off) (inf ? __builtin_nontemporal_load((const f32x4*)(rs + (off))) : ({ const u32x2_ t_ = *(const u32x2_*)(op + (off)); (f32x4){__builtin_bit_cast(float, t_.x << 16), __builtin_bit_cast(float, t_.x & 0xffff0000u), __builtin_bit_cast(float, t_.y << 16), __builtin_bit_cast(float, t_.y & 0xffff0000u)}; }))
        const bool prep = XN != nullptr;
        f32x4 gv[2][2], hv[2][2];
#pragma unroll
        for (int bj = 0; bj < 2; ++bj)
#pragma unroll
            for (int n = 0; n < 2; ++n) { gv[bj][n] = *(const f32x4*)(gp + col0 + bj * HALF + n * 16);
                hv[bj][n] = (f32x4){0.f, 0.f, 0.f, 0.f};
                if (prep) hv[bj][n] = *(const f32x4*)(nrm + col0 + bj * HALF + n * 16) * (1.f + *(const f32x4*)(sc + cnd * 6144 + col0 + bj * HALF + n * 16)); }
        f32x4 xc[2][2], xn[2][2];
#pragma unroll
        for (int bj = 0; bj < 2; ++bj)
#pragma unroll
            for (int n = 0; n < 2; ++n) xc[bj][n] = LDX(bj * HALF + n * 16);
#pragma unroll
        for (int it = 0; it < 8; ++it) { const int ai = it >> 2, m = it & 3; const size_t ro = (size_t)(ai * HALF + m * 16) * 1024;
            if (it < 7) { const int ai2 = (it + 1) >> 2, m2 = (it + 1) & 3; const size_t ro2 = (size_t)(ai2 * HALF + m2 * 16) * 1024;
#pragma unroll
                for (int bj = 0; bj < 2; ++bj)
#pragma unroll
                    for (int n = 0; n < 2; ++n) xn[bj][n] = LDX(ro2 + bj * HALF + n * 16); }
            float ssq = 0.f;
#pragma unroll
            for (int bj = 0; bj < 2; ++bj)
#pragma unroll
                for (int n = 0; n < 2; ++n) { const f32x4 v = xc[bj][n] + gv[bj][n] * acc[ai][bj][m][n];
                    *(u32x2_*)(op + ro + bj * HALF + n * 16) = (u32x2_){cvt_pk_bf16(v[0], v[1]), cvt_pk_bf16(v[2], v[3])};
                    if (prep) { ssq += (v[0] * v[0] + v[1] * v[1]) + (v[2] * v[2] + v[3] * v[3]); const f32x4 h = v * hv[bj][n];
                        unsigned w0 = cvt_pk_bf16(h[0], h[1]), w1 = cvt_pk_bf16(h[2], h[3]);
                        *(u32x2_*)(XN + (size_t)(rowb + ai * HALF + m * 16) * 1024 + col0 + bj * HALF + n * 16) = (u32x2_){w0, w1}; } }
            if (prep) { const int lane = fq * 16 + fr; ssq += shx_(ssq, 16, lane); ssq += shx_(ssq, 32, lane);
                if (fq == 0) SS[(size_t)(rowb + ai * HALF + m * 16) * 16 + u.pn * 4 + wc] = ssq; }
#pragma unroll
            for (int bj = 0; bj < 2; ++bj)
#pragma unroll
                for (int n = 0; n < 2; ++n) xc[bj][n] = xn[bj][n];
        }
    }
#undef LDX
};

struct EpiResidFinal {
    static constexpr bool PERM = false, AFTER_DRAIN = false;
    const bf16_t* res; float* out; const float* gate; float* SS; const float* fw; unsigned* cnt;
    __device__ __forceinline__ void operator()(f32x4 (&acc)[2][2][4][2], const Unit& u, int wr, int wc, int fr, int fq) const {
        asm volatile("" : "+v"(fr), "+v"(fq));
        const int cnd = u.pm < 32 ? 0 : 1 + ((u.pm - 32) >> 3);
        const float* gp = gate + cnd * 6144;
        const int col0 = u.pn * BM + wc * 32 + 4 * fq;
        const int rowb = u.pm * BM + wr * 64 + fr;
        typedef unsigned u32x2_ __attribute__((ext_vector_type(2)));
        const bf16_t* rs = res + (size_t)rowb * 1024 + col0;
#define LDXF(off) ({ const u32x2_ t_ = *(const u32x2_*)(rs + (off)); (f32x4){__builtin_bit_cast(float, t_.x << 16), __builtin_bit_cast(float, t_.x & 0xffff0000u), __builtin_bit_cast(float, t_.y << 16), __builtin_bit_cast(float, t_.y & 0xffff0000u)}; })
        f32x4 gv[2][2];
#pragma unroll
        for (int bj = 0; bj < 2; ++bj)
#pragma unroll
            for (int n = 0; n < 2; ++n) gv[bj][n] = *(const f32x4*)(gp + col0 + bj * HALF + n * 16);
        f32x4 xc[2][2], xn[2][2];
#pragma unroll
        for (int bj = 0; bj < 2; ++bj)
#pragma unroll
            for (int n = 0; n < 2; ++n) xc[bj][n] = LDXF(bj * HALF + n * 16);
#pragma unroll
        for (int it = 0; it < 8; ++it) { const int ai = it >> 2, m = it & 3;
            if (it < 7) { const int ai2 = (it + 1) >> 2, m2 = (it + 1) & 3; const size_t ro2 = (size_t)(ai2 * HALF + m2 * 16) * 1024;
#pragma unroll
                for (int bj = 0; bj < 2; ++bj)
#pragma unroll
                    for (int n = 0; n < 2; ++n) xn[bj][n] = LDXF(ro2 + bj * HALF + n * 16); }
            float ssq = 0.f;
#pragma unroll
            for (int bj = 0; bj < 2; ++bj)
#pragma unroll
                for (int n = 0; n < 2; ++n) { const f32x4 v = xc[bj][n] + gv[bj][n] * acc[ai][bj][m][n]; acc[ai][bj][m][n] = v;
                    ssq += (v[0] * v[0] + v[1] * v[1]) + (v[2] * v[2] + v[3] * v[3]); }
            { const int lane = fq * 16 + fr; ssq += shx_(ssq, 16, lane); ssq += shx_(ssq, 32, lane);
              if (fq == 0) __hip_atomic_store(SS + (size_t)(rowb + ai * HALF + m * 16) * 16 + u.pn * 4 + wc, ssq, __ATOMIC_RELAXED, __HIP_MEMORY_SCOPE_AGENT); }
#pragma unroll
            for (int bj = 0; bj < 2; ++bj)
#pragma unroll
                for (int n = 0; n < 2; ++n) xc[bj][n] = xn[bj][n];
        }
        asm volatile("s_waitcnt vmcnt(0)" ::: "memory"); __builtin_amdgcn_s_barrier(); asm volatile("" ::: "memory");
        if (wr == 0 && wc == 0 && fr == 0 && fq == 0) {
            __builtin_amdgcn_fence(__ATOMIC_RELEASE, "agent"); asm volatile("s_waitcnt vmcnt(0)" ::: "memory");
            __hip_atomic_fetch_add(cnt + u.pm, 1u, __ATOMIC_RELAXED, __HIP_MEMORY_SCOPE_AGENT);
            unsigned sp = 0;
            while (__hip_atomic_load(cnt + u.pm, __ATOMIC_RELAXED, __HIP_MEMORY_SCOPE_AGENT) < 4u) { __builtin_amdgcn_s_sleep(1); if (++sp > (1u << 22)) break; }
            __builtin_amdgcn_fence(__ATOMIC_ACQUIRE, "agent"); asm volatile("s_waitcnt vmcnt(0)" ::: "memory");
        }
        __builtin_amdgcn_s_barrier(); asm volatile("" ::: "memory");
        float rsv[8];
        { f32x4 t[8];
#pragma unroll
          for (int q = 0; q < 8; ++q) { const float* sp = SS + (size_t)(rowb + (q >> 2) * HALF + (q & 3) * 16) * 16 + 4 * fq;
              t[q] = (f32x4){__hip_atomic_load(sp, __ATOMIC_RELAXED, __HIP_MEMORY_SCOPE_AGENT), __hip_atomic_load(sp + 1, __ATOMIC_RELAXED, __HIP_MEMORY_SCOPE_AGENT),
                             __hip_atomic_load(sp + 2, __ATOMIC_RELAXED, __HIP_MEMORY_SCOPE_AGENT), __hip_atomic_load(sp + 3, __ATOMIC_RELAXED, __HIP_MEMORY_SCOPE_AGENT)}; }
          const int lane = fq * 16 + fr;
#pragma unroll
          for (int q = 0; q < 8; ++q) { float v = (t[q][0] + t[q][1]) + (t[q][2] + t[q][3]); v += shx_(v, 16, lane); v += shx_(v, 32, lane); rsv[q] = __builtin_amdgcn_rsqf(v * (1.f / 1024.f) + 1e-6f); } }
        f32x4 wv[2][2];
#pragma unroll
        for (int bj = 0; bj < 2; ++bj)
#pragma unroll
            for (int n = 0; n < 2; ++n) wv[bj][n] = *(const f32x4*)(fw + col0 + bj * HALF + n * 16);
        float* op = out + (size_t)rowb * 1024 + col0;
#pragma unroll
        for (int it = 0; it < 8; ++it) { const int ai = it >> 2, m = it & 3; const size_t ro = (size_t)(ai * HALF + m * 16) * 1024;
#pragma unroll
            for (int bj = 0; bj < 2; ++bj)
#pragma unroll
                for (int n = 0; n < 2; ++n) __builtin_nontemporal_store(acc[ai][bj][m][n] * rsv[it] * wv[bj][n], (f32x4*)(op + ro + bj * HALF + n * 16)); }
    }
};

__device__ __forceinline__ float dpp_ror1(float v) { return __builtin_bit_cast(float, __builtin_amdgcn_mov_dpp(__builtin_bit_cast(int, v), 0x121, 0xf, 0xf, false)); }
__device__ __forceinline__ float dpp_ror15(float v) { return __builtin_bit_cast(float, __builtin_amdgcn_mov_dpp(__builtin_bit_cast(int, v), 0x12f, 0xf, 0xf, false)); }
struct EpiUpGate {
    static constexpr bool PERM = true, AFTER_DRAIN = false;
    bf16_t* ACT; const float* SS; const float* bias; int ldb; const float* cw; float* HALO; PG8_LAS unsigned char* xb;
    __device__ __forceinline__ void operator()(f32x4 (&acc)[2][2][4][2], const Unit& u, int wr, int wc, int fr, int fq) const {
        asm volatile("" : "+v"(fr), "+v"(fq));
        const int cnd = u.pm < 32 ? 0 : 1 + ((u.pm - 32) >> 3);
        const bool samp = u.pm >= 32;
        const int j0 = u.pn * HALF + wc * 32 + 8 * fq;
        const int row0 = u.pm * BM + wr * 64 + fr;
        { const float* bp = bias + (size_t)cnd * ldb + j0;
          f32x4 bv[2][2];
#pragma unroll
          for (int bj = 0; bj < 2; ++bj)
#pragma unroll
              for (int n = 0; n < 2; ++n) bv[bj][n] = *(const f32x4*)(bp + bj * 2816 + 4 * n);
          float rsv[8]; row_scales(SS, row0, fr, fq, rsv);
#pragma unroll
          for (int ai = 0; ai < 2; ++ai)
#pragma unroll
              for (int m = 0; m < 4; ++m) { const float rs = rsv[ai * 4 + m];
#pragma unroll
                  for (int bj = 0; bj < 2; ++bj)
#pragma unroll
                      for (int n = 0; n < 2; ++n) acc[ai][bj][m][n] = acc[ai][bj][m][n] * rs + bv[bj][n]; } }
        PG8_LAS f32x4* WL = (PG8_LAS f32x4*)(xb + 8192);
        if (fr == 0) {
            f32x4 wt[2][2][3];
#pragma unroll
            for (int n = 0; n < 2; ++n)
#pragma unroll
                for (int bj = 0; bj < 2; ++bj)
#pragma unroll
                    for (int k = 0; k < 3; ++k) wt[n][bj][k] = *(const f32x4*)(cw + k * 5632 + bj * 2816 + j0 + 4 * n);
#pragma unroll
            for (int n = 0; n < 2; ++n)
#pragma unroll
                for (int bj = 0; bj < 2; ++bj)
#pragma unroll
                    for (int k = 0; k < 3; ++k) WL[((((wr * 4 + wc) * 4 + fq) * 2 + n) * 2 + bj) * 3 + k] = wt[n][bj][k];
        }
        PG8_LAS f32x4* XB = (PG8_LAS f32x4*)xb;
        const int wv = wr * 4 + wc, pw = (wr ^ 1) * 4 + wc;
        if (fr == 0) {
#pragma unroll
            for (int ai = 0; ai < 2; ++ai)
#pragma unroll
                for (int bj = 0; bj < 2; ++bj)
#pragma unroll
                    for (int n = 0; n < 2; ++n) XB[((wv * 4 + ai * 2) * 2 + bj) * 8 + 2 * fq + n] = acc[ai][bj][0][n]; }
        if (fr == 15) {
#pragma unroll
            for (int ai = 0; ai < 2; ++ai)
#pragma unroll
                for (int bj = 0; bj < 2; ++bj)
#pragma unroll
                    for (int n = 0; n < 2; ++n) XB[((wv * 4 + ai * 2 + 1) * 2 + bj) * 8 + 2 * fq + n] = acc[ai][bj][3][n]; }
        asm volatile("s_waitcnt lgkmcnt(0)" ::: "memory"); __builtin_amdgcn_s_barrier(); asm volatile("" ::: "memory");
        float* hb = HALO + (size_t)(samp ? u.pm - 32 : 0) * 4 * 5632;
#pragma unroll
        for (int ai = 0; ai < 2; ++ai) {
            const bool has_ab = !(wr == 0 && ai == 0), has_bl = !(wr == 1 && ai == 1);
            const int wab = (wr == 0) ? 1 : (ai == 0 ? 1 : 3), wbl = (wr == 0) ? (ai == 0 ? 0 : 2) : 2;
            unsigned pk[4][4];
#pragma unroll
            for (int n = 0; n < 2; ++n) {
                f32x4 ca[4];
#pragma unroll
                for (int bj = 0; bj < 2; ++bj) {
                    const PG8_LAS f32x4* wlp = WL + ((((wr * 4 + wc) * 4 + fq) * 2 + n) * 2 + bj) * 3;
                    const f32x4 w0 = wlp[0], w1 = wlp[1], w2 = wlp[2];
                    f32x4 ab = (f32x4){0.f, 0.f, 0.f, 0.f}, bl = ab;
                    if (has_ab) ab = XB[((pw * 4 + wab) * 2 + bj) * 8 + 2 * fq + n];
                    if (has_bl) bl = XB[((pw * 4 + wbl) * 2 + bj) * 8 + 2 * fq + n];
#pragma unroll
                    for (int m = 0; m < 4; ++m) {
                        f32x4 cvm;
#pragma unroll
                        for (int i = 0; i < 4; ++i) {
                            const float cur = acc[ai][bj][m][n][i];
                            const float pv = m == 0 ? ab[i] : acc[ai][bj][m == 0 ? 0 : m - 1][n][i];
                            const float nx = m == 3 ? bl[i] : acc[ai][bj][m == 3 ? 3 : m + 1][n][i];
                            const float up = dpp_ror1(fr == 15 ? pv : cur), dn = dpp_ror15(fr == 0 ? nx : cur);
                            cvm[i] = w0[i] * up + w1[i] * cur + w2[i] * dn;
                        }
                        if (samp) {
                            if (m == 0 && wr == 0 && ai == 0 && fr == 0) { *(f32x4*)(hb + 0 * 5632 + bj * 2816 + j0 + 4 * n) = acc[ai][bj][0][n]; *(f32x4*)(hb + 1 * 5632 + bj * 2816 + j0 + 4 * n) = cvm; }
                            if (m == 3 && wr == 1 && ai == 1 && fr == 15) { *(f32x4*)(hb + 2 * 5632 + bj * 2816 + j0 + 4 * n) = acc[ai][bj][3][n]; *(f32x4*)(hb + 3 * 5632 + bj * 2816 + j0 + 4 * n) = cvm; }
                        }
                        if (bj == 0) ca[m] = cvm;
                        else { float r[4];
#pragma unroll
                            for (int i = 0; i < 4; ++i) { const float xa = ca[m][i]; r[i] = xa * __builtin_amdgcn_rcpf(1.f + __builtin_amdgcn_exp2f(-xa * 1.4426950408889634f)) * cvm[i]; }
                            pk[m][2 * n] = cvt_pk_bf16(r[0], r[1]); pk[m][2 * n + 1] = cvt_pk_bf16(r[2], r[3]); }
                    }
                }
                __builtin_amdgcn_sched_barrier(0);
            }
#pragma unroll
            for (int m = 0; m < 4; ++m) *(u32x4*)(ACT + (size_t)(row0 + ai * HALF + m * 16) * 2816 + j0) = (u32x4){pk[m][0], pk[m][1], pk[m][2], pk[m][3]};
        }
    }
};

template <class Epi, class Sched, bool ALIGN_EPI = false, bool SP2 = false>
__device__ __forceinline__ void gemm_phase(PG8_LAS unsigned char* lds, const Gemm g, const Sched& S, const Epi& E, const int tid) {
    const int wid = __builtin_amdgcn_readfirstlane(tid >> 6), lane = tid & 63, wr = wid >> 2, wc = wid & 3, fr = lane & 15, fq = lane >> 4;
    const int K = g.K, nt = K / BK;
    unsigned voffA[2], voffB[2];
#pragma unroll
    for (int i = 0; i < 2; ++i) { int R, C; stage_rc(tid * 16 + i * 8192, R, C); const int Rb = Epi::PERM ? ((R & ~31) + perm32(R & 31)) : R;
        voffA[i] = (unsigned)(R * K + C) * 2u; voffB[i] = (unsigned)(Rb * K + C) * 2u; }
    const size_t kstep = (size_t)(BK * 2);
    const size_t hstep = (size_t)HALF * K * 2;
    const size_t tstep = 2 * hstep;
    const size_t bstep = g.bstep ? g.bstep : tstep, bh = g.bhalf ? g.bhalf : hstep;
    const unsigned ldsw = (unsigned)wid * 1024u;
    const int aoff = lds_byte(wr * 64 + fr, fq * 8), boff = lds_byte(wc * 32 + fr, fq * 8);
#define PG8_SA(b, h) (((b) * 2 + (h)) * HTB)
#define PG8_SB(b, h) ((4 + (b) * 2 + (h)) * HTB)
#define PG8_STAGE(bufoff, gbase, voff) do { _Pragma("unroll") for (int _i = 0; _i < 2; ++_i) \
        __builtin_amdgcn_global_load_lds((const unsigned*)((const char*)(gbase) + (voff)[_i]), (PG8_LAS unsigned*)(lds + (bufoff) + ldsw + _i * 8192), 16, 0, 0); } while (0)
#define PG8_LDA(dst, b, h) do { _Pragma("unroll") for (int m = 0; m < 4; ++m) _Pragma("unroll") for (int k = 0; k < 2; ++k) dst[m][k] = *(const PG8_LAS bf16x8*)(lds + PG8_SA(b, h) + aoff + m * 2048 + k * 1024); } while (0)
#define PG8_LDB(dst, b, h) do { _Pragma("unroll") for (int n = 0; n < 2; ++n) _Pragma("unroll") for (int k = 0; k < 2; ++k) dst[n][k] = *(const PG8_LAS bf16x8*)(lds + PG8_SB(b, h) + boff + n * 2048 + k * 1024); } while (0)
#define PG8_MMA(ai, bj, At, Bt) do { __builtin_amdgcn_s_setprio(1); _Pragma("unroll") for (int m = 0; m < 4; ++m) _Pragma("unroll") for (int n = 0; n < 2; ++n) _Pragma("unroll") for (int k = 0; k < 2; ++k) \
        acc[ai][bj][m][n] = __builtin_amdgcn_mfma_f32_16x16x32_bf16(Bt[n][k], At[m][k], acc[ai][bj][m][n], 0, 0, 0); __builtin_amdgcn_s_setprio(0); } while (0)
#define PG8_WAIT_V(n) asm volatile("s_waitcnt vmcnt(" #n ")" ::: "memory")
#define PG8_WAIT_L(n) asm volatile("s_waitcnt lgkmcnt(" #n ")" ::: "memory")
#define PG8_BAR __builtin_amdgcn_s_barrier()
#define PG8_SCHED __builtin_amdgcn_sched_barrier(0)
    Unit cur, nxt; int ui = 0;
    if (!S.next(0, cur)) return;
    f32x4 acc[2][2][4][2];
#pragma unroll
    for (int a = 0; a < 2; ++a)
#pragma unroll
        for (int b = 0; b < 2; ++b)
#pragma unroll
            for (int m = 0; m < 4; ++m)
#pragma unroll
                for (int n = 0; n < 2; ++n) acc[a][b][m][n] = (f32x4){0.f, 0.f, 0.f, 0.f};
    bf16x8 At[4][2], B0[2][2], B1[2][2];
    const char* cA = (const char*)g.A + (size_t)cur.pm * tstep; const char* cB = (const char*)g.Bt + (size_t)cur.pn * bstep;
    S.a_ready(cur);
    if constexpr (SP2) {
        PG8_STAGE(PG8_SB(0, 0), cB, voffB); PG8_STAGE(PG8_SB(0, 1), cB + bh, voffB); PG8_STAGE(PG8_SA(0, 0), cA, voffA); PG8_STAGE(PG8_SA(0, 1), cA + hstep, voffA);
        if (wr == 1) PG8_BAR;
        PG8_WAIT_V(2); PG8_BAR;
        PG8_STAGE(PG8_SB(1, 0), cB + kstep, voffB); PG8_STAGE(PG8_SA(1, 0), cA + kstep, voffA); PG8_STAGE(PG8_SB(1, 1), cB + bh + kstep, voffB);
        PG8_WAIT_V(6); PG8_BAR;
    } else {
        PG8_STAGE(PG8_SB(0, 0), cB, voffB); PG8_STAGE(PG8_SA(0, 0), cA, voffA); PG8_STAGE(PG8_SB(0, 1), cB + bh, voffB); PG8_STAGE(PG8_SA(0, 1), cA + hstep, voffA);
        if (wr == 1) PG8_BAR;
        PG8_WAIT_V(4); PG8_BAR;
        PG8_STAGE(PG8_SB(1, 0), cB + kstep, voffB); PG8_STAGE(PG8_SA(1, 0), cA + kstep, voffA); PG8_STAGE(PG8_SB(1, 1), cB + bh + kstep, voffB);
        PG8_WAIT_V(6); PG8_BAR;
    }
    for (;;) {
        const bool has_next = S.next(ui + 1, nxt);
        const char* nA = has_next ? (const char*)g.A + (size_t)nxt.pm * tstep : cA; const char* nB = has_next ? (const char*)g.Bt + (size_t)nxt.pn * bstep : cB;
        for (int t = 0; t < nt; t += 2) {
            const bool last = (t == nt - 2);
            const char* a1 = cA + (size_t)(t + 1) * kstep;
            const char* a2 = last ? nA : cA + (size_t)(t + 2) * kstep; const char* b2 = last ? nB : cB + (size_t)(t + 2) * kstep;
            const char* a3 = a2 + kstep; const char* b3 = b2 + kstep;
            if (last && has_next) S.a_ready(nxt);
            if constexpr (SP2) {
            PG8_LDB(B0, 0, 0); PG8_LDB(B1, 0, 1); PG8_SCHED; PG8_LDA(At, 0, 0); PG8_STAGE(PG8_SA(1, 1), a1 + hstep, voffA);
            PG8_WAIT_V(8); PG8_WAIT_L(0); PG8_BAR; PG8_MMA(0, 0, At, B0); PG8_MMA(0, 1, At, B1); PG8_BAR; PG8_SCHED;
            PG8_LDA(At, 0, 1); PG8_STAGE(PG8_SB(0, 0), b2, voffB); PG8_STAGE(PG8_SB(0, 1), b2 + bh, voffB); PG8_STAGE(PG8_SA(0, 0), a2, voffA);
            PG8_WAIT_V(8); PG8_WAIT_L(0); PG8_BAR; PG8_MMA(1, 0, At, B0); PG8_MMA(1, 1, At, B1); PG8_BAR; PG8_SCHED;
            PG8_LDB(B0, 1, 0); PG8_LDB(B1, 1, 1); PG8_SCHED; PG8_LDA(At, 1, 0); PG8_STAGE(PG8_SA(0, 1), a2 + hstep, voffA);
            PG8_WAIT_V(8); PG8_WAIT_L(0); PG8_BAR; PG8_MMA(0, 0, At, B0); PG8_MMA(0, 1, At, B1); PG8_BAR; PG8_SCHED;
            PG8_LDA(At, 1, 1); PG8_STAGE(PG8_SB(1, 0), b3, voffB); PG8_STAGE(PG8_SB(1, 1), b3 + bh, voffB); PG8_STAGE(PG8_SA(1, 0), a3, voffA);
            PG8_WAIT_V(8); PG8_WAIT_L(0); PG8_BAR; PG8_MMA(1, 0, At, B0); PG8_MMA(1, 1, At, B1); PG8_BAR; PG8_SCHED;
            } else {
            PG8_LDB(B0, 0, 0); PG8_SCHED; PG8_LDA(At, 0, 0); PG8_STAGE(PG8_SA(1, 1), a1 + hstep, voffA);
            PG8_WAIT_L(8); PG8_BAR; PG8_WAIT_L(0); PG8_MMA(0, 0, At, B0); PG8_BAR; PG8_SCHED;
            PG8_LDB(B1, 0, 1); PG8_STAGE(PG8_SB(0, 0), b2, voffB);
            PG8_BAR; PG8_WAIT_L(0); PG8_MMA(0, 1, At, B1); PG8_BAR;
            PG8_LDA(At, 0, 1); PG8_STAGE(PG8_SA(0, 0), a2, voffA);
            PG8_BAR; PG8_WAIT_L(0); PG8_MMA(1, 0, At, B0); PG8_BAR; PG8_SCHED;
            PG8_STAGE(PG8_SB(0, 1), b2 + bh, voffB);
            PG8_WAIT_V(6); PG8_BAR; PG8_MMA(1, 1, At, B1); PG8_BAR;
            PG8_LDB(B0, 1, 0); PG8_SCHED; PG8_LDA(At, 1, 0); PG8_STAGE(PG8_SA(0, 1), a2 + hstep, voffA);
            PG8_WAIT_L(8); PG8_BAR; PG8_WAIT_L(0); PG8_MMA(0, 0, At, B0); PG8_BAR; PG8_SCHED;
            PG8_LDB(B1, 1, 1); PG8_STAGE(PG8_SB(1, 0), b3, voffB);
            PG8_BAR; PG8_WAIT_L(0); PG8_MMA(0, 1, At, B1); PG8_BAR;
            PG8_LDA(At, 1, 1); PG8_STAGE(PG8_SA(1, 0), a3, voffA);
            PG8_BAR; PG8_WAIT_L(0); PG8_MMA(1, 0, At, B0); PG8_BAR; PG8_SCHED;
            PG8_STAGE(PG8_SB(1, 1), b3 + bh, voffB);
            PG8_WAIT_V(6); PG8_BAR; PG8_MMA(1, 1, At, B1); PG8_BAR;
            }
        }
        if constexpr (ALIGN_EPI) { if (wr == 0) PG8_BAR; }
        if constexpr (!Epi::AFTER_DRAIN) { E(acc, cur, wr, wc, fr, fq); S.done(cur); }
        if (!has_next) break;
#pragma unroll
        for (int a = 0; a < 2; ++a)
#pragma unroll
            for (int b = 0; b < 2; ++b)
#pragma unroll
                for (int m = 0; m < 4; ++m)
#pragma unroll
                    for (int n = 0; n < 2; ++n) acc[a][b][m][n] = (f32x4){0.f, 0.f, 0.f, 0.f};
        cur = nxt; cA = nA; cB = nB; ++ui;
        if constexpr (ALIGN_EPI) { if (wr == 1) PG8_BAR; }
    }
    PG8_WAIT_V(0);
    if constexpr (!ALIGN_EPI) { if (wr == 0) PG8_BAR; }
    PG8_BAR;
#undef PG8_SA
#undef PG8_SB
#undef PG8_STAGE
#undef PG8_LDA
#undef PG8_LDB
#undef PG8_MMA
#undef PG8_WAIT_V
#undef PG8_WAIT_L
#undef PG8_BAR
#undef PG8_SCHED
}
}

#define LAS __attribute__((address_space(3)))
#define CAS __attribute__((address_space(4)))
typedef unsigned short bf16;
typedef float f32x4 __attribute__((ext_vector_type(4)));
typedef short bf16x8 __attribute__((ext_vector_type(8)));
typedef unsigned u32x4 __attribute__((ext_vector_type(4)));
typedef unsigned u32x2 __attribute__((ext_vector_type(2)));

constexpr int NW = 8, NT = 512;
constexpr int DM = 1024, NTOK = 12288, NPR = 8192, NKR = 13312, INC = 2144, INP = 2304, DFF = 2816, DUP = 5632;
constexpr float EPS = 1e-6f, LOG2E = 1.4426950408889634f;
constexpr float QS = 0.125f * LOG2E;
constexpr float MLAQS = 0.10206207261596575f * LOG2E;

constexpr size_t MiB = 1u << 20;
constexpr size_t WS_CTL = 0, WS_MOD = 1 * MiB, WS_ROPE = 1 * MiB + 256 * 1024, WS_W = 2 * MiB, W_LSTRIDE = 24 * MiB;
constexpr size_t W_IN = 0, W_OUT = 4718592, W_UP = W_OUT + 2097152, W_DOWN = W_UP + 11534336, W_B2 = W_DOWN + 5767168;
static_assert(W_B2 + 786432 <= W_LSTRIDE, "weights");
constexpr size_t WS_XN = 50 * MiB, WS_PROJ = 74 * MiB, WS_A2 = 128 * MiB, WS_MQKV = 138 * MiB, WS_QC = 164 * MiB, WS_KPE = 203 * MiB, WS_YCAT = 204 * MiB;
constexpr size_t WS_ACT = 116 * MiB, WS_U = 116 * MiB, WS_SS1 = 228 * MiB, WS_SS2 = 229 * MiB, WS_HALO = 230 * MiB, WS_XRES = 232 * MiB, WS_END = 256 * MiB;
constexpr size_t WS_BIAS = 65536;
constexpr int NBIAS = 2304 + 5632;
constexpr size_t QSZ = (size_t)NKR * 256 * 2, KSZ = (size_t)NKR * 128 * 2;
constexpr int LDS_BYTES = 163840, LDS_CTL = 163840 - 256;
constexpr size_t WS_BAR = 16384;

struct Args { const float* in[28]; float* out; unsigned char* ws; };

__device__ __forceinline__ unsigned f2bf(float f) { unsigned u = __builtin_bit_cast(unsigned, f); return (u + 0x7fffu + ((u >> 16) & 1u)) >> 16; }
__device__ __forceinline__ unsigned pk2(float lo, float hi) { unsigned r; asm("v_cvt_pk_bf16_f32 %0, %1, %2" : "=v"(r) : "v"(lo), "v"(hi)); return r; }
__device__ __forceinline__ float bflo(unsigned u) { return __builtin_bit_cast(float, u << 16); }
__device__ __forceinline__ float bfhi(unsigned u) { return __builtin_bit_cast(float, u & 0xffff0000u); }
__device__ __forceinline__ f32x4 ld4bf(const bf16* p) { const u32x2 u = *(const u32x2*)p; return (f32x4){bflo(u.x), bfhi(u.x), bflo(u.y), bfhi(u.y)}; }
__device__ __forceinline__ void st4bf(bf16* p, f32x4 v) { u32x2 u; u.x = pk2(v[0], v[1]); u.y = pk2(v[2], v[3]); *(u32x2*)p = u; }
__device__ __forceinline__ float shx(float v, int m, int lane) { return __builtin_bit_cast(float, __builtin_amdgcn_ds_bpermute((lane ^ m) << 2, __builtin_bit_cast(int, v))); }
#define DPPF(v, ctrl) __builtin_bit_cast(float, __builtin_amdgcn_mov_dpp(__builtin_bit_cast(int, (v)), (ctrl), 0xf, 0xf, false))
__device__ __forceinline__ float sum16(float v, int) { v += DPPF(v, 0x121); v += DPPF(v, 0x122); v += DPPF(v, 0x124); v += DPPF(v, 0x128); return v; }
__device__ __forceinline__ float wave_sum(float v, int lane) {
    v = sum16(v, lane);
    const int iv = __builtin_bit_cast(int, v);
    const float a = __builtin_bit_cast(float, __builtin_amdgcn_readlane(iv, 0)), b = __builtin_bit_cast(float, __builtin_amdgcn_readlane(iv, 16)),
                c = __builtin_bit_cast(float, __builtin_amdgcn_readlane(iv, 32)), d = __builtin_bit_cast(float, __builtin_amdgcn_readlane(iv, 48));
    return (a + b) + (c + d);
}
__device__ __forceinline__ float dot4(f32x4 a) { return (a[0] * a[0] + a[1] * a[1]) + (a[2] * a[2] + a[3] * a[3]); }
__device__ __forceinline__ f32x4 shfl4(f32x4 v, int m, int lane) { return (f32x4){shx(v[0], m, lane), shx(v[1], m, lane), shx(v[2], m, lane), shx(v[3], m, lane)}; }

__device__ __forceinline__ void transpose_item(const float* W, int N, bf16* WT, int ldk, int row_off, int k_off, float scale, LAS float* scr, int item, int lane) {
    const int nblk = (N + 63) / 64, kb = item / nblk, nb = item % nblk, k0 = 64 * kb, n0 = 64 * nb;
    const bool act = n0 + lane < N;
    const float* wp = W + (size_t)k0 * N + n0 + lane;
    float v[64];
#pragma unroll
    for (int i = 0; i < 64; ++i) v[i] = act ? __builtin_nontemporal_load(wp + (size_t)i * N) : 0.f;
#pragma unroll
    for (int i = 0; i < 64; ++i) scr[i * 65 + lane] = v[i] * scale;
    asm volatile("s_waitcnt lgkmcnt(0)" ::: "memory");
    const int c = lane & 7;
#pragma unroll
    for (int j = 0; j < 8; ++j) { const int n = (lane >> 3) + 8 * j; const LAS float* s = scr + (8 * c) * 65 + n;
        u32x4 o; o.x = pk2(s[0 * 65], s[1 * 65]); o.y = pk2(s[2 * 65], s[3 * 65]); o.z = pk2(s[4 * 65], s[5 * 65]); o.w = pk2(s[6 * 65], s[7 * 65]);
        if (n0 + n < N) *(u32x4*)(WT + (size_t)(row_off + n0 + n) * ldk + k_off + k0 + 8 * c) = o; }
    asm volatile("s_waitcnt lgkmcnt(0)" ::: "memory");
}

template <class ArgsRef>
__device__ __forceinline__ void wconv(const ArgsRef& a, unsigned char* ws, int l, int sel, int w, int nwk, LAS float* scr, int lane) {
    constexpr int I_IN = 16 * 34, I_OUT = 16 * 16, I_UP = 16 * 88, I_DN = 44 * 16, I_Q = 3 * 6, I_KV = 2 * 8;
    const int n_in = (sel & 1) ? I_IN : 0, n_out = (sel & 2) ? I_OUT : 0, n_up = (sel & 4) ? I_UP : 0, n_dn = (sel & 8) ? I_DN : 0, n_q = (sel & 16) ? I_Q : 0, n_kv = (sel & 32) ? I_KV : 0;
    const int total = n_in + n_out + n_up + n_dn + n_q + n_kv;
    unsigned char* wl = ws + WS_W + l * W_LSTRIDE;
    for (int it = w; it < total; it += nwk) {
        int r = it;
        if (r < n_in) { transpose_item(a.in[13] + (size_t)l * 1024 * INC, INC, (bf16*)(wl + W_IN), 1024, 0, 0, 1.f, scr, r, lane); continue; } r -= n_in;
        if (r < n_out) { transpose_item(a.in[22] + (size_t)l * 1024 * 1024, 1024, (bf16*)(wl + W_OUT), 1024, 0, 0, 1.f, scr, r, lane); continue; } r -= n_out;
        if (r < n_up) { transpose_item(a.in[24] + (size_t)l * 1024 * DUP, DUP, (bf16*)(wl + W_UP), 1024, 0, 0, 1.f, scr, r, lane); continue; } r -= n_up;
        if (r < n_dn) { transpose_item(a.in[26] + (size_t)l * DFF * 1024, 1024, (bf16*)(wl + W_DOWN), DFF, 0, 0, 1.f, scr, r, lane); continue; } r -= n_dn;
        if (r < n_q) { transpose_item(a.in[16] + (size_t)l * 192 * 384, 384, (bf16*)(wl + W_B2), 384, 0, 0, MLAQS, scr, r, lane); continue; } r -= n_q;
        transpose_item(a.in[18] + (size_t)l * 128 * 512, 512, (bf16*)(wl + W_B2), 384, 384, 192, 1.f, scr, r, lane);
    }
}
template <class ArgsRef>
__device__ __forceinline__ void phase0(const ArgsRef& a, LAS unsigned char* lds, int tid, int lane, int wave) {
    unsigned char* ws = a.ws;
    const int G = gridDim.x, bid = blockIdx.x;
    if (bid < 96) {
        LAS float* sl = (LAS float*)(lds + 16384);
        for (int e = tid; e < 3072; e += NT) { const int c = e >> 10, k = e & 1023; const float v = c == 0 ? a.in[9][k] : a.in[8][(c - 1) * 1024 + k]; sl[e] = v / (1.f + __expf(-v)); }
        __syncthreads();
    }
    for (int it = bid; it < 96; it += G) {
        const int l = it / 48, n0 = (it % 48) * 128;
        const float* wa = a.in[10] + (size_t)l * 1024 * 6144;
        const LAS float* sl = (const LAS float*)(lds + 16384);
        float acc[3][2] = {{0.f, 0.f}, {0.f, 0.f}, {0.f, 0.f}};
        const int kb = wave * 128;
#pragma unroll 16
        for (int k = 0; k < 128; ++k) {
            const int kk = kb + k;
            typedef float f32x2_ __attribute__((ext_vector_type(2)));
            const f32x2_ w = __builtin_nontemporal_load((const f32x2_*)(wa + (size_t)kk * 6144 + n0 + 2 * lane));
            const float s0 = sl[kk], s1 = sl[1024 + kk], s2 = sl[2048 + kk];
            acc[0][0] += s0 * w.x; acc[0][1] += s0 * w.y; acc[1][0] += s1 * w.x; acc[1][1] += s1 * w.y; acc[2][0] += s2 * w.x; acc[2][1] += s2 * w.y;
        }
        LAS float* red = (LAS float*)lds;
#pragma unroll
        for (int c = 0; c < 3; ++c) { red[(wave * 3 + c) * 128 + 2 * lane] = acc[c][0]; red[(wave * 3 + c) * 128 + 2 * lane + 1] = acc[c][1]; }
        __syncthreads();
        if (tid < 384) { const int c = tid / 128, n = tid % 128; float s = 0.f;
#pragma unroll
            for (int w = 0; w < 8; ++w) s += red[(w * 3 + c) * 128 + n];
            ((float*)(ws + WS_MOD))[(size_t)(l * 3 + c) * 6144 + n0 + n] = s + a.in[11][(size_t)l * 6144 + n0 + n]; }
        __syncthreads();
    }
    if (bid == G - 1) {
        float* rt = (float*)(ws + WS_ROPE);
        for (int e = tid; e < 1024; e += NT) { const int pos = e >> 4, i = e & 15; const float inv = exp2f(-(float)(2 * i) / 32.f * 13.287712379549449f); const float ang = (float)pos * inv;
            rt[e] = __cosf(ang); rt[1024 + e] = __sinf(ang); }
        for (int e = tid; e < 512; e += NT) { const int pos = e >> 3, i = e & 7; const float inv = exp2f(-(float)(2 * i) / 16.f * 13.287712379549449f); const float ang = (float)pos * inv;
            rt[2048 + e] = __cosf(ang); rt[2560 + e] = __sinf(ang); }
    }
    const int gt = bid * NT + tid, NGT = G * NT;
    if (gt < 256) ((unsigned*)(ws + WS_CTL))[gt] = 0u;
    if (gt < 64) ((unsigned*)(ws + WS_CTL))[2048 + gt] = 0u;
    for (int l = 0; l < 2; ++l) {
        bf16* b2 = (bf16*)(ws + WS_W + l * W_LSTRIDE + W_B2);
        for (int ch = gt; ch < 1024 * 48; ch += NGT) { const int n = ch / 48, k = (ch % 48) * 8;
            const bool data = (n < 384 && k < 192) || (n >= 384 && n < 896 && k >= 192 && k < 320);
            if (!data) *(u32x4*)(b2 + (size_t)n * 384 + k) = (u32x4){0u, 0u, 0u, 0u}; }
        bf16* wi = (bf16*)(ws + WS_W + l * W_LSTRIDE + W_IN) + (size_t)INC * 1024;
        for (int ch = gt; ch < 160 * 128; ch += NGT) *(u32x4*)(wi + (size_t)ch * 8) = (u32x4){0u, 0u, 0u, 0u};
    }
    LAS float* scr = (LAS float*)(lds + 28672 + wave * 16640);
    wconv(a, ws, 0, 1 | 2 | 16 | 32, ((bid + G - (G > 96 ? 96 : 0)) % G) * NW + wave, G * NW, scr, lane);
}

__device__ __forceinline__ void prep_phase(const float* x0, const float* x1, const float* nw, const float* mod, int sc_off, bf16* XN, float* SS, int lane, int gw, int NGW) {
    for (int row = gw; row < NTOK; row += NGW) {
        const float* xr = row < NPR ? x0 + (size_t)row * DM : x1 + (size_t)(row - NPR) * DM;
        const int c = row < NPR ? 0 : 1 + ((row - NPR) >> 11);
        const float* mp = mod + c * 6144;
        f32x4 v[4]; float ss = 0.f;
#pragma unroll
        for (int j = 0; j < 4; ++j) { v[j] = __builtin_nontemporal_load((const f32x4*)(xr + 4 * (lane + 64 * j))); ss += dot4(v[j]); }
        ss = wave_sum(ss, lane);
#pragma unroll
        for (int j = 0; j < 4; ++j) { const int col = 4 * (lane + 64 * j);
            const f32x4 g = *(const f32x4*)(nw + col), sc = *(const f32x4*)(mp + sc_off + col);
            st4bf(XN + (size_t)row * DM + col, v[j] * g * (1.f + sc)); }
        if (lane < 16) SS[(size_t)row * 16 + lane] = lane == 0 ? ss : 0.f;
    }
}
template <class ArgsRef>
__device__ __forceinline__ void bias_phase(const ArgsRef& a, unsigned char* ws, LAS unsigned char* lds, int tid, int lane, int wave) {
    const float* mod = (const float*)(ws + WS_MOD);
    float* BIAS = (float*)(ws + WS_BIAS);
    for (int it = blockIdx.x; it < 62; it += gridDim.x) {
        const int l = it / 31, r = it % 31; const bool up = r >= 9;
        const int N = up ? DUP : INC, n0 = (up ? r - 9 : r) * 256 + 4 * lane;
        const float* W = up ? a.in[24] + (size_t)l * 1024 * DUP : a.in[13] + (size_t)l * 1024 * INC;
        const float* shp = mod + (size_t)l * 3 * 6144 + (up ? 3072 : 0);
        LAS float* sl = (LAS float*)(lds + 32768);
        for (int e = tid; e < 3072; e += NT) sl[e] = shp[(e >> 10) * 6144 + (e & 1023)];
        __syncthreads();
        const bool act = n0 < N;
        f32x4 acc[3] = {(f32x4){0.f, 0.f, 0.f, 0.f}, (f32x4){0.f, 0.f, 0.f, 0.f}, (f32x4){0.f, 0.f, 0.f, 0.f}};
        const int kb = wave * 128;
#pragma unroll 16
        for (int k = 0; k < 128; ++k) { const int kk = kb + k;
            const f32x4 w = act ? __builtin_nontemporal_load((const f32x4*)(W + (size_t)kk * N + n0)) : (f32x4){0.f, 0.f, 0.f, 0.f};
            acc[0] += w * sl[kk]; acc[1] += w * sl[1024 + kk]; acc[2] += w * sl[2048 + kk]; }
        LAS f32x4* red = (LAS f32x4*)lds;
#pragma unroll
        for (int c = 0; c < 3; ++c) red[(wave * 3 + c) * 64 + lane] = acc[c];
        __syncthreads();
        if (tid < 192) { const int c = tid >> 6, ln = tid & 63; f32x4 t = red[c * 64 + ln];
#pragma unroll
            for (int w = 1; w < 8; ++w) t += red[(w * 3 + c) * 64 + ln];
            const int nn = (up ? r - 9 : r) * 256 + 4 * ln;
            if (nn < N) *(f32x4*)(BIAS + (size_t)(l * 3 + c) * NBIAS + (up ? 2304 : 0) + nn) = t;
            else if (!up && nn < 2304) *(f32x4*)(BIAS + (size_t)(l * 3 + c) * NBIAS + nn) = (f32x4){0.f, 0.f, 0.f, 0.f}; }
        __syncthreads();
    }
}

struct P3Ptrs {
    const bf16* PROJ; bf16 *A2, *KPE, *YCAT, *Qc_rot, *Qc_raw, *Kc, *Vc, *Qd_rot, *Qd_raw, *Kd, *Vd;
    const float *conv_a, *gq_mla, *gkv_mla, *gq, *gk, *rope;
    const float *c_ckv, *c_kpe, *c_gk, *c_gv, *c_sk, *c_sv;
    float *o_ckv, *o_kpe, *o_gk, *o_gv, *o_sk, *o_sv;
    int l;
};
__device__ __forceinline__ f32x4 rope64(f32x4 v, int jl, int prow, int pcol, const float* rt, int lane) {
    const f32x4 pr = shfl4(v, 4, lane);
    const int pos = jl < 8 ? prow : pcol, fi = 4 * (jl & 3);
    const f32x4 c = *(const f32x4*)(rt + pos * 16 + fi), s = *(const f32x4*)(rt + 1024 + pos * 16 + fi);
    const float sg = (jl & 4) ? 1.f : -1.f;
    return v * c + pr * s * sg;
}
__device__ __forceinline__ void p3_phase(const P3Ptrs& P, int lane, int gw, int NGW) {
    const int l = P.l;
    for (int row = gw; row < NKR; row += NGW) {
        if (row < NTOK) {
            const bool samp = row >= NPR;
            int b, t, kr, T;
            if (!samp) { b = row >> 8; t = row & 255; kr = row; T = 256; } else { b = (row - NPR) >> 11; t = (row - NPR) & 2047; kr = NPR + b * 2560 + t; T = 2048; }
            const int prow = t >> 6, pcol = t & 63;
            const bf16* pr = P.PROJ + (size_t)row * INP;
            const size_t ob = (size_t)((b * 2 + l) * 256 + t);
            const int ci = 4 * lane, jl = lane & 15;
            const u32x2 z2 = (u32x2){0u, 0u};
            const bool hp = t > 0, hn = t < T - 1;
            const u32x2 r_xa = *(const u32x2*)(pr + ci), r_gb = *(const u32x2*)(pr + 256 + ci), r_gc = *(const u32x2*)(pr + 512 + ci);
            const u32x2 r_pxa = hp ? *(const u32x2*)(pr - INP + ci) : z2, r_pgc = hp ? *(const u32x2*)(pr - INP + 512 + ci) : z2;
            const u32x2 r_nxa = hn ? *(const u32x2*)(pr + INP + ci) : z2, r_ngc = hn ? *(const u32x2*)(pr + INP + 512 + ci) : z2;
            const u32x2 r_cq = lane < 48 ? *(const u32x2*)(pr + 768 + ci) : z2, r_ckv = lane < 32 ? *(const u32x2*)(pr + 960 + ci) : z2, r_kpe = lane < 8 ? *(const u32x2*)(pr + 1088 + ci) : z2;
            const u32x2 r_qc = *(const u32x2*)(pr + 1120 + ci), r_kvc = *(const u32x2*)(pr + 1376 + ci), r_qd = *(const u32x2*)(pr + 1632 + ci), r_kvd = *(const u32x2*)(pr + 1888 + ci);
            const float* cw = P.conv_a + (size_t)l * 768;
            const f32x4 w0 = *(const f32x4*)(cw + ci), w1 = *(const f32x4*)(cw + 256 + ci), w2 = *(const f32x4*)(cw + 512 + ci);
            const f32x4 g_qm = lane < 48 ? *(const f32x4*)(P.gq_mla + l * 192 + ci) : (f32x4){0.f, 0.f, 0.f, 0.f}, g_kvm = lane < 32 ? *(const f32x4*)(P.gkv_mla + l * 128 + ci) : (f32x4){0.f, 0.f, 0.f, 0.f};
            const f32x4 g_q = *(const f32x4*)(P.gq + l * 64 + 4 * jl), g_k = *(const f32x4*)(P.gk + l * 64 + 4 * jl);
            const int pos64 = jl < 8 ? prow : pcol, fi64 = 4 * (jl & 3);
            const f32x4 c64 = *(const f32x4*)(P.rope + pos64 * 16 + fi64), s64 = *(const f32x4*)(P.rope + 1024 + pos64 * 16 + fi64);
            const int pos32 = (lane & 7) < 4 ? prow : pcol, fi32 = 4 * (lane & 1);
            const f32x4 c32 = *(const f32x4*)(P.rope + 2048 + pos32 * 8 + fi32), s32 = *(const f32x4*)(P.rope + 2560 + pos32 * 8 + fi32);
#define CV4(u) ((f32x4){bflo((u).x), bfhi((u).x), bflo((u).y), bfhi((u).y)})
#define ROPE64(v) ((v) * c64 + shfl4((v), 4, lane) * s64 * ((jl & 4) ? 1.f : -1.f))
            { const f32x4 ya = CV4(r_gb) * (w0 * (CV4(r_pxa) * CV4(r_pgc)) + w1 * (CV4(r_xa) * CV4(r_gc)) + w2 * (CV4(r_nxa) * CV4(r_ngc)));
              st4bf(P.YCAT + (size_t)row * DM + ci, ya); }
            { const f32x4 v = CV4(r_cq);
              const float rs = rsqrtf(wave_sum(dot4(v), lane) * (1.f / 192.f) + EPS);
              if (lane < 48) st4bf(P.A2 + (size_t)kr * 384 + ci, v * rs * g_qm); }
            { const f32x4 v = CV4(r_ckv);
              const float rs = rsqrtf(wave_sum(dot4(v), lane) * (1.f / 128.f) + EPS);
              if (lane < 32) { const f32x4 o = v * rs * g_kvm;
                  st4bf(P.A2 + (size_t)kr * 384 + 192 + ci, o);
                  if (!samp) __builtin_nontemporal_store((f32x4)(o), (f32x4*)(P.o_ckv + ob * 128 + ci)); }
              else if (lane < 48) { unsigned zz = 0u; asm volatile("" : "+v"(zz)); *(u32x2*)(P.A2 + (size_t)kr * 384 + 320 + 4 * (lane - 32)) = (u32x2){zz, zz}; } }
            { const f32x4 v = CV4(r_kpe);
              const f32x4 r = v * c32 + shfl4(v, 2, lane) * s32 * ((lane & 2) ? 1.f : -1.f);
              if (lane < 8) { if (!samp) __builtin_nontemporal_store((f32x4)(v), (f32x4*)(P.o_kpe + ob * 32 + ci)); st4bf(P.KPE + (size_t)kr * 32 + ci, samp ? r : v); } }
            { f32x4 v = CV4(r_qc);
              const float rs = rsqrtf(sum16(dot4(v), lane) * (1.f / 64.f) + EPS);
              v = v * rs * g_q;
              st4bf(P.Qc_raw + (size_t)kr * 256 + ci, v * QS);
              const f32x4 r = ROPE64(v);
              if (samp) st4bf(P.Qc_rot + (size_t)kr * 256 + ci, r * QS); }
            { const f32x4 v = CV4(r_kvc);
              const float rs = rsqrtf(sum16(dot4(v), lane) * (1.f / 64.f) + EPS);
              const f32x4 kn = v * rs * g_k;
              const f32x4 r = ROPE64(kn);
              if (lane < 32) { if (!samp) __builtin_nontemporal_store((f32x4)(kn), (f32x4*)(P.o_gk + ob * 128 + ci)); st4bf(P.Kc + (size_t)kr * 128 + ci, samp ? r : kn); }
              else { if (!samp) __builtin_nontemporal_store((f32x4)(v), (f32x4*)(P.o_gv + ob * 128 + 4 * (lane - 32))); st4bf(P.Vc + (size_t)kr * 128 + 4 * (lane - 32), v); } }
            { const f32x4 v = CV4(r_qd);
              st4bf(P.Qd_raw + (size_t)kr * 256 + ci, v * QS);
              const f32x4 r = ROPE64(v);
              if (samp) st4bf(P.Qd_rot + (size_t)kr * 256 + ci, r * QS); }
            { const f32x4 v = CV4(r_kvd);
              const f32x4 r = ROPE64(v);
              if (lane < 32) { if (!samp) __builtin_nontemporal_store((f32x4)(v), (f32x4*)(P.o_sk + ob * 128 + ci)); st4bf(P.Kd + (size_t)kr * 128 + ci, samp ? r : v); }
              else { if (!samp) __builtin_nontemporal_store((f32x4)(v), (f32x4*)(P.o_sv + ob * 128 + 4 * (lane - 32))); st4bf(P.Vd + (size_t)kr * 128 + 4 * (lane - 32), v); } }
#undef CV4
#undef ROPE64
        } else {
            const int ci = row - NTOK, b = ci >> 9, j = ci & 511, kr = NPR + b * 2560 + 2048 + j;
            const size_t cb = (size_t)((b * 2 + l) * 512 + j);
            f32x4 z = (f32x4){0.f, 0.f, 0.f, 0.f}; asm volatile("" : "+v"(z));
            if (lane < 48) st4bf(P.A2 + (size_t)kr * 384 + 4 * lane, z);
            if (lane < 32) st4bf(P.A2 + (size_t)kr * 384 + 192 + 4 * lane, *(const f32x4*)(P.c_ckv + cb * 128 + 4 * lane));
            else if (lane < 48) st4bf(P.A2 + (size_t)kr * 384 + 320 + 4 * (lane - 32), z);
            if (lane < 8) st4bf(P.KPE + (size_t)kr * 32 + 4 * lane, *(const f32x4*)(P.c_kpe + cb * 32 + 4 * lane));
            if (lane < 32) { st4bf(P.Kc + (size_t)kr * 128 + 4 * lane, *(const f32x4*)(P.c_gk + cb * 128 + 4 * lane));
                             st4bf(P.Kd + (size_t)kr * 128 + 4 * lane, *(const f32x4*)(P.c_sk + cb * 128 + 4 * lane)); }
            else { st4bf(P.Vc + (size_t)kr * 128 + 4 * (lane - 32), *(const f32x4*)(P.c_gv + cb * 128 + 4 * (lane - 32)));
                   st4bf(P.Vd + (size_t)kr * 128 + 4 * (lane - 32), *(const f32x4*)(P.c_sv + cb * 128 + 4 * (lane - 32))); }
        }
    }
}

struct AttnSrc {
    const bf16* Qraw; const bf16* Qrot; int qpitch;
    const bf16* K0; int k0pitch; const bf16* K1;
    const bf16* V; int vpitch;
    bf16* Y; int outcol;
    int krbase, rowbase, q0, lo, hi, nctx;
    bool samp, window; float m0; bool sink;
    const float* rope;
};
template <int DK>
__device__ __forceinline__ void attn_unit(const AttnSrc& S, LAS unsigned char* lds, int tid, int lane, int wave, unsigned* ctr, unsigned& nxt_u) {
    constexpr int TK = 128, NKB = TK / 16, NPP = TK / 32;
    constexpr int KP = DK + 8, VP = TK + 8, KS = DK / 32, CPK = DK / 8;
    constexpr int NKC = TK * CPK / NT, NVC = TK * 8 / NT;
    LAS bf16* Ks = (LAS bf16*)lds;
    LAS bf16* Vt = (LAS bf16*)(lds + 2 * TK * KP * 2);
    const int g = lane >> 4, fr = lane & 15;
    const int qpos = S.q0 + wave * 16 + fr;
    const size_t qkr = (size_t)(S.krbase + qpos);
    bf16x8 qraw[KS], qrot[KS];
#pragma unroll
    for (int ks = 0; ks < KS; ++ks) { qraw[ks] = *(const bf16x8*)(S.Qraw + qkr * S.qpitch + ks * 32 + g * 8); qrot[ks] = qraw[ks]; }
    if (S.samp) {
        if (DK == 96) {
            const bf16x8 own = qraw[KS - 1], par = *(const bf16x8*)(S.Qraw + qkr * S.qpitch + 64 + (g ^ 1) * 8);
            const int pos = g < 2 ? (qpos >> 6) : (qpos & 63);
            const float sg = (g & 1) ? 1.f : -1.f;
            const float* ct = S.rope + 2048 + pos * 8; const float* st = S.rope + 2560 + pos * 8;
            bf16x8 r;
#pragma unroll
            for (int e = 0; e < 8; ++e) { const float o = bflo((unsigned)(unsigned short)own[e]), p = bflo((unsigned)(unsigned short)par[e]);
                r[e] = (short)f2bf(o * ct[e] + p * st[e] * sg); }
            qrot[KS - 1] = r;
        } else {
#pragma unroll
            for (int ks = 0; ks < KS; ++ks) qrot[ks] = *(const bf16x8*)(S.Qrot + qkr * S.qpitch + ks * 32 + g * 8);
        }
    }
    bf16x8 qc[KS];
#pragma unroll
    for (int ks = 0; ks < KS; ++ks) qc[ks] = S.samp ? qrot[ks] : qraw[ks];
    float m = S.m0, l = (S.sink && g == 0) ? 1.f : 0.f;
    f32x4 o[4];
#pragma unroll
    for (int d = 0; d < 4; ++d) o[d] = (f32x4){0.f, 0.f, 0.f, 0.f};
    const int nloc = S.hi - S.lo, ntile = nloc + S.nctx;
    u32x4 kreg[NKC], vreg[NVC];
    auto gload = [&](int j) {
        const int tile = j < nloc ? S.lo + j : (2048 / TK) + (j - nloc);
        const size_t kr = (size_t)(S.krbase + tile * TK);
#pragma unroll
        for (int c = 0; c < NKC; ++c) { const int ch = tid + c * NT, key = ch / CPK, part = ch % CPK;
            if (DK == 64) kreg[c] = *(const u32x4*)(S.K0 + (kr + key) * S.k0pitch + part * 8);
            else kreg[c] = part < 8 ? *(const u32x4*)(S.K0 + (kr + key) * S.k0pitch + part * 8) : *(const u32x4*)(S.K1 + (kr + key) * 32 + (part - 8) * 8); }
#pragma unroll
        for (int c = 0; c < NVC; ++c) { const int ch = tid + c * NT, vkey = ch & (TK - 1), vdc = ch / TK;
            vreg[c] = *(const u32x4*)(S.V + (kr + vkey) * S.vpitch + vdc * 8); }
    };
    auto lstore = [&](int buf) {
        LAS bf16* kb = Ks + buf * TK * KP; LAS bf16* vb = Vt + buf * 64 * VP;
#pragma unroll
        for (int c = 0; c < NKC; ++c) { const int ch = tid + c * NT, key = ch / CPK, part = ch % CPK; *(LAS u32x4*)(kb + key * KP + part * 8) = kreg[c]; }
#pragma unroll
        for (int c = 0; c < NVC; ++c) { const int ch = tid + c * NT, vkey = ch & (TK - 1), vdc = ch / TK;
            LAS bf16* vp = vb + (vdc * 8) * VP + vkey; const u32x4 v = vreg[c];
            vp[0 * VP] = (bf16)(v.x & 0xffffu); vp[1 * VP] = (bf16)(v.x >> 16); vp[2 * VP] = (bf16)(v.y & 0xffffu); vp[3 * VP] = (bf16)(v.y >> 16);
            vp[4 * VP] = (bf16)(v.z & 0xffffu); vp[5 * VP] = (bf16)(v.z >> 16); vp[6 * VP] = (bf16)(v.w & 0xffffu); vp[7 * VP] = (bf16)(v.w >> 16); }
    };
    gload(0); lstore(0);
    __syncthreads();
    for (int j = 0; j < ntile; ++j) {
        const int buf = j & 1;
        if (j + 1 < ntile) gload(j + 1);
        else if (tid == 0) nxt_u = atomicAdd(ctr, 1u);
        const bool loc = j < nloc;
        if (j == nloc) {
#pragma unroll
            for (int ks = 0; ks < KS; ++ks) qc[ks] = qraw[ks]; }
        const LAS bf16* kb = Ks + buf * TK * KP; const LAS bf16* vb = Vt + buf * 64 * VP;
        f32x4 s[NKB];
#pragma unroll
        for (int kk = 0; kk < NKB; ++kk) { s[kk] = (f32x4){0.f, 0.f, 0.f, 0.f};
#pragma unroll
            for (int ks = 0; ks < KS; ++ks) { const bf16x8 af = *(const LAS bf16x8*)(kb + (kk * 16 + fr) * KP + ks * 32 + g * 8);
                s[kk] = __builtin_amdgcn_mfma_f32_16x16x32_bf16(af, qc[ks], s[kk], 0, 0, 0); } }
        if (S.window && loc) {
            const int kp0 = (S.lo + j) * TK + g * 4;
#pragma unroll
            for (int kk = 0; kk < NKB; ++kk)
#pragma unroll
                for (int i = 0; i < 4; ++i) { const int d = kp0 + kk * 16 + i - qpos; if (d > 128 || d < -128) s[kk][i] = -INFINITY; }
        }
        float mx = -INFINITY;
#pragma unroll
        for (int kk = 0; kk < NKB; ++kk) mx = fmaxf(mx, fmaxf(fmaxf(s[kk][0], s[kk][1]), fmaxf(s[kk][2], s[kk][3])));
        if (__builtin_amdgcn_ballot_w64(mx > m + 8.f) != 0ull) {
            mx = fmaxf(mx, shx(mx, 16, lane)); mx = fmaxf(mx, shx(mx, 32, lane));
            const float mn = fmaxf(m, mx), alpha = __builtin_amdgcn_exp2f(m - mn);
            m = mn; l = l * alpha;
#pragma unroll
            for (int d = 0; d < 4; ++d) o[d] = o[d] * alpha;
        }
        float ls = 0.f;
#pragma unroll
        for (int kk = 0; kk < NKB; ++kk)
#pragma unroll
            for (int i = 0; i < 4; ++i) { const float p = __builtin_amdgcn_exp2f(s[kk][i] - m); s[kk][i] = p; ls += p; }
        l += ls;
        bf16x8 pf[NPP];
#pragma unroll
        for (int pp = 0; pp < NPP; ++pp) {
            const unsigned w0 = pk2(s[2 * pp][0], s[2 * pp][1]), w1 = pk2(s[2 * pp][2], s[2 * pp][3]), w2 = pk2(s[2 * pp + 1][0], s[2 * pp + 1][1]), w3 = pk2(s[2 * pp + 1][2], s[2 * pp + 1][3]);
            pf[pp] = __builtin_bit_cast(bf16x8, (u32x4){w0, w1, w2, w3});
        }
#pragma unroll
        for (int d = 0; d < 4; ++d)
#pragma unroll
            for (int pp = 0; pp < NPP; ++pp) {
                const LAS bf16* vr = vb + (d * 16 + fr) * VP + pp * 32 + g * 4;
                const u32x2 lo = *(const LAS u32x2*)vr, hi = *(const LAS u32x2*)(vr + 16);
                const bf16x8 af = __builtin_bit_cast(bf16x8, (u32x4){lo.x, lo.y, hi.x, hi.y});
                o[d] = __builtin_amdgcn_mfma_f32_16x16x32_bf16(af, pf[pp], o[d], 0, 0, 0);
            }
        if (j + 1 < ntile) lstore(buf ^ 1);
        __syncthreads();
    }
    float lt = l + shx(l, 16, lane); lt += shx(lt, 32, lane);
    const float inv = 1.f / lt;
    bf16* yr = S.Y + (size_t)(S.rowbase + qpos) * DM + S.outcol + g * 4;
#pragma unroll
    for (int d = 0; d < 4; ++d) st4bf(yr + d * 16, o[d] * inv);
}

struct AttnBufs { const bf16 *MQKV, *KPE, *Qc_rot, *Qc_raw, *Kc, *Vc, *Qd_rot, *Qd_raw, *Kd, *Vd; bf16* YCAT; const float* sink; const float* rope; unsigned* ctr; };
constexpr int ATT_NU = 384 + 768;
__device__ __forceinline__ void attn_phase(const AttnBufs& B, LAS unsigned char* lds, int tid, int lane, int wave) {
    volatile LAS unsigned* shu = (volatile LAS unsigned*)(lds + LDS_CTL);
    if (tid == 0) *shu = atomicAdd(B.ctr, 1u);
    __syncthreads();
    for (;;) {
        const int u = (int)*shu;
        if (u >= ATT_NU) break;
        unsigned nxt_u = 0u;
        int type, b, h, qt; bool samp;
        if (u < 384) { type = u >> 7; const int v = u & 127; b = v >> 6; h = (v >> 4) & 3; qt = v & 15; samp = true; }
        else { const int w = u - 384; type = w >> 8; const int v = w & 255; b = v >> 3; h = (v >> 1) & 3; qt = v & 1; samp = false; }
        AttnSrc S;
        S.samp = samp; S.q0 = qt * 128; S.rope = B.rope; S.Y = B.YCAT;
        S.krbase = samp ? NPR + b * 2560 : b * 256; S.rowbase = samp ? NPR + b * 2048 : b * 256;
        S.window = false; S.sink = false; S.m0 = -1e30f;
        if (!samp) { S.lo = 0; S.hi = 2; S.nctx = 0; }
        else { S.lo = 0; S.hi = 16; S.nctx = 4; }
        if (type == 0) {
            S.Qraw = B.MQKV + h * 96; S.Qrot = S.Qraw; S.qpitch = 1024; S.K0 = B.MQKV + 384 + h * 128; S.k0pitch = 1024; S.K1 = B.KPE; S.V = B.MQKV + 384 + h * 128 + 64; S.vpitch = 1024; S.outcol = 256 + h * 64;
            attn_unit<96>(S, lds, tid, lane, wave, B.ctr, nxt_u);
        } else {
            if (type == 1) { S.Qraw = B.Qc_raw + h * 64; S.Qrot = B.Qc_rot + h * 64; S.K0 = B.Kc + (h >> 1) * 64; S.V = B.Vc + (h >> 1) * 64; S.outcol = 512 + h * 64; }
            else { S.Qraw = B.Qd_raw + h * 64; S.Qrot = B.Qd_rot + h * 64; S.K0 = B.Kd + (h >> 1) * 64; S.V = B.Vd + (h >> 1) * 64; S.outcol = 768 + h * 64;
                   S.sink = true; S.m0 = B.sink[h] * LOG2E;
                   if (samp) { S.window = true; const int lo = S.q0 / 128 - 1; S.lo = lo < 0 ? 0 : lo; const int hi = S.q0 / 128 + 2; S.hi = hi > 16 ? 16 : hi; } }
            S.qpitch = 256; S.k0pitch = 128; S.K1 = nullptr; S.vpitch = 128;
            attn_unit<64>(S, lds, tid, lane, wave, B.ctr, nxt_u);
        }
        if (tid == 0) *shu = nxt_u;
        __syncthreads();
    }
}

__device__ __forceinline__ void load8(const bf16* p, float (&o)[8]) { const u32x4 u = *(const u32x4*)p; o[0] = bflo(u.x); o[1] = bfhi(u.x); o[2] = bflo(u.y); o[3] = bfhi(u.y); o[4] = bflo(u.z); o[5] = bfhi(u.z); o[6] = bflo(u.w); o[7] = bfhi(u.w); }
__device__ __forceinline__ void convgate_phase(const bf16* U, const float* cf, bf16* ACT, int gt, int NGT) {
    constexpr int NCH = DFF / 8, RG = 8;
    for (int it = gt; it < (NTOK / RG) * NCH; it += NGT) {
        const int rg = it / NCH, cc = it % NCH, r0 = rg * RG, col = cc * 8;
        const bool samp = r0 >= NPR; const int t0 = samp ? ((r0 - NPR) & 2047) : (r0 & 255), T = samp ? 2048 : 256;
        const bf16* up = U + (size_t)r0 * DUP + col;
        u32x4 ra[RG + 2], rb[RG + 2];
        const u32x4 z4 = (u32x4){0u, 0u, 0u, 0u};
        ra[0] = z4; rb[0] = z4; ra[RG + 1] = z4; rb[RG + 1] = z4;
        if (t0 > 0) { ra[0] = *(const u32x4*)(up - DUP); rb[0] = *(const u32x4*)(up - DUP + DFF); }
#pragma unroll
        for (int i = 0; i < RG; ++i) { ra[i + 1] = *(const u32x4*)(up + (size_t)i * DUP); rb[i + 1] = *(const u32x4*)(up + (size_t)i * DUP + DFF); }
        if (t0 + RG < T) { ra[RG + 1] = *(const u32x4*)(up + (size_t)RG * DUP); rb[RG + 1] = *(const u32x4*)(up + (size_t)RG * DUP + DFF); }
        float wa[3][8], wb[3][8];
#pragma unroll
        for (int k = 0; k < 3; ++k) { const f32x4 a0 = *(const f32x4*)(cf + k * DUP + col), a1 = *(const f32x4*)(cf + k * DUP + col + 4), b0 = *(const f32x4*)(cf + k * DUP + DFF + col), b1 = *(const f32x4*)(cf + k * DUP + DFF + col + 4);
#pragma unroll
            for (int e = 0; e < 4; ++e) { wa[k][e] = a0[e]; wa[k][4 + e] = a1[e]; wb[k][e] = b0[e]; wb[k][4 + e] = b1[e]; } }
#pragma unroll
        for (int i = 0; i < RG; ++i) {
            float r[8];
#pragma unroll
            for (int h = 0; h < 4; ++h) {
                const unsigned pa = ra[i][h], ca = ra[i + 1][h], na = ra[i + 2][h], pb = rb[i][h], cb = rb[i + 1][h], nb = rb[i + 2][h];
                const float xa0 = wa[0][2 * h] * bflo(pa) + wa[1][2 * h] * bflo(ca) + wa[2][2 * h] * bflo(na), xb0 = wb[0][2 * h] * bflo(pb) + wb[1][2 * h] * bflo(cb) + wb[2][2 * h] * bflo(nb);
                const float xa1 = wa[0][2 * h + 1] * bfhi(pa) + wa[1][2 * h + 1] * bfhi(ca) + wa[2][2 * h + 1] * bfhi(na), xb1 = wb[0][2 * h + 1] * bfhi(pb) + wb[1][2 * h + 1] * bfhi(cb) + wb[2][2 * h + 1] * bfhi(nb);
                r[2 * h] = xa0 * __builtin_amdgcn_rcpf(1.f + __builtin_amdgcn_exp2f(-xa0 * LOG2E)) * xb0;
                r[2 * h + 1] = xa1 * __builtin_amdgcn_rcpf(1.f + __builtin_amdgcn_exp2f(-xa1 * LOG2E)) * xb1;
            }
            u32x4 w; w.x = pk2(r[0], r[1]); w.y = pk2(r[2], r[3]); w.z = pk2(r[4], r[5]); w.w = pk2(r[6], r[7]);
            *(u32x4*)(ACT + (size_t)(r0 + i) * DFF + col) = w;
        }
    }
}

#define XB_TMO      128
#define XB_XCNT(j)  (256  + 64 * (j))
#define XB_XSUB(j)  (1280 + 64 * (j))
#define XB_XGEN(j)  (2304 + 64 * (j))
#define XB_TOP      3328
#define XB_TOPGEN   3392
#define XCD_BAR_WORDS 3456
#define XB_SPIN_CAP (1u << 20)
__device__ __forceinline__ unsigned xb_ld(unsigned* p)              { return __hip_atomic_load(p, __ATOMIC_RELAXED, __HIP_MEMORY_SCOPE_AGENT); }
__device__ __forceinline__ unsigned xb_add(unsigned* p, unsigned v) { return __hip_atomic_fetch_add(p, v, __ATOMIC_RELAXED, __HIP_MEMORY_SCOPE_AGENT); }
__device__ __forceinline__ unsigned xb_xcc_id() { return (unsigned)__builtin_amdgcn_s_getreg((3 << 11) | 20) & 0xFu; }
#define XB_SPIN(cond, bar) do { unsigned _sp = 0; while (cond) { __builtin_amdgcn_s_sleep(1); \
    if ((++_sp & 255u) == 0u) { if (xb_ld(&(bar)[XB_TMO])) break; if (_sp > XB_SPIN_CAP) { atomicAdd(&(bar)[XB_TMO], 1u); break; } } } } while (0)
struct XcdBarrier { unsigned* bar; unsigned x; volatile LAS unsigned* st; };
__device__ __forceinline__ void xcd_barrier_complete(unsigned* bar, unsigned x, unsigned& nloc, unsigned& nx) {
    const unsigned G = gridDim.x * gridDim.y * gridDim.z;
    unsigned sum, cnt, mine, sp = 0u;
    for (;;) {
        sum = 0u; cnt = 0u; mine = 0u;
#pragma unroll
        for (unsigned j = 0; j < 16; ++j) { const unsigned c = xb_ld(&bar[XB_XCNT(j)]); sum += c; cnt += (c > 0u) ? 1u : 0u; mine = (j == x) ? c : mine; }
        if (sum == G) break;
        __builtin_amdgcn_s_sleep(1);
        if ((++sp & 255u) == 0u) { if (xb_ld(&bar[XB_TMO])) break; if (sp > XB_SPIN_CAP) { atomicAdd(&bar[XB_TMO], 1u); break; } }
    }
    nloc = mine > 0u ? mine : 1u; nx = cnt > 0u ? cnt : 1u;
}
__device__ __forceinline__ void xcd_barrier(const XcdBarrier& b, const int tid_) {
    asm volatile("s_waitcnt vmcnt(0)" ::: "memory");
    __syncthreads();
    if (tid_ == 0) {
        unsigned* bar = b.bar;
        __builtin_amdgcn_s_waitcnt(0);
        unsigned nloc = b.st[0], nx = b.st[1];
        if (nloc == 0u) { xcd_barrier_complete(bar, b.x, nloc, nx); b.st[0] = nloc; b.st[1] = nx; }
        const unsigned old = xb_add(&bar[XB_XSUB(b.x)], 1u);
        const unsigned gen = old / nloc;
        if (old + 1u == (gen + 1u) * nloc) {
            __builtin_amdgcn_fence(__ATOMIC_RELEASE, "agent");
            asm volatile("s_waitcnt vmcnt(0)" ::: "memory");
            const unsigned og = xb_add(&bar[XB_TOP], 1u);
            const unsigned tg = og / nx;
            if (og + 1u == (tg + 1u) * nx) xb_add(&bar[XB_TOPGEN], 1u);
            else XB_SPIN(xb_ld(&bar[XB_TOPGEN]) == tg, bar);
            __builtin_amdgcn_fence(__ATOMIC_ACQUIRE, "agent");
            xb_add(&bar[XB_XGEN(b.x)], 1u);
            asm volatile("s_waitcnt vmcnt(0)" ::: "memory");
        } else {
            XB_SPIN(xb_ld(&bar[XB_XGEN(b.x)]) == gen, bar);
            __builtin_amdgcn_fence(__ATOMIC_ACQUIRE, "agent");
            asm volatile("s_waitcnt vmcnt(0)" ::: "memory");
        }
    }
    __syncthreads();
}

__device__ __forceinline__ int lane_id_volatile() { int l; asm volatile("v_mbcnt_lo_u32_b32 %0, -1, 0\n\tv_mbcnt_hi_u32_b32 %0, -1, %0" : "=v"(l)); return l; }

#ifndef PH
#define PH 0xFFFF
#endif
#define ON(k) ((PH >> (k)) & 1)
#ifndef REP
#define REP 0
#endif
#define NREP(k) (1 + ((REP >> (k)) & 1))
__global__ void __launch_bounds__(NT, 2) mega_fwd(Args a_unused) {
    extern __shared__ __attribute__((aligned(16))) unsigned char lds[];
    cg::grid_group grid = cg::this_grid();
    const int G = gridDim.x, bid = blockIdx.x;
    const int wave_s = __builtin_amdgcn_readfirstlane(threadIdx.x >> 6);
    PG8_LAS unsigned char* ring = (PG8_LAS unsigned char*)lds;
#define PHASE_BEGIN int tid = wave_s * 64 + lane_id_volatile(); asm volatile("" : "+v"(tid)); const CAS Args* ap_ = (const CAS Args*)__builtin_amdgcn_kernarg_segment_ptr(); asm volatile("" : "+s"(ap_)); const CAS Args& a = *ap_; unsigned char* ws = a.ws; float* out = a.out; \
    const int lane = tid & 63, wave = __builtin_amdgcn_readfirstlane(tid >> 6); const int gw = bid * NW + wave, NGW = G * NW, gt = bid * NT + tid, NGT = G * NT; \
    (void)lane; (void)wave; (void)gw; (void)NGW; (void)gt; (void)NGT; (void)out; \
    const float* mod = (const float*)(ws + WS_MOD); const float* rope = (const float*)(ws + WS_ROPE); (void)mod; (void)rope; \
    bf16* XN = (bf16*)(ws + WS_XN); bf16* PROJ = (bf16*)(ws + WS_PROJ); bf16* A2 = (bf16*)(ws + WS_A2); bf16* MQKV = (bf16*)(ws + WS_MQKV); \
    bf16* KPE = (bf16*)(ws + WS_KPE); bf16* YCAT = (bf16*)(ws + WS_YCAT); bf16* ACT = (bf16*)(ws + WS_ACT); bf16* U = (bf16*)(ws + WS_U); \
    bf16* Qc_rot = (bf16*)(ws + WS_QC); bf16* Qc_raw = (bf16*)(ws + WS_QC + QSZ); bf16* Kc = (bf16*)(ws + WS_QC + 2 * QSZ); bf16* Vc = (bf16*)(ws + WS_QC + 2 * QSZ + KSZ); \
    bf16* Qd_rot = (bf16*)(ws + WS_QC + 2 * QSZ + 2 * KSZ); bf16* Qd_raw = Qd_rot + (size_t)NKR * 256; bf16* Kd = Qd_raw + (size_t)NKR * 256; bf16* Vd = Kd + (size_t)NKR * 128; \
    (void)XN; (void)PROJ; (void)A2; (void)MQKV; (void)KPE; (void)YCAT; (void)ACT; (void)U; (void)Qc_rot; (void)Qc_raw; (void)Kc; (void)Vc; (void)Qd_rot; (void)Qd_raw; (void)Kd; (void)Vd;
#define GSYNC() do { const CAS Args* bp_ = (const CAS Args*)__builtin_amdgcn_kernarg_segment_ptr(); asm volatile("" : "+s"(bp_)); XcdBarrier xb_; xb_.bar = (unsigned*)(bp_->ws + WS_BAR); xb_.x = xb_xcc_id(); \
    xb_.st = (volatile LAS unsigned*)((LAS unsigned char*)lds + LDS_CTL + 32); xcd_barrier(xb_, wave_s * 64 + lane_id_volatile()); } while (0)
#define LAYER_VALS const float* modl = mod + (size_t)l * 3 * 6144; unsigned char* wl = ws + WS_W + l * W_LSTRIDE; (void)modl; (void)wl; \
    const float* x0 = l == 0 ? a.in[0] : nullptr; const float* x1 = l == 0 ? a.in[1] : nullptr; (void)x0; (void)x1; bf16* XRES = (bf16*)(ws + WS_XRES); (void)XRES;

    if (threadIdx.x < 16) ((volatile LAS unsigned*)((LAS unsigned char*)lds + LDS_CTL))[threadIdx.x] = 0u;
    __syncthreads();
    { PHASE_BEGIN if (tid == 0) (void)xb_add((unsigned*)(ws + WS_BAR) + XB_XCNT(xb_xcc_id()), 1u);
      if (ws == nullptr) grid.sync(); }
    for (int rep = 0; rep < NREP(0); ++rep) {
    if (ON(0)) { PHASE_BEGIN phase0(a, (LAS unsigned char*)lds, tid, lane, wave); }
    GSYNC(); }

    if (ON(1)) { PHASE_BEGIN
        if (G > 124) {
            if (bid < 62) bias_phase(a, ws, (LAS unsigned char*)lds, tid, lane, wave);
            else prep_phase(a.in[0], a.in[1], a.in[12], mod, 1024, XN, (float*)(ws + WS_SS1), lane, (bid - 62) * NW + wave, (G - 62) * NW);
        } else { bias_phase(a, ws, (LAS unsigned char*)lds, tid, lane, wave);
            prep_phase(a.in[0], a.in[1], a.in[12], mod, 1024, XN, (float*)(ws + WS_SS1), lane, gw, NGW); } }
    GSYNC();
#pragma unroll
    for (int l = 0; l < 2; ++l) {
        for (int rep = 0; rep < NREP(2); ++rep) {
        if (ON(2)) { PHASE_BEGIN LAYER_VALS pg8::Gemm g{XN, (const bf16*)(wl + W_IN), NTOK, INP, DM, 0, 0}; pg8::StaticOrder S; S.init(NTOK, INP, G, bid);
          pg8::EpiBf16RS E{PROJ, INP, (const float*)(ws + WS_SS1), (const float*)(ws + WS_BIAS) + (size_t)l * 3 * NBIAS, NBIAS};
          pg8::gemm_phase<pg8::EpiBf16RS, pg8::StaticOrder, true, true>(ring, g, S, E, tid); }
        GSYNC(); }
        for (int rep = 0; rep < NREP(3); ++rep) {
        if (ON(3)) { PHASE_BEGIN P3Ptrs P; P.PROJ = PROJ; P.A2 = A2; P.KPE = KPE; P.YCAT = YCAT; P.Qc_rot = Qc_rot; P.Qc_raw = Qc_raw; P.Kc = Kc; P.Vc = Vc; P.Qd_rot = Qd_rot; P.Qd_raw = Qd_raw; P.Kd = Kd; P.Vd = Vd;
          P.conv_a = a.in[14]; P.gq_mla = a.in[15]; P.gkv_mla = a.in[17]; P.gq = a.in[19]; P.gk = a.in[20]; P.rope = rope;
          P.c_ckv = a.in[2]; P.c_kpe = a.in[3]; P.c_gk = a.in[4]; P.c_gv = a.in[5]; P.c_sk = a.in[6]; P.c_sv = a.in[7];
          P.o_ckv = out + 12582912; P.o_kpe = out + 14680064; P.o_gk = out + 15204352; P.o_gv = out + 17301504; P.o_sk = out + 19398656; P.o_sv = out + 21495808; P.l = l;
          p3_phase(P, lane, gw, NGW); }
        GSYNC(); }
        for (int rep = 0; rep < NREP(4); ++rep) {
        if (ON(4)) { PHASE_BEGIN LAYER_VALS pg8::Gemm g{A2, (const bf16*)(wl + W_B2), NKR, 1024, 384, 0, 0}; pg8::StaticOrder S; S.init(NKR, 1024, G, bid); pg8::EpiBf16 E{MQKV, 1024};
          pg8::gemm_phase<pg8::EpiBf16, pg8::StaticOrder, true, true>(ring, g, S, E, tid); }
        GSYNC(); }
        for (int rep = 0; rep < NREP(5); ++rep) {
        if (ON(5)) { PHASE_BEGIN AttnBufs B; B.MQKV = MQKV; B.KPE = KPE; B.Qc_rot = Qc_rot; B.Qc_raw = Qc_raw; B.Kc = Kc; B.Vc = Vc; B.Qd_rot = Qd_rot; B.Qd_raw = Qd_raw; B.Kd = Kd; B.Vd = Vd; B.YCAT = YCAT;
          B.sink = a.in[21] + l * 4; B.rope = rope; B.ctr = (unsigned*)(ws + WS_CTL) + 64 * l + 128 * rep;
          attn_phase(B, (LAS unsigned char*)lds, tid, lane, wave); }
        GSYNC(); }
        if (ON(6)) { PHASE_BEGIN LAYER_VALS pg8::Gemm g{YCAT, (const bf16*)(wl + W_OUT), NTOK, DM, DM, 0, 0}; pg8::StaticOrder S; S.init(NTOK, DM, G, bid);
          pg8::EpiResid E{x0, x1, XRES, modl + 2048, XN, (float*)(ws + WS_SS2), a.in[23] + l * DM, modl + 4096};
          pg8::gemm_phase<pg8::EpiResid, pg8::StaticOrder, true, true>(ring, g, S, E, tid);
          if (l == 0) { const int wk = G > 192 ? bid - 192 : bid, nwk = G > 192 ? G - 192 : G;
            if (wk >= 0) wconv(a, ws, 0, 4 | 8, wk * NW + wave, nwk * NW, (LAS float*)((LAS unsigned char*)lds + wave * 16640), lane); } }
        GSYNC();
        for (int rep = 0; rep < NREP(8); ++rep) {
        if (ON(8)) { PHASE_BEGIN LAYER_VALS pg8::Gemm g{XN, (const bf16*)(wl + W_UP), NTOK, DUP, DM, (size_t)128 * DM * 2, (size_t)DFF * DM * 2}; pg8::StaticOrder S; S.init(NTOK, DUP, G, bid);
          pg8::EpiUpGate E{ACT, (const float*)(ws + WS_SS2), (const float*)(ws + WS_BIAS) + (size_t)l * 3 * NBIAS + 2304, NBIAS, a.in[25] + (size_t)l * 3 * DUP, (float*)(ws + WS_HALO), ring + 131072};
          pg8::gemm_phase<pg8::EpiUpGate, pg8::StaticOrder, true, true>(ring, g, S, E, tid); }
        GSYNC(); }
        if (ON(10)) { PHASE_BEGIN LAYER_VALS pg8::Gemm g{ACT, (const bf16*)(wl + W_DOWN), NTOK, DM, DFF, 0, 0}; pg8::StaticOrder S; S.init(NTOK, DM, G, bid);
          {
            const float* cwl = a.in[25] + (size_t)l * 3 * DUP; const float* HALO = (const float*)(ws + WS_HALO); pg8::Unit hu;
            bool fixed = false;
            for (int ui = 0; S.next(ui, hu); ++ui) { if (hu.pm < 32) continue; fixed = true; const int k = hu.pm - 32, pos = k & 7;
                for (int idx = tid; idx < 2 * DFF; idx += NT) { const int which = idx >= DFF ? 1 : 0, j = idx - which * DFF;
                    if (which == 0 ? pos == 0 : pos == 7) continue;
                    const float* Pp = HALO + (size_t)(k * 4 + (which ? 3 : 1)) * DUP; const float* Ep = HALO + (size_t)((which ? k + 1 : k - 1) * 4 + (which ? 0 : 2)) * DUP; const float* wp = cwl + (which ? 2 : 0) * DUP;
                    const float ca = Pp[j] + wp[j] * Ep[j], cb = Pp[DFF + j] + wp[DFF + j] * Ep[DFF + j];
                    const float r = ca * __builtin_amdgcn_rcpf(1.f + __builtin_amdgcn_exp2f(-ca * LOG2E)) * cb;
                    ACT[(size_t)(hu.pm * 256 + (which ? 255 : 0)) * DFF + j] = (bf16)(pk2(r, r) & 0xffffu); } }
            if (fixed) { asm volatile("s_waitcnt vmcnt(0)" ::: "memory"); __syncthreads();
                if (tid == 0) { __builtin_amdgcn_fence(__ATOMIC_RELEASE, "agent"); __builtin_amdgcn_fence(__ATOMIC_ACQUIRE, "agent"); asm volatile("s_waitcnt vmcnt(0)" ::: "memory"); }
                __syncthreads(); } }
          if (l == 1 && G >= 192) {
            pg8::EpiResidFinal E{XRES, out, modl + 5120, (float*)(ws + WS_SS1), a.in[27], (unsigned*)(ws + WS_CTL) + 2048};
            pg8::gemm_phase<pg8::EpiResidFinal, pg8::StaticOrder, true, true>(ring, g, S, E, tid);
          } else {
          pg8::EpiResid E{nullptr, nullptr, XRES, modl + 5120, l == 0 ? XN : nullptr, (float*)(ws + WS_SS1), a.in[12] + DM, mod + (size_t)3 * 6144 + 1024};
          pg8::gemm_phase<pg8::EpiResid, pg8::StaticOrder, true, true>(ring, g, S, E, tid); }
          if (l == 0) { const int wk = G > 192 ? bid - 192 : bid, nwk = G > 192 ? G - 192 : G;
            if (wk >= 0) wconv(a, ws, 1, 63, wk * NW + wave, nwk * NW, (LAS float*)((LAS unsigned char*)lds + wave * 16640), lane); } }
        if (!(l == 1 && G >= 192)) GSYNC();
    }
#ifdef XSYNC
    for (int i = 0; i < XSYNC; ++i) GSYNC();
#endif
    if (G < 192) { PHASE_BEGIN
    const bf16* XRES = (const bf16*)(ws + WS_XRES);
    for (int row = gw; row < NTOK; row += NGW) {
        float* xr = out + (size_t)row * DM;
        f32x4 v[4]; float ss = 0.f;
#pragma unroll
        for (int j = 0; j < 4; ++j) { v[j] = ld4bf(XRES + (size_t)row * DM + 4 * (lane + 64 * j)); ss += dot4(v[j]); }
        const float rs = rsqrtf(wave_sum(ss, lane) * (1.f / DM) + EPS);
#pragma unroll
        for (int j = 0; j < 4; ++j) { const int col = 4 * (lane + 64 * j); *(f32x4*)(xr + col) = v[j] * rs * *(const f32x4*)(a.in[27] + col); }
    } }
}

extern "C" void kernel_launch(void* const* d_in, const int* in_sizes, int n_in, void* d_out, int out_size, void* d_ws, size_t ws_size, hipStream_t stream) {
    static int grid = 0;
    if (grid == 0) {
        if (n_in != 28 || ws_size < WS_END) { fprintf(stderr, "kernel_launch: unexpected n_in %d / ws %zu\n", n_in, ws_size); grid = -1; return; }
        int dev = 0, cus = 0, per_cu = 0;
        hipGetDevice(&dev); hipDeviceGetAttribute(&cus, hipDeviceAttributeMultiprocessorCount, dev);
        hipFuncSetAttribute((const void*)mega_fwd, hipFuncAttributeMaxDynamicSharedMemorySize, LDS_BYTES);
        hipOccupancyMaxActiveBlocksPerMultiprocessor(&per_cu, (const void*)mega_fwd, NT, LDS_BYTES);
        if (per_cu < 1) per_cu = 1;
        grid = cus * per_cu;
        (void)hipGetLastError();
    }
    if (grid < 0) return;
    if (hipMemsetAsync((char*)d_ws + WS_BAR, 0, XCD_BAR_WORDS * 4, stream) != hipSuccess) { fprintf(stderr, "kernel_launch: memset of the barrier words failed\n"); return; }
    Args a{};
    for (int i = 0; i < 28; ++i) a.in[i] = (const float*)d_in[i];
    a.out = (float*)d_out; a.ws = (unsigned char*)d_ws;
    void* args[] = {&a};
    hipError_t e = hipLaunchCooperativeKernel((const void*)mega_fwd, dim3(grid), dim3(NT), args, LDS_BYTES, stream);
    if (e != hipSuccess) fprintf(stderr, "cooperative launch failed: %s (grid %d)\n", hipGetErrorString(e), grid);
}
```

```cpp
#include <hip/hip_runtime.h>
#include <hip/hip_cooperative_groups.h>
#include <cstdio>
#include <cstdint>
namespace cg = cooperative_groups;

namespace pg8 {
#define PG8_LAS __attribute__((address_space(3)))
typedef unsigned short bf16_t;
typedef short bf16x8 __attribute__((ext_vector_type(8)));
typedef float f32x4 __attribute__((ext_vector_type(4)));
typedef unsigned u32x4 __attribute__((ext_vector_type(4)));
constexpr int BM = 256, BK = 64, HALF = 128, HTB = HALF * BK * 2, STAGE_BYTES = 8 * HTB, NXCD = 8, WGM = 4;

__host__ __device__ __forceinline__ int lds_byte(int r, int c) { const int st = (r >> 4) * 2 + (c >> 5), rr = r & 15, cc = c & 31, ob = rr * 64 + cc * 2; return st * 1024 + (ob ^ (((ob >> 9) & 1) << 5)); }
__host__ __device__ __forceinline__ void stage_rc(int b, int& R, int& C) { const int st = b / 1024, sb = b % 1024, swz = sb ^ (((sb >> 9) & 1) << 5); R = (st >> 1) * 16 + swz / 64; C = (st & 1) * 32 + (swz % 64) / 2; }
__host__ __device__ __forceinline__ int perm32(int rho) { const int n = rho >> 4, i = rho & 15; return 8 * (i >> 2) + 4 * n + (i & 3); }

struct Unit { int pm, pn; };
struct Gemm { const bf16_t* A; const bf16_t* Bt; int M, N, K; size_t bstep, bhalf; };

struct StaticOrder {
    int nM, nN, nwg, G, c;
    __host__ __device__ __forceinline__ void init(int M, int N, int G_, int c_) { nM = M / BM; nN = N / BM; nwg = nM * nN; G = G_; c = c_; }
    __host__ __device__ __forceinline__ bool next(int i, Unit& u) const {
        const long L = (long)i * G + c; if (L >= nwg) return false;
        int wgid = (int)L; { const int q = nwg / NXCD, r = nwg % NXCD, xcd = wgid % NXCD, off = wgid / NXCD; wgid = (xcd < r ? xcd * (q + 1) : r * (q + 1) + (xcd - r) * q) + off; }
        const int nig = WGM * nN, gid = wgid / nig, fm = gid * WGM, gsz = (nM - fm) < WGM ? (nM - fm) : WGM;
        u.pm = fm + ((wgid % nig) % gsz); u.pn = (wgid % nig) / gsz; return true;
    }
    __device__ __forceinline__ void a_ready(const Unit&) const {}
    __device__ __forceinline__ void done(const Unit&) const {}
};

__device__ __forceinline__ unsigned cvt_pk_bf16(float lo, float hi) { unsigned r; asm volatile("v_cvt_pk_bf16_f32 %0, %1, %2" : "=v"(r) : "v"(lo), "v"(hi)); return r; }

struct EpiBf16 {
    static constexpr bool PERM = true, AFTER_DRAIN = false;
    bf16_t* O; int ldc;
    __device__ __forceinline__ void operator()(const f32x4 (&acc)[2][2][4][2], const Unit& u, int wr, int wc, int fr, int fq) const {
        asm volatile("" : "+v"(fr), "+v"(fq));
        const int row0 = u.pm * BM + wr * 64 + fr; const int col0 = u.pn * BM + wc * 32 + 8 * fq;
#pragma unroll
        for (int ai = 0; ai < 2; ++ai)
#pragma unroll
            for (int m = 0; m < 4; ++m) { bf16_t* rowp = O + (size_t)(row0 + ai * HALF + m * 16) * ldc + col0;
#pragma unroll
                for (int bj = 0; bj < 2; ++bj) { const f32x4 v0 = acc[ai][bj][m][0], v1 = acc[ai][bj][m][1];
                    u32x4 w; w.x = cvt_pk_bf16(v0[0], v0[1]); w.y = cvt_pk_bf16(v0[2], v0[3]); w.z = cvt_pk_bf16(v1[0], v1[1]); w.w = cvt_pk_bf16(v1[2], v1[3]);
                    *(u32x4*)(rowp + bj * HALF) = w; } }
    }
};
__device__ __forceinline__ float shx_(float v, int m, int lane) { return __builtin_bit_cast(float, __builtin_amdgcn_ds_bpermute((lane ^ m) << 2, __builtin_bit_cast(int, v))); }
__device__ __forceinline__ void row_scales(const float* SS, int row0, int fr, int fq, float (&rs)[8]) {
    f32x4 t[8];
#pragma unroll
    for (int q = 0; q < 8; ++q) t[q] = *(const f32x4*)(SS + (size_t)(row0 + (q >> 2) * HALF + (q & 3) * 16) * 16 + 4 * fq);
    const int lane = fq * 16 + fr;
#pragma unroll
    for (int q = 0; q < 8; ++q) { float v = (t[q][0] + t[q][1]) + (t[q][2] + t[q][3]); v += shx_(v, 16, lane); v += shx_(v, 32, lane); rs[q] = __builtin_amdgcn_rsqf(v * (1.f / 1024.f) + 1e-6f); }
}
struct EpiBf16RS {
    static constexpr bool PERM = true, AFTER_DRAIN = false;
    bf16_t* O; int ldc; const float* SS; const float* bias; int ldb;
    __device__ __forceinline__ void operator()(const f32x4 (&acc)[2][2][4][2], const Unit& u, int wr, int wc, int fr, int fq) const {
        asm volatile("" : "+v"(fr), "+v"(fq));
        const int cnd = u.pm < 32 ? 0 : 1 + ((u.pm - 32) >> 3);
        const int row0 = u.pm * BM + wr * 64 + fr; const int col0 = u.pn * BM + wc * 32 + 8 * fq;
        const float* bp = bias + (size_t)cnd * ldb + col0;
        f32x4 bv[2][2];
#pragma unroll
        for (int bj = 0; bj < 2; ++bj)
#pragma unroll
            for (int n = 0; n < 2; ++n) bv[bj][n] = *(const f32x4*)(bp + bj * HALF + 4 * n);
        float rsv[8]; row_scales(SS, row0, fr, fq, rsv);
#pragma unroll
        for (int ai = 0; ai < 2; ++ai)
#pragma unroll
            for (int m = 0; m < 4; ++m) { const int row = row0 + ai * HALF + m * 16; const float rs = rsv[ai * 4 + m];
                bf16_t* rowp = O + (size_t)row * ldc + col0;
#pragma unroll
                for (int bj = 0; bj < 2; ++bj) { const f32x4 v0 = acc[ai][bj][m][0] * rs + bv[bj][0], v1 = acc[ai][bj][m][1] * rs + bv[bj][1];
                    u32x4 w; w.x = cvt_pk_bf16(v0[0], v0[1]); w.y = cvt_pk_bf16(v0[2], v0[3]); w.z = cvt_pk_bf16(v1[0], v1[1]); w.w = cvt_pk_bf16(v1[2], v1[3]);
                    *(u32x4*)(rowp + bj * HALF) = w; } }
    }
};
struct EpiResid {
    static constexpr bool PERM = false, AFTER_DRAIN = false;
    const float* r0; const float* r1; bf16_t* XR; const float* gate;
    bf16_t* XN; float* SS; const float* nrm; const float* sc;
    __device__ __forceinline__ void operator()(const f32x4 (&acc)[2][2][4][2], const Unit& u, int wr, int wc, int fr, int fq) const {
        asm volatile("" : "+v"(fr), "+v"(fq));
        typedef unsigned u32x2_ __attribute__((ext_vector_type(2)));
        const int cnd = u.pm < 32 ? 0 : 1 + ((u.pm - 32) >> 3);
        const float* gp = gate + cnd * 6144;
        const int col0 = u.pn * BM + wc * 32 + 4 * fq;
        const int rowb = u.pm * BM + wr * 64 + fr;
        const bool inf = r0 != nullptr;
        const float* rs = (u.pm < 32 ? r0 + (size_t)rowb * 1024 : r1 + (size_t)(rowb - 8192) * 1024) + col0;
        bf16_t* op = XR + (size_t)rowb * 1024 + col0;
#define LDX(off) (inf ? __builtin_nontemporal_load((const f32x4*)(rs + (off))) : ({ const u32x2_ t_ = *(const u32x2_*)(op + (off)); (f32x4){__builtin_bit_cast(float, t_.x << 16), __builtin_bit_cast(float, t_.x & 0xffff0000u), __builtin_bit_cast(float, t_.y << 16), __builtin_bit_cast(float, t_.y & 0xffff0000u)}; }))
        const bool prep = XN != nullptr;
        f32x4 gv[2][2], hv[2][2];
#pragma unroll
        for (int bj = 0; bj < 2; ++bj)
#pragma unroll
            for (int n = 0; n < 2; ++n) { gv[bj][n] = *(const f32x4*)(gp + col0 + bj * HALF + n * 16);
                hv[bj][n] = (f32x4){0.f, 0.f, 0.f, 0.f};
                if (prep) hv[bj][n] = *(const f32x4*)(nrm + col0 + bj * HALF + n * 16) * (1.f + *(const f32x4*)(sc + cnd * 6144 + col0 + bj * HALF + n * 16)); }
        f32x4 xc[2][2], xn[2][2];
#pragma unroll
        for (int bj = 0; bj < 2; ++bj)
#pragma unroll
            for (int n = 0; n < 2; ++n) xc[bj][n] = LDX(bj * HALF + n * 16);
#pragma unroll
        for (int it = 0; it < 8; ++it) { const int ai = it >> 2, m = it & 3; const size_t ro = (size_t)(ai * HALF + m * 16) * 1024;
            if (it < 7) { const int ai2 = (it + 1) >> 2, m2 = (it + 1) & 3; const size_t ro2 = (size_t)(ai2 * HALF + m2 * 16) * 1024;
#pragma unroll
                for (int bj = 0; bj < 2; ++bj)
#pragma unroll
                    for (int n = 0; n < 2; ++n) xn[bj][n] = LDX(ro2 + bj * HALF + n * 16); }
            float ssq = 0.f;
#pragma unroll
            for (int bj = 0; bj < 2; ++bj)
#pragma unroll
                for (int n = 0; n < 2; ++n) { const f32x4 v = xc[bj][n] + gv[bj][n] * acc[ai][bj][m][n];
                    *(u32x2_*)(op + ro + bj * HALF + n * 16) = (u32x2_){cvt_pk_bf16(v[0], v[1]), cvt_pk_bf16(v[2], v[3])};
                    if (prep) { ssq += (v[0] * v[0] + v[1] * v[1]) + (v[2] * v[2] + v[3] * v[3]); const f32x4 h = v * hv[bj][n];
                        unsigned w0 = cvt_pk_bf16(h[0], h[1]), w1 = cvt_pk_bf16(h[2], h[3]);
                        *(u32x2_*)(XN + (size_t)(rowb + ai * HALF + m * 16) * 1024 + col0 + bj * HALF + n * 16) = (u32x2_){w0, w1}; } }
            if (prep) { const int lane = fq * 16 + fr; ssq += shx_(ssq, 16, lane); ssq += shx_(ssq, 32, lane);
                if (fq == 0) SS[(size_t)(rowb + ai * HALF + m * 16) * 16 + u.pn * 4 + wc] = ssq; }
#pragma unroll
            for (int bj = 0; bj < 2; ++bj)
#pragma unroll
                for (int n = 0; n < 2; ++n) xc[bj][n] = xn[bj][n];
        }
    }
#undef LDX
};

struct EpiResidFinal {
    static constexpr bool PERM = false, AFTER_DRAIN = false;
    const bf16_t* res; float* out; const float* gate; float* SS; const float* fw; unsigned* cnt;
    __device__ __forceinline__ void operator()(f32x4 (&acc)[2][2][4][2], const Unit& u, int wr, int wc, int fr, int fq) const {
        asm volatile("" : "+v"(fr), "+v"(fq));
        const int cnd = u.pm < 32 ? 0 : 1 + ((u.pm - 32) >> 3);
        const float* gp = gate + cnd * 6144;
        const int col0 = u.pn * BM + wc * 32 + 4 * fq;
        const int rowb = u.pm * BM + wr * 64 + fr;
        typedef unsigned u32x2_ __attribute__((ext_vector_type(2)));
        const bf16_t* rs = res + (size_t)rowb * 1024 + col0;
#define LDXF(off) ({ const u32x2_ t_ = *(const u32x2_*)(rs + (off)); (f32x4){__builtin_bit_cast(float, t_.x << 16), __builtin_bit_cast(float, t_.x & 0xffff0000u), __builtin_bit_cast(float, t_.y << 16), __builtin_bit_cast(float, t_.y & 0xffff0000u)}; })
        f32x4 gv[2][2];
#pragma unroll
        for (int bj = 0; bj < 2; ++bj)
#pragma unroll
            for (int n = 0; n < 2; ++n) gv[bj][n] = *(const f32x4*)(gp + col0 + bj * HALF + n * 16);
        f32x4 xc[2][2], xn[2][2];
#pragma unroll
        for (int bj = 0; bj < 2; ++bj)
#pragma unroll
            for (int n = 0; n < 2; ++n) xc[bj][n] = LDXF(bj * HALF + n * 16);
#pragma unroll
        for (int it = 0; it < 8; ++it) { const int ai = it >> 2, m = it & 3;
            if (it < 7) { const int ai2 = (it + 1) >> 2, m2 = (it + 1) & 3; const size_t ro2 = (size_t)(ai2 * HALF + m2 * 16) * 1024;
#pragma unroll
                for (int bj = 0; bj < 2; ++bj)
#pragma unroll
                    for (int n = 0; n < 2; ++n) xn[bj][n] = LDXF(ro2 + bj * HALF + n * 16); }
            float ssq = 0.f;
#pragma unroll
            for (int bj = 0; bj < 2; ++bj)
#pragma unroll
                for (int n = 0; n < 2; ++n) { const f32x4 v = xc[bj][n] + gv[bj][n] * acc[ai][bj][m][n]; acc[ai][bj][m][n] = v;
                    ssq += (v[0] * v[0] + v[1] * v[1]) + (v[2] * v[2] + v[3] * v[3]); }
            { const int lane = fq * 16 + fr; ssq += shx_(ssq, 16, lane); ssq += shx_(ssq, 32, lane);
              if (fq == 0) __hip_atomic_store(SS + (size_t)(rowb + ai * HALF + m * 16) * 16 + u.pn * 4 + wc, ssq, __ATOMIC_RELAXED, __HIP_MEMORY_SCOPE_AGENT); }
#pragma unroll
            for (int bj = 0; bj < 2; ++bj)
#pragma unroll
                for (int n = 0; n < 2; ++n) xc[bj][n] = xn[bj][n];
        }
        asm volatile("s_waitcnt vmcnt(0)" ::: "memory"); __builtin_amdgcn_s_barrier(); asm volatile("" ::: "memory");
        if (wr == 0 && wc == 0 && fr == 0 && fq == 0) {
            __builtin_amdgcn_fence(__ATOMIC_RELEASE, "agent"); asm volatile("s_waitcnt vmcnt(0)" ::: "memory");
            __hip_atomic_fetch_add(cnt + u.pm, 1u, __ATOMIC_RELAXED, __HIP_MEMORY_SCOPE_AGENT);
            unsigned sp = 0;
            while (__hip_atomic_load(cnt + u.pm, __ATOMIC_RELAXED, __HIP_MEMORY_SCOPE_AGENT) < 4u) { __builtin_amdgcn_s_sleep(1); if (++sp > (1u << 22)) break; }
            __builtin_amdgcn_fence(__ATOMIC_ACQUIRE, "agent"); asm volatile("s_waitcnt vmcnt(0)" ::: "memory");
        }
        __builtin_amdgcn_s_barrier(); asm volatile("" ::: "memory");
        float rsv[8];
        { f32x4 t[8];
#pragma unroll
          for (int q = 0; q < 8; ++q) { const float* sp = SS + (size_t)(rowb + (q >> 2) * HALF + (q & 3) * 16) * 16 + 4 * fq;
              t[q] = (f32x4){__hip_atomic_load(sp, __ATOMIC_RELAXED, __HIP_MEMORY_SCOPE_AGENT), __hip_atomic_load(sp + 1, __ATOMIC_RELAXED, __HIP_MEMORY_SCOPE_AGENT),
                             __hip_atomic_load(sp + 2, __ATOMIC_RELAXED, __HIP_MEMORY_SCOPE_AGENT), __hip_atomic_load(sp + 3, __ATOMIC_RELAXED, __HIP_MEMORY_SCOPE_AGENT)}; }
          const int lane = fq * 16 + fr;
#pragma unroll
          for (int q = 0; q < 8; ++q) { float v = (t[q][0] + t[q][1]) + (t[q][2] + t[q][3]); v += shx_(v, 16, lane); v += shx_(v, 32, lane); rsv[q] = __builtin_amdgcn_rsqf(v * (1.f / 1024.f) + 1e-6f); } }
        f32x4 wv[2][2];
#pragma unroll
        for (int bj = 0; bj < 2; ++bj)
#pragma unroll
            for (int n = 0; n < 2; ++n) wv[bj][n] = *(const f32x4*)(fw + col0 + bj * HALF + n * 16);
        float* op = out + (size_t)rowb * 1024 + col0;
#pragma unroll
        for (int it = 0; it < 8; ++it) { const int ai = it >> 2, m = it & 3; const size_t ro = (size_t)(ai * HALF + m * 16) * 1024;
#pragma unroll
            for (int bj = 0; bj < 2; ++bj)
#pragma unroll
                for (int n = 0; n < 2; ++n) __builtin_nontemporal_store(acc[ai][bj][m][n] * rsv[it] * wv[bj][n], (f32x4*)(op + ro + bj * HALF + n * 16)); }
    }
};

__device__ __forceinline__ float dpp_ror1(float v) { return __builtin_bit_cast(float, __builtin_amdgcn_mov_dpp(__builtin_bit_cast(int, v), 0x121, 0xf, 0xf, false)); }
__device__ __forceinline__ float dpp_ror15(float v) { return __builtin_bit_cast(float, __builtin_amdgcn_mov_dpp(__builtin_bit_cast(int, v), 0x12f, 0xf, 0xf, false)); }
struct EpiUpGate {
    static constexpr bool PERM = true, AFTER_DRAIN = false;
    bf16_t* ACT; const float* SS; const float* bias; int ldb; const float* cw; float* HALO; PG8_LAS unsigned char* xb;
    __device__ __forceinline__ void operator()(f32x4 (&acc)[2][2][4][2], const Unit& u, int wr, int wc, int fr, int fq) const {
        asm volatile("" : "+v"(fr), "+v"(fq));
        const int cnd = u.pm < 32 ? 0 : 1 + ((u.pm - 32) >> 3);
        const bool samp = u.pm >= 32;
        const int j0 = u.pn * HALF + wc * 32 + 8 * fq;
        const int row0 = u.pm * BM + wr * 64 + fr;
        { const float* bp = bias + (size_t)cnd * ldb + j0;
          f32x4 bv[2][2];
#pragma unroll
          for (int bj = 0; bj < 2; ++bj)
#pragma unroll
              for (int n = 0; n < 2; ++n) bv[bj][n] = *(const f32x4*)(bp + bj * 2816 + 4 * n);
          float rsv[8]; row_scales(SS, row0, fr, fq, rsv);
#pragma unroll
          for (int ai = 0; ai < 2; ++ai)
#pragma unroll
              for (int m = 0; m < 4; ++m) { const float rs = rsv[ai * 4 + m];
#pragma unroll
                  for (int bj = 0; bj < 2; ++bj)
#pragma unroll
                      for (int n = 0; n < 2; ++n) acc[ai][bj][m][n] = acc[ai][bj][m][n] * rs + bv[bj][n]; } }
        PG8_LAS f32x4* WL = (PG8_LAS f32x4*)(xb + 8192);
        if (fr == 0) {
            f32x4 wt[2][2][3];
#pragma unroll
            for (int n = 0; n < 2; ++n)
#pragma unroll
                for (int bj = 0; bj < 2; ++bj)
#pragma unroll
                    for (int k = 0; k < 3; ++k) wt[n][bj][k] = *(const f32x4*)(cw + k * 5632 + bj * 2816 + j0 + 4 * n);
#pragma unroll
            for (int n = 0; n < 2; ++n)
#pragma unroll
                for (int bj = 0; bj < 2; ++bj)
#pragma unroll
                    for (int k = 0; k < 3; ++k) WL[((((wr * 4 + wc) * 4 + fq) * 2 + n) * 2 + bj) * 3 + k] = wt[n][bj][k];
        }
        PG8_LAS f32x4* XB = (PG8_LAS f32x4*)xb;
        const int wv = wr * 4 + wc, pw = (wr ^ 1) * 4 + wc;
        if (fr == 0) {
#pragma unroll
            for (int ai = 0; ai < 2; ++ai)
#pragma unroll
                for (int bj = 0; bj < 2; ++bj)
#pragma unroll
                    for (int n = 0; n < 2; ++n) XB[((wv * 4 + ai * 2) * 2 + bj) * 8 + 2 * fq + n] = acc[ai][bj][0][n]; }
        if (fr == 15) {
#pragma unroll
            for (int ai = 0; ai < 2; ++ai)
#pragma unroll
                for (int bj = 0; bj < 2; ++bj)
#pragma unroll
                    for (int n = 0; n < 2; ++n) XB[((wv * 4 + ai * 2 + 1) * 2 + bj) * 8 + 2 * fq + n] = acc[ai][bj][3][n]; }
        asm volatile("s_waitcnt lgkmcnt(0)" ::: "memory"); __builtin_amdgcn_s_barrier(); asm volatile("" ::: "memory");
        float* hb = HALO + (size_t)(samp ? u.pm - 32 : 0) * 4 * 5632;
#pragma unroll
        for (int ai = 0; ai < 2; ++ai) {
            const bool has_ab = !(wr == 0 && ai == 0), has_bl = !(wr == 1 && ai == 1);
            const int wab = (wr == 0) ? 1 : (ai == 0 ? 1 : 3), wbl = (wr == 0) ? (ai == 0 ? 0 : 2) : 2;
            unsigned pk[4][4];
#pragma unroll
            for (int n = 0; n < 2; ++n) {
                f32x4 ca[4];
#pragma unroll
                for (int bj = 0; bj < 2; ++bj) {
                    const PG8_LAS f32x4* wlp = WL + ((((wr * 4 + wc) * 4 + fq) * 2 + n) * 2 + bj) * 3;
                    const f32x4 w0 = wlp[0], w1 = wlp[1], w2 = wlp[2];
                    f32x4 ab = (f32x4){0.f, 0.f, 0.f, 0.f}, bl = ab;
                    if (has_ab) ab = XB[((pw * 4 + wab) * 2 + bj) * 8 + 2 * fq + n];
                    if (has_bl) bl = XB[((pw * 4 + wbl) * 2 + bj) * 8 + 2 * fq + n];
#pragma unroll
                    for (int m = 0; m < 4; ++m) {
                        f32x4 cvm;
#pragma unroll
                        for (int i = 0; i < 4; ++i) {
                            const float cur = acc[ai][bj][m][n][i];
                            const float pv = m == 0 ? ab[i] : acc[ai][bj][m == 0 ? 0 : m - 1][n][i];
                            const float nx = m == 3 ? bl[i] : acc[ai][bj][m == 3 ? 3 : m + 1][n][i];
                            const float up = dpp_ror1(fr == 15 ? pv : cur), dn = dpp_ror15(fr == 0 ? nx : cur);
                            cvm[i] = w0[i] * up + w1[i] * cur + w2[i] * dn;
                        }
                        if (samp) {
                            if (m == 0 && wr == 0 && ai == 0 && fr == 0) { *(f32x4*)(hb + 0 * 5632 + bj * 2816 + j0 + 4 * n) = acc[ai][bj][0][n]; *(f32x4*)(hb + 1 * 5632 + bj * 2816 + j0 + 4 * n) = cvm; }
                            if (m == 3 && wr == 1 && ai == 1 && fr == 15) { *(f32x4*)(hb + 2 * 5632 + bj * 2816 + j0 + 4 * n) = acc[ai][bj][3][n]; *(f32x4*)(hb + 3 * 5632 + bj * 2816 + j0 + 4 * n) = cvm; }
                        }
                        if (bj == 0) ca[m] = cvm;
                        else { float r[4];
#pragma unroll
                            for (int i = 0; i < 4; ++i) { const float xa = ca[m][i]; r[i] = xa * __builtin_amdgcn_rcpf(1.f + __builtin_amdgcn_exp2f(-xa * 1.4426950408889634f)) * cvm[i]; }
                            pk[m][2 * n] = cvt_pk_bf16(r[0], r[1]); pk[m][2 * n + 1] = cvt_pk_bf16(r[2], r[3]); }
                    }
                }
                __builtin_amdgcn_sched_barrier(0);
            }
#pragma unroll
            for (int m = 0; m < 4; ++m) *(u32x4*)(ACT + (size_t)(row0 + ai * HALF + m * 16) * 2816 + j0) = (u32x4){pk[m][0], pk[m][1], pk[m][2], pk[m][3]};
        }
    }
};

template <class Epi, class Sched, bool ALIGN_EPI = false, bool SP2 = false>
__device__ __forceinline__ void gemm_phase(PG8_LAS unsigned char* lds, const Gemm g, const Sched& S, const Epi& E, const int tid) {
    const int wid = __builtin_amdgcn_readfirstlane(tid >> 6), lane = tid & 63, wr = wid >> 2, wc = wid & 3, fr = lane & 15, fq = lane >> 4;
    const int K = g.K, nt = K / BK;
    unsigned voffA[2], voffB[2];
#pragma unroll
    for (int i = 0; i < 2; ++i) { int R, C; stage_rc(tid * 16 + i * 8192, R, C); const int Rb = Epi::PERM ? ((R & ~31) + perm32(R & 31)) : R;
        voffA[i] = (unsigned)(R * K + C) * 2u; voffB[i] = (unsigned)(Rb * K + C) * 2u; }
    const size_t kstep = (size_t)(BK * 2);
    const size_t hstep = (size_t)HALF * K * 2;
    const size_t tstep = 2 * hstep;
    const size_t bstep = g.bstep ? g.bstep : tstep, bh = g.bhalf ? g.bhalf : hstep;
    const unsigned ldsw = (unsigned)wid * 1024u;
    const int aoff = lds_byte(wr * 64 + fr, fq * 8), boff = lds_byte(wc * 32 + fr, fq * 8);
#define PG8_SA(b, h) (((b) * 2 + (h)) * HTB)
#define PG8_SB(b, h) ((4 + (b) * 2 + (h)) * HTB)
#define PG8_STAGE(bufoff, gbase, voff) do { _Pragma("unroll") for (int _i = 0; _i < 2; ++_i) \
        __builtin_amdgcn_global_load_lds((const unsigned*)((const char*)(gbase) + (voff)[_i]), (PG8_LAS unsigned*)(lds + (bufoff) + ldsw + _i * 8192), 16, 0, 0); } while (0)
#define PG8_LDA(dst, b, h) do { _Pragma("unroll") for (int m = 0; m < 4; ++m) _Pragma("unroll") for (int k = 0; k < 2; ++k) dst[m][k] = *(const PG8_LAS bf16x8*)(lds + PG8_SA(b, h) + aoff + m * 2048 + k * 1024); } while (0)
#define PG8_LDB(dst, b, h) do { _Pragma("unroll") for (int n = 0; n < 2; ++n) _Pragma("unroll") for (int k = 0; k < 2; ++k) dst[n][k] = *(const PG8_LAS bf16x8*)(lds + PG8_SB(b, h) + boff + n * 2048 + k * 1024); } while (0)
#define PG8_MMA(ai, bj, At, Bt) do { __builtin_amdgcn_s_setprio(1); _Pragma("unroll") for (int m = 0; m < 4; ++m) _Pragma("unroll") for (int n = 0; n < 2; ++n) _Pragma("unroll") for (int k = 0; k < 2; ++k) \
        acc[ai][bj][m][n] = __builtin_amdgcn_mfma_f32_16x16x32_bf16(Bt[n][k], At[m][k], acc[ai][bj][m][n], 0, 0, 0); __builtin_amdgcn_s_setprio(0); } while (0)
#define PG8_WAIT_V(n) asm volatile("s_waitcnt vmcnt(" #n ")" ::: "memory")
#define PG8_WAIT_L(n) asm volatile("s_waitcnt lgkmcnt(" #n ")" ::: "memory")
#define PG8_BAR __builtin_amdgcn_s_barrier()
#define PG8_SCHED __builtin_amdgcn_sched_barrier(0)
    Unit cur, nxt; int ui = 0;
    if (!S.next(0, cur)) return;
    f32x4 acc[2][2][4][2];
#pragma unroll
    for (int a = 0; a < 2; ++a)
#pragma unroll
        for (int b = 0; b < 2; ++b)
#pragma unroll
            for (int m = 0; m < 4; ++m)
#pragma unroll
                for (int n = 0; n < 2; ++n) acc[a][b][m][n] = (f32x4){0.f, 0.f, 0.f, 0.f};
    bf16x8 At[4][2], B0[2][2], B1[2][2];
    const char* cA = (const char*)g.A + (size_t)cur.pm * tstep; const char* cB = (const char*)g.Bt + (size_t)cur.pn * bstep;
    S.a_ready(cur);
    if constexpr (SP2) {
        PG8_STAGE(PG8_SB(0, 0), cB, voffB); PG8_STAGE(PG8_SB(0, 1), cB + bh, voffB); PG8_STAGE(PG8_SA(0, 0), cA, voffA); PG8_STAGE(PG8_SA(0, 1), cA + hstep, voffA);
        if (wr == 1) PG8_BAR;
        PG8_WAIT_V(2); PG8_BAR;
        PG8_STAGE(PG8_SB(1, 0), cB + kstep, voffB); PG8_STAGE(PG8_SA(1, 0), cA + kstep, voffA); PG8_STAGE(PG8_SB(1, 1), cB + bh + kstep, voffB);
        PG8_WAIT_V(6); PG8_BAR;
    } else {
        PG8_STAGE(PG8_SB(0, 0), cB, voffB); PG8_STAGE(PG8_SA(0, 0), cA, voffA); PG8_STAGE(PG8_SB(0, 1), cB + bh, voffB); PG8_STAGE(PG8_SA(0, 1), cA + hstep, voffA);
        if (wr == 1) PG8_BAR;
        PG8_WAIT_V(4); PG8_BAR;
        PG8_STAGE(PG8_SB(1, 0), cB + kstep, voffB); PG8_STAGE(PG8_SA(1, 0), cA + kstep, voffA); PG8_STAGE(PG8_SB(1, 1), cB + bh + kstep, voffB);
        PG8_WAIT_V(6); PG8_BAR;
    }
    for (;;) {
        const bool has_next = S.next(ui + 1, nxt);
        const char* nA = has_next ? (const char*)g.A + (size_t)nxt.pm * tstep : cA; const char* nB = has_next ? (const char*)g.Bt + (size_t)nxt.pn * bstep : cB;
        for (int t = 0; t < nt; t += 2) {
            const bool last = (t == nt - 2);
            const char* a1 = cA + (size_t)(t + 1) * kstep;
            const char* a2 = last ? nA : cA + (size_t)(t + 2) * kstep; const char* b2 = last ? nB : cB + (size_t)(t + 2) * kstep;
            const char* a3 = a2 + kstep; const char* b3 = b2 + kstep;
            if (last && has_next) S.a_ready(nxt);
            if constexpr (SP2) {
            PG8_LDB(B0, 0, 0); PG8_LDB(B1, 0, 1); PG8_SCHED; PG8_LDA(At, 0, 0); PG8_STAGE(PG8_SA(1, 1), a1 + hstep, voffA);
            PG8_WAIT_V(8); PG8_WAIT_L(0); PG8_BAR; PG8_MMA(0, 0, At, B0); PG8_MMA(0, 1, At, B1); PG8_BAR; PG8_SCHED;
            PG8_LDA(At, 0, 1); PG8_STAGE(PG8_SB(0, 0), b2, voffB); PG8_STAGE(PG8_SB(0, 1), b2 + bh, voffB); PG8_STAGE(PG8_SA(0, 0), a2, voffA);
            PG8_WAIT_V(8); PG8_WAIT_L(0); PG8_BAR; PG8_MMA(1, 0, At, B0); PG8_MMA(1, 1, At, B1); PG8_BAR; PG8_SCHED;
            PG8_LDB(B0, 1, 0); PG8_LDB(B1, 1, 1); PG8_SCHED; PG8_LDA(At, 1, 0); PG8_STAGE(PG8_SA(0, 1), a2 + hstep, voffA);
            PG8_WAIT_V(8); PG8_WAIT_L(0); PG8_BAR; PG8_MMA(0, 0, At, B0); PG8_MMA(0, 1, At, B1); PG8_BAR; PG8_SCHED;
            PG8_LDA(At, 1, 1); PG8_STAGE(PG8_SB(1, 0), b3, voffB); PG8_STAGE(PG8_SB(1, 1), b3 + bh, voffB); PG8_STAGE(PG8_SA(1, 0), a3, voffA);
            PG8_WAIT_V(8); PG8_WAIT_L(0); PG8_BAR; PG8_MMA(1, 0, At, B0); PG8_MMA(1, 1, At, B1); PG8_BAR; PG8_SCHED;
            } else {
            PG8_LDB(B0, 0, 0); PG8_SCHED; PG8_LDA(At, 0, 0); PG8_STAGE(PG8_SA(1, 1), a1 + hstep, voffA);
            PG8_WAIT_L(8); PG8_BAR; PG8_WAIT_L(0); PG8_MMA(0, 0, At, B0); PG8_BAR; PG8_SCHED;
            PG8_LDB(B1, 0, 1); PG8_STAGE(PG8_SB(0, 0), b2, voffB);
            PG8_BAR; PG8_WAIT_L(0); PG8_MMA(0, 1, At, B1); PG8_BAR;
            PG8_LDA(At, 0, 1); PG8_STAGE(PG8_SA(0, 0), a2, voffA);
            PG8_BAR; PG8_WAIT_L(0); PG8_MMA(1, 0, At, B0); PG8_BAR; PG8_SCHED;
            PG8_STAGE(PG8_SB(0, 1), b2 + bh, voffB);
            PG8_WAIT_V(6); PG8_BAR; PG8_MMA(1, 1, At, B1); PG8_BAR;
            PG8_LDB(B0, 1, 0); PG8_SCHED; PG8_LDA(At, 1, 0); PG8_STAGE(PG8_SA(0, 1), a2 + hstep, voffA);
            PG8_WAIT_L(8); PG8_BAR; PG8_WAIT_L(0); PG8_MMA(0, 0, At, B0); PG8_BAR; PG8_SCHED;
            PG8_LDB(B1, 1, 1); PG8_STAGE(PG8_SB(1, 0), b3, voffB);
            PG8_BAR; PG8_WAIT_L(0); PG8_MMA(0, 1, At, B1); PG8_BAR;
            PG8_LDA(At, 1, 1); PG8_STAGE(PG8_SA(1, 0), a3, voffA);
            PG8_BAR; PG8_WAIT_L(0); PG8_MMA(1, 0, At, B0); PG8_BAR; PG8_SCHED;
            PG8_STAGE(PG8_SB(1, 1), b3 + bh, voffB);
            PG8_WAIT_V(6); PG8_BAR; PG8_MMA(1, 1, At, B1); PG8_BAR;
            }
        }
        if constexpr (ALIGN_EPI) { if (wr == 0) PG8_BAR; }
        if constexpr (!Epi::AFTER_DRAIN) { E(acc, cur, wr, wc, fr, fq); S.done(cur); }
        if (!has_next) break;
#pragma unroll
        for (int a = 0; a < 2; ++a)
#pragma unroll
            for (int b = 0; b < 2; ++b)
#pragma unroll
                for (int m = 0; m < 4; ++m)
#pragma unroll
                    for (int n = 0; n < 2; ++n) acc[a][b][m][n] = (f32x4){0.f, 0.f, 0.f, 0.f};
        cur = nxt; cA = nA; cB = nB; ++ui;
        if constexpr (ALIGN_EPI) { if (wr == 1) PG8_BAR; }
    }
    PG8_WAIT_V(0);
    if constexpr (!ALIGN_EPI) { if (wr == 0) PG8_BAR; }
    PG8_BAR;
#undef PG8_SA
#undef PG8_SB
#undef PG8_STAGE
#undef PG8_LDA
#undef PG8_LDB
#undef PG8_MMA
#undef PG8_WAIT_V
#undef PG8_WAIT_L
#undef PG8_BAR
#undef PG8_SCHED
}
}

#define LAS __attribute__((address_space(3)))
#define CAS __attribute__((address_space(4)))
typedef unsigned short bf16;
typedef float f32x4 __attribute__((ext_vector_type(4)));
typedef short bf16x8 __attribute__((ext_vector_type(8)));
typedef unsigned u32x4 __attribute__((ext_vector_type(4)));
typedef unsigned u32x2 __attribute__((ext_vector_type(2)));

constexpr int NW = 8, NT = 512;
constexpr int DM = 1024, NTOK = 12288, NPR = 8192, NKR = 13312, INC = 2144, INP = 2304, DFF = 2816, DUP = 5632;
constexpr float EPS = 1e-6f, LOG2E = 1.4426950408889634f;
constexpr float QS = 0.125f * LOG2E;
constexpr float MLAQS = 0.10206207261596575f * LOG2E;

constexpr size_t MiB = 1u << 20;
constexpr size_t WS_CTL = 0, WS_MOD = 1 * MiB, WS_ROPE = 1 * MiB + 256 * 1024, WS_W = 2 * MiB, W_LSTRIDE = 24 * MiB;
constexpr size_t W_IN = 0, W_OUT = 4718592, W_UP = W_OUT + 2097152, W_DOWN = W_UP + 11534336, W_B2 = W_DOWN + 5767168;
static_assert(W_B2 + 786432 <= W_LSTRIDE, "weights");
constexpr size_t WS_XN = 50 * MiB, WS_PROJ = 74 * MiB, WS_A2 = 128 * MiB, WS_MQKV = 138 * MiB, WS_QC = 164 * MiB, WS_KPE = 203 * MiB, WS_YCAT = 204 * MiB;
constexpr size_t WS_ACT = 116 * MiB, WS_U = 116 * MiB, WS_SS1 = 228 * MiB, WS_SS2 = 229 * MiB, WS_HALO = 230 * MiB, WS_XRES = 232 * MiB, WS_END = 256 * MiB;
constexpr size_t WS_BIAS = 65536;
constexpr int NBIAS = 2304 + 5632;
constexpr size_t QSZ = (size_t)NKR * 256 * 2, KSZ = (size_t)NKR * 128 * 2;
constexpr int LDS_BYTES = 163840, LDS_CTL = 163840 - 256;
constexpr size_t WS_BAR = 16384;

struct Args { const float* in[28]; float* out; unsigned char* ws; };

__device__ __forceinline__ unsigned f2bf(float f) { unsigned u = __builtin_bit_cast(unsigned, f); return (u + 0x7fffu + ((u >> 16) & 1u)) >> 16; }
__device__ __forceinline__ unsigned pk2(float lo, float hi) { unsigned r; asm("v_cvt_pk_bf16_f32 %0, %1, %2" : "=v"(r) : "v"(lo), "v"(hi)); return r; }
__device__ __forceinline__ float bflo(unsigned u) { return __builtin_bit_cast(float, u << 16); }
__device__ __forceinline__ float bfhi(unsigned u) { return __builtin_bit_cast(float, u & 0xffff0000u); }
__device__ __forceinline__ f32x4 ld4bf(const bf16* p) { const u32x2 u = *(const u32x2*)p; return (f32x4){bflo(u.x), bfhi(u.x), bflo(u.y), bfhi(u.y)}; }
__device__ __forceinline__ void st4bf(bf16* p, f32x4 v) { u32x2 u; u.x = pk2(v[0], v[1]); u.y = pk2(v[2], v[3]); *(u32x2*)p = u; }
__device__ __forceinline__ float shx(float v, int m, int lane) { return __builtin_bit_cast(float, __builtin_amdgcn_ds_bpermute((lane ^ m) << 2, __builtin_bit_cast(int, v))); }
#define DPPF(v, ctrl) __builtin_bit_cast(float, __builtin_amdgcn_mov_dpp(__builtin_bit_cast(int, (v)), (ctrl), 0xf, 0xf, false))
__device__ __forceinline__ float sum16(float v, int) { v += DPPF(v, 0x121); v += DPPF(v, 0x122); v += DPPF(v, 0x124); v += DPPF(v, 0x128); return v; }
__device__ __forceinline__ float wave_sum(float v, int lane) {
    v = sum16(v, lane);
    const int iv = __builtin_bit_cast(int, v);
    const float a = __builtin_bit_cast(float, __builtin_amdgcn_readlane(iv, 0)), b = __builtin_bit_cast(float, __builtin_amdgcn_readlane(iv, 16)),
                c = __builtin_bit_cast(float, __builtin_amdgcn_readlane(iv, 32)), d = __builtin_bit_cast(float, __builtin_amdgcn_readlane(iv, 48));
    return (a + b) + (c + d);
}
__device__ __forceinline__ float dot4(f32x4 a) { return (a[0] * a[0] + a[1] * a[1]) + (a[2] * a[2] + a[3] * a[3]); }
__device__ __forceinline__ f32x4 shfl4(f32x4 v, int m, int lane) { return (f32x4){shx(v[0], m, lane), shx(v[1], m, lane), shx(v[2], m, lane), shx(v[3], m, lane)}; }

__device__ __forceinline__ void transpose_item(const float* W, int N, bf16* WT, int ldk, int row_off, int k_off, float scale, LAS float* scr, int item, int lane) {
    const int nblk = (N + 63) / 64, kb = item / nblk, nb = item % nblk, k0 = 64 * kb, n0 = 64 * nb;
    const bool act = n0 + lane < N;
    const float* wp = W + (size_t)k0 * N + n0 + lane;
    float v[64];
#pragma unroll
    for (int i = 0; i < 64; ++i) v[i] = act ? __builtin_nontemporal_load(wp + (size_t)i * N) : 0.f;
#pragma unroll
    for (int i = 0; i < 64; ++i) scr[i * 65 + lane] = v[i] * scale;
    asm volatile("s_waitcnt lgkmcnt(0)" ::: "memory");
    const int c = lane & 7;
#pragma unroll
    for (int j = 0; j < 8; ++j) { const int n = (lane >> 3) + 8 * j; const LAS float* s = scr + (8 * c) * 65 + n;
        u32x4 o; o.x = pk2(s[0 * 65], s[1 * 65]); o.y = pk2(s[2 * 65], s[3 * 65]); o.z = pk2(s[4 * 65], s[5 * 65]); o.w = pk2(s[6 * 65], s[7 * 65]);
        if (n0 + n < N) *(u32x4*)(WT + (size_t)(row_off + n0 + n) * ldk + k_off + k0 + 8 * c) = o; }
    asm volatile("s_waitcnt lgkmcnt(0)" ::: "memory");
}

template <class ArgsRef>
__device__ __forceinline__ void wconv(const ArgsRef& a, unsigned char* ws, int l, int sel, int w, int nwk, LAS float* scr, int lane) {
    constexpr int I_IN = 16 * 34, I_OUT = 16 * 16, I_UP = 16 * 88, I_DN = 44 * 16, I_Q = 3 * 6, I_KV = 2 * 8;
    const int n_in = (sel & 1) ? I_IN : 0, n_out = (sel & 2) ? I_OUT : 0, n_up = (sel & 4) ? I_UP : 0, n_dn = (sel & 8) ? I_DN : 0, n_q = (sel & 16) ? I_Q : 0, n_kv = (sel & 32) ? I_KV : 0;
    const int total = n_in + n_out + n_up + n_dn + n_q + n_kv;
    unsigned char* wl = ws + WS_W + l * W_LSTRIDE;
    for (int it = w; it < total; it += nwk) {
        int r = it;
        if (r < n_in) { transpose_item(a.in[13] + (size_t)l * 1024 * INC, INC, (bf16*)(wl + W_IN), 1024, 0, 0, 1.f, scr, r, lane); continue; } r -= n_in;
        if (r < n_out) { transpose_item(a.in[22] + (size_t)l * 1024 * 1024, 1024, (bf16*)(wl + W_OUT), 1024, 0, 0, 1.f, scr, r, lane); continue; } r -= n_out;
        if (r < n_up) { transpose_item(a.in[24] + (size_t)l * 1024 * DUP, DUP, (bf16*)(wl + W_UP), 1024, 0, 0, 1.f, scr, r, lane); continue; } r -= n_up;
        if (r < n_dn) { transpose_item(a.in[26] + (size_t)l * DFF * 1024, 1024, (bf16*)(wl + W_DOWN), DFF, 0, 0, 1.f, scr, r, lane); continue; } r -= n_dn;
        if (r < n_q) { transpose_item(a.in[16] + (size_t)l * 192 * 384, 384, (bf16*)(wl + W_B2), 384, 0, 0, MLAQS, scr, r, lane); continue; } r -= n_q;
        transpose_item(a.in[18] + (size_t)l * 128 * 512, 512, (bf16*)(wl + W_B2), 384, 384, 192, 1.f, scr, r, lane);
    }
}
template <class ArgsRef>
__device__ __forceinline__ void phase0(const ArgsRef& a, LAS unsigned char* lds, int tid, int lane, int wave) {
    unsigned char* ws = a.ws;
    const int G = gridDim.x, bid = blockIdx.x;
    if (bid < 96) {
        LAS float* sl = (LAS float*)(lds + 16384);
        for (int e = tid; e < 3072; e += NT) { const int c = e >> 10, k = e & 1023; const float v = c == 0 ? a.in[9][k] : a.in[8][(c - 1) * 1024 + k]; sl[e] = v / (1.f + __expf(-v)); }
        __syncthreads();
    }
    for (int it = bid; it < 96; it += G) {
        const int l = it / 48, n0 = (it % 48) * 128;
        const float* wa = a.in[10] + (size_t)l * 1024 * 6144;
        const LAS float* sl = (const LAS float*)(lds + 16384);
        float acc[3][2] = {{0.f, 0.f}, {0.f, 0.f}, {0.f, 0.f}};
        const int kb = wave * 128;
#pragma unroll 16
        for (int k = 0; k < 128; ++k) {
            const int kk = kb + k;
            typedef float f32x2_ __attribute__((ext_vector_type(2)));
            const f32x2_ w = __builtin_nontemporal_load((const f32x2_*)(wa + (size_t)kk * 6144 + n0 + 2 * lane));
            const float s0 = sl[kk], s1 = sl[1024 + kk], s2 = sl[2048 + kk];
            acc[0][0] += s0 * w.x; acc[0][1] += s0 * w.y; acc[1][0] += s1 * w.x; acc[1][1] += s1 * w.y; acc[2][0] += s2 * w.x; acc[2][1] += s2 * w.y;
        }
        LAS float* red = (LAS float*)lds;
#pragma unroll
        for (int c = 0; c < 3; ++c) { red[(wave * 3 + c) * 128 + 2 * lane] = acc[c][0]; red[(wave * 3 + c) * 128 + 2 * lane + 1] = acc[c][1]; }
        __syncthreads();
        if (tid < 384) { const int c = tid / 128, n = tid % 128; float s = 0.f;
#pragma unroll
            for (int w = 0; w < 8; ++w) s += red[(w * 3 + c) * 128 + n];
            ((float*)(ws + WS_MOD))[(size_t)(l * 3 + c) * 6144 + n0 + n] = s + a.in[11][(size_t)l * 6144 + n0 + n]; }
        __syncthreads();
    }
    if (bid == G - 1) {
        float* rt = (float*)(ws + WS_ROPE);
        for (int e = tid; e < 1024; e += NT) { const int pos = e >> 4, i = e & 15; const float inv = exp2f(-(float)(2 * i) / 32.f * 13.287712379549449f); const float ang = (float)pos * inv;
            rt[e] = __cosf(ang); rt[1024 + e] = __sinf(ang); }
        for (int e = tid; e < 512; e += NT) { const int pos = e >> 3, i = e & 7; const float inv = exp2f(-(float)(2 * i) / 16.f * 13.287712379549449f); const float ang = (float)pos * inv;
            rt[2048 + e] = __cosf(ang); rt[2560 + e] = __sinf(ang); }
    }
    const int gt = bid * NT + tid, NGT = G * NT;
    if (gt < 256) ((unsigned*)(ws + WS_CTL))[gt] = 0u;
    if (gt < 64) ((unsigned*)(ws + WS_CTL))[2048 + gt] = 0u;
    for (int l = 0; l < 2; ++l) {
        bf16* b2 = (bf16*)(ws + WS_W + l * W_LSTRIDE + W_B2);
        for (int ch = gt; ch < 1024 * 48; ch += NGT) { const int n = ch / 48, k = (ch % 48) * 8;
            const bool data = (n < 384 && k < 192) || (n >= 384 && n < 896 && k >= 192 && k < 320);
            if (!data) *(u32x4*)(b2 + (size_t)n * 384 + k) = (u32x4){0u, 0u, 0u, 0u}; }
        bf16* wi = (bf16*)(ws + WS_W + l * W_LSTRIDE + W_IN) + (size_t)INC * 1024;
        for (int ch = gt; ch < 160 * 128; ch += NGT) *(u32x4*)(wi + (size_t)ch * 8) = (u32x4){0u, 0u, 0u, 0u};
    }
    LAS float* scr = (LAS float*)(lds + 28672 + wave * 16640);
    wconv(a, ws, 0, 1 | 2 | 16 | 32, ((bid + G - (G > 96 ? 96 : 0)) % G) * NW + wave, G * NW, scr, lane);
}

__device__ __forceinline__ void prep_phase(const float* x0, const float* x1, const float* nw, const float* mod, int sc_off, bf16* XN, float* SS, int lane, int gw, int NGW) {
    for (int row = gw; row < NTOK; row += NGW) {
        const float* xr = row < NPR ? x0 + (size_t)row * DM : x1 + (size_t)(row - NPR) * DM;
        const int c = row < NPR ? 0 : 1 + ((row - NPR) >> 11);
        const float* mp = mod + c * 6144;
        f32x4 v[4]; float ss = 0.f;
#pragma unroll
        for (int j = 0; j < 4; ++j) { v[j] = __builtin_nontemporal_load((const f32x4*)(xr + 4 * (lane + 64 * j))); ss += dot4(v[j]); }
        ss = wave_sum(ss, lane);
#pragma unroll
        for (int j = 0; j < 4; ++j) { const int col = 4 * (lane + 64 * j);
            const f32x4 g = *(const f32x4*)(nw + col), sc = *(const f32x4*)(mp + sc_off + col);
            st4bf(XN + (size_t)row * DM + col, v[j] * g * (1.f + sc)); }
        if (lane < 16) SS[(size_t)row * 16 + lane] = lane == 0 ? ss : 0.f;
    }
}
template <class ArgsRef>
__device__ __forceinline__ void bias_phase(const ArgsRef& a, unsigned char* ws, LAS unsigned char* lds, int tid, int lane, int wave) {
    const float* mod = (const float*)(ws + WS_MOD);
    float* BIAS = (float*)(ws + WS_BIAS);
    for (int it = blockIdx.x; it < 62; it += gridDim.x) {
        const int l = it / 31, r = it % 31; const bool up = r >= 9;
        const int N = up ? DUP : INC, n0 = (up ? r - 9 : r) * 256 + 4 * lane;
        const float* W = up ? a.in[24] + (size_t)l * 1024 * DUP : a.in[13] + (size_t)l * 1024 * INC;
        const float* shp = mod + (size_t)l * 3 * 6144 + (up ? 3072 : 0);
        LAS float* sl = (LAS float*)(lds + 32768);
        for (int e = tid; e < 3072; e += NT) sl[e] = shp[(e >> 10) * 6144 + (e & 1023)];
        __syncthreads();
        const bool act = n0 < N;
        f32x4 acc[3] = {(f32x4){0.f, 0.f, 0.f, 0.f}, (f32x4){0.f, 0.f, 0.f, 0.f}, (f32x4){0.f, 0.f, 0.f, 0.f}};
        const int kb = wave * 128;
#pragma unroll 16
        for (int k = 0; k < 128; ++k) { const int kk = kb + k;
            const f32x4 w = act ? __builtin_nontemporal_load((const f32x4*)(W + (size_t)kk * N + n0)) : (f32x4){0.f, 0.f, 0.f, 0.f};
            acc[0] += w * sl[kk]; acc[1] += w * sl[1024 + kk]; acc[2] += w * sl[2048 + kk]; }
        LAS f32x4* red = (LAS f32x4*)lds;
#pragma unroll
        for (int c = 0; c < 3; ++c) red[(wave * 3 + c) * 64 + lane] = acc[c];
        __syncthreads();
        if (tid < 192) { const int c = tid >> 6, ln = tid & 63; f32x4 t = red[c * 64 + ln];
#pragma unroll
            for (int w = 1; w < 8; ++w) t += red[(w * 3 + c) * 64 + ln];
            const int nn = (up ? r - 9 : r) * 256 + 4 * ln;
            if (nn < N) *(f32x4*)(BIAS + (size_t)(l * 3 + c) * NBIAS + (up ? 2304 : 0) + nn) = t;
            else if (!up && nn < 2304) *(f32x4*)(BIAS + (size_t)(l * 3 + c) * NBIAS + nn) = (f32x4){0.f, 0.f, 0.f, 0.f}; }
        __syncthreads();
    }
}

struct P3Ptrs {
    const bf16* PROJ; bf16 *A2, *KPE, *YCAT, *Qc_rot, *Qc_raw, *Kc, *Vc, *Qd_rot, *Qd_raw, *Kd, *Vd;
    const float *conv_a, *gq_mla, *gkv_mla, *gq, *gk, *rope;
    const float *c_ckv, *c_kpe, *c_gk, *c_gv, *c_sk, *c_sv;
    float *o_ckv, *o_kpe, *o_gk, *o_gv, *o_sk, *o_sv;
    int l;
};
__device__ __forceinline__ f32x4 rope64(f32x4 v, int jl, int prow, int pcol, const float* rt, int lane) {
    const f32x4 pr = shfl4(v, 4, lane);
    const int pos = jl < 8 ? prow : pcol, fi = 4 * (jl & 3);
    const f32x4 c = *(const f32x4*)(rt + pos * 16 + fi), s = *(const f32x4*)(rt + 1024 + pos * 16 + fi);
    const float sg = (jl & 4) ? 1.f : -1.f;
    return v * c + pr * s * sg;
}
__device__ __forceinline__ void p3_phase(const P3Ptrs& P, int lane, int gw, int NGW) {
    const int l = P.l;
    for (int row = gw; row < NKR; row += NGW) {
        if (row < NTOK) {
            const bool samp = row >= NPR;
            int b, t, kr, T;
            if (!samp) { b = row >> 8; t = row & 255; kr = row; T = 256; } else { b = (row - NPR) >> 11; t = (row - NPR) & 2047; kr = NPR + b * 2560 + t; T = 2048; }
            const int prow = t >> 6, pcol = t & 63;
            const bf16* pr = P.PROJ + (size_t)row * INP;
            const size_t ob = (size_t)((b * 2 + l) * 256 + t);
            const int ci = 4 * lane, jl = lane & 15;
            const u32x2 z2 = (u32x2){0u, 0u};
            const bool hp = t > 0, hn = t < T - 1;
            const u32x2 r_xa = *(const u32x2*)(pr + ci), r_gb = *(const u32x2*)(pr + 256 + ci), r_gc = *(const u32x2*)(pr + 512 + ci);
            const u32x2 r_pxa = hp ? *(const u32x2*)(pr - INP + ci) : z2, r_pgc = hp ? *(const u32x2*)(pr - INP + 512 + ci) : z2;
            const u32x2 r_nxa = hn ? *(const u32x2*)(pr + INP + ci) : z2, r_ngc = hn ? *(const u32x2*)(pr + INP + 512 + ci) : z2;
            const u32x2 r_cq = lane < 48 ? *(const u32x2*)(pr + 768 + ci) : z2, r_ckv = lane < 32 ? *(const u32x2*)(pr + 960 + ci) : z2, r_kpe = lane < 8 ? *(const u32x2*)(pr + 1088 + ci) : z2;
            const u32x2 r_qc = *(const u32x2*)(pr + 1120 + ci), r_kvc = *(const u32x2*)(pr + 1376 + ci), r_qd = *(const u32x2*)(pr + 1632 + ci), r_kvd = *(const u32x2*)(pr + 1888 + ci);
            const float* cw = P.conv_a + (size_t)l * 768;
            const f32x4 w0 = *(const f32x4*)(cw + ci), w1 = *(const f32x4*)(cw + 256 + ci), w2 = *(const f32x4*)(cw + 512 + ci);
            const f32x4 g_qm = lane < 48 ? *(const f32x4*)(P.gq_mla + l * 192 + ci) : (f32x4){0.f, 0.f, 0.f, 0.f}, g_kvm = lane < 32 ? *(const f32x4*)(P.gkv_mla + l * 128 + ci) : (f32x4){0.f, 0.f, 0.f, 0.f};
            const f32x4 g_q = *(const f32x4*)(P.gq + l * 64 + 4 * jl), g_k = *(const f32x4*)(P.gk + l * 64 + 4 * jl);
            const int pos64 = jl < 8 ? prow : pcol, fi64 = 4 * (jl & 3);
            const f32x4 c64 = *(const f32x4*)(P.rope + pos64 * 16 + fi64), s64 = *(const f32x4*)(P.rope + 1024 + pos64 * 16 + fi64);
            const int pos32 = (lane & 7) < 4 ? prow : pcol, fi32 = 4 * (lane & 1);
            const f32x4 c32 = *(const f32x4*)(P.rope + 2048 + pos32 * 8 + fi32), s32 = *(const f32x4*)(P.rope + 2560 + pos32 * 8 + fi32);
#define CV4(u) ((f32x4){bflo((u).x), bfhi((u).x), bflo((u).y), bfhi((u).y)})
#define ROPE64(v) ((v) * c64 + shfl4((v), 4, lane) * s64 * ((jl & 4) ? 1.f : -1.f))
            { const f32x4 ya = CV4(r_gb) * (w0 * (CV4(r_pxa) * CV4(r_pgc)) + w1 * (CV4(r_xa) * CV4(r_gc)) + w2 * (CV4(r_nxa) * CV4(r_ngc)));
              st4bf(P.YCAT + (size_t)row * DM + ci, ya); }
            { const f32x4 v = CV4(r_cq);
              const float rs = rsqrtf(wave_sum(dot4(v), lane) * (1.f / 192.f) + EPS);
              if (lane < 48) st4bf(P.A2 + (size_t)kr * 384 + ci, v * rs * g_qm); }
            { const f32x4 v = CV4(r_ckv);
              const float rs = rsqrtf(wave_sum(dot4(v), lane) * (1.f / 128.f) + EPS);
              if (lane < 32) { const f32x4 o = v * rs * g_kvm;
                  st4bf(P.A2 + (size_t)kr * 384 + 192 + ci, o);
                  if (!samp) __builtin_nontemporal_store((f32x4)(o), (f32x4*)(P.o_ckv + ob * 128 + ci)); }
              else if (lane < 48) { unsigned zz = 0u; asm volatile("" : "+v"(zz)); *(u32x2*)(P.A2 + (size_t)kr * 384 + 320 + 4 * (lane - 32)) = (u32x2){zz, zz}; } }
            { const f32x4 v = CV4(r_kpe);
              const f32x4 r = v * c32 + shfl4(v, 2, lane) * s32 * ((lane & 2) ? 1.f : -1.f);
              if (lane < 8) { if (!samp) __builtin_nontemporal_store((f32x4)(v), (f32x4*)(P.o_kpe + ob * 32 + ci)); st4bf(P.KPE + (size_t)kr * 32 + ci, samp ? r : v); } }
            { f32x4 v = CV4(r_qc);
              const float rs = rsqrtf(sum16(dot4(v), lane) * (1.f / 64.f) + EPS);
              v = v * rs * g_q;
              st4bf(P.Qc_raw + (size_t)kr * 256 + ci, v * QS);
              const f32x4 r = ROPE64(v);
              if (samp) st4bf(P.Qc_rot + (size_t)kr * 256 + ci, r * QS); }
            { const f32x4 v = CV4(r_kvc);
              const float rs = rsqrtf(sum16(dot4(v), lane) * (1.f / 64.f) + EPS);
              const f32x4 kn = v * rs * g_k;
              const f32x4 r = ROPE64(kn);
              if (lane < 32) { if (!samp) __builtin_nontemporal_store((f32x4)(kn), (f32x4*)(P.o_gk + ob * 128 + ci)); st4bf(P.Kc + (size_t)kr * 128 + ci, samp ? r : kn); }
              else { if (!samp) __builtin_nontemporal_store((f32x4)(v), (f32x4*)(P.o_gv + ob * 128 + 4 * (lane - 32))); st4bf(P.Vc + (size_t)kr * 128 + 4 * (lane - 32), v); } }
            { const f32x4 v = CV4(r_qd);
              st4bf(P.Qd_raw + (size_t)kr * 256 + ci, v * QS);
              const f32x4 r = ROPE64(v);
              if (samp) st4bf(P.Qd_rot + (size_t)kr * 256 + ci, r * QS); }
            { const f32x4 v = CV4(r_kvd);
              const f32x4 r = ROPE64(v);
              if (lane < 32) { if (!samp) __builtin_nontemporal_store((f32x4)(v), (f32x4*)(P.o_sk + ob * 128 + ci)); st4bf(P.Kd + (size_t)kr * 128 + ci, samp ? r : v); }
              else { if (!samp) __builtin_nontemporal_store((f32x4)(v), (f32x4*)(P.o_sv + ob * 128 + 4 * (lane - 32))); st4bf(P.Vd + (size_t)kr * 128 + 4 * (lane - 32), v); } }
#undef CV4
#undef ROPE64
        } else {
            const int ci = row - NTOK, b = ci >> 9, j = ci & 511, kr = NPR + b * 2560 + 2048 + j;
            const size_t cb = (size_t)((b * 2 + l) * 512 + j);
            f32x4 z = (f32x4){0.f, 0.f, 0.f, 0.f}; asm volatile("" : "+v"(z));
            if (lane < 48) st4bf(P.A2 + (size_t)kr * 384 + 4 * lane, z);
            if (lane < 32) st4bf(P.A2 + (size_t)kr * 384 + 192 + 4 * lane, *(const f32x4*)(P.c_ckv + cb * 128 + 4 * lane));
            else if (lane < 48) st4bf(P.A2 + (size_t)kr * 384 + 320 + 4 * (lane - 32), z);
            if (lane < 8) st4bf(P.KPE + (size_t)kr * 32 + 4 * lane, *(const f32x4*)(P.c_kpe + cb * 32 + 4 * lane));
            if (lane < 32) { st4bf(P.Kc + (size_t)kr * 128 + 4 * lane, *(const f32x4*)(P.c_gk + cb * 128 + 4 * lane));
                             st4bf(P.Kd + (size_t)kr * 128 + 4 * lane, *(const f32x4*)(P.c_sk + cb * 128 + 4 * lane)); }
            else { st4bf(P.Vc + (size_t)kr * 128 + 4 * (lane - 32), *(const f32x4*)(P.c_gv + cb * 128 + 4 * (lane - 32)));
                   st4bf(P.Vd + (size_t)kr * 128 + 4 * (lane - 32), *(const f32x4*)(P.c_sv + cb * 128 + 4 * (lane - 32))); }
        }
    }
}

struct AttnSrc {
    const bf16* Qraw; const bf16* Qrot; int qpitch;
    const bf16* K0; int k0pitch; const bf16* K1;
    const bf16* V; int vpitch;
    bf16* Y; int outcol;
    int krbase, rowbase, q0, lo, hi, nctx;
    bool samp, window; float m0; bool sink;
    const float* rope;
};
template <int DK>
__device__ __forceinline__ void attn_unit(const AttnSrc& S, LAS unsigned char* lds, int tid, int lane, int wave, unsigned* ctr, unsigned& nxt_u) {
    constexpr int TK = 128, NKB = TK / 16, NPP = TK / 32;
    constexpr int KP = DK + 8, VP = TK + 8, KS = DK / 32, CPK = DK / 8;
    constexpr int NKC = TK * CPK / NT, NVC = TK * 8 / NT;
    LAS bf16* Ks = (LAS bf16*)lds;
    LAS bf16* Vt = (LAS bf16*)(lds + 2 * TK * KP * 2);
    const int g = lane >> 4, fr = lane & 15;
    const int qpos = S.q0 + wave * 16 + fr;
    const size_t qkr = (size_t)(S.krbase + qpos);
    bf16x8 qraw[KS], qrot[KS];
#pragma unroll
    for (int ks = 0; ks < KS; ++ks) { qraw[ks] = *(const bf16x8*)(S.Qraw + qkr * S.qpitch + ks * 32 + g * 8); qrot[ks] = qraw[ks]; }
    if (S.samp) {
        if (DK == 96) {
            const bf16x8 own = qraw[KS - 1], par = *(const bf16x8*)(S.Qraw + qkr * S.qpitch + 64 + (g ^ 1) * 8);
            const int pos = g < 2 ? (qpos >> 6) : (qpos & 63);
            const float sg = (g & 1) ? 1.f : -1.f;
            const float* ct = S.rope + 2048 + pos * 8; const float* st = S.rope + 2560 + pos * 8;
            bf16x8 r;
#pragma unroll
            for (int e = 0; e < 8; ++e) { const float o = bflo((unsigned)(unsigned short)own[e]), p = bflo((unsigned)(unsigned short)par[e]);
                r[e] = (short)f2bf(o * ct[e] + p * st[e] * sg); }
            qrot[KS - 1] = r;
        } else {
#pragma unroll
            for (int ks = 0; ks < KS; ++ks) qrot[ks] = *(const bf16x8*)(S.Qrot + qkr * S.qpitch + ks * 32 + g * 8);
        }
    }
    bf16x8 qc[KS];
#pragma unroll
    for (int ks = 0; ks < KS; ++ks) qc[ks] = S.samp ? qrot[ks] : qraw[ks];
    float m = S.m0, l = (S.sink && g == 0) ? 1.f : 0.f;
    f32x4 o[4];
#pragma unroll
    for (int d = 0; d < 4; ++d) o[d] = (f32x4){0.f, 0.f, 0.f, 0.f};
    const int nloc = S.hi - S.lo, ntile = nloc + S.nctx;
    u32x4 kreg[NKC], vreg[NVC];
    auto gload = [&](int j) {
        const int tile = j < nloc ? S.lo + j : (2048 / TK) + (j - nloc);
        const size_t kr = (size_t)(S.krbase + tile * TK);
#pragma unroll
        for (int c = 0; c < NKC; ++c) { const int ch = tid + c * NT, key = ch / CPK, part = ch % CPK;
            if (DK == 64) kreg[c] = *(const u32x4*)(S.K0 + (kr + key) * S.k0pitch + part * 8);
            else kreg[c] = part < 8 ? *(const u32x4*)(S.K0 + (kr + key) * S.k0pitch + part * 8) : *(const u32x4*)(S.K1 + (kr + key) * 32 + (part - 8) * 8); }
#pragma unroll
        for (int c = 0; c < NVC; ++c) { const int ch = tid + c * NT, vkey = ch & (TK - 1), vdc = ch / TK;
            vreg[c] = *(const u32x4*)(S.V + (kr + vkey) * S.vpitch + vdc * 8); }
    };
    auto lstore = [&](int buf) {
        LAS bf16* kb = Ks + buf * TK * KP; LAS bf16* vb = Vt + buf * 64 * VP;
#pragma unroll
        for (int c = 0; c < NKC; ++c) { const int ch = tid + c * NT, key = ch / CPK, part = ch % CPK; *(LAS u32x4*)(kb + key * KP + part * 8) = kreg[c]; }
#pragma unroll
        for (int c = 0; c < NVC; ++c) { const int ch = tid + c * NT, vkey = ch & (TK - 1), vdc = ch / TK;
            LAS bf16* vp = vb + (vdc * 8) * VP + vkey; const u32x4 v = vreg[c];
            vp[0 * VP] = (bf16)(v.x & 0xffffu); vp[1 * VP] = (bf16)(v.x >> 16); vp[2 * VP] = (bf16)(v.y & 0xffffu); vp[3 * VP] = (bf16)(v.y >> 16);
            vp[4 * VP] = (bf16)(v.z & 0xffffu); vp[5 * VP] = (bf16)(v.z >> 16); vp[6 * VP] = (bf16)(v.w & 0xffffu); vp[7 * VP] = (bf16)(v.w >> 16); }
    };
    gload(0); lstore(0);
    __syncthreads();
    for (int j = 0; j < ntile; ++j) {
        const int buf = j & 1;
        if (j + 1 < ntile) gload(j + 1);
        else if (tid == 0) nxt_u = atomicAdd(ctr, 1u);
        const bool loc = j < nloc;
        if (j == nloc) {
#pragma unroll
            for (int ks = 0; ks < KS; ++ks) qc[ks] = qraw[ks]; }
        const LAS bf16* kb = Ks + buf * TK * KP; const LAS bf16* vb = Vt + buf * 64 * VP;
        f32x4 s[NKB];
#pragma unroll
        for (int kk = 0; kk < NKB; ++kk) { s[kk] = (f32x4){0.f, 0.f, 0.f, 0.f};
#pragma unroll
            for (int ks = 0; ks < KS; ++ks) { const bf16x8 af = *(const LAS bf16x8*)(kb + (kk * 16 + fr) * KP + ks * 32 + g * 8);
                s[kk] = __builtin_amdgcn_mfma_f32_16x16x32_bf16(af, qc[ks], s[kk], 0, 0, 0); } }
        if (S.window && loc) {
            const int kp0 = (S.lo + j) * TK + g * 4;
#pragma unroll
            for (int kk = 0; kk < NKB; ++kk)
#pragma unroll
                for (int i = 0; i < 4; ++i) { const int d = kp0 + kk * 16 + i - qpos; if (d > 128 || d < -128) s[kk][i] = -INFINITY; }
        }
        float mx = -INFINITY;
#pragma unroll
        for (int kk = 0; kk < NKB; ++kk) mx = fmaxf(mx, fmaxf(fmaxf(s[kk][0], s[kk][1]), fmaxf(s[kk][2], s[kk][3])));
        if (__builtin_amdgcn_ballot_w64(mx > m + 8.f) != 0ull) {
            mx = fmaxf(mx, shx(mx, 16, lane)); mx = fmaxf(mx, shx(mx, 32, lane));
            const float mn = fmaxf(m, mx), alpha = __builtin_amdgcn_exp2f(m - mn);
            m = mn; l = l * alpha;
#pragma unroll
            for (int d = 0; d < 4; ++d) o[d] = o[d] * alpha;
        }
        float ls = 0.f;
#pragma unroll
        for (int kk = 0; kk < NKB; ++kk)
#pragma unroll
            for (int i = 0; i < 4; ++i) { const float p = __builtin_amdgcn_exp2f(s[kk][i] - m); s[kk][i] = p; ls += p; }
        l += ls;
        bf16x8 pf[NPP];
#pragma unroll
        for (int pp = 0; pp < NPP; ++pp) {
            const unsigned w0 = pk2(s[2 * pp][0], s[2 * pp][1]), w1 = pk2(s[2 * pp][2], s[2 * pp][3]), w2 = pk2(s[2 * pp + 1][0], s[2 * pp + 1][1]), w3 = pk2(s[2 * pp + 1][2], s[2 * pp + 1][3]);
            pf[pp] = __builtin_bit_cast(bf16x8, (u32x4){w0, w1, w2, w3});
        }
#pragma unroll
        for (int d = 0; d < 4; ++d)
#pragma unroll
            for (int pp = 0; pp < NPP; ++pp) {
                const LAS bf16* vr = vb + (d * 16 + fr) * VP + pp * 32 + g * 4;
                const u32x2 lo = *(const LAS u32x2*)vr, hi = *(const LAS u32x2*)(vr + 16);
                const bf16x8 af = __builtin_bit_cast(bf16x8, (u32x4){lo.x, lo.y, hi.x, hi.y});
                o[d] = __builtin_amdgcn_mfma_f32_16x16x32_bf16(af, pf[pp], o[d], 0, 0, 0);
            }
        if (j + 1 < ntile) lstore(buf ^ 1);
        __syncthreads();
    }
    float lt = l + shx(l, 16, lane); lt += shx(lt, 32, lane);
    const float inv = 1.f / lt;
    bf16* yr = S.Y + (size_t)(S.rowbase + qpos) * DM + S.outcol + g * 4;
#pragma unroll
    for (int d = 0; d < 4; ++d) st4bf(yr + d * 16, o[d] * inv);
}

struct AttnBufs { const bf16 *MQKV, *KPE, *Qc_rot, *Qc_raw, *Kc, *Vc, *Qd_rot, *Qd_raw, *Kd, *Vd; bf16* YCAT; const float* sink; const float* rope; unsigned* ctr; };
constexpr int ATT_NU = 384 + 768;
__device__ __forceinline__ void attn_phase(const AttnBufs& B, LAS unsigned char* lds, int tid, int lane, int wave) {
    volatile LAS unsigned* shu = (volatile LAS unsigned*)(lds + LDS_CTL);
    if (tid == 0) *shu = atomicAdd(B.ctr, 1u);
    __syncthreads();
    for (;;) {
        const int u = (int)*shu;
        if (u >= ATT_NU) break;
        unsigned nxt_u = 0u;
        int type, b, h, qt; bool samp;
        if (u < 384) { type = u >> 7; const int v = u & 127; b = v >> 6; h = (v >> 4) & 3; qt = v & 15; samp = true; }
        else { const int w = u - 384; type = w >> 8; const int v = w & 255; b = v >> 3; h = (v >> 1) & 3; qt = v & 1; samp = false; }
        AttnSrc S;
        S.samp = samp; S.q0 = qt * 128; S.rope = B.rope; S.Y = B.YCAT;
        S.krbase = samp ? NPR + b * 2560 : b * 256; S.rowbase = samp ? NPR + b * 2048 : b * 256;
        S.window = false; S.sink = false; S.m0 = -1e30f;
        if (!samp) { S.lo = 0; S.hi = 2; S.nctx = 0; }
        else { S.lo = 0; S.hi = 16; S.nctx = 4; }
        if (type == 0) {
            S.Qraw = B.MQKV + h * 96; S.Qrot = S.Qraw; S.qpitch = 1024; S.K0 = B.MQKV + 384 + h * 128; S.k0pitch = 1024; S.K1 = B.KPE; S.V = B.MQKV + 384 + h * 128 + 64; S.vpitch = 1024; S.outcol = 256 + h * 64;
            attn_unit<96>(S, lds, tid, lane, wave, B.ctr, nxt_u);
        } else {
            if (type == 1) { S.Qraw = B.Qc_raw + h * 64; S.Qrot = B.Qc_rot + h * 64; S.K0 = B.Kc + (h >> 1) * 64; S.V = B.Vc + (h >> 1) * 64; S.outcol = 512 + h * 64; }
            else { S.Qraw = B.Qd_raw + h * 64; S.Qrot = B.Qd_rot + h * 64; S.K0 = B.Kd + (h >> 1) * 64; S.V = B.Vd + (h >> 1) * 64; S.outcol = 768 + h * 64;
                   S.sink = true; S.m0 = B.sink[h] * LOG2E;
                   if (samp) { S.window = true; const int lo = S.q0 / 128 - 1; S.lo = lo < 0 ? 0 : lo; const int hi = S.q0 / 128 + 2; S.hi = hi > 16 ? 16 : hi; } }
            S.qpitch = 256; S.k0pitch = 128; S.K1 = nullptr; S.vpitch = 128;
            attn_unit<64>(S, lds, tid, lane, wave, B.ctr, nxt_u);
        }
        if (tid == 0) *shu = nxt_u;
        __syncthreads();
    }
}

__device__ __forceinline__ void load8(const bf16* p, float (&o)[8]) { const u32x4 u = *(const u32x4*)p; o[0] = bflo(u.x); o[1] = bfhi(u.x); o[2] = bflo(u.y); o[3] = bfhi(u.y); o[4] = bflo(u.z); o[5] = bfhi(u.z); o[6] = bflo(u.w); o[7] = bfhi(u.w); }
__device__ __forceinline__ void convgate_phase(const bf16* U, const float* cf, bf16* ACT, int gt, int NGT) {
    constexpr int NCH = DFF / 8, RG = 8;
    for (int it = gt; it < (NTOK / RG) * NCH; it += NGT) {
        const int rg = it / NCH, cc = it % NCH, r0 = rg * RG, col = cc * 8;
        const bool samp = r0 >= NPR; const int t0 = samp ? ((r0 - NPR) & 2047) : (r0 & 255), T = samp ? 2048 : 256;
        const bf16* up = U + (size_t)r0 * DUP + col;
        u32x4 ra[RG + 2], rb[RG + 2];
        const u32x4 z4 = (u32x4){0u, 0u, 0u, 0u};
        ra[0] = z4; rb[0] = z4; ra[RG + 1] = z4; rb[RG + 1] = z4;
        if (t0 > 0) { ra[0] = *(const u32x4*)(up - DUP); rb[0] = *(const u32x4*)(up - DUP + DFF); }
#pragma unroll
        for (int i = 0; i < RG; ++i) { ra[i + 1] = *(const u32x4*)(up + (size_t)i * DUP); rb[i + 1] = *(const u32x4*)(up + (size_t)i * DUP + DFF); }
        if (t0 + RG < T) { ra[RG + 1] = *(const u32x4*)(up + (size_t)RG * DUP); rb[RG + 1] = *(const u32x4*)(up + (size_t)RG * DUP + DFF); }
        float wa[3][8], wb[3][8];
#pragma unroll
        for (int k = 0; k < 3; ++k) { const f32x4 a0 = *(const f32x4*)(cf + k * DUP + col), a1 = *(const f32x4*)(cf + k * DUP + col + 4), b0 = *(const f32x4*)(cf + k * DUP + DFF + col), b1 = *(const f32x4*)(cf + k * DUP + DFF + col + 4);
#pragma unroll
            for (int e = 0; e < 4; ++e) { wa[k][e] = a0[e]; wa[k][4 + e] = a1[e]; wb[k][e] = b0[e]; wb[k][4 + e] = b1[e]; } }
#pragma unroll
        for (int i = 0; i < RG; ++i) {
            float r[8];
#pragma unroll
            for (int h = 0; h < 4; ++h) {
                const unsigned pa = ra[i][h], ca = ra[i + 1][h], na = ra[i + 2][h], pb = rb[i][h], cb = rb[i + 1][h], nb = rb[i + 2][h];
                const float xa0 = wa[0][2 * h] * bflo(pa) + wa[1][2 * h] * bflo(ca) + wa[2][2 * h] * bflo(na), xb0 = wb[0][2 * h] * bflo(pb) + wb[1][2 * h] * bflo(cb) + wb[2][2 * h] * bflo(nb);
                const float xa1 = wa[0][2 * h + 1] * bfhi(pa) + wa[1][2 * h + 1] * bfhi(ca) + wa[2][2 * h + 1] * bfhi(na), xb1 = wb[0][2 * h + 1] * bfhi(pb) + wb[1][2 * h + 1] * bfhi(cb) + wb[2][2 * h + 1] * bfhi(nb);
                r[2 * h] = xa0 * __builtin_amdgcn_rcpf(1.f + __builtin_amdgcn_exp2f(-xa0 * LOG2E)) * xb0;
                r[2 * h + 1] = xa1 * __builtin_amdgcn_rcpf(1.f + __builtin_amdgcn_exp2f(-xa1 * LOG2E)) * xb1;
            }
            u32x4 w; w.x = pk2(r[0], r[1]); w.y = pk2(r[2], r[3]); w.z = pk2(r[4], r[5]); w.w = pk2(r[6], r[7]);
            *(u32x4*)(ACT + (size_t)(r0 + i) * DFF + col) = w;
        }
    }
}

#define XB_TMO      128
#define XB_XCNT(j)  (256  + 64 * (j))
#define XB_XSUB(j)  (1280 + 64 * (j))
#define XB_XGEN(j)  (2304 + 64 * (j))
#define XB_TOP      3328
#define XB_TOPGEN   3392
#define XCD_BAR_WORDS 3456
#define XB_SPIN_CAP (1u << 20)
__device__ __forceinline__ unsigned xb_ld(unsigned* p)              { return __hip_atomic_load(p, __ATOMIC_RELAXED, __HIP_MEMORY_SCOPE_AGENT); }
__device__ __forceinline__ unsigned xb_add(unsigned* p, unsigned v) { return __hip_atomic_fetch_add(p, v, __ATOMIC_RELAXED, __HIP_MEMORY_SCOPE_AGENT); }
__device__ __forceinline__ unsigned xb_xcc_id() { return (unsigned)__builtin_amdgcn_s_getreg((3 << 11) | 20) & 0xFu; }
#define XB_SPIN(cond, bar) do { unsigned _sp = 0; while (cond) { __builtin_amdgcn_s_sleep(1); \
    if ((++_sp & 255u) == 0u) { if (xb_ld(&(bar)[XB_TMO])) break; if (_sp > XB_SPIN_CAP) { atomicAdd(&(bar)[XB_TMO], 1u); break; } } } } while (0)
struct XcdBarrier { unsigned* bar; unsigned x; volatile LAS unsigned* st; };
__device__ __forceinline__ void xcd_barrier_complete(unsigned* bar, unsigned x, unsigned& nloc, unsigned& nx) {
    const unsigned G = gridDim.x * gridDim.y * gridDim.z;
    unsigned sum, cnt, mine, sp = 0u;
    for (;;) {
        sum = 0u; cnt = 0u; mine = 0u;
#pragma unroll
        for (unsigned j = 0; j < 16; ++j) { const unsigned c = xb_ld(&bar[XB_XCNT(j)]); sum += c; cnt += (c > 0u) ? 1u : 0u; mine = (j == x) ? c : mine; }
        if (sum == G) break;
        __builtin_amdgcn_s_sleep(1);
        if ((++sp & 255u) == 0u) { if (xb_ld(&bar[XB_TMO])) break; if (sp > XB_SPIN_CAP) { atomicAdd(&bar[XB_TMO], 1u); break; } }
    }
    nloc = mine > 0u ? mine : 1u; nx = cnt > 0u ? cnt : 1u;
}
__device__ __forceinline__ void xcd_barrier(const XcdBarrier& b, const int tid_) {
    asm volatile("s_waitcnt vmcnt(0)" ::: "memory");
    __syncthreads();
    if (tid_ == 0) {
        unsigned* bar = b.bar;
        __builtin_amdgcn_s_waitcnt(0);
        unsigned nloc = b.st[0], nx = b.st[1];
        if (nloc == 0u) { xcd_barrier_complete(bar, b.x, nloc, nx); b.st[0] = nloc; b.st[1] = nx; }
        const unsigned old = xb_add(&bar[XB_XSUB(b.x)], 1u);
        const unsigned gen = old / nloc;
        if (old + 1u == (gen + 1u) * nloc) {
            __builtin_amdgcn_fence(__ATOMIC_RELEASE, "agent");
            asm volatile("s_waitcnt vmcnt(0)" ::: "memory");
            const unsigned og = xb_add(&bar[XB_TOP], 1u);
            const unsigned tg = og / nx;
            if (og + 1u == (tg + 1u) * nx) xb_add(&bar[XB_TOPGEN], 1u);
            else XB_SPIN(xb_ld(&bar[XB_TOPGEN]) == tg, bar);
            __builtin_amdgcn_fence(__ATOMIC_ACQUIRE, "agent");
            xb_add(&bar[XB_XGEN(b.x)], 1u);
            asm volatile("s_waitcnt vmcnt(0)" ::: "memory");
        } else {
            XB_SPIN(xb_ld(&bar[XB_XGEN(b.x)]) == gen, bar);
            __builtin_amdgcn_fence(__ATOMIC_ACQUIRE, "agent");
            asm volatile("s_waitcnt vmcnt(0)" ::: "memory");
        }
    }
    __syncthreads();
}

__device__ __forceinline__ int lane_id_volatile() { int l; asm volatile("v_mbcnt_lo_u32_b32 %0, -1, 0\n\tv_mbcnt_hi_u32_b32 %0, -1, %0" : "=v"(l)); return l; }

#ifndef PH
#define PH 0xFFFF
#endif
#define ON(k) ((PH >> (k)) & 1)
#ifndef REP
#define REP 0
#endif
#define NREP(k) (1 + ((REP >> (k)) & 1))
__global__ void __launch_bounds__(NT, 2) mega_fwd(Args a_unused) {
    extern __shared__ __attribute__((aligned(16))) unsigned char lds[];
    cg::grid_group grid = cg::this_grid();
    const int G = gridDim.x, bid = blockIdx.x;
    const int wave_s = __builtin_amdgcn_readfirstlane(threadIdx.x >> 6);
    PG8_LAS unsigned char* ring = (PG8_LAS unsigned char*)lds;
#define PHASE_BEGIN int tid = wave_s * 64 + lane_id_volatile(); asm volatile("" : "+v"(tid)); const CAS Args* ap_ = (const CAS Args*)__builtin_amdgcn_kernarg_segment_ptr(); asm volatile("" : "+s"(ap_)); const CAS Args& a = *ap_; unsigned char* ws = a.ws; float* out = a.out; \
    const int lane = tid & 63, wave = __builtin_amdgcn_readfirstlane(tid >> 6); const int gw = bid * NW + wave, NGW = G * NW, gt = bid * NT + tid, NGT = G * NT; \
    (void)lane; (void)wave; (void)gw; (void)NGW; (void)gt; (void)NGT; (void)out; \
    const float* mod = (const float*)(ws + WS_MOD); const float* rope = (const float*)(ws + WS_ROPE); (void)mod; (void)rope; \
    bf16* XN = (bf16*)(ws + WS_XN); bf16* PROJ = (bf16*)(ws + WS_PROJ); bf16* A2 = (bf16*)(ws + WS_A2); bf16* MQKV = (bf16*)(ws + WS_MQKV); \
    bf16* KPE = (bf16*)(ws + WS_KPE); bf16* YCAT = (bf16*)(ws + WS_YCAT); bf16* ACT = (bf16*)(ws + WS_ACT); bf16* U = (bf16*)(ws + WS_U); \
    bf16* Qc_rot = (bf16*)(ws + WS_QC); bf16* Qc_raw = (bf16*)(ws + WS_QC + QSZ); bf16* Kc = (bf16*)(ws + WS_QC + 2 * QSZ); bf16* Vc = (bf16*)(ws + WS_QC + 2 * QSZ + KSZ); \
    bf16* Qd_rot = (bf16*)(ws + WS_QC + 2 * QSZ + 2 * KSZ); bf16* Qd_raw = Qd_rot + (size_t)NKR * 256; bf16* Kd = Qd_raw + (size_t)NKR * 256; bf16* Vd = Kd + (size_t)NKR * 128; \
    (void)XN; (void)PROJ; (void)A2; (void)MQKV; (void)KPE; (void)YCAT; (void)ACT; (void)U; (void)Qc_rot; (void)Qc_raw; (void)Kc; (void)Vc; (void)Qd_rot; (void)Qd_raw; (void)Kd; (void)Vd;
#define GSYNC() do { const CAS Args* bp_ = (const CAS Args*)__builtin_amdgcn_kernarg_segment_ptr(); asm volatile("" : "+s"(bp_)); XcdBarrier xb_; xb_.bar = (unsigned*)(bp_->ws + WS_BAR); xb_.x = xb_xcc_id(); \
    xb_.st = (volatile LAS unsigned*)((LAS unsigned char*)lds + LDS_CTL + 32); xcd_barrier(xb_, wave_s * 64 + lane_id_volatile()); } while (0)
#define LAYER_VALS const float* modl = mod + (size_t)l * 3 * 6144; unsigned char* wl = ws + WS_W + l * W_LSTRIDE; (void)modl; (void)wl; \
    const float* x0 = l == 0 ? a.in[0] : nullptr; const float* x1 = l == 0 ? a.in[1] : nullptr; (void)x0; (void)x1; bf16* XRES = (bf16*)(ws + WS_XRES); (void)XRES;

    if (threadIdx.x < 16) ((volatile LAS unsigned*)((LAS unsigned char*)lds + LDS_CTL))[threadIdx.x] = 0u;
    __syncthreads();
    { PHASE_BEGIN if (tid == 0) (void)xb_add((unsigned*)(ws + WS_BAR) + XB_XCNT(xb_xcc_id()), 1u);
      if (ws == nullptr) grid.sync(); }
    for (int rep = 0; rep < NREP(0); ++rep) {
    if (ON(0)) { PHASE_BEGIN phase0(a, (LAS unsigned char*)lds, tid, lane, wave); }
    GSYNC(); }

    if (ON(1)) { PHASE_BEGIN
        if (G > 124) {
            if (bid < 62) bias_phase(a, ws, (LAS unsigned char*)lds, tid, lane, wave);
            else prep_phase(a.in[0], a.in[1], a.in[12], mod, 1024, XN, (float*)(ws + WS_SS1), lane, (bid - 62) * NW + wave, (G - 62) * NW);
        } else { bias_phase(a, ws, (LAS unsigned char*)lds, tid, lane, wave);
            prep_phase(a.in[0], a.in[1], a.in[12], mod, 1024, XN, (float*)(ws + WS_SS1), lane, gw, NGW); } }
    GSYNC();
#pragma unroll
    for (int l = 0; l < 2; ++l) {
        for (int rep = 0; rep < NREP(2); ++rep) {
        if (ON(2)) { PHASE_BEGIN LAYER_VALS pg8::Gemm g{XN, (const bf16*)(wl + W_IN), NTOK, INP, DM, 0, 0}; pg8::StaticOrder S; S.init(NTOK, INP, G, bid);
          pg8::EpiBf16RS E{PROJ, INP, (const float*)(ws + WS_SS1), (const float*)(ws + WS_BIAS) + (size_t)l * 3 * NBIAS, NBIAS};
          pg8::gemm_phase<pg8::EpiBf16RS, pg8::StaticOrder, true, true>(ring, g, S, E, tid); }
        GSYNC(); }
        for (int rep = 0; rep < NREP(3); ++rep) {
        if (ON(3)) { PHASE_BEGIN P3Ptrs P; P.PROJ = PROJ; P.A2 = A2; P.KPE = KPE; P.YCAT = YCAT; P.Qc_rot = Qc_rot; P.Qc_raw = Qc_raw; P.Kc = Kc; P.Vc = Vc; P.Qd_rot = Qd_rot; P.Qd_raw = Qd_raw; P.Kd = Kd; P.Vd = Vd;
          P.conv_a = a.in[14]; P.gq_mla = a.in[15]; P.gkv_mla = a.in[17]; P.gq = a.in[19]; P.gk = a.in[20]; P.rope = rope;
          P.c_ckv = a.in[2]; P.c_kpe = a.in[3]; P.c_gk = a.in[4]; P.c_gv = a.in[5]; P.c_sk = a.in[6]; P.c_sv = a.in[7];
          P.o_ckv = out + 12582912; P.o_kpe = out + 14680064; P.o_gk = out + 15204352; P.o_gv = out + 17301504; P.o_sk = out + 19398656; P.o_sv = out + 21495808; P.l = l;
          p3_phase(P, lane, gw, NGW); }
        GSYNC(); }
        for (int rep = 0; rep < NREP(4); ++rep) {
        if (ON(4)) { PHASE_BEGIN LAYER_VALS pg8::Gemm g{A2, (const bf16*)(wl + W_B2), NKR, 1024, 384, 0, 0}; pg8::StaticOrder S; S.init(NKR, 1024, G, bid); pg8::EpiBf16 E{MQKV, 1024};
          pg8::gemm_phase<pg8::EpiBf16, pg8::StaticOrder, true, false>(ring, g, S, E, tid); }
        GSYNC(); }
        for (int rep = 0; rep < NREP(5); ++rep) {
        if (ON(5)) { PHASE_BEGIN AttnBufs B; B.MQKV = MQKV; B.KPE = KPE; B.Qc_rot = Qc_rot; B.Qc_raw = Qc_raw; B.Kc = Kc; B.Vc = Vc; B.Qd_rot = Qd_rot; B.Qd_raw = Qd_raw; B.Kd = Kd; B.Vd = Vd; B.YCAT = YCAT;
          B.sink = a.in[21] + l * 4; B.rope = rope; B.ctr = (unsigned*)(ws + WS_CTL) + 64 * l + 128 * rep;
          attn_phase(B, (LAS unsigned char*)lds, tid, lane, wave); }
        GSYNC(); }
        if (ON(6)) { PHASE_BEGIN LAYER_VALS pg8::Gemm g{YCAT, (const bf16*)(wl + W_OUT), NTOK, DM, DM, 0, 0}; pg8::StaticOrder S; S.init(NTOK, DM, G, bid);
          pg8::EpiResid E{x0, x1, XRES, modl + 2048, XN, (float*)(ws + WS_SS2), a.in[23] + l * DM, modl + 4096};
          pg8::gemm_phase<pg8::EpiResid, pg8::StaticOrder, true, true>(ring, g, S, E, tid);
          if (l == 0) { const int wk = G > 192 ? bid - 192 : bid, nwk = G > 192 ? G - 192 : G;
            if (wk >= 0) wconv(a, ws, 0, 4 | 8, wk * NW + wave, nwk * NW, (LAS float*)((LAS unsigned char*)lds + wave * 16640), lane); } }
        GSYNC();
        for (int rep = 0; rep < NREP(8); ++rep) {
        if (ON(8)) { PHASE_BEGIN LAYER_VALS pg8::Gemm g{XN, (const bf16*)(wl + W_UP), NTOK, DUP, DM, (size_t)128 * DM * 2, (size_t)DFF * DM * 2}; pg8::StaticOrder S; S.init(NTOK, DUP, G, bid);
          pg8::EpiUpGate E{ACT, (const float*)(ws + WS_SS2), (const float*)(ws + WS_BIAS) + (size_t)l * 3 * NBIAS + 2304, NBIAS, a.in[25] + (size_t)l * 3 * DUP, (float*)(ws + WS_HALO), ring + 131072};
          pg8::gemm_phase<pg8::EpiUpGate, pg8::StaticOrder, true, true>(ring, g, S, E, tid); }
        GSYNC(); }
        if (ON(10)) { PHASE_BEGIN LAYER_VALS pg8::Gemm g{ACT, (const bf16*)(wl + W_DOWN), NTOK, DM, DFF, 0, 0}; pg8::StaticOrder S; S.init(NTOK, DM, G, bid);
          {
            const float* cwl = a.in[25] + (size_t)l * 3 * DUP; const float* HALO = (const float*)(ws + WS_HALO); pg8::Unit hu;
            bool fixed = false;
            for (int ui = 0; S.next(ui, hu); ++ui) { if (hu.pm < 32) continue; fixed = true; const int k = hu.pm - 32, pos = k & 7;
                for (int idx = tid; idx < 2 * DFF; idx += NT) { const int which = idx >= DFF ? 1 : 0, j = idx - which * DFF;
                    if (which == 0 ? pos == 0 : pos == 7) continue;
                    const float* Pp = HALO + (size_t)(k * 4 + (which ? 3 : 1)) * DUP; const float* Ep = HALO + (size_t)((which ? k + 1 : k - 1) * 4 + (which ? 0 : 2)) * DUP; const float* wp = cwl + (which ? 2 : 0) * DUP;
                    const float ca = Pp[j] + wp[j] * Ep[j], cb = Pp[DFF + j] + wp[DFF + j] * Ep[DFF + j];
                    const float r = ca * __builtin_amdgcn_rcpf(1.f + __builtin_amdgcn_exp2f(-ca * LOG2E)) * cb;
                    ACT[(size_t)(hu.pm * 256 + (which ? 255 : 0)) * DFF + j] = (bf16)(pk2(r, r) & 0xffffu); } }
            if (fixed) { asm volatile("s_waitcnt vmcnt(0)" ::: "memory"); __syncthreads();
                if (tid == 0) { __builtin_amdgcn_fence(__ATOMIC_RELEASE, "agent"); __builtin_amdgcn_fence(__ATOMIC_ACQUIRE, "agent"); asm volatile("s_waitcnt vmcnt(0)" ::: "memory"); }
                __syncthreads(); } }
          if (l == 1 && G >= 192) {
            pg8::EpiResidFinal E{XRES, out, modl + 5120, (float*)(ws + WS_SS1), a.in[27], (unsigned*)(ws + WS_CTL) + 2048};
            pg8::gemm_phase<pg8::EpiResidFinal, pg8::StaticOrder, true, true>(ring, g, S, E, tid);
          } else {
          pg8::EpiResid E{nullptr, nullptr, XRES, modl + 5120, l == 0 ? XN : nullptr, (float*)(ws + WS_SS1), a.in[12] + DM, mod + (size_t)3 * 6144 + 1024};
          pg8::gemm_phase<pg8::EpiResid, pg8::StaticOrder, true, true>(ring, g, S, E, tid); }
          if (l == 0) { const int wk = G > 192 ? bid - 192 : bid, nwk = G > 192 ? G - 192 : G;
            if (wk >= 0) wconv(a, ws, 1, 63, wk * NW + wave, nwk * NW, (LAS float*)((LAS unsigned char*)lds + wave * 16640), lane); } }
        if (!(l == 1 && G >= 192)) GSYNC();
    }
#ifdef XSYNC
    for (int i = 0; i < XSYNC; ++i) GSYNC();
#endif
    if (G < 192) { PHASE_BEGIN
    const bf16* XRES = (const bf16*)(ws + WS_XRES);
    for (int row = gw; row < NTOK; row += NGW) {
        float* xr = out + (size_t)row * DM;
        f32x4 v[4]; float ss = 0.f;
#pragma unroll
        for (int j = 0; j < 4; ++j) { v[j] = ld4bf(XRES + (size_t)row * DM + 4 * (lane + 64 * j)); ss += dot4(v[j]); }
        const float rs = rsqrtf(wave_sum(ss, lane) * (1.f / DM) + EPS);
#pragma unroll
        for (int j = 0; j < 4; ++j) { const int col = 4 * (lane + 64 * j); *(f32x4*)(xr + col) = v[j] * rs * *(const f32x4*)(a.in[27] + col); }
    } }
}

extern "C" void kernel_launch(void* const* d_in, const int* in_sizes, int n_in, void* d_out, int out_size, void* d_ws, size_t ws_size, hipStream_t stream) {
    static int grid = 0;
    if (grid == 0) {
        if (n_in != 28 || ws_size < WS_END) { fprintf(stderr, "kernel_launch: unexpected n_in %d / ws %zu\n", n_in, ws_size); grid = -1; return; }
        int dev = 0, cus = 0, per_cu = 0;
        hipGetDevice(&dev); hipDeviceGetAttribute(&cus, hipDeviceAttributeMultiprocessorCount, dev);
        hipFuncSetAttribute((const void*)mega_fwd, hipFuncAttributeMaxDynamicSharedMemorySize, LDS_BYTES);
        hipOccupancyMaxActiveBlocksPerMultiprocessor(&per_cu, (const void*)mega_fwd, NT, LDS_BYTES);
        if (per_cu < 1) per_cu = 1;
        grid = cus * per_cu;
        (void)hipGetLastError();
    }
    if (grid < 0) return;
    if (hipMemsetAsync((char*)d_ws + WS_BAR, 0, XCD_BAR_WORDS * 4, stream) != hipSuccess) { fprintf(stderr, "kernel_launch: memset of the barrier words failed\n"); return; }
    Args a{};
    for (int i = 0; i < 28; ++i) a.in[i] = (const float*)d_in[i];
    a.out = (float*)d_out; a.ws = (unsigned char*)d_ws;
    void* args[] = {&a};
    hipError_t e = hipLaunchCooperativeKernel((const void*)mega_fwd, dim3(grid), dim3(NT), args, LDS_BYTES, stream);
    if (e != hipSuccess) fprintf(stderr, "cooperative launch failed: %s (grid %d)\n", hipGetErrorString(e), grid);
}
```

```cpp
#include <hip/hip_runtime.h>
#include <hip/hip_cooperative_groups.h>
#include <cstdio>
#include <cstdint>
namespace cg = cooperative_groups;

namespace pg8 {
#define PG8_LAS __attribute__((address_space(3)))
typedef unsigned short bf16_t;
typedef short bf16x8 __attribute__((ext_vector_type(8)));
typedef float f32x4 __attribute__((ext_vector_type(4)));
typedef unsigned u32x4 __attribute__((ext_vector_type(4)));
constexpr int BM = 256, BK = 64, HALF = 128, HTB = HALF * BK * 2, STAGE_BYTES = 8 * HTB, NXCD = 8, WGM = 4;

__host__ __device__ __forceinline__ int lds_byte(int r, int c) { const int st = (r >> 4) * 2 + (c >> 5), rr = r & 15, cc = c & 31, ob = rr * 64 + cc * 2; return st * 1024 + (ob ^ (((ob >> 9) & 1) << 5)); }
__host__ __device__ __forceinline__ void stage_rc(int b, int& R, int& C) { const int st = b / 1024, sb = b % 1024, swz = sb ^ (((sb >> 9) & 1) << 5); R = (st >> 1) * 16 + swz / 64; C = (st & 1) * 32 + (swz % 64) / 2; }
__host__ __device__ __forceinline__ int perm32(int rho) { const int n = rho >> 4, i = rho & 15; return 8 * (i >> 2) + 4 * n + (i & 3); }

struct Unit { int pm, pn; };
struct Gemm { const bf16_t* A; const bf16_t* Bt; int M, N, K; size_t bstep, bhalf; };

struct StaticOrder {
    int nM, nN, nwg, G, c;
    __host__ __device__ __forceinline__ void init(int M, int N, int G_, int c_) { nM = M / BM; nN = N / BM; nwg = nM * nN; G = G_; c = c_; }
    __host__ __device__ __forceinline__ bool next(int i, Unit& u) const {
        const long L = (long)i * G + c; if (L >= nwg) return false;
        int wgid = (int)L; { const int q = nwg / NXCD, r = nwg % NXCD, xcd = wgid % NXCD, off = wgid / NXCD; wgid = (xcd < r ? xcd * (q + 1) : r * (q + 1) + (xcd - r) * q) + off; }
        const int nig = WGM * nN, gid = wgid / nig, fm = gid * WGM, gsz = (nM - fm) < WGM ? (nM - fm) : WGM;
        u.pm = fm + ((wgid % nig) % gsz); u.pn = (wgid % nig) / gsz; return true;
    }
    __device__ __forceinline__ void a_ready(const Unit&) const {}
    __device__ __forceinline__ void done(const Unit&) const {}
};

__device__ __forceinline__ unsigned cvt_pk_bf16(float lo, float hi) { unsigned r; asm volatile("v_cvt_pk_bf16_f32 %0, %1, %2" : "=v"(r) : "v"(lo), "v"(hi)); return r; }

struct EpiBf16 {
    static constexpr bool PERM = true, AFTER_DRAIN = false;
    bf16_t* O; int ldc;
    __device__ __forceinline__ void operator()(const f32x4 (&acc)[2][2][4][2], const Unit& u, int wr, int wc, int fr, int fq) const {
        asm volatile("" : "+v"(fr), "+v"(fq));
        const int row0 = u.pm * BM + wr * 64 + fr; const int col0 = u.pn * BM + wc * 32 + 8 * fq;
#pragma unroll
        for (int ai = 0; ai < 2; ++ai)
#pragma unroll
            for (int m = 0; m < 4; ++m) { bf16_t* rowp = O + (size_t)(row0 + ai * HALF + m * 16) * ldc + col0;
#pragma unroll
                for (int bj = 0; bj < 2; ++bj) { const f32x4 v0 = acc[ai][bj][m][0], v1 = acc[ai][bj][m][1];
                    u32x4 w; w.x = cvt_pk_bf16(v0[0], v0[1]); w.y = cvt_pk_bf16(v0[2], v0[3]); w.z = cvt_pk_bf16(v1[0], v1[1]); w.w = cvt_pk_bf16(v1[2], v1[3]);
                    *(u32x4*)(rowp + bj * HALF) = w; } }
    }
};
__device__ __forceinline__ float shx_(float v, int m, int lane) { return __builtin_bit_cast(float, __builtin_amdgcn_ds_bpermute((lane ^ m) << 2, __builtin_bit_cast(int, v))); }
__device__ __forceinline__ void row_scales(const float* SS, int row0, int fr, int fq, float (&rs)[8]) {
    f32x4 t[8];
#pragma unroll
    for (int q = 0; q < 8; ++q) t[q] = *(const f32x4*)(SS + (size_t)(row0 + (q >> 2) * HALF + (q & 3) * 16) * 16 + 4 * fq);
    const int lane = fq * 16 + fr;
#pragma unroll
    for (int q = 0; q < 8; ++q) { float v = (t[q][0] + t[q][1]) + (t[q][2] + t[q][3]); v += shx_(v, 16, lane); v += shx_(v, 32, lane); rs[q] = __builtin_amdgcn_rsqf(v * (1.f / 1024.f) + 1e-6f); }
}
struct EpiBf16RS {
    static constexpr bool PERM = true, AFTER_DRAIN = false;
    bf16_t* O; int ldc; const float* SS; const float* bias; int ldb;
    __device__ __forceinline__ void operator()(const f32x4 (&acc)[2][2][4][2], const Unit& u, int wr, int wc, int fr, int fq) const {
        asm volatile("" : "+v"(fr), "+v"(fq));
        const int cnd = u.pm < 32 ? 0 : 1 + ((u.pm - 32) >> 3);
        const int row0 = u.pm * BM + wr * 64 + fr; const int col0 = u.pn * BM + wc * 32 + 8 * fq;
        const float* bp = bias + (size_t)cnd * ldb + col0;
        f32x4 bv[2][2];
#pragma unroll
        for (int bj = 0; bj < 2; ++bj)
#pragma unroll
            for (int n = 0; n < 2; ++n) bv[bj][n] = *(const f32x4*)(bp + bj * HALF + 4 * n);
        float rsv[8]; row_scales(SS, row0, fr, fq, rsv);
#pragma unroll
        for (int ai = 0; ai < 2; ++ai)
#pragma unroll
            for (int m = 0; m < 4; ++m) { const int row = row0 + ai * HALF + m * 16; const float rs = rsv[ai * 4 + m];
                bf16_t* rowp = O + (size_t)row * ldc + col0;
#pragma unroll
                for (int bj = 0; bj < 2; ++bj) { const f32x4 v0 = acc[ai][bj][m][0] * rs + bv[bj][0], v1 = acc[ai][bj][m][1] * rs + bv[bj][1];
                    u32x4 w; w.x = cvt_pk_bf16(v0[0], v0[1]); w.y = cvt_pk_bf16(v0[2], v0[3]); w.z = cvt_pk_bf16(v1[0], v1[1]); w.w = cvt_pk_bf16(v1[2], v1[3]);
                    *(u32x4*)(rowp + bj * HALF) = w; } }
    }
};
struct EpiResid {
    static constexpr bool PERM = false, AFTER_DRAIN = false;
    const float* r0; const float* r1; bf16_t* XR; const float* gate;
    bf16_t* XN; float* SS; const float* nrm; const float* sc;
    __device__ __forceinline__ void operator()(const f32x4 (&acc)[2][2][4][2], const Unit& u, int wr, int wc, int fr, int fq) const {
        asm volatile("" : "+v"(fr), "+v"(fq));
        typedef unsigned u32x2_ __attribute__((ext_vector_type(2)));
        const int cnd = u.pm < 32 ? 0 : 1 + ((u.pm - 32) >> 3);
        const float* gp = gate + cnd * 6144;
        const int col0 = u.pn * BM + wc * 32 + 4 * fq;
        const int rowb = u.pm * BM + wr * 64 + fr;
        const bool inf = r0 != nullptr;
        const float* rs = (u.pm < 32 ? r0 + (size_t)rowb * 1024 : r1 + (size_t)(rowb - 8192) * 1024) + col0;
        bf16_t* op = XR + (size_t)rowb * 1024 + col0;
#define LDX(off) (inf ? __builtin_nontemporal_load((const f32x4*)(rs + (off))) : ({ const u32x2_ t_ = *(const u32x2_*)(op + (off)); (f32x4){__builtin_bit_cast(float, t_.x << 16), __builtin_bit_cast(float, t_.x & 0xffff0000u), __builtin_bit_cast(float, t_.y << 16), __builtin_bit_cast(float, t_.y & 0xffff0000u)}; }))
        const bool prep = XN != nullptr;
        f32x4 gv[2][2], hv[2][2];
#pragma unroll
        for (int bj = 0; bj < 2; ++bj)
#pragma unroll
            for (int n = 0; n < 2; ++n) { gv[bj][n] = *(const f32x4*)(gp + col0 + bj * HALF + n * 16);
                hv[bj][n] = (f32x4){0.f, 0.f, 0.f, 0.f};
                if (prep) hv[bj][n] = *(const f32x4*)(nrm + col0 + bj * HALF + n * 16) * (1.f + *(const f32x4*)(sc + cnd * 6144 + col0 + bj * HALF + n * 16)); }
        f32x4 xc[2][2], xn[2][2];
#pragma unroll
        for (int bj = 0; bj < 2; ++bj)
#pragma unroll
            for (int n = 0; n < 2; ++n) xc[bj][n] = LDX(bj * HALF + n * 16);
#pragma unroll
        for (int it = 0; it < 8; ++it) { const int ai = it >> 2, m = it & 3; const size_t ro = (size_t)(ai * HALF + m * 16) * 1024;
            if (it < 7) { const int ai2 = (it + 1) >> 2, m2 = (it + 1) & 3; const size_t ro2 = (size_t)(ai2 * HALF + m2 * 16) * 1024;
#pragma unroll
                for (int bj = 0; bj < 2; ++bj)
#pragma unroll
                    for (int n = 0; n < 2; ++n) xn[bj][n] = LDX(ro2 + bj * HALF + n * 16); }
            float ssq = 0.f;
#pragma unroll
            for (int bj = 0; bj < 2; ++bj)
#pragma unroll
                for (int n = 0; n < 2; ++n) { const f32x4 v = xc[bj][n] + gv[bj][n] * acc[ai][bj][m][n];
                    *(u32x2_*)(op + ro + bj * HALF + n * 16) = (u32x2_){cvt_pk_bf16(v[0], v[1]), cvt_pk_bf16(v[2], v[3])};
                    if (prep) { ssq += (v[0] * v[0] + v[1] * v[1]) + (v[2] * v[2] + v[3] * v[3]); const f32x4 h = v * hv[bj][n];
                        unsigned w0 = cvt_pk_bf16(h[0], h[1]), w1 = cvt_pk_bf16(h[2], h[3]);
                        *(u32x2_*)(XN + (size_t)(rowb + ai * HALF + m * 16) * 1024 + col0 + bj * HALF + n * 16) = (u32x2_){w0, w1}; } }
            if (prep) { const int lane = fq * 16 + fr; ssq += shx_(ssq, 16, lane); ssq += shx_(ssq, 32, lane);
                if (fq == 0) SS[(size_t)(rowb + ai * HALF + m * 16) * 16 + u.pn * 4 + wc] = ssq; }
#pragma unroll
            for (int bj = 0; bj < 2; ++bj)
#pragma unroll
                for (int n = 0; n < 2; ++n) xc[bj][n] = xn[bj][n];
        }
    }
#undef LDX
};

struct EpiResidFinal {
    static constexpr bool PERM = false, AFTER_DRAIN = false;
    const bf16_t* res; float* out; const float* gate; float* SS; const float* fw; unsigned* cnt;
    __device__ __forceinline__ void operator()(f32x4 (&acc)[2][2][4][2], const Unit& u, int wr, int wc, int fr, int fq) const {
        asm volatile("" : "+v"(fr), "+v"(fq));
        const int cnd = u.pm < 32 ? 0 : 1 + ((u.pm - 32) >> 3);
        const float* gp = gate + cnd * 6144;
        const int col0 = u.pn * BM + wc * 32 + 4 * fq;
        const int rowb = u.pm * BM + wr * 64 + fr;
        typedef unsigned u32x2_ __attribute__((ext_vector_type(2)));
        const bf16_t* rs = res + (size_t)rowb * 1024 + col0;
#define LDXF(off) ({ const u32x2_ t_ = *(const u32x2_*)(rs + (off)); (f32x4){__builtin_bit_cast(float, t_.x << 16), __builtin_bit_cast(float, t_.x & 0xffff0000u), __builtin_bit_cast(float, t_.y << 16), __builtin_bit_cast(float, t_.y & 0xffff0000u)}; })
        f32x4 gv[2][2];
#pragma unroll
        for (int bj = 0; bj < 2; ++bj)
#pragma unroll
            for (int n = 0; n < 2; ++n) gv[bj][n] = *(const f32x4*)(gp + col0 + bj * HALF + n * 16);
        f32x4 xc[2][2], xn[2][2];
#pragma unroll
        for (int bj = 0; bj < 2; ++bj)
#pragma unroll
            for (int n = 0; n < 2; ++n) xc[bj][n] = LDXF(bj * HALF + n * 16);
#pragma unroll
        for (int it = 0; it < 8; ++it) { const int ai = it >> 2, m = it & 3;
            if (it < 7) { const int ai2 = (it + 1) >> 2, m2 = (it + 1) & 3; const size_t ro2 = (size_t)(ai2 * HALF + m2 * 16) * 1024;
#pragma unroll
                for (int bj = 0; bj < 2; ++bj)
#pragma unroll
                    for (int n = 0; n < 2; ++n) xn[bj][n] = LDXF(ro2 + bj * HALF + n * 16); }
            float ssq = 0.f;
#pragma unroll
            for (int bj = 0; bj < 2; ++bj)
#pragma unroll
                for (int n = 0; n < 2; ++n) { const f32x4 v = xc[bj][n] + gv[bj][n] * acc[ai][bj][m][n]; acc[ai][bj][m][n] = v;
                    ssq += (v[0] * v[0] + v[1] * v[1]) + (v[2] * v[2] + v[3] * v[3]); }
            { const int lane = fq * 16 + fr; ssq += shx_(ssq, 16, lane); ssq += shx_(ssq, 32, lane);
              if (fq == 0) __hip_atomic_store(SS + (size_t)(rowb + ai * HALF + m * 16) * 16 + u.pn * 4 + wc, ssq, __ATOMIC_RELAXED, __HIP_MEMORY_SCOPE_AGENT); }
#pragma unroll
            for (int bj = 0; bj < 2; ++bj)
#pragma unroll
                for (int n = 0; n < 2; ++n) xc[bj][n] = xn[bj][n];
        }
        asm volatile("s_waitcnt vmcnt(0)" ::: "memory"); __builtin_amdgcn_s_barrier(); asm volatile("" ::: "memory");
        if (wr == 0 && wc == 0 && fr == 0 && fq == 0) {
            __builtin_amdgcn_fence(__ATOMIC_RELEASE, "agent"); asm volatile("s_waitcnt vmcnt(0)" ::: "memory");
            __hip_atomic_fetch_add(cnt + u.pm, 1u, __ATOMIC_RELAXED, __HIP_MEMORY_SCOPE_AGENT);
            unsigned sp = 0;
            while (__hip_atomic_load(cnt + u.pm, __ATOMIC_RELAXED, __HIP_MEMORY_SCOPE_AGENT) < 4u) { __builtin_amdgcn_s_sleep(1); if (++sp > (1u << 22)) break; }
            __builtin_amdgcn_fence(__ATOMIC_ACQUIRE, "agent"); asm volatile("s_waitcnt vmcnt(0)" ::: "memory");
        }
        __builtin_amdgcn_s_barrier(); asm volatile("" ::: "memory");
        float rsv[8];
        { f32x4 t[8];
#pragma unroll
          for (int q = 0; q < 8; ++q) { const float* sp = SS + (size_t)(rowb + (q >> 2) * HALF + (q & 3) * 16) * 16 + 4 * fq;
              t[q] = (f32x4){__hip_atomic_load(sp, __ATOMIC_RELAXED, __HIP_MEMORY_SCOPE_AGENT), __hip_atomic_load(sp + 1, __ATOMIC_RELAXED, __HIP_MEMORY_SCOPE_AGENT),
                             __hip_atomic_load(sp + 2, __ATOMIC_RELAXED, __HIP_MEMORY_SCOPE_AGENT), __hip_atomic_load(sp + 3, __ATOMIC_RELAXED, __HIP_MEMORY_SCOPE_AGENT)}; }
          const int lane = fq * 16 + fr;
#pragma unroll
          for (int q = 0; q < 8; ++q) { float v = (t[q][0] + t[q][1]) + (t[q][2] + t[q][3]); v += shx_(v, 16, lane); v += shx_(v, 32, lane); rsv[q] = __builtin_amdgcn_rsqf(v * (1.f / 1024.f) + 1e-6f); } }
        f32x4 wv[2][2];
#pragma unroll
        for (int bj = 0; bj < 2; ++bj)
#pragma unroll
            for (int n = 0; n < 2; ++n) wv[bj][n] = *(const f32x4*)(fw + col0 + bj * HALF + n * 16);
        float* op = out + (size_t)rowb * 1024 + col0;
#pragma unroll
        for (int it = 0; it < 8; ++it) { const int ai = it >> 2, m = it & 3; const size_t ro = (size_t)(ai * HALF + m * 16) * 1024;
#pragma unroll
            for (int bj = 0; bj < 2; ++bj)
#pragma unroll
                for (int n = 0; n < 2; ++n) __builtin_nontemporal_store(acc[ai][bj][m][n] * rsv[it] * wv[bj][n], (f32x4*)(op + ro + bj * HALF + n * 16)); }
    }
};

__device__ __forceinline__ float dpp_ror1(float v) { return __builtin_bit_cast(float, __builtin_amdgcn_mov_dpp(__builtin_bit_cast(int, v), 0x121, 0xf, 0xf, false)); }
__device__ __forceinline__ float dpp_ror15(float v) { return __builtin_bit_cast(float, __builtin_amdgcn_mov_dpp(__builtin_bit_cast(int, v), 0x12f, 0xf, 0xf, false)); }
struct EpiUpGate {
    static constexpr bool PERM = true, AFTER_DRAIN = false;
    bf16_t* ACT; const float* SS; const float* bias; int ldb; const float* cw; float* HALO; PG8_LAS unsigned char* xb;
    __device__ __forceinline__ void operator()(f32x4 (&acc)[2][2][4][2], const Unit& u, int wr, int wc, int fr, int fq) const {
        asm volatile("" : "+v"(fr), "+v"(fq));
        const int cnd = u.pm < 32 ? 0 : 1 + ((u.pm - 32) >> 3);
        const bool samp = u.pm >= 32;
        const int j0 = u.pn * HALF + wc * 32 + 8 * fq;
        const int row0 = u.pm * BM + wr * 64 + fr;
        { const float* bp = bias + (size_t)cnd * ldb + j0;
          f32x4 bv[2][2];
#pragma unroll
          for (int bj = 0; bj < 2; ++bj)
#pragma unroll
              for (int n = 0; n < 2; ++n) bv[bj][n] = *(const f32x4*)(bp + bj * 2816 + 4 * n);
          float rsv[8]; row_scales(SS, row0, fr, fq, rsv);
#pragma unroll
          for (int ai = 0; ai < 2; ++ai)
#pragma unroll
              for (int m = 0; m < 4; ++m) { const float rs = rsv[ai * 4 + m];
#pragma unroll
                  for (int bj = 0; bj < 2; ++bj)
#pragma unroll
                      for (int n = 0; n < 2; ++n) acc[ai][bj][m][n] = acc[ai][bj][m][n] * rs + bv[bj][n]; } }
        PG8_LAS f32x4* WL = (PG8_LAS f32x4*)(xb + 8192);
        if (fr == 0) {
            f32x4 wt[2][2][3];
#pragma unroll
            for (int n = 0; n < 2; ++n)
#pragma unroll
                for (int bj = 0; bj < 2; ++bj)
#pragma unroll
                    for (int k = 0; k < 3; ++k) wt[n][bj][k] = *(const f32x4*)(cw + k * 5632 + bj * 2816 + j0 + 4 * n);
#pragma unroll
            for (int n = 0; n < 2; ++n)
#pragma unroll
                for (int bj = 0; bj < 2; ++bj)
#pragma unroll
                    for (int k = 0; k < 3; ++k) WL[((((wr * 4 + wc) * 4 + fq) * 2 + n) * 2 + bj) * 3 + k] = wt[n][bj][k];
        }
        PG8_LAS f32x4* XB = (PG8_LAS f32x4*)xb;
        const int wv = wr * 4 + wc, pw = (wr ^ 1) * 4 + wc;
        if (fr == 0) {
#pragma unroll
            for (int ai = 0; ai < 2; ++ai)
#pragma unroll
                for (int bj = 0; bj < 2; ++bj)
#pragma unroll
                    for (int n = 0; n < 2; ++n) XB[((wv * 4 + ai * 2) * 2 + bj) * 8 + 2 * fq + n] = acc[ai][bj][0][n]; }
        if (fr == 15) {
#pragma unroll
            for (int ai = 0; ai < 2; ++ai)
#pragma unroll
                for (int bj = 0; bj < 2; ++bj)
#pragma unroll
                    for (int n = 0; n < 2; ++n) XB[((wv * 4 + ai * 2 + 1) * 2 + bj) * 8 + 2 * fq + n] = acc[ai][bj][3][n]; }
        asm volatile("s_waitcnt lgkmcnt(0)" ::: "memory"); __builtin_amdgcn_s_barrier(); asm volatile("" ::: "memory");
        float* hb = HALO + (size_t)(samp ? u.pm - 32 : 0) * 4 * 5632;
#pragma unroll
        for (int ai = 0; ai < 2; ++ai) {
            const bool has_ab = !(wr == 0 && ai == 0), has_bl = !(wr == 1 && ai == 1);
            const int wab = (wr == 0) ? 1 : (ai == 0 ? 1 : 3), wbl = (wr == 0) ? (ai == 0 ? 0 : 2) : 2;
            unsigned pk[4][4];
#pragma unroll
            for (int n = 0; n < 2; ++n) {
                f32x4 ca[4];
#pragma unroll
                for (int bj = 0; bj < 2; ++bj) {
                    const PG8_LAS f32x4* wlp = WL + ((((wr * 4 + wc) * 4 + fq) * 2 + n) * 2 + bj) * 3;
                    const f32x4 w0 = wlp[0], w1 = wlp[1], w2 = wlp[2];
                    f32x4 ab = (f32x4){0.f, 0.f, 0.f, 0.f}, bl = ab;
                    if (has_ab) ab = XB[((pw * 4 + wab) * 2 + bj) * 8 + 2 * fq + n];
                    if (has_bl) bl = XB[((pw * 4 + wbl) * 2 + bj) * 8 + 2 * fq + n];
#pragma unroll
                    for (int m = 0; m < 4; ++m) {
                        f32x4 cvm;
#pragma unroll
                        for (int i = 0; i < 4; ++i) {
                            const float cur = acc[ai][bj][m][n][i];
                            const float pv = m == 0 ? ab[i] : acc[ai][bj][m == 0 ? 0 : m - 1][n][i];
                            const float nx = m == 3 ? bl[i] : acc[ai][bj][m == 3 ? 3 : m + 1][n][i];
                            const float up = dpp_ror1(fr == 15 ? pv : cur), dn = dpp_ror15(fr == 0 ? nx : cur);
                            cvm[i] = w0[i] * up + w1[i] * cur + w2[i] * dn;
                        }
                        if (samp) {
                            if (m == 0 && wr == 0 && ai == 0 && fr == 0) { *(f32x4*)(hb + 0 * 5632 + bj * 2816 + j0 + 4 * n) = acc[ai][bj][0][n]; *(f32x4*)(hb + 1 * 5632 + bj * 2816 + j0 + 4 * n) = cvm; }
                            if (m == 3 && wr == 1 && ai == 1 && fr == 15) { *(f32x4*)(hb + 2 * 5632 + bj * 2816 + j0 + 4 * n) = acc[ai][bj][3][n]; *(f32x4*)(hb + 3 * 5632 + bj * 2816 + j0 + 4 * n) = cvm; }
                        }
                        if (bj == 0) ca[m] = cvm;
                        else { float r[4];
#pragma unroll
                            for (int i = 0; i < 4; ++i) { const float xa = ca[m][i]; r[i] = xa * __builtin_amdgcn_rcpf(1.f + __builtin_amdgcn_exp2f(-xa * 1.4426950408889634f)) * cvm[i]; }
                            pk[m][2 * n] = cvt_pk_bf16(r[0], r[1]); pk[m][2 * n + 1] = cvt_pk_bf16(r[2], r[3]); }
                    }
                }
                __builtin_amdgcn_sched_barrier(0);
            }
#pragma unroll
            for (int m = 0; m < 4; ++m) *(u32x4*)(ACT + (size_t)(row0 + ai * HALF + m * 16) * 2816 + j0) = (u32x4){pk[m][0], pk[m][1], pk[m][2], pk[m][3]};
        }
    }
};

template <class Epi, class Sched, bool ALIGN_EPI = false, bool SP2 = false>
__device__ __forceinline__ void gemm_phase(PG8_LAS unsigned char* lds, const Gemm g, const Sched& S, const Epi& E, const int tid) {
    const int wid = __builtin_amdgcn_readfirstlane(tid >> 6), lane = tid & 63, wr = wid >> 2, wc = wid & 3, fr = lane & 15, fq = lane >> 4;
    const int K = g.K, nt = K / BK;
    unsigned voffA[2], voffB[2];
#pragma unroll
    for (int i = 0; i < 2; ++i) { int R, C; stage_rc(tid * 16 + i * 8192, R, C); const int Rb = Epi::PERM ? ((R & ~31) + perm32(R & 31)) : R;
        voffA[i] = (unsigned)(R * K + C) * 2u; voffB[i] = (unsigned)(Rb * K + C) * 2u; }
    const size_t kstep = (size_t)(BK * 2);
    const size_t hstep = (size_t)HALF * K * 2;
    const size_t tstep = 2 * hstep;
    const size_t bstep = g.bstep ? g.bstep : tstep, bh = g.bhalf ? g.bhalf : hstep;
    const unsigned ldsw = (unsigned)wid * 1024u;
    const int aoff = lds_byte(wr * 64 + fr, fq * 8), boff = lds_byte(wc * 32 + fr, fq * 8);
#define PG8_SA(b, h) (((b) * 2 + (h)) * HTB)
#define PG8_SB(b, h) ((4 + (b) * 2 + (h)) * HTB)
#define PG8_STAGE(bufoff, gbase, voff) do { _Pragma("unroll") for (int _i = 0; _i < 2; ++_i) \
        __builtin_amdgcn_global_load_lds((const unsigned*)((const char*)(gbase) + (voff)[_i]), (PG8_LAS unsigned*)(lds + (bufoff) + ldsw + _i * 8192), 16, 0, 0); } while (0)
#define PG8_LDA(dst, b, h) do { _Pragma("unroll") for (int m = 0; m < 4; ++m) _Pragma("unroll") for (int k = 0; k < 2; ++k) dst[m][k] = *(const PG8_LAS bf16x8*)(lds + PG8_SA(b, h) + aoff + m * 2048 + k * 1024); } while (0)
#define PG8_LDB(dst, b, h) do { _Pragma("unroll") for (int n = 0; n < 2; ++n) _Pragma("unroll") for (int k = 0; k < 2; ++k) dst[n][k] = *(const PG8_LAS bf16x8*)(lds + PG8_SB(b, h) + boff + n * 2048 + k * 1024); } while (0)
#define PG8_MMA(ai, bj, At, Bt) do { __builtin_amdgcn_s_setprio(1); _Pragma("unroll") for (int m = 0; m < 4; ++m) _Pragma("unroll") for (int n = 0; n < 2; ++n) _Pragma("unroll") for (int k = 0; k < 2; ++k) \
        acc[ai][bj][m][n] = __builtin_amdgcn_mfma_f32_16x16x32_bf16(Bt[n][k], At[m][k], acc[ai][bj][m][n], 0, 0, 0); __builtin_amdgcn_s_setprio(0); } while (0)
#define PG8_WAIT_V(n) asm volatile("s_waitcnt vmcnt(" #n ")" ::: "memory")
#define PG8_WAIT_L(n) asm volatile("s_waitcnt lgkmcnt(" #n ")" ::: "memory")
#define PG8_BAR __builtin_amdgcn_s_barrier()
#define PG8_SCHED __builtin_amdgcn_sched_barrier(0)
    Unit cur, nxt; int ui = 0;
    if (!S.next(0, cur)) return;
    f32x4 acc[2][2][4][2];
#pragma unroll
    for (int a = 0; a < 2; ++a)
#pragma unroll
        for (int b = 0; b < 2; ++b)
#pragma unroll
            for (int m = 0; m < 4; ++m)
#pragma unroll
                for (int n = 0; n < 2; ++n) acc[a][b][m][n] = (f32x4){0.f, 0.f, 0.f, 0.f};
    bf16x8 At[4][2], B0[2][2], B1[2][2];
    const char* cA = (const char*)g.A + (size_t)cur.pm * tstep; const char* cB = (const char*)g.Bt + (size_t)cur.pn * bstep;
    S.a_ready(cur);
    if constexpr (SP2) {
        PG8_STAGE(PG8_SB(0, 0), cB, voffB); PG8_STAGE(PG8_SB(0, 1), cB + bh, voffB); PG8_STAGE(PG8_SA(0, 0), cA, voffA); PG8_STAGE(PG8_SA(0, 1), cA + hstep, voffA);
        if (wr == 1) PG8_BAR;
        PG8_WAIT_V(2); PG8_BAR;
        PG8_STAGE(PG8_SB(1, 0), cB + kstep, voffB); PG8_STAGE(PG8_SA(1, 0), cA + kstep, voffA); PG8_STAGE(PG8_SB(1, 1), cB + bh + kstep, voffB);
        PG8_WAIT_V(6); PG8_BAR;
    } else {
        PG8_STAGE(PG8_SB(0, 0), cB, voffB); PG8_STAGE(PG8_SA(0, 0), cA, voffA); PG8_STAGE(PG8_SB(0, 1), cB + bh, voffB); PG8_STAGE(PG8_SA(0, 1), cA + hstep, voffA);
        if (wr == 1) PG8_BAR;
        PG8_WAIT_V(4); PG8_BAR;
        PG8_STAGE(PG8_SB(1, 0), cB + kstep, voffB); PG8_STAGE(PG8_SA(1, 0), cA + kstep, voffA); PG8_STAGE(PG8_SB(1, 1), cB + bh + kstep, voffB);
        PG8_WAIT_V(6); PG8_BAR;
    }
    for (;;) {
        const bool has_next = S.next(ui + 1, nxt);
        const char* nA = has_next ? (const char*)g.A + (size_t)nxt.pm * tstep : cA; const char* nB = has_next ? (const char*)g.Bt + (size_t)nxt.pn * bstep : cB;
        for (int t = 0; t < nt; t += 2) {
            const bool last = (t == nt - 2);
            const char* a1 = cA + (size_t)(t + 1) * kstep;
            const char* a2 = last ? nA : cA + (size_t)(t + 2) * kstep; const char* b2 = last ? nB : cB + (size_t)(t + 2) * kstep;
            const char* a3 = a2 + kstep; const char* b3 = b2 + kstep;
            if (last && has_next) S.a_ready(nxt);
            if constexpr (SP2) {
            PG8_LDB(B0, 0, 0); PG8_LDB(B1, 0, 1); PG8_SCHED; PG8_LDA(At, 0, 0); PG8_STAGE(PG8_SA(1, 1), a1 + hstep, voffA);
            PG8_WAIT_V(8); PG8_WAIT_L(0); PG8_BAR; PG8_MMA(0, 0, At, B0); PG8_MMA(0, 1, At, B1); PG8_BAR; PG8_SCHED;
            PG8_LDA(At, 0, 1); PG8_STAGE(PG8_SB(0, 0), b2, voffB); PG8_STAGE(PG8_SB(0, 1), b2 + bh, voffB); PG8_STAGE(PG8_SA(0, 0), a2, voffA);
            PG8_WAIT_V(8); PG8_WAIT_L(0); PG8_BAR; PG8_MMA(1, 0, At, B0); PG8_MMA(1, 1, At, B1); PG8_BAR; PG8_SCHED;
            PG8_LDB(B0, 1, 0); PG8_LDB(B1, 1, 1); PG8_SCHED; PG8_LDA(At, 1, 0); PG8_STAGE(PG8_SA(0, 1), a2 + hstep, voffA);
            PG8_WAIT_V(8); PG8_WAIT_L(0); PG8_BAR; PG8_MMA(0, 0, At, B0); PG8_MMA(0, 1, At, B1); PG8_BAR; PG8_SCHED;
            PG8_LDA(At, 1, 1); PG8_STAGE(PG8_SB(1, 0), b3, voffB); PG8_STAGE(PG8_SB(1, 1), b3 + bh, voffB); PG8_STAGE(PG8_SA(1, 0), a3, voffA);
            PG8_WAIT_V(8); PG8_WAIT_L(0); PG8_BAR; PG8_MMA(1, 0, At, B0); PG8_MMA(1, 1, At, B1); PG8_BAR; PG8_SCHED;
            } else {
            PG8_LDB(B0, 0, 0); PG8_SCHED; PG8_LDA(At, 0, 0); PG8_STAGE(PG8_SA(1, 1), a1 + hstep, voffA);
            PG8_WAIT_L(8); PG8_BAR; PG8_WAIT_L(0); PG8_MMA(0, 0, At, B0); PG8_BAR; PG8_SCHED;
            PG8_LDB(B1, 0, 1); PG8_STAGE(PG8_SB(0, 0), b2, voffB);
            PG8_BAR; PG8_WAIT_L(0); PG8_MMA(0, 1, At, B1); PG8_BAR;
            PG8_LDA(At, 0, 1); PG8_STAGE(PG8_SA(0, 0), a2, voffA);
            PG8_BAR; PG8_WAIT_L(0); PG8_MMA(1, 0, At, B0); PG8_BAR; PG8_SCHED;
            PG8_STAGE(PG8_SB(0, 1), b2 + bh, voffB);
            PG8_WAIT_V(6); PG8_BAR; PG8_MMA(1, 1, At, B1); PG8_BAR;
            PG8_LDB(B0, 1, 0); PG8_SCHED; PG8_LDA(At, 1, 0); PG8_STAGE(PG8_SA(0, 1), a2 + hstep, voffA);
            PG8_WAIT_L(8); PG8_BAR; PG8_WAIT_L(0); PG8_MMA(0, 0, At, B0); PG8_BAR; PG8_SCHED;
            PG8_LDB(B1, 1, 1); PG8_STAGE(PG8_SB(1, 0), b3, voffB);
            PG8_BAR; PG8_WAIT_L(0); PG8_MMA(0, 1, At, B1); PG8_BAR;
            PG8_LDA(At, 1, 1); PG8_STAGE(PG8_SA(1, 0), a3, voffA);
            PG8_BAR; PG8_WAIT_L(0); PG8_MMA(1, 0, At, B0); PG8_BAR; PG8_SCHED;
            PG8_STAGE(PG8_SB(1, 1), b3 + bh, voffB);
            PG8_WAIT_V(6); PG8_BAR; PG8_MMA(1, 1, At, B1); PG8_BAR;
            }
        }
        if constexpr (ALIGN_EPI) { if (wr == 0) PG8_BAR; }
        if constexpr (!Epi::AFTER_DRAIN) { E(acc, cur, wr, wc, fr, fq); S.done(cur); }
        if (!has_next) break;
#pragma unroll
        for (int a = 0; a < 2; ++a)
#pragma unroll
            for (int b = 0; b < 2; ++b)
#pragma unroll
                for (int m = 0; m < 4; ++m)
#pragma unroll
                    for (int n = 0; n < 2; ++n) acc[a][b][m][n] = (f32x4){0.f, 0.f, 0.f, 0.f};
        cur = nxt; cA = nA; cB = nB; ++ui;
        if constexpr (ALIGN_EPI) { if (wr == 1) PG8_BAR; }
    }
    PG8_WAIT_V(0);
    if constexpr (!ALIGN_EPI) { if (wr == 0) PG8_BAR; }
    PG8_BAR;
#undef PG8_SA
#undef PG8_SB
#undef PG8_STAGE
#undef PG8_LDA
#undef PG8_LDB
#undef PG8_MMA
#undef PG8_WAIT_V
#undef PG8_WAIT_L
#undef PG8_BAR
#undef PG8_SCHED
}
}

#define LAS __attribute__((address_space(3)))
#define CAS __attribute__((address_space(4)))
typedef unsigned short bf16;
typedef float f32x4 __attribute__((ext_vector_type(4)));
typedef short bf16x8 __attribute__((ext_vector_type(8)));
typedef unsigned u32x4 __attribute__((ext_vector_type(4)));
typedef unsigned u32x2 __attribute__((ext_vector_type(2)));

constexpr int NW = 8, NT = 512;
constexpr int DM = 1024, NTOK = 12288, NPR = 8192, NKR = 13312, INC = 2144, INP = 2304, DFF = 2816, DUP = 5632;
constexpr float EPS = 1e-6f, LOG2E = 1.4426950408889634f;
constexpr float QS = 0.125f * LOG2E;
constexpr float MLAQS = 0.10206207261596575f * LOG2E;

constexpr size_t MiB = 1u << 20;
constexpr size_t WS_CTL = 0, WS_MOD = 1 * MiB, WS_ROPE = 1 * MiB + 256 * 1024, WS_W = 2 * MiB, W_LSTRIDE = 24 * MiB;
constexpr size_t W_IN = 0, W_OUT = 4718592, W_UP = W_OUT + 2097152, W_DOWN = W_UP + 11534336, W_B2 = W_DOWN + 5767168;
static_assert(W_B2 + 786432 <= W_LSTRIDE, "weights");
constexpr size_t WS_XN = 50 * MiB, WS_PROJ = 74 * MiB, WS_A2 = 128 * MiB, WS_MQKV = 138 * MiB, WS_QC = 164 * MiB, WS_KPE = 203 * MiB, WS_YCAT = 204 * MiB;
constexpr size_t WS_ACT = 116 * MiB, WS_U = 116 * MiB, WS_SS1 = 228 * MiB, WS_SS2 = 229 * MiB, WS_HALO = 230 * MiB, WS_XRES = 232 * MiB, WS_END = 256 * MiB;
constexpr size_t WS_BIAS = 65536;
constexpr int NBIAS = 2304 + 5632;
constexpr size_t QSZ = (size_t)NKR * 256 * 2, KSZ = (size_t)NKR * 128 * 2;
constexpr int LDS_BYTES = 163840, LDS_CTL = 163840 - 256;
constexpr size_t WS_BAR = 16384;

struct Args { const float* in[28]; float* out; unsigned char* ws; };

__device__ __forceinline__ unsigned f2bf(float f) { unsigned u = __builtin_bit_cast(unsigned, f); return (u + 0x7fffu + ((u >> 16) & 1u)) >> 16; }
__device__ __forceinline__ unsigned pk2(float lo, float hi) { unsigned r; asm("v_cvt_pk_bf16_f32 %0, %1, %2" : "=v"(r) : "v"(lo), "v"(hi)); return r; }
__device__ __forceinline__ float bflo(unsigned u) { return __builtin_bit_cast(float, u << 16); }
__device__ __forceinline__ float bfhi(unsigned u) { return __builtin_bit_cast(float, u & 0xffff0000u); }
__device__ __forceinline__ f32x4 ld4bf(const bf16* p) { const u32x2 u = *(const u32x2*)p; return (f32x4){bflo(u.x), bfhi(u.x), bflo(u.y), bfhi(u.y)}; }
__device__ __forceinline__ void st4bf(bf16* p, f32x4 v) { u32x2 u; u.x = pk2(v[0], v[1]); u.y = pk2(v[2], v[3]); *(u32x2*)p = u; }
__device__ __forceinline__ float shx(float v, int m, int lane) { return __builtin_bit_cast(float, __builtin_amdgcn_ds_bpermute((lane ^ m) << 2, __builtin_bit_cast(int, v))); }
#define DPPF(v, ctrl) __builtin_bit_cast(float, __builtin_amdgcn_mov_dpp(__builtin_bit_cast(int, (v)), (ctrl), 0xf, 0xf, false))
__device__ __forceinline__ float sum16(float v, int) { v += DPPF(v, 0x121); v += DPPF(v, 0x122); v += DPPF(v, 0x124); v += DPPF(v, 0x128); return v; }
__device__ __forceinline__ float wave_sum(float v, int lane) {
    v = sum16(v, lane);
    const int iv = __builtin_bit_cast(int, v);
    const float a = __builtin_bit_cast(float, __builtin_amdgcn_readlane(iv, 0)), b = __builtin_bit_cast(float, __builtin_amdgcn_readlane(iv, 16)),
                c = __builtin_bit_cast(float, __builtin_amdgcn_readlane(iv, 32)), d = __builtin_bit_cast(float, __builtin_amdgcn_readlane(iv, 48));
    return (a + b) + (c + d);
}
__device__ __forceinline__ float dot4(f32x4 a) { return (a[0] * a[0] + a[1] * a[1]) + (a[2] * a[2] + a[3] * a[3]); }
__device__ __forceinline__ f32x4 shfl4(f32x4 v, int m, int lane) { return (f32x4){shx(v[0], m, lane), shx(v[1], m, lane), shx(v[2], m, lane), shx(v[3], m, lane)}; }

__device__ __forceinline__ void transpose_item(const float* W, int N, bf16* WT, int ldk, int row_off, int k_off, float scale, LAS float* scr, int item, int lane) {
    const int nblk = (N + 63) / 64, kb = item / nblk, nb = item % nblk, k0 = 64 * kb, n0 = 64 * nb;
    const bool act = n0 + lane < N;
    const float* wp = W + (size_t)k0 * N + n0 + lane;
    float v[64];
#pragma unroll
    for (int i = 0; i < 64; ++i) v[i] = act ? __builtin_nontemporal_load(wp + (size_t)i * N) : 0.f;
#pragma unroll
    for (int i = 0; i < 64; ++i) scr[i * 65 + lane] = v[i] * scale;
    asm volatile("s_waitcnt lgkmcnt(0)" ::: "memory");
    const int c = lane & 7;
#pragma unroll
    for (int j = 0; j < 8; ++j) { const int n = (lane >> 3) + 8 * j; const LAS float* s = scr + (8 * c) * 65 + n;
        u32x4 o; o.x = pk2(s[0 * 65], s[1 * 65]); o.y = pk2(s[2 * 65], s[3 * 65]); o.z = pk2(s[4 * 65], s[5 * 65]); o.w = pk2(s[6 * 65], s[7 * 65]);
        if (n0 + n < N) *(u32x4*)(WT + (size_t)(row_off + n0 + n) * ldk + k_off + k0 + 8 * c) = o; }
    asm volatile("s_waitcnt lgkmcnt(0)" ::: "memory");
}

template <class ArgsRef>
__device__ __forceinline__ void wconv(const ArgsRef& a, unsigned char* ws, int l, int sel, int w, int nwk, LAS float* scr, int lane) {
    constexpr int I_IN = 16 * 34, I_OUT = 16 * 16, I_UP = 16 * 88, I_DN = 44 * 16, I_Q = 3 * 6, I_KV = 2 * 8;
    const int n_in = (sel & 1) ? I_IN : 0, n_out = (sel & 2) ? I_OUT : 0, n_up = (sel & 4) ? I_UP : 0, n_dn = (sel & 8) ? I_DN : 0, n_q = (sel & 16) ? I_Q : 0, n_kv = (sel & 32) ? I_KV : 0;
    const int total = n_in + n_out + n_up + n_dn + n_q + n_kv;
    unsigned char* wl = ws + WS_W + l * W_LSTRIDE;
    for (int it = w; it < total; it += nwk) {
        int r = it;
        if (r < n_in) { transpose_item(a.in[13] + (size_t)l * 1024 * INC, INC, (bf16*)(wl + W_IN), 1024, 0, 0, 1.f, scr, r, lane); continue; } r -= n_in;
        if (r < n_out) { transpose_item(a.in[22] + (size_t)l * 1024 * 1024, 1024, (bf16*)(wl + W_OUT), 1024, 0, 0, 1.f, scr, r, lane); continue; } r -= n_out;
        if (r < n_up) { transpose_item(a.in[24] + (size_t)l * 1024 * DUP, DUP, (bf16*)(wl + W_UP), 1024, 0, 0, 1.f, scr, r, lane); continue; } r -= n_up;
        if (r < n_dn) { transpose_item(a.in[26] + (size_t)l * DFF * 1024, 1024, (bf16*)(wl + W_DOWN), DFF, 0, 0, 1.f, scr, r, lane); continue; } r -= n_dn;
        if (r < n_q) { transpose_item(a.in[16] + (size_t)l * 192 * 384, 384, (bf16*)(wl + W_B2), 384, 0, 0, MLAQS, scr, r, lane); continue; } r -= n_q;
        transpose_item(a.in[18] + (size_t)l * 128 * 512, 512, (bf16*)(wl + W_B2), 384, 384, 192, 1.f, scr, r, lane);
    }
}
template <class ArgsRef>
__device__ __forceinline__ void phase0(const ArgsRef& a, LAS unsigned char* lds, int tid, int lane, int wave) {
    unsigned char* ws = a.ws;
    const int G = gridDim.x, bid = blockIdx.x;
    if (bid < 96) {
        LAS float* sl = (LAS float*)(lds + 16384);
        for (int e = tid; e < 3072; e += NT) { const int c = e >> 10, k = e & 1023; const float v = c == 0 ? a.in[9][k] : a.in[8][(c - 1) * 1024 + k]; sl[e] = v / (1.f + __expf(-v)); }
        __syncthreads();
    }
    for (int it = bid; it < 96; it += G) {
        const int l = it / 48, n0 = (it % 48) * 128;
        const float* wa = a.in[10] + (size_t)l * 1024 * 6144;
        const LAS float* sl = (const LAS float*)(lds + 16384);
        float acc[3][2] = {{0.f, 0.f}, {0.f, 0.f}, {0.f, 0.f}};
        const int kb = wave * 128;
#pragma unroll 16
        for (int k = 0; k < 128; ++k) {
            const int kk = kb + k;
            typedef float f32x2_ __attribute__((ext_vector_type(2)));
            const f32x2_ w = __builtin_nontemporal_load((const f32x2_*)(wa + (size_t)kk * 6144 + n0 + 2 * lane));
            const float s0 = sl[kk], s1 = sl[1024 + kk], s2 = sl[2048 + kk];
            acc[0][0] += s0 * w.x; acc[0][1] += s0 * w.y; acc[1][0] += s1 * w.x; acc[1][1] += s1 * w.y; acc[2][0] += s2 * w.x; acc[2][1] += s2 * w.y;
        }
        LAS float* red = (LAS float*)lds;
#pragma unroll
        for (int c = 0; c < 3; ++c) { red[(wave * 3 + c) * 128 + 2 * lane] = acc[c][0]; red[(wave * 3 + c) * 128 + 2 * lane + 1] = acc[c][1]; }
        __syncthreads();
        if (tid < 384) { const int c = tid / 128, n = tid % 128; float s = 0.f;
#pragma unroll
            for (int w = 0; w < 8; ++w) s += red[(w * 3 + c) * 128 + n];
            ((float*)(ws + WS_MOD))[(size_t)(l * 3 + c) * 6144 + n0 + n] = s + a.in[11][(size_t)l * 6144 + n0 + n]; }
        __syncthreads();
    }
    if (bid == G - 1) {
        float* rt = (float*)(ws + WS_ROPE);
        for (int e = tid; e < 1024; e += NT) { const int pos = e >> 4, i = e & 15; const float inv = exp2f(-(float)(2 * i) / 32.f * 13.287712379549449f); const float ang = (float)pos * inv;
            rt[e] = __cosf(ang); rt[1024 + e] = __sinf(ang); }
        for (int e = tid; e < 512; e += NT) { const int pos = e >> 3, i = e & 7; const float inv = exp2f(-(float)(2 * i) / 16.f * 13.287712379549449f); const float ang = (float)pos * inv;
            rt[2048 + e] = __cosf(ang); rt[2560 + e] = __sinf(ang); }
    }
    const int gt = bid * NT + tid, NGT = G * NT;
    if (gt < 256) ((unsigned*)(ws + WS_CTL))[gt] = 0u;
    if (gt < 64) ((unsigned*)(ws + WS_CTL))[2048 + gt] = 0u;
    for (int l = 0; l < 2; ++l) {
        bf16* b2 = (bf16*)(ws + WS_W + l * W_LSTRIDE + W_B2);
        for (int ch = gt; ch < 1024 * 48; ch += NGT) { const int n = ch / 48, k = (ch % 48) * 8;
            const bool data = (n < 384 && k < 192) || (n >= 384 && n < 896 && k >= 192 && k < 320);
            if (!data) *(u32x4*)(b2 + (size_t)n * 384 + k) = (u32x4){0u, 0u, 0u, 0u}; }
        bf16* wi = (bf16*)(ws + WS_W + l * W_LSTRIDE + W_IN) + (size_t)INC * 1024;
        for (int ch = gt; ch < 160 * 128; ch += NGT) *(u32x4*)(wi + (size_t)ch * 8) = (u32x4){0u, 0u, 0u, 0u};
    }
    LAS float* scr = (LAS float*)(lds + 28672 + wave * 16640);
    wconv(a, ws, 0, 1 | 2 | 16 | 32, ((bid + G - (G > 96 ? 96 : 0)) % G) * NW + wave, G * NW, scr, lane);
}

__device__ __forceinline__ void prep_phase(const float* x0, const float* x1, const float* nw, const float* mod, int sc_off, bf16* XN, float* SS, int lane, int gw, int NGW) {
    for (int row = gw; row < NTOK; row += NGW) {
        const float* xr = row < NPR ? x0 + (size_t)row * DM : x1 + (size_t)(row - NPR) * DM;
        const int c = row < NPR ? 0 : 1 + ((row - NPR) >> 11);
        const float* mp = mod + c * 6144;
        f32x4 v[4]; float ss = 0.f;
#pragma unroll
        for (int j = 0; j < 4; ++j) { v[j] = __builtin_nontemporal_load((const f32x4*)(xr + 4 * (lane + 64 * j))); ss += dot4(v[j]); }
        ss = wave_sum(ss, lane);
#pragma unroll
        for (int j = 0; j < 4; ++j) { const int col = 4 * (lane + 64 * j);
            const f32x4 g = *(const f32x4*)(nw + col), sc = *(const f32x4*)(mp + sc_off + col);
            st4bf(XN + (size_t)row * DM + col, v[j] * g * (1.f + sc)); }
        if (lane < 16) SS[(size_t)row * 16 + lane] = lane == 0 ? ss : 0.f;
    }
}
template <class ArgsRef>
__device__ __forceinline__ void bias_phase(const ArgsRef& a, unsigned char* ws, LAS unsigned char* lds, int tid, int lane, int wave) {
    const float* mod = (const float*)(ws + WS_MOD);
    float* BIAS = (float*)(ws + WS_BIAS);
    for (int it = blockIdx.x; it < 62; it += gridDim.x) {
        const int l = it / 31, r = it % 31; const bool up = r >= 9;
        const int N = up ? DUP : INC, n0 = (up ? r - 9 : r) * 256 + 4 * lane;
        const float* W = up ? a.in[24] + (size_t)l * 1024 * DUP : a.in[13] + (size_t)l * 1024 * INC;
        const float* shp = mod + (size_t)l * 3 * 6144 + (up ? 3072 : 0);
        LAS float* sl = (LAS float*)(lds + 32768);
        for (int e = tid; e < 3072; e += NT) sl[e] = shp[(e >> 10) * 6144 + (e & 1023)];
        __syncthreads();
        const bool act = n0 < N;
        f32x4 acc[3] = {(f32x4){0.f, 0.f, 0.f, 0.f}, (f32x4){0.f, 0.f, 0.f, 0.f}, (f32x4){0.f, 0.f, 0.f, 0.f}};
        const int kb = wave * 128;
#pragma unroll 16
        for (int k = 0; k < 128; ++k) { const int kk = kb + k;
            const f32x4 w = act ? __builtin_nontemporal_load((const f32x4*)(W + (size_t)kk * N + n0)) : (f32x4){0.f, 0.f, 0.f, 0.f};
            acc[0] += w * sl[kk]; acc[1] += w * sl[1024 + kk]; acc[2] += w * sl[2048 + kk]; }
        LAS f32x4* red = (LAS f32x4*)lds;
#pragma unroll
        for (int c = 0; c < 3; ++c) red[(wave * 3 + c) * 64 + lane] = acc[c];
        __syncthreads();
        if (tid < 192) { const int c = tid >> 6, ln = tid & 63; f32x4 t = red[c * 64 + ln];
#pragma unroll
            for (int w = 1; w < 8; ++w) t += red[(w * 3 + c) * 64 + ln];
            const int nn = (up ? r - 9 : r) * 256 + 4 * ln;
            if (nn < N) *(f32x4*)(BIAS + (size_t)(l * 3 + c) * NBIAS + (up ? 2304 : 0) + nn) = t;
            else if (!up && nn < 2304) *(f32x4*)(BIAS + (size_t)(l * 3 + c) * NBIAS + nn) = (f32x4){0.f, 0.f, 0.f, 0.f}; }
        __syncthreads();
    }
}

struct P3Ptrs {
    const bf16* PROJ; bf16 *A2, *KPE, *YCAT, *Qc_rot, *Qc_raw, *Kc, *Vc, *Qd_rot, *Qd_raw, *Kd, *Vd;
    const float *conv_a, *gq_mla, *gkv_mla, *gq, *gk, *rope;
    const float *c_ckv, *c_kpe, *c_gk, *c_gv, *c_sk, *c_sv;
    float *o_ckv, *o_kpe, *o_gk, *o_gv, *o_sk, *o_sv;
    int l;
};
__device__ __forceinline__ f32x4 rope64(f32x4 v, int jl, int prow, int pcol, const float* rt, int lane) {
    const f32x4 pr = shfl4(v, 4, lane);
    const int pos = jl < 8 ? prow : pcol, fi = 4 * (jl & 3);
    const f32x4 c = *(const f32x4*)(rt + pos * 16 + fi), s = *(const f32x4*)(rt + 1024 + pos * 16 + fi);
    const float sg = (jl & 4) ? 1.f : -1.f;
    return v * c + pr * s * sg;
}
__device__ __forceinline__ void p3_phase(const P3Ptrs& P, int lane, int gw, int NGW) {
    const int l = P.l;
    for (int row = gw; row < NKR; row += NGW) {
        if (row < NTOK) {
            const bool samp = row >= NPR;
            int b, t, kr, T;
            if (!samp) { b = row >> 8; t = row & 255; kr = row; T = 256; } else { b = (row - NPR) >> 11; t = (row - NPR) & 2047; kr = NPR + b * 2560 + t; T = 2048; }
            const int prow = t >> 6, pcol = t & 63;
            const bf16* pr = P.PROJ + (size_t)row * INP;
            const size_t ob = (size_t)((b * 2 + l) * 256 + t);
            const int ci = 4 * lane, jl = lane & 15;
            const u32x2 z2 = (u32x2){0u, 0u};
            const bool hp = t > 0, hn = t < T - 1;
            const u32x2 r_xa = *(const u32x2*)(pr + ci), r_gb = *(const u32x2*)(pr + 256 + ci), r_gc = *(const u32x2*)(pr + 512 + ci);
            const u32x2 r_pxa = hp ? *(const u32x2*)(pr - INP + ci) : z2, r_pgc = hp ? *(const u32x2*)(pr - INP + 512 + ci) : z2;
            const u32x2 r_nxa = hn ? *(const u32x2*)(pr + INP + ci) : z2, r_ngc = hn ? *(const u32x2*)(pr + INP + 512 + ci) : z2;
            const u32x2 r_cq = lane < 48 ? *(const u32x2*)(pr + 768 + ci) : z2, r_ckv = lane < 32 ? *(const u32x2*)(pr + 960 + ci) : z2, r_kpe = lane < 8 ? *(const u32x2*)(pr + 1088 + ci) : z2;
            const u32x2 r_qc = *(const u32x2*)(pr + 1120 + ci), r_kvc = *(const u32x2*)(pr + 1376 + ci), r_qd = *(const u32x2*)(pr + 1632 + ci), r_kvd = *(const u32x2*)(pr + 1888 + ci);
            const float* cw = P.conv_a + (size_t)l * 768;
            const f32x4 w0 = *(const f32x4*)(cw + ci), w1 = *(const f32x4*)(cw + 256 + ci), w2 = *(const f32x4*)(cw + 512 + ci);
            const f32x4 g_qm = lane < 48 ? *(const f32x4*)(P.gq_mla + l * 192 + ci) : (f32x4){0.f, 0.f, 0.f, 0.f}, g_kvm = lane < 32 ? *(const f32x4*)(P.gkv_mla + l * 128 + ci) : (f32x4){0.f, 0.f, 0.f, 0.f};
            const f32x4 g_q = *(const f32x4*)(P.gq + l * 64 + 4 * jl), g_k = *(const f32x4*)(P.gk + l * 64 + 4 * jl);
            const int pos64 = jl < 8 ? prow : pcol, fi64 = 4 * (jl & 3);
            const f32x4 c64 = *(const f32x4*)(P.rope + pos64 * 16 + fi64), s64 = *(const f32x4*)(P.rope + 1024 + pos64 * 16 + fi64);
            const int pos32 = (lane & 7) < 4 ? prow : pcol, fi32 = 4 * (lane & 1);
            const f32x4 c32 = *(const f32x4*)(P.rope + 2048 + pos32 * 8 + fi32), s32 = *(const f32x4*)(P.rope + 2560 + pos32 * 8 + fi32);
#define CV4(u) ((f32x4){bflo((u).x), bfhi((u).x), bflo((u).y), bfhi((u).y)})
#define ROPE64(v) ((v) * c64 + shfl4((v), 4, lane) * s64 * ((jl & 4) ? 1.f : -1.f))
            { const f32x4 ya = CV4(r_gb) * (w0 * (CV4(r_pxa) * CV4(r_pgc)) + w1 * (CV4(r_xa) * CV4(r_gc)) + w2 * (CV4(r_nxa) * CV4(r_ngc)));
              st4bf(P.YCAT + (size_t)row * DM + ci, ya); }
            { const f32x4 v = CV4(r_cq);
              const float rs = rsqrtf(wave_sum(dot4(v), lane) * (1.f / 192.f) + EPS);
              if (lane < 48) st4bf(P.A2 + (size_t)kr * 384 + ci, v * rs * g_qm); }
            { const f32x4 v = CV4(r_ckv);
              const float rs = rsqrtf(wave_sum(dot4(v), lane) * (1.f / 128.f) + EPS);
              if (lane < 32) { const f32x4 o = v * rs * g_kvm;
                  st4bf(P.A2 + (size_t)kr * 384 + 192 + ci, o);
                  if (!samp) __builtin_nontemporal_store((f32x4)(o), (f32x4*)(P.o_ckv + ob * 128 + ci)); }
              else if (lane < 48) { unsigned zz = 0u; asm volatile("" : "+v"(zz)); *(u32x2*)(P.A2 + (size_t)kr * 384 + 320 + 4 * (lane - 32)) = (u32x2){zz, zz}; } }
            { const f32x4 v = CV4(r_kpe);
              const f32x4 r = v * c32 + shfl4(v, 2, lane) * s32 * ((lane & 2) ? 1.f : -1.f);
              if (lane < 8) { if (!samp) __builtin_nontemporal_store((f32x4)(v), (f32x4*)(P.o_kpe + ob * 32 + ci)); st4bf(P.KPE + (size_t)kr * 32 + ci, samp ? r : v); } }
            { f32x4 v = CV4(r_qc);
              const float rs = rsqrtf(sum16(dot4(v), lane) * (1.f / 64.f) + EPS);
              v = v * rs * g_q;
              st4bf(P.Qc_raw + (size_t)kr * 256 + ci, v * QS);
              const f32x4 r = ROPE64(v);
              if (samp) st4bf(P.Qc_rot + (size_t)kr * 256 + ci, r * QS); }
            { const f32x4 v = CV4(r_kvc);
              const float rs = rsqrtf(sum16(dot4(v), lane) * (1.f / 64.f) + EPS);
              const f32x4 kn = v * rs * g_k;
              const f32x4 r = ROPE64(kn);
              if (lane < 32) { if (!samp) __builtin_nontemporal_store((f32x4)(kn), (f32x4*)(P.o_gk + ob * 128 + ci)); st4bf(P.Kc + (size_t)kr * 128 + ci, samp ? r : kn); }
              else { if (!samp) __builtin_nontemporal_store((f32x4)(v), (f32x4*)(P.o_gv + ob * 128 + 4 * (lane - 32))); st4bf(P.Vc + (size_t)kr * 128 + 4 * (lane - 32), v); } }
            { const f32x4 v = CV4(r_qd);
              st4bf(P.Qd_raw + (size_t)kr * 256 + ci, v * QS);
              const f32x4 r = ROPE64(v);
              if (samp) st4bf(P.Qd_rot + (size_t)kr * 256 + ci, r * QS); }
            { const f32x4 v = CV4(r_kvd);
              const f32x4 r = ROPE64(v);
              if (lane < 32) { if (!samp) __builtin_nontemporal_store((f32x4)(v), (f32x4*)(P.o_sk + ob * 128 + ci)); st4bf(P.Kd + (size_t)kr * 128 + ci, samp ? r : v); }
              else { if (!samp) __builtin_nontemporal_store((f32x4)(v), (f32x4*)(P.o_sv + ob * 128 + 4 * (lane - 32))); st4bf(P.Vd + (size_t)kr * 128 + 4 * (lane - 32), v); } }
#undef CV4
#undef ROPE64
        } else {
            const int ci = row - NTOK, b = ci >> 9, j = ci & 511, kr = NPR + b * 2560 + 2048 + j;
            const size_t cb = (size_t)((b * 2 + l) * 512 + j);
            f32x4 z = (f32x4){0.f, 0.f, 0.f, 0.f}; asm volatile("" : "+v"(z));
            if (lane < 48) st4bf(P.A2 + (size_t)kr * 384 + 4 * lane, z);
            if (lane < 32) st4bf(P.A2 + (size_t)kr * 384 + 192 + 4 * lane, __builtin_nontemporal_load((const f32x4*)(P.c_ckv + cb * 128 + 4 * lane)));
            else if (lane < 48) st4bf(P.A2 + (size_t)kr * 384 + 320 + 4 * (lane - 32), z);
            if (lane < 8) st4bf(P.KPE + (size_t)kr * 32 + 4 * lane, __builtin_nontemporal_load((const f32x4*)(P.c_kpe + cb * 32 + 4 * lane)));
            if (lane < 32) { st4bf(P.Kc + (size_t)kr * 128 + 4 * lane, __builtin_nontemporal_load((const f32x4*)(P.c_gk + cb * 128 + 4 * lane)));
                             st4bf(P.Kd + (size_t)kr * 128 + 4 * lane, __builtin_nontemporal_load((const f32x4*)(P.c_sk + cb * 128 + 4 * lane))); }
            else { st4bf(P.Vc + (size_t)kr * 128 + 4 * (lane - 32), __builtin_nontemporal_load((const f32x4*)(P.c_gv + cb * 128 + 4 * (lane - 32))));
                   st4bf(P.Vd + (size_t)kr * 128 + 4 * (lane - 32), __builtin_nontemporal_load((const f32x4*)(P.c_sv + cb * 128 + 4 * (lane - 32)))); }
        }
    }
}

struct AttnSrc {
    const bf16* Qraw; const bf16* Qrot; int qpitch;
    const bf16* K0; int k0pitch; const bf16* K1;
    const bf16* V; int vpitch;
    bf16* Y; int outcol;
    int krbase, rowbase, q0, lo, hi, nctx;
    bool samp, window; float m0; bool sink;
    const float* rope;
};
template <int DK>
__device__ __forceinline__ void attn_unit(const AttnSrc& S, LAS unsigned char* lds, int tid, int lane, int wave, unsigned* ctr, unsigned& nxt_u) {
    constexpr int TK = 128, NKB = TK / 16, NPP = TK / 32;
    constexpr int KP = DK + 8, VP = TK + 8, KS = DK / 32, CPK = DK / 8;
    constexpr int NKC = TK * CPK / NT, NVC = TK * 8 / NT;
    LAS bf16* Ks = (LAS bf16*)lds;
    LAS bf16* Vt = (LAS bf16*)(lds + 2 * TK * KP * 2);
    const int g = lane >> 4, fr = lane & 15;
    const int qpos = S.q0 + wave * 16 + fr;
    const size_t qkr = (size_t)(S.krbase + qpos);
    bf16x8 qraw[KS], qrot[KS];
#pragma unroll
    for (int ks = 0; ks < KS; ++ks) { qraw[ks] = *(const bf16x8*)(S.Qraw + qkr * S.qpitch + ks * 32 + g * 8); qrot[ks] = qraw[ks]; }
    if (S.samp) {
        if (DK == 96) {
            const bf16x8 own = qraw[KS - 1], par = *(const bf16x8*)(S.Qraw + qkr * S.qpitch + 64 + (g ^ 1) * 8);
            const int pos = g < 2 ? (qpos >> 6) : (qpos & 63);
            const float sg = (g & 1) ? 1.f : -1.f;
            const float* ct = S.rope + 2048 + pos * 8; const float* st = S.rope + 2560 + pos * 8;
            bf16x8 r;
#pragma unroll
            for (int e = 0; e < 8; ++e) { const float o = bflo((unsigned)(unsigned short)own[e]), p = bflo((unsigned)(unsigned short)par[e]);
                r[e] = (short)f2bf(o * ct[e] + p * st[e] * sg); }
            qrot[KS - 1] = r;
        } else {
#pragma unroll
            for (int ks = 0; ks < KS; ++ks) qrot[ks] = *(const bf16x8*)(S.Qrot + qkr * S.qpitch + ks * 32 + g * 8);
        }
    }
    bf16x8 qc[KS];
#pragma unroll
    for (int ks = 0; ks < KS; ++ks) qc[ks] = S.samp ? qrot[ks] : qraw[ks];
    float m = S.m0, l = (S.sink && g == 0) ? 1.f : 0.f;
    f32x4 o[4];
#pragma unroll
    for (int d = 0; d < 4; ++d) o[d] = (f32x4){0.f, 0.f, 0.f, 0.f};
    const int nloc = S.hi - S.lo, ntile = nloc + S.nctx;
    u32x4 kreg[NKC], vreg[NVC];
    auto gload = [&](int j) {
        const int tile = j < nloc ? S.lo + j : (2048 / TK) + (j - nloc);
        const size_t kr = (size_t)(S.krbase + tile * TK);
#pragma unroll
        for (int c = 0; c < NKC; ++c) { const int ch = tid + c * NT, key = ch / CPK, part = ch % CPK;
            if (DK == 64) kreg[c] = *(const u32x4*)(S.K0 + (kr + key) * S.k0pitch + part * 8);
            else kreg[c] = part < 8 ? *(const u32x4*)(S.K0 + (kr + key) * S.k0pitch + part * 8) : *(const u32x4*)(S.K1 + (kr + key) * 32 + (part - 8) * 8); }
#pragma unroll
        for (int c = 0; c < NVC; ++c) { const int ch = tid + c * NT, vkey = ch & (TK - 1), vdc = ch / TK;
            vreg[c] = *(const u32x4*)(S.V + (kr + vkey) * S.vpitch + vdc * 8); }
    };
    auto lstore = [&](int buf) {
        LAS bf16* kb = Ks + buf * TK * KP; LAS bf16* vb = Vt + buf * 64 * VP;
#pragma unroll
        for (int c = 0; c < NKC; ++c) { const int ch = tid + c * NT, key = ch / CPK, part = ch % CPK; *(LAS u32x4*)(kb + key * KP + part * 8) = kreg[c]; }
#pragma unroll
        for (int c = 0; c < NVC; ++c) { const int ch = tid + c * NT, vkey = ch & (TK - 1), vdc = ch / TK;
            LAS bf16* vp = vb + (vdc * 8) * VP + vkey; const u32x4 v = vreg[c];
            vp[0 * VP] = (bf16)(v.x & 0xffffu); vp[1 * VP] = (bf16)(v.x >> 16); vp[2 * VP] = (bf16)(v.y & 0xffffu); vp[3 * VP] = (bf16)(v.y >> 16);
            vp[4 * VP] = (bf16)(v.z & 0xffffu); vp[5 * VP] = (bf16)(v.z >> 16); vp[6 * VP] = (bf16)(v.w & 0xffffu); vp[7 * VP] = (bf16)(v.w >> 16); }
    };
    gload(0); lstore(0);
    __syncthreads();
    for (int j = 0; j < ntile; ++j) {
        const int buf = j & 1;
        if (j + 1 < ntile) gload(j + 1);
        else if (tid == 0) nxt_u = atomicAdd(ctr, 1u);
        const bool loc = j < nloc;
        if (j == nloc) {
#pragma unroll
            for (int ks = 0; ks < KS; ++ks) qc[ks] = qraw[ks]; }
        const LAS bf16* kb = Ks + buf * TK * KP; const LAS bf16* vb = Vt + buf * 64 * VP;
        f32x4 s[NKB];
#pragma unroll
        for (int kk = 0; kk < NKB; ++kk) { s[kk] = (f32x4){0.f, 0.f, 0.f, 0.f};
#pragma unroll
            for (int ks = 0; ks < KS; ++ks) { const bf16x8 af = *(const LAS bf16x8*)(kb + (kk * 16 + fr) * KP + ks * 32 + g * 8);
                s[kk] = __builtin_amdgcn_mfma_f32_16x16x32_bf16(af, qc[ks], s[kk], 0, 0, 0); } }
        if (S.window && loc) {
            const int kp0 = (S.lo + j) * TK + g * 4;
#pragma unroll
            for (int kk = 0; kk < NKB; ++kk)
#pragma unroll
                for (int i = 0; i < 4; ++i) { const int d = kp0 + kk * 16 + i - qpos; if (d > 128 || d < -128) s[kk][i] = -INFINITY; }
        }
        float mx = -INFINITY;
#pragma unroll
        for (int kk = 0; kk < NKB; ++kk) mx = fmaxf(mx, fmaxf(fmaxf(s[kk][0], s[kk][1]), fmaxf(s[kk][2], s[kk][3])));
        if (__builtin_amdgcn_ballot_w64(mx > m + 8.f) != 0ull) {
            mx = fmaxf(mx, shx(mx, 16, lane)); mx = fmaxf(mx, shx(mx, 32, lane));
            const float mn = fmaxf(m, mx), alpha = __builtin_amdgcn_exp2f(m - mn);
            m = mn; l = l * alpha;
#pragma unroll
            for (int d = 0; d < 4; ++d) o[d] = o[d] * alpha;
        }
        float ls = 0.f;
#pragma unroll
        for (int kk = 0; kk < NKB; ++kk)
#pragma unroll
            for (int i = 0; i < 4; ++i) { const float p = __builtin_amdgcn_exp2f(s[kk][i] - m); s[kk][i] = p; ls += p; }
        l += ls;
        bf16x8 pf[NPP];
#pragma unroll
        for (int pp = 0; pp < NPP; ++pp) {
            const unsigned w0 = pk2(s[2 * pp][0], s[2 * pp][1]), w1 = pk2(s[2 * pp][2], s[2 * pp][3]), w2 = pk2(s[2 * pp + 1][0], s[2 * pp + 1][1]), w3 = pk2(s[2 * pp + 1][2], s[2 * pp + 1][3]);
            pf[pp] = __builtin_bit_cast(bf16x8, (u32x4){w0, w1, w2, w3});
        }
#pragma unroll
        for (int d = 0; d < 4; ++d)
#pragma unroll
            for (int pp = 0; pp < NPP; ++pp) {
                const LAS bf16* vr = vb + (d * 16 + fr) * VP + pp * 32 + g * 4;
                const u32x2 lo = *(const LAS u32x2*)vr, hi = *(const LAS u32x2*)(vr + 16);
                const bf16x8 af = __builtin_bit_cast(bf16x8, (u32x4){lo.x, lo.y, hi.x, hi.y});
                o[d] = __builtin_amdgcn_mfma_f32_16x16x32_bf16(af, pf[pp], o[d], 0, 0, 0);
            }
        if (j + 1 < ntile) lstore(buf ^ 1);
        __syncthreads();
    }
    float lt = l + shx(l, 16, lane); lt += shx(lt, 32, lane);
    const float inv = 1.f / lt;
    bf16* yr = S.Y + (size_t)(S.rowbase + qpos) * DM + S.outcol + g * 4;
#pragma unroll
    for (int d = 0; d < 4; ++d) st4bf(yr + d * 16, o[d] * inv);
}

struct AttnBufs { const bf16 *MQKV, *KPE, *Qc_rot, *Qc_raw, *Kc, *Vc, *Qd_rot, *Qd_raw, *Kd, *Vd; bf16* YCAT; const float* sink; const float* rope; unsigned* ctr; };
constexpr int ATT_NU = 384 + 768;
__device__ __forceinline__ void attn_phase(const AttnBufs& B, LAS unsigned char* lds, int tid, int lane, int wave) {
    volatile LAS unsigned* shu = (volatile LAS unsigned*)(lds + LDS_CTL);
    if (tid == 0) *shu = atomicAdd(B.ctr, 1u);
    __syncthreads();
    for (;;) {
        const int u = (int)*shu;
        if (u >= ATT_NU) break;
        unsigned nxt_u = 0u;
        int type, b, h, qt; bool samp;
        if (u < 384) { type = u >> 7; const int v = u & 127; b = v >> 6; h = (v >> 4) & 3; qt = v & 15; samp = true; }
        else { const int w = u - 384; type = w >> 8; const int v = w & 255; b = v >> 3; h = (v >> 1) & 3; qt = v & 1; samp = false; }
        AttnSrc S;
        S.samp = samp; S.q0 = qt * 128; S.rope = B.rope; S.Y = B.YCAT;
        S.krbase = samp ? NPR + b * 2560 : b * 256; S.rowbase = samp ? NPR + b * 2048 : b * 256;
        S.window = false; S.sink = false; S.m0 = -1e30f;
        if (!samp) { S.lo = 0; S.hi = 2; S.nctx = 0; }
        else { S.lo = 0; S.hi = 16; S.nctx = 4; }
        if (type == 0) {
            S.Qraw = B.MQKV + h * 96; S.Qrot = S.Qraw; S.qpitch = 1024; S.K0 = B.MQKV + 384 + h * 128; S.k0pitch = 1024; S.K1 = B.KPE; S.V = B.MQKV + 384 + h * 128 + 64; S.vpitch = 1024; S.outcol = 256 + h * 64;
            attn_unit<96>(S, lds, tid, lane, wave, B.ctr, nxt_u);
        } else {
            if (type == 1) { S.Qraw = B.Qc_raw + h * 64; S.Qrot = B.Qc_rot + h * 64; S.K0 = B.Kc + (h >> 1) * 64; S.V = B.Vc + (h >> 1) * 64; S.outcol = 512 + h * 64; }
            else { S.Qraw = B.Qd_raw + h * 64; S.Qrot = B.Qd_rot + h * 64; S.K0 = B.Kd + (h >> 1) * 64; S.V = B.Vd + (h >> 1) * 64; S.outcol = 768 + h * 64;
                   S.sink = true; S.m0 = B.sink[h] * LOG2E;
                   if (samp) { S.window = true; const int lo = S.q0 / 128 - 1; S.lo = lo < 0 ? 0 : lo; const int hi = S.q0 / 128 + 2; S.hi = hi > 16 ? 16 : hi; } }
            S.qpitch = 256; S.k0pitch = 128; S.K1 = nullptr; S.vpitch = 128;
            attn_unit<64>(S, lds, tid, lane, wave, B.ctr, nxt_u);
        }
        if (tid == 0) *shu = nxt_u;
        __syncthreads();
    }
}

__device__ __forceinline__ void load8(const bf16* p, float (&o)[8]) { const u32x4 u = *(const u32x4*)p; o[0] = bflo(u.x); o[1] = bfhi(u.x); o[2] = bflo(u.y); o[3] = bfhi(u.y); o[4] = bflo(u.z); o[5] = bfhi(u.z); o[6] = bflo(u.w); o[7] = bfhi(u.w); }
__device__ __forceinline__ void convgate_phase(const bf16* U, const float* cf, bf16* ACT, int gt, int NGT) {
    constexpr int NCH = DFF / 8, RG = 8;
    for (int it = gt; it < (NTOK / RG) * NCH; it += NGT) {
        const int rg = it / NCH, cc = it % NCH, r0 = rg * RG, col = cc * 8;
        const bool samp = r0 >= NPR; const int t0 = samp ? ((r0 - NPR) & 2047) : (r0 & 255), T = samp ? 2048 : 256;
        const bf16* up = U + (size_t)r0 * DUP + col;
        u32x4 ra[RG + 2], rb[RG + 2];
        const u32x4 z4 = (u32x4){0u, 0u, 0u, 0u};
        ra[0] = z4; rb[0] = z4; ra[RG + 1] = z4; rb[RG + 1] = z4;
        if (t0 > 0) { ra[0] = *(const u32x4*)(up - DUP); rb[0] = *(const u32x4*)(up - DUP + DFF); }
#pragma unroll
        for (int i = 0; i < RG; ++i) { ra[i + 1] = *(const u32x4*)(up + (size_t)i * DUP); rb[i + 1] = *(const u32x4*)(up + (size_t)i * DUP + DFF); }
        if (t0 + RG < T) { ra[RG + 1] = *(const u32x4*)(up + (size_t)RG * DUP); rb[RG + 1] = *(const u32x4*)(up + (size_t)RG * DUP + DFF); }
        float wa[3][8], wb[3][8];
#pragma unroll
        for (int k = 0; k < 3; ++k) { const f32x4 a0 = *(const f32x4*)(cf + k * DUP + col), a1 = *(const f32x4*)(cf + k * DUP + col + 4), b0 = *(const f32x4*)(cf + k * DUP + DFF + col), b1 = *(const f32x4*)(cf + k * DUP + DFF + col + 4);
#pragma unroll
            for (int e = 0; e < 4; ++e) { wa[k][e] = a0[e]; wa[k][4 + e] = a1[e]; wb[k][e] = b0[e]; wb[k][4 + e] = b1[e]; } }
#pragma unroll
        for (int i = 0; i < RG; ++i) {
            float r[8];
#pragma unroll
            for (int h = 0; h < 4; ++h) {
                const unsigned pa = ra[i][h], ca = ra[i + 1][h], na = ra[i + 2][h], pb = rb[i][h], cb = rb[i + 1][h], nb = rb[i + 2][h];
                const float xa0 = wa[0][2 * h] * bflo(pa) + wa[1][2 * h] * bflo(ca) + wa[2][2 * h] * bflo(na), xb0 = wb[0][2 * h] * bflo(pb) + wb[1][2 * h] * bflo(cb) + wb[2][2 * h] * bflo(nb);
                const float xa1 = wa[0][2 * h + 1] * bfhi(pa) + wa[1][2 * h + 1] * bfhi(ca) + wa[2][2 * h + 1] * bfhi(na), xb1 = wb[0][2 * h + 1] * bfhi(pb) + wb[1][2 * h + 1] * bfhi(cb) + wb[2][2 * h + 1] * bfhi(nb);
                r[2 * h] = xa0 * __builtin_amdgcn_rcpf(1.f + __builtin_amdgcn_exp2f(-xa0 * LOG2E)) * xb0;
                r[2 * h + 1] = xa1 * __builtin_amdgcn_rcpf(1.f + __builtin_amdgcn_exp2f(-xa1 * LOG2E)) * xb1;
            }
            u32x4 w; w.x = pk2(r[0], r[1]); w.y = pk2(r[2], r[3]); w.z = pk2(r[4], r[5]); w.w = pk2(r[6], r[7]);
            *(u32x4*)(ACT + (size_t)(r0 + i) * DFF + col) = w;
        }
    }
}

#define XB_TMO      128
#define XB_XCNT(j)  (256  + 64 * (j))
#define XB_XSUB(j)  (1280 + 64 * (j))
#define XB_XGEN(j)  (2304 + 64 * (j))
#define XB_TOP      3328
#define XB_TOPGEN   3392
#define XCD_BAR_WORDS 3456
#define XB_SPIN_CAP (1u << 20)
__device__ __forceinline__ unsigned xb_ld(unsigned* p)              { return __hip_atomic_load(p, __ATOMIC_RELAXED, __HIP_MEMORY_SCOPE_AGENT); }
__device__ __forceinline__ unsigned xb_add(unsigned* p, unsigned v) { return __hip_atomic_fetch_add(p, v, __ATOMIC_RELAXED, __HIP_MEMORY_SCOPE_AGENT); }
__device__ __forceinline__ unsigned xb_xcc_id() { return (unsigned)__builtin_amdgcn_s_getreg((3 << 11) | 20) & 0xFu; }
#define XB_SPIN(cond, bar) do { unsigned _sp = 0; while (cond) { __builtin_amdgcn_s_sleep(1); \
    if ((++_sp & 255u) == 0u) { if (xb_ld(&(bar)[XB_TMO])) break; if (_sp > XB_SPIN_CAP) { atomicAdd(&(bar)[XB_TMO], 1u); break; } } } } while (0)
struct XcdBarrier { unsigned* bar; unsigned x; volatile LAS unsigned* st; };
__device__ __forceinline__ void xcd_barrier_complete(unsigned* bar, unsigned x, unsigned& nloc, unsigned& nx) {
    const unsigned G = gridDim.x * gridDim.y * gridDim.z;
    unsigned sum, cnt, mine, sp = 0u;
    for (;;) {
        sum = 0u; cnt = 0u; mine = 0u;
#pragma unroll
        for (unsigned j = 0; j < 16; ++j) { const unsigned c = xb_ld(&bar[XB_XCNT(j)]); sum += c; cnt += (c > 0u) ? 1u : 0u; mine = (j == x) ? c : mine; }
        if (sum == G) break;
        __builtin_amdgcn_s_sleep(1);
        if ((++sp & 255u) == 0u) { if (xb_ld(&bar[XB_TMO])) break; if (sp > XB_SPIN_CAP) { atomicAdd(&bar[XB_TMO], 1u); break; } }
    }
    nloc = mine > 0u ? mine : 1u; nx = cnt > 0u ? cnt : 1u;
}
__device__ __forceinline__ void xcd_barrier(const XcdBarrier& b, const int tid_) {
    asm volatile("s_waitcnt vmcnt(0)" ::: "memory");
    __syncthreads();
    if (tid_ == 0) {
        unsigned* bar = b.bar;
        __builtin_amdgcn_s_waitcnt(0);
        unsigned nloc = b.st[0], nx = b.st[1];
        if (nloc == 0u) { xcd_barrier_complete(bar, b.x, nloc, nx); b.st[0] = nloc; b.st[1] = nx; }
        const unsigned old = xb_add(&bar[XB_XSUB(b.x)], 1u);
        const unsigned gen = old / nloc;
        if (old + 1u == (gen + 1u) * nloc) {
            __builtin_amdgcn_fence(__ATOMIC_RELEASE, "agent");
            asm volatile("s_waitcnt vmcnt(0)" ::: "memory");
            const unsigned og = xb_add(&bar[XB_TOP], 1u);
            const unsigned tg = og / nx;
            if (og + 1u == (tg + 1u) * nx) xb_add(&bar[XB_TOPGEN], 1u);
            else XB_SPIN(xb_ld(&bar[XB_TOPGEN]) == tg, bar);
            __builtin_amdgcn_fence(__ATOMIC_ACQUIRE, "agent");
            xb_add(&bar[XB_XGEN(b.x)], 1u);
            asm volatile("s_waitcnt vmcnt(0)" ::: "memory");
        } else {
            XB_SPIN(xb_ld(&bar[XB_XGEN(b.x)]) == gen, bar);
            __builtin_amdgcn_fence(__ATOMIC_ACQUIRE, "agent");
            asm volatile("s_waitcnt vmcnt(0)" ::: "memory");
        }
    }
    __syncthreads();
}

__device__ __forceinline__ int lane_id_volatile() { int l; asm volatile("v_mbcnt_lo_u32_b32 %0, -1, 0\n\tv_mbcnt_hi_u32_b32 %0, -1, %0" : "=v"(l)); return l; }

#ifndef PH
#define PH 0xFFFF
#endif
#define ON(k) ((PH >> (k)) & 1)
#ifndef REP
#define REP 0
#endif
#define NREP(k) (1 + ((REP >> (k)) & 1))
__global__ void __launch_bounds__(NT, 2) mega_fwd(Args a_unused) {
    extern __shared__ __attribute__((aligned(16))) unsigned char lds[];
    cg::grid_group grid = cg::this_grid();
    const int G = gridDim.x, bid = blockIdx.x;
    const int wave_s = __builtin_amdgcn_readfirstlane(threadIdx.x >> 6);
    PG8_LAS unsigned char* ring = (PG8_LAS unsigned char*)lds;
#define PHASE_BEGIN int tid = wave_s * 64 + lane_id_volatile(); asm volatile("" : "+v"(tid)); const CAS Args* ap_ = (const CAS Args*)__builtin_amdgcn_kernarg_segment_ptr(); asm volatile("" : "+s"(ap_)); const CAS Args& a = *ap_; unsigned char* ws = a.ws; float* out = a.out; \
    const int lane = tid & 63, wave = __builtin_amdgcn_readfirstlane(tid >> 6); const int gw = bid * NW + wave, NGW = G * NW, gt = bid * NT + tid, NGT = G * NT; \
    (void)lane; (void)wave; (void)gw; (void)NGW; (void)gt; (void)NGT; (void)out; \
    const float* mod = (const float*)(ws + WS_MOD); const float* rope = (const float*)(ws + WS_ROPE); (void)mod; (void)rope; \
    bf16* XN = (bf16*)(ws + WS_XN); bf16* PROJ = (bf16*)(ws + WS_PROJ); bf16* A2 = (bf16*)(ws + WS_A2); bf16* MQKV = (bf16*)(ws + WS_MQKV); \
    bf16* KPE = (bf16*)(ws + WS_KPE); bf16* YCAT = (bf16*)(ws + WS_YCAT); bf16* ACT = (bf16*)(ws + WS_ACT); bf16* U = (bf16*)(ws + WS_U); \
    bf16* Qc_rot = (bf16*)(ws + WS_QC); bf16* Qc_raw = (bf16*)(ws + WS_QC + QSZ); bf16* Kc = (bf16*)(ws + WS_QC + 2 * QSZ); bf16* Vc = (bf16*)(ws + WS_QC + 2 * QSZ + KSZ); \
    bf16* Qd_rot = (bf16*)(ws + WS_QC + 2 * QSZ + 2 * KSZ); bf16* Qd_raw = Qd_rot + (size_t)NKR * 256; bf16* Kd = Qd_raw + (size_t)NKR * 256; bf16* Vd = Kd + (size_t)NKR * 128; \
    (void)XN; (void)PROJ; (void)A2; (void)MQKV; (void)KPE; (void)YCAT; (void)ACT; (void)U; (void)Qc_rot; (void)Qc_raw; (void)Kc; (void)Vc; (void)Qd_rot; (void)Qd_raw; (void)Kd; (void)Vd;
#define GSYNC() do { const CAS Args* bp_ = (const CAS Args*)__builtin_amdgcn_kernarg_segment_ptr(); asm volatile("" : "+s"(bp_)); XcdBarrier xb_; xb_.bar = (unsigned*)(bp_->ws + WS_BAR); xb_.x = xb_xcc_id(); \
    xb_.st = (volatile LAS unsigned*)((LAS unsigned char*)lds + LDS_CTL + 32); xcd_barrier(xb_, wave_s * 64 + lane_id_volatile()); } while (0)
#define LAYER_VALS const float* modl = mod + (size_t)l * 3 * 6144; unsigned char* wl = ws + WS_W + l * W_LSTRIDE; (void)modl; (void)wl; \
    const float* x0 = l == 0 ? a.in[0] : nullptr; const float* x1 = l == 0 ? a.in[1] : nullptr; (void)x0; (void)x1; bf16* XRES = (bf16*)(ws + WS_XRES); (void)XRES;

    if (threadIdx.x < 16) ((volatile LAS unsigned*)((LAS unsigned char*)lds + LDS_CTL))[threadIdx.x] = 0u;
    __syncthreads();
    { PHASE_BEGIN if (tid == 0) (void)xb_add((unsigned*)(ws + WS_BAR) + XB_XCNT(xb_xcc_id()), 1u);
      if (ws == nullptr) grid.sync(); }
    for (int rep = 0; rep < NREP(0); ++rep) {
    if (ON(0)) { PHASE_BEGIN phase0(a, (LAS unsigned char*)lds, tid, lane, wave); }
    GSYNC(); }

    if (ON(1)) { PHASE_BEGIN
        if (G > 124) {
            if (bid < 62) bias_phase(a, ws, (LAS unsigned char*)lds, tid, lane, wave);
            else prep_phase(a.in[0], a.in[1], a.in[12], mod, 1024, XN, (float*)(ws + WS_SS1), lane, (bid - 62) * NW + wave, (G - 62) * NW);
        } else { bias_phase(a, ws, (LAS unsigned char*)lds, tid, lane, wave);
            prep_phase(a.in[0], a.in[1], a.in[12], mod, 1024, XN, (float*)(ws + WS_SS1), lane, gw, NGW); } }
    GSYNC();
#pragma unroll
    for (int l = 0; l < 2; ++l) {
        for (int rep = 0; rep < NREP(2); ++rep) {
        if (ON(2)) { PHASE_BEGIN LAYER_VALS pg8::Gemm g{XN, (const bf16*)(wl + W_IN), NTOK, INP, DM, 0, 0}; pg8::StaticOrder S; S.init(NTOK, INP, G, bid);
          pg8::EpiBf16RS E{PROJ, INP, (const float*)(ws + WS_SS1), (const float*)(ws + WS_BIAS) + (size_t)l * 3 * NBIAS, NBIAS};
          pg8::gemm_phase<pg8::EpiBf16RS, pg8::StaticOrder, true, true>(ring, g, S, E, tid); }
        GSYNC(); }
        for (int rep = 0; rep < NREP(3); ++rep) {
        if (ON(3)) { PHASE_BEGIN P3Ptrs P; P.PROJ = PROJ; P.A2 = A2; P.KPE = KPE; P.YCAT = YCAT; P.Qc_rot = Qc_rot; P.Qc_raw = Qc_raw; P.Kc = Kc; P.Vc = Vc; P.Qd_rot = Qd_rot; P.Qd_raw = Qd_raw; P.Kd = Kd; P.Vd = Vd;
          P.conv_a = a.in[14]; P.gq_mla = a.in[15]; P.gkv_mla = a.in[17]; P.gq = a.in[19]; P.gk = a.in[20]; P.rope = rope;
          P.c_ckv = a.in[2]; P.c_kpe = a.in[3]; P.c_gk = a.in[4]; P.c_gv = a.in[5]; P.c_sk = a.in[6]; P.c_sv = a.in[7];
          P.o_ckv = out + 12582912; P.o_kpe = out + 14680064; P.o_gk = out + 15204352; P.o_gv = out + 17301504; P.o_sk = out + 19398656; P.o_sv = out + 21495808; P.l = l;
          p3_phase(P, lane, gw, NGW); }
        GSYNC(); }
        for (int rep = 0; rep < NREP(4); ++rep) {
        if (ON(4)) { PHASE_BEGIN LAYER_VALS pg8::Gemm g{A2, (const bf16*)(wl + W_B2), NKR, 1024, 384, 0, 0}; pg8::StaticOrder S; S.init(NKR, 1024, G, bid); pg8::EpiBf16 E{MQKV, 1024};
          pg8::gemm_phase<pg8::EpiBf16, pg8::StaticOrder, true, false>(ring, g, S, E, tid); }
        GSYNC(); }
        for (int rep = 0; rep < NREP(5); ++rep) {
        if (ON(5)) { PHASE_BEGIN AttnBufs B; B.MQKV = MQKV; B.KPE = KPE; B.Qc_rot = Qc_rot; B.Qc_raw = Qc_raw; B.Kc = Kc; B.Vc = Vc; B.Qd_rot = Qd_rot; B.Qd_raw = Qd_raw; B.Kd = Kd; B.Vd = Vd; B.YCAT = YCAT;
          B.sink = a.in[21] + l * 4; B.rope = rope; B.ctr = (unsigned*)(ws + WS_CTL) + 64 * l + 128 * rep;
          attn_phase(B, (LAS unsigned char*)lds, tid, lane, wave); }
        GSYNC(); }
        if (ON(6)) { PHASE_BEGIN LAYER_VALS pg8::Gemm g{YCAT, (const bf16*)(wl + W_OUT), NTOK, DM, DM, 0, 0}; pg8::StaticOrder S; S.init(NTOK, DM, G, bid);
          pg8::EpiResid E{x0, x1, XRES, modl + 2048, XN, (float*)(ws + WS_SS2), a.in[23] + l * DM, modl + 4096};
          pg8::gemm_phase<pg8::EpiResid, pg8::StaticOrder, true, true>(ring, g, S, E, tid);
          if (l == 0) { const int wk = G > 192 ? bid - 192 : bid, nwk = G > 192 ? G - 192 : G;
            if (wk >= 0) wconv(a, ws, 0, 4 | 8, wk * NW + wave, nwk * NW, (LAS float*)((LAS unsigned char*)lds + wave * 16640), lane); } }
        GSYNC();
        for (int rep = 0; rep < NREP(8); ++rep) {
        if (ON(8)) { PHASE_BEGIN LAYER_VALS pg8::Gemm g{XN, (const bf16*)(wl + W_UP), NTOK, DUP, DM, (size_t)128 * DM * 2, (size_t)DFF * DM * 2}; pg8::StaticOrder S; S.init(NTOK, DUP, G, bid);
          pg8::EpiUpGate E{ACT, (const float*)(ws + WS_SS2), (const float*)(ws + WS_BIAS) + (size_t)l * 3 * NBIAS + 2304, NBIAS, a.in[25] + (size_t)l * 3 * DUP, (float*)(ws + WS_HALO), ring + 131072};
          pg8::gemm_phase<pg8::EpiUpGate, pg8::StaticOrder, true, true>(ring, g, S, E, tid); }
        GSYNC(); }
        if (ON(10)) { PHASE_BEGIN LAYER_VALS pg8::Gemm g{ACT, (const bf16*)(wl + W_DOWN), NTOK, DM, DFF, 0, 0}; pg8::StaticOrder S; S.init(NTOK, DM, G, bid);
          {
            const float* cwl = a.in[25] + (size_t)l * 3 * DUP; const float* HALO = (const float*)(ws + WS_HALO); pg8::Unit hu;
            bool fixed = false;
            for (int ui = 0; S.next(ui, hu); ++ui) { if (hu.pm < 32) continue; fixed = true; const int k = hu.pm - 32, pos = k & 7;
                for (int idx = tid; idx < 2 * DFF; idx += NT) { const int which = idx >= DFF ? 1 : 0, j = idx - which * DFF;
                    if (which == 0 ? pos == 0 : pos == 7) continue;
                    const float* Pp = HALO + (size_t)(k * 4 + (which ? 3 : 1)) * DUP; const float* Ep = HALO + (size_t)((which ? k + 1 : k - 1) * 4 + (which ? 0 : 2)) * DUP; const float* wp = cwl + (which ? 2 : 0) * DUP;
                    const float ca = Pp[j] + wp[j] * Ep[j], cb = Pp[DFF + j] + wp[DFF + j] * Ep[DFF + j];
                    const float r = ca * __builtin_amdgcn_rcpf(1.f + __builtin_amdgcn_exp2f(-ca * LOG2E)) * cb;
                    ACT[(size_t)(hu.pm * 256 + (which ? 255 : 0)) * DFF + j] = (bf16)(pk2(r, r) & 0xffffu); } }
            if (fixed) { asm volatile("s_waitcnt vmcnt(0)" ::: "memory"); __syncthreads();
                if (tid == 0) { __builtin_amdgcn_fence(__ATOMIC_RELEASE, "agent"); __builtin_amdgcn_fence(__ATOMIC_ACQUIRE, "agent"); asm volatile("s_waitcnt vmcnt(0)" ::: "memory"); }
                __syncthreads(); } }
          if (l == 1 && G >= 192) {
            pg8::EpiResidFinal E{XRES, out, modl + 5120, (float*)(ws + WS_SS1), a.in[27], (unsigned*)(ws + WS_CTL) + 2048};
            pg8::gemm_phase<pg8::EpiResidFinal, pg8::StaticOrder, true, true>(ring, g, S, E, tid);
          } else {
          pg8::EpiResid E{nullptr, nullptr, XRES, modl + 5120, l == 0 ? XN : nullptr, (float*)(ws + WS_SS1), a.in[12] + DM, mod + (size_t)3 * 6144 + 1024};
          pg8::gemm_phase<pg8::EpiResid, pg8::StaticOrder, true, true>(ring, g, S, E, tid); }
          if (l == 0) { const int wk = G > 192 ? bid - 192 : bid, nwk = G > 192 ? G - 192 : G;
            if (wk >= 0) wconv(a, ws, 1, 63, wk * NW + wave, nwk * NW, (LAS float*)((LAS unsigned char*)lds + wave * 16640), lane); } }
        if (!(l == 1 && G >= 192)) GSYNC();
    }
#ifdef XSYNC
    for (int i = 0; i < XSYNC; ++i) GSYNC();
#endif
    if (G < 192) { PHASE_BEGIN
    const bf16* XRES = (const bf16*)(ws + WS_XRES);
    for (int row = gw; row < NTOK; row += NGW) {
        float* xr = out + (size_t)row * DM;
        f32x4 v[4]; float ss = 0.f;
#pragma unroll
        for (int j = 0; j < 4; ++j) { v[j] = ld4bf(XRES + (size_t)row * DM + 4 * (lane + 64 * j)); ss += dot4(v[j]); }
        const float rs = rsqrtf(wave_sum(ss, lane) * (1.f / DM) + EPS);
#pragma unroll
        for (int j = 0; j < 4; ++j) { const int col = 4 * (lane + 64 * j); *(f32x4*)(xr + col) = v[j] * rs * *(const f32x4*)(a.in[27] + col); }
    } }
}

extern "C" void kernel_launch(void* const* d_in, const int* in_sizes, int n_in, void* d_out, int out_size, void* d_ws, size_t ws_size, hipStream_t stream) {
    static int grid = 0;
    if (grid == 0) {
        if (n_in != 28 || ws_size < WS_END) { fprintf(stderr, "kernel_launch: unexpected n_in %d / ws %zu\n", n_in, ws_size); grid = -1; return; }
        int dev = 0, cus = 0, per_cu = 0;
        hipGetDevice(&dev); hipDeviceGetAttribute(&cus, hipDeviceAttributeMultiprocessorCount, dev);
        hipFuncSetAttribute((const void*)mega_fwd, hipFuncAttributeMaxDynamicSharedMemorySize, LDS_BYTES);
        hipOccupancyMaxActiveBlocksPerMultiprocessor(&per_cu, (const void*)mega_fwd, NT, LDS_BYTES);
        if (per_cu < 1) per_cu = 1;
        grid = cus * per_cu;
        (void)hipGetLastError();
    }
    if (grid < 0) return;
    if (hipMemsetAsync((char*)d_ws + WS_BAR, 0, XCD_BAR_WORDS * 4, stream) != hipSuccess) { fprintf(stderr, "kernel_launch: memset of the barrier words failed\n"); return; }
    Args a{};
    for (int i = 0; i < 28; ++i) a.in[i] = (const float*)d_in[i];
    a.out = (float*)d_out; a.ws = (unsigned char*)d_ws;
    void* args[] = {&a};
    hipError_t e = hipLaunchCooperativeKernel((const void*)mega_fwd, dim3(grid), dim3(NT), args, LDS_BYTES, stream);
    if (e != hipSuccess) fprintf(stderr, "cooperative launch failed: %s (grid %d)\n", hipGetErrorString(e), grid);
}
```
